# Optimizing an MI355X kernel written in HIP

```python
import math
import jax, jax.numpy as jnp
from jax import lax
import numpy as np

D_MODEL = 1024
BATCH = 8
SEQ = 4096
DEPTH = 1

HEAD_DIM = 64
SWA_HEADS = 8
SWA_KV_HEADS = 2
WINDOW = 128
BLOCK = 128
DSA_HEADS = 8
DSA_KV_HEADS = 1
IDX_HEADS = 4
IDX_DIM = 64
TOPK_MAX = 256
D_MIX = (SWA_HEADS + DSA_HEADS) * HEAD_DIM
ROPE_THETA = 10000.0

MIX_SIZES = (
    SWA_HEADS * HEAD_DIM,
    SWA_KV_HEADS * HEAD_DIM,
    SWA_KV_HEADS * HEAD_DIM,
    DSA_HEADS * HEAD_DIM,
    DSA_KV_HEADS * HEAD_DIM,
    DSA_KV_HEADS * HEAD_DIM,
    IDX_HEADS * IDX_DIM,
    IDX_DIM,
    IDX_HEADS,
)
SPLIT_POINTS = [sum(MIX_SIZES[:i + 1]) for i in range(len(MIX_SIZES) - 1)]
VALUE_COLUMNS = (2, 5)

PEER_HEADS = 8
PEER_NKEYS = 128
PEER_DKEY = 256
PEER_TOPK = 16
PEER_EXPERTS = PEER_NKEYS * PEER_NKEYS
PEER_CHUNK = 128

ALPHA = (2.0 * DEPTH) ** 0.25
BETA = (8.0 * DEPTH) ** -0.25
LN_EPS = 1e-5

kernel_name = 'hymba_swa_sink_dsa_peer_deepnorm'


def _layer_norm(t, g, b):
    tf = t.astype(jnp.float32)
    mu = jnp.mean(tf, axis=-1, keepdims=True)
    var = jnp.mean(jnp.square(tf - mu), axis=-1, keepdims=True)
    y = (tf - mu) * lax.rsqrt(var + LN_EPS) * g.astype(jnp.float32) + b.astype(jnp.float32)
    return y.astype(t.dtype)


def _rope_tables(seq, dim):
    inv = ROPE_THETA ** (-jnp.arange(0, dim, 2, dtype=jnp.float32) / dim)
    ang = jnp.arange(seq, dtype=jnp.float32)[:, None] * inv[None, :]
    return jnp.cos(ang), jnp.sin(ang)


def _apply_rope(t, cos, sin):
    half = t.shape[-1] // 2
    t1, t2 = t[..., :half], t[..., half:]
    c = cos[:, None, :].astype(t.dtype)
    s = sin[:, None, :].astype(t.dtype)
    return jnp.concatenate([t1 * c - t2 * s, t2 * c + t1 * s], axis=-1)


def _swa_sink_attention(q, k, v, sinks):
    B, S, H, Dh = q.shape
    Hkv = k.shape[2]
    G = H // Hkv
    nb = S // BLOCK
    qb = q.reshape(B, nb, BLOCK, Hkv, G, Dh)

    def band_keys(t):
        tp = jnp.pad(t, ((0, 0), (BLOCK, 0), (0, 0), (0, 0)))
        prev = tp[:, :S].reshape(B, nb, BLOCK, Hkv, Dh)
        cur = t.reshape(B, nb, BLOCK, Hkv, Dh)
        return jnp.concatenate([prev, cur], axis=2)

    kb, vb = band_keys(k), band_keys(v)
    s = jnp.einsum('bnqkgd,bnskd->bnkgqs', qb, kb).astype(jnp.float32) * (Dh ** -0.5)
    qi = jnp.arange(BLOCK)[:, None]
    sj = jnp.arange(2 * BLOCK)[None, :]
    diff = qi + BLOCK - sj
    band = (diff >= 0) & (diff < WINDOW)
    blk = jnp.arange(nb)[:, None, None]
    valid = band[None] & ((blk > 0) | (sj[None] >= BLOCK))
    s = jnp.where(valid[None, :, None, None], s, -jnp.inf)
    sink = sinks.astype(jnp.float32).reshape(Hkv, G)
    sink_col = jnp.broadcast_to(sink[None, None, :, :, None, None], s.shape[:-1] + (1,))
    p = jax.nn.softmax(jnp.concatenate([s, sink_col], axis=-1), axis=-1)[..., :-1]
    o = jnp.einsum('bnkgqs,bnskd->bnqkgd', p.astype(v.dtype), vb)
    return o.reshape(B, S, H * Dh)


def _dsa_attention(q, k, v, q_idx, k_idx, w_idx):
    B, S, H, Dh = q.shape
    nb = S // BLOCK
    k_sel = min(TOPK_MAX, S // 4)
    spos = jnp.arange(S)
    w_scale = (IDX_HEADS ** -0.5) * (IDX_DIM ** -0.5)

    def to_blocks(a):
        return jnp.moveaxis(a.reshape((B, nb, BLOCK) + a.shape[2:]), 1, 0)

    def one_block(args):
        qb, qib, wib, t0 = args
        qpos = t0 + jnp.arange(BLOCK)
        rel = jax.nn.relu(jnp.einsum('bqhd,bsd->bqhs', qib, k_idx).astype(jnp.float32))
        iscore = jnp.einsum('bqh,bqhs->bqs', wib.astype(jnp.float32) * w_scale, rel)
        iscore = jnp.where(spos[None, None, :] <= qpos[None, :, None], iscore, -jnp.inf)
        _, sel = lax.top_k(iscore, k_sel)
        kg = jax.vmap(lambda kk, ii: kk[ii])(k, sel)
        vg = jax.vmap(lambda vv, ii: vv[ii])(v, sel)
        s = jnp.einsum('bqhd,bqkd->bhqk', qb, kg).astype(jnp.float32) * (Dh ** -0.5)
        valid = sel <= qpos[None, :, None]
        s = jnp.where(valid[:, None], s, -jnp.inf)
        p = jax.nn.softmax(s, axis=-1)
        return jnp.einsum('bhqk,bqkd->bqhd', p.astype(v.dtype), vg)

    starts = jnp.arange(nb) * BLOCK
    o = lax.map(one_block, (to_blocks(q), to_blocks(q_idx), to_blocks(w_idx), starts))
    return jnp.moveaxis(o, 0, 1).reshape(B, S, H * Dh)


def _peer(x, wq, subkeys, u_tab, v_tab):
    B, S, D = x.shape
    xc = x.reshape((B * S) // PEER_CHUNK, PEER_CHUNK, D)

    def chunk(xb):
        q = (xb @ wq).reshape(PEER_CHUNK, PEER_HEADS, 2, PEER_DKEY // 2)
        s = jnp.einsum('chpd,hpnd->chpn', q, subkeys).astype(jnp.float32)
        v1, i1 = lax.top_k(s[:, :, 0], PEER_TOPK)
        v2, i2 = lax.top_k(s[:, :, 1], PEER_TOPK)
        cand = (v1[..., :, None] + v2[..., None, :]).reshape(PEER_CHUNK, PEER_HEADS, PEER_TOPK * PEER_TOPK)
        sc, ci = lax.top_k(cand, PEER_TOPK)
        e = (jnp.take_along_axis(i1, ci // PEER_TOPK, axis=-1) * PEER_NKEYS
             + jnp.take_along_axis(i2, ci % PEER_TOPK, axis=-1))
        g = jax.nn.softmax(sc, axis=-1)
        u = u_tab[e]
        vv = v_tab[e]
        a = jax.nn.gelu(jnp.einsum('cd,chkd->chk', xb, u).astype(jnp.float32), approximate=False)
        return jnp.einsum('chk,chkd->cd', (g * a).astype(x.dtype), vv)

    return lax.map(chunk, xc).reshape(B, S, D)


def setup_inputs(seed: int = 0) -> dict:
    key = jax.random.key(seed)
    ks = jax.random.split(key, 32)
    f32 = jnp.float32
    x = jax.random.normal(ks[0], (BATCH, SEQ, D_MODEL), f32)
    pieces = []
    for i, n in enumerate(MIX_SIZES):
        w = jax.random.normal(ks[1 + i], (DEPTH, D_MODEL, n), f32) * (D_MODEL ** -0.5)
        if i in VALUE_COLUMNS:
            w = w * BETA
        pieces.append(w)
    w_in = jnp.concatenate(pieces, axis=-1)
    idx_k_g = 1.0 + 0.01 * jax.random.normal(ks[12], (DEPTH, IDX_DIM), f32)
    idx_k_b = 0.01 * jax.random.normal(ks[13], (DEPTH, IDX_DIM), f32)
    sinks = 0.5 * jax.random.normal(ks[14], (DEPTH, SWA_HEADS), f32)
    w_o = jax.random.normal(ks[15], (DEPTH, D_MIX, D_MODEL), f32) * (D_MIX ** -0.5) * BETA
    ln1_g = 1.0 + 0.01 * jax.random.normal(ks[16], (DEPTH, D_MODEL), f32)
    ln1_b = 0.01 * jax.random.normal(ks[17], (DEPTH, D_MODEL), f32)
    peer_wq = jax.random.normal(ks[18], (DEPTH, D_MODEL, PEER_HEADS * PEER_DKEY), f32) * (D_MODEL ** -0.5)
    peer_subkeys = jax.random.normal(ks[19], (DEPTH, PEER_HEADS, 2, PEER_NKEYS, PEER_DKEY // 2), f32) * ((PEER_DKEY // 2) ** -0.5)
    peer_u = jax.random.normal(ks[20], (DEPTH, PEER_EXPERTS, D_MODEL), f32) * (D_MODEL ** -0.5)
    peer_v = jax.random.normal(ks[21], (DEPTH, PEER_EXPERTS, D_MODEL), f32) * BETA
    ln2_g = 1.0 + 0.01 * jax.random.normal(ks[22], (DEPTH, D_MODEL), f32)
    ln2_b = 0.01 * jax.random.normal(ks[23], (DEPTH, D_MODEL), f32)
    return {'x': x, 'w_in': w_in, 'idx_k_g': idx_k_g, 'idx_k_b': idx_k_b, 'sinks': sinks,
            'w_o': w_o, 'ln1_g': ln1_g, 'ln1_b': ln1_b, 'peer_wq': peer_wq,
            'peer_subkeys': peer_subkeys, 'peer_u': peer_u, 'peer_v': peer_v,
            'ln2_g': ln2_g, 'ln2_b': ln2_b}


def reference(x, w_in, idx_k_g, idx_k_b, sinks, w_o, ln1_g, ln1_b, peer_wq,
              peer_subkeys, peer_u, peer_v, ln2_g, ln2_b):
    B, S, _ = x.shape
    cos, sin = _rope_tables(S, HEAD_DIM)
    h = x
    for l in range(DEPTH):
        proj = h @ w_in[l]
        qa, ka, va, qb, kb, vb, qi, ki, wi = jnp.split(proj, SPLIT_POINTS, axis=-1)
        qa = _apply_rope(qa.reshape(B, S, SWA_HEADS, HEAD_DIM), cos, sin)
        ka = _apply_rope(ka.reshape(B, S, SWA_KV_HEADS, HEAD_DIM), cos, sin)
        va = va.reshape(B, S, SWA_KV_HEADS, HEAD_DIM)
        qb = _apply_rope(qb.reshape(B, S, DSA_HEADS, HEAD_DIM), cos, sin)
        kb = _apply_rope(kb.reshape(B, S, 1, HEAD_DIM), cos, sin)[:, :, 0]
        qi = _apply_rope(qi.reshape(B, S, IDX_HEADS, IDX_DIM), cos, sin)
        ki = _layer_norm(ki, idx_k_g[l], idx_k_b[l])
        ki = _apply_rope(ki.reshape(B, S, 1, IDX_DIM), cos, sin)[:, :, 0]
        oa = _swa_sink_attention(qa, ka, va, sinks[l])
        ob = _dsa_attention(qb, kb, vb, qi, ki, wi)
        mix = jnp.concatenate([oa, ob], axis=-1) @ w_o[l]
        h = _layer_norm(ALPHA * h + mix, ln1_g[l], ln1_b[l])
        ffn = _peer(h, peer_wq[l], peer_subkeys[l], peer_u[l], peer_v[l])
        h = _layer_norm(ALPHA * h + ffn, ln2_g[l], ln2_b[l])
    return h
```

```cpp
#include <hip/hip_runtime.h>
#include <hip/hip_cooperative_groups.h>
#include <cstdio>
#include <cstdint>
namespace cg = cooperative_groups;

typedef unsigned short bf16_t;
typedef short bf16x8 __attribute__((ext_vector_type(8)));
typedef float f32x4 __attribute__((ext_vector_type(4)));
typedef float f32x16 __attribute__((ext_vector_type(16)));
typedef unsigned u32x4 __attribute__((ext_vector_type(4)));
typedef unsigned u32x2 __attribute__((ext_vector_type(2)));
#define DI __device__ __forceinline__

constexpr int D_MODEL = 1024, BATCH = 8, SEQ = 4096, NTOK = BATCH * SEQ;
constexpr int NMIX = 1732, NMIX_PAD = 1792;
constexpr int PEER_N = 2048;
constexpr float ALPHA = 1.189207115002721f;
constexpr float LN_EPS = 1e-5f;
constexpr int NTHREADS = 256;
constexpr int LDS_BYTES = 77824;

constexpr size_t MB = 1024 * 1024;
constexpr size_t WS_CTL   = 0;
constexpr size_t WS_ROPE  = 1 * MB;
constexpr size_t WS_WINT  = 2 * MB;
constexpr size_t WS_WOT   = 6 * MB;
constexpr size_t WS_WQT   = 8 * MB;
constexpr size_t WS_SK    = 12 * MB;
constexpr size_t WS_UT    = 13 * MB;
constexpr size_t WS_VT    = 45 * MB;
constexpr size_t WS_XB    = 77 * MB;
constexpr size_t WS_QA    = 141 * MB;
constexpr size_t WS_KA    = 173 * MB;
constexpr size_t WS_VA    = 181 * MB;
constexpr size_t WS_QB    = 189 * MB;
constexpr size_t WS_KB    = 221 * MB;
constexpr size_t WS_VB    = 225 * MB;
constexpr size_t WS_QI    = 229 * MB;
constexpr size_t WS_KI    = 245 * MB;
constexpr size_t WS_WI    = 249 * MB;
constexpr size_t WS_ATT   = 250 * MB;
constexpr size_t WS_PE    = 314 * MB;
constexpr size_t WS_PG    = 322 * MB;
constexpr size_t WS_END   = 338 * MB;

struct Params {
    const float* x; const float* w_in; const float* idx_k_g; const float* idx_k_b; const float* sinks; const float* w_o;
    const float* ln1_g; const float* ln1_b; const float* peer_wq; const float* peer_subkeys; const float* peer_u; const float* peer_v;
    const float* ln2_g; const float* ln2_b;
    float* out; unsigned char* ws;
    int ph_lo, ph_hi;
};

DI unsigned f2bf(float x) { unsigned u = __float_as_uint(x); u += 0x7fffu + ((u >> 16) & 1u); return u >> 16; }
DI unsigned pack_bf16(float lo, float hi) { return f2bf(lo) | (f2bf(hi) << 16); }
DI float bf_lo(unsigned w) { return __uint_as_float(w << 16); }
DI float bf_hi(unsigned w) { return __uint_as_float(w & 0xffff0000u); }
DI bf16x8 as_bf16x8(u32x4 v) { return __builtin_bit_cast(bf16x8, v); }
DI u32x4 ldg16(const void* p) { return *(const u32x4*)p; }
DI f32x4 mfma16(bf16x8 a, bf16x8 b, f32x4 c) { return __builtin_amdgcn_mfma_f32_16x16x32_bf16(a, b, c, 0, 0, 0); }
DI f32x16 mfma32(bf16x8 a, bf16x8 b, f32x16 c) { return __builtin_amdgcn_mfma_f32_32x32x16_bf16(a, b, c, 0, 0, 0); }
DI float wave_sum(float v) {
#pragma unroll
    for (int o = 32; o >= 1; o >>= 1) v += __shfl_xor(v, o);
    return v;
}

DI void gemm_128x128(const bf16_t* __restrict__ X, int ldx, const bf16_t* __restrict__ Wt, int ldw, int K, unsigned char* lds, f32x4 (&acc)[4][4]) {
    const int tid = threadIdx.x, lane = tid & 63, wave = tid >> 6, wm = wave >> 1, wn = wave & 1, c = lane & 15, g = lane >> 4;
    unsigned char* Xs = lds; unsigned char* Ws = lds + 16384;
    const int lrow = tid >> 3, lch = tid & 7;
    const bf16_t* xp = X + (size_t)lrow * ldx + lch * 8;
    const bf16_t* wp = Wt + (size_t)lrow * ldw + lch * 8;
    const int st_off = lrow * 128 + ((lch ^ (lrow & 7)) << 4);
    u32x4 xr[4], wr[4];
#pragma unroll
    for (int i = 0; i < 4; ++i) { xr[i] = ldg16(xp + (size_t)(32 * i) * ldx); wr[i] = ldg16(wp + (size_t)(32 * i) * ldw); }
#pragma unroll
    for (int m = 0; m < 4; ++m)
#pragma unroll
        for (int n = 0; n < 4; ++n) acc[m][n] = (f32x4){0.f, 0.f, 0.f, 0.f};
    const int nk = K / 64;
    for (int kt = 0; kt < nk; ++kt) {
        __syncthreads();
#pragma unroll
        for (int i = 0; i < 4; ++i) { *(u32x4*)(Xs + st_off + i * 4096) = xr[i]; *(u32x4*)(Ws + st_off + i * 4096) = wr[i]; }
        __syncthreads();
        if (kt + 1 < nk) {
#pragma unroll
            for (int i = 0; i < 4; ++i) { xr[i] = ldg16(xp + (size_t)(32 * i) * ldx + (kt + 1) * 64); wr[i] = ldg16(wp + (size_t)(32 * i) * ldw + (kt + 1) * 64); }
        }
#pragma unroll
        for (int s = 0; s < 2; ++s) {
            bf16x8 xf[4], wf[4];
#pragma unroll
            for (int m = 0; m < 4; ++m) { const int row = wm * 64 + m * 16 + c; xf[m] = as_bf16x8(*(const u32x4*)(Xs + row * 128 + (((4 * s + g) ^ (c & 7)) << 4))); }
#pragma unroll
            for (int n = 0; n < 4; ++n) { const int row = wn * 64 + n * 16 + c; wf[n] = as_bf16x8(*(const u32x4*)(Ws + row * 128 + (((4 * s + g) ^ (c & 7)) << 4))); }
#pragma unroll
            for (int m = 0; m < 4; ++m)
#pragma unroll
                for (int n = 0; n < 4; ++n) acc[m][n] = mfma16(wf[n], xf[m], acc[m][n]);
        }
    }
}

DI void p0_prep(const Params& p, unsigned char* lds) {
    const int tid = threadIdx.x, nb = gridDim.x, bid = blockIdx.x;
    const size_t gtid = (size_t)bid * NTHREADS + tid, gsz = (size_t)nb * NTHREADS;
    unsigned char* ws = p.ws;
    if (bid == 0 && tid < 64) ((unsigned*)(ws + WS_CTL))[tid] = 0u;
    {
        float* ct = (float*)(ws + WS_ROPE); float* stb = ct + SEQ * 32;
        for (size_t i = gtid; i < (size_t)SEQ * 32; i += gsz) {
            const int pos = (int)(i >> 5), fi = (int)(i & 31);
            const float inv = powf(10000.0f, -(float)(2 * fi) / 64.0f);
            const float ang = (float)pos * inv;
            ct[i] = cosf(ang); stb[i] = sinf(ang);
        }
    }
    auto conv = [&](const float* src, bf16_t* dst, size_t n) {
        for (size_t i = gtid * 8; i < n; i += gsz * 8) {
            const f32x4 a = *(const f32x4*)(src + i), b = *(const f32x4*)(src + i + 4);
            u32x4 o; o.x = pack_bf16(a.x, a.y); o.y = pack_bf16(a.z, a.w); o.z = pack_bf16(b.x, b.y); o.w = pack_bf16(b.z, b.w);
            *(u32x4*)(dst + i) = o;
        }
    };
    conv(p.x, (bf16_t*)(ws + WS_XB), (size_t)NTOK * D_MODEL);
    conv(p.peer_u, (bf16_t*)(ws + WS_UT), (size_t)16384 * 1024);
    conv(p.peer_v, (bf16_t*)(ws + WS_VT), (size_t)16384 * 1024);
    conv(p.peer_subkeys, (bf16_t*)(ws + WS_SK), (size_t)8 * 2 * 128 * 128);
    float* tl = (float*)lds;
    auto transp = [&](const float* src, bf16_t* dst, int N, int Npad) {
        const int tn = Npad / 64, tk = 1024 / 64;
        for (int t = bid; t < tn * tk; t += nb) {
            const int n0 = (t % tn) * 64, k0 = (t / tn) * 64;
            __syncthreads();
            for (int e = tid; e < 4096; e += NTHREADS) { const int kk = e >> 6, nn = e & 63; tl[kk * 65 + nn] = (n0 + nn < N) ? src[(size_t)(k0 + kk) * N + n0 + nn] : 0.f; }
            __syncthreads();
            for (int e = tid; e < 4096; e += NTHREADS) { const int nn = e >> 6, kk = e & 63; dst[(size_t)(n0 + nn) * 1024 + k0 + kk] = (bf16_t)f2bf(tl[kk * 65 + nn]); }
        }
    };
    transp(p.w_in, (bf16_t*)(ws + WS_WINT), NMIX, NMIX_PAD);
    transp(p.w_o, (bf16_t*)(ws + WS_WOT), 1024, 1024);
    transp(p.peer_wq, (bf16_t*)(ws + WS_WQT), PEER_N, PEER_N);
}

DI void p1_inproj(const Params& p, unsigned char* lds) {
    unsigned char* ws = p.ws;
    const bf16_t* XB = (const bf16_t*)(ws + WS_XB); const bf16_t* WT = (const bf16_t*)(ws + WS_WINT);
    const float* cosT = (const float*)(ws + WS_ROPE); const float* sinT = cosT + SEQ * 32;
    const int tid = threadIdx.x, lane = tid & 63, wave = tid >> 6, wm = wave >> 1, wn = wave & 1, c = lane & 15, g = lane >> 4;
    constexpr int NT = NMIX_PAD / 128, MT = NTOK / 128;
    for (int t = blockIdx.x; t < NT * MT; t += gridDim.x) {
        const int mt = t / NT, nt = t % NT;
        f32x4 acc[4][4];
        gemm_128x128(XB + (size_t)mt * 128 * 1024, 1024, WT + (size_t)nt * 128 * 1024, 1024, 1024, lds, acc);
        const int col64 = nt * 2 + wn;
        bf16_t* dst; int ld, coff; bool rope = true; float scale = 1.f;
        if (col64 < 8)       { dst = (bf16_t*)(ws + WS_QA); ld = 512; coff = col64 * 64; scale = 0.125f; }
        else if (col64 < 10) { dst = (bf16_t*)(ws + WS_KA); ld = 128; coff = (col64 - 8) * 64; }
        else if (col64 < 12) { dst = (bf16_t*)(ws + WS_VA); ld = 128; coff = (col64 - 10) * 64; rope = false; }
        else if (col64 < 20) { dst = (bf16_t*)(ws + WS_QB); ld = 512; coff = (col64 - 12) * 64; scale = 0.125f; }
        else if (col64 == 20) { dst = (bf16_t*)(ws + WS_KB); ld = 64; coff = 0; }
        else if (col64 == 21) { dst = (bf16_t*)(ws + WS_VB); ld = 64; coff = 0; rope = false; }
        else if (col64 < 26) { dst = (bf16_t*)(ws + WS_QI); ld = 256; coff = (col64 - 22) * 64; }
        else                 { dst = (bf16_t*)(ws + WS_KI); ld = 64; coff = 0; }
        if (col64 == 27) {
            if (g == 0) {
#pragma unroll
                for (int m = 0; m < 4; ++m) { const int tok = mt * 128 + wm * 64 + m * 16 + c; *(f32x4*)((float*)(ws + WS_WI) + (size_t)tok * 4) = acc[m][0] * 0.0625f; }
            }
            continue;
        }
#pragma unroll
        for (int m = 0; m < 4; ++m) {
            const int tok = mt * 128 + wm * 64 + m * 16 + c, pos = tok & (SEQ - 1);
            f32x4 v[4] = {acc[m][0], acc[m][1], acc[m][2], acc[m][3]};
            if (col64 == 26) {
                float s = 0.f;
#pragma unroll
                for (int n = 0; n < 4; ++n) s += (v[n][0] + v[n][1]) + (v[n][2] + v[n][3]);
                s += __shfl_xor(s, 16); s += __shfl_xor(s, 32);
                const float mu = s * (1.f / 64.f); float q = 0.f;
#pragma unroll
                for (int n = 0; n < 4; ++n) { const f32x4 d = v[n] - mu; q += (d[0] * d[0] + d[1] * d[1]) + (d[2] * d[2] + d[3] * d[3]); }
                q += __shfl_xor(q, 16); q += __shfl_xor(q, 32);
                const float rstd = rsqrtf(q * (1.f / 64.f) + LN_EPS);
#pragma unroll
                for (int n = 0; n < 4; ++n) {
                    const f32x4 gg = *(const f32x4*)(p.idx_k_g + 16 * n + 4 * g), bb = *(const f32x4*)(p.idx_k_b + 16 * n + 4 * g);
                    v[n] = (v[n] - mu) * rstd * gg + bb;
                }
            }
            if (rope) {
#pragma unroll
                for (int n = 0; n < 2; ++n) {
                    const f32x4 cs = *(const f32x4*)(cosT + pos * 32 + 16 * n + 4 * g), sn = *(const f32x4*)(sinT + pos * 32 + 16 * n + 4 * g);
                    const f32x4 t1 = v[n], t2 = v[n + 2];
                    v[n] = t1 * cs - t2 * sn; v[n + 2] = t2 * cs + t1 * sn;
                }
            }
#pragma unroll
            for (int n = 0; n < 4; ++n) {
                const f32x4 o = v[n] * scale; u32x2 w; w.x = pack_bf16(o[0], o[1]); w.y = pack_bf16(o[2], o[3]);
                *(u32x2*)(dst + (size_t)tok * ld + coff + 16 * n + 4 * g) = w;
            }
        }
    }
}

constexpr int NDSA = NTOK / 4, NSWA = BATCH * 32 * 8;
constexpr int P2_SC = 0, P2_HIST = 32768, P2_LIST = 49152, P2_ITEM = 51200;

DI unsigned f16_key(float v) {
    _Float16 hv = (_Float16)v; unsigned short hb = __builtin_bit_cast(unsigned short, hv); unsigned b = hb;
    if (b == 0x8000u) b = 0u;
    return (b & 0x8000u) ? ((~b) & 0xffffu) : (b | 0x8000u);
}

DI void p2_dsa_item(const Params& p, unsigned char* lds, int item) {
    unsigned char* ws = p.ws;
    const bf16_t* QI = (const bf16_t*)(ws + WS_QI); const bf16_t* KI = (const bf16_t*)(ws + WS_KI); const float* WI = (const float*)(ws + WS_WI);
    const bf16_t* QB = (const bf16_t*)(ws + WS_QB); const bf16_t* KB = (const bf16_t*)(ws + WS_KB); const bf16_t* VB = (const bf16_t*)(ws + WS_VB);
    bf16_t* ATT = (bf16_t*)(ws + WS_ATT);
    const int tid = threadIdx.x, lane = tid & 63, wave = tid >> 6, c = lane & 15, g = lane >> 4;
    const int b = item & 7, tb = 1023 - (item >> 3), t0 = tb * 4, tok0 = b * SEQ + t0;
    unsigned short* sc = (unsigned short*)(lds + P2_SC);
    unsigned* hist = (unsigned*)(lds + P2_HIST) + wave * 1024;
    unsigned short* list = (unsigned short*)(lds + P2_LIST) + wave * 256;
    {
        bf16x8 af[2];
#pragma unroll
        for (int s = 0; s < 2; ++s) af[s] = as_bf16x8(ldg16(QI + (size_t)(tok0 + (c >> 2)) * 256 + (c & 3) * 64 + 32 * s + 8 * g));
        const f32x4 wv = *(const f32x4*)(WI + (size_t)(tok0 + g) * 4);
        const int ntile = (t0 + 4 + 15) >> 4;
        for (int kt = wave; kt < ntile; kt += 4) {
            const int key = kt * 16 + c;
            const bf16_t* kp = KI + (size_t)(b * SEQ + key) * 64 + 8 * g;
            const bf16x8 b0 = as_bf16x8(ldg16(kp)), b1 = as_bf16x8(ldg16(kp + 32));
            f32x4 d = mfma16(af[0], b0, (f32x4){0.f, 0.f, 0.f, 0.f});
            d = mfma16(af[1], b1, d);
            const float s = wv[0] * fmaxf(d[0], 0.f) + wv[1] * fmaxf(d[1], 0.f) + wv[2] * fmaxf(d[2], 0.f) + wv[3] * fmaxf(d[3], 0.f);
            sc[g * 4096 + key] = (unsigned short)f16_key(s);
        }
    }
    __syncthreads();
    const int n = t0 + wave + 1;
    const int L = n < 256 ? n : 256;
    const unsigned short* myk = sc + wave * 4096;
    if (n <= 256) {
        for (int i = lane; i < n; i += 64) list[i] = (unsigned short)i;
    } else {
#pragma unroll
        for (int i = 0; i < 4; ++i) *(u32x4*)(hist + lane * 16 + i * 4) = (u32x4){0u, 0u, 0u, 0u};
        for (int i = lane; i < n; i += 64) { const unsigned m = myk[i]; atomicAdd(&hist[m >> 6], 1u); }
        unsigned h[16];
#pragma unroll
        for (int i = 0; i < 4; ++i) { const u32x4 t = *(const u32x4*)(hist + lane * 16 + i * 4); h[4 * i] = t.x; h[4 * i + 1] = t.y; h[4 * i + 2] = t.z; h[4 * i + 3] = t.w; }
#pragma unroll
        for (int i = 0; i < 4; ++i) *(u32x4*)(hist + lane * 16 + i * 4) = (u32x4){0u, 0u, 0u, 0u};
        unsigned sl = 0;
#pragma unroll
        for (int i = 0; i < 16; ++i) sl += h[i];
        unsigned pre = sl;
#pragma unroll
        for (int o = 1; o < 64; o <<= 1) { const unsigned t = __shfl_up(pre, o); if (lane >= o) pre += t; }
        const unsigned tot = __shfl(pre, 63);
        const unsigned suf = tot - pre;
        int found = -1; unsigned cab = 0, cum = suf;
#pragma unroll
        for (int j = 15; j >= 0; --j) { const bool hit = (found < 0) && (cum + h[j] >= 256u); if (hit) { found = lane * 16 + j; cab = cum; } cum += h[j]; }
        const bool mine = (suf < 256u) && (suf + sl >= 256u);
        const unsigned long long mm = __ballot(mine);
        const int src = __ffsll((long long)mm) - 1;
        const unsigned bstar = (unsigned)__shfl(found, src), cabove = __shfl(cab, src);
        const unsigned r1 = 256u - cabove;
        for (int i = lane; i < n; i += 64) { const unsigned m = myk[i]; if ((m >> 6) == bstar) atomicAdd(&hist[m & 63u], 1u); }
        const unsigned cnt = hist[lane];
        hist[lane] = 0u;
        unsigned pre2 = cnt;
#pragma unroll
        for (int o = 1; o < 64; o <<= 1) { const unsigned t = __shfl_up(pre2, o); if (lane >= o) pre2 += t; }
        const unsigned tot2 = __shfl(pre2, 63);
        const unsigned suf2 = tot2 - pre2;
        const bool mine2 = (suf2 < r1) && (suf2 + cnt >= r1);
        const unsigned long long mm2 = __ballot(mine2);
        const int src2 = __ffsll((long long)mm2) - 1;
        const unsigned T = (bstar << 6) | (unsigned)src2;
        const unsigned req = r1 - __shfl(suf2, src2);
        unsigned eq_run = 0, out_run = 0;
        for (int base = 0; base < n; base += 64) {
            const int i = base + lane; const bool in = i < n; const unsigned m = in ? myk[i] : 0u;
            const bool gt = in && (m > T), eq = in && (m == T);
            const unsigned long long eqm = __ballot(eq);
            const unsigned eq_rank = eq_run + __builtin_amdgcn_mbcnt_hi((unsigned)(eqm >> 32), __builtin_amdgcn_mbcnt_lo((unsigned)eqm, 0u));
            const bool take = gt || (eq && eq_rank < req);
            const unsigned long long tm = __ballot(take);
            const unsigned pos = out_run + __builtin_amdgcn_mbcnt_hi((unsigned)(tm >> 32), __builtin_amdgcn_mbcnt_lo((unsigned)tm, 0u));
            if (take && pos < 256u) list[pos] = (unsigned short)i;
            eq_run += (unsigned)__popcll(eqm); out_run += (unsigned)__popcll(tm);
        }
    }
    const int tok = tok0 + wave;
    bf16x8 qf[2], sel[2];
#pragma unroll
    for (int s = 0; s < 2; ++s) {
        u32x4 t = (u32x4){0u, 0u, 0u, 0u};
        if (c < 8) t = ldg16(QB + (size_t)tok * 512 + c * 64 + 32 * s + 8 * g);
        qf[s] = as_bf16x8(t);
#pragma unroll
        for (int j = 0; j < 8; ++j) sel[s][j] = (8 * g + j == 16 * s + c) ? (short)0x3F80 : (short)0;
    }
    const bf16_t* kbase = KB + (size_t)b * SEQ * 64 + 8 * g;
    const bf16_t* vbase = VB + (size_t)b * SEQ * 64 + 8 * g;
    f32x4 st[16];
#pragma unroll
    for (int T = 0; T < 16; ++T) {
        const int idx = T * 16 + c; const int kid = (idx < L) ? (int)list[idx] : 0;
        const bf16_t* kp = kbase + (size_t)kid * 64;
        const bf16x8 k0 = as_bf16x8(ldg16(kp)), k1 = as_bf16x8(ldg16(kp + 32));
        f32x4 d = mfma16(k0, qf[0], (f32x4){0.f, 0.f, 0.f, 0.f});
        st[T] = mfma16(k1, qf[1], d);
        if ((T & 3) == 3) __builtin_amdgcn_sched_barrier(0);
    }
    float mx = -3.0e38f;
    {
        const int lrem = L - 4 * g;
#pragma unroll
        for (int T = 0; T < 16; ++T)
#pragma unroll
            for (int r = 0; r < 4; ++r) { const float sv = (T * 16 + r < lrem) ? st[T][r] : -3.0e38f; st[T][r] = sv; mx = fmaxf(mx, sv); }
    }
    mx = fmaxf(mx, __shfl_xor(mx, 16)); mx = fmaxf(mx, __shfl_xor(mx, 32));
    float lsum = 0.f;
#pragma unroll
    for (int T = 0; T < 16; ++T)
#pragma unroll
        for (int r = 0; r < 4; ++r) { const float e = __expf(st[T][r] - mx); st[T][r] = e; lsum += e; }
    lsum += __shfl_xor(lsum, 16); lsum += __shfl_xor(lsum, 32);
    const float rl = 1.0f / lsum;
    f32x4 O[4];
#pragma unroll
    for (int cb = 0; cb < 4; ++cb) O[cb] = (f32x4){0.f, 0.f, 0.f, 0.f};
#pragma unroll
    for (int u = 0; u < 8; ++u) {
        const int i0 = (2 * u) * 16 + c, i1 = (2 * u + 1) * 16 + c;
        const int kid0 = (i0 < L) ? (int)list[i0] : 0, kid1 = (i1 < L) ? (int)list[i1] : 0;
        const bf16_t* vp0 = vbase + (size_t)kid0 * 64; const bf16_t* vp1 = vbase + (size_t)kid1 * 64;
        bf16x8 va0[2], va1[2];
        va0[0] = as_bf16x8(ldg16(vp0)); va0[1] = as_bf16x8(ldg16(vp0 + 32)); va1[0] = as_bf16x8(ldg16(vp1)); va1[1] = as_bf16x8(ldg16(vp1 + 32));
        u32x4 pf; pf.x = pack_bf16(st[2 * u][0] * rl, st[2 * u][1] * rl); pf.y = pack_bf16(st[2 * u][2] * rl, st[2 * u][3] * rl);
        pf.z = pack_bf16(st[2 * u + 1][0] * rl, st[2 * u + 1][1] * rl); pf.w = pack_bf16(st[2 * u + 1][2] * rl, st[2 * u + 1][3] * rl);
#pragma unroll
        for (int cb = 0; cb < 4; ++cb) {
            const f32x4 z = (f32x4){0.f, 0.f, 0.f, 0.f};
            const f32x4 v0 = mfma16(va0[cb >> 1], sel[cb & 1], z), v1 = mfma16(va1[cb >> 1], sel[cb & 1], z);
            u32x4 vf; vf.x = pack_bf16(v0[0], v0[1]); vf.y = pack_bf16(v0[2], v0[3]); vf.z = pack_bf16(v1[0], v1[1]); vf.w = pack_bf16(v1[2], v1[3]);
            O[cb] = mfma16(as_bf16x8(pf), as_bf16x8(vf), O[cb]);
        }
        if (u & 1) __builtin_amdgcn_sched_barrier(0);
    }
    if (g < 2) {
#pragma unroll
        for (int cb = 0; cb < 4; ++cb)
#pragma unroll
            for (int r = 0; r < 4; ++r) ATT[(size_t)tok * 1024 + 512 + (4 * g + r) * 64 + 16 * cb + c] = (bf16_t)f2bf(O[cb][r]);
    }
}

DI void p2_swa_item(const Params& p, int item2) {
    unsigned char* ws = p.ws;
    const bf16_t* QA = (const bf16_t*)(ws + WS_QA); const bf16_t* KA = (const bf16_t*)(ws + WS_KA); const bf16_t* VA = (const bf16_t*)(ws + WS_VA);
    bf16_t* ATT = (bf16_t*)(ws + WS_ATT);
    const int tid = threadIdx.x, lane = tid & 63, wave = tid >> 6, r = lane & 31, h = lane >> 5;
    const int hq = item2 & 7, blk = (item2 >> 3) & 31, b = item2 >> 8, kvh = hq >> 2;
    const int qi = 32 * wave + r, tokq = b * SEQ + blk * 128 + qi;
    bf16x8 qf[4], sel[2];
#pragma unroll
    for (int s = 0; s < 4; ++s) qf[s] = as_bf16x8(ldg16(QA + (size_t)tokq * 512 + hq * 64 + 16 * s + 8 * h));
#pragma unroll
    for (int x = 0; x < 2; ++x)
#pragma unroll
        for (int j = 0; j < 8; ++j) sel[x][j] = (8 * h + j + 16 * x == r) ? (short)0x3F80 : (short)0;
    const float sink = p.sinks[hq];
    f32x16 ST[5];
#pragma unroll
    for (int ti = 0; ti < 5; ++ti) {
        const int sj = 32 * (wave + ti) + r; int pos = blk * 128 - 128 + sj; pos = pos < 0 ? 0 : pos;
        const bf16_t* kp = KA + (size_t)(b * SEQ + pos) * 128 + kvh * 64 + 8 * h;
        f32x16 d; for (int i = 0; i < 16; ++i) d[i] = 0.f;
#pragma unroll
        for (int s = 0; s < 4; ++s) d = mfma32(as_bf16x8(ldg16(kp + 16 * s)), qf[s], d);
        ST[ti] = d;
    }
    float mx = sink;
    {
        const int lo = r + 1 - 4 * h;
        const int lo0 = (blk > 0) ? lo : (lo > 128 - 32 * wave - 4 * h ? lo : 128 - 32 * wave - 4 * h);
#pragma unroll
        for (int ti = 0; ti < 5; ++ti)
#pragma unroll
            for (int reg = 0; reg < 16; ++reg) {
                const int e = 32 * ti + (reg & 3) + 8 * (reg >> 2);
                const float sv = (e >= lo0 && e < lo + 128) ? ST[ti][reg] : -3.0e38f; ST[ti][reg] = sv; mx = fmaxf(mx, sv);
            }
    }
    mx = fmaxf(mx, __shfl_xor(mx, 32));
    float lsum = 0.f;
#pragma unroll
    for (int ti = 0; ti < 5; ++ti)
#pragma unroll
        for (int reg = 0; reg < 16; ++reg) { const float e = __expf(ST[ti][reg] - mx); ST[ti][reg] = e; lsum += e; }
    lsum += __shfl_xor(lsum, 32);
    lsum += __expf(sink - mx);
    const float rl = 1.0f / lsum;
    f32x16 OT[2];
    for (int i = 0; i < 16; ++i) { OT[0][i] = 0.f; OT[1][i] = 0.f; }
#pragma unroll
    for (int ti = 0; ti < 5; ++ti) {
        const int sj = 32 * (wave + ti) + r; int pos = blk * 128 - 128 + sj; pos = pos < 0 ? 0 : pos;
        const bf16_t* vp = VA + (size_t)(b * SEQ + pos) * 128 + kvh * 64 + 8 * h;
        bf16x8 vf[4];
#pragma unroll
        for (int s = 0; s < 4; ++s) vf[s] = as_bf16x8(ldg16(vp + 16 * s));
        u32x4 pb[2];
#pragma unroll
        for (int s2 = 0; s2 < 2; ++s2) {
            pb[s2].x = pack_bf16(ST[ti][8 * s2 + 0] * rl, ST[ti][8 * s2 + 1] * rl); pb[s2].y = pack_bf16(ST[ti][8 * s2 + 2] * rl, ST[ti][8 * s2 + 3] * rl);
            pb[s2].z = pack_bf16(ST[ti][8 * s2 + 4] * rl, ST[ti][8 * s2 + 5] * rl); pb[s2].w = pack_bf16(ST[ti][8 * s2 + 6] * rl, ST[ti][8 * s2 + 7] * rl);
        }
#pragma unroll
        for (int db = 0; db < 2; ++db) {
            f32x16 vt; for (int i = 0; i < 16; ++i) vt[i] = 0.f;
            vt = mfma32(vf[2 * db], sel[0], vt); vt = mfma32(vf[2 * db + 1], sel[1], vt);
#pragma unroll
            for (int s2 = 0; s2 < 2; ++s2) {
                u32x4 va; va.x = pack_bf16(vt[8 * s2 + 0], vt[8 * s2 + 1]); va.y = pack_bf16(vt[8 * s2 + 2], vt[8 * s2 + 3]);
                va.z = pack_bf16(vt[8 * s2 + 4], vt[8 * s2 + 5]); va.w = pack_bf16(vt[8 * s2 + 6], vt[8 * s2 + 7]);
                OT[db] = mfma32(as_bf16x8(va), as_bf16x8(pb[s2]), OT[db]);
            }
        }
    }
#pragma unroll
    for (int db = 0; db < 2; ++db)
#pragma unroll
        for (int q4 = 0; q4 < 4; ++q4) {
            u32x2 w; w.x = pack_bf16(OT[db][4 * q4], OT[db][4 * q4 + 1]); w.y = pack_bf16(OT[db][4 * q4 + 2], OT[db][4 * q4 + 3]);
            *(u32x2*)(ATT + (size_t)tokq * 1024 + hq * 64 + 32 * db + 8 * q4 + 4 * h) = w;
        }
}

DI void p2_attention(const Params& p, unsigned char* lds) {
    unsigned* ctr = (unsigned*)(p.ws + WS_CTL);
    volatile int* s_item = (volatile int*)(lds + P2_ITEM);
    for (;;) {
        __syncthreads();
        if (threadIdx.x == 0) *s_item = (int)atomicAdd(ctr, 1u);
        __syncthreads();
        const int item = *s_item;
        if (item >= NDSA + NSWA) break;

#if !defined(NO_DSA)
        if (item < NDSA) p2_dsa_item(p, lds, item);
#endif
#if !defined(NO_SWA)
        if (item >= NDSA) p2_swa_item(p, item - NDSA);
#endif

    }
}

DI void p3_outproj(const Params& p, unsigned char* lds) {
    unsigned char* ws = p.ws;
    const bf16_t* ATT = (const bf16_t*)(ws + WS_ATT); const bf16_t* WT = (const bf16_t*)(ws + WS_WOT);
    const int tid = threadIdx.x, lane = tid & 63, wave = tid >> 6, wm = wave >> 1, wn = wave & 1, c = lane & 15, g = lane >> 4;
    constexpr int NT = 8, MT = NTOK / 128;
    for (int t = blockIdx.x; t < NT * MT; t += gridDim.x) {
        const int mt = t / NT, nt = t % NT;
        f32x4 acc[4][4];
        gemm_128x128(ATT + (size_t)mt * 128 * 1024, 1024, WT + (size_t)nt * 128 * 1024, 1024, 1024, lds, acc);
#pragma unroll
        for (int m = 0; m < 4; ++m) {
            const int tok = mt * 128 + wm * 64 + m * 16 + c;
#pragma unroll
            for (int n = 0; n < 4; ++n) {
                const size_t o = (size_t)tok * 1024 + nt * 128 + wn * 64 + 16 * n + 4 * g;
                const f32x4 xv = *(const f32x4*)(p.x + o);
                *(f32x4*)(p.out + o) = xv * ALPHA + acc[m][n];
            }
        }
    }
}

DI void p3b_ln1(const Params& p) {
    bf16_t* H1B = (bf16_t*)(p.ws + WS_XB);
    const int lane = threadIdx.x & 63, gw = blockIdx.x * 4 + (threadIdx.x >> 6), nw = gridDim.x * 4;
    for (int row = gw; row < NTOK; row += nw) {
        f32x4 v[4]; float s = 0.f;
#pragma unroll
        for (int i = 0; i < 4; ++i) { v[i] = *(const f32x4*)(p.out + (size_t)row * 1024 + (lane + 64 * i) * 4); s += (v[i][0] + v[i][1]) + (v[i][2] + v[i][3]); }
        const float mu = wave_sum(s) * (1.f / 1024.f); float q = 0.f;
#pragma unroll
        for (int i = 0; i < 4; ++i) { const f32x4 d = v[i] - mu; q += (d[0] * d[0] + d[1] * d[1]) + (d[2] * d[2] + d[3] * d[3]); }
        const float rstd = rsqrtf(wave_sum(q) * (1.f / 1024.f) + LN_EPS);
#pragma unroll
        for (int i = 0; i < 4; ++i) {
            const int col = (lane + 64 * i) * 4;
            const f32x4 gg = *(const f32x4*)(p.ln1_g + col), bb = *(const f32x4*)(p.ln1_b + col);
            const f32x4 o = (v[i] - mu) * rstd * gg + bb;
            u32x2 w; w.x = pack_bf16(o[0], o[1]); w.y = pack_bf16(o[2], o[3]);
            *(u32x2*)(H1B + (size_t)row * 1024 + col) = w;
        }
    }
}

DI void top16_insert(float (&tv)[16], int (&ti)[16], float v, int i) {
#pragma unroll
    for (int j = 0; j < 16; ++j) { const bool sw = v > tv[j]; const float a = tv[j]; const int b = ti[j]; tv[j] = sw ? v : a; ti[j] = sw ? i : b; v = sw ? a : v; i = sw ? b : i; }
}
constexpr int P4_QS = 32768, P4_ST0V = 66048, P4_ST0I = 66048 + 8704, P4_ST1I = 8704;

DI void p4_peer_query(const Params& p, unsigned char* lds) {
    unsigned char* ws = p.ws;
    const bf16_t* H1B = (const bf16_t*)(ws + WS_XB); const bf16_t* WQT = (const bf16_t*)(ws + WS_WQT); const bf16_t* SK = (const bf16_t*)(ws + WS_SK);
    unsigned short* PE = (unsigned short*)(ws + WS_PE); float* PG = (float*)(ws + WS_PG);
    const int tid = threadIdx.x, lane = tid & 63, wave = tid >> 6, wm = wave >> 1, wn = wave & 1, c = lane & 15, g = lane >> 4;
    const int lrow = tid >> 3, lch = tid & 7;
    float* Ss = (float*)lds;
    float* st0v = (float*)(lds + P4_ST0V); unsigned char* st0i = lds + P4_ST0I; unsigned char* st1i = lds + P4_ST1I;
    constexpr int MT = NTOK / 128;
    for (int t = blockIdx.x; t < MT * 8; t += gridDim.x) {
        const int mt = t >> 3, head = t & 7;
        float tv[16]; int ti[16];
#pragma unroll 1
        for (int ph = 0; ph < 2; ++ph) {
            f32x4 acc[4][4];
            gemm_128x128(H1B + (size_t)mt * 128 * 1024, 1024, WQT + (size_t)(head * 256 + ph * 128) * 1024, 1024, 1024, lds, acc);
            __syncthreads();
#pragma unroll
            for (int m = 0; m < 4; ++m)
#pragma unroll
                for (int n = 0; n < 4; ++n) {
                    const int row = wm * 64 + m * 16 + c;
                    u32x2 w; w.x = pack_bf16(acc[m][n][0], acc[m][n][1]); w.y = pack_bf16(acc[m][n][2], acc[m][n][3]);
                    *(u32x2*)(lds + P4_QS + wn * 16384 + row * 128 + (((2 * n + (g >> 1)) ^ (row & 7)) << 4) + (g & 1) * 8) = w;
                }
            {
                const bf16_t* sp = SK + (size_t)((head * 2 + ph) * 128 + lrow) * 128 + lch * 8;
#pragma unroll
                for (int k2 = 0; k2 < 2; ++k2)
#pragma unroll
                    for (int i = 0; i < 4; ++i) *(u32x4*)(lds + k2 * 16384 + (lrow + 32 * i) * 128 + ((lch ^ (lrow & 7)) << 4)) = ldg16(sp + (size_t)(32 * i) * 128 + k2 * 64);
            }
            __syncthreads();
            f32x4 a2[4][4];
#pragma unroll
            for (int m = 0; m < 4; ++m)
#pragma unroll
                for (int n = 0; n < 4; ++n) a2[m][n] = (f32x4){0.f, 0.f, 0.f, 0.f};
#pragma unroll
            for (int k2 = 0; k2 < 2; ++k2)
#pragma unroll
                for (int s = 0; s < 2; ++s) {
                    bf16x8 xf[4], wf[4];
#pragma unroll
                    for (int m = 0; m < 4; ++m) { const int row = wm * 64 + m * 16 + c; xf[m] = as_bf16x8(*(const u32x4*)(lds + P4_QS + k2 * 16384 + row * 128 + (((4 * s + g) ^ (c & 7)) << 4))); }
#pragma unroll
                    for (int n = 0; n < 4; ++n) { const int row = wn * 64 + n * 16 + c; wf[n] = as_bf16x8(*(const u32x4*)(lds + k2 * 16384 + row * 128 + (((4 * s + g) ^ (c & 7)) << 4))); }
#pragma unroll
                    for (int m = 0; m < 4; ++m)
#pragma unroll
                        for (int n = 0; n < 4; ++n) a2[m][n] = mfma16(wf[n], xf[m], a2[m][n]);
                }
            __syncthreads();
#pragma unroll
            for (int m = 0; m < 4; ++m)
#pragma unroll
                for (int n = 0; n < 4; ++n)
#pragma unroll
                    for (int r = 0; r < 4; ++r) Ss[(wm * 64 + m * 16 + c) * 129 + wn * 64 + 16 * n + 4 * g + r] = a2[m][n][r];
            __syncthreads();
            if (tid < 128) {
#pragma unroll
                for (int j = 0; j < 16; ++j) { tv[j] = -3.0e38f; ti[j] = 0; }
                const float* rowp = Ss + tid * 129;
#pragma unroll 4
                for (int j = 0; j < 128; ++j) { const float v = rowp[j]; if (v > tv[15]) top16_insert(tv, ti, v, j); }
                if (ph == 0) {
#pragma unroll
                    for (int j = 0; j < 16; ++j) { st0v[tid * 17 + j] = tv[j]; st0i[tid * 20 + j] = (unsigned char)ti[j]; }
                }
            }
            __syncthreads();
        }
        if (tid < 128) {
#pragma unroll
            for (int j = 0; j < 16; ++j) st1i[tid * 20 + j] = (unsigned char)ti[j];
            float cv[16]; int ci[16];
#pragma unroll
            for (int j = 0; j < 16; ++j) { cv[j] = -3.0e38f; ci[j] = 0; }
#pragma unroll 1
            for (int a = 0; a < 16; ++a) {
                const float va = st0v[tid * 17 + a];
#pragma unroll
                for (int b = 0; b < 16; ++b) { const float v = va + tv[b]; if (v > cv[15]) top16_insert(cv, ci, v, a * 16 + b); }
            }
            const float cmax = cv[0]; float den = 0.f;
#pragma unroll
            for (int j = 0; j < 16; ++j) { cv[j] = __expf(cv[j] - cmax); den += cv[j]; }
            const float rden = 1.0f / den;
            const size_t ob = (size_t)(mt * 128 + tid) * 128 + head * 16;
#pragma unroll
            for (int j = 0; j < 16; ++j) {
                const int e = (int)st0i[tid * 20 + (ci[j] >> 4)] * 128 + (int)st1i[tid * 20 + (ci[j] & 15)];
                PE[ob + j] = (unsigned short)e; PG[ob + j] = cv[j] * rden;
            }
        }
        __syncthreads();
    }
}

DI float gelu_exact(float z) { return 0.5f * z * (1.0f + erff(z * 0.70710678118654752f)); }
DI float rdlane(float v, int l) { return __int_as_float(__builtin_amdgcn_readlane(__float_as_int(v), l)); }

DI void p5_gather(const Params& p) {
    unsigned char* ws = p.ws;
    const bf16_t* H1B = (const bf16_t*)(ws + WS_XB); const bf16_t* UT = (const bf16_t*)(ws + WS_UT); const bf16_t* VT = (const bf16_t*)(ws + WS_VT);
    const unsigned short* PE = (const unsigned short*)(ws + WS_PE); const float* PG = (const float*)(ws + WS_PG);
    const int lane = threadIdx.x & 63, gw = blockIdx.x * 4 + (threadIdx.x >> 6), nw = gridDim.x * 4;
    const bool b5 = (lane & 32) != 0, b4 = (lane & 16) != 0, b3 = (lane & 8) != 0;
    for (int tok = gw; tok < NTOK; tok += nw) {
        float x[16], acc[16];
        {
            const u32x4 xa = ldg16(H1B + (size_t)tok * 1024 + lane * 8), xb = ldg16(H1B + (size_t)tok * 1024 + 512 + lane * 8);
            x[0] = bf_lo(xa.x); x[1] = bf_hi(xa.x); x[2] = bf_lo(xa.y); x[3] = bf_hi(xa.y); x[4] = bf_lo(xa.z); x[5] = bf_hi(xa.z); x[6] = bf_lo(xa.w); x[7] = bf_hi(xa.w);
            x[8] = bf_lo(xb.x); x[9] = bf_hi(xb.x); x[10] = bf_lo(xb.y); x[11] = bf_hi(xb.y); x[12] = bf_lo(xb.z); x[13] = bf_hi(xb.z); x[14] = bf_lo(xb.w); x[15] = bf_hi(xb.w);
        }
#pragma unroll
        for (int i = 0; i < 16; ++i) acc[i] = 0.f;
        const int pe_lo = (int)PE[(size_t)tok * 128 + lane], pe_hi = (int)PE[(size_t)tok * 128 + 64 + lane];
        const float pg_lo = PG[(size_t)tok * 128 + lane], pg_hi = PG[(size_t)tok * 128 + 64 + lane];
#pragma unroll 1
        for (int hb = 0; hb < 16; ++hb) {
            const int pes = hb < 8 ? pe_lo : pe_hi; const float pgs = hb < 8 ? pg_lo : pg_hi;
            const int lb = (hb & 7) * 8;
            float d[8];
#pragma unroll
            for (int j = 0; j < 8; ++j) {
                const int e = __builtin_amdgcn_readlane(pes, lb + j);
                const bf16_t* up = UT + (size_t)e * 1024 + lane * 8;
                const u32x4 ua = ldg16(up), ub = ldg16(up + 512);
                float s = x[0] * bf_lo(ua.x);
                s = fmaf(x[1], bf_hi(ua.x), s); s = fmaf(x[2], bf_lo(ua.y), s); s = fmaf(x[3], bf_hi(ua.y), s);
                s = fmaf(x[4], bf_lo(ua.z), s); s = fmaf(x[5], bf_hi(ua.z), s); s = fmaf(x[6], bf_lo(ua.w), s); s = fmaf(x[7], bf_hi(ua.w), s);
                s = fmaf(x[8], bf_lo(ub.x), s); s = fmaf(x[9], bf_hi(ub.x), s); s = fmaf(x[10], bf_lo(ub.y), s); s = fmaf(x[11], bf_hi(ub.y), s);
                s = fmaf(x[12], bf_lo(ub.z), s); s = fmaf(x[13], bf_hi(ub.z), s); s = fmaf(x[14], bf_lo(ub.w), s); s = fmaf(x[15], bf_hi(ub.w), s);
                d[j] = s;
            }
            float r4[4], r2[2], r1;
#pragma unroll
            for (int j = 0; j < 4; ++j) { const float keep = b5 ? d[j + 4] : d[j], send = b5 ? d[j] : d[j + 4]; r4[j] = keep + __shfl_xor(send, 32); }
#pragma unroll
            for (int j = 0; j < 2; ++j) { const float keep = b4 ? r4[j + 2] : r4[j], send = b4 ? r4[j] : r4[j + 2]; r2[j] = keep + __shfl_xor(send, 16); }
            { const float keep = b3 ? r2[1] : r2[0], send = b3 ? r2[0] : r2[1]; r1 = keep + __shfl_xor(send, 8); }
            r1 += __shfl_xor(r1, 4); r1 += __shfl_xor(r1, 2); r1 += __shfl_xor(r1, 1);
            const float gate = __shfl(pgs, lb + ((lane >> 3) & 7));
            const float coef = gelu_exact(r1) * gate;
#pragma unroll
            for (int j = 0; j < 8; ++j) {
                const int e = __builtin_amdgcn_readlane(pes, lb + j);
                const float cj = rdlane(coef, 8 * j);
                const bf16_t* vp = VT + (size_t)e * 1024 + lane * 8;
                const u32x4 va = ldg16(vp), vb = ldg16(vp + 512);
                acc[0] = fmaf(cj, bf_lo(va.x), acc[0]); acc[1] = fmaf(cj, bf_hi(va.x), acc[1]); acc[2] = fmaf(cj, bf_lo(va.y), acc[2]); acc[3] = fmaf(cj, bf_hi(va.y), acc[3]);
                acc[4] = fmaf(cj, bf_lo(va.z), acc[4]); acc[5] = fmaf(cj, bf_hi(va.z), acc[5]); acc[6] = fmaf(cj, bf_lo(va.w), acc[6]); acc[7] = fmaf(cj, bf_hi(va.w), acc[7]);
                acc[8] = fmaf(cj, bf_lo(vb.x), acc[8]); acc[9] = fmaf(cj, bf_hi(vb.x), acc[9]); acc[10] = fmaf(cj, bf_lo(vb.y), acc[10]); acc[11] = fmaf(cj, bf_hi(vb.y), acc[11]);
                acc[12] = fmaf(cj, bf_lo(vb.z), acc[12]); acc[13] = fmaf(cj, bf_hi(vb.z), acc[13]); acc[14] = fmaf(cj, bf_lo(vb.w), acc[14]); acc[15] = fmaf(cj, bf_hi(vb.w), acc[15]);
            }
        }
        float s = 0.f;
#pragma unroll
        for (int i = 0; i < 16; ++i) { acc[i] = fmaf(ALPHA, x[i], acc[i]); s += acc[i]; }
        const float mu = wave_sum(s) * (1.f / 1024.f); float q = 0.f;
#pragma unroll
        for (int i = 0; i < 16; ++i) { const float dd = acc[i] - mu; q = fmaf(dd, dd, q); }
        const float rstd = rsqrtf(wave_sum(q) * (1.f / 1024.f) + LN_EPS);
#pragma unroll
        for (int hfi = 0; hfi < 2; ++hfi)
#pragma unroll
            for (int k4 = 0; k4 < 2; ++k4) {
                const int col = hfi * 512 + lane * 8 + k4 * 4;
                const f32x4 gg = *(const f32x4*)(p.ln2_g + col), bb = *(const f32x4*)(p.ln2_b + col);
                f32x4 o;
#pragma unroll
                for (int e = 0; e < 4; ++e) o[e] = (acc[hfi * 8 + k4 * 4 + e] - mu) * rstd * gg[e] + bb[e];
                *(f32x4*)(p.out + (size_t)tok * 1024 + col) = o;
            }
    }
}

constexpr int NPHASE = 7;
__global__ void __launch_bounds__(NTHREADS, 2) mega_fwd(Params p) {
    extern __shared__ __attribute__((aligned(16))) unsigned char lds[];
    cg::grid_group grid = cg::this_grid();
    const int lo = p.ph_lo, hi = p.ph_hi;
#define RUN_PHASE(k, call) if (lo <= (k) && (k) < hi) { call; if ((k) + 1 < hi) grid.sync(); }
#ifndef PH_MASK
#define PH_MASK 127
#endif
#if PH_MASK & 1
    RUN_PHASE(0, p0_prep(p, lds))
#endif
#if PH_MASK & 2
    RUN_PHASE(1, p1_inproj(p, lds))
#endif
#if PH_MASK & 4
    RUN_PHASE(2, p2_attention(p, lds))
#endif
#if PH_MASK & 8
    RUN_PHASE(3, p3_outproj(p, lds))
#endif
#if PH_MASK & 16
    RUN_PHASE(4, p3b_ln1(p))
#endif
#if PH_MASK & 32
    RUN_PHASE(5, p4_peer_query(p, lds))
#endif
#if PH_MASK & 64
    RUN_PHASE(6, p5_gather(p))
#endif
}

#ifndef MK_N_LAUNCHES
#define MK_N_LAUNCHES 1
#endif

extern "C" void kernel_launch(void* const* d_in, const int* in_sizes, int n_in, void* d_out, int out_size, void* d_ws, size_t ws_size, hipStream_t stream) {
    static int grid_blocks = 0;
    if (grid_blocks == 0) {
        if (n_in != 14 || out_size != NTOK * D_MODEL || ws_size < WS_END) {
            fprintf(stderr, "kernel_launch: unexpected problem (n_in %d, out %d, ws %zu, need %zu)\n", n_in, out_size, ws_size, (size_t)WS_END); grid_blocks = -1; return;
        }
        int dev = 0, cus = 0, per_cu = 0;
        hipGetDevice(&dev);
        hipDeviceGetAttribute(&cus, hipDeviceAttributeMultiprocessorCount, dev);
        if (hipFuncSetAttribute((const void*)mega_fwd, hipFuncAttributeMaxDynamicSharedMemorySize, LDS_BYTES) != hipSuccess) { fprintf(stderr, "kernel_launch: hipFuncSetAttribute failed\n"); }
        if (hipOccupancyMaxActiveBlocksPerMultiprocessor(&per_cu, (const void*)mega_fwd, NTHREADS, LDS_BYTES) != hipSuccess || per_cu < 1) { fprintf(stderr, "kernel_launch: occupancy query failed\n"); per_cu = 1; }
        if (per_cu > 2) per_cu = 2;
        (void)hipGetLastError();
        grid_blocks = cus * per_cu;
        fprintf(stderr, "kernel_launch: %d CUs x %d blocks\n", cus, per_cu);
    }
    if (grid_blocks < 0) return;
    Params p{};
    p.x = (const float*)d_in[0]; p.w_in = (const float*)d_in[1]; p.idx_k_g = (const float*)d_in[2]; p.idx_k_b = (const float*)d_in[3]; p.sinks = (const float*)d_in[4];
    p.w_o = (const float*)d_in[5]; p.ln1_g = (const float*)d_in[6]; p.ln1_b = (const float*)d_in[7]; p.peer_wq = (const float*)d_in[8]; p.peer_subkeys = (const float*)d_in[9];
    p.peer_u = (const float*)d_in[10]; p.peer_v = (const float*)d_in[11]; p.ln2_g = (const float*)d_in[12]; p.ln2_b = (const float*)d_in[13];
    p.out = (float*)d_out; p.ws = (unsigned char*)d_ws;
#if MK_N_LAUNCHES == 1
    p.ph_lo = 0; p.ph_hi = NPHASE;
    void* args[] = {&p};
    hipError_t e = hipLaunchCooperativeKernel((const void*)mega_fwd, dim3(grid_blocks), dim3(NTHREADS), args, LDS_BYTES, stream);
    if (e != hipSuccess) fprintf(stderr, "cooperative launch failed: %s (grid %d)\n", hipGetErrorString(e), grid_blocks);
#else
    for (int ph = 0; ph < NPHASE; ++ph) {
        p.ph_lo = ph; p.ph_hi = ph + 1;
        void* args[] = {&p};
        hipError_t e = hipLaunchCooperativeKernel((const void*)mega_fwd, dim3(grid_blocks), dim3(NTHREADS), args, LDS_BYTES, stream);
        if (e != hipSuccess) fprintf(stderr, "cooperative launch failed: %s (grid %d, phase %d)\n", hipGetErrorString(e), grid_blocks, ph);
    }
#endif
}
```

```cpp
#include <hip/hip_runtime.h>
#include <hip/hip_cooperative_groups.h>
#include <cstdio>
#include <cstdint>
namespace cg = cooperative_groups;

typedef unsigned short bf16_t;
typedef short bf16x8 __attribute__((ext_vector_type(8)));
typedef float f32x4 __attribute__((ext_vector_type(4)));
typedef float f32x16 __attribute__((ext_vector_type(16)));
typedef unsigned u32x4 __attribute__((ext_vector_type(4)));
typedef unsigned u32x2 __attribute__((ext_vector_type(2)));
#define DI __device__ __forceinline__

constexpr int D_MODEL = 1024, BATCH = 8, SEQ = 4096, NTOK = BATCH * SEQ;
constexpr int NMIX = 1732, NMIX_PAD = 1792;
constexpr int PEER_N = 2048;
constexpr float ALPHA = 1.189207115002721f;
constexpr float LN_EPS = 1e-5f;
constexpr int NTHREADS = 256;
constexpr int LDS_BYTES = 77824;

constexpr size_t MB = 1024 * 1024;
constexpr size_t WS_CTL   = 0;
constexpr size_t WS_ROPE  = 1 * MB;
constexpr size_t WS_WINT  = 2 * MB;
constexpr size_t WS_WOT   = 6 * MB;
constexpr size_t WS_WQT   = 8 * MB;
constexpr size_t WS_SK    = 12 * MB;
constexpr size_t WS_UT    = 13 * MB;
constexpr size_t WS_VT    = 29 * MB;
constexpr size_t WS_SU    = 45 * MB;
constexpr size_t WS_SV    = 46 * MB;
constexpr size_t WS_XB    = 77 * MB;
constexpr size_t WS_QA    = 141 * MB;
constexpr size_t WS_KA    = 173 * MB;
constexpr size_t WS_VA    = 181 * MB;
constexpr size_t WS_QB    = 189 * MB;
constexpr size_t WS_KB    = 221 * MB;
constexpr size_t WS_VB    = 225 * MB;
constexpr size_t WS_QI    = 229 * MB;
constexpr size_t WS_KI    = 245 * MB;
constexpr size_t WS_WI    = 249 * MB;
constexpr size_t WS_ATT   = 250 * MB;
constexpr size_t WS_PE    = 314 * MB;
constexpr size_t WS_PG    = 322 * MB;
constexpr size_t WS_PS    = 338 * MB;
constexpr size_t WS_END   = 354 * MB;

struct Params {
    const float* x; const float* w_in; const float* idx_k_g; const float* idx_k_b; const float* sinks; const float* w_o;
    const float* ln1_g; const float* ln1_b; const float* peer_wq; const float* peer_subkeys; const float* peer_u; const float* peer_v;
    const float* ln2_g; const float* ln2_b;
    float* out; unsigned char* ws;
    int ph_lo, ph_hi;
};

DI unsigned f2bf(float x) { unsigned u = __float_as_uint(x); u += 0x7fffu + ((u >> 16) & 1u); return u >> 16; }
DI unsigned pack_bf16(float lo, float hi) { return f2bf(lo) | (f2bf(hi) << 16); }
DI float bf_lo(unsigned w) { return __uint_as_float(w << 16); }
DI float bf_hi(unsigned w) { return __uint_as_float(w & 0xffff0000u); }
DI bf16x8 as_bf16x8(u32x4 v) { return __builtin_bit_cast(bf16x8, v); }
DI u32x4 ldg16(const void* p) { return *(const u32x4*)p; }
DI f32x4 mfma16(bf16x8 a, bf16x8 b, f32x4 c) { return __builtin_amdgcn_mfma_f32_16x16x32_bf16(a, b, c, 0, 0, 0); }
DI f32x16 mfma32(bf16x8 a, bf16x8 b, f32x16 c) { return __builtin_amdgcn_mfma_f32_32x32x16_bf16(a, b, c, 0, 0, 0); }
DI float wave_sum(float v) {
#pragma unroll
    for (int o = 32; o >= 1; o >>= 1) v += __shfl_xor(v, o);
    return v;
}

DI void gemm_128x128(const bf16_t* __restrict__ X, int ldx, const bf16_t* __restrict__ Wt, int ldw, int K, unsigned char* lds, f32x4 (&acc)[4][4]) {
    const int tid = threadIdx.x, lane = tid & 63, wave = tid >> 6, wm = wave >> 1, wn = wave & 1, c = lane & 15, g = lane >> 4;
    unsigned char* Xs = lds; unsigned char* Ws = lds + 16384;
    const int lrow = tid >> 3, lch = tid & 7;
    const bf16_t* xp = X + (size_t)lrow * ldx + lch * 8;
    const bf16_t* wp = Wt + (size_t)lrow * ldw + lch * 8;
    const int st_off = lrow * 128 + ((lch ^ (lrow & 7)) << 4);
    u32x4 xr[4], wr[4];
#pragma unroll
    for (int i = 0; i < 4; ++i) { xr[i] = ldg16(xp + (size_t)(32 * i) * ldx); wr[i] = ldg16(wp + (size_t)(32 * i) * ldw); }
#pragma unroll
    for (int m = 0; m < 4; ++m)
#pragma unroll
        for (int n = 0; n < 4; ++n) acc[m][n] = (f32x4){0.f, 0.f, 0.f, 0.f};
    const int nk = K / 64;
    for (int kt = 0; kt < nk; ++kt) {
        __syncthreads();
#pragma unroll
        for (int i = 0; i < 4; ++i) { *(u32x4*)(Xs + st_off + i * 4096) = xr[i]; *(u32x4*)(Ws + st_off + i * 4096) = wr[i]; }
        __syncthreads();
        if (kt + 1 < nk) {
#pragma unroll
            for (int i = 0; i < 4; ++i) { xr[i] = ldg16(xp + (size_t)(32 * i) * ldx + (kt + 1) * 64); wr[i] = ldg16(wp + (size_t)(32 * i) * ldw + (kt + 1) * 64); }
        }
#pragma unroll
        for (int s = 0; s < 2; ++s) {
            bf16x8 xf[4], wf[4];
#pragma unroll
            for (int m = 0; m < 4; ++m) { const int row = wm * 64 + m * 16 + c; xf[m] = as_bf16x8(*(const u32x4*)(Xs + row * 128 + (((4 * s + g) ^ (c & 7)) << 4))); }
#pragma unroll
            for (int n = 0; n < 4; ++n) { const int row = wn * 64 + n * 16 + c; wf[n] = as_bf16x8(*(const u32x4*)(Ws + row * 128 + (((4 * s + g) ^ (c & 7)) << 4))); }
#pragma unroll
            for (int m = 0; m < 4; ++m)
#pragma unroll
                for (int n = 0; n < 4; ++n) acc[m][n] = mfma16(wf[n], xf[m], acc[m][n]);
        }
    }
}

DI void p0_prep(const Params& p, unsigned char* lds) {
    const int tid = threadIdx.x, nb = gridDim.x, bid = blockIdx.x;
    const size_t gtid = (size_t)bid * NTHREADS + tid, gsz = (size_t)nb * NTHREADS;
    unsigned char* ws = p.ws;
    if (bid == 0 && tid < 64) ((unsigned*)(ws + WS_CTL))[tid] = 0u;
    {
        float* ct = (float*)(ws + WS_ROPE); float* stb = ct + SEQ * 32;
        for (size_t i = gtid; i < (size_t)SEQ * 32; i += gsz) {
            const int pos = (int)(i >> 5), fi = (int)(i & 31);
            const float inv = powf(10000.0f, -(float)(2 * fi) / 64.0f);
            const float ang = (float)pos * inv;
            ct[i] = cosf(ang); stb[i] = sinf(ang);
        }
    }
    auto conv = [&](const float* src, bf16_t* dst, size_t n) {
        for (size_t i = gtid * 8; i < n; i += gsz * 8) {
            const f32x4 a = *(const f32x4*)(src + i), b = *(const f32x4*)(src + i + 4);
            u32x4 o; o.x = pack_bf16(a.x, a.y); o.y = pack_bf16(a.z, a.w); o.z = pack_bf16(b.x, b.y); o.w = pack_bf16(b.z, b.w);
            *(u32x4*)(dst + i) = o;
        }
    };
    conv(p.x, (bf16_t*)(ws + WS_XB), (size_t)NTOK * D_MODEL);
    {
        const int lane = tid & 63, gw = bid * 4 + (tid >> 6), nw = nb * 4;
        for (int row = gw; row < 2 * 16384; row += nw) {
            const bool isv = row >= 16384; const int e = isv ? row - 16384 : row;
            const float* src = (isv ? p.peer_v : p.peer_u) + (size_t)e * 1024 + lane * 16;
            f32x4 v[4]; float mx = 0.f;
#pragma unroll
            for (int i = 0; i < 4; ++i) { v[i] = *(const f32x4*)(src + 4 * i); mx = fmaxf(mx, fmaxf(fmaxf(fabsf(v[i][0]), fabsf(v[i][1])), fmaxf(fabsf(v[i][2]), fabsf(v[i][3])))); }
#pragma unroll
            for (int o = 32; o >= 1; o >>= 1) mx = fmaxf(mx, __shfl_xor(mx, o));
            const float sc = mx > 0.f ? mx * (1.0f / 440.0f) : 1.0f, inv = mx > 0.f ? 440.0f / mx : 1.0f;
            u32x4 o4;
#pragma unroll
            for (int i = 0; i < 4; ++i) {
                int w = 0;
                w = __builtin_amdgcn_cvt_pk_fp8_f32(v[i][0] * inv, v[i][1] * inv, w, false);
                w = __builtin_amdgcn_cvt_pk_fp8_f32(v[i][2] * inv, v[i][3] * inv, w, true);
                o4[i] = (unsigned)w;
            }
            *(u32x4*)(ws + (isv ? WS_VT : WS_UT) + (size_t)e * 1024 + lane * 16) = o4;
            if (lane == 0) ((float*)(ws + (isv ? WS_SV : WS_SU)))[e] = sc;
        }
    }
    conv(p.peer_subkeys, (bf16_t*)(ws + WS_SK), (size_t)8 * 2 * 128 * 128);
    float* tl = (float*)lds;
    auto transp = [&](const float* src, bf16_t* dst, int N, int Npad) {
        const int tn = Npad / 64, tk = 1024 / 64;
        for (int t = bid; t < tn * tk; t += nb) {
            const int n0 = (t % tn) * 64, k0 = (t / tn) * 64;
            __syncthreads();
            for (int e = tid; e < 4096; e += NTHREADS) { const int kk = e >> 6, nn = e & 63; tl[kk * 65 + nn] = (n0 + nn < N) ? src[(size_t)(k0 + kk) * N + n0 + nn] : 0.f; }
            __syncthreads();
            for (int e = tid; e < 4096; e += NTHREADS) { const int nn = e >> 6, kk = e & 63; dst[(size_t)(n0 + nn) * 1024 + k0 + kk] = (bf16_t)f2bf(tl[kk * 65 + nn]); }
        }
    };
    transp(p.w_in, (bf16_t*)(ws + WS_WINT), NMIX, NMIX_PAD);
    transp(p.w_o, (bf16_t*)(ws + WS_WOT), 1024, 1024);
    transp(p.peer_wq, (bf16_t*)(ws + WS_WQT), PEER_N, PEER_N);
}

DI void p1_inproj(const Params& p, unsigned char* lds) {
    unsigned char* ws = p.ws;
    const bf16_t* XB = (const bf16_t*)(ws + WS_XB); const bf16_t* WT = (const bf16_t*)(ws + WS_WINT);
    const float* cosT = (const float*)(ws + WS_ROPE); const float* sinT = cosT + SEQ * 32;
    const int tid = threadIdx.x, lane = tid & 63, wave = tid >> 6, wm = wave >> 1, wn = wave & 1, c = lane & 15, g = lane >> 4;
    constexpr int NT = NMIX_PAD / 128, MT = NTOK / 128;
    for (int t = blockIdx.x; t < NT * MT; t += gridDim.x) {
        const int mt = t / NT, nt = t % NT;
        f32x4 acc[4][4];
        gemm_128x128(XB + (size_t)mt * 128 * 1024, 1024, WT + (size_t)nt * 128 * 1024, 1024, 1024, lds, acc);
        const int col64 = nt * 2 + wn;
        bf16_t* dst; int ld, coff; bool rope = true; float scale = 1.f;
        if (col64 < 8)       { dst = (bf16_t*)(ws + WS_QA); ld = 512; coff = col64 * 64; scale = 0.125f; }
        else if (col64 < 10) { dst = (bf16_t*)(ws + WS_KA); ld = 128; coff = (col64 - 8) * 64; }
        else if (col64 < 12) { dst = (bf16_t*)(ws + WS_VA); ld = 128; coff = (col64 - 10) * 64; rope = false; }
        else if (col64 < 20) { dst = (bf16_t*)(ws + WS_QB); ld = 512; coff = (col64 - 12) * 64; scale = 0.125f; }
        else if (col64 == 20) { dst = (bf16_t*)(ws + WS_KB); ld = 64; coff = 0; }
        else if (col64 == 21) { dst = (bf16_t*)(ws + WS_VB); ld = 64; coff = 0; rope = false; }
        else if (col64 < 26) { dst = (bf16_t*)(ws + WS_QI); ld = 256; coff = (col64 - 22) * 64; }
        else                 { dst = (bf16_t*)(ws + WS_KI); ld = 64; coff = 0; }
        if (col64 == 27) {
            if (g == 0) {
#pragma unroll
                for (int m = 0; m < 4; ++m) { const int tok = mt * 128 + wm * 64 + m * 16 + c; *(f32x4*)((float*)(ws + WS_WI) + (size_t)tok * 4) = acc[m][0] * 0.0625f; }
            }
            continue;
        }
#pragma unroll
        for (int m = 0; m < 4; ++m) {
            const int tok = mt * 128 + wm * 64 + m * 16 + c, pos = tok & (SEQ - 1);
            f32x4 v[4] = {acc[m][0], acc[m][1], acc[m][2], acc[m][3]};
            if (col64 == 26) {
                float s = 0.f;
#pragma unroll
                for (int n = 0; n < 4; ++n) s += (v[n][0] + v[n][1]) + (v[n][2] + v[n][3]);
                s += __shfl_xor(s, 16); s += __shfl_xor(s, 32);
                const float mu = s * (1.f / 64.f); float q = 0.f;
#pragma unroll
                for (int n = 0; n < 4; ++n) { const f32x4 d = v[n] - mu; q += (d[0] * d[0] + d[1] * d[1]) + (d[2] * d[2] + d[3] * d[3]); }
                q += __shfl_xor(q, 16); q += __shfl_xor(q, 32);
                const float rstd = rsqrtf(q * (1.f / 64.f) + LN_EPS);
#pragma unroll
                for (int n = 0; n < 4; ++n) {
                    const f32x4 gg = *(const f32x4*)(p.idx_k_g + 16 * n + 4 * g), bb = *(const f32x4*)(p.idx_k_b + 16 * n + 4 * g);
                    v[n] = (v[n] - mu) * rstd * gg + bb;
                }
            }
            if (rope) {
#pragma unroll
                for (int n = 0; n < 2; ++n) {
                    const f32x4 cs = *(const f32x4*)(cosT + pos * 32 + 16 * n + 4 * g), sn = *(const f32x4*)(sinT + pos * 32 + 16 * n + 4 * g);
                    const f32x4 t1 = v[n], t2 = v[n + 2];
                    v[n] = t1 * cs - t2 * sn; v[n + 2] = t2 * cs + t1 * sn;
                }
            }
#pragma unroll
            for (int n = 0; n < 4; ++n) {
                const f32x4 o = v[n] * scale; u32x2 w; w.x = pack_bf16(o[0], o[1]); w.y = pack_bf16(o[2], o[3]);
                *(u32x2*)(dst + (size_t)tok * ld + coff + 16 * n + 4 * g) = w;
            }
        }
    }
}

constexpr int NDSA = NTOK / 4, NSWA = BATCH * 32 * 8;
constexpr int P2_SC = 0, P2_HIST = 32768, P2_LIST = 49152, P2_ITEM = 51200;

DI unsigned f16_key(float v) {
    _Float16 hv = (_Float16)v; unsigned short hb = __builtin_bit_cast(unsigned short, hv); unsigned b = hb;
    if (b == 0x8000u) b = 0u;
    return (b & 0x8000u) ? ((~b) & 0xffffu) : (b | 0x8000u);
}

template <int MODE> DI void p2_dsa_item(const Params& p, unsigned char* lds, int item) {
    unsigned char* ws = p.ws;
    const bf16_t* QI = (const bf16_t*)(ws + WS_QI); const bf16_t* KI = (const bf16_t*)(ws + WS_KI); const float* WI = (const float*)(ws + WS_WI);
    const bf16_t* QB = (const bf16_t*)(ws + WS_QB); const bf16_t* KB = (const bf16_t*)(ws + WS_KB); const bf16_t* VB = (const bf16_t*)(ws + WS_VB);
    bf16_t* ATT = (bf16_t*)(ws + WS_ATT);
    const int tid = threadIdx.x, lane = tid & 63, wave = tid >> 6, c = lane & 15, g = lane >> 4;
    const int b = item & 7, tb = 1023 - (item >> 3), t0 = tb * 4, tok0 = b * SEQ + t0;
    unsigned short* sc = (unsigned short*)(lds + P2_SC);
    unsigned* hist = (unsigned*)(lds + P2_HIST) + wave * 1024;
    unsigned short* list = (unsigned short*)(lds + P2_LIST) + wave * 256;
    {
        bf16x8 af[2];
#pragma unroll
        for (int s = 0; s < 2; ++s) af[s] = as_bf16x8(ldg16(QI + (size_t)(tok0 + (c >> 2)) * 256 + (c & 3) * 64 + 32 * s + 8 * g));
        const f32x4 wv = *(const f32x4*)(WI + (size_t)(tok0 + g) * 4);
        const int ntile = (t0 + 4 + 15) >> 4;
        for (int kt = wave; kt < ntile; kt += 4) {
            const int key = kt * 16 + c;
            const bf16_t* kp = KI + (size_t)(b * SEQ + key) * 64 + 8 * g;
            const bf16x8 b0 = as_bf16x8(ldg16(kp)), b1 = as_bf16x8(ldg16(kp + 32));
            f32x4 d = mfma16(af[0], b0, (f32x4){0.f, 0.f, 0.f, 0.f});
            d = mfma16(af[1], b1, d);
            const float s = wv[0] * fmaxf(d[0], 0.f) + wv[1] * fmaxf(d[1], 0.f) + wv[2] * fmaxf(d[2], 0.f) + wv[3] * fmaxf(d[3], 0.f);
            sc[g * 4096 + key] = (unsigned short)f16_key(s);
        }
    }
    __syncthreads();
    if (!(MODE & 2)) return;
    const int n = t0 + wave + 1;
    const int L = n < 256 ? n : 256;
    const unsigned short* myk = sc + wave * 4096;
    if (n <= 256) {
        for (int i = lane; i < n; i += 64) list[i] = (unsigned short)i;
    } else {
#pragma unroll
        for (int i = 0; i < 4; ++i) *(u32x4*)(hist + lane * 16 + i * 4) = (u32x4){0u, 0u, 0u, 0u};
        for (int i = lane; i < n; i += 64) { const unsigned m = myk[i]; atomicAdd(&hist[m >> 6], 1u); }
        unsigned h[16];
#pragma unroll
        for (int i = 0; i < 4; ++i) { const u32x4 t = *(const u32x4*)(hist + lane * 16 + i * 4); h[4 * i] = t.x; h[4 * i + 1] = t.y; h[4 * i + 2] = t.z; h[4 * i + 3] = t.w; }
#pragma unroll
        for (int i = 0; i < 4; ++i) *(u32x4*)(hist + lane * 16 + i * 4) = (u32x4){0u, 0u, 0u, 0u};
        unsigned sl = 0;
#pragma unroll
        for (int i = 0; i < 16; ++i) sl += h[i];
        unsigned pre = sl;
#pragma unroll
        for (int o = 1; o < 64; o <<= 1) { const unsigned t = __shfl_up(pre, o); if (lane >= o) pre += t; }
        const unsigned tot = __shfl(pre, 63);
        const unsigned suf = tot - pre;
        int found = -1; unsigned cab = 0, cum = suf;
#pragma unroll
        for (int j = 15; j >= 0; --j) { const bool hit = (found < 0) && (cum + h[j] >= 256u); if (hit) { found = lane * 16 + j; cab = cum; } cum += h[j]; }
        const bool mine = (suf < 256u) && (suf + sl >= 256u);
        const unsigned long long mm = __ballot(mine);
        const int src = __ffsll((long long)mm) - 1;
        const unsigned bstar = (unsigned)__shfl(found, src), cabove = __shfl(cab, src);
        const unsigned r1 = 256u - cabove;
        for (int i = lane; i < n; i += 64) { const unsigned m = myk[i]; if ((m >> 6) == bstar) atomicAdd(&hist[m & 63u], 1u); }
        const unsigned cnt = hist[lane];
        hist[lane] = 0u;
        unsigned pre2 = cnt;
#pragma unroll
        for (int o = 1; o < 64; o <<= 1) { const unsigned t = __shfl_up(pre2, o); if (lane >= o) pre2 += t; }
        const unsigned tot2 = __shfl(pre2, 63);
        const unsigned suf2 = tot2 - pre2;
        const bool mine2 = (suf2 < r1) && (suf2 + cnt >= r1);
        const unsigned long long mm2 = __ballot(mine2);
        const int src2 = __ffsll((long long)mm2) - 1;
        const unsigned T = (bstar << 6) | (unsigned)src2;
        const unsigned req = r1 - __shfl(suf2, src2);
        unsigned eq_run = 0, out_run = 0;
        for (int base = 0; base < n; base += 64) {
            const int i = base + lane; const bool in = i < n; const unsigned m = in ? myk[i] : 0u;
            const bool gt = in && (m > T), eq = in && (m == T);
            const unsigned long long eqm = __ballot(eq);
            const unsigned eq_rank = eq_run + __builtin_amdgcn_mbcnt_hi((unsigned)(eqm >> 32), __builtin_amdgcn_mbcnt_lo((unsigned)eqm, 0u));
            const bool take = gt || (eq && eq_rank < req);
            const unsigned long long tm = __ballot(take);
            const unsigned pos = out_run + __builtin_amdgcn_mbcnt_hi((unsigned)(tm >> 32), __builtin_amdgcn_mbcnt_lo((unsigned)tm, 0u));
            if (take && pos < 256u) list[pos] = (unsigned short)i;
            eq_run += (unsigned)__popcll(eqm); out_run += (unsigned)__popcll(tm);
        }
    }
    if (!(MODE & 4)) return;
    const int tok = tok0 + wave;
    bf16x8 qf[2], sel[2];
#pragma unroll
    for (int s = 0; s < 2; ++s) {
        u32x4 t = (u32x4){0u, 0u, 0u, 0u};
        if (c < 8) t = ldg16(QB + (size_t)tok * 512 + c * 64 + 32 * s + 8 * g);
        qf[s] = as_bf16x8(t);
#pragma unroll
        for (int j = 0; j < 8; ++j) sel[s][j] = (8 * g + j == 16 * s + c) ? (short)0x3F80 : (short)0;
    }
    const bf16_t* kbase = KB + (size_t)b * SEQ * 64 + 8 * g;
    const bf16_t* vbase = VB + (size_t)b * SEQ * 64 + 8 * g;
    f32x4 st[16];
#pragma unroll
    for (int T = 0; T < 16; ++T) {
        const int idx = T * 16 + c; const int kid = (idx < L) ? (int)list[idx] : 0;
        const bf16_t* kp = kbase + (size_t)kid * 64;
        const bf16x8 k0 = as_bf16x8(ldg16(kp)), k1 = as_bf16x8(ldg16(kp + 32));
        f32x4 d = mfma16(k0, qf[0], (f32x4){0.f, 0.f, 0.f, 0.f});
        st[T] = mfma16(k1, qf[1], d);
        if ((T & 3) == 3) __builtin_amdgcn_sched_barrier(0);
    }
    float mx = -3.0e38f;
    {
        const int lrem = L - 4 * g;
#pragma unroll
        for (int T = 0; T < 16; ++T)
#pragma unroll
            for (int r = 0; r < 4; ++r) { const float sv = (T * 16 + r < lrem) ? st[T][r] : -3.0e38f; st[T][r] = sv; mx = fmaxf(mx, sv); }
    }
    mx = fmaxf(mx, __shfl_xor(mx, 16)); mx = fmaxf(mx, __shfl_xor(mx, 32));
    float lsum = 0.f;
#pragma unroll
    for (int T = 0; T < 16; ++T)
#pragma unroll
        for (int r = 0; r < 4; ++r) { const float e = __expf(st[T][r] - mx); st[T][r] = e; lsum += e; }
    lsum += __shfl_xor(lsum, 16); lsum += __shfl_xor(lsum, 32);
    const float rl = 1.0f / lsum;
    f32x4 O[4];
#pragma unroll
    for (int cb = 0; cb < 4; ++cb) O[cb] = (f32x4){0.f, 0.f, 0.f, 0.f};
#pragma unroll
    for (int u = 0; u < 8; ++u) {
        const int i0 = (2 * u) * 16 + c, i1 = (2 * u + 1) * 16 + c;
        const int kid0 = (i0 < L) ? (int)list[i0] : 0, kid1 = (i1 < L) ? (int)list[i1] : 0;
        const bf16_t* vp0 = vbase + (size_t)kid0 * 64; const bf16_t* vp1 = vbase + (size_t)kid1 * 64;
        bf16x8 va0[2], va1[2];
        va0[0] = as_bf16x8(ldg16(vp0)); va0[1] = as_bf16x8(ldg16(vp0 + 32)); va1[0] = as_bf16x8(ldg16(vp1)); va1[1] = as_bf16x8(ldg16(vp1 + 32));
        u32x4 pf; pf.x = pack_bf16(st[2 * u][0] * rl, st[2 * u][1] * rl); pf.y = pack_bf16(st[2 * u][2] * rl, st[2 * u][3] * rl);
        pf.z = pack_bf16(st[2 * u + 1][0] * rl, st[2 * u + 1][1] * rl); pf.w = pack_bf16(st[2 * u + 1][2] * rl, st[2 * u + 1][3] * rl);
#pragma unroll
        for (int cb = 0; cb < 4; ++cb) {
            const f32x4 z = (f32x4){0.f, 0.f, 0.f, 0.f};
            const f32x4 v0 = mfma16(va0[cb >> 1], sel[cb & 1], z), v1 = mfma16(va1[cb >> 1], sel[cb & 1], z);
            u32x4 vf; vf.x = pack_bf16(v0[0], v0[1]); vf.y = pack_bf16(v0[2], v0[3]); vf.z = pack_bf16(v1[0], v1[1]); vf.w = pack_bf16(v1[2], v1[3]);
            O[cb] = mfma16(as_bf16x8(pf), as_bf16x8(vf), O[cb]);
        }
        if (u & 1) __builtin_amdgcn_sched_barrier(0);
    }
    if (g < 2) {
#pragma unroll
        for (int cb = 0; cb < 4; ++cb)
#pragma unroll
            for (int r = 0; r < 4; ++r) ATT[(size_t)tok * 1024 + 512 + (4 * g + r) * 64 + 16 * cb + c] = (bf16_t)f2bf(O[cb][r]);
    }
}

DI void p2_swa_item(const Params& p, int item2) {
    unsigned char* ws = p.ws;
    const bf16_t* QA = (const bf16_t*)(ws + WS_QA); const bf16_t* KA = (const bf16_t*)(ws + WS_KA); const bf16_t* VA = (const bf16_t*)(ws + WS_VA);
    bf16_t* ATT = (bf16_t*)(ws + WS_ATT);
    const int tid = threadIdx.x, lane = tid & 63, wave = tid >> 6, r = lane & 31, h = lane >> 5;
    const int hq = item2 & 7, blk = (item2 >> 3) & 31, b = item2 >> 8, kvh = hq >> 2;
    const int qi = 32 * wave + r, tokq = b * SEQ + blk * 128 + qi;
    bf16x8 qf[4], sel[2];
#pragma unroll
    for (int s = 0; s < 4; ++s) qf[s] = as_bf16x8(ldg16(QA + (size_t)tokq * 512 + hq * 64 + 16 * s + 8 * h));
#pragma unroll
    for (int x = 0; x < 2; ++x)
#pragma unroll
        for (int j = 0; j < 8; ++j) sel[x][j] = (8 * h + j + 16 * x == r) ? (short)0x3F80 : (short)0;
    const float sink = p.sinks[hq];
    f32x16 ST[5];
#pragma unroll
    for (int ti = 0; ti < 5; ++ti) {
        const int sj = 32 * (wave + ti) + r; int pos = blk * 128 - 128 + sj; pos = pos < 0 ? 0 : pos;
        const bf16_t* kp = KA + (size_t)(b * SEQ + pos) * 128 + kvh * 64 + 8 * h;
        f32x16 d; for (int i = 0; i < 16; ++i) d[i] = 0.f;
#pragma unroll
        for (int s = 0; s < 4; ++s) d = mfma32(as_bf16x8(ldg16(kp + 16 * s)), qf[s], d);
        ST[ti] = d;
    }
    float mx = sink;
    {
        const int lo = r + 1 - 4 * h;
        const int lo0 = (blk > 0) ? lo : (lo > 128 - 32 * wave - 4 * h ? lo : 128 - 32 * wave - 4 * h);
#pragma unroll
        for (int ti = 0; ti < 5; ++ti)
#pragma unroll
            for (int reg = 0; reg < 16; ++reg) {
                const int e = 32 * ti + (reg & 3) + 8 * (reg >> 2);
                const float sv = (e >= lo0 && e < lo + 128) ? ST[ti][reg] : -3.0e38f; ST[ti][reg] = sv; mx = fmaxf(mx, sv);
            }
    }
    mx = fmaxf(mx, __shfl_xor(mx, 32));
    float lsum = 0.f;
#pragma unroll
    for (int ti = 0; ti < 5; ++ti)
#pragma unroll
        for (int reg = 0; reg < 16; ++reg) { const float e = __expf(ST[ti][reg] - mx); ST[ti][reg] = e; lsum += e; }
    lsum += __shfl_xor(lsum, 32);
    lsum += __expf(sink - mx);
    const float rl = 1.0f / lsum;
    f32x16 OT[2];
    for (int i = 0; i < 16; ++i) { OT[0][i] = 0.f; OT[1][i] = 0.f; }
#pragma unroll
    for (int ti = 0; ti < 5; ++ti) {
        const int sj = 32 * (wave + ti) + r; int pos = blk * 128 - 128 + sj; pos = pos < 0 ? 0 : pos;
        const bf16_t* vp = VA + (size_t)(b * SEQ + pos) * 128 + kvh * 64 + 8 * h;
        bf16x8 vf[4];
#pragma unroll
        for (int s = 0; s < 4; ++s) vf[s] = as_bf16x8(ldg16(vp + 16 * s));
        u32x4 pb[2];
#pragma unroll
        for (int s2 = 0; s2 < 2; ++s2) {
            pb[s2].x = pack_bf16(ST[ti][8 * s2 + 0] * rl, ST[ti][8 * s2 + 1] * rl); pb[s2].y = pack_bf16(ST[ti][8 * s2 + 2] * rl, ST[ti][8 * s2 + 3] * rl);
            pb[s2].z = pack_bf16(ST[ti][8 * s2 + 4] * rl, ST[ti][8 * s2 + 5] * rl); pb[s2].w = pack_bf16(ST[ti][8 * s2 + 6] * rl, ST[ti][8 * s2 + 7] * rl);
        }
#pragma unroll
        for (int db = 0; db < 2; ++db) {
            f32x16 vt; for (int i = 0; i < 16; ++i) vt[i] = 0.f;
            vt = mfma32(vf[2 * db], sel[0], vt); vt = mfma32(vf[2 * db + 1], sel[1], vt);
#pragma unroll
            for (int s2 = 0; s2 < 2; ++s2) {
                u32x4 va; va.x = pack_bf16(vt[8 * s2 + 0], vt[8 * s2 + 1]); va.y = pack_bf16(vt[8 * s2 + 2], vt[8 * s2 + 3]);
                va.z = pack_bf16(vt[8 * s2 + 4], vt[8 * s2 + 5]); va.w = pack_bf16(vt[8 * s2 + 6], vt[8 * s2 + 7]);
                OT[db] = mfma32(as_bf16x8(va), as_bf16x8(pb[s2]), OT[db]);
            }
        }
    }
#pragma unroll
    for (int db = 0; db < 2; ++db)
#pragma unroll
        for (int q4 = 0; q4 < 4; ++q4) {
            u32x2 w; w.x = pack_bf16(OT[db][4 * q4], OT[db][4 * q4 + 1]); w.y = pack_bf16(OT[db][4 * q4 + 2], OT[db][4 * q4 + 3]);
            *(u32x2*)(ATT + (size_t)tokq * 1024 + hq * 64 + 32 * db + 8 * q4 + 4 * h) = w;
        }
}

template <int MODE> DI void p2_attention(const Params& p, unsigned char* lds, int cidx = 0) {
    unsigned* ctr = (unsigned*)(p.ws + WS_CTL) + cidx;
    volatile int* s_item = (volatile int*)(lds + P2_ITEM);
    for (;;) {
        __syncthreads();
        if (threadIdx.x == 0) *s_item = (int)atomicAdd(ctr, 1u);
        __syncthreads();
        const int item = *s_item;
        if (item >= NDSA + NSWA) break;

#if !defined(NO_DSA)
        if (item < NDSA) p2_dsa_item<MODE>(p, lds, item);
#endif
#if !defined(NO_SWA)
        if (item >= NDSA && (MODE & 8)) p2_swa_item(p, item - NDSA);
#endif

    }
}

DI void p3_outproj(const Params& p, unsigned char* lds) {
    unsigned char* ws = p.ws;
    const bf16_t* ATT = (const bf16_t*)(ws + WS_ATT); const bf16_t* WT = (const bf16_t*)(ws + WS_WOT);
    const int tid = threadIdx.x, lane = tid & 63, wave = tid >> 6, wm = wave >> 1, wn = wave & 1, c = lane & 15, g = lane >> 4;
    constexpr int NT = 8, MT = NTOK / 128;
    for (int t = blockIdx.x; t < NT * MT; t += gridDim.x) {
        const int mt = t / NT, nt = t % NT;
        f32x4 acc[4][4];
        gemm_128x128(ATT + (size_t)mt * 128 * 1024, 1024, WT + (size_t)nt * 128 * 1024, 1024, 1024, lds, acc);
#pragma unroll
        for (int m = 0; m < 4; ++m) {
            const int tok = mt * 128 + wm * 64 + m * 16 + c;
#pragma unroll
            for (int n = 0; n < 4; ++n) {
                const size_t o = (size_t)tok * 1024 + nt * 128 + wn * 64 + 16 * n + 4 * g;
                const f32x4 xv = *(const f32x4*)(p.x + o);
                *(f32x4*)(p.out + o) = xv * ALPHA + acc[m][n];
            }
        }
    }
}

DI void p3b_ln1(const Params& p) {
    bf16_t* H1B = (bf16_t*)(p.ws + WS_XB);
    const int lane = threadIdx.x & 63, gw = blockIdx.x * 4 + (threadIdx.x >> 6), nw = gridDim.x * 4;
    for (int row = gw; row < NTOK; row += nw) {
        f32x4 v[4]; float s = 0.f;
#pragma unroll
        for (int i = 0; i < 4; ++i) { v[i] = *(const f32x4*)(p.out + (size_t)row * 1024 + (lane + 64 * i) * 4); s += (v[i][0] + v[i][1]) + (v[i][2] + v[i][3]); }
        const float mu = wave_sum(s) * (1.f / 1024.f); float q = 0.f;
#pragma unroll
        for (int i = 0; i < 4; ++i) { const f32x4 d = v[i] - mu; q += (d[0] * d[0] + d[1] * d[1]) + (d[2] * d[2] + d[3] * d[3]); }
        const float rstd = rsqrtf(wave_sum(q) * (1.f / 1024.f) + LN_EPS);
#pragma unroll
        for (int i = 0; i < 4; ++i) {
            const int col = (lane + 64 * i) * 4;
            const f32x4 gg = *(const f32x4*)(p.ln1_g + col), bb = *(const f32x4*)(p.ln1_b + col);
            const f32x4 o = (v[i] - mu) * rstd * gg + bb;
            u32x2 w; w.x = pack_bf16(o[0], o[1]); w.y = pack_bf16(o[2], o[3]);
            *(u32x2*)(H1B + (size_t)row * 1024 + col) = w;
        }
    }
}

DI void top16_insert(float (&tv)[16], int (&ti)[16], float v, int i) {
#pragma unroll
    for (int j = 0; j < 16; ++j) { const bool sw = v > tv[j]; const float a = tv[j]; const int b = ti[j]; tv[j] = sw ? v : a; ti[j] = sw ? i : b; v = sw ? a : v; i = sw ? b : i; }
}
constexpr int P4_QS = 32768, P4_ST0V = 66048, P4_ST0I = 66048 + 8704, P4_ST1I = 8704;

DI void p4_peer_query(const Params& p, unsigned char* lds) {
    unsigned char* ws = p.ws;
    const bf16_t* H1B = (const bf16_t*)(ws + WS_XB); const bf16_t* WQT = (const bf16_t*)(ws + WS_WQT); const bf16_t* SK = (const bf16_t*)(ws + WS_SK);
    unsigned short* PE = (unsigned short*)(ws + WS_PE); float* PG = (float*)(ws + WS_PG); float* PS = (float*)(ws + WS_PS);
    const float* SU = (const float*)(ws + WS_SU); const float* SV = (const float*)(ws + WS_SV);
    const int tid = threadIdx.x, lane = tid & 63, wave = tid >> 6, wm = wave >> 1, wn = wave & 1, c = lane & 15, g = lane >> 4;
    const int lrow = tid >> 3, lch = tid & 7;
    float* Ss = (float*)lds;
    float* st0v = (float*)(lds + P4_ST0V); unsigned char* st0i = lds + P4_ST0I; unsigned char* st1i = lds + P4_ST1I;
    constexpr int MT = NTOK / 128;
    for (int t = blockIdx.x; t < MT * 8; t += gridDim.x) {
        const int mt = t >> 3, head = t & 7;
        float tv[16]; int ti[16];
#pragma unroll 1
        for (int ph = 0; ph < 2; ++ph) {
            f32x4 acc[4][4];
            gemm_128x128(H1B + (size_t)mt * 128 * 1024, 1024, WQT + (size_t)(head * 256 + ph * 128) * 1024, 1024, 1024, lds, acc);
            __syncthreads();
#pragma unroll
            for (int m = 0; m < 4; ++m)
#pragma unroll
                for (int n = 0; n < 4; ++n) {
                    const int row = wm * 64 + m * 16 + c;
                    u32x2 w; w.x = pack_bf16(acc[m][n][0], acc[m][n][1]); w.y = pack_bf16(acc[m][n][2], acc[m][n][3]);
                    *(u32x2*)(lds + P4_QS + wn * 16384 + row * 128 + (((2 * n + (g >> 1)) ^ (row & 7)) << 4) + (g & 1) * 8) = w;
                }
            {
                const bf16_t* sp = SK + (size_t)((head * 2 + ph) * 128 + lrow) * 128 + lch * 8;
#pragma unroll
                for (int k2 = 0; k2 < 2; ++k2)
#pragma unroll
                    for (int i = 0; i < 4; ++i) *(u32x4*)(lds + k2 * 16384 + (lrow + 32 * i) * 128 + ((lch ^ (lrow & 7)) << 4)) = ldg16(sp + (size_t)(32 * i) * 128 + k2 * 64);
            }
            __syncthreads();
            f32x4 a2[4][4];
#pragma unroll
            for (int m = 0; m < 4; ++m)
#pragma unroll
                for (int n = 0; n < 4; ++n) a2[m][n] = (f32x4){0.f, 0.f, 0.f, 0.f};
#pragma unroll
            for (int k2 = 0; k2 < 2; ++k2)
#pragma unroll
                for (int s = 0; s < 2; ++s) {
                    bf16x8 xf[4], wf[4];
#pragma unroll
                    for (int m = 0; m < 4; ++m) { const int row = wm * 64 + m * 16 + c; xf[m] = as_bf16x8(*(const u32x4*)(lds + P4_QS + k2 * 16384 + row * 128 + (((4 * s + g) ^ (c & 7)) << 4))); }
#pragma unroll
                    for (int n = 0; n < 4; ++n) { const int row = wn * 64 + n * 16 + c; wf[n] = as_bf16x8(*(const u32x4*)(lds + k2 * 16384 + row * 128 + (((4 * s + g) ^ (c & 7)) << 4))); }
#pragma unroll
                    for (int m = 0; m < 4; ++m)
#pragma unroll
                        for (int n = 0; n < 4; ++n) a2[m][n] = mfma16(wf[n], xf[m], a2[m][n]);
                }
            __syncthreads();
#pragma unroll
            for (int m = 0; m < 4; ++m)
#pragma unroll
                for (int n = 0; n < 4; ++n)
#pragma unroll
                    for (int r = 0; r < 4; ++r) Ss[(wm * 64 + m * 16 + c) * 129 + wn * 64 + 16 * n + 4 * g + r] = a2[m][n][r];
            __syncthreads();
            if (tid < 128) {
#pragma unroll
                for (int j = 0; j < 16; ++j) { tv[j] = -3.0e38f; ti[j] = 0; }
                const float* rowp = Ss + tid * 129;
#pragma unroll 4
                for (int j = 0; j < 128; ++j) { const float v = rowp[j]; if (v > tv[15]) top16_insert(tv, ti, v, j); }
                if (ph == 0) {
#pragma unroll
                    for (int j = 0; j < 16; ++j) { st0v[tid * 17 + j] = tv[j]; st0i[tid * 20 + j] = (unsigned char)ti[j]; }
                }
            }
            __syncthreads();
        }
        if (tid < 128) {
#pragma unroll
            for (int j = 0; j < 16; ++j) st1i[tid * 20 + j] = (unsigned char)ti[j];
            float cv[16]; int ci[16];
#pragma unroll
            for (int j = 0; j < 16; ++j) { cv[j] = -3.0e38f; ci[j] = 0; }
#pragma unroll 1
            for (int a = 0; a < 16; ++a) {
                const float va = st0v[tid * 17 + a];
#pragma unroll
                for (int b = 0; b < 16; ++b) { const float v = va + tv[b]; if (v > cv[15]) top16_insert(cv, ci, v, a * 16 + b); }
            }
            const float cmax = cv[0]; float den = 0.f;
#pragma unroll
            for (int j = 0; j < 16; ++j) { cv[j] = __expf(cv[j] - cmax); den += cv[j]; }
            const float rden = 1.0f / den;
            const size_t ob = (size_t)(mt * 128 + tid) * 128 + head * 16;
#pragma unroll
            for (int j = 0; j < 16; ++j) {
                const int e = (int)st0i[tid * 20 + (ci[j] >> 4)] * 128 + (int)st1i[tid * 20 + (ci[j] & 15)];
                PE[ob + j] = (unsigned short)e; PG[ob + j] = cv[j] * rden * SV[e]; PS[ob + j] = SU[e];
            }
        }
        __syncthreads();
    }
}

DI float gelu_exact(float z) { return 0.5f * z * (1.0f + erff(z * 0.70710678118654752f)); }
DI float rdlane(float v, int l) { return __int_as_float(__builtin_amdgcn_readlane(__float_as_int(v), l)); }

typedef float f32x2 __attribute__((ext_vector_type(2)));
DI void p5_gather(const Params& p) {
    unsigned char* ws = p.ws;
    const bf16_t* H1B = (const bf16_t*)(ws + WS_XB); const unsigned char* UT = ws + WS_UT; const unsigned char* VT = ws + WS_VT;
    const unsigned short* PE = (const unsigned short*)(ws + WS_PE); const float* PG = (const float*)(ws + WS_PG); const float* PS = (const float*)(ws + WS_PS);
    const int lane = threadIdx.x & 63, gw = blockIdx.x * 4 + (threadIdx.x >> 6), nw = gridDim.x * 4;
    const bool b5 = (lane & 32) != 0, b4 = (lane & 16) != 0, b3 = (lane & 8) != 0, b2 = (lane & 4) != 0;
    for (int tok = gw; tok < NTOK; tok += nw) {
        float x[16], acc[16];
        {
            const u32x4 xa = ldg16(H1B + (size_t)tok * 1024 + lane * 16), xb = ldg16(H1B + (size_t)tok * 1024 + lane * 16 + 8);
            x[0] = bf_lo(xa.x); x[1] = bf_hi(xa.x); x[2] = bf_lo(xa.y); x[3] = bf_hi(xa.y); x[4] = bf_lo(xa.z); x[5] = bf_hi(xa.z); x[6] = bf_lo(xa.w); x[7] = bf_hi(xa.w);
            x[8] = bf_lo(xb.x); x[9] = bf_hi(xb.x); x[10] = bf_lo(xb.y); x[11] = bf_hi(xb.y); x[12] = bf_lo(xb.z); x[13] = bf_hi(xb.z); x[14] = bf_lo(xb.w); x[15] = bf_hi(xb.w);
        }
#pragma unroll
        for (int i = 0; i < 16; ++i) acc[i] = 0.f;
        const int pe_lo = (int)PE[(size_t)tok * 128 + lane], pe_hi = (int)PE[(size_t)tok * 128 + 64 + lane];
        const float pg_lo = PG[(size_t)tok * 128 + lane], pg_hi = PG[(size_t)tok * 128 + 64 + lane];
        const float ps_lo = PS[(size_t)tok * 128 + lane], ps_hi = PS[(size_t)tok * 128 + 64 + lane];
#pragma unroll 1
        for (int hd = 0; hd < 8; ++hd) {
            const int pes = hd < 4 ? pe_lo : pe_hi; const float pgs = hd < 4 ? pg_lo : pg_hi, pss = hd < 4 ? ps_lo : ps_hi;
            const int lb = (hd & 3) * 16;
            float d[16];
#pragma unroll
            for (int j = 0; j < 16; ++j) {
                const int e = __builtin_amdgcn_readlane(pes, lb + j);
                const u32x4 uw = ldg16(UT + (size_t)e * 1024 + lane * 16);
                float s = 0.f;
#pragma unroll
                for (int k = 0; k < 4; ++k) {
                    const f32x2 f0 = __builtin_amdgcn_cvt_pk_f32_fp8((int)uw[k], false), f1 = __builtin_amdgcn_cvt_pk_f32_fp8((int)uw[k], true);
                    s = fmaf(x[4 * k], f0.x, s); s = fmaf(x[4 * k + 1], f0.y, s); s = fmaf(x[4 * k + 2], f1.x, s); s = fmaf(x[4 * k + 3], f1.y, s);
                }
                d[j] = s;
            }
            float r8[8], r4[4], r2[2], r1;
#pragma unroll
            for (int j = 0; j < 8; ++j) { const float keep = b5 ? d[j + 8] : d[j], send = b5 ? d[j] : d[j + 8]; r8[j] = keep + __shfl_xor(send, 32); }
#pragma unroll
            for (int j = 0; j < 4; ++j) { const float keep = b4 ? r8[j + 4] : r8[j], send = b4 ? r8[j] : r8[j + 4]; r4[j] = keep + __shfl_xor(send, 16); }
#pragma unroll
            for (int j = 0; j < 2; ++j) { const float keep = b3 ? r4[j + 2] : r4[j], send = b3 ? r4[j] : r4[j + 2]; r2[j] = keep + __shfl_xor(send, 8); }
            { const float keep = b2 ? r2[1] : r2[0], send = b2 ? r2[0] : r2[1]; r1 = keep + __shfl_xor(send, 4); }
            r1 += __shfl_xor(r1, 2); r1 += __shfl_xor(r1, 1);
            const int mine = lb + ((lane >> 2) & 15);
            const float coef = gelu_exact(r1 * __shfl(pss, mine)) * __shfl(pgs, mine);
#pragma unroll
            for (int j = 0; j < 16; ++j) {
                const int e = __builtin_amdgcn_readlane(pes, lb + j);
                const float cj = rdlane(coef, 4 * j);
                const u32x4 vw = ldg16(VT + (size_t)e * 1024 + lane * 16);
#pragma unroll
                for (int k = 0; k < 4; ++k) {
                    const f32x2 f0 = __builtin_amdgcn_cvt_pk_f32_fp8((int)vw[k], false), f1 = __builtin_amdgcn_cvt_pk_f32_fp8((int)vw[k], true);
                    acc[4 * k] = fmaf(cj, f0.x, acc[4 * k]); acc[4 * k + 1] = fmaf(cj, f0.y, acc[4 * k + 1]); acc[4 * k + 2] = fmaf(cj, f1.x, acc[4 * k + 2]); acc[4 * k + 3] = fmaf(cj, f1.y, acc[4 * k + 3]);
                }
            }
        }
        float s = 0.f;
#pragma unroll
        for (int i = 0; i < 16; ++i) { acc[i] = fmaf(ALPHA, x[i], acc[i]); s += acc[i]; }
        const float mu = wave_sum(s) * (1.f / 1024.f); float q = 0.f;
#pragma unroll
        for (int i = 0; i < 16; ++i) { const float dd = acc[i] - mu; q = fmaf(dd, dd, q); }
        const float rstd = rsqrtf(wave_sum(q) * (1.f / 1024.f) + LN_EPS);
#pragma unroll
        for (int k4 = 0; k4 < 4; ++k4) {
            const int col = lane * 16 + k4 * 4;
            const f32x4 gg = *(const f32x4*)(p.ln2_g + col), bb = *(const f32x4*)(p.ln2_b + col);
            f32x4 o;
#pragma unroll
            for (int e = 0; e < 4; ++e) o[e] = (acc[k4 * 4 + e] - mu) * rstd * gg[e] + bb[e];
            *(f32x4*)(p.out + (size_t)tok * 1024 + col) = o;
        }
    }
}

constexpr int NPHASE = 7;
__global__ void __launch_bounds__(NTHREADS, 2) mega_fwd(Params p) {
    extern __shared__ __attribute__((aligned(16))) unsigned char lds[];
    cg::grid_group grid = cg::this_grid();
    const int lo = p.ph_lo, hi = p.ph_hi;
#ifndef P2_PROBE_MODE
#define P2_PROBE_MODE 15
#endif
#ifndef REP_MASK
#define REP_MASK 0
#endif
#define RUN_PHASE_NOREP(k, call) if (lo <= (k) && (k) < hi) { call; if ((k) + 1 < hi) grid.sync(); }
#define RUN_PHASE(k, call) if (lo <= (k) && (k) < hi) { call; if ((REP_MASK >> (k)) & 1) { grid.sync(); call; } if ((k) + 1 < hi) grid.sync(); }
#ifndef PH_MASK
#define PH_MASK 127
#endif
#if PH_MASK & 1
    RUN_PHASE(0, p0_prep(p, lds))
#endif
#if PH_MASK & 2
    RUN_PHASE(1, p1_inproj(p, lds))
#endif
#if PH_MASK & 4
#if (REP_MASK >> 2) & 1
    if (lo <= 2 && 2 < hi) { p2_attention<P2_PROBE_MODE>(p, lds, 1); grid.sync(); }
#endif
    RUN_PHASE_NOREP(2, p2_attention<15>(p, lds, 0))
#endif
#if PH_MASK & 8
    RUN_PHASE(3, p3_outproj(p, lds))
#endif
#if PH_MASK & 16
    RUN_PHASE(4, p3b_ln1(p))
#endif
#if PH_MASK & 32
    RUN_PHASE(5, p4_peer_query(p, lds))
#endif
#if PH_MASK & 64
    RUN_PHASE(6, p5_gather(p))
#endif
}

#ifndef MK_N_LAUNCHES
#define MK_N_LAUNCHES 1
#endif

extern "C" void kernel_launch(void* const* d_in, const int* in_sizes, int n_in, void* d_out, int out_size, void* d_ws, size_t ws_size, hipStream_t stream) {
    static int grid_blocks = 0;
    if (grid_blocks == 0) {
        if (n_in != 14 || out_size != NTOK * D_MODEL || ws_size < WS_END) {
            fprintf(stderr, "kernel_launch: unexpected problem (n_in %d, out %d, ws %zu, need %zu)\n", n_in, out_size, ws_size, (size_t)WS_END); grid_blocks = -1; return;
        }
        int dev = 0, cus = 0, per_cu = 0;
        hipGetDevice(&dev);
        hipDeviceGetAttribute(&cus, hipDeviceAttributeMultiprocessorCount, dev);
        if (hipFuncSetAttribute((const void*)mega_fwd, hipFuncAttributeMaxDynamicSharedMemorySize, LDS_BYTES) != hipSuccess) { fprintf(stderr, "kernel_launch: hipFuncSetAttribute failed\n"); }
        if (hipOccupancyMaxActiveBlocksPerMultiprocessor(&per_cu, (const void*)mega_fwd, NTHREADS, LDS_BYTES) != hipSuccess || per_cu < 1) { fprintf(stderr, "kernel_launch: occupancy query failed\n"); per_cu = 1; }
        if (per_cu > 2) per_cu = 2;
        (void)hipGetLastError();
        grid_blocks = cus * per_cu;
        fprintf(stderr, "kernel_launch: %d CUs x %d blocks\n", cus, per_cu);
    }
    if (grid_blocks < 0) return;
    Params p{};
    p.x = (const float*)d_in[0]; p.w_in = (const float*)d_in[1]; p.idx_k_g = (const float*)d_in[2]; p.idx_k_b = (const float*)d_in[3]; p.sinks = (const float*)d_in[4];
    p.w_o = (const float*)d_in[5]; p.ln1_g = (const float*)d_in[6]; p.ln1_b = (const float*)d_in[7]; p.peer_wq = (const float*)d_in[8]; p.peer_subkeys = (const float*)d_in[9];
    p.peer_u = (const float*)d_in[10]; p.peer_v = (const float*)d_in[11]; p.ln2_g = (const float*)d_in[12]; p.ln2_b = (const float*)d_in[13];
    p.out = (float*)d_out; p.ws = (unsigned char*)d_ws;
#if MK_N_LAUNCHES == 1
    p.ph_lo = 0; p.ph_hi = NPHASE;
    void* args[] = {&p};
    hipError_t e = hipLaunchCooperativeKernel((const void*)mega_fwd, dim3(grid_blocks), dim3(NTHREADS), args, LDS_BYTES, stream);
    if (e != hipSuccess) fprintf(stderr, "cooperative launch failed: %s (grid %d)\n", hipGetErrorString(e), grid_blocks);
#else
    for (int ph = 0; ph < NPHASE; ++ph) {
        p.ph_lo = ph; p.ph_hi = ph + 1;
        void* args[] = {&p};
        hipError_t e = hipLaunchCooperativeKernel((const void*)mega_fwd, dim3(grid_blocks), dim3(NTHREADS), args, LDS_BYTES, stream);
        if (e != hipSuccess) fprintf(stderr, "cooperative launch failed: %s (grid %d, phase %d)\n", hipGetErrorString(e), grid_blocks, ph);
    }
#endif
}
```

```cpp
#include <hip/hip_runtime.h>
#include <hip/hip_cooperative_groups.h>
#include <cstdio>
#include <cstdint>
namespace cg = cooperative_groups;

typedef unsigned short bf16_t;
typedef short bf16x8 __attribute__((ext_vector_type(8)));
typedef float f32x4 __attribute__((ext_vector_type(4)));
typedef float f32x16 __attribute__((ext_vector_type(16)));
typedef unsigned u32x4 __attribute__((ext_vector_type(4)));
typedef unsigned u32x2 __attribute__((ext_vector_type(2)));
#define DI __device__ __forceinline__

constexpr int D_MODEL = 1024, BATCH = 8, SEQ = 4096, NTOK = BATCH * SEQ;
constexpr int NMIX = 1732, NMIX_PAD = 1792;
constexpr int PEER_N = 2048;
constexpr float ALPHA = 1.189207115002721f;
constexpr float LN_EPS = 1e-5f;
constexpr int NTHREADS = 256;
constexpr int LDS_BYTES = 77824;

constexpr size_t MB = 1024 * 1024;
constexpr size_t WS_CTL   = 0;
constexpr size_t WS_BAR   = 65536;
constexpr size_t WS_ROPE  = 1 * MB;
constexpr size_t WS_WINT  = 2 * MB;
constexpr size_t WS_WOT   = 6 * MB;
constexpr size_t WS_WQT   = 8 * MB;
constexpr size_t WS_SK    = 12 * MB;
constexpr size_t WS_UT    = 13 * MB;
constexpr size_t WS_VT    = 29 * MB;
constexpr size_t WS_SU    = 45 * MB;
constexpr size_t WS_SV    = 46 * MB;
constexpr size_t WS_XB    = 77 * MB;
constexpr size_t WS_QA    = 141 * MB;
constexpr size_t WS_KA    = 173 * MB;
constexpr size_t WS_VA    = 181 * MB;
constexpr size_t WS_QB    = 189 * MB;
constexpr size_t WS_KB    = 221 * MB;
constexpr size_t WS_VB    = 225 * MB;
constexpr size_t WS_QI    = 229 * MB;
constexpr size_t WS_KI    = 245 * MB;
constexpr size_t WS_WI    = 249 * MB;
constexpr size_t WS_ATT   = 250 * MB;
constexpr size_t WS_PE    = 314 * MB;
constexpr size_t WS_PG    = 322 * MB;
constexpr size_t WS_PS    = 338 * MB;
constexpr size_t WS_END   = 354 * MB;

struct Params {
    const float* x; const float* w_in; const float* idx_k_g; const float* idx_k_b; const float* sinks; const float* w_o;
    const float* ln1_g; const float* ln1_b; const float* peer_wq; const float* peer_subkeys; const float* peer_u; const float* peer_v;
    const float* ln2_g; const float* ln2_b;
    float* out; unsigned char* ws;
    int ph_lo, ph_hi;
};

DI unsigned f2bf(float x) { unsigned u = __float_as_uint(x); u += 0x7fffu + ((u >> 16) & 1u); return u >> 16; }
DI unsigned pack_bf16(float lo, float hi) { return f2bf(lo) | (f2bf(hi) << 16); }
DI float bf_lo(unsigned w) { return __uint_as_float(w << 16); }
DI float bf_hi(unsigned w) { return __uint_as_float(w & 0xffff0000u); }
DI bf16x8 as_bf16x8(u32x4 v) { return __builtin_bit_cast(bf16x8, v); }
DI u32x4 ldg16(const void* p) { return *(const u32x4*)p; }
DI f32x4 mfma16(bf16x8 a, bf16x8 b, f32x4 c) { return __builtin_amdgcn_mfma_f32_16x16x32_bf16(a, b, c, 0, 0, 0); }
DI f32x16 mfma32(bf16x8 a, bf16x8 b, f32x16 c) { return __builtin_amdgcn_mfma_f32_32x32x16_bf16(a, b, c, 0, 0, 0); }
DI float wave_sum(float v) {
#pragma unroll
    for (int o = 32; o >= 1; o >>= 1) v += __shfl_xor(v, o);
    return v;
}

DI void gemm_128x128(const bf16_t* __restrict__ X, int ldx, const bf16_t* __restrict__ Wt, int ldw, int K, unsigned char* lds, f32x4 (&acc)[4][4]) {
    const int tid = threadIdx.x, lane = tid & 63, wave = tid >> 6, wm = wave >> 1, wn = wave & 1, c = lane & 15, g = lane >> 4;
    unsigned char* Xs = lds; unsigned char* Ws = lds + 16384;
    const int lrow = tid >> 3, lch = tid & 7;
    const bf16_t* xp = X + (size_t)lrow * ldx + lch * 8;
    const bf16_t* wp = Wt + (size_t)lrow * ldw + lch * 8;
    const int st_off = lrow * 128 + ((lch ^ (lrow & 7)) << 4);
    u32x4 xr[4], wr[4];
#pragma unroll
    for (int i = 0; i < 4; ++i) { xr[i] = ldg16(xp + (size_t)(32 * i) * ldx); wr[i] = ldg16(wp + (size_t)(32 * i) * ldw); }
#pragma unroll
    for (int m = 0; m < 4; ++m)
#pragma unroll
        for (int n = 0; n < 4; ++n) acc[m][n] = (f32x4){0.f, 0.f, 0.f, 0.f};
    const int nk = K / 64;
    for (int kt = 0; kt < nk; ++kt) {
        __syncthreads();
#pragma unroll
        for (int i = 0; i < 4; ++i) { *(u32x4*)(Xs + st_off + i * 4096) = xr[i]; *(u32x4*)(Ws + st_off + i * 4096) = wr[i]; }
        __syncthreads();
        if (kt + 1 < nk) {
#pragma unroll
            for (int i = 0; i < 4; ++i) { xr[i] = ldg16(xp + (size_t)(32 * i) * ldx + (kt + 1) * 64); wr[i] = ldg16(wp + (size_t)(32 * i) * ldw + (kt + 1) * 64); }
        }
#pragma unroll
        for (int s = 0; s < 2; ++s) {
            bf16x8 xf[4], wf[4];
#pragma unroll
            for (int m = 0; m < 4; ++m) { const int row = wm * 64 + m * 16 + c; xf[m] = as_bf16x8(*(const u32x4*)(Xs + row * 128 + (((4 * s + g) ^ (c & 7)) << 4))); }
#pragma unroll
            for (int n = 0; n < 4; ++n) { const int row = wn * 64 + n * 16 + c; wf[n] = as_bf16x8(*(const u32x4*)(Ws + row * 128 + (((4 * s + g) ^ (c & 7)) << 4))); }
#pragma unroll
            for (int m = 0; m < 4; ++m)
#pragma unroll
                for (int n = 0; n < 4; ++n) acc[m][n] = mfma16(wf[n], xf[m], acc[m][n]);
        }
    }
}

DI void p0_prep(const Params& p, unsigned char* lds) {
    const int tid = threadIdx.x, nb = gridDim.x, bid = blockIdx.x;
    const size_t gtid = (size_t)bid * NTHREADS + tid, gsz = (size_t)nb * NTHREADS;
    unsigned char* ws = p.ws;
    if (bid == 0) { for (int i = tid; i < 64; i += NTHREADS) ((unsigned*)(ws + WS_CTL))[i] = 0u; for (int i = tid; i < 3456; i += NTHREADS) ((unsigned*)(ws + WS_BAR))[i] = 0u; }
    {
        float* ct = (float*)(ws + WS_ROPE); float* stb = ct + SEQ * 32;
        for (size_t i = gtid; i < (size_t)SEQ * 32; i += gsz) {
            const int pos = (int)(i >> 5), fi = (int)(i & 31);
            const float inv = powf(10000.0f, -(float)(2 * fi) / 64.0f);
            const float ang = (float)pos * inv;
            ct[i] = cosf(ang); stb[i] = sinf(ang);
        }
    }
    auto conv = [&](const float* src, bf16_t* dst, size_t n) {
        for (size_t i = gtid * 8; i < n; i += gsz * 8) {
            const f32x4 a = *(const f32x4*)(src + i), b = *(const f32x4*)(src + i + 4);
            u32x4 o; o.x = pack_bf16(a.x, a.y); o.y = pack_bf16(a.z, a.w); o.z = pack_bf16(b.x, b.y); o.w = pack_bf16(b.z, b.w);
            *(u32x4*)(dst + i) = o;
        }
    };
    conv(p.x, (bf16_t*)(ws + WS_XB), (size_t)NTOK * D_MODEL);
    {
        const int lane = tid & 63, gw = bid * 4 + (tid >> 6), nw = nb * 4;
        for (int row = gw; row < 2 * 16384; row += nw) {
            const bool isv = row >= 16384; const int e = isv ? row - 16384 : row;
            const float* src = (isv ? p.peer_v : p.peer_u) + (size_t)e * 1024 + lane * 16;
            f32x4 v[4]; float mx = 0.f;
#pragma unroll
            for (int i = 0; i < 4; ++i) { v[i] = *(const f32x4*)(src + 4 * i); mx = fmaxf(mx, fmaxf(fmaxf(fabsf(v[i][0]), fabsf(v[i][1])), fmaxf(fabsf(v[i][2]), fabsf(v[i][3])))); }
#pragma unroll
            for (int o = 32; o >= 1; o >>= 1) mx = fmaxf(mx, __shfl_xor(mx, o));
            const float sc = mx > 0.f ? mx * (1.0f / 440.0f) : 1.0f, inv = mx > 0.f ? 440.0f / mx : 1.0f;
            u32x4 o4;
#pragma unroll
            for (int i = 0; i < 4; ++i) {
                int w = 0;
                w = __builtin_amdgcn_cvt_pk_fp8_f32(v[i][0] * inv, v[i][1] * inv, w, false);
                w = __builtin_amdgcn_cvt_pk_fp8_f32(v[i][2] * inv, v[i][3] * inv, w, true);
                o4[i] = (unsigned)w;
            }
            *(u32x4*)(ws + (isv ? WS_VT : WS_UT) + (size_t)e * 1024 + lane * 16) = o4;
            if (lane == 0) ((float*)(ws + (isv ? WS_SV : WS_SU)))[e] = sc;
        }
    }
    conv(p.peer_subkeys, (bf16_t*)(ws + WS_SK), (size_t)8 * 2 * 128 * 128);
    float* tl = (float*)lds;
    auto transp = [&](const float* src, bf16_t* dst, int N, int Npad) {
        const int tn = Npad / 64, tk = 1024 / 64;
        for (int t = bid; t < tn * tk; t += nb) {
            const int n0 = (t % tn) * 64, k0 = (t / tn) * 64;
            __syncthreads();
            for (int e = tid; e < 4096; e += NTHREADS) { const int kk = e >> 6, nn = e & 63; tl[kk * 65 + nn] = (n0 + nn < N) ? src[(size_t)(k0 + kk) * N + n0 + nn] : 0.f; }
            __syncthreads();
            for (int e = tid; e < 4096; e += NTHREADS) { const int nn = e >> 6, kk = e & 63; dst[(size_t)(n0 + nn) * 1024 + k0 + kk] = (bf16_t)f2bf(tl[kk * 65 + nn]); }
        }
    };
    transp(p.w_in, (bf16_t*)(ws + WS_WINT), NMIX, NMIX_PAD);
    transp(p.w_o, (bf16_t*)(ws + WS_WOT), 1024, 1024);
    transp(p.peer_wq, (bf16_t*)(ws + WS_WQT), PEER_N, PEER_N);
}

DI void p1_inproj(const Params& p, unsigned char* lds) {
    unsigned char* ws = p.ws;
    const bf16_t* XB = (const bf16_t*)(ws + WS_XB); const bf16_t* WT = (const bf16_t*)(ws + WS_WINT);
    const float* cosT = (const float*)(ws + WS_ROPE); const float* sinT = cosT + SEQ * 32;
    const int tid = threadIdx.x, lane = tid & 63, wave = tid >> 6, wm = wave >> 1, wn = wave & 1, c = lane & 15, g = lane >> 4;
    constexpr int NT = NMIX_PAD / 128, MT = NTOK / 128;
    for (int t = blockIdx.x; t < NT * MT; t += gridDim.x) {
        const int mt = t / NT, nt = t % NT;
        f32x4 acc[4][4];
        gemm_128x128(XB + (size_t)mt * 128 * 1024, 1024, WT + (size_t)nt * 128 * 1024, 1024, 1024, lds, acc);
        const int col64 = nt * 2 + wn;
        bf16_t* dst; int ld, coff; bool rope = true; float scale = 1.f;
        if (col64 < 8)       { dst = (bf16_t*)(ws + WS_QA); ld = 512; coff = col64 * 64; scale = 0.125f; }
        else if (col64 < 10) { dst = (bf16_t*)(ws + WS_KA); ld = 128; coff = (col64 - 8) * 64; }
        else if (col64 < 12) { dst = (bf16_t*)(ws + WS_VA); ld = 128; coff = (col64 - 10) * 64; rope = false; }
        else if (col64 < 20) { dst = (bf16_t*)(ws + WS_QB); ld = 512; coff = (col64 - 12) * 64; scale = 0.125f; }
        else if (col64 == 20) { dst = (bf16_t*)(ws + WS_KB); ld = 64; coff = 0; }
        else if (col64 == 21) { dst = (bf16_t*)(ws + WS_VB); ld = 64; coff = 0; rope = false; }
        else if (col64 < 26) { dst = (bf16_t*)(ws + WS_QI); ld = 256; coff = (col64 - 22) * 64; }
        else                 { dst = (bf16_t*)(ws + WS_KI); ld = 64; coff = 0; }
        if (col64 == 27) {
            if (g == 0) {
#pragma unroll
                for (int m = 0; m < 4; ++m) { const int tok = mt * 128 + wm * 64 + m * 16 + c; *(f32x4*)((float*)(ws + WS_WI) + (size_t)tok * 4) = acc[m][0] * 0.0625f; }
            }
            continue;
        }
#pragma unroll
        for (int m = 0; m < 4; ++m) {
            const int tok = mt * 128 + wm * 64 + m * 16 + c, pos = tok & (SEQ - 1);
            f32x4 v[4] = {acc[m][0], acc[m][1], acc[m][2], acc[m][3]};
            if (col64 == 26) {
                float s = 0.f;
#pragma unroll
                for (int n = 0; n < 4; ++n) s += (v[n][0] + v[n][1]) + (v[n][2] + v[n][3]);
                s += __shfl_xor(s, 16); s += __shfl_xor(s, 32);
                const float mu = s * (1.f / 64.f); float q = 0.f;
#pragma unroll
                for (int n = 0; n < 4; ++n) { const f32x4 d = v[n] - mu; q += (d[0] * d[0] + d[1] * d[1]) + (d[2] * d[2] + d[3] * d[3]); }
                q += __shfl_xor(q, 16); q += __shfl_xor(q, 32);
                const float rstd = rsqrtf(q * (1.f / 64.f) + LN_EPS);
#pragma unroll
                for (int n = 0; n < 4; ++n) {
                    const f32x4 gg = *(const f32x4*)(p.idx_k_g + 16 * n + 4 * g), bb = *(const f32x4*)(p.idx_k_b + 16 * n + 4 * g);
                    v[n] = (v[n] - mu) * rstd * gg + bb;
                }
            }
            if (rope) {
#pragma unroll
                for (int n = 0; n < 2; ++n) {
                    const f32x4 cs = *(const f32x4*)(cosT + pos * 32 + 16 * n + 4 * g), sn = *(const f32x4*)(sinT + pos * 32 + 16 * n + 4 * g);
                    const f32x4 t1 = v[n], t2 = v[n + 2];
                    v[n] = t1 * cs - t2 * sn; v[n + 2] = t2 * cs + t1 * sn;
                }
            }
#pragma unroll
            for (int n = 0; n < 4; ++n) {
                const f32x4 o = v[n] * scale; u32x2 w; w.x = pack_bf16(o[0], o[1]); w.y = pack_bf16(o[2], o[3]);
                *(u32x2*)(dst + (size_t)tok * ld + coff + 16 * n + 4 * g) = w;
            }
        }
    }
}

constexpr int NDSA = NTOK / 4, NSWA = BATCH * 32 * 8;
constexpr int P2_SC = 0, P2_HIST = 32768, P2_LIST = 49152, P2_ITEM = 51200;

DI unsigned f16_key(float v) {
    _Float16 hv = (_Float16)v; unsigned short hb = __builtin_bit_cast(unsigned short, hv); unsigned b = hb;
    if (b == 0x8000u) b = 0u;
    return (b & 0x8000u) ? ((~b) & 0xffffu) : (b | 0x8000u);
}

template <int MODE> DI void p2_dsa_item(const Params& p, unsigned char* lds, int b, int tb) {
    unsigned char* ws = p.ws;
    const bf16_t* QI = (const bf16_t*)(ws + WS_QI); const bf16_t* KI = (const bf16_t*)(ws + WS_KI); const float* WI = (const float*)(ws + WS_WI);
    const bf16_t* QB = (const bf16_t*)(ws + WS_QB); const bf16_t* KB = (const bf16_t*)(ws + WS_KB); const bf16_t* VB = (const bf16_t*)(ws + WS_VB);
    bf16_t* ATT = (bf16_t*)(ws + WS_ATT);
    int tid = threadIdx.x; asm volatile("" : "+v"(tid));
    const int lane = tid & 63, wave = __builtin_amdgcn_readfirstlane(tid >> 6), c = lane & 15, g = lane >> 4;
    const int t0 = tb * 4, tok0 = b * SEQ + t0;
    unsigned short* sc = (unsigned short*)(lds + P2_SC);
    unsigned* hist = (unsigned*)(lds + P2_HIST) + wave * 1024;
    unsigned short* list = (unsigned short*)(lds + P2_LIST) + wave * 256;
    const int tok = tok0 + wave;
    {
        bf16x8 af[2];
#pragma unroll
        for (int s = 0; s < 2; ++s) af[s] = as_bf16x8(ldg16(QI + (size_t)(tok0 + (c >> 2)) * 256 + (c & 3) * 64 + 32 * s + 8 * g));
        const f32x4 wv = *(const f32x4*)(WI + (size_t)(tok0 + g) * 4);
        const int ntile = (t0 + 4 + 15) >> 4, ntile32 = (ntile + 31) & ~31;
        const bf16_t* kib = KI + (size_t)b * SEQ * 64 + 8 * g;
        for (int kt0 = wave * 8; kt0 < ntile32; kt0 += 32) {
            u32x4 kb[8][2];
#pragma unroll
            for (int u = 0; u < 8; ++u) {
                int kt = kt0 + u; kt = kt < ntile ? kt : ntile - 1;
                const bf16_t* kp = kib + (size_t)(kt * 16 + c) * 64;
                kb[u][0] = ldg16(kp); kb[u][1] = ldg16(kp + 32);
            }
#pragma unroll
            for (int u = 0; u < 8; ++u) {
                f32x4 d = mfma16(af[0], as_bf16x8(kb[u][0]), (f32x4){0.f, 0.f, 0.f, 0.f});
                d = mfma16(af[1], as_bf16x8(kb[u][1]), d);
                const float s = wv[0] * fmaxf(d[0], 0.f) + wv[1] * fmaxf(d[1], 0.f) + wv[2] * fmaxf(d[2], 0.f) + wv[3] * fmaxf(d[3], 0.f);
                const int key = (kt0 + u) * 16 + c;
                sc[g * 4096 + key] = (key <= t0 + g) ? (unsigned short)f16_key(s) : (unsigned short)0;
            }
        }
    }
    __syncthreads();
    if (!(MODE & 2)) return;
    const int n = t0 + wave + 1;
    const int L = n < 256 ? n : 256;
    const unsigned short* myk = sc + wave * 4096;
    if (n <= 256) {
        for (int i = lane; i < n; i += 64) list[i] = (unsigned short)i;
    } else {
        u32x4 kk[8];
#pragma unroll
        for (int i = 0; i < 8; ++i) kk[i] = (512 * i < n) ? *(const u32x4*)(myk + 512 * i + 8 * lane) : (u32x4){0u, 0u, 0u, 0u};
#pragma unroll
        for (int i = 0; i < 4; ++i) *(u32x4*)(hist + lane * 16 + i * 4) = (u32x4){0u, 0u, 0u, 0u};
#pragma unroll
        for (int i = 0; i < 8; ++i) {
            if (512 * i < n) {
#pragma unroll
                for (int w = 0; w < 4; ++w) { const unsigned wd = kk[i][w]; atomicAdd(&hist[(wd & 0xffffu) >> 6], 1u); atomicAdd(&hist[wd >> 22], 1u); }
            }
        }
        unsigned h[16];
#pragma unroll
        for (int i = 0; i < 4; ++i) { const u32x4 t = *(const u32x4*)(hist + lane * 16 + i * 4); h[4 * i] = t.x; h[4 * i + 1] = t.y; h[4 * i + 2] = t.z; h[4 * i + 3] = t.w; }
#pragma unroll
        for (int i = 0; i < 4; ++i) *(u32x4*)(hist + lane * 16 + i * 4) = (u32x4){0u, 0u, 0u, 0u};
        unsigned sl = 0;
#pragma unroll
        for (int i = 0; i < 16; ++i) sl += h[i];
        unsigned pre = sl;
#pragma unroll
        for (int o = 1; o < 64; o <<= 1) { const unsigned t = __shfl_up(pre, o); if (lane >= o) pre += t; }
        const unsigned tot = __shfl(pre, 63);
        const unsigned suf = tot - pre;
        int found = -1; unsigned cab = 0, cum = suf;
#pragma unroll
        for (int j = 15; j >= 0; --j) { const bool hit = (found < 0) && (cum + h[j] >= 256u); if (hit) { found = lane * 16 + j; cab = cum; } cum += h[j]; }
        const bool mine = (suf < 256u) && (suf + sl >= 256u);
        const unsigned long long mm = __ballot(mine);
        const int src = __ffsll((long long)mm) - 1;
        const unsigned bstar = (unsigned)__shfl(found, src), cabove = __shfl(cab, src);
        const unsigned r1 = 256u - cabove;
#pragma unroll
        for (int i = 0; i < 8; ++i) {
            if (512 * i < n) {
#pragma unroll
                for (int w = 0; w < 4; ++w) {
                    const unsigned wd = kk[i][w];
                    if (((wd & 0xffffu) >> 6) == bstar) atomicAdd(&hist[wd & 63u], 1u);
                    if ((wd >> 22) == bstar) atomicAdd(&hist[(wd >> 16) & 63u], 1u);
                }
            }
        }
        const unsigned cnt = hist[lane];
        hist[lane] = 0u;
        unsigned pre2 = cnt;
#pragma unroll
        for (int o = 1; o < 64; o <<= 1) { const unsigned t = __shfl_up(pre2, o); if (lane >= o) pre2 += t; }
        const unsigned tot2 = __shfl(pre2, 63);
        const unsigned suf2 = tot2 - pre2;
        const bool mine2 = (suf2 < r1) && (suf2 + cnt >= r1);
        const unsigned long long mm2 = __ballot(mine2);
        const int src2 = __ffsll((long long)mm2) - 1;
        const unsigned T = (bstar << 6) | (unsigned)src2;
        const unsigned req = r1 - __shfl(suf2, src2);
        const unsigned toteq = __shfl(cnt, src2);
        const bool alleq = (req == toteq);
        const unsigned Tt = alleq ? T : T + 1u;
        unsigned cg = 0;
#pragma unroll
        for (int i = 0; i < 8; ++i)
#pragma unroll
            for (int w = 0; w < 4; ++w) { const unsigned wd = kk[i][w]; cg += ((wd & 0xffffu) >= Tt) ? 1u : 0u; cg += ((wd >> 16) >= Tt) ? 1u : 0u; }
        unsigned pre3 = cg;
#pragma unroll
        for (int o = 1; o < 64; o <<= 1) { const unsigned t = __shfl_up(pre3, o); if (lane >= o) pre3 += t; }
        unsigned off = pre3 - cg;
#pragma unroll
        for (int i = 0; i < 8; ++i)
#pragma unroll
            for (int w = 0; w < 4; ++w) {
                const unsigned wd = kk[i][w]; const int idx = 512 * i + 8 * lane + 2 * w;
                if ((wd & 0xffffu) >= Tt) { list[off & 255u] = (unsigned short)idx; ++off; }
                if ((wd >> 16) >= Tt) { list[off & 255u] = (unsigned short)(idx + 1); ++off; }
            }
        if (!alleq) {
            const unsigned cgt = 256u - req; unsigned eq_run = 0;
            for (int base = 0; base < n; base += 64) {
                const int i = base + lane; const unsigned m = (i < n) ? myk[i] : 0u;
                const bool eq = (m == T);
                const unsigned long long eqm = __ballot(eq);
                const unsigned rank = eq_run + __builtin_amdgcn_mbcnt_hi((unsigned)(eqm >> 32), __builtin_amdgcn_mbcnt_lo((unsigned)eqm, 0u));
                if (eq && rank < req) list[cgt + rank] = (unsigned short)i;
                eq_run += (unsigned)__popcll(eqm);
            }
        }
    }
    if (!(MODE & 4)) return;
    bf16x8 qf[2], sel[2];
#pragma unroll
    for (int s = 0; s < 2; ++s) {
        u32x4 t = (u32x4){0u, 0u, 0u, 0u};
        if (c < 8) t = ldg16(QB + (size_t)tok * 512 + c * 64 + 32 * s + 8 * g);
        qf[s] = as_bf16x8(t);
#pragma unroll
        for (int j = 0; j < 8; ++j) sel[s][j] = (8 * g + j == 16 * s + c) ? (short)0x3F80 : (short)0;
    }
    f32x4 st[16];
    const unsigned char* kbb = (const unsigned char*)(KB + (size_t)b * SEQ * 64); const unsigned char* vbb = (const unsigned char*)(VB + (size_t)b * SEQ * 64);
    auto loadrows = [&](const unsigned char* base, int T0, u32x4 (&dst)[4][2]) {
#pragma unroll
        for (int T = 0; T < 4; ++T) {
            const int idx = (T0 + T) * 16 + c; const unsigned kid = (idx < L) ? (unsigned)list[idx] : 0u;
            const unsigned off = kid * 128u + 16u * g;
            dst[T][0] = ldg16(base + off); dst[T][1] = ldg16(base + off + 64u);
        }
    };
    auto scoreK = [&](int T0, const u32x4 (&src)[4][2]) {
#pragma unroll
        for (int T = 0; T < 4; ++T) {
            f32x4 d = mfma16(as_bf16x8(src[T][0]), qf[0], (f32x4){0.f, 0.f, 0.f, 0.f});
            st[T0 + T] = mfma16(as_bf16x8(src[T][1]), qf[1], d);
        }
    };
    u32x4 bufA[4][2], bufB[4][2];
    loadrows(kbb, 0, bufA); loadrows(kbb, 4, bufB);
    __builtin_amdgcn_sched_barrier(0);
    scoreK(0, bufA); loadrows(kbb, 8, bufA);
    __builtin_amdgcn_sched_barrier(0);
    scoreK(4, bufB); loadrows(kbb, 12, bufB);
    __builtin_amdgcn_sched_barrier(0);
    scoreK(8, bufA); loadrows(vbb, 0, bufA);
    __builtin_amdgcn_sched_barrier(0);
    scoreK(12, bufB); loadrows(vbb, 4, bufB);
    __builtin_amdgcn_sched_barrier(0);
    float mx = -3.0e38f;
    {
        const int lrem = L - 4 * g;
#pragma unroll
        for (int T = 0; T < 16; ++T)
#pragma unroll
            for (int r = 0; r < 4; ++r) { const float sv = (T * 16 + r < lrem) ? st[T][r] : -3.0e38f; st[T][r] = sv; mx = fmaxf(mx, sv); }
    }
    mx = fmaxf(mx, __shfl_xor(mx, 16)); mx = fmaxf(mx, __shfl_xor(mx, 32));
    float lsum = 0.f;
#pragma unroll
    for (int T = 0; T < 16; ++T)
#pragma unroll
        for (int r = 0; r < 4; ++r) { const float e = __expf(st[T][r] - mx); st[T][r] = e; lsum += e; }
    lsum += __shfl_xor(lsum, 16); lsum += __shfl_xor(lsum, 32);
    const float rl = 1.0f / lsum;
    u32x4 pfv[8];
#pragma unroll
    for (int u = 0; u < 8; ++u) {
        const int Ta = 2 * u, Tb = Ta + 1;
        pfv[u].x = pack_bf16(st[Ta][0] * rl, st[Ta][1] * rl); pfv[u].y = pack_bf16(st[Ta][2] * rl, st[Ta][3] * rl);
        pfv[u].z = pack_bf16(st[Tb][0] * rl, st[Tb][1] * rl); pfv[u].w = pack_bf16(st[Tb][2] * rl, st[Tb][3] * rl);
    }
    __builtin_amdgcn_sched_barrier(0);
    f32x4 O[4];
#pragma unroll
    for (int cb = 0; cb < 4; ++cb) O[cb] = (f32x4){0.f, 0.f, 0.f, 0.f};
    auto pv = [&](int T0, const u32x4 (&src)[4][2]) {
#pragma unroll
        for (int u = 0; u < 2; ++u) {
            const u32x4 pf = pfv[(T0 >> 1) + u];
#pragma unroll
            for (int cb = 0; cb < 4; ++cb) {
                const f32x4 z = (f32x4){0.f, 0.f, 0.f, 0.f};
                const f32x4 v0 = mfma16(as_bf16x8(src[2 * u][cb >> 1]), sel[cb & 1], z), v1 = mfma16(as_bf16x8(src[2 * u + 1][cb >> 1]), sel[cb & 1], z);
                u32x4 vf; vf.x = pack_bf16(v0[0], v0[1]); vf.y = pack_bf16(v0[2], v0[3]); vf.z = pack_bf16(v1[0], v1[1]); vf.w = pack_bf16(v1[2], v1[3]);
                O[cb] = mfma16(as_bf16x8(pf), as_bf16x8(vf), O[cb]);
            }
        }
    };
    pv(0, bufA); loadrows(vbb, 8, bufA);
    __builtin_amdgcn_sched_barrier(0);
    pv(4, bufB); loadrows(vbb, 12, bufB);
    __builtin_amdgcn_sched_barrier(0);
    pv(8, bufA);
    pv(12, bufB);
    if (g < 2) {
#pragma unroll
        for (int cb = 0; cb < 4; ++cb)
#pragma unroll
            for (int r = 0; r < 4; ++r) ATT[(size_t)tok * 1024 + 512 + (4 * g + r) * 64 + 16 * cb + c] = (bf16_t)f2bf(O[cb][r]);
    }
}

DI void p2_swa_item(const Params& p, int item2) {
    unsigned char* ws = p.ws;
    const bf16_t* QA = (const bf16_t*)(ws + WS_QA); const bf16_t* KA = (const bf16_t*)(ws + WS_KA); const bf16_t* VA = (const bf16_t*)(ws + WS_VA);
    bf16_t* ATT = (bf16_t*)(ws + WS_ATT);
    int tid = threadIdx.x; asm volatile("" : "+v"(tid));
    const int lane = tid & 63, wave = __builtin_amdgcn_readfirstlane(tid >> 6), r = lane & 31, h = lane >> 5;
    const int hq = item2 & 7, blk = (item2 >> 3) & 31, b = item2 >> 8, kvh = hq >> 2;
    const int qi = 32 * wave + r, tokq = b * SEQ + blk * 128 + qi;
    bf16x8 qf[4], sel[2];
#pragma unroll
    for (int s = 0; s < 4; ++s) qf[s] = as_bf16x8(ldg16(QA + (size_t)tokq * 512 + hq * 64 + 16 * s + 8 * h));
#pragma unroll
    for (int x = 0; x < 2; ++x)
#pragma unroll
        for (int j = 0; j < 8; ++j) sel[x][j] = (8 * h + j + 16 * x == r) ? (short)0x3F80 : (short)0;
    const float sink = p.sinks[hq];
    f32x16 ST[5];
#pragma unroll
    for (int ti = 0; ti < 5; ++ti) {
        const int sj = 32 * (wave + ti) + r; int pos = blk * 128 - 128 + sj; pos = pos < 0 ? 0 : pos;
        const bf16_t* kp = KA + (size_t)(b * SEQ + pos) * 128 + kvh * 64 + 8 * h;
        f32x16 d; for (int i = 0; i < 16; ++i) d[i] = 0.f;
#pragma unroll
        for (int s = 0; s < 4; ++s) d = mfma32(as_bf16x8(ldg16(kp + 16 * s)), qf[s], d);
        ST[ti] = d;
    }
    float mx = sink;
    {
        const int lo = r + 1 - 4 * h;
        const int lo0 = (blk > 0) ? lo : (lo > 128 - 32 * wave - 4 * h ? lo : 128 - 32 * wave - 4 * h);
#pragma unroll
        for (int ti = 0; ti < 5; ++ti)
#pragma unroll
            for (int reg = 0; reg < 16; ++reg) {
                const int e = 32 * ti + (reg & 3) + 8 * (reg >> 2);
                const float sv = (e >= lo0 && e < lo + 128) ? ST[ti][reg] : -3.0e38f; ST[ti][reg] = sv; mx = fmaxf(mx, sv);
            }
    }
    mx = fmaxf(mx, __shfl_xor(mx, 32));
    float lsum = 0.f;
#pragma unroll
    for (int ti = 0; ti < 5; ++ti)
#pragma unroll
        for (int reg = 0; reg < 16; ++reg) { const float e = __expf(ST[ti][reg] - mx); ST[ti][reg] = e; lsum += e; }
    lsum += __shfl_xor(lsum, 32);
    lsum += __expf(sink - mx);
    const float rl = 1.0f / lsum;
    f32x16 OT[2];
    for (int i = 0; i < 16; ++i) { OT[0][i] = 0.f; OT[1][i] = 0.f; }
#pragma unroll
    for (int ti = 0; ti < 5; ++ti) {
        const int sj = 32 * (wave + ti) + r; int pos = blk * 128 - 128 + sj; pos = pos < 0 ? 0 : pos;
        const bf16_t* vp = VA + (size_t)(b * SEQ + pos) * 128 + kvh * 64 + 8 * h;
        bf16x8 vf[4];
#pragma unroll
        for (int s = 0; s < 4; ++s) vf[s] = as_bf16x8(ldg16(vp + 16 * s));
        u32x4 pb[2];
#pragma unroll
        for (int s2 = 0; s2 < 2; ++s2) {
            pb[s2].x = pack_bf16(ST[ti][8 * s2 + 0] * rl, ST[ti][8 * s2 + 1] * rl); pb[s2].y = pack_bf16(ST[ti][8 * s2 + 2] * rl, ST[ti][8 * s2 + 3] * rl);
            pb[s2].z = pack_bf16(ST[ti][8 * s2 + 4] * rl, ST[ti][8 * s2 + 5] * rl); pb[s2].w = pack_bf16(ST[ti][8 * s2 + 6] * rl, ST[ti][8 * s2 + 7] * rl);
        }
#pragma unroll
        for (int db = 0; db < 2; ++db) {
            f32x16 vt; for (int i = 0; i < 16; ++i) vt[i] = 0.f;
            vt = mfma32(vf[2 * db], sel[0], vt); vt = mfma32(vf[2 * db + 1], sel[1], vt);
#pragma unroll
            for (int s2 = 0; s2 < 2; ++s2) {
                u32x4 va; va.x = pack_bf16(vt[8 * s2 + 0], vt[8 * s2 + 1]); va.y = pack_bf16(vt[8 * s2 + 2], vt[8 * s2 + 3]);
                va.z = pack_bf16(vt[8 * s2 + 4], vt[8 * s2 + 5]); va.w = pack_bf16(vt[8 * s2 + 6], vt[8 * s2 + 7]);
                OT[db] = mfma32(as_bf16x8(va), as_bf16x8(pb[s2]), OT[db]);
            }
        }
    }
#pragma unroll
    for (int db = 0; db < 2; ++db)
#pragma unroll
        for (int q4 = 0; q4 < 4; ++q4) {
            u32x2 w; w.x = pack_bf16(OT[db][4 * q4], OT[db][4 * q4 + 1]); w.y = pack_bf16(OT[db][4 * q4 + 2], OT[db][4 * q4 + 3]);
            *(u32x2*)(ATT + (size_t)tokq * 1024 + hq * 64 + 32 * db + 8 * q4 + 4 * h) = w;
        }
}

template <int MODE> DI void p2_attention(const Params& p, unsigned char* lds, int cidx = 0) {
    const int G = gridDim.x, bi = blockIdx.x, rounds = (1024 + G - 1) / G;
    for (int b = 0; b < BATCH; ++b)
        for (int r = 0; r < rounds; ++r) {
            const int idx = (r & 1) ? r * G + (G - 1 - bi) : r * G + bi;
            if (idx < 1024) { __syncthreads(); p2_dsa_item<MODE>(p, lds, b, 1023 - idx); }
        }
    if (MODE & 8) for (int item2 = bi; item2 < NSWA; item2 += G) p2_swa_item(p, item2);
}

DI void p3_outproj(const Params& p, unsigned char* lds) {
    unsigned char* ws = p.ws;
    const bf16_t* ATT = (const bf16_t*)(ws + WS_ATT); const bf16_t* WT = (const bf16_t*)(ws + WS_WOT);
    const int tid = threadIdx.x, lane = tid & 63, wave = tid >> 6, wm = wave >> 1, wn = wave & 1, c = lane & 15, g = lane >> 4;
    constexpr int NT = 8, MT = NTOK / 128;
    for (int t = blockIdx.x; t < NT * MT; t += gridDim.x) {
        const int mt = t / NT, nt = t % NT;
        f32x4 acc[4][4];
        gemm_128x128(ATT + (size_t)mt * 128 * 1024, 1024, WT + (size_t)nt * 128 * 1024, 1024, 1024, lds, acc);
#pragma unroll
        for (int m = 0; m < 4; ++m) {
            const int tok = mt * 128 + wm * 64 + m * 16 + c;
#pragma unroll
            for (int n = 0; n < 4; ++n) {
                const size_t o = (size_t)tok * 1024 + nt * 128 + wn * 64 + 16 * n + 4 * g;
                const f32x4 xv = *(const f32x4*)(p.x + o);
                *(f32x4*)(p.out + o) = xv * ALPHA + acc[m][n];
            }
        }
    }
}

DI void p3b_ln1(const Params& p) {
    bf16_t* H1B = (bf16_t*)(p.ws + WS_XB);
    const int lane = threadIdx.x & 63, gw = blockIdx.x * 4 + (threadIdx.x >> 6), nw = gridDim.x * 4;
    for (int row = gw; row < NTOK; row += nw) {
        f32x4 v[4]; float s = 0.f;
#pragma unroll
        for (int i = 0; i < 4; ++i) { v[i] = *(const f32x4*)(p.out + (size_t)row * 1024 + (lane + 64 * i) * 4); s += (v[i][0] + v[i][1]) + (v[i][2] + v[i][3]); }
        const float mu = wave_sum(s) * (1.f / 1024.f); float q = 0.f;
#pragma unroll
        for (int i = 0; i < 4; ++i) { const f32x4 d = v[i] - mu; q += (d[0] * d[0] + d[1] * d[1]) + (d[2] * d[2] + d[3] * d[3]); }
        const float rstd = rsqrtf(wave_sum(q) * (1.f / 1024.f) + LN_EPS);
#pragma unroll
        for (int i = 0; i < 4; ++i) {
            const int col = (lane + 64 * i) * 4;
            const f32x4 gg = *(const f32x4*)(p.ln1_g + col), bb = *(const f32x4*)(p.ln1_b + col);
            const f32x4 o = (v[i] - mu) * rstd * gg + bb;
            u32x2 w; w.x = pack_bf16(o[0], o[1]); w.y = pack_bf16(o[2], o[3]);
            *(u32x2*)(H1B + (size_t)row * 1024 + col) = w;
        }
    }
}

DI void top16_insert(float (&tv)[16], int (&ti)[16], float v, int i) {
#pragma unroll
    for (int j = 0; j < 16; ++j) { const bool sw = v > tv[j]; const float a = tv[j]; const int b = ti[j]; tv[j] = sw ? v : a; ti[j] = sw ? i : b; v = sw ? a : v; i = sw ? b : i; }
}
constexpr int P4_QS = 32768, P4_ST0V = 66048, P4_ST0I = 66048 + 8704, P4_ST1I = 8704;

DI void p4_peer_query(const Params& p, unsigned char* lds) {
    unsigned char* ws = p.ws;
    const bf16_t* H1B = (const bf16_t*)(ws + WS_XB); const bf16_t* WQT = (const bf16_t*)(ws + WS_WQT); const bf16_t* SK = (const bf16_t*)(ws + WS_SK);
    unsigned short* PE = (unsigned short*)(ws + WS_PE); float* PG = (float*)(ws + WS_PG); float* PS = (float*)(ws + WS_PS);
    const float* SU = (const float*)(ws + WS_SU); const float* SV = (const float*)(ws + WS_SV);
    const int tid = threadIdx.x, lane = tid & 63, wave = tid >> 6, wm = wave >> 1, wn = wave & 1, c = lane & 15, g = lane >> 4;
    const int lrow = tid >> 3, lch = tid & 7;
    float* Ss = (float*)lds;
    float* st0v = (float*)(lds + P4_ST0V); unsigned char* st0i = lds + P4_ST0I; unsigned char* st1i = lds + P4_ST1I;
    constexpr int MT = NTOK / 128;
    for (int t = blockIdx.x; t < MT * 8; t += gridDim.x) {
        const int mt = t >> 3, head = t & 7;
        float tv[16]; int ti[16];
#pragma unroll 1
        for (int ph = 0; ph < 2; ++ph) {
            f32x4 acc[4][4];
            gemm_128x128(H1B + (size_t)mt * 128 * 1024, 1024, WQT + (size_t)(head * 256 + ph * 128) * 1024, 1024, 1024, lds, acc);
            __syncthreads();
#pragma unroll
            for (int m = 0; m < 4; ++m)
#pragma unroll
                for (int n = 0; n < 4; ++n) {
                    const int row = wm * 64 + m * 16 + c;
                    u32x2 w; w.x = pack_bf16(acc[m][n][0], acc[m][n][1]); w.y = pack_bf16(acc[m][n][2], acc[m][n][3]);
                    *(u32x2*)(lds + P4_QS + wn * 16384 + row * 128 + (((2 * n + (g >> 1)) ^ (row & 7)) << 4) + (g & 1) * 8) = w;
                }
            {
                const bf16_t* sp = SK + (size_t)((head * 2 + ph) * 128 + lrow) * 128 + lch * 8;
#pragma unroll
                for (int k2 = 0; k2 < 2; ++k2)
#pragma unroll
                    for (int i = 0; i < 4; ++i) *(u32x4*)(lds + k2 * 16384 + (lrow + 32 * i) * 128 + ((lch ^ (lrow & 7)) << 4)) = ldg16(sp + (size_t)(32 * i) * 128 + k2 * 64);
            }
            __syncthreads();
            f32x4 a2[4][4];
#pragma unroll
            for (int m = 0; m < 4; ++m)
#pragma unroll
                for (int n = 0; n < 4; ++n) a2[m][n] = (f32x4){0.f, 0.f, 0.f, 0.f};
#pragma unroll
            for (int k2 = 0; k2 < 2; ++k2)
#pragma unroll
                for (int s = 0; s < 2; ++s) {
                    bf16x8 xf[4], wf[4];
#pragma unroll
                    for (int m = 0; m < 4; ++m) { const int row = wm * 64 + m * 16 + c; xf[m] = as_bf16x8(*(const u32x4*)(lds + P4_QS + k2 * 16384 + row * 128 + (((4 * s + g) ^ (c & 7)) << 4))); }
#pragma unroll
                    for (int n = 0; n < 4; ++n) { const int row = wn * 64 + n * 16 + c; wf[n] = as_bf16x8(*(const u32x4*)(lds + k2 * 16384 + row * 128 + (((4 * s + g) ^ (c & 7)) << 4))); }
#pragma unroll
                    for (int m = 0; m < 4; ++m)
#pragma unroll
                        for (int n = 0; n < 4; ++n) a2[m][n] = mfma16(wf[n], xf[m], a2[m][n]);
                }
            __syncthreads();
#pragma unroll
            for (int m = 0; m < 4; ++m)
#pragma unroll
                for (int n = 0; n < 4; ++n)
#pragma unroll
                    for (int r = 0; r < 4; ++r) Ss[(wm * 64 + m * 16 + c) * 129 + wn * 64 + 16 * n + 4 * g + r] = a2[m][n][r];
            __syncthreads();
            if (tid < 128) {
#pragma unroll
                for (int j = 0; j < 16; ++j) { tv[j] = -3.0e38f; ti[j] = 0; }
                const float* rowp = Ss + tid * 129;
#pragma unroll 4
                for (int j = 0; j < 128; ++j) { const float v = rowp[j]; if (v > tv[15]) top16_insert(tv, ti, v, j); }
                if (ph == 0) {
#pragma unroll
                    for (int j = 0; j < 16; ++j) { st0v[tid * 17 + j] = tv[j]; st0i[tid * 20 + j] = (unsigned char)ti[j]; }
                }
            }
            __syncthreads();
        }
        if (tid < 128) {
#pragma unroll
            for (int j = 0; j < 16; ++j) st1i[tid * 20 + j] = (unsigned char)ti[j];
            float cv[16]; int ci[16];
#pragma unroll
            for (int j = 0; j < 16; ++j) { cv[j] = -3.0e38f; ci[j] = 0; }
#pragma unroll 1
            for (int a = 0; a < 16; ++a) {
                const float va = st0v[tid * 17 + a];
#pragma unroll
                for (int b = 0; b < 16; ++b) { const float v = va + tv[b]; if (v > cv[15]) top16_insert(cv, ci, v, a * 16 + b); }
            }
            const float cmax = cv[0]; float den = 0.f;
#pragma unroll
            for (int j = 0; j < 16; ++j) { cv[j] = __expf(cv[j] - cmax); den += cv[j]; }
            const float rden = 1.0f / den;
            const size_t ob = (size_t)(mt * 128 + tid) * 128 + head * 16;
#pragma unroll
            for (int j = 0; j < 16; ++j) {
                const int e = (int)st0i[tid * 20 + (ci[j] >> 4)] * 128 + (int)st1i[tid * 20 + (ci[j] & 15)];
                PE[ob + j] = (unsigned short)e; PG[ob + j] = cv[j] * rden * SV[e]; PS[ob + j] = SU[e];
            }
        }
        __syncthreads();
    }
}

DI float gelu_exact(float z) { return 0.5f * z * (1.0f + erff(z * 0.70710678118654752f)); }
DI float rdlane(float v, int l) { return __int_as_float(__builtin_amdgcn_readlane(__float_as_int(v), l)); }

typedef float f32x2 __attribute__((ext_vector_type(2)));
DI void p5_gather(const Params& p) {
    unsigned char* ws = p.ws;
    const bf16_t* H1B = (const bf16_t*)(ws + WS_XB); const unsigned char* UT = ws + WS_UT; const unsigned char* VT = ws + WS_VT;
    const unsigned short* PE = (const unsigned short*)(ws + WS_PE); const float* PG = (const float*)(ws + WS_PG); const float* PS = (const float*)(ws + WS_PS);
    const int lane = threadIdx.x & 63, gw = blockIdx.x * 4 + (threadIdx.x >> 6), nw = gridDim.x * 4;
    const bool b5 = (lane & 32) != 0, b4 = (lane & 16) != 0, b3 = (lane & 8) != 0, b2 = (lane & 4) != 0;
    for (int tok = gw; tok < NTOK; tok += nw) {
        float x[16], acc[16];
        {
            const u32x4 xa = ldg16(H1B + (size_t)tok * 1024 + lane * 16), xb = ldg16(H1B + (size_t)tok * 1024 + lane * 16 + 8);
            x[0] = bf_lo(xa.x); x[1] = bf_hi(xa.x); x[2] = bf_lo(xa.y); x[3] = bf_hi(xa.y); x[4] = bf_lo(xa.z); x[5] = bf_hi(xa.z); x[6] = bf_lo(xa.w); x[7] = bf_hi(xa.w);
            x[8] = bf_lo(xb.x); x[9] = bf_hi(xb.x); x[10] = bf_lo(xb.y); x[11] = bf_hi(xb.y); x[12] = bf_lo(xb.z); x[13] = bf_hi(xb.z); x[14] = bf_lo(xb.w); x[15] = bf_hi(xb.w);
        }
#pragma unroll
        for (int i = 0; i < 16; ++i) acc[i] = 0.f;
        const int pe_lo = (int)PE[(size_t)tok * 128 + lane], pe_hi = (int)PE[(size_t)tok * 128 + 64 + lane];
        const float pg_lo = PG[(size_t)tok * 128 + lane], pg_hi = PG[(size_t)tok * 128 + 64 + lane];
        const float ps_lo = PS[(size_t)tok * 128 + lane], ps_hi = PS[(size_t)tok * 128 + 64 + lane];
#pragma unroll 1
        for (int hd = 0; hd < 8; ++hd) {
            const int pes = hd < 4 ? pe_lo : pe_hi; const float pgs = hd < 4 ? pg_lo : pg_hi, pss = hd < 4 ? ps_lo : ps_hi;
            const int lb = (hd & 3) * 16;
            float d[16];
#pragma unroll
            for (int j = 0; j < 16; ++j) {
                const int e = __builtin_amdgcn_readlane(pes, lb + j);
                const u32x4 uw = ldg16(UT + (size_t)e * 1024 + lane * 16);
                float s = 0.f;
#pragma unroll
                for (int k = 0; k < 4; ++k) {
                    const f32x2 f0 = __builtin_amdgcn_cvt_pk_f32_fp8((int)uw[k], false), f1 = __builtin_amdgcn_cvt_pk_f32_fp8((int)uw[k], true);
                    s = fmaf(x[4 * k], f0.x, s); s = fmaf(x[4 * k + 1], f0.y, s); s = fmaf(x[4 * k + 2], f1.x, s); s = fmaf(x[4 * k + 3], f1.y, s);
                }
                d[j] = s;
            }
            float r8[8], r4[4], r2[2], r1;
#pragma unroll
            for (int j = 0; j < 8; ++j) { const float keep = b5 ? d[j + 8] : d[j], send = b5 ? d[j] : d[j + 8]; r8[j] = keep + __shfl_xor(send, 32); }
#pragma unroll
            for (int j = 0; j < 4; ++j) { const float keep = b4 ? r8[j + 4] : r8[j], send = b4 ? r8[j] : r8[j + 4]; r4[j] = keep + __shfl_xor(send, 16); }
#pragma unroll
            for (int j = 0; j < 2; ++j) { const float keep = b3 ? r4[j + 2] : r4[j], send = b3 ? r4[j] : r4[j + 2]; r2[j] = keep + __shfl_xor(send, 8); }
            { const float keep = b2 ? r2[1] : r2[0], send = b2 ? r2[0] : r2[1]; r1 = keep + __shfl_xor(send, 4); }
            r1 += __shfl_xor(r1, 2); r1 += __shfl_xor(r1, 1);
            const int mine = lb + ((lane >> 2) & 15);
            const float coef = gelu_exact(r1 * __shfl(pss, mine)) * __shfl(pgs, mine);
#pragma unroll
            for (int j = 0; j < 16; ++j) {
                const int e = __builtin_amdgcn_readlane(pes, lb + j);
                const float cj = rdlane(coef, 4 * j);
                const u32x4 vw = ldg16(VT + (size_t)e * 1024 + lane * 16);
#pragma unroll
                for (int k = 0; k < 4; ++k) {
                    const f32x2 f0 = __builtin_amdgcn_cvt_pk_f32_fp8((int)vw[k], false), f1 = __builtin_amdgcn_cvt_pk_f32_fp8((int)vw[k], true);
                    acc[4 * k] = fmaf(cj, f0.x, acc[4 * k]); acc[4 * k + 1] = fmaf(cj, f0.y, acc[4 * k + 1]); acc[4 * k + 2] = fmaf(cj, f1.x, acc[4 * k + 2]); acc[4 * k + 3] = fmaf(cj, f1.y, acc[4 * k + 3]);
                }
            }
        }
        float s = 0.f;
#pragma unroll
        for (int i = 0; i < 16; ++i) { acc[i] = fmaf(ALPHA, x[i], acc[i]); s += acc[i]; }
        const float mu = wave_sum(s) * (1.f / 1024.f); float q = 0.f;
#pragma unroll
        for (int i = 0; i < 16; ++i) { const float dd = acc[i] - mu; q = fmaf(dd, dd, q); }
        const float rstd = rsqrtf(wave_sum(q) * (1.f / 1024.f) + LN_EPS);
#pragma unroll
        for (int k4 = 0; k4 < 4; ++k4) {
            const int col = lane * 16 + k4 * 4;
            const f32x4 gg = *(const f32x4*)(p.ln2_g + col), bb = *(const f32x4*)(p.ln2_b + col);
            f32x4 o;
#pragma unroll
            for (int e = 0; e < 4; ++e) o[e] = (acc[k4 * 4 + e] - mu) * rstd * gg[e] + bb[e];
            *(f32x4*)(p.out + (size_t)tok * 1024 + col) = o;
        }
    }
}

#define XB_TMO      128
#define XB_XCNT(j)  (256  + 64 * (j))
#define XB_XSUB(j)  (1280 + 64 * (j))
#define XB_XGEN(j)  (2304 + 64 * (j))
#define XB_TOP      3328
#define XB_TOPGEN   3392
#define XCD_BAR_WORDS 3456
#define XB_SPIN_CAP (1u << 22)
#define LAS __attribute__((address_space(3)))
DI unsigned xb_ld(unsigned* p)              { return __hip_atomic_load(p, __ATOMIC_RELAXED, __HIP_MEMORY_SCOPE_AGENT); }
DI unsigned xb_add(unsigned* p, unsigned v) { return __hip_atomic_fetch_add(p, v, __ATOMIC_RELAXED, __HIP_MEMORY_SCOPE_AGENT); }
DI unsigned xb_xcc_id() { return (unsigned)__builtin_amdgcn_s_getreg((3 << 11) | 20) & 0xFu; }
#define XB_SPIN(cond, bar) do { unsigned _sp = 0; while (cond) { __builtin_amdgcn_s_sleep(1); \
    if ((++_sp & 255u) == 0u) { if (xb_ld(&(bar)[XB_TMO])) break; if (_sp > XB_SPIN_CAP) { atomicAdd(&(bar)[XB_TMO], 1u); break; } } } } while (0)
struct XcdBarrier { unsigned* bar; unsigned x; volatile LAS unsigned* st; };
DI XcdBarrier xcd_barrier_post(unsigned* bar, volatile LAS unsigned* st) {
    XcdBarrier b; b.bar = bar; b.x = xb_xcc_id(); b.st = st;
    if (threadIdx.x == 0) (void)xb_add(&bar[XB_XCNT(b.x)], 1u);
    return b;
}
DI void xcd_barrier_complete(unsigned* bar, unsigned x, unsigned& nloc, unsigned& nx) {
    const unsigned G = gridDim.x * gridDim.y * gridDim.z;
    unsigned sum, cnt, mine, sp = 0u;
    for (;;) {
        sum = 0u; cnt = 0u; mine = 0u;
#pragma unroll
        for (unsigned j = 0; j < 16; ++j) { const unsigned c = xb_ld(&bar[XB_XCNT(j)]); sum += c; cnt += (c > 0u) ? 1u : 0u; mine = (j == x) ? c : mine; }
        if (sum == G) break;
        __builtin_amdgcn_s_sleep(1);
        if ((++sp & 255u) == 0u) { if (xb_ld(&bar[XB_TMO])) break; if (sp > XB_SPIN_CAP) { atomicAdd(&bar[XB_TMO], 1u); break; } }
    }
    nloc = mine > 0u ? mine : 1u; nx = cnt > 0u ? cnt : 1u;
}
DI void xcd_barrier(const XcdBarrier& b) {
    asm volatile("s_waitcnt vmcnt(0)" ::: "memory");
    __syncthreads();
    if (threadIdx.x == 0) {
        unsigned* bar = b.bar;
        __builtin_amdgcn_s_waitcnt(0);
        unsigned nloc = b.st[0], nx = b.st[1];
        if (nloc == 0u) { xcd_barrier_complete(bar, b.x, nloc, nx); b.st[0] = nloc; b.st[1] = nx; }
        const unsigned old = xb_add(&bar[XB_XSUB(b.x)], 1u);
        const unsigned gen = old / nloc;
        if (old + 1u == (gen + 1u) * nloc) {
            __builtin_amdgcn_fence(__ATOMIC_RELEASE, "agent");
            asm volatile("s_waitcnt vmcnt(0)" ::: "memory");
            const unsigned og = xb_add(&bar[XB_TOP], 1u);
            const unsigned tg = og / nx;
            if (og + 1u == (tg + 1u) * nx) xb_add(&bar[XB_TOPGEN], 1u);
            else XB_SPIN(xb_ld(&bar[XB_TOPGEN]) == tg, bar);
            __builtin_amdgcn_fence(__ATOMIC_ACQUIRE, "agent");
            xb_add(&bar[XB_XGEN(b.x)], 1u);
            asm volatile("s_waitcnt vmcnt(0)" ::: "memory");
        } else {
            XB_SPIN(xb_ld(&bar[XB_XGEN(b.x)]) == gen, bar);
            __builtin_amdgcn_fence(__ATOMIC_ACQUIRE, "agent");
            asm volatile("s_waitcnt vmcnt(0)" ::: "memory");
        }
    }
    __syncthreads();
}

constexpr int NPHASE = 7;
__global__ void __launch_bounds__(NTHREADS, 2) mega_fwd(Params p) {
    extern __shared__ __attribute__((aligned(16))) unsigned char lds[];
    cg::grid_group grid = cg::this_grid();
    const int lo = p.ph_lo, hi = p.ph_hi;
    volatile LAS unsigned* xbst = (volatile LAS unsigned*)(LAS unsigned char*)(lds + LDS_BYTES - 16);
#ifndef REP_MASK
#define REP_MASK 0
#endif
#ifndef P2_PROBE_MODE
#define P2_PROBE_MODE 15
#endif
#ifndef PH_MASK
#define PH_MASK 127
#endif
    if (threadIdx.x == 0) { xbst[0] = 0u; xbst[1] = 0u; }
    p0_prep(p, lds);
    grid.sync();
    XcdBarrier xb = xcd_barrier_post((unsigned*)(p.ws + WS_BAR), xbst);
#define GSYNC() xcd_barrier(xb)
#define RUN_PHASE(k, call) { call; if ((REP_MASK >> (k)) & 1) { GSYNC(); call; } }
#if PH_MASK & 2
    RUN_PHASE(1, p1_inproj(p, lds))
#endif
    GSYNC();
#if PH_MASK & 4
#if (REP_MASK >> 2) & 1
    p2_attention<P2_PROBE_MODE>(p, lds, 1); GSYNC();
#endif
    p2_attention<15>(p, lds, 0);
#endif
    GSYNC();
#if PH_MASK & 8
    RUN_PHASE(3, p3_outproj(p, lds))
#endif
    GSYNC();
#if PH_MASK & 16
    RUN_PHASE(4, p3b_ln1(p))
#endif
    GSYNC();
#if PH_MASK & 32
    RUN_PHASE(5, p4_peer_query(p, lds))
#endif
    GSYNC();
#if PH_MASK & 64
    RUN_PHASE(6, p5_gather(p))
#endif
}

#ifndef MK_N_LAUNCHES
#define MK_N_LAUNCHES 1
#endif

extern "C" void kernel_launch(void* const* d_in, const int* in_sizes, int n_in, void* d_out, int out_size, void* d_ws, size_t ws_size, hipStream_t stream) {
    static int grid_blocks = 0;
    if (grid_blocks == 0) {
        if (n_in != 14 || out_size != NTOK * D_MODEL || ws_size < WS_END) {
            fprintf(stderr, "kernel_launch: unexpected problem (n_in %d, out %d, ws %zu, need %zu)\n", n_in, out_size, ws_size, (size_t)WS_END); grid_blocks = -1; return;
        }
        int dev = 0, cus = 0, per_cu = 0;
        hipGetDevice(&dev);
        hipDeviceGetAttribute(&cus, hipDeviceAttributeMultiprocessorCount, dev);
        if (hipFuncSetAttribute((const void*)mega_fwd, hipFuncAttributeMaxDynamicSharedMemorySize, LDS_BYTES) != hipSuccess) { fprintf(stderr, "kernel_launch: hipFuncSetAttribute failed\n"); }
        if (hipOccupancyMaxActiveBlocksPerMultiprocessor(&per_cu, (const void*)mega_fwd, NTHREADS, LDS_BYTES) != hipSuccess || per_cu < 1) { fprintf(stderr, "kernel_launch: occupancy query failed\n"); per_cu = 1; }
        if (per_cu > 2) per_cu = 2;
        (void)hipGetLastError();
        grid_blocks = cus * per_cu;
        fprintf(stderr, "kernel_launch: %d CUs x %d blocks\n", cus, per_cu);
    }
    if (grid_blocks < 0) return;
    Params p{};
    p.x = (const float*)d_in[0]; p.w_in = (const float*)d_in[1]; p.idx_k_g = (const float*)d_in[2]; p.idx_k_b = (const float*)d_in[3]; p.sinks = (const float*)d_in[4];
    p.w_o = (const float*)d_in[5]; p.ln1_g = (const float*)d_in[6]; p.ln1_b = (const float*)d_in[7]; p.peer_wq = (const float*)d_in[8]; p.peer_subkeys = (const float*)d_in[9];
    p.peer_u = (const float*)d_in[10]; p.peer_v = (const float*)d_in[11]; p.ln2_g = (const float*)d_in[12]; p.ln2_b = (const float*)d_in[13];
    p.out = (float*)d_out; p.ws = (unsigned char*)d_ws;
    p.ph_lo = 0; p.ph_hi = NPHASE;
    void* args[] = {&p};
    hipError_t e = hipLaunchCooperativeKernel((const void*)mega_fwd, dim3(grid_blocks), dim3(NTHREADS), args, LDS_BYTES, stream);
    if (e != hipSuccess) fprintf(stderr, "cooperative launch failed: %s (grid %d)\n", hipGetErrorString(e), grid_blocks);
}
```

```cpp
#include <hip/hip_runtime.h>
#include <hip/hip_cooperative_groups.h>
#include <cstdio>
#include <cstdint>
namespace cg = cooperative_groups;

typedef unsigned short bf16_t;
typedef short bf16x8 __attribute__((ext_vector_type(8)));
typedef float f32x4 __attribute__((ext_vector_type(4)));
typedef float f32x16 __attribute__((ext_vector_type(16)));
typedef unsigned u32x4 __attribute__((ext_vector_type(4)));
typedef unsigned u32x2 __attribute__((ext_vector_type(2)));
#define DI __device__ __forceinline__

constexpr int D_MODEL = 1024, BATCH = 8, SEQ = 4096, NTOK = BATCH * SEQ;
constexpr int NMIX = 1732, NMIX_PAD = 1792;
constexpr int PEER_N = 2048;
constexpr float ALPHA = 1.189207115002721f;
constexpr float LN_EPS = 1e-5f;
constexpr int NTHREADS = 256;
constexpr int LDS_BYTES = 77824;

constexpr size_t MB = 1024 * 1024;
constexpr size_t WS_CTL   = 0;
constexpr size_t WS_BAR   = 65536;
constexpr size_t WS_ROPE  = 1 * MB;
constexpr size_t WS_WINT  = 2 * MB;
constexpr size_t WS_WOT   = 6 * MB;
constexpr size_t WS_WQT   = 8 * MB;
constexpr size_t WS_SK    = 12 * MB;
constexpr size_t WS_UT    = 13 * MB;
constexpr size_t WS_VT    = 29 * MB;
constexpr size_t WS_SU    = 45 * MB;
constexpr size_t WS_SV    = 46 * MB;
constexpr size_t WS_XB    = 77 * MB;
constexpr size_t WS_QA    = 141 * MB;
constexpr size_t WS_KA    = 173 * MB;
constexpr size_t WS_VA    = 181 * MB;
constexpr size_t WS_QB    = 189 * MB;
constexpr size_t WS_KB    = 221 * MB;
constexpr size_t WS_VB    = 225 * MB;
constexpr size_t WS_QI    = 229 * MB;
constexpr size_t WS_KI    = 245 * MB;
constexpr size_t WS_WI    = 249 * MB;
constexpr size_t WS_ATT   = 250 * MB;
constexpr size_t WS_PE    = 314 * MB;
constexpr size_t WS_PG    = 322 * MB;
constexpr size_t WS_PS    = 338 * MB;
constexpr size_t WS_END   = 354 * MB;

struct Params {
    const float* x; const float* w_in; const float* idx_k_g; const float* idx_k_b; const float* sinks; const float* w_o;
    const float* ln1_g; const float* ln1_b; const float* peer_wq; const float* peer_subkeys; const float* peer_u; const float* peer_v;
    const float* ln2_g; const float* ln2_b;
    float* out; unsigned char* ws;
    int ph_lo, ph_hi;
};

DI unsigned f2bf(float x) { unsigned u = __float_as_uint(x); u += 0x7fffu + ((u >> 16) & 1u); return u >> 16; }
DI unsigned pack_bf16(float lo, float hi) { return f2bf(lo) | (f2bf(hi) << 16); }
DI float bf_lo(unsigned w) { return __uint_as_float(w << 16); }
DI float bf_hi(unsigned w) { return __uint_as_float(w & 0xffff0000u); }
DI bf16x8 as_bf16x8(u32x4 v) { return __builtin_bit_cast(bf16x8, v); }
DI u32x4 ldg16(const void* p) { return *(const u32x4*)p; }
DI f32x4 mfma16(bf16x8 a, bf16x8 b, f32x4 c) { return __builtin_amdgcn_mfma_f32_16x16x32_bf16(a, b, c, 0, 0, 0); }
DI f32x16 mfma32(bf16x8 a, bf16x8 b, f32x16 c) { return __builtin_amdgcn_mfma_f32_32x32x16_bf16(a, b, c, 0, 0, 0); }
DI float wave_sum(float v) {
#pragma unroll
    for (int o = 32; o >= 1; o >>= 1) v += __shfl_xor(v, o);
    return v;
}

DI void gemm_128x128(const bf16_t* __restrict__ X, int ldx, const bf16_t* __restrict__ Wt, int ldw, int K, unsigned char* lds, f32x4 (&acc)[4][4]) {
    const int tid = threadIdx.x, lane = tid & 63, wave = tid >> 6, wm = wave >> 1, wn = wave & 1, c = lane & 15, g = lane >> 4;
    unsigned char* Xs = lds; unsigned char* Ws = lds + 16384;
    const int lrow = tid >> 3, lch = tid & 7;
    const bf16_t* xp = X + (size_t)lrow * ldx + lch * 8;
    const bf16_t* wp = Wt + (size_t)lrow * ldw + lch * 8;
    const int st_off = lrow * 128 + ((lch ^ (lrow & 7)) << 4);
    u32x4 xr[4], wr[4];
#pragma unroll
    for (int i = 0; i < 4; ++i) { xr[i] = ldg16(xp + (size_t)(32 * i) * ldx); wr[i] = ldg16(wp + (size_t)(32 * i) * ldw); }
#pragma unroll
    for (int m = 0; m < 4; ++m)
#pragma unroll
        for (int n = 0; n < 4; ++n) acc[m][n] = (f32x4){0.f, 0.f, 0.f, 0.f};
    const int nk = K / 64;
    for (int kt = 0; kt < nk; ++kt) {
        __syncthreads();
#pragma unroll
        for (int i = 0; i < 4; ++i) { *(u32x4*)(Xs + st_off + i * 4096) = xr[i]; *(u32x4*)(Ws + st_off + i * 4096) = wr[i]; }
        __syncthreads();
        if (kt + 1 < nk) {
#pragma unroll
            for (int i = 0; i < 4; ++i) { xr[i] = ldg16(xp + (size_t)(32 * i) * ldx + (kt + 1) * 64); wr[i] = ldg16(wp + (size_t)(32 * i) * ldw + (kt + 1) * 64); }
        }
#pragma unroll
        for (int s = 0; s < 2; ++s) {
            bf16x8 xf[4], wf[4];
#pragma unroll
            for (int m = 0; m < 4; ++m) { const int row = wm * 64 + m * 16 + c; xf[m] = as_bf16x8(*(const u32x4*)(Xs + row * 128 + (((4 * s + g) ^ (c & 7)) << 4))); }
#pragma unroll
            for (int n = 0; n < 4; ++n) { const int row = wn * 64 + n * 16 + c; wf[n] = as_bf16x8(*(const u32x4*)(Ws + row * 128 + (((4 * s + g) ^ (c & 7)) << 4))); }
#pragma unroll
            for (int m = 0; m < 4; ++m)
#pragma unroll
                for (int n = 0; n < 4; ++n) acc[m][n] = mfma16(wf[n], xf[m], acc[m][n]);
        }
    }
}

DI void p0_prep(const Params& p, unsigned char* lds) {
    const int tid = threadIdx.x, nb = gridDim.x, bid = blockIdx.x;
    const size_t gtid = (size_t)bid * NTHREADS + tid, gsz = (size_t)nb * NTHREADS;
    unsigned char* ws = p.ws;
    if (bid == 0) { for (int i = tid; i < 64; i += NTHREADS) ((unsigned*)(ws + WS_CTL))[i] = 0u; for (int i = tid; i < 3456; i += NTHREADS) ((unsigned*)(ws + WS_BAR))[i] = 0u; }
    {
        float* ct = (float*)(ws + WS_ROPE); float* stb = ct + SEQ * 32;
        for (size_t i = gtid; i < (size_t)SEQ * 32; i += gsz) {
            const int pos = (int)(i >> 5), fi = (int)(i & 31);
            const float inv = powf(10000.0f, -(float)(2 * fi) / 64.0f);
            const float ang = (float)pos * inv;
            ct[i] = cosf(ang); stb[i] = sinf(ang);
        }
    }
    auto conv = [&](const float* src, bf16_t* dst, size_t n) {
        for (size_t i = gtid * 8; i < n; i += gsz * 8) {
            const f32x4 a = *(const f32x4*)(src + i), b = *(const f32x4*)(src + i + 4);
            u32x4 o; o.x = pack_bf16(a.x, a.y); o.y = pack_bf16(a.z, a.w); o.z = pack_bf16(b.x, b.y); o.w = pack_bf16(b.z, b.w);
            *(u32x4*)(dst + i) = o;
        }
    };
    conv(p.x, (bf16_t*)(ws + WS_XB), (size_t)NTOK * D_MODEL);
    {
        const int lane = tid & 63, gw = bid * 4 + (tid >> 6), nw = nb * 4;
        for (int row = gw; row < 2 * 16384; row += nw) {
            const bool isv = row >= 16384; const int e = isv ? row - 16384 : row;
            const float* src = (isv ? p.peer_v : p.peer_u) + (size_t)e * 1024 + lane * 16;
            f32x4 v[4]; float mx = 0.f;
#pragma unroll
            for (int i = 0; i < 4; ++i) { v[i] = *(const f32x4*)(src + 4 * i); mx = fmaxf(mx, fmaxf(fmaxf(fabsf(v[i][0]), fabsf(v[i][1])), fmaxf(fabsf(v[i][2]), fabsf(v[i][3])))); }
#pragma unroll
            for (int o = 32; o >= 1; o >>= 1) mx = fmaxf(mx, __shfl_xor(mx, o));
            const float sc = mx > 0.f ? mx * (1.0f / 440.0f) : 1.0f, inv = mx > 0.f ? 440.0f / mx : 1.0f;
            u32x4 o4;
#pragma unroll
            for (int i = 0; i < 4; ++i) {
                int w = 0;
                w = __builtin_amdgcn_cvt_pk_fp8_f32(v[i][0] * inv, v[i][1] * inv, w, false);
                w = __builtin_amdgcn_cvt_pk_fp8_f32(v[i][2] * inv, v[i][3] * inv, w, true);
                o4[i] = (unsigned)w;
            }
            *(u32x4*)(ws + (isv ? WS_VT : WS_UT) + (size_t)e * 1024 + lane * 16) = o4;
            if (lane == 0) ((float*)(ws + (isv ? WS_SV : WS_SU)))[e] = sc;
        }
    }
    conv(p.peer_subkeys, (bf16_t*)(ws + WS_SK), (size_t)8 * 2 * 128 * 128);
    float* tl = (float*)lds;
    auto transp = [&](const float* src, bf16_t* dst, int N, int Npad) {
        const int tn = Npad / 64, tk = 1024 / 64;
        for (int t = bid; t < tn * tk; t += nb) {
            const int n0 = (t % tn) * 64, k0 = (t / tn) * 64;
            __syncthreads();
            for (int e = tid; e < 4096; e += NTHREADS) { const int kk = e >> 6, nn = e & 63; tl[kk * 65 + nn] = (n0 + nn < N) ? src[(size_t)(k0 + kk) * N + n0 + nn] : 0.f; }
            __syncthreads();
            for (int e = tid; e < 4096; e += NTHREADS) { const int nn = e >> 6, kk = e & 63; dst[(size_t)(n0 + nn) * 1024 + k0 + kk] = (bf16_t)f2bf(tl[kk * 65 + nn]); }
        }
    };
    transp(p.w_in, (bf16_t*)(ws + WS_WINT), NMIX, NMIX_PAD);
    transp(p.w_o, (bf16_t*)(ws + WS_WOT), 1024, 1024);
    transp(p.peer_wq, (bf16_t*)(ws + WS_WQT), PEER_N, PEER_N);
}

DI void p1_inproj(const Params& p, unsigned char* lds) {
    unsigned char* ws = p.ws;
    const bf16_t* XB = (const bf16_t*)(ws + WS_XB); const bf16_t* WT = (const bf16_t*)(ws + WS_WINT);
    const float* cosT = (const float*)(ws + WS_ROPE); const float* sinT = cosT + SEQ * 32;
    const int tid = threadIdx.x, lane = tid & 63, wave = tid >> 6, wm = wave >> 1, wn = wave & 1, c = lane & 15, g = lane >> 4;
    constexpr int NT = NMIX_PAD / 128, MT = NTOK / 128;
    for (int t = blockIdx.x; t < NT * MT; t += gridDim.x) {
        const int mt = t / NT, nt = t % NT;
        f32x4 acc[4][4];
        gemm_128x128(XB + (size_t)mt * 128 * 1024, 1024, WT + (size_t)nt * 128 * 1024, 1024, 1024, lds, acc);
        const int col64 = nt * 2 + wn;
        bf16_t* dst; int ld, coff; bool rope = true; float scale = 1.f;
        if (col64 < 8)       { dst = (bf16_t*)(ws + WS_QA); ld = 512; coff = col64 * 64; scale = 0.125f; }
        else if (col64 < 10) { dst = (bf16_t*)(ws + WS_KA); ld = 128; coff = (col64 - 8) * 64; }
        else if (col64 < 12) { dst = (bf16_t*)(ws + WS_VA); ld = 128; coff = (col64 - 10) * 64; rope = false; }
        else if (col64 < 20) { dst = (bf16_t*)(ws + WS_QB); ld = 512; coff = (col64 - 12) * 64; scale = 0.125f; }
        else if (col64 == 20) { dst = (bf16_t*)(ws + WS_KB); ld = 64; coff = 0; }
        else if (col64 == 21) { dst = (bf16_t*)(ws + WS_VB); ld = 64; coff = 0; rope = false; }
        else if (col64 < 26) { dst = (bf16_t*)(ws + WS_QI); ld = 256; coff = (col64 - 22) * 64; }
        else                 { dst = (bf16_t*)(ws + WS_KI); ld = 64; coff = 0; }
        if (col64 == 27) {
            if (g == 0) {
#pragma unroll
                for (int m = 0; m < 4; ++m) { const int tok = mt * 128 + wm * 64 + m * 16 + c; *(f32x4*)((float*)(ws + WS_WI) + (size_t)tok * 4) = acc[m][0] * 0.0625f; }
            }
            continue;
        }
#pragma unroll
        for (int m = 0; m < 4; ++m) {
            const int tok = mt * 128 + wm * 64 + m * 16 + c, pos = tok & (SEQ - 1);
            f32x4 v[4] = {acc[m][0], acc[m][1], acc[m][2], acc[m][3]};
            if (col64 == 26) {
                float s = 0.f;
#pragma unroll
                for (int n = 0; n < 4; ++n) s += (v[n][0] + v[n][1]) + (v[n][2] + v[n][3]);
                s += __shfl_xor(s, 16); s += __shfl_xor(s, 32);
                const float mu = s * (1.f / 64.f); float q = 0.f;
#pragma unroll
                for (int n = 0; n < 4; ++n) { const f32x4 d = v[n] - mu; q += (d[0] * d[0] + d[1] * d[1]) + (d[2] * d[2] + d[3] * d[3]); }
                q += __shfl_xor(q, 16); q += __shfl_xor(q, 32);
                const float rstd = rsqrtf(q * (1.f / 64.f) + LN_EPS);
#pragma unroll
                for (int n = 0; n < 4; ++n) {
                    const f32x4 gg = *(const f32x4*)(p.idx_k_g + 16 * n + 4 * g), bb = *(const f32x4*)(p.idx_k_b + 16 * n + 4 * g);
                    v[n] = (v[n] - mu) * rstd * gg + bb;
                }
            }
            if (rope) {
#pragma unroll
                for (int n = 0; n < 2; ++n) {
                    const f32x4 cs = *(const f32x4*)(cosT + pos * 32 + 16 * n + 4 * g), sn = *(const f32x4*)(sinT + pos * 32 + 16 * n + 4 * g);
                    const f32x4 t1 = v[n], t2 = v[n + 2];
                    v[n] = t1 * cs - t2 * sn; v[n + 2] = t2 * cs + t1 * sn;
                }
            }
#pragma unroll
            for (int n = 0; n < 4; ++n) {
                const f32x4 o = v[n] * scale; u32x2 w; w.x = pack_bf16(o[0], o[1]); w.y = pack_bf16(o[2], o[3]);
                *(u32x2*)(dst + (size_t)tok * ld + coff + 16 * n + 4 * g) = w;
            }
        }
    }
}

constexpr int NDSA = NTOK / 4, NSWA = BATCH * 32 * 8;
constexpr int P2_SC = 0, P2_STG = 32768  , P2_LIST = 65536;

DI unsigned f16_key(float v) {
    _Float16 hv = (_Float16)v; unsigned short hb = __builtin_bit_cast(unsigned short, hv); unsigned b = hb;
    if (b == 0x8000u) b = 0u;
    return (b & 0x8000u) ? ((~b) & 0xffffu) : (b | 0x8000u);
}

template <int MODE> DI void p2_dsa_item(const Params& p, unsigned char* lds, int b, int tb) {
    unsigned char* ws = p.ws;
    const bf16_t* QI = (const bf16_t*)(ws + WS_QI); const bf16_t* KI = (const bf16_t*)(ws + WS_KI); const float* WI = (const float*)(ws + WS_WI);
    const bf16_t* QB = (const bf16_t*)(ws + WS_QB); const bf16_t* KB = (const bf16_t*)(ws + WS_KB); const bf16_t* VB = (const bf16_t*)(ws + WS_VB);
    bf16_t* ATT = (bf16_t*)(ws + WS_ATT);
    int tid = threadIdx.x; asm volatile("" : "+v"(tid));
    const int lane = tid & 63, wave = __builtin_amdgcn_readfirstlane(tid >> 6), c = lane & 15, g = lane >> 4;
    const int t0 = tb * 4, tok0 = b * SEQ + t0;
    unsigned short* sc = (unsigned short*)(lds + P2_SC);
    unsigned char* stg = lds + P2_STG + wave * 8192;
    unsigned* hist = (unsigned*)stg;
    unsigned short* list = (unsigned short*)(lds + P2_LIST) + wave * 256;
    const int tok = tok0 + wave;
    {
        bf16x8 af[2];
#pragma unroll
        for (int s = 0; s < 2; ++s) af[s] = as_bf16x8(ldg16(QI + (size_t)(tok0 + (c >> 2)) * 256 + (c & 3) * 64 + 32 * s + 8 * g));
        const f32x4 wv = *(const f32x4*)(WI + (size_t)(tok0 + g) * 4);
        const int ntile = (t0 + 4 + 15) >> 4, ngrp = ((ntile + 31) & ~31) >> 2;
        const unsigned char* kib = (const unsigned char*)(KI + (size_t)b * SEQ * 64);
        const int lr = lane >> 3, lc = lane & 7;
        const unsigned st_off = lr * 128 + ((lc ^ lr) << 4);
        asm volatile("" :: "v"(af[0]), "v"(af[1]), "v"(wv));
        auto ldgrp = [&](int gg, u32x4 (&dst)[8]) {
            gg = gg < ngrp ? gg : ngrp - 1;
#pragma unroll
            for (int i = 0; i < 8; ++i) dst[i] = ldg16(kib + (size_t)(gg * 64 + i * 8 + lr) * 128 + lc * 16);
        };
        auto proc = [&](int gg, const u32x4 (&src)[8]) {
#pragma unroll
            for (int i = 0; i < 8; ++i) *(u32x4*)(stg + i * 1024 + st_off) = src[i];
            bf16x8 k0[4], k1[4];
#pragma unroll
            for (int u = 0; u < 4; ++u) {
                k0[u] = as_bf16x8(*(const u32x4*)(stg + (16 * u + c) * 128 + ((g ^ (c & 7)) << 4)));
                k1[u] = as_bf16x8(*(const u32x4*)(stg + (16 * u + c) * 128 + (((4 + g) ^ (c & 7)) << 4)));
            }
            unsigned short res[4];
#pragma unroll
            for (int u = 0; u < 4; ++u) {
                f32x4 d = mfma16(af[0], k0[u], (f32x4){0.f, 0.f, 0.f, 0.f});
                d = mfma16(af[1], k1[u], d);
                const float s = wv[0] * fmaxf(d[0], 0.f) + wv[1] * fmaxf(d[1], 0.f) + wv[2] * fmaxf(d[2], 0.f) + wv[3] * fmaxf(d[3], 0.f);
                const int key = gg * 64 + u * 16 + c;
                res[u] = (key <= t0 + g) ? (unsigned short)f16_key(s) : (unsigned short)0;
            }
#pragma unroll
            for (int u = 0; u < 4; ++u) sc[g * 4096 + gg * 64 + u * 16 + c] = res[u];
        };
        u32x4 r0[8], r1[8], r2[8];
        ldgrp(wave, r0); ldgrp(wave + 4, r1); ldgrp(wave + 8, r2);
        for (int gi = wave; gi < ngrp; gi += 12) {
            proc(gi, r0); ldgrp(gi + 12, r0);
            if (gi + 4 < ngrp) proc(gi + 4, r1);
            ldgrp(gi + 16, r1);
            if (gi + 8 < ngrp) proc(gi + 8, r2);
            ldgrp(gi + 20, r2);
        }
    }
    __syncthreads();
    if (!(MODE & 2)) return;
    const int n = t0 + wave + 1;
    const int L = n < 256 ? n : 256;
    const unsigned short* myk = sc + wave * 4096;
    if (n <= 256) {
        for (int i = lane; i < n; i += 64) list[i] = (unsigned short)i;
    } else {
        u32x4 kk[8];
#pragma unroll
        for (int i = 0; i < 8; ++i) kk[i] = (512 * i < n) ? *(const u32x4*)(myk + 512 * i + 8 * lane) : (u32x4){0u, 0u, 0u, 0u};
#pragma unroll
        for (int i = 0; i < 4; ++i) *(u32x4*)(hist + lane * 16 + i * 4) = (u32x4){0u, 0u, 0u, 0u};
#pragma unroll
        for (int i = 0; i < 8; ++i) {
            if (512 * i < n) {
#pragma unroll
                for (int w = 0; w < 4; ++w) { const unsigned wd = kk[i][w]; atomicAdd(&hist[(wd & 0xffffu) >> 6], 1u); atomicAdd(&hist[wd >> 22], 1u); }
            }
        }
        unsigned h[16];
#pragma unroll
        for (int i = 0; i < 4; ++i) { const u32x4 t = *(const u32x4*)(hist + lane * 16 + i * 4); h[4 * i] = t.x; h[4 * i + 1] = t.y; h[4 * i + 2] = t.z; h[4 * i + 3] = t.w; }
#pragma unroll
        for (int i = 0; i < 4; ++i) *(u32x4*)(hist + lane * 16 + i * 4) = (u32x4){0u, 0u, 0u, 0u};
        unsigned sl = 0;
#pragma unroll
        for (int i = 0; i < 16; ++i) sl += h[i];
        unsigned pre = sl;
#pragma unroll
        for (int o = 1; o < 64; o <<= 1) { const unsigned t = __shfl_up(pre, o); if (lane >= o) pre += t; }
        const unsigned tot = __shfl(pre, 63);
        const unsigned suf = tot - pre;
        int found = -1; unsigned cab = 0, cum = suf;
#pragma unroll
        for (int j = 15; j >= 0; --j) { const bool hit = (found < 0) && (cum + h[j] >= 256u); if (hit) { found = lane * 16 + j; cab = cum; } cum += h[j]; }
        const bool mine = (suf < 256u) && (suf + sl >= 256u);
        const unsigned long long mm = __ballot(mine);
        const int src = __ffsll((long long)mm) - 1;
        const unsigned bstar = (unsigned)__shfl(found, src), cabove = __shfl(cab, src);
        const unsigned r1 = 256u - cabove;
#pragma unroll
        for (int i = 0; i < 8; ++i) {
            if (512 * i < n) {
#pragma unroll
                for (int w = 0; w < 4; ++w) {
                    const unsigned wd = kk[i][w];
                    if (((wd & 0xffffu) >> 6) == bstar) atomicAdd(&hist[wd & 63u], 1u);
                    if ((wd >> 22) == bstar) atomicAdd(&hist[(wd >> 16) & 63u], 1u);
                }
            }
        }
        const unsigned cnt = hist[lane];
        hist[lane] = 0u;
        unsigned pre2 = cnt;
#pragma unroll
        for (int o = 1; o < 64; o <<= 1) { const unsigned t = __shfl_up(pre2, o); if (lane >= o) pre2 += t; }
        const unsigned tot2 = __shfl(pre2, 63);
        const unsigned suf2 = tot2 - pre2;
        const bool mine2 = (suf2 < r1) && (suf2 + cnt >= r1);
        const unsigned long long mm2 = __ballot(mine2);
        const int src2 = __ffsll((long long)mm2) - 1;
        const unsigned T = (bstar << 6) | (unsigned)src2;
        const unsigned req = r1 - __shfl(suf2, src2);
        const unsigned toteq = __shfl(cnt, src2);
        const bool alleq = (req == toteq);
        const unsigned Tt = alleq ? T : T + 1u;
        unsigned cg = 0;
#pragma unroll
        for (int i = 0; i < 8; ++i)
#pragma unroll
            for (int w = 0; w < 4; ++w) { const unsigned wd = kk[i][w]; cg += ((wd & 0xffffu) >= Tt) ? 1u : 0u; cg += ((wd >> 16) >= Tt) ? 1u : 0u; }
        unsigned pre3 = cg;
#pragma unroll
        for (int o = 1; o < 64; o <<= 1) { const unsigned t = __shfl_up(pre3, o); if (lane >= o) pre3 += t; }
        unsigned off = pre3 - cg;
#pragma unroll
        for (int i = 0; i < 8; ++i)
#pragma unroll
            for (int w = 0; w < 4; ++w) {
                const unsigned wd = kk[i][w]; const int idx = 512 * i + 8 * lane + 2 * w;
                if ((wd & 0xffffu) >= Tt) { list[off & 255u] = (unsigned short)idx; ++off; }
                if ((wd >> 16) >= Tt) { list[off & 255u] = (unsigned short)(idx + 1); ++off; }
            }
        if (!alleq) {
            const unsigned cgt = 256u - req; unsigned eq_run = 0;
            for (int base = 0; base < n; base += 64) {
                const int i = base + lane; const unsigned m = (i < n) ? myk[i] : 0u;
                const bool eq = (m == T);
                const unsigned long long eqm = __ballot(eq);
                const unsigned rank = eq_run + __builtin_amdgcn_mbcnt_hi((unsigned)(eqm >> 32), __builtin_amdgcn_mbcnt_lo((unsigned)eqm, 0u));
                if (eq && rank < req) list[cgt + rank] = (unsigned short)i;
                eq_run += (unsigned)__popcll(eqm);
            }
        }
    }
    if (!(MODE & 4)) return;
    bf16x8 qf[2], sel[2];
#pragma unroll
    for (int s = 0; s < 2; ++s) {
        u32x4 t = (u32x4){0u, 0u, 0u, 0u};
        if (c < 8) t = ldg16(QB + (size_t)tok * 512 + c * 64 + 32 * s + 8 * g);
        qf[s] = as_bf16x8(t);
#pragma unroll
        for (int j = 0; j < 8; ++j) sel[s][j] = (8 * g + j == 16 * s + c) ? (short)0x3F80 : (short)0;
    }
    f32x4 st[16];
    const unsigned char* kbb = (const unsigned char*)(KB + (size_t)b * SEQ * 64); const unsigned char* vbb = (const unsigned char*)(VB + (size_t)b * SEQ * 64);
    const int lr = lane >> 3, lc = lane & 7;
    const unsigned st_off = lr * 128 + ((lc ^ lr) << 4);
    auto loadg = [&](const unsigned char* base, int T0, u32x4 (&dst)[8]) {
#pragma unroll
        for (int i = 0; i < 8; ++i) {
            const int idx = T0 * 16 + i * 8 + lr; const unsigned kid = (idx < L) ? (unsigned)list[idx] : 0u;
            dst[i] = ldg16(base + kid * 128u + lc * 16u);
        }
    };
    auto stage = [&](const u32x4 (&src)[8]) {
#pragma unroll
        for (int i = 0; i < 8; ++i) *(u32x4*)(stg + i * 1024 + st_off) = src[i];
    };
    auto frag = [&](int u, int s2) -> bf16x8 { return as_bf16x8(*(const u32x4*)(stg + (16 * u + c) * 128 + (((4 * s2 + g) ^ (c & 7)) << 4))); };
    auto scoreK = [&](int T0) {
#pragma unroll
        for (int T = 0; T < 4; ++T) {
            f32x4 d = mfma16(frag(T, 0), qf[0], (f32x4){0.f, 0.f, 0.f, 0.f});
            st[T0 + T] = mfma16(frag(T, 1), qf[1], d);
        }
    };
    u32x4 rA[8], rB[8], rC[8], rD[8];
    loadg(kbb, 0, rA); loadg(kbb, 4, rB); loadg(kbb, 8, rC); loadg(kbb, 12, rD);
    __builtin_amdgcn_sched_barrier(0);
    stage(rA); scoreK(0);
    stage(rB); scoreK(4);
    __builtin_amdgcn_sched_barrier(0);
    loadg(vbb, 0, rA); loadg(vbb, 4, rB);
    stage(rC); scoreK(8);
    stage(rD); scoreK(12);
    __builtin_amdgcn_sched_barrier(0);
    float mx = -3.0e38f;
    {
        const int lrem = L - 4 * g;
#pragma unroll
        for (int T = 0; T < 16; ++T)
#pragma unroll
            for (int r = 0; r < 4; ++r) { const float sv = (T * 16 + r < lrem) ? st[T][r] : -3.0e38f; st[T][r] = sv; mx = fmaxf(mx, sv); }
    }
    mx = fmaxf(mx, __shfl_xor(mx, 16)); mx = fmaxf(mx, __shfl_xor(mx, 32));
    float lsum = 0.f;
#pragma unroll
    for (int T = 0; T < 16; ++T)
#pragma unroll
        for (int r = 0; r < 4; ++r) { const float e = __expf(st[T][r] - mx); st[T][r] = e; lsum += e; }
    lsum += __shfl_xor(lsum, 16); lsum += __shfl_xor(lsum, 32);
    const float rl = 1.0f / lsum;
    u32x4 pfv[8];
#pragma unroll
    for (int u = 0; u < 8; ++u) {
        const int Ta = 2 * u, Tb = Ta + 1;
        pfv[u].x = pack_bf16(st[Ta][0] * rl, st[Ta][1] * rl); pfv[u].y = pack_bf16(st[Ta][2] * rl, st[Ta][3] * rl);
        pfv[u].z = pack_bf16(st[Tb][0] * rl, st[Tb][1] * rl); pfv[u].w = pack_bf16(st[Tb][2] * rl, st[Tb][3] * rl);
    }
    __builtin_amdgcn_sched_barrier(0);
    f32x4 O[4];
#pragma unroll
    for (int cb = 0; cb < 4; ++cb) O[cb] = (f32x4){0.f, 0.f, 0.f, 0.f};
    auto pv = [&](int T0) {
#pragma unroll
        for (int u = 0; u < 2; ++u) {
            const u32x4 pf = pfv[(T0 >> 1) + u];
#pragma unroll
            for (int cb = 0; cb < 4; ++cb) {
                const f32x4 z = (f32x4){0.f, 0.f, 0.f, 0.f};
                const f32x4 v0 = mfma16(frag(2 * u, cb >> 1), sel[cb & 1], z), v1 = mfma16(frag(2 * u + 1, cb >> 1), sel[cb & 1], z);
                u32x4 vf; vf.x = pack_bf16(v0[0], v0[1]); vf.y = pack_bf16(v0[2], v0[3]); vf.z = pack_bf16(v1[0], v1[1]); vf.w = pack_bf16(v1[2], v1[3]);
                O[cb] = mfma16(as_bf16x8(pf), as_bf16x8(vf), O[cb]);
            }
        }
    };
    loadg(vbb, 8, rC); loadg(vbb, 12, rD);
    __builtin_amdgcn_sched_barrier(0);
    stage(rA); pv(0);
    stage(rB); pv(4);
    __builtin_amdgcn_sched_barrier(0);
    stage(rC); pv(8);
    stage(rD); pv(12);
    if (g < 2) {
#pragma unroll
        for (int cb = 0; cb < 4; ++cb)
#pragma unroll
            for (int r = 0; r < 4; ++r) ATT[(size_t)tok * 1024 + 512 + (4 * g + r) * 64 + 16 * cb + c] = (bf16_t)f2bf(O[cb][r]);
    }
}

DI void p2_swa_item(const Params& p, int item2) {
    unsigned char* ws = p.ws;
    const bf16_t* QA = (const bf16_t*)(ws + WS_QA); const bf16_t* KA = (const bf16_t*)(ws + WS_KA); const bf16_t* VA = (const bf16_t*)(ws + WS_VA);
    bf16_t* ATT = (bf16_t*)(ws + WS_ATT);
    int tid = threadIdx.x; asm volatile("" : "+v"(tid));
    const int lane = tid & 63, wave = __builtin_amdgcn_readfirstlane(tid >> 6), r = lane & 31, h = lane >> 5;
    const int hq = item2 & 7, blk = (item2 >> 3) & 31, b = item2 >> 8, kvh = hq >> 2;
    const int qi = 32 * wave + r, tokq = b * SEQ + blk * 128 + qi;
    bf16x8 qf[4], sel[2];
#pragma unroll
    for (int s = 0; s < 4; ++s) qf[s] = as_bf16x8(ldg16(QA + (size_t)tokq * 512 + hq * 64 + 16 * s + 8 * h));
#pragma unroll
    for (int x = 0; x < 2; ++x)
#pragma unroll
        for (int j = 0; j < 8; ++j) sel[x][j] = (8 * h + j + 16 * x == r) ? (short)0x3F80 : (short)0;
    const float sink = p.sinks[hq];
    f32x16 ST[5];
#pragma unroll
    for (int ti = 0; ti < 5; ++ti) {
        const int sj = 32 * (wave + ti) + r; int pos = blk * 128 - 128 + sj; pos = pos < 0 ? 0 : pos;
        const bf16_t* kp = KA + (size_t)(b * SEQ + pos) * 128 + kvh * 64 + 8 * h;
        f32x16 d; for (int i = 0; i < 16; ++i) d[i] = 0.f;
#pragma unroll
        for (int s = 0; s < 4; ++s) d = mfma32(as_bf16x8(ldg16(kp + 16 * s)), qf[s], d);
        ST[ti] = d;
    }
    float mx = sink;
    {
        const int lo = r + 1 - 4 * h;
        const int lo0 = (blk > 0) ? lo : (lo > 128 - 32 * wave - 4 * h ? lo : 128 - 32 * wave - 4 * h);
#pragma unroll
        for (int ti = 0; ti < 5; ++ti)
#pragma unroll
            for (int reg = 0; reg < 16; ++reg) {
                const int e = 32 * ti + (reg & 3) + 8 * (reg >> 2);
                const float sv = (e >= lo0 && e < lo + 128) ? ST[ti][reg] : -3.0e38f; ST[ti][reg] = sv; mx = fmaxf(mx, sv);
            }
    }
    mx = fmaxf(mx, __shfl_xor(mx, 32));
    float lsum = 0.f;
#pragma unroll
    for (int ti = 0; ti < 5; ++ti)
#pragma unroll
        for (int reg = 0; reg < 16; ++reg) { const float e = __expf(ST[ti][reg] - mx); ST[ti][reg] = e; lsum += e; }
    lsum += __shfl_xor(lsum, 32);
    lsum += __expf(sink - mx);
    const float rl = 1.0f / lsum;
    f32x16 OT[2];
    for (int i = 0; i < 16; ++i) { OT[0][i] = 0.f; OT[1][i] = 0.f; }
#pragma unroll
    for (int ti = 0; ti < 5; ++ti) {
        const int sj = 32 * (wave + ti) + r; int pos = blk * 128 - 128 + sj; pos = pos < 0 ? 0 : pos;
        const bf16_t* vp = VA + (size_t)(b * SEQ + pos) * 128 + kvh * 64 + 8 * h;
        bf16x8 vf[4];
#pragma unroll
        for (int s = 0; s < 4; ++s) vf[s] = as_bf16x8(ldg16(vp + 16 * s));
        u32x4 pb[2];
#pragma unroll
        for (int s2 = 0; s2 < 2; ++s2) {
            pb[s2].x = pack_bf16(ST[ti][8 * s2 + 0] * rl, ST[ti][8 * s2 + 1] * rl); pb[s2].y = pack_bf16(ST[ti][8 * s2 + 2] * rl, ST[ti][8 * s2 + 3] * rl);
            pb[s2].z = pack_bf16(ST[ti][8 * s2 + 4] * rl, ST[ti][8 * s2 + 5] * rl); pb[s2].w = pack_bf16(ST[ti][8 * s2 + 6] * rl, ST[ti][8 * s2 + 7] * rl);
        }
#pragma unroll
        for (int db = 0; db < 2; ++db) {
            f32x16 vt; for (int i = 0; i < 16; ++i) vt[i] = 0.f;
            vt = mfma32(vf[2 * db], sel[0], vt); vt = mfma32(vf[2 * db + 1], sel[1], vt);
#pragma unroll
            for (int s2 = 0; s2 < 2; ++s2) {
                u32x4 va; va.x = pack_bf16(vt[8 * s2 + 0], vt[8 * s2 + 1]); va.y = pack_bf16(vt[8 * s2 + 2], vt[8 * s2 + 3]);
                va.z = pack_bf16(vt[8 * s2 + 4], vt[8 * s2 + 5]); va.w = pack_bf16(vt[8 * s2 + 6], vt[8 * s2 + 7]);
                OT[db] = mfma32(as_bf16x8(va), as_bf16x8(pb[s2]), OT[db]);
            }
        }
    }
#pragma unroll
    for (int db = 0; db < 2; ++db)
#pragma unroll
        for (int q4 = 0; q4 < 4; ++q4) {
            u32x2 w; w.x = pack_bf16(OT[db][4 * q4], OT[db][4 * q4 + 1]); w.y = pack_bf16(OT[db][4 * q4 + 2], OT[db][4 * q4 + 3]);
            *(u32x2*)(ATT + (size_t)tokq * 1024 + hq * 64 + 32 * db + 8 * q4 + 4 * h) = w;
        }
}

template <int MODE> DI void p2_attention(const Params& p, unsigned char* lds, int cidx = 0) {
    const int G = gridDim.x, bi = blockIdx.x, rounds = (1024 + G - 1) / G;
    for (int b = 0; b < BATCH; ++b)
        for (int r = 0; r < rounds; ++r) {
            const int idx = (r & 1) ? r * G + (G - 1 - bi) : r * G + bi;
            if (idx < 1024) { __syncthreads(); p2_dsa_item<MODE>(p, lds, b, 1023 - idx); }
        }
    if (MODE & 8) for (int item2 = bi; item2 < NSWA; item2 += G) p2_swa_item(p, item2);
}

DI void p3_outproj(const Params& p, unsigned char* lds) {
    unsigned char* ws = p.ws;
    const bf16_t* ATT = (const bf16_t*)(ws + WS_ATT); const bf16_t* WT = (const bf16_t*)(ws + WS_WOT);
    const int tid = threadIdx.x, lane = tid & 63, wave = tid >> 6, wm = wave >> 1, wn = wave & 1, c = lane & 15, g = lane >> 4;
    constexpr int NT = 8, MT = NTOK / 128;
    for (int t = blockIdx.x; t < NT * MT; t += gridDim.x) {
        const int mt = t / NT, nt = t % NT;
        f32x4 acc[4][4];
        gemm_128x128(ATT + (size_t)mt * 128 * 1024, 1024, WT + (size_t)nt * 128 * 1024, 1024, 1024, lds, acc);
#pragma unroll
        for (int m = 0; m < 4; ++m) {
            const int tok = mt * 128 + wm * 64 + m * 16 + c;
#pragma unroll
            for (int n = 0; n < 4; ++n) {
                const size_t o = (size_t)tok * 1024 + nt * 128 + wn * 64 + 16 * n + 4 * g;
                const f32x4 xv = *(const f32x4*)(p.x + o);
                *(f32x4*)(p.out + o) = xv * ALPHA + acc[m][n];
            }
        }
    }
}

DI void p3b_ln1(const Params& p) {
    bf16_t* H1B = (bf16_t*)(p.ws + WS_XB);
    const int lane = threadIdx.x & 63, gw = blockIdx.x * 4 + (threadIdx.x >> 6), nw = gridDim.x * 4;
    for (int row = gw; row < NTOK; row += nw) {
        f32x4 v[4]; float s = 0.f;
#pragma unroll
        for (int i = 0; i < 4; ++i) { v[i] = *(const f32x4*)(p.out + (size_t)row * 1024 + (lane + 64 * i) * 4); s += (v[i][0] + v[i][1]) + (v[i][2] + v[i][3]); }
        const float mu = wave_sum(s) * (1.f / 1024.f); float q = 0.f;
#pragma unroll
        for (int i = 0; i < 4; ++i) { const f32x4 d = v[i] - mu; q += (d[0] * d[0] + d[1] * d[1]) + (d[2] * d[2] + d[3] * d[3]); }
        const float rstd = rsqrtf(wave_sum(q) * (1.f / 1024.f) + LN_EPS);
#pragma unroll
        for (int i = 0; i < 4; ++i) {
            const int col = (lane + 64 * i) * 4;
            const f32x4 gg = *(const f32x4*)(p.ln1_g + col), bb = *(const f32x4*)(p.ln1_b + col);
            const f32x4 o = (v[i] - mu) * rstd * gg + bb;
            u32x2 w; w.x = pack_bf16(o[0], o[1]); w.y = pack_bf16(o[2], o[3]);
            *(u32x2*)(H1B + (size_t)row * 1024 + col) = w;
        }
    }
}

DI int f2key(float v) { const int b = __float_as_int(v); return b ^ ((b >> 31) & 0x7fffffff); }
DI float key2f(int k) { return __int_as_float(k ^ ((k >> 31) & 0x7fffffff)); }
DI void ce_desc(int& a, int& b) { const int hi = a > b ? a : b, lo = a > b ? b : a; a = hi; b = lo; }
DI void bitonic_merge16(int (&k)[16]) {
#pragma unroll
    for (int d = 8; d >= 1; d >>= 1)
#pragma unroll
        for (int i = 0; i < 16; ++i) if ((i & d) == 0) ce_desc(k[i], k[i | d]);
}
DI void bitonic_sort16(int (&k)[16]) {
#pragma unroll
    for (int sz = 2; sz <= 16; sz <<= 1) {
#pragma unroll
        for (int i = 0; i < 16; ++i) { const int j = i ^ (sz - 1); if (j > i) ce_desc(k[i], k[j]); }
#pragma unroll
        for (int d = sz >> 2; d >= 1; d >>= 1)
#pragma unroll
            for (int i = 0; i < 16; ++i) if ((i & d) == 0) ce_desc(k[i], k[i | d]);
    }
}
DI void top16_merge(int (&t)[16], const int (&sdesc)[16]) {
#pragma unroll
    for (int i = 0; i < 16; ++i) t[i] = t[i] > sdesc[15 - i] ? t[i] : sdesc[15 - i];
    bitonic_merge16(t);
}
constexpr int P4_QS = 32768, P4_SS_STRIDE = 132, P4_ST0 = 67584  , P4_M = 0  , P4_ST1 = 8704  ;

DI void p4_peer_query(const Params& p, unsigned char* lds) {
    unsigned char* ws = p.ws;
    const bf16_t* H1B = (const bf16_t*)(ws + WS_XB); const bf16_t* WQT = (const bf16_t*)(ws + WS_WQT); const bf16_t* SK = (const bf16_t*)(ws + WS_SK);
    unsigned short* PE = (unsigned short*)(ws + WS_PE); float* PG = (float*)(ws + WS_PG); float* PS = (float*)(ws + WS_PS);
    const float* SU = (const float*)(ws + WS_SU); const float* SV = (const float*)(ws + WS_SV);
    const int tid = threadIdx.x, lane = tid & 63, wave = tid >> 6, wm = wave >> 1, wn = wave & 1, c = lane & 15, g = lane >> 4;
    const int lrow = tid >> 3, lch = tid & 7;
    const int srow = tid & 127, shalf = tid >> 7;
    float* Ss = (float*)lds;
    float* st0 = (float*)(lds + P4_ST0); float* mbuf = (float*)(lds + P4_M); float* st1 = (float*)(lds + P4_ST1);
    constexpr int MT = NTOK / 128;
    for (int t = blockIdx.x; t < MT * 8; t += gridDim.x) {
        const int mt = t >> 3, head = t & 7;
#pragma unroll 1
        for (int ph = 0; ph < 2; ++ph) {
            f32x4 acc[4][4];
            gemm_128x128(H1B + (size_t)mt * 128 * 1024, 1024, WQT + (size_t)(head * 256 + ph * 128) * 1024, 1024, 1024, lds, acc);
            __syncthreads();
#pragma unroll
            for (int m = 0; m < 4; ++m)
#pragma unroll
                for (int n = 0; n < 4; ++n) {
                    const int row = wm * 64 + m * 16 + c;
                    u32x2 w; w.x = pack_bf16(acc[m][n][0], acc[m][n][1]); w.y = pack_bf16(acc[m][n][2], acc[m][n][3]);
                    *(u32x2*)(lds + P4_QS + wn * 16384 + row * 128 + (((2 * n + (g >> 1)) ^ (row & 7)) << 4) + (g & 1) * 8) = w;
                }
            {
                const bf16_t* sp = SK + (size_t)((head * 2 + ph) * 128 + lrow) * 128 + lch * 8;
#pragma unroll
                for (int k2 = 0; k2 < 2; ++k2)
#pragma unroll
                    for (int i = 0; i < 4; ++i) *(u32x4*)(lds + k2 * 16384 + (lrow + 32 * i) * 128 + ((lch ^ (lrow & 7)) << 4)) = ldg16(sp + (size_t)(32 * i) * 128 + k2 * 64);
            }
            __syncthreads();
            f32x4 a2[4][4];
#pragma unroll
            for (int m = 0; m < 4; ++m)
#pragma unroll
                for (int n = 0; n < 4; ++n) a2[m][n] = (f32x4){0.f, 0.f, 0.f, 0.f};
#pragma unroll
            for (int k2 = 0; k2 < 2; ++k2)
#pragma unroll
                for (int s = 0; s < 2; ++s) {
                    bf16x8 xf[4], wf[4];
#pragma unroll
                    for (int m = 0; m < 4; ++m) { const int row = wm * 64 + m * 16 + c; xf[m] = as_bf16x8(*(const u32x4*)(lds + P4_QS + k2 * 16384 + row * 128 + (((4 * s + g) ^ (c & 7)) << 4))); }
#pragma unroll
                    for (int n = 0; n < 4; ++n) { const int row = wn * 64 + n * 16 + c; wf[n] = as_bf16x8(*(const u32x4*)(lds + k2 * 16384 + row * 128 + (((4 * s + g) ^ (c & 7)) << 4))); }
#pragma unroll
                    for (int m = 0; m < 4; ++m)
#pragma unroll
                        for (int n = 0; n < 4; ++n) a2[m][n] = mfma16(wf[n], xf[m], a2[m][n]);
                }
            __syncthreads();
#pragma unroll
            for (int m = 0; m < 4; ++m)
#pragma unroll
                for (int n = 0; n < 4; ++n) {
                    const int key0 = wn * 64 + 16 * n + 4 * g;
                    u32x4 w;
#pragma unroll
                    for (int r = 0; r < 4; ++r) w[r] = (unsigned)f2key(__uint_as_float((__float_as_uint(a2[m][n][r]) & 0xFFFFFF80u) | (unsigned)(key0 + r)));
                    *(u32x4*)(Ss + (wm * 64 + m * 16 + c) * P4_SS_STRIDE + key0) = w;
                }
            __syncthreads();
            int tv[16];
            {
                const int* rowp = (const int*)Ss + srow * P4_SS_STRIDE + shalf * 64;
#pragma unroll
                for (int bt = 0; bt < 4; ++bt) {
                    int bk[16];
#pragma unroll
                    for (int j = 0; j < 4; ++j) { const u32x4 v = *(const u32x4*)(rowp + 16 * bt + 4 * j); bk[4 * j] = (int)v.x; bk[4 * j + 1] = (int)v.y; bk[4 * j + 2] = (int)v.z; bk[4 * j + 3] = (int)v.w; }
                    bitonic_sort16(bk);
                    if (bt == 0) {
#pragma unroll
                        for (int j = 0; j < 16; ++j) tv[j] = bk[j];
                    } else top16_merge(tv, bk);
                }
            }
            __syncthreads();
            int* mbi = (int*)mbuf;
            if (shalf == 1) {
#pragma unroll
                for (int j = 0; j < 16; ++j) mbi[srow * 17 + j] = tv[j];
            }
            __syncthreads();
            if (shalf == 0) {
                int* dst = (int*)((ph == 0) ? st0 : st1);
                int ob[16];
#pragma unroll
                for (int j = 0; j < 16; ++j) ob[j] = mbi[srow * 17 + j];
                top16_merge(tv, ob);
#pragma unroll
                for (int j = 0; j < 16; ++j) dst[srow * 17 + j] = tv[j];
            }
        }
        __syncthreads();
        int cv[16];
        {
            const int* st0i = (const int*)st0; const int* st1i = (const int*)st1;
            float v2[16];
#pragma unroll
            for (int b = 0; b < 16; ++b) v2[b] = key2f(st1i[srow * 17 + b]);
#pragma unroll
            for (int a8 = 0; a8 < 8; ++a8) {
                const int a = shalf * 8 + a8; const float va = key2f(st0i[srow * 17 + a]);
                int bk[16];
#pragma unroll
                for (int b = 0; b < 16; ++b) bk[b] = (f2key(va + v2[b]) & (int)0xFFFFFF00) | (a * 16 + 15 - b);
                if (a8 == 0) {
#pragma unroll
                    for (int j = 0; j < 16; ++j) cv[j] = bk[j];
                } else top16_merge(cv, bk);
            }
        }
        __syncthreads();
        int* mbi = (int*)mbuf;
        if (shalf == 1) {
#pragma unroll
            for (int j = 0; j < 16; ++j) mbi[srow * 17 + j] = cv[j];
        }
        __syncthreads();
        if (shalf == 0) {
            const int* st0i = (const int*)st0; const int* st1i = (const int*)st1;
            int fk[16]; float fv[16];
#pragma unroll
            for (int j = 0; j < 16; ++j) { const int o = mbi[srow * 17 + 15 - j]; fk[j] = cv[j] > o ? cv[j] : o; fv[j] = key2f(fk[j]); }
            float cmax = fv[0];
#pragma unroll
            for (int j = 1; j < 16; ++j) cmax = fmaxf(cmax, fv[j]);
            float den = 0.f; float ev[16];
#pragma unroll
            for (int j = 0; j < 16; ++j) { ev[j] = __expf(fv[j] - cmax); den += ev[j]; }
            const float rden = 1.0f / den;
            const size_t ob = (size_t)(mt * 128 + srow) * 128 + head * 16;
#pragma unroll
            for (int j = 0; j < 16; ++j) {
                const unsigned cde = (unsigned)fk[j] & 0xFFu;
                const unsigned a = cde >> 4, b = 15u - (cde & 15u);
                const unsigned i1 = __float_as_uint(key2f(st0i[srow * 17 + a])) & 0x7Fu, i2 = __float_as_uint(key2f(st1i[srow * 17 + b])) & 0x7Fu;
                const int e = (int)(i1 * 128u + i2);
                PE[ob + j] = (unsigned short)e; PG[ob + j] = ev[j] * rden * SV[e]; PS[ob + j] = SU[e];
            }
        }
        __syncthreads();
    }
}

DI float gelu_exact(float z) { return 0.5f * z * (1.0f + erff(z * 0.70710678118654752f)); }
DI float rdlane(float v, int l) { return __int_as_float(__builtin_amdgcn_readlane(__float_as_int(v), l)); }

typedef float f32x2 __attribute__((ext_vector_type(2)));
DI void p5_gather(const Params& p) {
    unsigned char* ws = p.ws;
    const bf16_t* H1B = (const bf16_t*)(ws + WS_XB); const unsigned char* UT = ws + WS_UT; const unsigned char* VT = ws + WS_VT;
    const unsigned short* PE = (const unsigned short*)(ws + WS_PE); const float* PG = (const float*)(ws + WS_PG); const float* PS = (const float*)(ws + WS_PS);
    const int lane = threadIdx.x & 63, gw = blockIdx.x * 4 + (threadIdx.x >> 6), nw = gridDim.x * 4;
    const bool b5 = (lane & 32) != 0, b4 = (lane & 16) != 0, b3 = (lane & 8) != 0, b2 = (lane & 4) != 0;
    for (int tok = gw; tok < NTOK; tok += nw) {
        float x[16], acc[16];
        {
            const u32x4 xa = ldg16(H1B + (size_t)tok * 1024 + lane * 16), xb = ldg16(H1B + (size_t)tok * 1024 + lane * 16 + 8);
            x[0] = bf_lo(xa.x); x[1] = bf_hi(xa.x); x[2] = bf_lo(xa.y); x[3] = bf_hi(xa.y); x[4] = bf_lo(xa.z); x[5] = bf_hi(xa.z); x[6] = bf_lo(xa.w); x[7] = bf_hi(xa.w);
            x[8] = bf_lo(xb.x); x[9] = bf_hi(xb.x); x[10] = bf_lo(xb.y); x[11] = bf_hi(xb.y); x[12] = bf_lo(xb.z); x[13] = bf_hi(xb.z); x[14] = bf_lo(xb.w); x[15] = bf_hi(xb.w);
        }
#pragma unroll
        for (int i = 0; i < 16; ++i) acc[i] = 0.f;
        const int pe_lo = (int)PE[(size_t)tok * 128 + lane], pe_hi = (int)PE[(size_t)tok * 128 + 64 + lane];
        const float pg_lo = PG[(size_t)tok * 128 + lane], pg_hi = PG[(size_t)tok * 128 + 64 + lane];
        const float ps_lo = PS[(size_t)tok * 128 + lane], ps_hi = PS[(size_t)tok * 128 + 64 + lane];
#pragma unroll 1
        for (int hd = 0; hd < 8; ++hd) {
            const int pes = hd < 4 ? pe_lo : pe_hi; const float pgs = hd < 4 ? pg_lo : pg_hi, pss = hd < 4 ? ps_lo : ps_hi;
            const int lb = (hd & 3) * 16;
            float d[16];
#pragma unroll
            for (int j = 0; j < 16; ++j) {
                const int e = __builtin_amdgcn_readlane(pes, lb + j);
                const u32x4 uw = ldg16(UT + (size_t)e * 1024 + lane * 16);
                float s = 0.f;
#pragma unroll
                for (int k = 0; k < 4; ++k) {
                    const f32x2 f0 = __builtin_amdgcn_cvt_pk_f32_fp8((int)uw[k], false), f1 = __builtin_amdgcn_cvt_pk_f32_fp8((int)uw[k], true);
                    s = fmaf(x[4 * k], f0.x, s); s = fmaf(x[4 * k + 1], f0.y, s); s = fmaf(x[4 * k + 2], f1.x, s); s = fmaf(x[4 * k + 3], f1.y, s);
                }
                d[j] = s;
            }
            float r8[8], r4[4], r2[2], r1;
#pragma unroll
            for (int j = 0; j < 8; ++j) { const float keep = b5 ? d[j + 8] : d[j], send = b5 ? d[j] : d[j + 8]; r8[j] = keep + __shfl_xor(send, 32); }
#pragma unroll
            for (int j = 0; j < 4; ++j) { const float keep = b4 ? r8[j + 4] : r8[j], send = b4 ? r8[j] : r8[j + 4]; r4[j] = keep + __shfl_xor(send, 16); }
#pragma unroll
            for (int j = 0; j < 2; ++j) { const float keep = b3 ? r4[j + 2] : r4[j], send = b3 ? r4[j] : r4[j + 2]; r2[j] = keep + __shfl_xor(send, 8); }
            { const float keep = b2 ? r2[1] : r2[0], send = b2 ? r2[0] : r2[1]; r1 = keep + __shfl_xor(send, 4); }
            r1 += __shfl_xor(r1, 2); r1 += __shfl_xor(r1, 1);
            const int mine = lb + ((lane >> 2) & 15);
            const float coef = gelu_exact(r1 * __shfl(pss, mine)) * __shfl(pgs, mine);
#pragma unroll
            for (int j = 0; j < 16; ++j) {
                const int e = __builtin_amdgcn_readlane(pes, lb + j);
                const float cj = rdlane(coef, 4 * j);
                const u32x4 vw = ldg16(VT + (size_t)e * 1024 + lane * 16);
#pragma unroll
                for (int k = 0; k < 4; ++k) {
                    const f32x2 f0 = __builtin_amdgcn_cvt_pk_f32_fp8((int)vw[k], false), f1 = __builtin_amdgcn_cvt_pk_f32_fp8((int)vw[k], true);
                    acc[4 * k] = fmaf(cj, f0.x, acc[4 * k]); acc[4 * k + 1] = fmaf(cj, f0.y, acc[4 * k + 1]); acc[4 * k + 2] = fmaf(cj, f1.x, acc[4 * k + 2]); acc[4 * k + 3] = fmaf(cj, f1.y, acc[4 * k + 3]);
                }
            }
        }
        float s = 0.f;
#pragma unroll
        for (int i = 0; i < 16; ++i) { acc[i] = fmaf(ALPHA, x[i], acc[i]); s += acc[i]; }
        const float mu = wave_sum(s) * (1.f / 1024.f); float q = 0.f;
#pragma unroll
        for (int i = 0; i < 16; ++i) { const float dd = acc[i] - mu; q = fmaf(dd, dd, q); }
        const float rstd = rsqrtf(wave_sum(q) * (1.f / 1024.f) + LN_EPS);
#pragma unroll
        for (int k4 = 0; k4 < 4; ++k4) {
            const int col = lane * 16 + k4 * 4;
            const f32x4 gg = *(const f32x4*)(p.ln2_g + col), bb = *(const f32x4*)(p.ln2_b + col);
            f32x4 o;
#pragma unroll
            for (int e = 0; e < 4; ++e) o[e] = (acc[k4 * 4 + e] - mu) * rstd * gg[e] + bb[e];
            *(f32x4*)(p.out + (size_t)tok * 1024 + col) = o;
        }
    }
}

#define XB_TMO      128
#define XB_XCNT(j)  (256  + 64 * (j))
#define XB_XSUB(j)  (1280 + 64 * (j))
#define XB_XGEN(j)  (2304 + 64 * (j))
#define XB_TOP      3328
#define XB_TOPGEN   3392
#define XCD_BAR_WORDS 3456
#define XB_SPIN_CAP (1u << 22)
#define LAS __attribute__((address_space(3)))
DI unsigned xb_ld(unsigned* p)              { return __hip_atomic_load(p, __ATOMIC_RELAXED, __HIP_MEMORY_SCOPE_AGENT); }
DI unsigned xb_add(unsigned* p, unsigned v) { return __hip_atomic_fetch_add(p, v, __ATOMIC_RELAXED, __HIP_MEMORY_SCOPE_AGENT); }
DI unsigned xb_xcc_id() { return (unsigned)__builtin_amdgcn_s_getreg((3 << 11) | 20) & 0xFu; }
#define XB_SPIN(cond, bar) do { unsigned _sp = 0; while (cond) { __builtin_amdgcn_s_sleep(1); \
    if ((++_sp & 255u) == 0u) { if (xb_ld(&(bar)[XB_TMO])) break; if (_sp > XB_SPIN_CAP) { atomicAdd(&(bar)[XB_TMO], 1u); break; } } } } while (0)
struct XcdBarrier { unsigned* bar; unsigned x; volatile LAS unsigned* st; };
DI XcdBarrier xcd_barrier_post(unsigned* bar, volatile LAS unsigned* st) {
    XcdBarrier b; b.bar = bar; b.x = xb_xcc_id(); b.st = st;
    if (threadIdx.x == 0) (void)xb_add(&bar[XB_XCNT(b.x)], 1u);
    return b;
}
DI void xcd_barrier_complete(unsigned* bar, unsigned x, unsigned& nloc, unsigned& nx) {
    const unsigned G = gridDim.x * gridDim.y * gridDim.z;
    unsigned sum, cnt, mine, sp = 0u;
    for (;;) {
        sum = 0u; cnt = 0u; mine = 0u;
#pragma unroll
        for (unsigned j = 0; j < 16; ++j) { const unsigned c = xb_ld(&bar[XB_XCNT(j)]); sum += c; cnt += (c > 0u) ? 1u : 0u; mine = (j == x) ? c : mine; }
        if (sum == G) break;
        __builtin_amdgcn_s_sleep(1);
        if ((++sp & 255u) == 0u) { if (xb_ld(&bar[XB_TMO])) break; if (sp > XB_SPIN_CAP) { atomicAdd(&bar[XB_TMO], 1u); break; } }
    }
    nloc = mine > 0u ? mine : 1u; nx = cnt > 0u ? cnt : 1u;
}
DI void xcd_barrier(const XcdBarrier& b) {
    asm volatile("s_waitcnt vmcnt(0)" ::: "memory");
    __syncthreads();
    if (threadIdx.x == 0) {
        unsigned* bar = b.bar;
        __builtin_amdgcn_s_waitcnt(0);
        unsigned nloc = b.st[0], nx = b.st[1];
        if (nloc == 0u) { xcd_barrier_complete(bar, b.x, nloc, nx); b.st[0] = nloc; b.st[1] = nx; }
        const unsigned old = xb_add(&bar[XB_XSUB(b.x)], 1u);
        const unsigned gen = old / nloc;
        if (old + 1u == (gen + 1u) * nloc) {
            __builtin_amdgcn_fence(__ATOMIC_RELEASE, "agent");
            asm volatile("s_waitcnt vmcnt(0)" ::: "memory");
            const unsigned og = xb_add(&bar[XB_TOP], 1u);
            const unsigned tg = og / nx;
            if (og + 1u == (tg + 1u) * nx) xb_add(&bar[XB_TOPGEN], 1u);
            else XB_SPIN(xb_ld(&bar[XB_TOPGEN]) == tg, bar);
            __builtin_amdgcn_fence(__ATOMIC_ACQUIRE, "agent");
            xb_add(&bar[XB_XGEN(b.x)], 1u);
            asm volatile("s_waitcnt vmcnt(0)" ::: "memory");
        } else {
            XB_SPIN(xb_ld(&bar[XB_XGEN(b.x)]) == gen, bar);
            __builtin_amdgcn_fence(__ATOMIC_ACQUIRE, "agent");
            asm volatile("s_waitcnt vmcnt(0)" ::: "memory");
        }
    }
    __syncthreads();
}

constexpr int NPHASE = 7;
__global__ void __launch_bounds__(NTHREADS, 2) mega_fwd(Params p) {
    extern __shared__ __attribute__((aligned(16))) unsigned char lds[];
    cg::grid_group grid = cg::this_grid();
    const int lo = p.ph_lo, hi = p.ph_hi;
    volatile LAS unsigned* xbst = (volatile LAS unsigned*)(LAS unsigned char*)(lds + LDS_BYTES - 16);
#ifndef REP_MASK
#define REP_MASK 0
#endif
#ifndef P2_PROBE_MODE
#define P2_PROBE_MODE 15
#endif
#ifndef PH_MASK
#define PH_MASK 127
#endif
    if (threadIdx.x == 0) { xbst[0] = 0u; xbst[1] = 0u; }
    p0_prep(p, lds);
    grid.sync();
    XcdBarrier xb = xcd_barrier_post((unsigned*)(p.ws + WS_BAR), xbst);
#define GSYNC() xcd_barrier(xb)
#define RUN_PHASE(k, call) { call; if ((REP_MASK >> (k)) & 1) { GSYNC(); call; } }
#if PH_MASK & 2
    RUN_PHASE(1, p1_inproj(p, lds))
#endif
    GSYNC();
#if PH_MASK & 4
#if (REP_MASK >> 2) & 1
    p2_attention<P2_PROBE_MODE>(p, lds, 1); GSYNC();
#endif
    p2_attention<15>(p, lds, 0);
#endif
    GSYNC();
#if PH_MASK & 8
    RUN_PHASE(3, p3_outproj(p, lds))
#endif
    GSYNC();
#if PH_MASK & 16
    RUN_PHASE(4, p3b_ln1(p))
#endif
    GSYNC();
#if PH_MASK & 32
    RUN_PHASE(5, p4_peer_query(p, lds))
#endif
    GSYNC();
#if PH_MASK & 64
    RUN_PHASE(6, p5_gather(p))
#endif
}

#ifndef MK_N_LAUNCHES
#define MK_N_LAUNCHES 1
#endif

extern "C" void kernel_launch(void* const* d_in, const int* in_sizes, int n_in, void* d_out, int out_size, void* d_ws, size_t ws_size, hipStream_t stream) {
    static int grid_blocks = 0;
    if (grid_blocks == 0) {
        if (n_in != 14 || out_size != NTOK * D_MODEL || ws_size < WS_END) {
            fprintf(stderr, "kernel_launch: unexpected problem (n_in %d, out %d, ws %zu, need %zu)\n", n_in, out_size, ws_size, (size_t)WS_END); grid_blocks = -1; return;
        }
        int dev = 0, cus = 0, per_cu = 0;
        hipGetDevice(&dev);
        hipDeviceGetAttribute(&cus, hipDeviceAttributeMultiprocessorCount, dev);
        if (hipFuncSetAttribute((const void*)mega_fwd, hipFuncAttributeMaxDynamicSharedMemorySize, LDS_BYTES) != hipSuccess) { fprintf(stderr, "kernel_launch: hipFuncSetAttribute failed\n"); }
        if (hipOccupancyMaxActiveBlocksPerMultiprocessor(&per_cu, (const void*)mega_fwd, NTHREADS, LDS_BYTES) != hipSuccess || per_cu < 1) { fprintf(stderr, "kernel_launch: occupancy query failed\n"); per_cu = 1; }
        if (per_cu > 2) per_cu = 2;
        (void)hipGetLastError();
        grid_blocks = cus * per_cu;
        fprintf(stderr, "kernel_launch: %d CUs x %d blocks\n", cus, per_cu);
    }
    if (grid_blocks < 0) return;
    Params p{};
    p.x = (const float*)d_in[0]; p.w_in = (const float*)d_in[1]; p.idx_k_g = (const float*)d_in[2]; p.idx_k_b = (const float*)d_in[3]; p.sinks = (const float*)d_in[4];
    p.w_o = (const float*)d_in[5]; p.ln1_g = (const float*)d_in[6]; p.ln1_b = (const float*)d_in[7]; p.peer_wq = (const float*)d_in[8]; p.peer_subkeys = (const float*)d_in[9];
    p.peer_u = (const float*)d_in[10]; p.peer_v = (const float*)d_in[11]; p.ln2_g = (const float*)d_in[12]; p.ln2_b = (const float*)d_in[13];
    p.out = (float*)d_out; p.ws = (unsigned char*)d_ws;
    p.ph_lo = 0; p.ph_hi = NPHASE;
    void* args[] = {&p};
    hipError_t e = hipLaunchCooperativeKernel((const void*)mega_fwd, dim3(grid_blocks), dim3(NTHREADS), args, LDS_BYTES, stream);
    if (e != hipSuccess) fprintf(stderr, "cooperative launch failed: %s (grid %d)\n", hipGetErrorString(e), grid_blocks);
}
```

```cpp
#include <hip/hip_runtime.h>
#include <hip/hip_cooperative_groups.h>
#include <cstdio>
#include <cstdint>
namespace cg = cooperative_groups;

typedef unsigned short bf16_t;
typedef short bf16x8 __attribute__((ext_vector_type(8)));
typedef float f32x4 __attribute__((ext_vector_type(4)));
typedef float f32x16 __attribute__((ext_vector_type(16)));
typedef unsigned u32x4 __attribute__((ext_vector_type(4)));
typedef unsigned u32x2 __attribute__((ext_vector_type(2)));
#define DI __device__ __forceinline__

constexpr int D_MODEL = 1024, BATCH = 8, SEQ = 4096, NTOK = BATCH * SEQ;
constexpr int NMIX = 1732, NMIX_PAD = 1792;
constexpr int PEER_N = 2048;
constexpr float ALPHA = 1.189207115002721f;
constexpr float LN_EPS = 1e-5f;
constexpr int NTHREADS = 256;
constexpr int LDS_BYTES = 77824;

constexpr size_t MB = 1024 * 1024;
constexpr size_t WS_CTL   = 0;
constexpr size_t WS_BAR   = 65536;
constexpr size_t WS_ROPE  = 1 * MB;
constexpr size_t WS_WINT  = 2 * MB;
constexpr size_t WS_WOT   = 6 * MB;
constexpr size_t WS_WQT   = 8 * MB;
constexpr size_t WS_SK    = 12 * MB;
constexpr size_t WS_UT    = 13 * MB;
constexpr size_t WS_VT    = 29 * MB;
constexpr size_t WS_SU    = 45 * MB;
constexpr size_t WS_SV    = 46 * MB;
constexpr size_t WS_XB    = 77 * MB;
constexpr size_t WS_QA    = 141 * MB;
constexpr size_t WS_KA    = 173 * MB;
constexpr size_t WS_VA    = 181 * MB;
constexpr size_t WS_QB    = 189 * MB;
constexpr size_t WS_KB    = 221 * MB;
constexpr size_t WS_VB    = 225 * MB;
constexpr size_t WS_QI    = 229 * MB;
constexpr size_t WS_KI    = 245 * MB;
constexpr size_t WS_WI    = 249 * MB;
constexpr size_t WS_ATT   = 250 * MB;
constexpr size_t WS_PE    = 314 * MB;
constexpr size_t WS_PG    = 322 * MB;
constexpr size_t WS_PS    = 338 * MB;
constexpr size_t WS_END   = 354 * MB;

struct Params {
    const float* x; const float* w_in; const float* idx_k_g; const float* idx_k_b; const float* sinks; const float* w_o;
    const float* ln1_g; const float* ln1_b; const float* peer_wq; const float* peer_subkeys; const float* peer_u; const float* peer_v;
    const float* ln2_g; const float* ln2_b;
    float* out; unsigned char* ws;
    int ph_lo, ph_hi;
};

DI unsigned f2bf(float x) { unsigned u = __float_as_uint(x); u += 0x7fffu + ((u >> 16) & 1u); return u >> 16; }
DI unsigned pack_bf16(float lo, float hi) { return f2bf(lo) | (f2bf(hi) << 16); }
DI float bf_lo(unsigned w) { return __uint_as_float(w << 16); }
DI float bf_hi(unsigned w) { return __uint_as_float(w & 0xffff0000u); }
DI bf16x8 as_bf16x8(u32x4 v) { return __builtin_bit_cast(bf16x8, v); }
DI u32x4 ldg16(const void* p) { return *(const u32x4*)p; }
DI f32x4 mfma16(bf16x8 a, bf16x8 b, f32x4 c) { return __builtin_amdgcn_mfma_f32_16x16x32_bf16(a, b, c, 0, 0, 0); }
DI f32x16 mfma32(bf16x8 a, bf16x8 b, f32x16 c) { return __builtin_amdgcn_mfma_f32_32x32x16_bf16(a, b, c, 0, 0, 0); }
DI float wave_sum(float v) {
#pragma unroll
    for (int o = 32; o >= 1; o >>= 1) v += __shfl_xor(v, o);
    return v;
}

DI void glds16(const void* src, void* lds_dst) { __builtin_amdgcn_global_load_lds((const unsigned*)src, (__attribute__((address_space(3))) unsigned*)lds_dst, 16, 0, 0); }
DI void gemm_128x128(const bf16_t* __restrict__ X, int ldx, const bf16_t* __restrict__ Wt, int ldw, int K, unsigned char* lds, f32x4 (&acc)[4][4]) {
    int tid = threadIdx.x; asm volatile("" : "+v"(tid));
    const int lane = tid & 63, wave = tid >> 6, wm = wave >> 1, wn = wave & 1, c = lane & 15, g = lane >> 4;
    const int lrow = tid >> 3, lch = tid & 7;
    const bf16_t* xp = X + (size_t)lrow * ldx + ((lch ^ (lrow & 7)) * 8);
    const bf16_t* wp = Wt + (size_t)lrow * ldw + ((lch ^ (lrow & 7)) * 8);
    unsigned char* dst0 = lds + tid * 16;
#pragma unroll
    for (int m = 0; m < 4; ++m)
#pragma unroll
        for (int n = 0; n < 4; ++n) acc[m][n] = (f32x4){0.f, 0.f, 0.f, 0.f};
    const int nk = K / 64;
    __syncthreads();
#pragma unroll
    for (int i = 0; i < 4; ++i) { glds16(xp + (size_t)(32 * i) * ldx, dst0 + i * 4096); glds16(wp + (size_t)(32 * i) * ldw, dst0 + 16384 + i * 4096); }
    asm volatile("s_waitcnt vmcnt(0)" ::: "memory");
    __syncthreads();
    for (int kt = 0; kt < nk; ++kt) {
        const unsigned char* Xs = lds + (kt & 1) * 32768; const unsigned char* Ws = Xs + 16384;
        if (kt + 1 < nk) {
            unsigned char* d = dst0 + ((kt + 1) & 1) * 32768;
#pragma unroll
            for (int i = 0; i < 4; ++i) { glds16(xp + (size_t)(32 * i) * ldx + (kt + 1) * 64, d + i * 4096); glds16(wp + (size_t)(32 * i) * ldw + (kt + 1) * 64, d + 16384 + i * 4096); }
        }
#pragma unroll
        for (int s = 0; s < 2; ++s) {
            bf16x8 xf[4], wf[4];
#pragma unroll
            for (int m = 0; m < 4; ++m) { const int row = wm * 64 + m * 16 + c; xf[m] = as_bf16x8(*(const u32x4*)(Xs + row * 128 + (((4 * s + g) ^ (c & 7)) << 4))); }
#pragma unroll
            for (int n = 0; n < 4; ++n) { const int row = wn * 64 + n * 16 + c; wf[n] = as_bf16x8(*(const u32x4*)(Ws + row * 128 + (((4 * s + g) ^ (c & 7)) << 4))); }
#pragma unroll
            for (int m = 0; m < 4; ++m)
#pragma unroll
                for (int n = 0; n < 4; ++n) acc[m][n] = mfma16(wf[n], xf[m], acc[m][n]);
        }
        asm volatile("s_waitcnt vmcnt(0)" ::: "memory");
        __syncthreads();
    }
}

DI bool tile_of(int k, int NT, int MT, int& mt, int& nt) {
    const int G = gridDim.x, bid = blockIdx.x;
    if (((G | MT) & 7) == 0) {
        const int idx = (bid >> 3) + k * (G >> 3);
        if (idx >= (MT >> 3) * NT) return false;
        mt = (idx / NT) * 8 + (bid & 7); nt = idx % NT;
    } else {
        const int t = bid + k * G;
        if (t >= MT * NT) return false;
        mt = t / NT; nt = t % NT;
    }
    return true;
}

DI void p0_prep(const Params& p, unsigned char* lds) {
    const int tid = threadIdx.x, nb = gridDim.x, bid = blockIdx.x;
    const size_t gtid = (size_t)bid * NTHREADS + tid, gsz = (size_t)nb * NTHREADS;
    unsigned char* ws = p.ws;
    {
        float* ct = (float*)(ws + WS_ROPE); float* stb = ct + SEQ * 32;
        for (size_t i = gtid; i < (size_t)SEQ * 32; i += gsz) {
            const int pos = (int)(i >> 5), fi = (int)(i & 31);
            const float inv = powf(10000.0f, -(float)(2 * fi) / 64.0f);
            const float ang = (float)pos * inv;
            ct[i] = cosf(ang); stb[i] = sinf(ang);
        }
    }
    auto conv = [&](const float* src, bf16_t* dst, size_t n) {
        for (size_t i = gtid * 8; i < n; i += gsz * 8) {
            const f32x4 a = *(const f32x4*)(src + i), b = *(const f32x4*)(src + i + 4);
            u32x4 o; o.x = pack_bf16(a.x, a.y); o.y = pack_bf16(a.z, a.w); o.z = pack_bf16(b.x, b.y); o.w = pack_bf16(b.z, b.w);
            *(u32x4*)(dst + i) = o;
        }
    };
    conv(p.x, (bf16_t*)(ws + WS_XB), (size_t)NTOK * D_MODEL);
    {
        const int lane = tid & 63, gw = bid * 4 + (tid >> 6), nw = nb * 4;
        for (int row = gw; row < 2 * 16384; row += nw) {
            const bool isv = row >= 16384; const int e = isv ? row - 16384 : row;
            const float* src = (isv ? p.peer_v : p.peer_u) + (size_t)e * 1024 + lane * 16;
            f32x4 v[4]; float mx = 0.f;
#pragma unroll
            for (int i = 0; i < 4; ++i) { v[i] = *(const f32x4*)(src + 4 * i); mx = fmaxf(mx, fmaxf(fmaxf(fabsf(v[i][0]), fabsf(v[i][1])), fmaxf(fabsf(v[i][2]), fabsf(v[i][3])))); }
#pragma unroll
            for (int o = 32; o >= 1; o >>= 1) mx = fmaxf(mx, __shfl_xor(mx, o));
            const float sc = mx > 0.f ? mx * (1.0f / 440.0f) : 1.0f, inv = mx > 0.f ? 440.0f / mx : 1.0f;
            u32x4 o4;
#pragma unroll
            for (int i = 0; i < 4; ++i) {
                int w = 0;
                w = __builtin_amdgcn_cvt_pk_fp8_f32(v[i][0] * inv, v[i][1] * inv, w, false);
                w = __builtin_amdgcn_cvt_pk_fp8_f32(v[i][2] * inv, v[i][3] * inv, w, true);
                o4[i] = (unsigned)w;
            }
            *(u32x4*)(ws + (isv ? WS_VT : WS_UT) + (size_t)e * 1024 + lane * 16) = o4;
            if (lane == 0) ((float*)(ws + (isv ? WS_SV : WS_SU)))[e] = sc;
        }
    }
    conv(p.peer_subkeys, (bf16_t*)(ws + WS_SK), (size_t)8 * 2 * 128 * 128);
    float* tl = (float*)lds;
    auto transp = [&](const float* src, bf16_t* dst, int N, int Npad) {
        const int tn = Npad / 64, tk = 1024 / 64;
        for (int t = bid; t < tn * tk; t += nb) {
            const int n0 = (t % tn) * 64, k0 = (t / tn) * 64;
            __syncthreads();
            for (int e = tid; e < 4096; e += NTHREADS) { const int kk = e >> 6, nn = e & 63; tl[kk * 65 + nn] = (n0 + nn < N) ? src[(size_t)(k0 + kk) * N + n0 + nn] : 0.f; }
            __syncthreads();
            for (int e = tid; e < 4096; e += NTHREADS) { const int nn = e >> 6, kk = e & 63; dst[(size_t)(n0 + nn) * 1024 + k0 + kk] = (bf16_t)f2bf(tl[kk * 65 + nn]); }
        }
    };
    transp(p.w_in, (bf16_t*)(ws + WS_WINT), NMIX, NMIX_PAD);
    transp(p.w_o, (bf16_t*)(ws + WS_WOT), 1024, 1024);
    transp(p.peer_wq, (bf16_t*)(ws + WS_WQT), PEER_N, PEER_N);
}

DI void p1_inproj(const Params& p, unsigned char* lds) {
    unsigned char* ws = p.ws;
    const bf16_t* XB = (const bf16_t*)(ws + WS_XB); const bf16_t* WT = (const bf16_t*)(ws + WS_WINT);
    const float* cosT = (const float*)(ws + WS_ROPE); const float* sinT = cosT + SEQ * 32;
    const int tid = threadIdx.x, lane = tid & 63, wave = tid >> 6, wm = wave >> 1, wn = wave & 1, c = lane & 15, g = lane >> 4;
    constexpr int NT = NMIX_PAD / 128, MT = NTOK / 128;
    int mt, nt;
    for (int k = 0; tile_of(k, NT, MT, mt, nt); ++k) {
        f32x4 acc[4][4];
        gemm_128x128(XB + (size_t)mt * 128 * 1024, 1024, WT + (size_t)nt * 128 * 1024, 1024, 1024, lds, acc);
        const int col64 = nt * 2 + wn;
        bf16_t* dst; int ld, coff; bool rope = true; float scale = 1.f;
        if (col64 < 8)       { dst = (bf16_t*)(ws + WS_QA); ld = 512; coff = col64 * 64; scale = 0.125f; }
        else if (col64 < 10) { dst = (bf16_t*)(ws + WS_KA); ld = 128; coff = (col64 - 8) * 64; }
        else if (col64 < 12) { dst = (bf16_t*)(ws + WS_VA); ld = 128; coff = (col64 - 10) * 64; rope = false; }
        else if (col64 < 20) { dst = (bf16_t*)(ws + WS_QB); ld = 512; coff = (col64 - 12) * 64; scale = 0.125f; }
        else if (col64 == 20) { dst = (bf16_t*)(ws + WS_KB); ld = 64; coff = 0; }
        else if (col64 == 21) { dst = (bf16_t*)(ws + WS_VB); ld = 64; coff = 0; rope = false; }
        else if (col64 < 26) { dst = (bf16_t*)(ws + WS_QI); ld = 256; coff = (col64 - 22) * 64; }
        else                 { dst = (bf16_t*)(ws + WS_KI); ld = 64; coff = 0; }
        if (col64 == 27) {
            if (g == 0) {
#pragma unroll
                for (int m = 0; m < 4; ++m) { const int tok = mt * 128 + wm * 64 + m * 16 + c; *(f32x4*)((float*)(ws + WS_WI) + (size_t)tok * 4) = acc[m][0] * 0.0625f; }
            }
            continue;
        }
#pragma unroll
        for (int m = 0; m < 4; ++m) {
            const int tok = mt * 128 + wm * 64 + m * 16 + c, pos = tok & (SEQ - 1);
            f32x4 v[4] = {acc[m][0], acc[m][1], acc[m][2], acc[m][3]};
            if (col64 == 26) {
                float s = 0.f;
#pragma unroll
                for (int n = 0; n < 4; ++n) s += (v[n][0] + v[n][1]) + (v[n][2] + v[n][3]);
                s += __shfl_xor(s, 16); s += __shfl_xor(s, 32);
                const float mu = s * (1.f / 64.f); float q = 0.f;
#pragma unroll
                for (int n = 0; n < 4; ++n) { const f32x4 d = v[n] - mu; q += (d[0] * d[0] + d[1] * d[1]) + (d[2] * d[2] + d[3] * d[3]); }
                q += __shfl_xor(q, 16); q += __shfl_xor(q, 32);
                const float rstd = rsqrtf(q * (1.f / 64.f) + LN_EPS);
#pragma unroll
                for (int n = 0; n < 4; ++n) {
                    const f32x4 gg = *(const f32x4*)(p.idx_k_g + 16 * n + 4 * g), bb = *(const f32x4*)(p.idx_k_b + 16 * n + 4 * g);
                    v[n] = (v[n] - mu) * rstd * gg + bb;
                }
            }
            if (rope) {
#pragma unroll
                for (int n = 0; n < 2; ++n) {
                    const f32x4 cs = *(const f32x4*)(cosT + pos * 32 + 16 * n + 4 * g), sn = *(const f32x4*)(sinT + pos * 32 + 16 * n + 4 * g);
                    const f32x4 t1 = v[n], t2 = v[n + 2];
                    v[n] = t1 * cs - t2 * sn; v[n + 2] = t2 * cs + t1 * sn;
                }
            }
#pragma unroll
            for (int n = 0; n < 4; ++n) {
                const f32x4 o = v[n] * scale; u32x2 w; w.x = pack_bf16(o[0], o[1]); w.y = pack_bf16(o[2], o[3]);
                *(u32x2*)(dst + (size_t)tok * ld + coff + 16 * n + 4 * g) = w;
            }
        }
    }
}

constexpr int NDSA = NTOK / 4, NSWA = BATCH * 32 * 8;
constexpr int P2_SC = 0, P2_STG = 32768  , P2_LIST = 65536;

DI unsigned f16_key(float v) {
    _Float16 hv = (_Float16)v; unsigned short hb = __builtin_bit_cast(unsigned short, hv); unsigned b = hb;
    if (b == 0x8000u) b = 0u;
    return (b & 0x8000u) ? ((~b) & 0xffffu) : (b | 0x8000u);
}

template <int MODE> DI void p2_dsa_item(const Params& p, unsigned char* lds, int b, int tb) {
    unsigned char* ws = p.ws;
    const bf16_t* QI = (const bf16_t*)(ws + WS_QI); const bf16_t* KI = (const bf16_t*)(ws + WS_KI); const float* WI = (const float*)(ws + WS_WI);
    const bf16_t* QB = (const bf16_t*)(ws + WS_QB); const bf16_t* KB = (const bf16_t*)(ws + WS_KB); const bf16_t* VB = (const bf16_t*)(ws + WS_VB);
    bf16_t* ATT = (bf16_t*)(ws + WS_ATT);
    int tid = threadIdx.x; asm volatile("" : "+v"(tid));
    const int lane = tid & 63, wave = __builtin_amdgcn_readfirstlane(tid >> 6), c = lane & 15, g = lane >> 4;
    const int t0 = tb * 4, tok0 = b * SEQ + t0;
    unsigned short* sc = (unsigned short*)(lds + P2_SC);
    unsigned char* stg = lds + P2_STG + wave * 8192;
    unsigned* hist = (unsigned*)stg;
    unsigned short* list = (unsigned short*)(lds + P2_LIST) + wave * 256;
    const int tok = tok0 + wave;
    {
        bf16x8 af[2];
#pragma unroll
        for (int s = 0; s < 2; ++s) af[s] = as_bf16x8(ldg16(QI + (size_t)(tok0 + (c >> 2)) * 256 + (c & 3) * 64 + 32 * s + 8 * g));
        const f32x4 wv = *(const f32x4*)(WI + (size_t)(tok0 + g) * 4);
        const int ntile = (t0 + 4 + 15) >> 4, ngrp = ((ntile + 31) & ~31) >> 2;
        const unsigned char* kib = (const unsigned char*)(KI + (size_t)b * SEQ * 64);
        const int lr = lane >> 3, lc = lane & 7;
        const unsigned st_off = lr * 128 + ((lc ^ lr) << 4);
        asm volatile("" :: "v"(af[0]), "v"(af[1]), "v"(wv));
        auto ldgrp = [&](int gg, u32x4 (&dst)[8]) {
            gg = gg < ngrp ? gg : ngrp - 1;
#pragma unroll
            for (int i = 0; i < 8; ++i) dst[i] = ldg16(kib + (size_t)(gg * 64 + i * 8 + lr) * 128 + lc * 16);
        };
        auto proc = [&](int gg, const u32x4 (&src)[8]) {
#pragma unroll
            for (int i = 0; i < 8; ++i) *(u32x4*)(stg + i * 1024 + st_off) = src[i];
            bf16x8 k0[4], k1[4];
#pragma unroll
            for (int u = 0; u < 4; ++u) {
                k0[u] = as_bf16x8(*(const u32x4*)(stg + (16 * u + c) * 128 + ((g ^ (c & 7)) << 4)));
                k1[u] = as_bf16x8(*(const u32x4*)(stg + (16 * u + c) * 128 + (((4 + g) ^ (c & 7)) << 4)));
            }
            unsigned short res[4];
#pragma unroll
            for (int u = 0; u < 4; ++u) {
                f32x4 d = mfma16(af[0], k0[u], (f32x4){0.f, 0.f, 0.f, 0.f});
                d = mfma16(af[1], k1[u], d);
                const float s = wv[0] * fmaxf(d[0], 0.f) + wv[1] * fmaxf(d[1], 0.f) + wv[2] * fmaxf(d[2], 0.f) + wv[3] * fmaxf(d[3], 0.f);
                const int key = gg * 64 + u * 16 + c;
                res[u] = (key <= t0 + g) ? (unsigned short)f16_key(s) : (unsigned short)0;
            }
#pragma unroll
            for (int u = 0; u < 4; ++u) sc[g * 4096 + gg * 64 + u * 16 + c] = res[u];
        };
        u32x4 r0[8], r1[8], r2[8];
        ldgrp(wave, r0); ldgrp(wave + 4, r1); ldgrp(wave + 8, r2);
        for (int gi = wave; gi < ngrp; gi += 12) {
            proc(gi, r0); ldgrp(gi + 12, r0);
            if (gi + 4 < ngrp) proc(gi + 4, r1);
            ldgrp(gi + 16, r1);
            if (gi + 8 < ngrp) proc(gi + 8, r2);
            ldgrp(gi + 20, r2);
        }
    }
    __syncthreads();
    if (!(MODE & 2)) return;
    const int n = t0 + wave + 1;
    const int L = n < 256 ? n : 256;
    const unsigned short* myk = sc + wave * 4096;
    if (n <= 256) {
        for (int i = lane; i < n; i += 64) list[i] = (unsigned short)i;
    } else {
        u32x4 kk[8];
#pragma unroll
        for (int i = 0; i < 8; ++i) kk[i] = (512 * i < n) ? *(const u32x4*)(myk + 512 * i + 8 * lane) : (u32x4){0u, 0u, 0u, 0u};
#pragma unroll
        for (int i = 0; i < 4; ++i) *(u32x4*)(hist + lane * 16 + i * 4) = (u32x4){0u, 0u, 0u, 0u};
#pragma unroll
        for (int i = 0; i < 8; ++i) {
            if (512 * i < n) {
#pragma unroll
                for (int w = 0; w < 4; ++w) { const unsigned wd = kk[i][w]; atomicAdd(&hist[(wd & 0xffffu) >> 6], 1u); atomicAdd(&hist[wd >> 22], 1u); }
            }
        }
        unsigned h[16];
#pragma unroll
        for (int i = 0; i < 4; ++i) { const u32x4 t = *(const u32x4*)(hist + lane * 16 + i * 4); h[4 * i] = t.x; h[4 * i + 1] = t.y; h[4 * i + 2] = t.z; h[4 * i + 3] = t.w; }
#pragma unroll
        for (int i = 0; i < 4; ++i) *(u32x4*)(hist + lane * 16 + i * 4) = (u32x4){0u, 0u, 0u, 0u};
        unsigned sl = 0;
#pragma unroll
        for (int i = 0; i < 16; ++i) sl += h[i];
        unsigned pre = sl;
#pragma unroll
        for (int o = 1; o < 64; o <<= 1) { const unsigned t = __shfl_up(pre, o); if (lane >= o) pre += t; }
        const unsigned tot = __shfl(pre, 63);
        const unsigned suf = tot - pre;
        int found = -1; unsigned cab = 0, cum = suf;
#pragma unroll
        for (int j = 15; j >= 0; --j) { const bool hit = (found < 0) && (cum + h[j] >= 256u); if (hit) { found = lane * 16 + j; cab = cum; } cum += h[j]; }
        const bool mine = (suf < 256u) && (suf + sl >= 256u);
        const unsigned long long mm = __ballot(mine);
        const int src = __ffsll((long long)mm) - 1;
        const unsigned bstar = (unsigned)__shfl(found, src), cabove = __shfl(cab, src);
        const unsigned r1 = 256u - cabove;
#pragma unroll
        for (int i = 0; i < 8; ++i) {
            if (512 * i < n) {
#pragma unroll
                for (int w = 0; w < 4; ++w) {
                    const unsigned wd = kk[i][w];
                    if (((wd & 0xffffu) >> 6) == bstar) atomicAdd(&hist[wd & 63u], 1u);
                    if ((wd >> 22) == bstar) atomicAdd(&hist[(wd >> 16) & 63u], 1u);
                }
            }
        }
        const unsigned cnt = hist[lane];
        hist[lane] = 0u;
        unsigned pre2 = cnt;
#pragma unroll
        for (int o = 1; o < 64; o <<= 1) { const unsigned t = __shfl_up(pre2, o); if (lane >= o) pre2 += t; }
        const unsigned tot2 = __shfl(pre2, 63);
        const unsigned suf2 = tot2 - pre2;
        const bool mine2 = (suf2 < r1) && (suf2 + cnt >= r1);
        const unsigned long long mm2 = __ballot(mine2);
        const int src2 = __ffsll((long long)mm2) - 1;
        const unsigned T = (bstar << 6) | (unsigned)src2;
        const unsigned req = r1 - __shfl(suf2, src2);
        const unsigned toteq = __shfl(cnt, src2);
        const bool alleq = (req == toteq);
        const unsigned Tt = alleq ? T : T + 1u;
        unsigned cg = 0;
#pragma unroll
        for (int i = 0; i < 8; ++i)
#pragma unroll
            for (int w = 0; w < 4; ++w) { const unsigned wd = kk[i][w]; cg += ((wd & 0xffffu) >= Tt) ? 1u : 0u; cg += ((wd >> 16) >= Tt) ? 1u : 0u; }
        unsigned pre3 = cg;
#pragma unroll
        for (int o = 1; o < 64; o <<= 1) { const unsigned t = __shfl_up(pre3, o); if (lane >= o) pre3 += t; }
        unsigned off = pre3 - cg;
#pragma unroll
        for (int i = 0; i < 8; ++i)
#pragma unroll
            for (int w = 0; w < 4; ++w) {
                const unsigned wd = kk[i][w]; const int idx = 512 * i + 8 * lane + 2 * w;
                if ((wd & 0xffffu) >= Tt) { list[off & 255u] = (unsigned short)idx; ++off; }
                if ((wd >> 16) >= Tt) { list[off & 255u] = (unsigned short)(idx + 1); ++off; }
            }
        if (!alleq) {
            const unsigned cgt = 256u - req; unsigned eq_run = 0;
            for (int base = 0; base < n; base += 64) {
                const int i = base + lane; const unsigned m = (i < n) ? myk[i] : 0u;
                const bool eq = (m == T);
                const unsigned long long eqm = __ballot(eq);
                const unsigned rank = eq_run + __builtin_amdgcn_mbcnt_hi((unsigned)(eqm >> 32), __builtin_amdgcn_mbcnt_lo((unsigned)eqm, 0u));
                if (eq && rank < req) list[cgt + rank] = (unsigned short)i;
                eq_run += (unsigned)__popcll(eqm);
            }
        }
    }
    if (!(MODE & 4)) return;
    bf16x8 qf[2], sel[2];
#pragma unroll
    for (int s = 0; s < 2; ++s) {
        u32x4 t = (u32x4){0u, 0u, 0u, 0u};
        if (c < 8) t = ldg16(QB + (size_t)tok * 512 + c * 64 + 32 * s + 8 * g);
        qf[s] = as_bf16x8(t);
#pragma unroll
        for (int j = 0; j < 8; ++j) sel[s][j] = (8 * g + j == 16 * s + c) ? (short)0x3F80 : (short)0;
    }
    f32x4 st[16];
    const unsigned char* kbb = (const unsigned char*)(KB + (size_t)b * SEQ * 64); const unsigned char* vbb = (const unsigned char*)(VB + (size_t)b * SEQ * 64);
    const int lr = lane >> 3, lc = lane & 7;
    const unsigned st_off = lr * 128 + ((lc ^ lr) << 4);
    auto loadg = [&](const unsigned char* base, int T0, u32x4 (&dst)[8]) {
#pragma unroll
        for (int i = 0; i < 8; ++i) {
            const int idx = T0 * 16 + i * 8 + lr; const unsigned kid = (idx < L) ? (unsigned)list[idx] : 0u;
            dst[i] = ldg16(base + kid * 128u + lc * 16u);
        }
    };
    auto stage = [&](const u32x4 (&src)[8]) {
#pragma unroll
        for (int i = 0; i < 8; ++i) *(u32x4*)(stg + i * 1024 + st_off) = src[i];
    };
    auto frag = [&](int u, int s2) -> bf16x8 { return as_bf16x8(*(const u32x4*)(stg + (16 * u + c) * 128 + (((4 * s2 + g) ^ (c & 7)) << 4))); };
    auto scoreK = [&](int T0) {
#pragma unroll
        for (int T = 0; T < 4; ++T) {
            f32x4 d = mfma16(frag(T, 0), qf[0], (f32x4){0.f, 0.f, 0.f, 0.f});
            st[T0 + T] = mfma16(frag(T, 1), qf[1], d);
        }
    };
    u32x4 rA[8], rB[8], rC[8], rD[8];
    loadg(kbb, 0, rA); loadg(kbb, 4, rB); loadg(kbb, 8, rC); loadg(kbb, 12, rD);
    __builtin_amdgcn_sched_barrier(0);
    stage(rA); scoreK(0);
    stage(rB); scoreK(4);
    __builtin_amdgcn_sched_barrier(0);
    loadg(vbb, 0, rA); loadg(vbb, 4, rB);
    stage(rC); scoreK(8);
    stage(rD); scoreK(12);
    __builtin_amdgcn_sched_barrier(0);
    float mx = -3.0e38f;
    {
        const int lrem = L - 4 * g;
#pragma unroll
        for (int T = 0; T < 16; ++T)
#pragma unroll
            for (int r = 0; r < 4; ++r) { const float sv = (T * 16 + r < lrem) ? st[T][r] : -3.0e38f; st[T][r] = sv; mx = fmaxf(mx, sv); }
    }
    mx = fmaxf(mx, __shfl_xor(mx, 16)); mx = fmaxf(mx, __shfl_xor(mx, 32));
    float lsum = 0.f;
#pragma unroll
    for (int T = 0; T < 16; ++T)
#pragma unroll
        for (int r = 0; r < 4; ++r) { const float e = __expf(st[T][r] - mx); st[T][r] = e; lsum += e; }
    lsum += __shfl_xor(lsum, 16); lsum += __shfl_xor(lsum, 32);
    const float rl = 1.0f / lsum;
    u32x4 pfv[8];
#pragma unroll
    for (int u = 0; u < 8; ++u) {
        const int Ta = 2 * u, Tb = Ta + 1;
        pfv[u].x = pack_bf16(st[Ta][0] * rl, st[Ta][1] * rl); pfv[u].y = pack_bf16(st[Ta][2] * rl, st[Ta][3] * rl);
        pfv[u].z = pack_bf16(st[Tb][0] * rl, st[Tb][1] * rl); pfv[u].w = pack_bf16(st[Tb][2] * rl, st[Tb][3] * rl);
    }
    __builtin_amdgcn_sched_barrier(0);
    f32x4 O[4];
#pragma unroll
    for (int cb = 0; cb < 4; ++cb) O[cb] = (f32x4){0.f, 0.f, 0.f, 0.f};
    auto pv = [&](int T0) {
#pragma unroll
        for (int u = 0; u < 2; ++u) {
            const u32x4 pf = pfv[(T0 >> 1) + u];
#pragma unroll
            for (int cb = 0; cb < 4; ++cb) {
                const f32x4 z = (f32x4){0.f, 0.f, 0.f, 0.f};
                const f32x4 v0 = mfma16(frag(2 * u, cb >> 1), sel[cb & 1], z), v1 = mfma16(frag(2 * u + 1, cb >> 1), sel[cb & 1], z);
                u32x4 vf; vf.x = pack_bf16(v0[0], v0[1]); vf.y = pack_bf16(v0[2], v0[3]); vf.z = pack_bf16(v1[0], v1[1]); vf.w = pack_bf16(v1[2], v1[3]);
                O[cb] = mfma16(as_bf16x8(pf), as_bf16x8(vf), O[cb]);
            }
        }
    };
    loadg(vbb, 8, rC); loadg(vbb, 12, rD);
    __builtin_amdgcn_sched_barrier(0);
    stage(rA); pv(0);
    stage(rB); pv(4);
    __builtin_amdgcn_sched_barrier(0);
    stage(rC); pv(8);
    stage(rD); pv(12);
    if (g < 2) {
#pragma unroll
        for (int cb = 0; cb < 4; ++cb)
#pragma unroll
            for (int r = 0; r < 4; ++r) ATT[(size_t)tok * 1024 + 512 + (4 * g + r) * 64 + 16 * cb + c] = (bf16_t)f2bf(O[cb][r]);
    }
}

DI void p2_swa_item(const Params& p, int item2) {
    unsigned char* ws = p.ws;
    const bf16_t* QA = (const bf16_t*)(ws + WS_QA); const bf16_t* KA = (const bf16_t*)(ws + WS_KA); const bf16_t* VA = (const bf16_t*)(ws + WS_VA);
    bf16_t* ATT = (bf16_t*)(ws + WS_ATT);
    int tid = threadIdx.x; asm volatile("" : "+v"(tid));
    const int lane = tid & 63, wave = __builtin_amdgcn_readfirstlane(tid >> 6), r = lane & 31, h = lane >> 5;
    const int hq = item2 & 7, blk = (item2 >> 3) & 31, b = item2 >> 8, kvh = hq >> 2;
    const int qi = 32 * wave + r, tokq = b * SEQ + blk * 128 + qi;
    bf16x8 qf[4], sel[2];
#pragma unroll
    for (int s = 0; s < 4; ++s) qf[s] = as_bf16x8(ldg16(QA + (size_t)tokq * 512 + hq * 64 + 16 * s + 8 * h));
#pragma unroll
    for (int x = 0; x < 2; ++x)
#pragma unroll
        for (int j = 0; j < 8; ++j) sel[x][j] = (8 * h + j + 16 * x == r) ? (short)0x3F80 : (short)0;
    const float sink = p.sinks[hq];
    f32x16 ST[5];
#pragma unroll
    for (int ti = 0; ti < 5; ++ti) {
        const int sj = 32 * (wave + ti) + r; int pos = blk * 128 - 128 + sj; pos = pos < 0 ? 0 : pos;
        const bf16_t* kp = KA + (size_t)(b * SEQ + pos) * 128 + kvh * 64 + 8 * h;
        f32x16 d; for (int i = 0; i < 16; ++i) d[i] = 0.f;
#pragma unroll
        for (int s = 0; s < 4; ++s) d = mfma32(as_bf16x8(ldg16(kp + 16 * s)), qf[s], d);
        ST[ti] = d;
    }
    float mx = sink;
    {
        const int lo = r + 1 - 4 * h;
        const int lo0 = (blk > 0) ? lo : (lo > 128 - 32 * wave - 4 * h ? lo : 128 - 32 * wave - 4 * h);
#pragma unroll
        for (int ti = 0; ti < 5; ++ti)
#pragma unroll
            for (int reg = 0; reg < 16; ++reg) {
                const int e = 32 * ti + (reg & 3) + 8 * (reg >> 2);
                const float sv = (e >= lo0 && e < lo + 128) ? ST[ti][reg] : -3.0e38f; ST[ti][reg] = sv; mx = fmaxf(mx, sv);
            }
    }
    mx = fmaxf(mx, __shfl_xor(mx, 32));
    float lsum = 0.f;
#pragma unroll
    for (int ti = 0; ti < 5; ++ti)
#pragma unroll
        for (int reg = 0; reg < 16; ++reg) { const float e = __expf(ST[ti][reg] - mx); ST[ti][reg] = e; lsum += e; }
    lsum += __shfl_xor(lsum, 32);
    lsum += __expf(sink - mx);
    const float rl = 1.0f / lsum;
    f32x16 OT[2];
    for (int i = 0; i < 16; ++i) { OT[0][i] = 0.f; OT[1][i] = 0.f; }
#pragma unroll
    for (int ti = 0; ti < 5; ++ti) {
        const int sj = 32 * (wave + ti) + r; int pos = blk * 128 - 128 + sj; pos = pos < 0 ? 0 : pos;
        const bf16_t* vp = VA + (size_t)(b * SEQ + pos) * 128 + kvh * 64 + 8 * h;
        bf16x8 vf[4];
#pragma unroll
        for (int s = 0; s < 4; ++s) vf[s] = as_bf16x8(ldg16(vp + 16 * s));
        u32x4 pb[2];
#pragma unroll
        for (int s2 = 0; s2 < 2; ++s2) {
            pb[s2].x = pack_bf16(ST[ti][8 * s2 + 0] * rl, ST[ti][8 * s2 + 1] * rl); pb[s2].y = pack_bf16(ST[ti][8 * s2 + 2] * rl, ST[ti][8 * s2 + 3] * rl);
            pb[s2].z = pack_bf16(ST[ti][8 * s2 + 4] * rl, ST[ti][8 * s2 + 5] * rl); pb[s2].w = pack_bf16(ST[ti][8 * s2 + 6] * rl, ST[ti][8 * s2 + 7] * rl);
        }
#pragma unroll
        for (int db = 0; db < 2; ++db) {
            f32x16 vt; for (int i = 0; i < 16; ++i) vt[i] = 0.f;
            vt = mfma32(vf[2 * db], sel[0], vt); vt = mfma32(vf[2 * db + 1], sel[1], vt);
#pragma unroll
            for (int s2 = 0; s2 < 2; ++s2) {
                u32x4 va; va.x = pack_bf16(vt[8 * s2 + 0], vt[8 * s2 + 1]); va.y = pack_bf16(vt[8 * s2 + 2], vt[8 * s2 + 3]);
                va.z = pack_bf16(vt[8 * s2 + 4], vt[8 * s2 + 5]); va.w = pack_bf16(vt[8 * s2 + 6], vt[8 * s2 + 7]);
                OT[db] = mfma32(as_bf16x8(va), as_bf16x8(pb[s2]), OT[db]);
            }
        }
    }
#pragma unroll
    for (int db = 0; db < 2; ++db)
#pragma unroll
        for (int q4 = 0; q4 < 4; ++q4) {
            u32x2 w; w.x = pack_bf16(OT[db][4 * q4], OT[db][4 * q4 + 1]); w.y = pack_bf16(OT[db][4 * q4 + 2], OT[db][4 * q4 + 3]);
            *(u32x2*)(ATT + (size_t)tokq * 1024 + hq * 64 + 32 * db + 8 * q4 + 4 * h) = w;
        }
}

template <int MODE> DI void p2_attention(const Params& p, unsigned char* lds, int cidx = 0) {
    const int G = gridDim.x, bi = blockIdx.x, rounds = (1024 + G - 1) / G;
    for (int b = 0; b < BATCH; ++b)
        for (int r = 0; r < rounds; ++r) {
            const int idx = (r & 1) ? r * G + (G - 1 - bi) : r * G + bi;
            if (idx < 1024) { __syncthreads(); p2_dsa_item<MODE>(p, lds, b, 1023 - idx); }
        }
    if (MODE & 8) for (int item2 = bi; item2 < NSWA; item2 += G) p2_swa_item(p, item2);
}

DI void p3_outproj(const Params& p, unsigned char* lds) {
    unsigned char* ws = p.ws;
    const bf16_t* ATT = (const bf16_t*)(ws + WS_ATT); const bf16_t* WT = (const bf16_t*)(ws + WS_WOT);
    const int tid = threadIdx.x, lane = tid & 63, wave = tid >> 6, wm = wave >> 1, wn = wave & 1, c = lane & 15, g = lane >> 4;
    constexpr int NT = 8, MT = NTOK / 128;
    int mt, nt;
    for (int k = 0; tile_of(k, NT, MT, mt, nt); ++k) {
        f32x4 acc[4][4];
        gemm_128x128(ATT + (size_t)mt * 128 * 1024, 1024, WT + (size_t)nt * 128 * 1024, 1024, 1024, lds, acc);
#pragma unroll
        for (int m = 0; m < 4; ++m) {
            const int tok = mt * 128 + wm * 64 + m * 16 + c;
#pragma unroll
            for (int n = 0; n < 4; ++n) {
                const size_t o = (size_t)tok * 1024 + nt * 128 + wn * 64 + 16 * n + 4 * g;
                const f32x4 xv = *(const f32x4*)(p.x + o);
                *(f32x4*)(p.out + o) = xv * ALPHA + acc[m][n];
            }
        }
    }
}

DI void p3b_ln1(const Params& p) {
    bf16_t* H1B = (bf16_t*)(p.ws + WS_XB);
    const int lane = threadIdx.x & 63, gw = blockIdx.x * 4 + (threadIdx.x >> 6), nw = gridDim.x * 4;
    for (int row = gw; row < NTOK; row += nw) {
        f32x4 v[4]; float s = 0.f;
#pragma unroll
        for (int i = 0; i < 4; ++i) { v[i] = *(const f32x4*)(p.out + (size_t)row * 1024 + (lane + 64 * i) * 4); s += (v[i][0] + v[i][1]) + (v[i][2] + v[i][3]); }
        const float mu = wave_sum(s) * (1.f / 1024.f); float q = 0.f;
#pragma unroll
        for (int i = 0; i < 4; ++i) { const f32x4 d = v[i] - mu; q += (d[0] * d[0] + d[1] * d[1]) + (d[2] * d[2] + d[3] * d[3]); }
        const float rstd = rsqrtf(wave_sum(q) * (1.f / 1024.f) + LN_EPS);
#pragma unroll
        for (int i = 0; i < 4; ++i) {
            const int col = (lane + 64 * i) * 4;
            const f32x4 gg = *(const f32x4*)(p.ln1_g + col), bb = *(const f32x4*)(p.ln1_b + col);
            const f32x4 o = (v[i] - mu) * rstd * gg + bb;
            u32x2 w; w.x = pack_bf16(o[0], o[1]); w.y = pack_bf16(o[2], o[3]);
            *(u32x2*)(H1B + (size_t)row * 1024 + col) = w;
        }
    }
}

DI int f2key(float v) { const int b = __float_as_int(v); return b ^ ((b >> 31) & 0x7fffffff); }
DI float key2f(int k) { return __int_as_float(k ^ ((k >> 31) & 0x7fffffff)); }
DI void ce_desc(int& a, int& b) { const int hi = a > b ? a : b, lo = a > b ? b : a; a = hi; b = lo; }
DI void bitonic_merge16(int (&k)[16]) {
#pragma unroll
    for (int d = 8; d >= 1; d >>= 1)
#pragma unroll
        for (int i = 0; i < 16; ++i) if ((i & d) == 0) ce_desc(k[i], k[i | d]);
}
DI void bitonic_sort16(int (&k)[16]) {
#pragma unroll
    for (int sz = 2; sz <= 16; sz <<= 1) {
#pragma unroll
        for (int i = 0; i < 16; ++i) { const int j = i ^ (sz - 1); if (j > i) ce_desc(k[i], k[j]); }
#pragma unroll
        for (int d = sz >> 2; d >= 1; d >>= 1)
#pragma unroll
            for (int i = 0; i < 16; ++i) if ((i & d) == 0) ce_desc(k[i], k[i | d]);
    }
}
DI void top16_merge(int (&t)[16], const int (&sdesc)[16]) {
#pragma unroll
    for (int i = 0; i < 16; ++i) t[i] = t[i] > sdesc[15 - i] ? t[i] : sdesc[15 - i];
    bitonic_merge16(t);
}
constexpr int P4_QS = 32768, P4_SS_STRIDE = 132, P4_ST0 = 67584  , P4_M = 0  , P4_ST1 = 8704  ;

DI void p4_peer_query(const Params& p, unsigned char* lds) {
    unsigned char* ws = p.ws;
    const bf16_t* H1B = (const bf16_t*)(ws + WS_XB); const bf16_t* WQT = (const bf16_t*)(ws + WS_WQT); const bf16_t* SK = (const bf16_t*)(ws + WS_SK);
    unsigned short* PE = (unsigned short*)(ws + WS_PE); float* PG = (float*)(ws + WS_PG); float* PS = (float*)(ws + WS_PS);
    const float* SU = (const float*)(ws + WS_SU); const float* SV = (const float*)(ws + WS_SV);
    float* Ss = (float*)lds;
    float* st0 = (float*)(lds + P4_ST0); float* mbuf = (float*)(lds + P4_M); float* st1 = (float*)(lds + P4_ST1);
    constexpr int MT = NTOK / 128;
    int mt, head;
    for (int k = 0; tile_of(k, 8, MT, mt, head); ++k) {
        int tid = threadIdx.x; asm volatile("" : "+v"(tid));
        const int lane = tid & 63, wave = tid >> 6, wm = wave >> 1, wn = wave & 1, c = lane & 15, g = lane >> 4;
        const int lrow = tid >> 3, lch = tid & 7;
        const int srow = tid & 127, shalf = tid >> 7;
#pragma unroll 1
        for (int ph = 0; ph < 2; ++ph) {
            f32x4 acc[4][4];
            gemm_128x128(H1B + (size_t)mt * 128 * 1024, 1024, WQT + (size_t)(head * 256 + ph * 128) * 1024, 1024, 1024, lds, acc);
            __syncthreads();
#pragma unroll
            for (int m = 0; m < 4; ++m)
#pragma unroll
                for (int n = 0; n < 4; ++n) {
                    const int row = wm * 64 + m * 16 + c;
                    u32x2 w; w.x = pack_bf16(acc[m][n][0], acc[m][n][1]); w.y = pack_bf16(acc[m][n][2], acc[m][n][3]);
                    *(u32x2*)(lds + P4_QS + wn * 16384 + row * 128 + (((2 * n + (g >> 1)) ^ (row & 7)) << 4) + (g & 1) * 8) = w;
                }
            {
                const bf16_t* sp = SK + (size_t)((head * 2 + ph) * 128 + lrow) * 128 + lch * 8;
#pragma unroll
                for (int k2 = 0; k2 < 2; ++k2)
#pragma unroll
                    for (int i = 0; i < 4; ++i) *(u32x4*)(lds + k2 * 16384 + (lrow + 32 * i) * 128 + ((lch ^ (lrow & 7)) << 4)) = ldg16(sp + (size_t)(32 * i) * 128 + k2 * 64);
            }
            __syncthreads();
            f32x4 a2[4][4];
#pragma unroll
            for (int m = 0; m < 4; ++m)
#pragma unroll
                for (int n = 0; n < 4; ++n) a2[m][n] = (f32x4){0.f, 0.f, 0.f, 0.f};
#pragma unroll
            for (int k2 = 0; k2 < 2; ++k2)
#pragma unroll
                for (int s = 0; s < 2; ++s) {
                    bf16x8 xf[4], wf[4];
#pragma unroll
                    for (int m = 0; m < 4; ++m) { const int row = wm * 64 + m * 16 + c; xf[m] = as_bf16x8(*(const u32x4*)(lds + P4_QS + k2 * 16384 + row * 128 + (((4 * s + g) ^ (c & 7)) << 4))); }
#pragma unroll
                    for (int n = 0; n < 4; ++n) { const int row = wn * 64 + n * 16 + c; wf[n] = as_bf16x8(*(const u32x4*)(lds + k2 * 16384 + row * 128 + (((4 * s + g) ^ (c & 7)) << 4))); }
#pragma unroll
                    for (int m = 0; m < 4; ++m)
#pragma unroll
                        for (int n = 0; n < 4; ++n) a2[m][n] = mfma16(wf[n], xf[m], a2[m][n]);
                }
            __syncthreads();
#pragma unroll
            for (int m = 0; m < 4; ++m)
#pragma unroll
                for (int n = 0; n < 4; ++n) {
                    const int key0 = wn * 64 + 16 * n + 4 * g;
                    u32x4 w;
#pragma unroll
                    for (int r = 0; r < 4; ++r) w[r] = (unsigned)f2key(__uint_as_float((__float_as_uint(a2[m][n][r]) & 0xFFFFFF80u) | (unsigned)(key0 + r)));
                    *(u32x4*)(Ss + (wm * 64 + m * 16 + c) * P4_SS_STRIDE + key0) = w;
                }
            __syncthreads();
            int tv[16];
            {
                const int* rowp = (const int*)Ss + srow * P4_SS_STRIDE + shalf * 64;
#pragma unroll
                for (int bt = 0; bt < 4; ++bt) {
                    int bk[16];
#pragma unroll
                    for (int j = 0; j < 4; ++j) { const u32x4 v = *(const u32x4*)(rowp + 16 * bt + 4 * j); bk[4 * j] = (int)v.x; bk[4 * j + 1] = (int)v.y; bk[4 * j + 2] = (int)v.z; bk[4 * j + 3] = (int)v.w; }
                    bitonic_sort16(bk);
                    if (bt == 0) {
#pragma unroll
                        for (int j = 0; j < 16; ++j) tv[j] = bk[j];
                    } else top16_merge(tv, bk);
                }
            }
            __syncthreads();
            int* mbi = (int*)mbuf;
            if (shalf == 1) {
#pragma unroll
                for (int j = 0; j < 16; ++j) mbi[srow * 17 + j] = tv[j];
            }
            __syncthreads();
            if (shalf == 0) {
                int* dst = (int*)((ph == 0) ? st0 : st1);
                int ob[16];
#pragma unroll
                for (int j = 0; j < 16; ++j) ob[j] = mbi[srow * 17 + j];
                top16_merge(tv, ob);
#pragma unroll
                for (int j = 0; j < 16; ++j) dst[srow * 17 + j] = tv[j];
            }
        }
        __syncthreads();
        int cv[16];
        {
            const int* st0i = (const int*)st0; const int* st1i = (const int*)st1;
            float v2[16];
#pragma unroll
            for (int b = 0; b < 16; ++b) v2[b] = key2f(st1i[srow * 17 + b]);
#pragma unroll
            for (int a8 = 0; a8 < 8; ++a8) {
                const int a = shalf * 8 + a8; const float va = key2f(st0i[srow * 17 + a]);
                int bk[16];
#pragma unroll
                for (int b = 0; b < 16; ++b) bk[b] = (f2key(va + v2[b]) & (int)0xFFFFFF00) | (a * 16 + 15 - b);
                if (a8 == 0) {
#pragma unroll
                    for (int j = 0; j < 16; ++j) cv[j] = bk[j];
                } else top16_merge(cv, bk);
            }
        }
        __syncthreads();
        int* mbi = (int*)mbuf;
        if (shalf == 1) {
#pragma unroll
            for (int j = 0; j < 16; ++j) mbi[srow * 17 + j] = cv[j];
        }
        __syncthreads();
        if (shalf == 0) {
            const int* st0i = (const int*)st0; const int* st1i = (const int*)st1;
            int fk[16]; float fv[16];
#pragma unroll
            for (int j = 0; j < 16; ++j) { const int o = mbi[srow * 17 + 15 - j]; fk[j] = cv[j] > o ? cv[j] : o; fv[j] = key2f(fk[j]); }
            float cmax = fv[0];
#pragma unroll
            for (int j = 1; j < 16; ++j) cmax = fmaxf(cmax, fv[j]);
            float den = 0.f; float ev[16];
#pragma unroll
            for (int j = 0; j < 16; ++j) { ev[j] = __expf(fv[j] - cmax); den += ev[j]; }
            const float rden = 1.0f / den;
            const size_t ob = (size_t)(mt * 128 + srow) * 128 + head * 16;
#pragma unroll
            for (int j = 0; j < 16; ++j) {
                const unsigned cde = (unsigned)fk[j] & 0xFFu;
                const unsigned a = cde >> 4, b = 15u - (cde & 15u);
                const unsigned i1 = __float_as_uint(key2f(st0i[srow * 17 + a])) & 0x7Fu, i2 = __float_as_uint(key2f(st1i[srow * 17 + b])) & 0x7Fu;
                const int e = (int)(i1 * 128u + i2);
                PE[ob + j] = (unsigned short)e; PG[ob + j] = ev[j] * rden * SV[e]; PS[ob + j] = SU[e];
            }
        }
        __syncthreads();
    }
}

DI float gelu_exact(float z) { return 0.5f * z * (1.0f + erff(z * 0.70710678118654752f)); }
DI float rdlane(float v, int l) { return __int_as_float(__builtin_amdgcn_readlane(__float_as_int(v), l)); }

typedef float f32x2 __attribute__((ext_vector_type(2)));
DI void p5_gather(const Params& p) {
    unsigned char* ws = p.ws;
    const bf16_t* H1B = (const bf16_t*)(ws + WS_XB); const unsigned char* UT = ws + WS_UT; const unsigned char* VT = ws + WS_VT;
    const unsigned short* PE = (const unsigned short*)(ws + WS_PE); const float* PG = (const float*)(ws + WS_PG); const float* PS = (const float*)(ws + WS_PS);
    const int lane = threadIdx.x & 63, gw = blockIdx.x * 4 + (threadIdx.x >> 6), nw = gridDim.x * 4;
    const bool b5 = (lane & 32) != 0, b4 = (lane & 16) != 0, b3 = (lane & 8) != 0, b2 = (lane & 4) != 0;
    for (int tok = gw; tok < NTOK; tok += nw) {
        float x[16], acc[16];
        {
            const u32x4 xa = ldg16(H1B + (size_t)tok * 1024 + lane * 16), xb = ldg16(H1B + (size_t)tok * 1024 + lane * 16 + 8);
            x[0] = bf_lo(xa.x); x[1] = bf_hi(xa.x); x[2] = bf_lo(xa.y); x[3] = bf_hi(xa.y); x[4] = bf_lo(xa.z); x[5] = bf_hi(xa.z); x[6] = bf_lo(xa.w); x[7] = bf_hi(xa.w);
            x[8] = bf_lo(xb.x); x[9] = bf_hi(xb.x); x[10] = bf_lo(xb.y); x[11] = bf_hi(xb.y); x[12] = bf_lo(xb.z); x[13] = bf_hi(xb.z); x[14] = bf_lo(xb.w); x[15] = bf_hi(xb.w);
        }
#pragma unroll
        for (int i = 0; i < 16; ++i) acc[i] = 0.f;
        const int pe_lo = (int)PE[(size_t)tok * 128 + lane], pe_hi = (int)PE[(size_t)tok * 128 + 64 + lane];
        const float pg_lo = PG[(size_t)tok * 128 + lane], pg_hi = PG[(size_t)tok * 128 + 64 + lane];
        const float ps_lo = PS[(size_t)tok * 128 + lane], ps_hi = PS[(size_t)tok * 128 + 64 + lane];
#pragma unroll 1
        for (int hd = 0; hd < 8; ++hd) {
            const int pes = hd < 4 ? pe_lo : pe_hi; const float pgs = hd < 4 ? pg_lo : pg_hi, pss = hd < 4 ? ps_lo : ps_hi;
            const int lb = (hd & 3) * 16;
            float d[16];
#pragma unroll
            for (int j = 0; j < 16; ++j) {
                const int e = __builtin_amdgcn_readlane(pes, lb + j);
                const u32x4 uw = ldg16(UT + (size_t)e * 1024 + lane * 16);
                float s = 0.f;
#pragma unroll
                for (int k = 0; k < 4; ++k) {
                    const f32x2 f0 = __builtin_amdgcn_cvt_pk_f32_fp8((int)uw[k], false), f1 = __builtin_amdgcn_cvt_pk_f32_fp8((int)uw[k], true);
                    s = fmaf(x[4 * k], f0.x, s); s = fmaf(x[4 * k + 1], f0.y, s); s = fmaf(x[4 * k + 2], f1.x, s); s = fmaf(x[4 * k + 3], f1.y, s);
                }
                d[j] = s;
            }
            float r8[8], r4[4], r2[2], r1;
#pragma unroll
            for (int j = 0; j < 8; ++j) { const float keep = b5 ? d[j + 8] : d[j], send = b5 ? d[j] : d[j + 8]; r8[j] = keep + __shfl_xor(send, 32); }
#pragma unroll
            for (int j = 0; j < 4; ++j) { const float keep = b4 ? r8[j + 4] : r8[j], send = b4 ? r8[j] : r8[j + 4]; r4[j] = keep + __shfl_xor(send, 16); }
#pragma unroll
            for (int j = 0; j < 2; ++j) { const float keep = b3 ? r4[j + 2] : r4[j], send = b3 ? r4[j] : r4[j + 2]; r2[j] = keep + __shfl_xor(send, 8); }
            { const float keep = b2 ? r2[1] : r2[0], send = b2 ? r2[0] : r2[1]; r1 = keep + __shfl_xor(send, 4); }
            r1 += __shfl_xor(r1, 2); r1 += __shfl_xor(r1, 1);
            const int mine = lb + ((lane >> 2) & 15);
            const float coef = gelu_exact(r1 * __shfl(pss, mine)) * __shfl(pgs, mine);
#pragma unroll
            for (int j = 0; j < 16; ++j) {
                const int e = __builtin_amdgcn_readlane(pes, lb + j);
                const float cj = rdlane(coef, 4 * j);
                const u32x4 vw = ldg16(VT + (size_t)e * 1024 + lane * 16);
#pragma unroll
                for (int k = 0; k < 4; ++k) {
                    const f32x2 f0 = __builtin_amdgcn_cvt_pk_f32_fp8((int)vw[k], false), f1 = __builtin_amdgcn_cvt_pk_f32_fp8((int)vw[k], true);
                    acc[4 * k] = fmaf(cj, f0.x, acc[4 * k]); acc[4 * k + 1] = fmaf(cj, f0.y, acc[4 * k + 1]); acc[4 * k + 2] = fmaf(cj, f1.x, acc[4 * k + 2]); acc[4 * k + 3] = fmaf(cj, f1.y, acc[4 * k + 3]);
                }
            }
        }
        float s = 0.f;
#pragma unroll
        for (int i = 0; i < 16; ++i) { acc[i] = fmaf(ALPHA, x[i], acc[i]); s += acc[i]; }
        const float mu = wave_sum(s) * (1.f / 1024.f); float q = 0.f;
#pragma unroll
        for (int i = 0; i < 16; ++i) { const float dd = acc[i] - mu; q = fmaf(dd, dd, q); }
        const float rstd = rsqrtf(wave_sum(q) * (1.f / 1024.f) + LN_EPS);
#pragma unroll
        for (int k4 = 0; k4 < 4; ++k4) {
            const int col = lane * 16 + k4 * 4;
            const f32x4 gg = *(const f32x4*)(p.ln2_g + col), bb = *(const f32x4*)(p.ln2_b + col);
            f32x4 o;
#pragma unroll
            for (int e = 0; e < 4; ++e) o[e] = (acc[k4 * 4 + e] - mu) * rstd * gg[e] + bb[e];
            *(f32x4*)(p.out + (size_t)tok * 1024 + col) = o;
        }
    }
}

#define XB_TMO      128
#define XB_XCNT(j)  (256  + 64 * (j))
#define XB_XSUB(j)  (1280 + 64 * (j))
#define XB_XGEN(j)  (2304 + 64 * (j))
#define XB_TOP      3328
#define XB_TOPGEN   3392
#define XCD_BAR_WORDS 3456
#define XB_SPIN_CAP (1u << 22)
#define LAS __attribute__((address_space(3)))
DI unsigned xb_ld(unsigned* p)              { return __hip_atomic_load(p, __ATOMIC_RELAXED, __HIP_MEMORY_SCOPE_AGENT); }
DI unsigned xb_add(unsigned* p, unsigned v) { return __hip_atomic_fetch_add(p, v, __ATOMIC_RELAXED, __HIP_MEMORY_SCOPE_AGENT); }
DI unsigned xb_xcc_id() { return (unsigned)__builtin_amdgcn_s_getreg((3 << 11) | 20) & 0xFu; }
#define XB_SPIN(cond, bar) do { unsigned _sp = 0; while (cond) { __builtin_amdgcn_s_sleep(1); \
    if ((++_sp & 255u) == 0u) { if (xb_ld(&(bar)[XB_TMO])) break; if (_sp > XB_SPIN_CAP) { atomicAdd(&(bar)[XB_TMO], 1u); break; } } } } while (0)
struct XcdBarrier { unsigned* bar; unsigned x; volatile LAS unsigned* st; };
DI XcdBarrier xcd_barrier_post(unsigned* bar, volatile LAS unsigned* st) {
    XcdBarrier b; b.bar = bar; b.x = xb_xcc_id(); b.st = st;
    if (threadIdx.x == 0) (void)xb_add(&bar[XB_XCNT(b.x)], 1u);
    return b;
}
DI void xcd_barrier_complete(unsigned* bar, unsigned x, unsigned& nloc, unsigned& nx) {
    const unsigned G = gridDim.x * gridDim.y * gridDim.z;
    unsigned sum, cnt, mine, sp = 0u;
    for (;;) {
        sum = 0u; cnt = 0u; mine = 0u;
#pragma unroll
        for (unsigned j = 0; j < 16; ++j) { const unsigned c = xb_ld(&bar[XB_XCNT(j)]); sum += c; cnt += (c > 0u) ? 1u : 0u; mine = (j == x) ? c : mine; }
        if (sum == G) break;
        __builtin_amdgcn_s_sleep(1);
        if ((++sp & 255u) == 0u) { if (xb_ld(&bar[XB_TMO])) break; if (sp > XB_SPIN_CAP) { atomicAdd(&bar[XB_TMO], 1u); break; } }
    }
    nloc = mine > 0u ? mine : 1u; nx = cnt > 0u ? cnt : 1u;
}
DI void xcd_barrier(const XcdBarrier& b) {
    asm volatile("s_waitcnt vmcnt(0)" ::: "memory");
    __syncthreads();
    if (threadIdx.x == 0) {
        unsigned* bar = b.bar;
        __builtin_amdgcn_s_waitcnt(0);
        unsigned nloc = b.st[0], nx = b.st[1];
        if (nloc == 0u) { xcd_barrier_complete(bar, b.x, nloc, nx); b.st[0] = nloc; b.st[1] = nx; }
        const unsigned old = xb_add(&bar[XB_XSUB(b.x)], 1u);
        const unsigned gen = old / nloc;
        if (old + 1u == (gen + 1u) * nloc) {
            __builtin_amdgcn_fence(__ATOMIC_RELEASE, "agent");
            asm volatile("s_waitcnt vmcnt(0)" ::: "memory");
            const unsigned og = xb_add(&bar[XB_TOP], 1u);
            const unsigned tg = og / nx;
            if (og + 1u == (tg + 1u) * nx) xb_add(&bar[XB_TOPGEN], 1u);
            else XB_SPIN(xb_ld(&bar[XB_TOPGEN]) == tg, bar);
            __builtin_amdgcn_fence(__ATOMIC_ACQUIRE, "agent");
            xb_add(&bar[XB_XGEN(b.x)], 1u);
            asm volatile("s_waitcnt vmcnt(0)" ::: "memory");
        } else {
            XB_SPIN(xb_ld(&bar[XB_XGEN(b.x)]) == gen, bar);
            __builtin_amdgcn_fence(__ATOMIC_ACQUIRE, "agent");
            asm volatile("s_waitcnt vmcnt(0)" ::: "memory");
        }
    }
    __syncthreads();
}

constexpr int NPHASE = 7;
__global__ void __launch_bounds__(NTHREADS, 2) mega_fwd(Params p) {
    extern __shared__ __attribute__((aligned(16))) unsigned char lds[];
    cg::grid_group grid = cg::this_grid();
    const int lo = p.ph_lo, hi = p.ph_hi;
    volatile LAS unsigned* xbst = (volatile LAS unsigned*)(LAS unsigned char*)(lds + LDS_BYTES - 16);
#ifndef REP_MASK
#define REP_MASK 0
#endif
#ifndef P2_PROBE_MODE
#define P2_PROBE_MODE 15
#endif
#ifndef PH_MASK
#define PH_MASK 127
#endif
    if (lo == 0x7fffffff) grid.sync();
    if (threadIdx.x == 0) { xbst[0] = 0u; xbst[1] = 0u; }
    __syncthreads();
    XcdBarrier xb = xcd_barrier_post((unsigned*)(p.ws + WS_BAR), xbst);
#define GSYNC() xcd_barrier(xb)
    p0_prep(p, lds);
    GSYNC();
#define RUN_PHASE(k, call) { call; if ((REP_MASK >> (k)) & 1) { GSYNC(); call; } }
#if PH_MASK & 2
    RUN_PHASE(1, p1_inproj(p, lds))
#endif
    GSYNC();
#if PH_MASK & 4
#if (REP_MASK >> 2) & 1
    p2_attention<P2_PROBE_MODE>(p, lds, 1); GSYNC();
#endif
    p2_attention<15>(p, lds, 0);
#endif
    GSYNC();
#if PH_MASK & 8
    RUN_PHASE(3, p3_outproj(p, lds))
#endif
    GSYNC();
#if PH_MASK & 16
    RUN_PHASE(4, p3b_ln1(p))
#endif
    GSYNC();
#if PH_MASK & 32
    RUN_PHASE(5, p4_peer_query(p, lds))
#endif
    GSYNC();
#if PH_MASK & 64
    RUN_PHASE(6, p5_gather(p))
#endif
}

#ifndef MK_N_LAUNCHES
#define MK_N_LAUNCHES 1
#endif

extern "C" void kernel_launch(void* const* d_in, const int* in_sizes, int n_in, void* d_out, int out_size, void* d_ws, size_t ws_size, hipStream_t stream) {
    static int grid_blocks = 0;
    if (grid_blocks == 0) {
        if (n_in != 14 || out_size != NTOK * D_MODEL || ws_size < WS_END) {
            fprintf(stderr, "kernel_launch: unexpected problem (n_in %d, out %d, ws %zu, need %zu)\n", n_in, out_size, ws_size, (size_t)WS_END); grid_blocks = -1; return;
        }
        int dev = 0, cus = 0, per_cu = 0;
        hipGetDevice(&dev);
        hipDeviceGetAttribute(&cus, hipDeviceAttributeMultiprocessorCount, dev);
        if (hipFuncSetAttribute((const void*)mega_fwd, hipFuncAttributeMaxDynamicSharedMemorySize, LDS_BYTES) != hipSuccess) { fprintf(stderr, "kernel_launch: hipFuncSetAttribute failed\n"); }
        if (hipOccupancyMaxActiveBlocksPerMultiprocessor(&per_cu, (const void*)mega_fwd, NTHREADS, LDS_BYTES) != hipSuccess || per_cu < 1) { fprintf(stderr, "kernel_launch: occupancy query failed\n"); per_cu = 1; }
        if (per_cu > 2) per_cu = 2;
        (void)hipGetLastError();
        grid_blocks = cus * per_cu;
        fprintf(stderr, "kernel_launch: %d CUs x %d blocks\n", cus, per_cu);
    }
    if (grid_blocks < 0) return;
    Params p{};
    p.x = (const float*)d_in[0]; p.w_in = (const float*)d_in[1]; p.idx_k_g = (const float*)d_in[2]; p.idx_k_b = (const float*)d_in[3]; p.sinks = (const float*)d_in[4];
    p.w_o = (const float*)d_in[5]; p.ln1_g = (const float*)d_in[6]; p.ln1_b = (const float*)d_in[7]; p.peer_wq = (const float*)d_in[8]; p.peer_subkeys = (const float*)d_in[9];
    p.peer_u = (const float*)d_in[10]; p.peer_v = (const float*)d_in[11]; p.ln2_g = (const float*)d_in[12]; p.ln2_b = (const float*)d_in[13];
    p.out = (float*)d_out; p.ws = (unsigned char*)d_ws;
    p.ph_lo = 0; p.ph_hi = NPHASE;
    if (hipMemsetAsync((unsigned char*)d_ws + WS_BAR, 0, XCD_BAR_WORDS * 4, stream) != hipSuccess) { fprintf(stderr, "kernel_launch: memset of the barrier words failed\n"); return; }
    void* args[] = {&p};
    hipError_t e = hipLaunchCooperativeKernel((const void*)mega_fwd, dim3(grid_blocks), dim3(NTHREADS), args, LDS_BYTES, stream);
    if (e != hipSuccess) fprintf(stderr, "cooperative launch failed: %s (grid %d)\n", hipGetErrorString(e), grid_blocks);
}
```

```cpp
#include <hip/hip_runtime.h>
#include <hip/hip_cooperative_groups.h>
#include <cstdio>
#include <cstdint>
namespace cg = cooperative_groups;

typedef unsigned short bf16_t;
typedef short bf16x8 __attribute__((ext_vector_type(8)));
typedef float f32x4 __attribute__((ext_vector_type(4)));
typedef float f32x16 __attribute__((ext_vector_type(16)));
typedef unsigned u32x4 __attribute__((ext_vector_type(4)));
typedef unsigned u32x2 __attribute__((ext_vector_type(2)));
#define DI __device__ __forceinline__

constexpr int D_MODEL = 1024, BATCH = 8, SEQ = 4096, NTOK = BATCH * SEQ;
constexpr int NMIX = 1732, NMIX_PAD = 1792;
constexpr int PEER_N = 2048;
constexpr float ALPHA = 1.189207115002721f;
constexpr float LN_EPS = 1e-5f;
constexpr int NTHREADS = 256;
constexpr int LDS_BYTES = 77824;

constexpr size_t MB = 1024 * 1024;
constexpr size_t WS_CTL   = 0;
constexpr size_t WS_BAR   = 65536;
constexpr size_t WS_ROPE  = 1 * MB;
constexpr size_t WS_WINT  = 2 * MB;
constexpr size_t WS_WOT   = 6 * MB;
constexpr size_t WS_WQT   = 8 * MB;
constexpr size_t WS_SK    = 12 * MB;
constexpr size_t WS_UT    = 13 * MB;
constexpr size_t WS_VT    = 29 * MB;
constexpr size_t WS_SU    = 45 * MB;
constexpr size_t WS_SV    = 46 * MB;
constexpr size_t WS_XB    = 77 * MB;
constexpr size_t WS_QA    = 141 * MB;
constexpr size_t WS_KA    = 173 * MB;
constexpr size_t WS_VA    = 181 * MB;
constexpr size_t WS_QB    = 189 * MB;
constexpr size_t WS_KB    = 221 * MB;
constexpr size_t WS_VB    = 225 * MB;
constexpr size_t WS_QI    = 229 * MB;
constexpr size_t WS_KI    = 245 * MB;
constexpr size_t WS_WI    = 249 * MB;
constexpr size_t WS_ATT   = 250 * MB;
constexpr size_t WS_PE    = 314 * MB;
constexpr size_t WS_PG    = 322 * MB;
constexpr size_t WS_PS    = 338 * MB;
constexpr size_t WS_END   = 354 * MB;

struct Params {
    const float* x; const float* w_in; const float* idx_k_g; const float* idx_k_b; const float* sinks; const float* w_o;
    const float* ln1_g; const float* ln1_b; const float* peer_wq; const float* peer_subkeys; const float* peer_u; const float* peer_v;
    const float* ln2_g; const float* ln2_b;
    float* out; unsigned char* ws;
    int ph_lo, ph_hi;
};

DI unsigned f2bf(float x) { unsigned u = __float_as_uint(x); u += 0x7fffu + ((u >> 16) & 1u); return u >> 16; }
DI unsigned pack_bf16(float lo, float hi) { return f2bf(lo) | (f2bf(hi) << 16); }
DI float bf_lo(unsigned w) { return __uint_as_float(w << 16); }
DI float bf_hi(unsigned w) { return __uint_as_float(w & 0xffff0000u); }
DI bf16x8 as_bf16x8(u32x4 v) { return __builtin_bit_cast(bf16x8, v); }
DI u32x4 ldg16(const void* p) { return *(const u32x4*)p; }
DI f32x4 mfma16(bf16x8 a, bf16x8 b, f32x4 c) { return __builtin_amdgcn_mfma_f32_16x16x32_bf16(a, b, c, 0, 0, 0); }
DI f32x16 mfma32(bf16x8 a, bf16x8 b, f32x16 c) { return __builtin_amdgcn_mfma_f32_32x32x16_bf16(a, b, c, 0, 0, 0); }
DI float wave_sum(float v) {
#pragma unroll
    for (int o = 32; o >= 1; o >>= 1) v += __shfl_xor(v, o);
    return v;
}

DI void glds16(const void* src, void* lds_dst) { __builtin_amdgcn_global_load_lds((const unsigned*)src, (__attribute__((address_space(3))) unsigned*)lds_dst, 16, 0, 0); }
DI void gemm_128x128(const bf16_t* __restrict__ X, int ldx, const bf16_t* __restrict__ Wt, int ldw, int K, unsigned char* lds, f32x4 (&acc)[4][4]) {
    int tid = threadIdx.x; asm volatile("" : "+v"(tid));
    const int lane = tid & 63, wave = tid >> 6, wm = wave >> 1, wn = wave & 1, c = lane & 15, g = lane >> 4;
    const int lrow = tid >> 3, lch = tid & 7;
    const bf16_t* xp = X + (size_t)lrow * ldx + ((lch ^ (lrow & 7)) * 8);
    const bf16_t* wp = Wt + (size_t)lrow * ldw + ((lch ^ (lrow & 7)) * 8);
    unsigned char* dst0 = lds + tid * 16;
#pragma unroll
    for (int m = 0; m < 4; ++m)
#pragma unroll
        for (int n = 0; n < 4; ++n) acc[m][n] = (f32x4){0.f, 0.f, 0.f, 0.f};
    const int nk = K / 64;
    __syncthreads();
#pragma unroll
    for (int i = 0; i < 4; ++i) { glds16(xp + (size_t)(32 * i) * ldx, dst0 + i * 4096); glds16(wp + (size_t)(32 * i) * ldw, dst0 + 16384 + i * 4096); }
    asm volatile("s_waitcnt vmcnt(0)" ::: "memory");
    __syncthreads();
    for (int kt = 0; kt < nk; ++kt) {
        const unsigned char* Xs = lds + (kt & 1) * 32768; const unsigned char* Ws = Xs + 16384;
        if (kt + 1 < nk) {
            unsigned char* d = dst0 + ((kt + 1) & 1) * 32768;
#pragma unroll
            for (int i = 0; i < 4; ++i) { glds16(xp + (size_t)(32 * i) * ldx + (kt + 1) * 64, d + i * 4096); glds16(wp + (size_t)(32 * i) * ldw + (kt + 1) * 64, d + 16384 + i * 4096); }
        }
#pragma unroll
        for (int s = 0; s < 2; ++s) {
            bf16x8 xf[4], wf[4];
#pragma unroll
            for (int m = 0; m < 4; ++m) { const int row = wm * 64 + m * 16 + c; xf[m] = as_bf16x8(*(const u32x4*)(Xs + row * 128 + (((4 * s + g) ^ (c & 7)) << 4))); }
#pragma unroll
            for (int n = 0; n < 4; ++n) { const int row = wn * 64 + n * 16 + c; wf[n] = as_bf16x8(*(const u32x4*)(Ws + row * 128 + (((4 * s + g) ^ (c & 7)) << 4))); }
#pragma unroll
            for (int m = 0; m < 4; ++m)
#pragma unroll
                for (int n = 0; n < 4; ++n) acc[m][n] = mfma16(wf[n], xf[m], acc[m][n]);
        }
        asm volatile("s_waitcnt vmcnt(0)" ::: "memory");
        __syncthreads();
    }
}

DI bool tile_of(int k, int NT, int MT, int& mt, int& nt) {
    const int G = gridDim.x, bid = blockIdx.x;
    if (((G | MT) & 7) == 0) {
        const int idx = (bid >> 3) + k * (G >> 3);
        if (idx >= (MT >> 3) * NT) return false;
        mt = (idx / NT) * 8 + (bid & 7); nt = idx % NT;
    } else {
        const int t = bid + k * G;
        if (t >= MT * NT) return false;
        mt = t / NT; nt = t % NT;
    }
    return true;
}

DI void p0_prep(const Params& p, unsigned char* lds) {
    const int tid = threadIdx.x, nb = gridDim.x, bid = blockIdx.x;
    const size_t gtid = (size_t)bid * NTHREADS + tid, gsz = (size_t)nb * NTHREADS;
    unsigned char* ws = p.ws;
    {
        float* ct = (float*)(ws + WS_ROPE); float* stb = ct + SEQ * 32;
        for (size_t i = gtid; i < (size_t)SEQ * 32; i += gsz) {
            const int pos = (int)(i >> 5), fi = (int)(i & 31);
            const float inv = powf(10000.0f, -(float)(2 * fi) / 64.0f);
            const float ang = (float)pos * inv;
            ct[i] = cosf(ang); stb[i] = sinf(ang);
        }
    }
    auto conv = [&](const float* src, bf16_t* dst, size_t n) {
        for (size_t i = gtid * 8; i < n; i += gsz * 8) {
            const f32x4 a = *(const f32x4*)(src + i), b = *(const f32x4*)(src + i + 4);
            u32x4 o; o.x = pack_bf16(a.x, a.y); o.y = pack_bf16(a.z, a.w); o.z = pack_bf16(b.x, b.y); o.w = pack_bf16(b.z, b.w);
            *(u32x4*)(dst + i) = o;
        }
    };
    conv(p.x, (bf16_t*)(ws + WS_XB), (size_t)NTOK * D_MODEL);
    {
        const int lane = tid & 63, gw = bid * 4 + (tid >> 6), nw = nb * 4;
        for (int row = gw; row < 2 * 16384; row += nw) {
            const bool isv = row >= 16384; const int e = isv ? row - 16384 : row;
            const float* src = (isv ? p.peer_v : p.peer_u) + (size_t)e * 1024 + lane * 16;
            f32x4 v[4]; float mx = 0.f;
#pragma unroll
            for (int i = 0; i < 4; ++i) { v[i] = *(const f32x4*)(src + 4 * i); mx = fmaxf(mx, fmaxf(fmaxf(fabsf(v[i][0]), fabsf(v[i][1])), fmaxf(fabsf(v[i][2]), fabsf(v[i][3])))); }
#pragma unroll
            for (int o = 32; o >= 1; o >>= 1) mx = fmaxf(mx, __shfl_xor(mx, o));
            const float sc = mx > 0.f ? mx * (1.0f / 5.99f) : 1.0f, inv = mx > 0.f ? 5.99f / mx : 1.0f;
            u32x2 o2;
#pragma unroll
            for (int k = 0; k < 2; ++k) {
                unsigned w = 0;
                w = __builtin_amdgcn_cvt_scalef32_pk_fp4_f32(w, v[2 * k][0] * inv, v[2 * k][1] * inv, 1.0f, 0);
                w = __builtin_amdgcn_cvt_scalef32_pk_fp4_f32(w, v[2 * k][2] * inv, v[2 * k][3] * inv, 1.0f, 1);
                w = __builtin_amdgcn_cvt_scalef32_pk_fp4_f32(w, v[2 * k + 1][0] * inv, v[2 * k + 1][1] * inv, 1.0f, 2);
                w = __builtin_amdgcn_cvt_scalef32_pk_fp4_f32(w, v[2 * k + 1][2] * inv, v[2 * k + 1][3] * inv, 1.0f, 3);
                o2[k] = w;
            }
            *(u32x2*)(ws + (isv ? WS_VT : WS_UT) + (size_t)e * 512 + lane * 8) = o2;
            if (lane == 0) ((float*)(ws + (isv ? WS_SV : WS_SU)))[e] = sc;
        }
    }
    conv(p.peer_subkeys, (bf16_t*)(ws + WS_SK), (size_t)8 * 2 * 128 * 128);
    float* tl = (float*)lds;
    auto transp = [&](const float* src, bf16_t* dst, int N, int Npad) {
        const int tn = Npad / 64, tk = 1024 / 64;
        for (int t = bid; t < tn * tk; t += nb) {
            const int n0 = (t % tn) * 64, k0 = (t / tn) * 64;
            __syncthreads();
            for (int e = tid; e < 4096; e += NTHREADS) { const int kk = e >> 6, nn = e & 63; tl[kk * 65 + nn] = (n0 + nn < N) ? src[(size_t)(k0 + kk) * N + n0 + nn] : 0.f; }
            __syncthreads();
            for (int e = tid; e < 4096; e += NTHREADS) { const int nn = e >> 6, kk = e & 63; dst[(size_t)(n0 + nn) * 1024 + k0 + kk] = (bf16_t)f2bf(tl[kk * 65 + nn]); }
        }
    };
    transp(p.w_in, (bf16_t*)(ws + WS_WINT), NMIX, NMIX_PAD);
    transp(p.w_o, (bf16_t*)(ws + WS_WOT), 1024, 1024);
    transp(p.peer_wq, (bf16_t*)(ws + WS_WQT), PEER_N, PEER_N);
}

DI void p1_inproj(const Params& p, unsigned char* lds) {
    unsigned char* ws = p.ws;
    const bf16_t* XB = (const bf16_t*)(ws + WS_XB); const bf16_t* WT = (const bf16_t*)(ws + WS_WINT);
    const float* cosT = (const float*)(ws + WS_ROPE); const float* sinT = cosT + SEQ * 32;
    const int tid = threadIdx.x, lane = tid & 63, wave = tid >> 6, wm = wave >> 1, wn = wave & 1, c = lane & 15, g = lane >> 4;
    constexpr int NT = NMIX_PAD / 128, MT = NTOK / 128;
    int mt, nt;
    for (int k = 0; tile_of(k, NT, MT, mt, nt); ++k) {
        f32x4 acc[4][4];
        gemm_128x128(XB + (size_t)mt * 128 * 1024, 1024, WT + (size_t)nt * 128 * 1024, 1024, 1024, lds, acc);
        const int col64 = nt * 2 + wn;
        bf16_t* dst; int ld, coff; bool rope = true; float scale = 1.f;
        if (col64 < 8)       { dst = (bf16_t*)(ws + WS_QA); ld = 512; coff = col64 * 64; scale = 0.125f; }
        else if (col64 < 10) { dst = (bf16_t*)(ws + WS_KA); ld = 128; coff = (col64 - 8) * 64; }
        else if (col64 < 12) { dst = (bf16_t*)(ws + WS_VA); ld = 128; coff = (col64 - 10) * 64; rope = false; }
        else if (col64 < 20) { dst = (bf16_t*)(ws + WS_QB); ld = 512; coff = (col64 - 12) * 64; scale = 0.125f; }
        else if (col64 == 20) { dst = (bf16_t*)(ws + WS_KB); ld = 64; coff = 0; }
        else if (col64 == 21) { dst = (bf16_t*)(ws + WS_VB); ld = 64; coff = 0; rope = false; }
        else if (col64 < 26) { dst = (bf16_t*)(ws + WS_QI); ld = 256; coff = (col64 - 22) * 64; }
        else                 { dst = (bf16_t*)(ws + WS_KI); ld = 64; coff = 0; }
        if (col64 == 27) {
            if (g == 0) {
#pragma unroll
                for (int m = 0; m < 4; ++m) { const int tok = mt * 128 + wm * 64 + m * 16 + c; *(f32x4*)((float*)(ws + WS_WI) + (size_t)tok * 4) = acc[m][0] * 0.0625f; }
            }
            continue;
        }
#pragma unroll
        for (int m = 0; m < 4; ++m) {
            const int tok = mt * 128 + wm * 64 + m * 16 + c, pos = tok & (SEQ - 1);
            f32x4 v[4] = {acc[m][0], acc[m][1], acc[m][2], acc[m][3]};
            if (col64 == 26) {
                float s = 0.f;
#pragma unroll
                for (int n = 0; n < 4; ++n) s += (v[n][0] + v[n][1]) + (v[n][2] + v[n][3]);
                s += __shfl_xor(s, 16); s += __shfl_xor(s, 32);
                const float mu = s * (1.f / 64.f); float q = 0.f;
#pragma unroll
                for (int n = 0; n < 4; ++n) { const f32x4 d = v[n] - mu; q += (d[0] * d[0] + d[1] * d[1]) + (d[2] * d[2] + d[3] * d[3]); }
                q += __shfl_xor(q, 16); q += __shfl_xor(q, 32);
                const float rstd = rsqrtf(q * (1.f / 64.f) + LN_EPS);
#pragma unroll
                for (int n = 0; n < 4; ++n) {
                    const f32x4 gg = *(const f32x4*)(p.idx_k_g + 16 * n + 4 * g), bb = *(const f32x4*)(p.idx_k_b + 16 * n + 4 * g);
                    v[n] = (v[n] - mu) * rstd * gg + bb;
                }
            }
            if (rope) {
#pragma unroll
                for (int n = 0; n < 2; ++n) {
                    const f32x4 cs = *(const f32x4*)(cosT + pos * 32 + 16 * n + 4 * g), sn = *(const f32x4*)(sinT + pos * 32 + 16 * n + 4 * g);
                    const f32x4 t1 = v[n], t2 = v[n + 2];
                    v[n] = t1 * cs - t2 * sn; v[n + 2] = t2 * cs + t1 * sn;
                }
            }
#pragma unroll
            for (int n = 0; n < 4; ++n) {
                const f32x4 o = v[n] * scale; u32x2 w; w.x = pack_bf16(o[0], o[1]); w.y = pack_bf16(o[2], o[3]);
                *(u32x2*)(dst + (size_t)tok * ld + coff + 16 * n + 4 * g) = w;
            }
        }
    }
}

constexpr int NDSA = NTOK / 4, NSWA = BATCH * 32 * 8;
constexpr int P2_SC = 0, P2_STG = 32768  , P2_LIST = 65536;

DI unsigned f16_key(float v) {
    _Float16 hv = (_Float16)v; unsigned short hb = __builtin_bit_cast(unsigned short, hv); unsigned b = hb;
    if (b == 0x8000u) b = 0u;
    return (b & 0x8000u) ? ((~b) & 0xffffu) : (b | 0x8000u);
}

template <int MODE> DI void p2_dsa_item(const Params& p, unsigned char* lds, int b, int tb) {
    unsigned char* ws = p.ws;
    const bf16_t* QI = (const bf16_t*)(ws + WS_QI); const bf16_t* KI = (const bf16_t*)(ws + WS_KI); const float* WI = (const float*)(ws + WS_WI);
    const bf16_t* QB = (const bf16_t*)(ws + WS_QB); const bf16_t* KB = (const bf16_t*)(ws + WS_KB); const bf16_t* VB = (const bf16_t*)(ws + WS_VB);
    bf16_t* ATT = (bf16_t*)(ws + WS_ATT);
    int tid = threadIdx.x; asm volatile("" : "+v"(tid));
    const int lane = tid & 63, wave = __builtin_amdgcn_readfirstlane(tid >> 6), c = lane & 15, g = lane >> 4;
    const int t0 = tb * 4, tok0 = b * SEQ + t0;
    unsigned short* sc = (unsigned short*)(lds + P2_SC);
    unsigned char* stg = lds + P2_STG + wave * 8192;
    unsigned* hist = (unsigned*)stg;
    unsigned short* list = (unsigned short*)(lds + P2_LIST) + wave * 256;
    const int tok = tok0 + wave;
    {
        bf16x8 af[2];
#pragma unroll
        for (int s = 0; s < 2; ++s) af[s] = as_bf16x8(ldg16(QI + (size_t)(tok0 + (c >> 2)) * 256 + (c & 3) * 64 + 32 * s + 8 * g));
        const f32x4 wv = *(const f32x4*)(WI + (size_t)(tok0 + g) * 4);
        const int ntile = (t0 + 4 + 15) >> 4, ngrp = ((ntile + 31) & ~31) >> 2;
        const unsigned char* kib = (const unsigned char*)(KI + (size_t)b * SEQ * 64);
        const int lr = lane >> 3, lc = lane & 7;
        const unsigned st_off = lr * 128 + ((lc ^ lr) << 4);
        asm volatile("" :: "v"(af[0]), "v"(af[1]), "v"(wv));
        auto ldgrp = [&](int gg, u32x4 (&dst)[8]) {
            gg = gg < ngrp ? gg : ngrp - 1;
#pragma unroll
            for (int i = 0; i < 8; ++i) dst[i] = ldg16(kib + (size_t)(gg * 64 + i * 8 + lr) * 128 + lc * 16);
        };
        auto proc = [&](int gg, const u32x4 (&src)[8]) {
#pragma unroll
            for (int i = 0; i < 8; ++i) *(u32x4*)(stg + i * 1024 + st_off) = src[i];
            bf16x8 k0[4], k1[4];
#pragma unroll
            for (int u = 0; u < 4; ++u) {
                k0[u] = as_bf16x8(*(const u32x4*)(stg + (16 * u + c) * 128 + ((g ^ (c & 7)) << 4)));
                k1[u] = as_bf16x8(*(const u32x4*)(stg + (16 * u + c) * 128 + (((4 + g) ^ (c & 7)) << 4)));
            }
            unsigned short res[4];
#pragma unroll
            for (int u = 0; u < 4; ++u) {
                f32x4 d = mfma16(af[0], k0[u], (f32x4){0.f, 0.f, 0.f, 0.f});
                d = mfma16(af[1], k1[u], d);
                const float s = wv[0] * fmaxf(d[0], 0.f) + wv[1] * fmaxf(d[1], 0.f) + wv[2] * fmaxf(d[2], 0.f) + wv[3] * fmaxf(d[3], 0.f);
                const int key = gg * 64 + u * 16 + c;
                res[u] = (key <= t0 + g) ? (unsigned short)f16_key(s) : (unsigned short)0;
            }
#pragma unroll
            for (int u = 0; u < 4; ++u) sc[g * 4096 + gg * 64 + u * 16 + c] = res[u];
        };
        u32x4 r0[8], r1[8], r2[8];
        ldgrp(wave, r0); ldgrp(wave + 4, r1); ldgrp(wave + 8, r2);
        for (int gi = wave; gi < ngrp; gi += 12) {
            proc(gi, r0); ldgrp(gi + 12, r0);
            if (gi + 4 < ngrp) proc(gi + 4, r1);
            ldgrp(gi + 16, r1);
            if (gi + 8 < ngrp) proc(gi + 8, r2);
            ldgrp(gi + 20, r2);
        }
    }
    __syncthreads();
    if (!(MODE & 2)) return;
    const int n = t0 + wave + 1;
    const int L = n < 256 ? n : 256;
    const unsigned short* myk = sc + wave * 4096;
    if (n <= 256) {
        for (int i = lane; i < n; i += 64) list[i] = (unsigned short)i;
    } else {
        u32x4 kk[8];
#pragma unroll
        for (int i = 0; i < 8; ++i) kk[i] = (512 * i < n) ? *(const u32x4*)(myk + 512 * i + 8 * lane) : (u32x4){0u, 0u, 0u, 0u};
#pragma unroll
        for (int i = 0; i < 4; ++i) *(u32x4*)(hist + lane * 16 + i * 4) = (u32x4){0u, 0u, 0u, 0u};
#pragma unroll
        for (int i = 0; i < 8; ++i) {
            if (512 * i < n) {
#pragma unroll
                for (int w = 0; w < 4; ++w) { const unsigned wd = kk[i][w]; atomicAdd(&hist[(wd & 0xffffu) >> 6], 1u); atomicAdd(&hist[wd >> 22], 1u); }
            }
        }
        unsigned h[16];
#pragma unroll
        for (int i = 0; i < 4; ++i) { const u32x4 t = *(const u32x4*)(hist + lane * 16 + i * 4); h[4 * i] = t.x; h[4 * i + 1] = t.y; h[4 * i + 2] = t.z; h[4 * i + 3] = t.w; }
#pragma unroll
        for (int i = 0; i < 4; ++i) *(u32x4*)(hist + lane * 16 + i * 4) = (u32x4){0u, 0u, 0u, 0u};
        unsigned sl = 0;
#pragma unroll
        for (int i = 0; i < 16; ++i) sl += h[i];
        unsigned pre = sl;
#pragma unroll
        for (int o = 1; o < 64; o <<= 1) { const unsigned t = __shfl_up(pre, o); if (lane >= o) pre += t; }
        const unsigned tot = __shfl(pre, 63);
        const unsigned suf = tot - pre;
        int found = -1; unsigned cab = 0, cum = suf;
#pragma unroll
        for (int j = 15; j >= 0; --j) { const bool hit = (found < 0) && (cum + h[j] >= 256u); if (hit) { found = lane * 16 + j; cab = cum; } cum += h[j]; }
        const bool mine = (suf < 256u) && (suf + sl >= 256u);
        const unsigned long long mm = __ballot(mine);
        const int src = __ffsll((long long)mm) - 1;
        const unsigned bstar = (unsigned)__shfl(found, src), cabove = __shfl(cab, src);
        const unsigned r1 = 256u - cabove;
#pragma unroll
        for (int i = 0; i < 8; ++i) {
            if (512 * i < n) {
#pragma unroll
                for (int w = 0; w < 4; ++w) {
                    const unsigned wd = kk[i][w];
                    if (((wd & 0xffffu) >> 6) == bstar) atomicAdd(&hist[wd & 63u], 1u);
                    if ((wd >> 22) == bstar) atomicAdd(&hist[(wd >> 16) & 63u], 1u);
                }
            }
        }
        const unsigned cnt = hist[lane];
        hist[lane] = 0u;
        unsigned pre2 = cnt;
#pragma unroll
        for (int o = 1; o < 64; o <<= 1) { const unsigned t = __shfl_up(pre2, o); if (lane >= o) pre2 += t; }
        const unsigned tot2 = __shfl(pre2, 63);
        const unsigned suf2 = tot2 - pre2;
        const bool mine2 = (suf2 < r1) && (suf2 + cnt >= r1);
        const unsigned long long mm2 = __ballot(mine2);
        const int src2 = __ffsll((long long)mm2) - 1;
        const unsigned T = (bstar << 6) | (unsigned)src2;
        const unsigned req = r1 - __shfl(suf2, src2);
        const unsigned toteq = __shfl(cnt, src2);
        const bool alleq = (req == toteq);
        const unsigned Tt = alleq ? T : T + 1u;
        unsigned cg = 0;
#pragma unroll
        for (int i = 0; i < 8; ++i)
#pragma unroll
            for (int w = 0; w < 4; ++w) { const unsigned wd = kk[i][w]; cg += ((wd & 0xffffu) >= Tt) ? 1u : 0u; cg += ((wd >> 16) >= Tt) ? 1u : 0u; }
        unsigned pre3 = cg;
#pragma unroll
        for (int o = 1; o < 64; o <<= 1) { const unsigned t = __shfl_up(pre3, o); if (lane >= o) pre3 += t; }
        unsigned off = pre3 - cg;
#pragma unroll
        for (int i = 0; i < 8; ++i)
#pragma unroll
            for (int w = 0; w < 4; ++w) {
                const unsigned wd = kk[i][w]; const int idx = 512 * i + 8 * lane + 2 * w;
                if ((wd & 0xffffu) >= Tt) { list[off & 255u] = (unsigned short)idx; ++off; }
                if ((wd >> 16) >= Tt) { list[off & 255u] = (unsigned short)(idx + 1); ++off; }
            }
        if (!alleq) {
            const unsigned cgt = 256u - req; unsigned eq_run = 0;
            for (int base = 0; base < n; base += 64) {
                const int i = base + lane; const unsigned m = (i < n) ? myk[i] : 0u;
                const bool eq = (m == T);
                const unsigned long long eqm = __ballot(eq);
                const unsigned rank = eq_run + __builtin_amdgcn_mbcnt_hi((unsigned)(eqm >> 32), __builtin_amdgcn_mbcnt_lo((unsigned)eqm, 0u));
                if (eq && rank < req) list[cgt + rank] = (unsigned short)i;
                eq_run += (unsigned)__popcll(eqm);
            }
        }
    }
    if (!(MODE & 4)) return;
    bf16x8 qf[2], sel[2];
#pragma unroll
    for (int s = 0; s < 2; ++s) {
        u32x4 t = (u32x4){0u, 0u, 0u, 0u};
        if (c < 8) t = ldg16(QB + (size_t)tok * 512 + c * 64 + 32 * s + 8 * g);
        qf[s] = as_bf16x8(t);
#pragma unroll
        for (int j = 0; j < 8; ++j) sel[s][j] = (8 * g + j == 16 * s + c) ? (short)0x3F80 : (short)0;
    }
    f32x4 st[16];
    const unsigned char* kbb = (const unsigned char*)(KB + (size_t)b * SEQ * 64); const unsigned char* vbb = (const unsigned char*)(VB + (size_t)b * SEQ * 64);
    const int lr = lane >> 3, lc = lane & 7;
    const unsigned st_off = lr * 128 + ((lc ^ lr) << 4);
    auto loadg = [&](const unsigned char* base, int T0, u32x4 (&dst)[8]) {
#pragma unroll
        for (int i = 0; i < 8; ++i) {
            const int idx = T0 * 16 + i * 8 + lr; const unsigned kid = (idx < L) ? (unsigned)list[idx] : 0u;
            dst[i] = ldg16(base + kid * 128u + lc * 16u);
        }
    };
    auto stage = [&](const u32x4 (&src)[8]) {
#pragma unroll
        for (int i = 0; i < 8; ++i) *(u32x4*)(stg + i * 1024 + st_off) = src[i];
    };
    auto frag = [&](int u, int s2) -> bf16x8 { return as_bf16x8(*(const u32x4*)(stg + (16 * u + c) * 128 + (((4 * s2 + g) ^ (c & 7)) << 4))); };
    auto scoreK = [&](int T0) {
#pragma unroll
        for (int T = 0; T < 4; ++T) {
            f32x4 d = mfma16(frag(T, 0), qf[0], (f32x4){0.f, 0.f, 0.f, 0.f});
            st[T0 + T] = mfma16(frag(T, 1), qf[1], d);
        }
    };
    u32x4 rA[8], rB[8], rC[8], rD[8];
    loadg(kbb, 0, rA); loadg(kbb, 4, rB); loadg(kbb, 8, rC); loadg(kbb, 12, rD);
    __builtin_amdgcn_sched_barrier(0);
    stage(rA); scoreK(0);
    stage(rB); scoreK(4);
    __builtin_amdgcn_sched_barrier(0);
    loadg(vbb, 0, rA); loadg(vbb, 4, rB);
    stage(rC); scoreK(8);
    stage(rD); scoreK(12);
    __builtin_amdgcn_sched_barrier(0);
    float mx = -3.0e38f;
    {
        const int lrem = L - 4 * g;
#pragma unroll
        for (int T = 0; T < 16; ++T)
#pragma unroll
            for (int r = 0; r < 4; ++r) { const float sv = (T * 16 + r < lrem) ? st[T][r] : -3.0e38f; st[T][r] = sv; mx = fmaxf(mx, sv); }
    }
    mx = fmaxf(mx, __shfl_xor(mx, 16)); mx = fmaxf(mx, __shfl_xor(mx, 32));
    float lsum = 0.f;
#pragma unroll
    for (int T = 0; T < 16; ++T)
#pragma unroll
        for (int r = 0; r < 4; ++r) { const float e = __expf(st[T][r] - mx); st[T][r] = e; lsum += e; }
    lsum += __shfl_xor(lsum, 16); lsum += __shfl_xor(lsum, 32);
    const float rl = 1.0f / lsum;
    u32x4 pfv[8];
#pragma unroll
    for (int u = 0; u < 8; ++u) {
        const int Ta = 2 * u, Tb = Ta + 1;
        pfv[u].x = pack_bf16(st[Ta][0] * rl, st[Ta][1] * rl); pfv[u].y = pack_bf16(st[Ta][2] * rl, st[Ta][3] * rl);
        pfv[u].z = pack_bf16(st[Tb][0] * rl, st[Tb][1] * rl); pfv[u].w = pack_bf16(st[Tb][2] * rl, st[Tb][3] * rl);
    }
    __builtin_amdgcn_sched_barrier(0);
    f32x4 O[4];
#pragma unroll
    for (int cb = 0; cb < 4; ++cb) O[cb] = (f32x4){0.f, 0.f, 0.f, 0.f};
    auto pv = [&](int T0) {
#pragma unroll
        for (int u = 0; u < 2; ++u) {
            const u32x4 pf = pfv[(T0 >> 1) + u];
#pragma unroll
            for (int cb = 0; cb < 4; ++cb) {
                const f32x4 z = (f32x4){0.f, 0.f, 0.f, 0.f};
                const f32x4 v0 = mfma16(frag(2 * u, cb >> 1), sel[cb & 1], z), v1 = mfma16(frag(2 * u + 1, cb >> 1), sel[cb & 1], z);
                u32x4 vf; vf.x = pack_bf16(v0[0], v0[1]); vf.y = pack_bf16(v0[2], v0[3]); vf.z = pack_bf16(v1[0], v1[1]); vf.w = pack_bf16(v1[2], v1[3]);
                O[cb] = mfma16(as_bf16x8(pf), as_bf16x8(vf), O[cb]);
            }
        }
    };
    loadg(vbb, 8, rC); loadg(vbb, 12, rD);
    __builtin_amdgcn_sched_barrier(0);
    stage(rA); pv(0);
    stage(rB); pv(4);
    __builtin_amdgcn_sched_barrier(0);
    stage(rC); pv(8);
    stage(rD); pv(12);
    if (g < 2) {
#pragma unroll
        for (int cb = 0; cb < 4; ++cb)
#pragma unroll
            for (int r = 0; r < 4; ++r) ATT[(size_t)tok * 1024 + 512 + (4 * g + r) * 64 + 16 * cb + c] = (bf16_t)f2bf(O[cb][r]);
    }
}

DI void p2_swa_item(const Params& p, int item2) {
    unsigned char* ws = p.ws;
    const bf16_t* QA = (const bf16_t*)(ws + WS_QA); const bf16_t* KA = (const bf16_t*)(ws + WS_KA); const bf16_t* VA = (const bf16_t*)(ws + WS_VA);
    bf16_t* ATT = (bf16_t*)(ws + WS_ATT);
    int tid = threadIdx.x; asm volatile("" : "+v"(tid));
    const int lane = tid & 63, wave = __builtin_amdgcn_readfirstlane(tid >> 6), r = lane & 31, h = lane >> 5;
    const int hq = item2 & 7, blk = (item2 >> 3) & 31, b = item2 >> 8, kvh = hq >> 2;
    const int qi = 32 * wave + r, tokq = b * SEQ + blk * 128 + qi;
    bf16x8 qf[4], sel[2];
#pragma unroll
    for (int s = 0; s < 4; ++s) qf[s] = as_bf16x8(ldg16(QA + (size_t)tokq * 512 + hq * 64 + 16 * s + 8 * h));
#pragma unroll
    for (int x = 0; x < 2; ++x)
#pragma unroll
        for (int j = 0; j < 8; ++j) sel[x][j] = (8 * h + j + 16 * x == r) ? (short)0x3F80 : (short)0;
    const float sink = p.sinks[hq];
    f32x16 ST[5];
#pragma unroll
    for (int ti = 0; ti < 5; ++ti) {
        const int sj = 32 * (wave + ti) + r; int pos = blk * 128 - 128 + sj; pos = pos < 0 ? 0 : pos;
        const bf16_t* kp = KA + (size_t)(b * SEQ + pos) * 128 + kvh * 64 + 8 * h;
        f32x16 d; for (int i = 0; i < 16; ++i) d[i] = 0.f;
#pragma unroll
        for (int s = 0; s < 4; ++s) d = mfma32(as_bf16x8(ldg16(kp + 16 * s)), qf[s], d);
        ST[ti] = d;
    }
    float mx = sink;
    {
        const int lo = r + 1 - 4 * h;
        const int lo0 = (blk > 0) ? lo : (lo > 128 - 32 * wave - 4 * h ? lo : 128 - 32 * wave - 4 * h);
#pragma unroll
        for (int ti = 0; ti < 5; ++ti)
#pragma unroll
            for (int reg = 0; reg < 16; ++reg) {
                const int e = 32 * ti + (reg & 3) + 8 * (reg >> 2);
                const float sv = (e >= lo0 && e < lo + 128) ? ST[ti][reg] : -3.0e38f; ST[ti][reg] = sv; mx = fmaxf(mx, sv);
            }
    }
    mx = fmaxf(mx, __shfl_xor(mx, 32));
    float lsum = 0.f;
#pragma unroll
    for (int ti = 0; ti < 5; ++ti)
#pragma unroll
        for (int reg = 0; reg < 16; ++reg) { const float e = __expf(ST[ti][reg] - mx); ST[ti][reg] = e; lsum += e; }
    lsum += __shfl_xor(lsum, 32);
    lsum += __expf(sink - mx);
    const float rl = 1.0f / lsum;
    f32x16 OT[2];
    for (int i = 0; i < 16; ++i) { OT[0][i] = 0.f; OT[1][i] = 0.f; }
#pragma unroll
    for (int ti = 0; ti < 5; ++ti) {
        const int sj = 32 * (wave + ti) + r; int pos = blk * 128 - 128 + sj; pos = pos < 0 ? 0 : pos;
        const bf16_t* vp = VA + (size_t)(b * SEQ + pos) * 128 + kvh * 64 + 8 * h;
        bf16x8 vf[4];
#pragma unroll
        for (int s = 0; s < 4; ++s) vf[s] = as_bf16x8(ldg16(vp + 16 * s));
        u32x4 pb[2];
#pragma unroll
        for (int s2 = 0; s2 < 2; ++s2) {
            pb[s2].x = pack_bf16(ST[ti][8 * s2 + 0] * rl, ST[ti][8 * s2 + 1] * rl); pb[s2].y = pack_bf16(ST[ti][8 * s2 + 2] * rl, ST[ti][8 * s2 + 3] * rl);
            pb[s2].z = pack_bf16(ST[ti][8 * s2 + 4] * rl, ST[ti][8 * s2 + 5] * rl); pb[s2].w = pack_bf16(ST[ti][8 * s2 + 6] * rl, ST[ti][8 * s2 + 7] * rl);
        }
#pragma unroll
        for (int db = 0; db < 2; ++db) {
            f32x16 vt; for (int i = 0; i < 16; ++i) vt[i] = 0.f;
            vt = mfma32(vf[2 * db], sel[0], vt); vt = mfma32(vf[2 * db + 1], sel[1], vt);
#pragma unroll
            for (int s2 = 0; s2 < 2; ++s2) {
                u32x4 va; va.x = pack_bf16(vt[8 * s2 + 0], vt[8 * s2 + 1]); va.y = pack_bf16(vt[8 * s2 + 2], vt[8 * s2 + 3]);
                va.z = pack_bf16(vt[8 * s2 + 4], vt[8 * s2 + 5]); va.w = pack_bf16(vt[8 * s2 + 6], vt[8 * s2 + 7]);
                OT[db] = mfma32(as_bf16x8(va), as_bf16x8(pb[s2]), OT[db]);
            }
        }
    }
#pragma unroll
    for (int db = 0; db < 2; ++db)
#pragma unroll
        for (int q4 = 0; q4 < 4; ++q4) {
            u32x2 w; w.x = pack_bf16(OT[db][4 * q4], OT[db][4 * q4 + 1]); w.y = pack_bf16(OT[db][4 * q4 + 2], OT[db][4 * q4 + 3]);
            *(u32x2*)(ATT + (size_t)tokq * 1024 + hq * 64 + 32 * db + 8 * q4 + 4 * h) = w;
        }
}

template <int MODE> DI void p2_attention(const Params& p, unsigned char* lds, int cidx = 0) {
    const int G = gridDim.x, bi = blockIdx.x, rounds = (1024 + G - 1) / G;
    for (int b = 0; b < BATCH; ++b)
        for (int r = 0; r < rounds; ++r) {
            const int idx = (r & 1) ? r * G + (G - 1 - bi) : r * G + bi;
            if (idx < 1024) { __syncthreads(); p2_dsa_item<MODE>(p, lds, b, 1023 - idx); }
        }
    if (MODE & 8) for (int item2 = bi; item2 < NSWA; item2 += G) p2_swa_item(p, item2);
}

DI void p3_outproj(const Params& p, unsigned char* lds) {
    unsigned char* ws = p.ws;
    const bf16_t* ATT = (const bf16_t*)(ws + WS_ATT); const bf16_t* WT = (const bf16_t*)(ws + WS_WOT);
    const int tid = threadIdx.x, lane = tid & 63, wave = tid >> 6, wm = wave >> 1, wn = wave & 1, c = lane & 15, g = lane >> 4;
    constexpr int NT = 8, MT = NTOK / 128;
    int mt, nt;
    for (int k = 0; tile_of(k, NT, MT, mt, nt); ++k) {
        f32x4 acc[4][4];
        gemm_128x128(ATT + (size_t)mt * 128 * 1024, 1024, WT + (size_t)nt * 128 * 1024, 1024, 1024, lds, acc);
#pragma unroll
        for (int m = 0; m < 4; ++m) {
            const int tok = mt * 128 + wm * 64 + m * 16 + c;
#pragma unroll
            for (int n = 0; n < 4; ++n) {
                const size_t o = (size_t)tok * 1024 + nt * 128 + wn * 64 + 16 * n + 4 * g;
                const f32x4 xv = *(const f32x4*)(p.x + o);
                *(f32x4*)(p.out + o) = xv * ALPHA + acc[m][n];
            }
        }
    }
}

DI void p3b_ln1(const Params& p) {
    bf16_t* H1B = (bf16_t*)(p.ws + WS_XB);
    const int lane = threadIdx.x & 63, gw = blockIdx.x * 4 + (threadIdx.x >> 6), nw = gridDim.x * 4;
    for (int row = gw; row < NTOK; row += nw) {
        f32x4 v[4]; float s = 0.f;
#pragma unroll
        for (int i = 0; i < 4; ++i) { v[i] = *(const f32x4*)(p.out + (size_t)row * 1024 + (lane + 64 * i) * 4); s += (v[i][0] + v[i][1]) + (v[i][2] + v[i][3]); }
        const float mu = wave_sum(s) * (1.f / 1024.f); float q = 0.f;
#pragma unroll
        for (int i = 0; i < 4; ++i) { const f32x4 d = v[i] - mu; q += (d[0] * d[0] + d[1] * d[1]) + (d[2] * d[2] + d[3] * d[3]); }
        const float rstd = rsqrtf(wave_sum(q) * (1.f / 1024.f) + LN_EPS);
#pragma unroll
        for (int i = 0; i < 4; ++i) {
            const int col = (lane + 64 * i) * 4;
            const f32x4 gg = *(const f32x4*)(p.ln1_g + col), bb = *(const f32x4*)(p.ln1_b + col);
            const f32x4 o = (v[i] - mu) * rstd * gg + bb;
            u32x2 w; w.x = pack_bf16(o[0], o[1]); w.y = pack_bf16(o[2], o[3]);
            *(u32x2*)(H1B + (size_t)row * 1024 + col) = w;
        }
    }
}

DI int f2key(float v) { const int b = __float_as_int(v); return b ^ ((b >> 31) & 0x7fffffff); }
DI float key2f(int k) { return __int_as_float(k ^ ((k >> 31) & 0x7fffffff)); }
DI void ce_desc(int& a, int& b) { const int hi = a > b ? a : b, lo = a > b ? b : a; a = hi; b = lo; }
DI void bitonic_merge16(int (&k)[16]) {
#pragma unroll
    for (int d = 8; d >= 1; d >>= 1)
#pragma unroll
        for (int i = 0; i < 16; ++i) if ((i & d) == 0) ce_desc(k[i], k[i | d]);
}
DI void bitonic_sort16(int (&k)[16]) {
#pragma unroll
    for (int sz = 2; sz <= 16; sz <<= 1) {
#pragma unroll
        for (int i = 0; i < 16; ++i) { const int j = i ^ (sz - 1); if (j > i) ce_desc(k[i], k[j]); }
#pragma unroll
        for (int d = sz >> 2; d >= 1; d >>= 1)
#pragma unroll
            for (int i = 0; i < 16; ++i) if ((i & d) == 0) ce_desc(k[i], k[i | d]);
    }
}
DI void top16_merge(int (&t)[16], const int (&sdesc)[16]) {
#pragma unroll
    for (int i = 0; i < 16; ++i) t[i] = t[i] > sdesc[15 - i] ? t[i] : sdesc[15 - i];
    bitonic_merge16(t);
}
constexpr int P4_QS = 32768, P4_SS_STRIDE = 132, P4_ST0 = 67584  , P4_M = 0  , P4_ST1 = 8704  ;

DI void p4_peer_query(const Params& p, unsigned char* lds) {
    unsigned char* ws = p.ws;
    const bf16_t* H1B = (const bf16_t*)(ws + WS_XB); const bf16_t* WQT = (const bf16_t*)(ws + WS_WQT); const bf16_t* SK = (const bf16_t*)(ws + WS_SK);
    unsigned short* PE = (unsigned short*)(ws + WS_PE); float* PG = (float*)(ws + WS_PG); float* PS = (float*)(ws + WS_PS);
    const float* SU = (const float*)(ws + WS_SU); const float* SV = (const float*)(ws + WS_SV);
    float* Ss = (float*)lds;
    float* st0 = (float*)(lds + P4_ST0); float* mbuf = (float*)(lds + P4_M); float* st1 = (float*)(lds + P4_ST1);
    constexpr int MT = NTOK / 128;
    int mt, head;
    for (int k = 0; tile_of(k, 8, MT, mt, head); ++k) {
        int tid = threadIdx.x; asm volatile("" : "+v"(tid));
        const int lane = tid & 63, wave = tid >> 6, wm = wave >> 1, wn = wave & 1, c = lane & 15, g = lane >> 4;
        const int lrow = tid >> 3, lch = tid & 7;
        const int srow = tid & 127, shalf = tid >> 7;
#pragma unroll 1
        for (int ph = 0; ph < 2; ++ph) {
            f32x4 acc[4][4];
            gemm_128x128(H1B + (size_t)mt * 128 * 1024, 1024, WQT + (size_t)(head * 256 + ph * 128) * 1024, 1024, 1024, lds, acc);
            __syncthreads();
#pragma unroll
            for (int m = 0; m < 4; ++m)
#pragma unroll
                for (int n = 0; n < 4; ++n) {
                    const int row = wm * 64 + m * 16 + c;
                    u32x2 w; w.x = pack_bf16(acc[m][n][0], acc[m][n][1]); w.y = pack_bf16(acc[m][n][2], acc[m][n][3]);
                    *(u32x2*)(lds + P4_QS + wn * 16384 + row * 128 + (((2 * n + (g >> 1)) ^ (row & 7)) << 4) + (g & 1) * 8) = w;
                }
            {
                const bf16_t* sp = SK + (size_t)((head * 2 + ph) * 128 + lrow) * 128 + lch * 8;
#pragma unroll
                for (int k2 = 0; k2 < 2; ++k2)
#pragma unroll
                    for (int i = 0; i < 4; ++i) *(u32x4*)(lds + k2 * 16384 + (lrow + 32 * i) * 128 + ((lch ^ (lrow & 7)) << 4)) = ldg16(sp + (size_t)(32 * i) * 128 + k2 * 64);
            }
            __syncthreads();
            f32x4 a2[4][4];
#pragma unroll
            for (int m = 0; m < 4; ++m)
#pragma unroll
                for (int n = 0; n < 4; ++n) a2[m][n] = (f32x4){0.f, 0.f, 0.f, 0.f};
#pragma unroll
            for (int k2 = 0; k2 < 2; ++k2)
#pragma unroll
                for (int s = 0; s < 2; ++s) {
                    bf16x8 xf[4], wf[4];
#pragma unroll
                    for (int m = 0; m < 4; ++m) { const int row = wm * 64 + m * 16 + c; xf[m] = as_bf16x8(*(const u32x4*)(lds + P4_QS + k2 * 16384 + row * 128 + (((4 * s + g) ^ (c & 7)) << 4))); }
#pragma unroll
                    for (int n = 0; n < 4; ++n) { const int row = wn * 64 + n * 16 + c; wf[n] = as_bf16x8(*(const u32x4*)(lds + k2 * 16384 + row * 128 + (((4 * s + g) ^ (c & 7)) << 4))); }
#pragma unroll
                    for (int m = 0; m < 4; ++m)
#pragma unroll
                        for (int n = 0; n < 4; ++n) a2[m][n] = mfma16(wf[n], xf[m], a2[m][n]);
                }
            __syncthreads();
#pragma unroll
            for (int m = 0; m < 4; ++m)
#pragma unroll
                for (int n = 0; n < 4; ++n) {
                    const int key0 = wn * 64 + 16 * n + 4 * g;
                    u32x4 w;
#pragma unroll
                    for (int r = 0; r < 4; ++r) w[r] = (unsigned)f2key(__uint_as_float((__float_as_uint(a2[m][n][r]) & 0xFFFFFF80u) | (unsigned)(key0 + r)));
                    *(u32x4*)(Ss + (wm * 64 + m * 16 + c) * P4_SS_STRIDE + key0) = w;
                }
            __syncthreads();
            int tv[16];
            {
                const int* rowp = (const int*)Ss + srow * P4_SS_STRIDE + shalf * 64;
#pragma unroll
                for (int bt = 0; bt < 4; ++bt) {
                    int bk[16];
#pragma unroll
                    for (int j = 0; j < 4; ++j) { const u32x4 v = *(const u32x4*)(rowp + 16 * bt + 4 * j); bk[4 * j] = (int)v.x; bk[4 * j + 1] = (int)v.y; bk[4 * j + 2] = (int)v.z; bk[4 * j + 3] = (int)v.w; }
                    bitonic_sort16(bk);
                    if (bt == 0) {
#pragma unroll
                        for (int j = 0; j < 16; ++j) tv[j] = bk[j];
                    } else top16_merge(tv, bk);
                }
            }
            __syncthreads();
            int* mbi = (int*)mbuf;
            if (shalf == 1) {
#pragma unroll
                for (int j = 0; j < 16; ++j) mbi[srow * 17 + j] = tv[j];
            }
            __syncthreads();
            if (shalf == 0) {
                int* dst = (int*)((ph == 0) ? st0 : st1);
                int ob[16];
#pragma unroll
                for (int j = 0; j < 16; ++j) ob[j] = mbi[srow * 17 + j];
                top16_merge(tv, ob);
#pragma unroll
                for (int j = 0; j < 16; ++j) dst[srow * 17 + j] = tv[j];
            }
        }
        __syncthreads();
        int cv[16];
        {
            const int* st0i = (const int*)st0; const int* st1i = (const int*)st1;
            float v2[16];
#pragma unroll
            for (int b = 0; b < 16; ++b) v2[b] = key2f(st1i[srow * 17 + b]);
#pragma unroll
            for (int a8 = 0; a8 < 8; ++a8) {
                const int a = shalf * 8 + a8; const float va = key2f(st0i[srow * 17 + a]);
                int bk[16];
#pragma unroll
                for (int b = 0; b < 16; ++b) bk[b] = (f2key(va + v2[b]) & (int)0xFFFFFF00) | (a * 16 + 15 - b);
                if (a8 == 0) {
#pragma unroll
                    for (int j = 0; j < 16; ++j) cv[j] = bk[j];
                } else top16_merge(cv, bk);
            }
        }
        __syncthreads();
        int* mbi = (int*)mbuf;
        if (shalf == 1) {
#pragma unroll
            for (int j = 0; j < 16; ++j) mbi[srow * 17 + j] = cv[j];
        }
        __syncthreads();
        if (shalf == 0) {
            const int* st0i = (const int*)st0; const int* st1i = (const int*)st1;
            int fk[16]; float fv[16];
#pragma unroll
            for (int j = 0; j < 16; ++j) { const int o = mbi[srow * 17 + 15 - j]; fk[j] = cv[j] > o ? cv[j] : o; fv[j] = key2f(fk[j]); }
            float cmax = fv[0];
#pragma unroll
            for (int j = 1; j < 16; ++j) cmax = fmaxf(cmax, fv[j]);
            float den = 0.f; float ev[16];
#pragma unroll
            for (int j = 0; j < 16; ++j) { ev[j] = __expf(fv[j] - cmax); den += ev[j]; }
            const float rden = 1.0f / den;
            const size_t ob = (size_t)(mt * 128 + srow) * 128 + head * 16;
#pragma unroll
            for (int j = 0; j < 16; ++j) {
                const unsigned cde = (unsigned)fk[j] & 0xFFu;
                const unsigned a = cde >> 4, b = 15u - (cde & 15u);
                const unsigned i1 = __float_as_uint(key2f(st0i[srow * 17 + a])) & 0x7Fu, i2 = __float_as_uint(key2f(st1i[srow * 17 + b])) & 0x7Fu;
                const int e = (int)(i1 * 128u + i2);
                PE[ob + j] = (unsigned short)e; PG[ob + j] = ev[j] * rden * SV[e]; PS[ob + j] = SU[e];
            }
        }
        __syncthreads();
    }
}

DI float gelu_exact(float z) { return 0.5f * z * (1.0f + erff(z * 0.70710678118654752f)); }
DI float rdlane(float v, int l) { return __int_as_float(__builtin_amdgcn_readlane(__float_as_int(v), l)); }

typedef float f32x2 __attribute__((ext_vector_type(2)));
DI void p5_gather(const Params& p) {
    unsigned char* ws = p.ws;
    const bf16_t* H1B = (const bf16_t*)(ws + WS_XB); const unsigned char* UT = ws + WS_UT; const unsigned char* VT = ws + WS_VT;
    const unsigned short* PE = (const unsigned short*)(ws + WS_PE); const float* PG = (const float*)(ws + WS_PG); const float* PS = (const float*)(ws + WS_PS);
    const int lane = threadIdx.x & 63, gw = blockIdx.x * 4 + (threadIdx.x >> 6), nw = gridDim.x * 4;
    const bool b5 = (lane & 32) != 0, b4 = (lane & 16) != 0, b3 = (lane & 8) != 0, b2 = (lane & 4) != 0, b1 = (lane & 2) != 0;
    for (int tok = gw; tok < NTOK; tok += nw) {
        float x[16], acc[16];
        {
            const u32x4 xa = ldg16(H1B + (size_t)tok * 1024 + lane * 16), xb = ldg16(H1B + (size_t)tok * 1024 + lane * 16 + 8);
            x[0] = bf_lo(xa.x); x[1] = bf_hi(xa.x); x[2] = bf_lo(xa.y); x[3] = bf_hi(xa.y); x[4] = bf_lo(xa.z); x[5] = bf_hi(xa.z); x[6] = bf_lo(xa.w); x[7] = bf_hi(xa.w);
            x[8] = bf_lo(xb.x); x[9] = bf_hi(xb.x); x[10] = bf_lo(xb.y); x[11] = bf_hi(xb.y); x[12] = bf_lo(xb.z); x[13] = bf_hi(xb.z); x[14] = bf_lo(xb.w); x[15] = bf_hi(xb.w);
        }
#pragma unroll
        for (int i = 0; i < 16; ++i) acc[i] = 0.f;
        const int pe_lo = (int)PE[(size_t)tok * 128 + lane], pe_hi = (int)PE[(size_t)tok * 128 + 64 + lane];
        const float pg_lo = PG[(size_t)tok * 128 + lane], pg_hi = PG[(size_t)tok * 128 + 64 + lane];
        const float ps_lo = PS[(size_t)tok * 128 + lane], ps_hi = PS[(size_t)tok * 128 + 64 + lane];
#pragma unroll 1
        for (int hb = 0; hb < 4; ++hb) {
            const int pes = hb < 2 ? pe_lo : pe_hi; const float pgs = hb < 2 ? pg_lo : pg_hi, pss = hb < 2 ? ps_lo : ps_hi;
            const int lb = (hb & 1) * 32;
            float d[32];
#pragma unroll
            for (int j = 0; j < 32; ++j) {
                const int e = __builtin_amdgcn_readlane(pes, lb + j);
                const u32x2 uw = *(const u32x2*)(UT + (size_t)e * 512 + lane * 8);
                float s = 0.f;
#define P5_DOT(k, bs) { const f32x2 f = __builtin_amdgcn_cvt_scalef32_pk_f32_fp4(uw[k], 1.0f, bs); s = fmaf(x[8 * (k) + 2 * (bs)], f.x, s); s = fmaf(x[8 * (k) + 2 * (bs) + 1], f.y, s); }
                P5_DOT(0, 0) P5_DOT(0, 1) P5_DOT(0, 2) P5_DOT(0, 3) P5_DOT(1, 0) P5_DOT(1, 1) P5_DOT(1, 2) P5_DOT(1, 3)
                d[j] = s;
            }
            float r16[16], r8[8], r4[4], r2[2], r1;
#pragma unroll
            for (int j = 0; j < 16; ++j) { const float keep = b5 ? d[j + 16] : d[j], send = b5 ? d[j] : d[j + 16]; r16[j] = keep + __shfl_xor(send, 32); }
#pragma unroll
            for (int j = 0; j < 8; ++j) { const float keep = b4 ? r16[j + 8] : r16[j], send = b4 ? r16[j] : r16[j + 8]; r8[j] = keep + __shfl_xor(send, 16); }
#pragma unroll
            for (int j = 0; j < 4; ++j) { const float keep = b3 ? r8[j + 4] : r8[j], send = b3 ? r8[j] : r8[j + 4]; r4[j] = keep + __shfl_xor(send, 8); }
#pragma unroll
            for (int j = 0; j < 2; ++j) { const float keep = b2 ? r4[j + 2] : r4[j], send = b2 ? r4[j] : r4[j + 2]; r2[j] = keep + __shfl_xor(send, 4); }
            { const float keep = b1 ? r2[1] : r2[0], send = b1 ? r2[0] : r2[1]; r1 = keep + __shfl_xor(send, 2); }
            r1 += __shfl_xor(r1, 1);
            const int mine = lb + ((lane >> 1) & 31);
            const float coef = gelu_exact(r1 * __shfl(pss, mine)) * __shfl(pgs, mine);
#pragma unroll
            for (int j = 0; j < 32; ++j) {
                const int e = __builtin_amdgcn_readlane(pes, lb + j);
                const float cj = rdlane(coef, 2 * j);
                const u32x2 vw = *(const u32x2*)(VT + (size_t)e * 512 + lane * 8);
#define P5_AXPY(k, bs) { const f32x2 f = __builtin_amdgcn_cvt_scalef32_pk_f32_fp4(vw[k], 1.0f, bs); acc[8 * (k) + 2 * (bs)] = fmaf(cj, f.x, acc[8 * (k) + 2 * (bs)]); acc[8 * (k) + 2 * (bs) + 1] = fmaf(cj, f.y, acc[8 * (k) + 2 * (bs) + 1]); }
                P5_AXPY(0, 0) P5_AXPY(0, 1) P5_AXPY(0, 2) P5_AXPY(0, 3) P5_AXPY(1, 0) P5_AXPY(1, 1) P5_AXPY(1, 2) P5_AXPY(1, 3)
            }
        }
        float s = 0.f;
#pragma unroll
        for (int i = 0; i < 16; ++i) { acc[i] = fmaf(ALPHA, x[i], acc[i]); s += acc[i]; }
        const float mu = wave_sum(s) * (1.f / 1024.f); float q = 0.f;
#pragma unroll
        for (int i = 0; i < 16; ++i) { const float dd = acc[i] - mu; q = fmaf(dd, dd, q); }
        const float rstd = rsqrtf(wave_sum(q) * (1.f / 1024.f) + LN_EPS);
#pragma unroll
        for (int k4 = 0; k4 < 4; ++k4) {
            const int col = lane * 16 + k4 * 4;
            const f32x4 gg = *(const f32x4*)(p.ln2_g + col), bb = *(const f32x4*)(p.ln2_b + col);
            f32x4 o;
#pragma unroll
            for (int e = 0; e < 4; ++e) o[e] = (acc[k4 * 4 + e] - mu) * rstd * gg[e] + bb[e];
            *(f32x4*)(p.out + (size_t)tok * 1024 + col) = o;
        }
    }
}

#define XB_TMO      128
#define XB_XCNT(j)  (256  + 64 * (j))
#define XB_XSUB(j)  (1280 + 64 * (j))
#define XB_XGEN(j)  (2304 + 64 * (j))
#define XB_TOP      3328
#define XB_TOPGEN   3392
#define XCD_BAR_WORDS 3456
#define XB_SPIN_CAP (1u << 22)
#define LAS __attribute__((address_space(3)))
DI unsigned xb_ld(unsigned* p)              { return __hip_atomic_load(p, __ATOMIC_RELAXED, __HIP_MEMORY_SCOPE_AGENT); }
DI unsigned xb_add(unsigned* p, unsigned v) { return __hip_atomic_fetch_add(p, v, __ATOMIC_RELAXED, __HIP_MEMORY_SCOPE_AGENT); }
DI unsigned xb_xcc_id() { return (unsigned)__builtin_amdgcn_s_getreg((3 << 11) | 20) & 0xFu; }
#define XB_SPIN(cond, bar) do { unsigned _sp = 0; while (cond) { __builtin_amdgcn_s_sleep(1); \
    if ((++_sp & 255u) == 0u) { if (xb_ld(&(bar)[XB_TMO])) break; if (_sp > XB_SPIN_CAP) { atomicAdd(&(bar)[XB_TMO], 1u); break; } } } } while (0)
struct XcdBarrier { unsigned* bar; unsigned x; volatile LAS unsigned* st; };
DI XcdBarrier xcd_barrier_post(unsigned* bar, volatile LAS unsigned* st) {
    XcdBarrier b; b.bar = bar; b.x = xb_xcc_id(); b.st = st;
    if (threadIdx.x == 0) (void)xb_add(&bar[XB_XCNT(b.x)], 1u);
    return b;
}
DI void xcd_barrier_complete(unsigned* bar, unsigned x, unsigned& nloc, unsigned& nx) {
    const unsigned G = gridDim.x * gridDim.y * gridDim.z;
    unsigned sum, cnt, mine, sp = 0u;
    for (;;) {
        sum = 0u; cnt = 0u; mine = 0u;
#pragma unroll
        for (unsigned j = 0; j < 16; ++j) { const unsigned c = xb_ld(&bar[XB_XCNT(j)]); sum += c; cnt += (c > 0u) ? 1u : 0u; mine = (j == x) ? c : mine; }
        if (sum == G) break;
        __builtin_amdgcn_s_sleep(1);
        if ((++sp & 255u) == 0u) { if (xb_ld(&bar[XB_TMO])) break; if (sp > XB_SPIN_CAP) { atomicAdd(&bar[XB_TMO], 1u); break; } }
    }
    nloc = mine > 0u ? mine : 1u; nx = cnt > 0u ? cnt : 1u;
}
DI void xcd_barrier(const XcdBarrier& b) {
    asm volatile("s_waitcnt vmcnt(0)" ::: "memory");
    __syncthreads();
    if (threadIdx.x == 0) {
        unsigned* bar = b.bar;
        __builtin_amdgcn_s_waitcnt(0);
        unsigned nloc = b.st[0], nx = b.st[1];
        if (nloc == 0u) { xcd_barrier_complete(bar, b.x, nloc, nx); b.st[0] = nloc; b.st[1] = nx; }
        const unsigned old = xb_add(&bar[XB_XSUB(b.x)], 1u);
        const unsigned gen = old / nloc;
        if (old + 1u == (gen + 1u) * nloc) {
            __builtin_amdgcn_fence(__ATOMIC_RELEASE, "agent");
            asm volatile("s_waitcnt vmcnt(0)" ::: "memory");
            const unsigned og = xb_add(&bar[XB_TOP], 1u);
            const unsigned tg = og / nx;
            if (og + 1u == (tg + 1u) * nx) xb_add(&bar[XB_TOPGEN], 1u);
            else XB_SPIN(xb_ld(&bar[XB_TOPGEN]) == tg, bar);
            __builtin_amdgcn_fence(__ATOMIC_ACQUIRE, "agent");
            xb_add(&bar[XB_XGEN(b.x)], 1u);
            asm volatile("s_waitcnt vmcnt(0)" ::: "memory");
        } else {
            XB_SPIN(xb_ld(&bar[XB_XGEN(b.x)]) == gen, bar);
            __builtin_amdgcn_fence(__ATOMIC_ACQUIRE, "agent");
            asm volatile("s_waitcnt vmcnt(0)" ::: "memory");
        }
    }
    __syncthreads();
}

constexpr int NPHASE = 7;
__global__ void __launch_bounds__(NTHREADS, 2) mega_fwd(Params p) {
    extern __shared__ __attribute__((aligned(16))) unsigned char lds[];
    cg::grid_group grid = cg::this_grid();
    const int lo = p.ph_lo, hi = p.ph_hi;
    volatile LAS unsigned* xbst = (volatile LAS unsigned*)(LAS unsigned char*)(lds + LDS_BYTES - 16);
#ifndef REP_MASK
#define REP_MASK 0
#endif
#ifndef P2_PROBE_MODE
#define P2_PROBE_MODE 15
#endif
#ifndef PH_MASK
#define PH_MASK 127
#endif
    if (lo == 0x7fffffff) grid.sync();
    if (threadIdx.x == 0) { xbst[0] = 0u; xbst[1] = 0u; }
    __syncthreads();
    XcdBarrier xb = xcd_barrier_post((unsigned*)(p.ws + WS_BAR), xbst);
#define GSYNC() xcd_barrier(xb)
    p0_prep(p, lds);
    GSYNC();
#define RUN_PHASE(k, call) { call; if ((REP_MASK >> (k)) & 1) { GSYNC(); call; } }
#if PH_MASK & 2
    RUN_PHASE(1, p1_inproj(p, lds))
#endif
    GSYNC();
#if PH_MASK & 4
#if (REP_MASK >> 2) & 1
    p2_attention<P2_PROBE_MODE>(p, lds, 1); GSYNC();
#endif
    p2_attention<15>(p, lds, 0);
#endif
    GSYNC();
#if PH_MASK & 8
    RUN_PHASE(3, p3_outproj(p, lds))
#endif
    GSYNC();
#if PH_MASK & 16
    RUN_PHASE(4, p3b_ln1(p))
#endif
    GSYNC();
#if PH_MASK & 32
    RUN_PHASE(5, p4_peer_query(p, lds))
#endif
    GSYNC();
#if PH_MASK & 64
    RUN_PHASE(6, p5_gather(p))
#endif
}

#ifndef MK_N_LAUNCHES
#define MK_N_LAUNCHES 1
#endif

extern "C" void kernel_launch(void* const* d_in, const int* in_sizes, int n_in, void* d_out, int out_size, void* d_ws, size_t ws_size, hipStream_t stream) {
    static int grid_blocks = 0;
    if (grid_blocks == 0) {
        if (n_in != 14 || out_size != NTOK * D_MODEL || ws_size < WS_END) {
            fprintf(stderr, "kernel_launch: unexpected problem (n_in %d, out %d, ws %zu, need %zu)\n", n_in, out_size, ws_size, (size_t)WS_END); grid_blocks = -1; return;
        }
        int dev = 0, cus = 0, per_cu = 0;
        hipGetDevice(&dev);
        hipDeviceGetAttribute(&cus, hipDeviceAttributeMultiprocessorCount, dev);
        if (hipFuncSetAttribute((const void*)mega_fwd, hipFuncAttributeMaxDynamicSharedMemorySize, LDS_BYTES) != hipSuccess) { fprintf(stderr, "kernel_launch: hipFuncSetAttribute failed\n"); }
        if (hipOccupancyMaxActiveBlocksPerMultiprocessor(&per_cu, (const void*)mega_fwd, NTHREADS, LDS_BYTES) != hipSuccess || per_cu < 1) { fprintf(stderr, "kernel_launch: occupancy query failed\n"); per_cu = 1; }
        if (per_cu > 2) per_cu = 2;
        (void)hipGetLastError();
        grid_blocks = cus * per_cu;
        fprintf(stderr, "kernel_launch: %d CUs x %d blocks\n", cus, per_cu);
    }
    if (grid_blocks < 0) return;
    Params p{};
    p.x = (const float*)d_in[0]; p.w_in = (const float*)d_in[1]; p.idx_k_g = (const float*)d_in[2]; p.idx_k_b = (const float*)d_in[3]; p.sinks = (const float*)d_in[4];
    p.w_o = (const float*)d_in[5]; p.ln1_g = (const float*)d_in[6]; p.ln1_b = (const float*)d_in[7]; p.peer_wq = (const float*)d_in[8]; p.peer_subkeys = (const float*)d_in[9];
    p.peer_u = (const float*)d_in[10]; p.peer_v = (const float*)d_in[11]; p.ln2_g = (const float*)d_in[12]; p.ln2_b = (const float*)d_in[13];
    p.out = (float*)d_out; p.ws = (unsigned char*)d_ws;
    p.ph_lo = 0; p.ph_hi = NPHASE;
    if (hipMemsetAsync((unsigned char*)d_ws + WS_BAR, 0, XCD_BAR_WORDS * 4, stream) != hipSuccess) { fprintf(stderr, "kernel_launch: memset of the barrier words failed\n"); return; }
    void* args[] = {&p};
    hipError_t e = hipLaunchCooperativeKernel((const void*)mega_fwd, dim3(grid_blocks), dim3(NTHREADS), args, LDS_BYTES, stream);
    if (e != hipSuccess) fprintf(stderr, "cooperative launch failed: %s (grid %d)\n", hipGetErrorString(e), grid_blocks);
}
```

```cpp
#include <hip/hip_runtime.h>
#include <hip/hip_cooperative_groups.h>
#include <cstdio>
#include <cstdint>
namespace cg = cooperative_groups;

typedef unsigned short bf16_t;
typedef short bf16x8 __attribute__((ext_vector_type(8)));
typedef float f32x4 __attribute__((ext_vector_type(4)));
typedef float f32x16 __attribute__((ext_vector_type(16)));
typedef unsigned u32x4 __attribute__((ext_vector_type(4)));
typedef unsigned u32x2 __attribute__((ext_vector_type(2)));
#define DI __device__ __forceinline__

constexpr int D_MODEL = 1024, BATCH = 8, SEQ = 4096, NTOK = BATCH * SEQ;
constexpr int NMIX = 1732, NMIX_PAD = 1792;
constexpr int PEER_N = 2048;
constexpr float ALPHA = 1.189207115002721f;
constexpr float LN_EPS = 1e-5f;
constexpr int NTHREADS = 256;
constexpr int LDS_BYTES = 77824;

constexpr size_t MB = 1024 * 1024;
constexpr size_t WS_CTL   = 0;
constexpr size_t WS_BAR   = 65536;
constexpr size_t WS_ROPE  = 1 * MB;
constexpr size_t WS_WINT  = 2 * MB;
constexpr size_t WS_WOT   = 6 * MB;
constexpr size_t WS_WQT   = 8 * MB;
constexpr size_t WS_SK    = 12 * MB;
constexpr size_t WS_UT    = 13 * MB;
constexpr size_t WS_VT    = 29 * MB;
constexpr size_t WS_SU    = 45 * MB;
constexpr size_t WS_SV    = 46 * MB;
constexpr size_t WS_XB    = 77 * MB;
constexpr size_t WS_QA    = 141 * MB;
constexpr size_t WS_KA    = 173 * MB;
constexpr size_t WS_VA    = 181 * MB;
constexpr size_t WS_QB    = 189 * MB;
constexpr size_t WS_KB    = 221 * MB;
constexpr size_t WS_VB    = 225 * MB;
constexpr size_t WS_QI    = 229 * MB;
constexpr size_t WS_KI    = 245 * MB;
constexpr size_t WS_WI    = 249 * MB;
constexpr size_t WS_ATT   = 250 * MB;
constexpr size_t WS_PE    = 314 * MB;
constexpr size_t WS_PG    = 322 * MB;
constexpr size_t WS_PS    = 338 * MB;
constexpr size_t WS_END   = 354 * MB;

struct Params {
    const float* x; const float* w_in; const float* idx_k_g; const float* idx_k_b; const float* sinks; const float* w_o;
    const float* ln1_g; const float* ln1_b; const float* peer_wq; const float* peer_subkeys; const float* peer_u; const float* peer_v;
    const float* ln2_g; const float* ln2_b;
    float* out; unsigned char* ws;
    int ph_lo, ph_hi;
};

DI unsigned f2bf(float x) { unsigned u = __float_as_uint(x); u += 0x7fffu + ((u >> 16) & 1u); return u >> 16; }
DI unsigned pack_bf16(float lo, float hi) { return f2bf(lo) | (f2bf(hi) << 16); }
DI float bf_lo(unsigned w) { return __uint_as_float(w << 16); }
DI float bf_hi(unsigned w) { return __uint_as_float(w & 0xffff0000u); }
DI bf16x8 as_bf16x8(u32x4 v) { return __builtin_bit_cast(bf16x8, v); }
DI u32x4 ldg16(const void* p) { return *(const u32x4*)p; }
DI f32x4 mfma16(bf16x8 a, bf16x8 b, f32x4 c) { return __builtin_amdgcn_mfma_f32_16x16x32_bf16(a, b, c, 0, 0, 0); }
DI f32x16 mfma32(bf16x8 a, bf16x8 b, f32x16 c) { return __builtin_amdgcn_mfma_f32_32x32x16_bf16(a, b, c, 0, 0, 0); }
DI float wave_sum(float v) {
#pragma unroll
    for (int o = 32; o >= 1; o >>= 1) v += __shfl_xor(v, o);
    return v;
}

DI void glds16(const void* src, void* lds_dst) { __builtin_amdgcn_global_load_lds((const unsigned*)src, (__attribute__((address_space(3))) unsigned*)lds_dst, 16, 0, 0); }
DI void gemm_128x128(const bf16_t* __restrict__ X, int ldx, const bf16_t* __restrict__ Wt, int ldw, int K, unsigned char* lds, f32x4 (&acc)[4][4]) {
    int tid = threadIdx.x; asm volatile("" : "+v"(tid));
    const int lane = tid & 63, wave = tid >> 6, wm = wave >> 1, wn = wave & 1, c = lane & 15, g = lane >> 4;
    const int lrow = tid >> 3, lch = tid & 7;
    const bf16_t* xp = X + (size_t)lrow * ldx + ((lch ^ (lrow & 7)) * 8);
    const bf16_t* wp = Wt + (size_t)lrow * ldw + ((lch ^ (lrow & 7)) * 8);
    unsigned char* dst0 = lds + tid * 16;
#pragma unroll
    for (int m = 0; m < 4; ++m)
#pragma unroll
        for (int n = 0; n < 4; ++n) acc[m][n] = (f32x4){0.f, 0.f, 0.f, 0.f};
    const int nk = K / 64;
    __syncthreads();
#pragma unroll
    for (int i = 0; i < 4; ++i) { glds16(xp + (size_t)(32 * i) * ldx, dst0 + i * 4096); glds16(wp + (size_t)(32 * i) * ldw, dst0 + 16384 + i * 4096); }
    asm volatile("s_waitcnt vmcnt(0)" ::: "memory");
    __syncthreads();
    for (int kt = 0; kt < nk; ++kt) {
        const unsigned char* Xs = lds + (kt & 1) * 32768; const unsigned char* Ws = Xs + 16384;
        if (kt + 1 < nk) {
            unsigned char* d = dst0 + ((kt + 1) & 1) * 32768;
#pragma unroll
            for (int i = 0; i < 4; ++i) { glds16(xp + (size_t)(32 * i) * ldx + (kt + 1) * 64, d + i * 4096); glds16(wp + (size_t)(32 * i) * ldw + (kt + 1) * 64, d + 16384 + i * 4096); }
        }
#pragma unroll
        for (int s = 0; s < 2; ++s) {
            bf16x8 xf[4], wf[4];
#pragma unroll
            for (int m = 0; m < 4; ++m) { const int row = wm * 64 + m * 16 + c; xf[m] = as_bf16x8(*(const u32x4*)(Xs + row * 128 + (((4 * s + g) ^ (c & 7)) << 4))); }
#pragma unroll
            for (int n = 0; n < 4; ++n) { const int row = wn * 64 + n * 16 + c; wf[n] = as_bf16x8(*(const u32x4*)(Ws + row * 128 + (((4 * s + g) ^ (c & 7)) << 4))); }
#pragma unroll
            for (int m = 0; m < 4; ++m)
#pragma unroll
                for (int n = 0; n < 4; ++n) acc[m][n] = mfma16(wf[n], xf[m], acc[m][n]);
        }
        asm volatile("s_waitcnt vmcnt(0)" ::: "memory");
        __syncthreads();
    }
}

DI bool tile_of(int k, int NT, int MT, int& mt, int& nt) {
    const int G = gridDim.x, bid = blockIdx.x;
    if (((G | MT) & 7) == 0) {
        const int idx = (bid >> 3) + k * (G >> 3);
        if (idx >= (MT >> 3) * NT) return false;
        mt = (idx / NT) * 8 + (bid & 7); nt = idx % NT;
    } else {
        const int t = bid + k * G;
        if (t >= MT * NT) return false;
        mt = t / NT; nt = t % NT;
    }
    return true;
}

DI void p0_prep(const Params& p, unsigned char* lds) {
    const int tid = threadIdx.x, nb = gridDim.x, bid = blockIdx.x;
    const size_t gtid = (size_t)bid * NTHREADS + tid, gsz = (size_t)nb * NTHREADS;
    unsigned char* ws = p.ws;
    {
        float* ct = (float*)(ws + WS_ROPE); float* stb = ct + SEQ * 32;
        for (size_t i = gtid; i < (size_t)SEQ * 32; i += gsz) {
            const int pos = (int)(i >> 5), fi = (int)(i & 31);
            const float inv = powf(10000.0f, -(float)(2 * fi) / 64.0f);
            const float ang = (float)pos * inv;
            ct[i] = cosf(ang); stb[i] = sinf(ang);
        }
    }
    auto conv = [&](const float* src, bf16_t* dst, size_t n) {
        for (size_t i = gtid * 8; i < n; i += gsz * 8) {
            const f32x4 a = *(const f32x4*)(src + i), b = *(const f32x4*)(src + i + 4);
            u32x4 o; o.x = pack_bf16(a.x, a.y); o.y = pack_bf16(a.z, a.w); o.z = pack_bf16(b.x, b.y); o.w = pack_bf16(b.z, b.w);
            *(u32x4*)(dst + i) = o;
        }
    };
    conv(p.x, (bf16_t*)(ws + WS_XB), (size_t)NTOK * D_MODEL);
    {
        const int lane = tid & 63, gw = bid * 4 + (tid >> 6), nw = nb * 4;
        for (int row = gw; row < 2 * 16384; row += nw) {
            const bool isv = row >= 16384; const int e = isv ? row - 16384 : row;
            const float* src = (isv ? p.peer_v : p.peer_u) + (size_t)e * 1024 + lane * 16;
            f32x4 v[4]; float mx = 0.f;
#pragma unroll
            for (int i = 0; i < 4; ++i) { v[i] = *(const f32x4*)(src + 4 * i); mx = fmaxf(mx, fmaxf(fmaxf(fabsf(v[i][0]), fabsf(v[i][1])), fmaxf(fabsf(v[i][2]), fabsf(v[i][3])))); }
#pragma unroll
            for (int o = 32; o >= 1; o >>= 1) mx = fmaxf(mx, __shfl_xor(mx, o));
            const float sc = mx > 0.f ? mx * (1.0f / 5.99f) : 1.0f, inv = mx > 0.f ? 5.99f / mx : 1.0f;
            u32x2 o2;
#pragma unroll
            for (int k = 0; k < 2; ++k) {
                unsigned w = 0;
                w = __builtin_amdgcn_cvt_scalef32_pk_fp4_f32(w, v[2 * k][0] * inv, v[2 * k][1] * inv, 1.0f, 0);
                w = __builtin_amdgcn_cvt_scalef32_pk_fp4_f32(w, v[2 * k][2] * inv, v[2 * k][3] * inv, 1.0f, 1);
                w = __builtin_amdgcn_cvt_scalef32_pk_fp4_f32(w, v[2 * k + 1][0] * inv, v[2 * k + 1][1] * inv, 1.0f, 2);
                w = __builtin_amdgcn_cvt_scalef32_pk_fp4_f32(w, v[2 * k + 1][2] * inv, v[2 * k + 1][3] * inv, 1.0f, 3);
                o2[k] = w;
            }
            *(u32x2*)(ws + (isv ? WS_VT : WS_UT) + (size_t)e * 512 + lane * 8) = o2;
            if (lane == 0) ((float*)(ws + (isv ? WS_SV : WS_SU)))[e] = sc;
        }
    }
    conv(p.peer_subkeys, (bf16_t*)(ws + WS_SK), (size_t)8 * 2 * 128 * 128);
    float* tl = (float*)lds;
    auto transp = [&](const float* src, bf16_t* dst, int N, int Npad) {
        const int tn = Npad / 64, tk = 1024 / 64;
        for (int t = bid; t < tn * tk; t += nb) {
            const int n0 = (t % tn) * 64, k0 = (t / tn) * 64;
            __syncthreads();
            for (int e = tid; e < 4096; e += NTHREADS) { const int kk = e >> 6, nn = e & 63; tl[kk * 65 + nn] = (n0 + nn < N) ? src[(size_t)(k0 + kk) * N + n0 + nn] : 0.f; }
            __syncthreads();
            for (int e = tid; e < 4096; e += NTHREADS) { const int nn = e >> 6, kk = e & 63; dst[(size_t)(n0 + nn) * 1024 + k0 + kk] = (bf16_t)f2bf(tl[kk * 65 + nn]); }
        }
    };
    transp(p.w_in, (bf16_t*)(ws + WS_WINT), NMIX, NMIX_PAD);
    transp(p.w_o, (bf16_t*)(ws + WS_WOT), 1024, 1024);
    transp(p.peer_wq, (bf16_t*)(ws + WS_WQT), PEER_N, PEER_N);
}

DI void p1_inproj(const Params& p, unsigned char* lds) {
    unsigned char* ws = p.ws;
    const bf16_t* XB = (const bf16_t*)(ws + WS_XB); const bf16_t* WT = (const bf16_t*)(ws + WS_WINT);
    const float* cosT = (const float*)(ws + WS_ROPE); const float* sinT = cosT + SEQ * 32;
    const int tid = threadIdx.x, lane = tid & 63, wave = tid >> 6, wm = wave >> 1, wn = wave & 1, c = lane & 15, g = lane >> 4;
    constexpr int NT = NMIX_PAD / 128, MT = NTOK / 128;
    int mt, nt;
    for (int k = 0; tile_of(k, NT, MT, mt, nt); ++k) {
        f32x4 acc[4][4];
        gemm_128x128(XB + (size_t)mt * 128 * 1024, 1024, WT + (size_t)nt * 128 * 1024, 1024, 1024, lds, acc);
        const int col64 = nt * 2 + wn;
        bf16_t* dst; int ld, coff; bool rope = true; float scale = 1.f;
        if (col64 < 8)       { dst = (bf16_t*)(ws + WS_QA); ld = 512; coff = col64 * 64; scale = 0.125f; }
        else if (col64 < 10) { dst = (bf16_t*)(ws + WS_KA); ld = 128; coff = (col64 - 8) * 64; }
        else if (col64 < 12) { dst = (bf16_t*)(ws + WS_VA); ld = 128; coff = (col64 - 10) * 64; rope = false; }
        else if (col64 < 20) { dst = (bf16_t*)(ws + WS_QB); ld = 512; coff = (col64 - 12) * 64; scale = 0.125f; }
        else if (col64 == 20) { dst = (bf16_t*)(ws + WS_KB); ld = 64; coff = 0; }
        else if (col64 == 21) { dst = (bf16_t*)(ws + WS_VB); ld = 64; coff = 0; rope = false; }
        else if (col64 < 26) { dst = (bf16_t*)(ws + WS_QI); ld = 256; coff = (col64 - 22) * 64; }
        else                 { dst = (bf16_t*)(ws + WS_KI); ld = 64; coff = 0; }
        if (col64 == 27) {
            if (g == 0) {
#pragma unroll
                for (int m = 0; m < 4; ++m) { const int tok = mt * 128 + wm * 64 + m * 16 + c; *(f32x4*)((float*)(ws + WS_WI) + (size_t)tok * 4) = acc[m][0] * 0.0625f; }
            }
            continue;
        }
#pragma unroll
        for (int m = 0; m < 4; ++m) {
            const int tok = mt * 128 + wm * 64 + m * 16 + c, pos = tok & (SEQ - 1);
            f32x4 v[4] = {acc[m][0], acc[m][1], acc[m][2], acc[m][3]};
            if (col64 == 26) {
                float s = 0.f;
#pragma unroll
                for (int n = 0; n < 4; ++n) s += (v[n][0] + v[n][1]) + (v[n][2] + v[n][3]);
                s += __shfl_xor(s, 16); s += __shfl_xor(s, 32);
                const float mu = s * (1.f / 64.f); float q = 0.f;
#pragma unroll
                for (int n = 0; n < 4; ++n) { const f32x4 d = v[n] - mu; q += (d[0] * d[0] + d[1] * d[1]) + (d[2] * d[2] + d[3] * d[3]); }
                q += __shfl_xor(q, 16); q += __shfl_xor(q, 32);
                const float rstd = rsqrtf(q * (1.f / 64.f) + LN_EPS);
#pragma unroll
                for (int n = 0; n < 4; ++n) {
                    const f32x4 gg = *(const f32x4*)(p.idx_k_g + 16 * n + 4 * g), bb = *(const f32x4*)(p.idx_k_b + 16 * n + 4 * g);
                    v[n] = (v[n] - mu) * rstd * gg + bb;
                }
            }
            if (rope) {
#pragma unroll
                for (int n = 0; n < 2; ++n) {
                    const f32x4 cs = *(const f32x4*)(cosT + pos * 32 + 16 * n + 4 * g), sn = *(const f32x4*)(sinT + pos * 32 + 16 * n + 4 * g);
                    const f32x4 t1 = v[n], t2 = v[n + 2];
                    v[n] = t1 * cs - t2 * sn; v[n + 2] = t2 * cs + t1 * sn;
                }
            }
#pragma unroll
            for (int n = 0; n < 4; ++n) {
                const f32x4 o = v[n] * scale; u32x2 w; w.x = pack_bf16(o[0], o[1]); w.y = pack_bf16(o[2], o[3]);
                *(u32x2*)(dst + (size_t)tok * ld + coff + 16 * n + 4 * g) = w;
            }
        }
    }
}

constexpr int NDSA = NTOK / 4, NSWA = BATCH * 32 * 8;
constexpr int P2_STG = 0  , P2_LIST = 32768;

DI unsigned f16_key(float v) {
    _Float16 hv = (_Float16)v; unsigned short hb = __builtin_bit_cast(unsigned short, hv); unsigned b = hb;
    if (b == 0x8000u) b = 0u;
    return (b & 0x8000u) ? ((~b) & 0xffffu) : (b | 0x8000u);
}

DI size_t sc_row_off(int t) { const size_t m = (size_t)(t >> 3); return 8 * (4 * m * (m + 1) + (size_t)(t & 7) * (m + 1)); }
constexpr size_t SC_BATCH = 8404992;
DI unsigned short* sc_batch_base(const Params& p, int b) { return (b < 7) ? (unsigned short*)p.out + (size_t)b * SC_BATCH : (unsigned short*)(p.ws + WS_XB); }

DI void p2a_indexer(const Params& p, unsigned char* lds) {
    unsigned char* ws = p.ws;
    const bf16_t* QI = (const bf16_t*)(ws + WS_QI); const bf16_t* KI = (const bf16_t*)(ws + WS_KI); const float* WI = (const float*)(ws + WS_WI);
    const int G = gridDim.x, bi = blockIdx.x;
    for (int it = 0; it < 2; ++it) {
        const int item = (it == 0) ? bi : 1023 - bi;
        for (int id = (G == 512) ? item : bi + it * G; id < 1024; id += (G == 512) ? 1024 : 2 * G) {
            int tid = threadIdx.x; asm volatile("" : "+v"(tid));
            const int lane = tid & 63, wave = tid >> 6, c = lane & 15, g = lane >> 4, lrow = tid >> 3, lch = tid & 7;
            const int b = id >> 7, t0 = (id & 127) * 32, tokw = b * SEQ + t0 + 8 * wave;
            unsigned short* scb = sc_batch_base(p, b);
            bf16x8 af[2][2]; f32x4 wv[2];
#pragma unroll
            for (int rt = 0; rt < 2; ++rt) {
#pragma unroll
                for (int s2 = 0; s2 < 2; ++s2) af[rt][s2] = as_bf16x8(ldg16(QI + (size_t)(tokw + 4 * rt + (c >> 2)) * 256 + (c & 3) * 64 + 32 * s2 + 8 * g));
                wv[rt] = *(const f32x4*)(WI + (size_t)(tokw + 4 * rt + g) * 4);
            }
            asm volatile("" :: "v"(af[0][0]), "v"(af[0][1]), "v"(af[1][0]), "v"(af[1][1]), "v"(wv[0]), "v"(wv[1]));
            const int nkt = ((t0 + 31) >> 7) + 1;
            const unsigned char* kib = (const unsigned char*)(KI + (size_t)b * SEQ * 64);
            unsigned char* dst0 = lds + tid * 16;
            auto stage = [&](int kt, int buf) {
#pragma unroll
                for (int i = 0; i < 4; ++i) {
                    const int row = lrow + 32 * i;
                    glds16(kib + (size_t)(kt * 128 + row) * 128 + ((lch ^ ((row >> 3) & 7)) << 4), dst0 + buf * 16384 + i * 4096);
                }
            };
            __syncthreads();
            stage(0, 0);
            asm volatile("s_waitcnt vmcnt(0)" ::: "memory");
            __syncthreads();
            for (int kt = 0; kt < nkt; ++kt) {
                const unsigned char* Ks = lds + (kt & 1) * 16384;
                if (kt + 1 < nkt) stage(kt + 1, (kt + 1) & 1);
                unsigned res[2][4];
#pragma unroll
                for (int ct = 0; ct < 8; ++ct) {
                    const int row = 8 * c + ct;
                    const bf16x8 k0 = as_bf16x8(*(const u32x4*)(Ks + row * 128 + ((g ^ (c & 7)) << 4)));
                    const bf16x8 k1 = as_bf16x8(*(const u32x4*)(Ks + row * 128 + (((4 + g) ^ (c & 7)) << 4)));
#pragma unroll
                    for (int rt = 0; rt < 2; ++rt) {
                        f32x4 d = mfma16(af[rt][0], k0, (f32x4){0.f, 0.f, 0.f, 0.f});
                        d = mfma16(af[rt][1], k1, d);
                        const float sv = wv[rt][0] * fmaxf(d[0], 0.f) + wv[rt][1] * fmaxf(d[1], 0.f) + wv[rt][2] * fmaxf(d[2], 0.f) + wv[rt][3] * fmaxf(d[3], 0.f);
                        const int key = kt * 128 + row, tq = t0 + 8 * wave + 4 * rt + g;
                        const unsigned kv = (key <= tq) ? f16_key(sv) : 0u;
                        if (ct & 1) res[rt][ct >> 1] |= kv << 16; else res[rt][ct >> 1] = kv;
                    }
                }
#pragma unroll
                for (int rt = 0; rt < 2; ++rt) {
                    const int tq = t0 + 8 * wave + 4 * rt + g;
                    if (16 * kt + c <= (tq >> 3)) {
                        u32x4 w; w.x = res[rt][0]; w.y = res[rt][1]; w.z = res[rt][2]; w.w = res[rt][3];
                        *(u32x4*)(scb + sc_row_off(tq) + kt * 128 + 8 * c) = w;
                    }
                }
                asm volatile("s_waitcnt vmcnt(0)" ::: "memory");
                __syncthreads();
            }
        }
    }
}

template <int MODE> DI void p2_dsa_item(const Params& p, unsigned char* lds, int b, int tb) {
    unsigned char* ws = p.ws;
    const bf16_t* QI = (const bf16_t*)(ws + WS_QI); const bf16_t* KI = (const bf16_t*)(ws + WS_KI); const float* WI = (const float*)(ws + WS_WI);
    const bf16_t* QB = (const bf16_t*)(ws + WS_QB); const bf16_t* KB = (const bf16_t*)(ws + WS_KB); const bf16_t* VB = (const bf16_t*)(ws + WS_VB);
    bf16_t* ATT = (bf16_t*)(ws + WS_ATT);
    int tid = threadIdx.x; asm volatile("" : "+v"(tid));
    const int lane = tid & 63, wave = __builtin_amdgcn_readfirstlane(tid >> 6), c = lane & 15, g = lane >> 4;
    const int t0 = tb * 4, tok0 = b * SEQ + t0;
    unsigned char* stg = lds + P2_STG + wave * 8192;
    unsigned* hist = (unsigned*)stg;
    unsigned short* list = (unsigned short*)(lds + P2_LIST) + wave * 256;
    const int tok = tok0 + wave;
    if (!(MODE & 2)) return;
    const int n = t0 + wave + 1;
    const int L = n < 256 ? n : 256;
    const unsigned short* myk = sc_batch_base(p, b) + sc_row_off(t0 + wave);
    if (n <= 256) {
        for (int i = lane; i < n; i += 64) list[i] = (unsigned short)i;
    } else {
        u32x4 kk[8];
#pragma unroll
        for (int i = 0; i < 8; ++i) kk[i] = (512 * i + 8 * lane < n) ? ldg16(myk + 512 * i + 8 * lane) : (u32x4){0u, 0u, 0u, 0u};
#pragma unroll
        for (int i = 0; i < 4; ++i) *(u32x4*)(hist + lane * 16 + i * 4) = (u32x4){0u, 0u, 0u, 0u};
#pragma unroll
        for (int i = 0; i < 8; ++i) {
            if (512 * i < n) {
#pragma unroll
                for (int w = 0; w < 4; ++w) { const unsigned wd = kk[i][w]; atomicAdd(&hist[(wd & 0xffffu) >> 6], 1u); atomicAdd(&hist[wd >> 22], 1u); }
            }
        }
        unsigned h[16];
#pragma unroll
        for (int i = 0; i < 4; ++i) { const u32x4 t = *(const u32x4*)(hist + lane * 16 + i * 4); h[4 * i] = t.x; h[4 * i + 1] = t.y; h[4 * i + 2] = t.z; h[4 * i + 3] = t.w; }
#pragma unroll
        for (int i = 0; i < 4; ++i) *(u32x4*)(hist + lane * 16 + i * 4) = (u32x4){0u, 0u, 0u, 0u};
        unsigned sl = 0;
#pragma unroll
        for (int i = 0; i < 16; ++i) sl += h[i];
        unsigned pre = sl;
#pragma unroll
        for (int o = 1; o < 64; o <<= 1) { const unsigned t = __shfl_up(pre, o); if (lane >= o) pre += t; }
        const unsigned tot = __shfl(pre, 63);
        const unsigned suf = tot - pre;
        int found = -1; unsigned cab = 0, cum = suf;
#pragma unroll
        for (int j = 15; j >= 0; --j) { const bool hit = (found < 0) && (cum + h[j] >= 256u); if (hit) { found = lane * 16 + j; cab = cum; } cum += h[j]; }
        const bool mine = (suf < 256u) && (suf + sl >= 256u);
        const unsigned long long mm = __ballot(mine);
        const int src = __ffsll((long long)mm) - 1;
        const unsigned bstar = (unsigned)__shfl(found, src), cabove = __shfl(cab, src);
        const unsigned r1 = 256u - cabove;
#pragma unroll
        for (int i = 0; i < 8; ++i) {
            if (512 * i < n) {
#pragma unroll
                for (int w = 0; w < 4; ++w) {
                    const unsigned wd = kk[i][w];
                    if (((wd & 0xffffu) >> 6) == bstar) atomicAdd(&hist[wd & 63u], 1u);
                    if ((wd >> 22) == bstar) atomicAdd(&hist[(wd >> 16) & 63u], 1u);
                }
            }
        }
        const unsigned cnt = hist[lane];
        hist[lane] = 0u;
        unsigned pre2 = cnt;
#pragma unroll
        for (int o = 1; o < 64; o <<= 1) { const unsigned t = __shfl_up(pre2, o); if (lane >= o) pre2 += t; }
        const unsigned tot2 = __shfl(pre2, 63);
        const unsigned suf2 = tot2 - pre2;
        const bool mine2 = (suf2 < r1) && (suf2 + cnt >= r1);
        const unsigned long long mm2 = __ballot(mine2);
        const int src2 = __ffsll((long long)mm2) - 1;
        const unsigned T = (bstar << 6) | (unsigned)src2;
        const unsigned req = r1 - __shfl(suf2, src2);
        const unsigned toteq = __shfl(cnt, src2);
        const bool alleq = (req == toteq);
        const unsigned Tt = alleq ? T : T + 1u;
        unsigned cg = 0;
#pragma unroll
        for (int i = 0; i < 8; ++i)
#pragma unroll
            for (int w = 0; w < 4; ++w) { const unsigned wd = kk[i][w]; cg += ((wd & 0xffffu) >= Tt) ? 1u : 0u; cg += ((wd >> 16) >= Tt) ? 1u : 0u; }
        unsigned pre3 = cg;
#pragma unroll
        for (int o = 1; o < 64; o <<= 1) { const unsigned t = __shfl_up(pre3, o); if (lane >= o) pre3 += t; }
        unsigned off = pre3 - cg;
#pragma unroll
        for (int i = 0; i < 8; ++i)
#pragma unroll
            for (int w = 0; w < 4; ++w) {
                const unsigned wd = kk[i][w]; const int idx = 512 * i + 8 * lane + 2 * w;
                if ((wd & 0xffffu) >= Tt) { list[off & 255u] = (unsigned short)idx; ++off; }
                if ((wd >> 16) >= Tt) { list[off & 255u] = (unsigned short)(idx + 1); ++off; }
            }
        if (!alleq) {
            const unsigned cgt = 256u - req; unsigned eq_run = 0;
            for (int base = 0; base < n; base += 64) {
                const int i = base + lane; const unsigned m = (i < n) ? myk[i] : 0u;
                const bool eq = (m == T);
                const unsigned long long eqm = __ballot(eq);
                const unsigned rank = eq_run + __builtin_amdgcn_mbcnt_hi((unsigned)(eqm >> 32), __builtin_amdgcn_mbcnt_lo((unsigned)eqm, 0u));
                if (eq && rank < req) list[cgt + rank] = (unsigned short)i;
                eq_run += (unsigned)__popcll(eqm);
            }
        }
    }
    if (!(MODE & 4)) return;
    bf16x8 qf[2], sel[2];
#pragma unroll
    for (int s = 0; s < 2; ++s) {
        u32x4 t = (u32x4){0u, 0u, 0u, 0u};
        if (c < 8) t = ldg16(QB + (size_t)tok * 512 + c * 64 + 32 * s + 8 * g);
        qf[s] = as_bf16x8(t);
#pragma unroll
        for (int j = 0; j < 8; ++j) sel[s][j] = (8 * g + j == 16 * s + c) ? (short)0x3F80 : (short)0;
    }
    f32x4 st[16];
    const unsigned char* kbb = (const unsigned char*)(KB + (size_t)b * SEQ * 64); const unsigned char* vbb = (const unsigned char*)(VB + (size_t)b * SEQ * 64);
    const int lr = lane >> 3, lc = lane & 7;
    const unsigned st_off = lr * 128 + ((lc ^ lr) << 4);
    auto loadg = [&](const unsigned char* base, int T0, u32x4 (&dst)[8]) {
#pragma unroll
        for (int i = 0; i < 8; ++i) {
            const int idx = T0 * 16 + i * 8 + lr; const unsigned kid = (idx < L) ? (unsigned)list[idx] : 0u;
            dst[i] = ldg16(base + kid * 128u + lc * 16u);
        }
    };
    auto stage = [&](const u32x4 (&src)[8]) {
#pragma unroll
        for (int i = 0; i < 8; ++i) *(u32x4*)(stg + i * 1024 + st_off) = src[i];
    };
    auto frag = [&](int u, int s2) -> bf16x8 { return as_bf16x8(*(const u32x4*)(stg + (16 * u + c) * 128 + (((4 * s2 + g) ^ (c & 7)) << 4))); };
    auto scoreK = [&](int T0) {
#pragma unroll
        for (int T = 0; T < 4; ++T) {
            f32x4 d = mfma16(frag(T, 0), qf[0], (f32x4){0.f, 0.f, 0.f, 0.f});
            st[T0 + T] = mfma16(frag(T, 1), qf[1], d);
        }
    };
    u32x4 rA[8], rB[8], rC[8], rD[8];
    loadg(kbb, 0, rA); loadg(kbb, 4, rB); loadg(kbb, 8, rC); loadg(kbb, 12, rD);
    __builtin_amdgcn_sched_barrier(0);
    stage(rA); scoreK(0);
    stage(rB); scoreK(4);
    __builtin_amdgcn_sched_barrier(0);
    loadg(vbb, 0, rA); loadg(vbb, 4, rB);
    stage(rC); scoreK(8);
    stage(rD); scoreK(12);
    __builtin_amdgcn_sched_barrier(0);
    float mx = -3.0e38f;
    {
        const int lrem = L - 4 * g;
#pragma unroll
        for (int T = 0; T < 16; ++T)
#pragma unroll
            for (int r = 0; r < 4; ++r) { const float sv = (T * 16 + r < lrem) ? st[T][r] : -3.0e38f; st[T][r] = sv; mx = fmaxf(mx, sv); }
    }
    mx = fmaxf(mx, __shfl_xor(mx, 16)); mx = fmaxf(mx, __shfl_xor(mx, 32));
    float lsum = 0.f;
#pragma unroll
    for (int T = 0; T < 16; ++T)
#pragma unroll
        for (int r = 0; r < 4; ++r) { const float e = __expf(st[T][r] - mx); st[T][r] = e; lsum += e; }
    lsum += __shfl_xor(lsum, 16); lsum += __shfl_xor(lsum, 32);
    const float rl = 1.0f / lsum;
    u32x4 pfv[8];
#pragma unroll
    for (int u = 0; u < 8; ++u) {
        const int Ta = 2 * u, Tb = Ta + 1;
        pfv[u].x = pack_bf16(st[Ta][0] * rl, st[Ta][1] * rl); pfv[u].y = pack_bf16(st[Ta][2] * rl, st[Ta][3] * rl);
        pfv[u].z = pack_bf16(st[Tb][0] * rl, st[Tb][1] * rl); pfv[u].w = pack_bf16(st[Tb][2] * rl, st[Tb][3] * rl);
    }
    __builtin_amdgcn_sched_barrier(0);
    f32x4 O[4];
#pragma unroll
    for (int cb = 0; cb < 4; ++cb) O[cb] = (f32x4){0.f, 0.f, 0.f, 0.f};
    auto pv = [&](int T0) {
#pragma unroll
        for (int u = 0; u < 2; ++u) {
            const u32x4 pf = pfv[(T0 >> 1) + u];
#pragma unroll
            for (int cb = 0; cb < 4; ++cb) {
                const f32x4 z = (f32x4){0.f, 0.f, 0.f, 0.f};
                const f32x4 v0 = mfma16(frag(2 * u, cb >> 1), sel[cb & 1], z), v1 = mfma16(frag(2 * u + 1, cb >> 1), sel[cb & 1], z);
                u32x4 vf; vf.x = pack_bf16(v0[0], v0[1]); vf.y = pack_bf16(v0[2], v0[3]); vf.z = pack_bf16(v1[0], v1[1]); vf.w = pack_bf16(v1[2], v1[3]);
                O[cb] = mfma16(as_bf16x8(pf), as_bf16x8(vf), O[cb]);
            }
        }
    };
    loadg(vbb, 8, rC); loadg(vbb, 12, rD);
    __builtin_amdgcn_sched_barrier(0);
    stage(rA); pv(0);
    stage(rB); pv(4);
    __builtin_amdgcn_sched_barrier(0);
    stage(rC); pv(8);
    stage(rD); pv(12);
    if (g < 2) {
#pragma unroll
        for (int cb = 0; cb < 4; ++cb)
#pragma unroll
            for (int r = 0; r < 4; ++r) ATT[(size_t)tok * 1024 + 512 + (4 * g + r) * 64 + 16 * cb + c] = (bf16_t)f2bf(O[cb][r]);
    }
}

DI void p2_swa_item(const Params& p, int item2) {
    unsigned char* ws = p.ws;
    const bf16_t* QA = (const bf16_t*)(ws + WS_QA); const bf16_t* KA = (const bf16_t*)(ws + WS_KA); const bf16_t* VA = (const bf16_t*)(ws + WS_VA);
    bf16_t* ATT = (bf16_t*)(ws + WS_ATT);
    int tid = threadIdx.x; asm volatile("" : "+v"(tid));
    const int lane = tid & 63, wave = __builtin_amdgcn_readfirstlane(tid >> 6), r = lane & 31, h = lane >> 5;
    const int hq = item2 & 7, blk = (item2 >> 3) & 31, b = item2 >> 8, kvh = hq >> 2;
    const int qi = 32 * wave + r, tokq = b * SEQ + blk * 128 + qi;
    bf16x8 qf[4], sel[2];
#pragma unroll
    for (int s = 0; s < 4; ++s) qf[s] = as_bf16x8(ldg16(QA + (size_t)tokq * 512 + hq * 64 + 16 * s + 8 * h));
#pragma unroll
    for (int x = 0; x < 2; ++x)
#pragma unroll
        for (int j = 0; j < 8; ++j) sel[x][j] = (8 * h + j + 16 * x == r) ? (short)0x3F80 : (short)0;
    const float sink = p.sinks[hq];
    f32x16 ST[5];
#pragma unroll
    for (int ti = 0; ti < 5; ++ti) {
        const int sj = 32 * (wave + ti) + r; int pos = blk * 128 - 128 + sj; pos = pos < 0 ? 0 : pos;
        const bf16_t* kp = KA + (size_t)(b * SEQ + pos) * 128 + kvh * 64 + 8 * h;
        f32x16 d; for (int i = 0; i < 16; ++i) d[i] = 0.f;
#pragma unroll
        for (int s = 0; s < 4; ++s) d = mfma32(as_bf16x8(ldg16(kp + 16 * s)), qf[s], d);
        ST[ti] = d;
    }
    float mx = sink;
    {
        const int lo = r + 1 - 4 * h;
        const int lo0 = (blk > 0) ? lo : (lo > 128 - 32 * wave - 4 * h ? lo : 128 - 32 * wave - 4 * h);
#pragma unroll
        for (int ti = 0; ti < 5; ++ti)
#pragma unroll
            for (int reg = 0; reg < 16; ++reg) {
                const int e = 32 * ti + (reg & 3) + 8 * (reg >> 2);
                const float sv = (e >= lo0 && e < lo + 128) ? ST[ti][reg] : -3.0e38f; ST[ti][reg] = sv; mx = fmaxf(mx, sv);
            }
    }
    mx = fmaxf(mx, __shfl_xor(mx, 32));
    float lsum = 0.f;
#pragma unroll
    for (int ti = 0; ti < 5; ++ti)
#pragma unroll
        for (int reg = 0; reg < 16; ++reg) { const float e = __expf(ST[ti][reg] - mx); ST[ti][reg] = e; lsum += e; }
    lsum += __shfl_xor(lsum, 32);
    lsum += __expf(sink - mx);
    const float rl = 1.0f / lsum;
    f32x16 OT[2];
    for (int i = 0; i < 16; ++i) { OT[0][i] = 0.f; OT[1][i] = 0.f; }
#pragma unroll
    for (int ti = 0; ti < 5; ++ti) {
        const int sj = 32 * (wave + ti) + r; int pos = blk * 128 - 128 + sj; pos = pos < 0 ? 0 : pos;
        const bf16_t* vp = VA + (size_t)(b * SEQ + pos) * 128 + kvh * 64 + 8 * h;
        bf16x8 vf[4];
#pragma unroll
        for (int s = 0; s < 4; ++s) vf[s] = as_bf16x8(ldg16(vp + 16 * s));
        u32x4 pb[2];
#pragma unroll
        for (int s2 = 0; s2 < 2; ++s2) {
            pb[s2].x = pack_bf16(ST[ti][8 * s2 + 0] * rl, ST[ti][8 * s2 + 1] * rl); pb[s2].y = pack_bf16(ST[ti][8 * s2 + 2] * rl, ST[ti][8 * s2 + 3] * rl);
            pb[s2].z = pack_bf16(ST[ti][8 * s2 + 4] * rl, ST[ti][8 * s2 + 5] * rl); pb[s2].w = pack_bf16(ST[ti][8 * s2 + 6] * rl, ST[ti][8 * s2 + 7] * rl);
        }
#pragma unroll
        for (int db = 0; db < 2; ++db) {
            f32x16 vt; for (int i = 0; i < 16; ++i) vt[i] = 0.f;
            vt = mfma32(vf[2 * db], sel[0], vt); vt = mfma32(vf[2 * db + 1], sel[1], vt);
#pragma unroll
            for (int s2 = 0; s2 < 2; ++s2) {
                u32x4 va; va.x = pack_bf16(vt[8 * s2 + 0], vt[8 * s2 + 1]); va.y = pack_bf16(vt[8 * s2 + 2], vt[8 * s2 + 3]);
                va.z = pack_bf16(vt[8 * s2 + 4], vt[8 * s2 + 5]); va.w = pack_bf16(vt[8 * s2 + 6], vt[8 * s2 + 7]);
                OT[db] = mfma32(as_bf16x8(va), as_bf16x8(pb[s2]), OT[db]);
            }
        }
    }
#pragma unroll
    for (int db = 0; db < 2; ++db)
#pragma unroll
        for (int q4 = 0; q4 < 4; ++q4) {
            u32x2 w; w.x = pack_bf16(OT[db][4 * q4], OT[db][4 * q4 + 1]); w.y = pack_bf16(OT[db][4 * q4 + 2], OT[db][4 * q4 + 3]);
            *(u32x2*)(ATT + (size_t)tokq * 1024 + hq * 64 + 32 * db + 8 * q4 + 4 * h) = w;
        }
}

template <int MODE> DI void p2_attention(const Params& p, unsigned char* lds, int cidx = 0) {
    const int G = gridDim.x, bi = blockIdx.x, rounds = (1024 + G - 1) / G;
    for (int b = 0; b < BATCH; ++b)
        for (int r = 0; r < rounds; ++r) {
            const int idx = (r & 1) ? r * G + (G - 1 - bi) : r * G + bi;
            if (idx < 1024) p2_dsa_item<MODE>(p, lds, b, 1023 - idx);
        }
    if (MODE & 8) for (int item2 = bi; item2 < NSWA; item2 += G) p2_swa_item(p, item2);
}

DI void p3_outproj(const Params& p, unsigned char* lds) {
    unsigned char* ws = p.ws;
    const bf16_t* ATT = (const bf16_t*)(ws + WS_ATT); const bf16_t* WT = (const bf16_t*)(ws + WS_WOT);
    const int tid = threadIdx.x, lane = tid & 63, wave = tid >> 6, wm = wave >> 1, wn = wave & 1, c = lane & 15, g = lane >> 4;
    constexpr int NT = 8, MT = NTOK / 128;
    int mt, nt;
    for (int k = 0; tile_of(k, NT, MT, mt, nt); ++k) {
        f32x4 acc[4][4];
        gemm_128x128(ATT + (size_t)mt * 128 * 1024, 1024, WT + (size_t)nt * 128 * 1024, 1024, 1024, lds, acc);
#pragma unroll
        for (int m = 0; m < 4; ++m) {
            const int tok = mt * 128 + wm * 64 + m * 16 + c;
#pragma unroll
            for (int n = 0; n < 4; ++n) {
                const size_t o = (size_t)tok * 1024 + nt * 128 + wn * 64 + 16 * n + 4 * g;
                const f32x4 xv = *(const f32x4*)(p.x + o);
                *(f32x4*)(p.out + o) = xv * ALPHA + acc[m][n];
            }
        }
    }
}

DI void p3b_ln1(const Params& p) {
    bf16_t* H1B = (bf16_t*)(p.ws + WS_XB);
    const int lane = threadIdx.x & 63, gw = blockIdx.x * 4 + (threadIdx.x >> 6), nw = gridDim.x * 4;
    for (int row = gw; row < NTOK; row += nw) {
        f32x4 v[4]; float s = 0.f;
#pragma unroll
        for (int i = 0; i < 4; ++i) { v[i] = *(const f32x4*)(p.out + (size_t)row * 1024 + (lane + 64 * i) * 4); s += (v[i][0] + v[i][1]) + (v[i][2] + v[i][3]); }
        const float mu = wave_sum(s) * (1.f / 1024.f); float q = 0.f;
#pragma unroll
        for (int i = 0; i < 4; ++i) { const f32x4 d = v[i] - mu; q += (d[0] * d[0] + d[1] * d[1]) + (d[2] * d[2] + d[3] * d[3]); }
        const float rstd = rsqrtf(wave_sum(q) * (1.f / 1024.f) + LN_EPS);
#pragma unroll
        for (int i = 0; i < 4; ++i) {
            const int col = (lane + 64 * i) * 4;
            const f32x4 gg = *(const f32x4*)(p.ln1_g + col), bb = *(const f32x4*)(p.ln1_b + col);
            const f32x4 o = (v[i] - mu) * rstd * gg + bb;
            u32x2 w; w.x = pack_bf16(o[0], o[1]); w.y = pack_bf16(o[2], o[3]);
            *(u32x2*)(H1B + (size_t)row * 1024 + col) = w;
        }
    }
}

DI int f2key(float v) { const int b = __float_as_int(v); return b ^ ((b >> 31) & 0x7fffffff); }
DI float key2f(int k) { return __int_as_float(k ^ ((k >> 31) & 0x7fffffff)); }
DI void ce_desc(int& a, int& b) { const int hi = a > b ? a : b, lo = a > b ? b : a; a = hi; b = lo; }
DI void bitonic_merge16(int (&k)[16]) {
#pragma unroll
    for (int d = 8; d >= 1; d >>= 1)
#pragma unroll
        for (int i = 0; i < 16; ++i) if ((i & d) == 0) ce_desc(k[i], k[i | d]);
}
DI void bitonic_sort16(int (&k)[16]) {
#pragma unroll
    for (int sz = 2; sz <= 16; sz <<= 1) {
#pragma unroll
        for (int i = 0; i < 16; ++i) { const int j = i ^ (sz - 1); if (j > i) ce_desc(k[i], k[j]); }
#pragma unroll
        for (int d = sz >> 2; d >= 1; d >>= 1)
#pragma unroll
            for (int i = 0; i < 16; ++i) if ((i & d) == 0) ce_desc(k[i], k[i | d]);
    }
}
DI void top16_merge(int (&t)[16], const int (&sdesc)[16]) {
#pragma unroll
    for (int i = 0; i < 16; ++i) t[i] = t[i] > sdesc[15 - i] ? t[i] : sdesc[15 - i];
    bitonic_merge16(t);
}
constexpr int P4_QS = 32768, P4_SS_STRIDE = 132, P4_ST0 = 67584  , P4_M = 0  , P4_ST1 = 8704  ;

DI void p4_peer_query(const Params& p, unsigned char* lds) {
    unsigned char* ws = p.ws;
    const bf16_t* H1B = (const bf16_t*)(ws + WS_XB); const bf16_t* WQT = (const bf16_t*)(ws + WS_WQT); const bf16_t* SK = (const bf16_t*)(ws + WS_SK);
    unsigned short* PE = (unsigned short*)(ws + WS_PE); float* PG = (float*)(ws + WS_PG); float* PS = (float*)(ws + WS_PS);
    const float* SU = (const float*)(ws + WS_SU); const float* SV = (const float*)(ws + WS_SV);
    float* Ss = (float*)lds;
    float* st0 = (float*)(lds + P4_ST0); float* mbuf = (float*)(lds + P4_M); float* st1 = (float*)(lds + P4_ST1);
    constexpr int MT = NTOK / 128;
    int mt, head;
    for (int k = 0; tile_of(k, 8, MT, mt, head); ++k) {
        int tid = threadIdx.x; asm volatile("" : "+v"(tid));
        const int lane = tid & 63, wave = tid >> 6, wm = wave >> 1, wn = wave & 1, c = lane & 15, g = lane >> 4;
        const int lrow = tid >> 3, lch = tid & 7;
        const int srow = tid & 127, shalf = tid >> 7;
#pragma unroll 1
        for (int ph = 0; ph < 2; ++ph) {
            f32x4 acc[4][4];
            gemm_128x128(H1B + (size_t)mt * 128 * 1024, 1024, WQT + (size_t)(head * 256 + ph * 128) * 1024, 1024, 1024, lds, acc);
            __syncthreads();
#pragma unroll
            for (int m = 0; m < 4; ++m)
#pragma unroll
                for (int n = 0; n < 4; ++n) {
                    const int row = wm * 64 + m * 16 + c;
                    u32x2 w; w.x = pack_bf16(acc[m][n][0], acc[m][n][1]); w.y = pack_bf16(acc[m][n][2], acc[m][n][3]);
                    *(u32x2*)(lds + P4_QS + wn * 16384 + row * 128 + (((2 * n + (g >> 1)) ^ (row & 7)) << 4) + (g & 1) * 8) = w;
                }
            {
                const bf16_t* sp = SK + (size_t)((head * 2 + ph) * 128 + lrow) * 128 + lch * 8;
#pragma unroll
                for (int k2 = 0; k2 < 2; ++k2)
#pragma unroll
                    for (int i = 0; i < 4; ++i) *(u32x4*)(lds + k2 * 16384 + (lrow + 32 * i) * 128 + ((lch ^ (lrow & 7)) << 4)) = ldg16(sp + (size_t)(32 * i) * 128 + k2 * 64);
            }
            __syncthreads();
            f32x4 a2[4][4];
#pragma unroll
            for (int m = 0; m < 4; ++m)
#pragma unroll
                for (int n = 0; n < 4; ++n) a2[m][n] = (f32x4){0.f, 0.f, 0.f, 0.f};
#pragma unroll
            for (int k2 = 0; k2 < 2; ++k2)
#pragma unroll
                for (int s = 0; s < 2; ++s) {
                    bf16x8 xf[4], wf[4];
#pragma unroll
                    for (int m = 0; m < 4; ++m) { const int row = wm * 64 + m * 16 + c; xf[m] = as_bf16x8(*(const u32x4*)(lds + P4_QS + k2 * 16384 + row * 128 + (((4 * s + g) ^ (c & 7)) << 4))); }
#pragma unroll
                    for (int n = 0; n < 4; ++n) { const int row = wn * 64 + n * 16 + c; wf[n] = as_bf16x8(*(const u32x4*)(lds + k2 * 16384 + row * 128 + (((4 * s + g) ^ (c & 7)) << 4))); }
#pragma unroll
                    for (int m = 0; m < 4; ++m)
#pragma unroll
                        for (int n = 0; n < 4; ++n) a2[m][n] = mfma16(wf[n], xf[m], a2[m][n]);
                }
            __syncthreads();
#pragma unroll
            for (int m = 0; m < 4; ++m)
#pragma unroll
                for (int n = 0; n < 4; ++n) {
                    const int key0 = wn * 64 + 16 * n + 4 * g;
                    u32x4 w;
#pragma unroll
                    for (int r = 0; r < 4; ++r) w[r] = (unsigned)f2key(__uint_as_float((__float_as_uint(a2[m][n][r]) & 0xFFFFFF80u) | (unsigned)(key0 + r)));
                    *(u32x4*)(Ss + (wm * 64 + m * 16 + c) * P4_SS_STRIDE + key0) = w;
                }
            __syncthreads();
            int tv[16];
            {
                const int* rowp = (const int*)Ss + srow * P4_SS_STRIDE + shalf * 64;
#pragma unroll
                for (int bt = 0; bt < 4; ++bt) {
                    int bk[16];
#pragma unroll
                    for (int j = 0; j < 4; ++j) { const u32x4 v = *(const u32x4*)(rowp + 16 * bt + 4 * j); bk[4 * j] = (int)v.x; bk[4 * j + 1] = (int)v.y; bk[4 * j + 2] = (int)v.z; bk[4 * j + 3] = (int)v.w; }
                    bitonic_sort16(bk);
                    if (bt == 0) {
#pragma unroll
                        for (int j = 0; j < 16; ++j) tv[j] = bk[j];
                    } else top16_merge(tv, bk);
                }
            }
            __syncthreads();
            int* mbi = (int*)mbuf;
            if (shalf == 1) {
#pragma unroll
                for (int j = 0; j < 16; ++j) mbi[srow * 17 + j] = tv[j];
            }
            __syncthreads();
            if (shalf == 0) {
                int* dst = (int*)((ph == 0) ? st0 : st1);
                int ob[16];
#pragma unroll
                for (int j = 0; j < 16; ++j) ob[j] = mbi[srow * 17 + j];
                top16_merge(tv, ob);
#pragma unroll
                for (int j = 0; j < 16; ++j) dst[srow * 17 + j] = tv[j];
            }
        }
        __syncthreads();
        int cv[16];
        {
            const int* st0i = (const int*)st0; const int* st1i = (const int*)st1;
            float v2[16];
#pragma unroll
            for (int b = 0; b < 16; ++b) v2[b] = key2f(st1i[srow * 17 + b]);
#pragma unroll
            for (int a8 = 0; a8 < 8; ++a8) {
                const int a = shalf * 8 + a8; const float va = key2f(st0i[srow * 17 + a]);
                int bk[16];
#pragma unroll
                for (int b = 0; b < 16; ++b) bk[b] = (f2key(va + v2[b]) & (int)0xFFFFFF00) | (a * 16 + 15 - b);
                if (a8 == 0) {
#pragma unroll
                    for (int j = 0; j < 16; ++j) cv[j] = bk[j];
                } else top16_merge(cv, bk);
            }
        }
        __syncthreads();
        int* mbi = (int*)mbuf;
        if (shalf == 1) {
#pragma unroll
            for (int j = 0; j < 16; ++j) mbi[srow * 17 + j] = cv[j];
        }
        __syncthreads();
        if (shalf == 0) {
            const int* st0i = (const int*)st0; const int* st1i = (const int*)st1;
            int fk[16]; float fv[16];
#pragma unroll
            for (int j = 0; j < 16; ++j) { const int o = mbi[srow * 17 + 15 - j]; fk[j] = cv[j] > o ? cv[j] : o; fv[j] = key2f(fk[j]); }
            float cmax = fv[0];
#pragma unroll
            for (int j = 1; j < 16; ++j) cmax = fmaxf(cmax, fv[j]);
            float den = 0.f; float ev[16];
#pragma unroll
            for (int j = 0; j < 16; ++j) { ev[j] = __expf(fv[j] - cmax); den += ev[j]; }
            const float rden = 1.0f / den;
            const size_t ob = (size_t)(mt * 128 + srow) * 128 + head * 16;
#pragma unroll
            for (int j = 0; j < 16; ++j) {
                const unsigned cde = (unsigned)fk[j] & 0xFFu;
                const unsigned a = cde >> 4, b = 15u - (cde & 15u);
                const unsigned i1 = __float_as_uint(key2f(st0i[srow * 17 + a])) & 0x7Fu, i2 = __float_as_uint(key2f(st1i[srow * 17 + b])) & 0x7Fu;
                const int e = (int)(i1 * 128u + i2);
                PE[ob + j] = (unsigned short)e; PG[ob + j] = ev[j] * rden * SV[e]; PS[ob + j] = SU[e];
            }
        }
        __syncthreads();
    }
}

DI float gelu_exact(float z) { return 0.5f * z * (1.0f + erff(z * 0.70710678118654752f)); }
DI float rdlane(float v, int l) { return __int_as_float(__builtin_amdgcn_readlane(__float_as_int(v), l)); }

typedef float f32x2 __attribute__((ext_vector_type(2)));
DI void p5_gather(const Params& p) {
    unsigned char* ws = p.ws;
    const bf16_t* H1B = (const bf16_t*)(ws + WS_XB); const unsigned char* UT = ws + WS_UT; const unsigned char* VT = ws + WS_VT;
    const unsigned short* PE = (const unsigned short*)(ws + WS_PE); const float* PG = (const float*)(ws + WS_PG); const float* PS = (const float*)(ws + WS_PS);
    const int lane = threadIdx.x & 63, gw = blockIdx.x * 4 + (threadIdx.x >> 6), nw = gridDim.x * 4;
    const bool b5 = (lane & 32) != 0, b4 = (lane & 16) != 0, b3 = (lane & 8) != 0, b2 = (lane & 4) != 0, b1 = (lane & 2) != 0;
    for (int tok = gw; tok < NTOK; tok += nw) {
        float x[16], acc[16];
        {
            const u32x4 xa = ldg16(H1B + (size_t)tok * 1024 + lane * 16), xb = ldg16(H1B + (size_t)tok * 1024 + lane * 16 + 8);
            x[0] = bf_lo(xa.x); x[1] = bf_hi(xa.x); x[2] = bf_lo(xa.y); x[3] = bf_hi(xa.y); x[4] = bf_lo(xa.z); x[5] = bf_hi(xa.z); x[6] = bf_lo(xa.w); x[7] = bf_hi(xa.w);
            x[8] = bf_lo(xb.x); x[9] = bf_hi(xb.x); x[10] = bf_lo(xb.y); x[11] = bf_hi(xb.y); x[12] = bf_lo(xb.z); x[13] = bf_hi(xb.z); x[14] = bf_lo(xb.w); x[15] = bf_hi(xb.w);
        }
#pragma unroll
        for (int i = 0; i < 16; ++i) acc[i] = 0.f;
        const int pe_lo = (int)PE[(size_t)tok * 128 + lane], pe_hi = (int)PE[(size_t)tok * 128 + 64 + lane];
        const float pg_lo = PG[(size_t)tok * 128 + lane], pg_hi = PG[(size_t)tok * 128 + 64 + lane];
        const float ps_lo = PS[(size_t)tok * 128 + lane], ps_hi = PS[(size_t)tok * 128 + 64 + lane];
#pragma unroll 1
        for (int hb = 0; hb < 4; ++hb) {
            const int pes = hb < 2 ? pe_lo : pe_hi; const float pgs = hb < 2 ? pg_lo : pg_hi, pss = hb < 2 ? ps_lo : ps_hi;
            const int lb = (hb & 1) * 32;
            float d[32];
#pragma unroll
            for (int j = 0; j < 32; ++j) {
                const int e = __builtin_amdgcn_readlane(pes, lb + j);
                const u32x2 uw = *(const u32x2*)(UT + (size_t)e * 512 + lane * 8);
                float s = 0.f;
#define P5_DOT(k, bs) { const f32x2 f = __builtin_amdgcn_cvt_scalef32_pk_f32_fp4(uw[k], 1.0f, bs); s = fmaf(x[8 * (k) + 2 * (bs)], f.x, s); s = fmaf(x[8 * (k) + 2 * (bs) + 1], f.y, s); }
                P5_DOT(0, 0) P5_DOT(0, 1) P5_DOT(0, 2) P5_DOT(0, 3) P5_DOT(1, 0) P5_DOT(1, 1) P5_DOT(1, 2) P5_DOT(1, 3)
                d[j] = s;
            }
            float r16[16], r8[8], r4[4], r2[2], r1;
#pragma unroll
            for (int j = 0; j < 16; ++j) { const float keep = b5 ? d[j + 16] : d[j], send = b5 ? d[j] : d[j + 16]; r16[j] = keep + __shfl_xor(send, 32); }
#pragma unroll
            for (int j = 0; j < 8; ++j) { const float keep = b4 ? r16[j + 8] : r16[j], send = b4 ? r16[j] : r16[j + 8]; r8[j] = keep + __shfl_xor(send, 16); }
#pragma unroll
            for (int j = 0; j < 4; ++j) { const float keep = b3 ? r8[j + 4] : r8[j], send = b3 ? r8[j] : r8[j + 4]; r4[j] = keep + __shfl_xor(send, 8); }
#pragma unroll
            for (int j = 0; j < 2; ++j) { const float keep = b2 ? r4[j + 2] : r4[j], send = b2 ? r4[j] : r4[j + 2]; r2[j] = keep + __shfl_xor(send, 4); }
            { const float keep = b1 ? r2[1] : r2[0], send = b1 ? r2[0] : r2[1]; r1 = keep + __shfl_xor(send, 2); }
            r1 += __shfl_xor(r1, 1);
            const int mine = lb + ((lane >> 1) & 31);
            const float coef = gelu_exact(r1 * __shfl(pss, mine)) * __shfl(pgs, mine);
#pragma unroll
            for (int j = 0; j < 32; ++j) {
                const int e = __builtin_amdgcn_readlane(pes, lb + j);
                const float cj = rdlane(coef, 2 * j);
                const u32x2 vw = *(const u32x2*)(VT + (size_t)e * 512 + lane * 8);
#define P5_AXPY(k, bs) { const f32x2 f = __builtin_amdgcn_cvt_scalef32_pk_f32_fp4(vw[k], 1.0f, bs); acc[8 * (k) + 2 * (bs)] = fmaf(cj, f.x, acc[8 * (k) + 2 * (bs)]); acc[8 * (k) + 2 * (bs) + 1] = fmaf(cj, f.y, acc[8 * (k) + 2 * (bs) + 1]); }
                P5_AXPY(0, 0) P5_AXPY(0, 1) P5_AXPY(0, 2) P5_AXPY(0, 3) P5_AXPY(1, 0) P5_AXPY(1, 1) P5_AXPY(1, 2) P5_AXPY(1, 3)
            }
        }
        float s = 0.f;
#pragma unroll
        for (int i = 0; i < 16; ++i) { acc[i] = fmaf(ALPHA, x[i], acc[i]); s += acc[i]; }
        const float mu = wave_sum(s) * (1.f / 1024.f); float q = 0.f;
#pragma unroll
        for (int i = 0; i < 16; ++i) { const float dd = acc[i] - mu; q = fmaf(dd, dd, q); }
        const float rstd = rsqrtf(wave_sum(q) * (1.f / 1024.f) + LN_EPS);
#pragma unroll
        for (int k4 = 0; k4 < 4; ++k4) {
            const int col = lane * 16 + k4 * 4;
            const f32x4 gg = *(const f32x4*)(p.ln2_g + col), bb = *(const f32x4*)(p.ln2_b + col);
            f32x4 o;
#pragma unroll
            for (int e = 0; e < 4; ++e) o[e] = (acc[k4 * 4 + e] - mu) * rstd * gg[e] + bb[e];
            *(f32x4*)(p.out + (size_t)tok * 1024 + col) = o;
        }
    }
}

#define XB_TMO      128
#define XB_XCNT(j)  (256  + 64 * (j))
#define XB_XSUB(j)  (1280 + 64 * (j))
#define XB_XGEN(j)  (2304 + 64 * (j))
#define XB_TOP      3328
#define XB_TOPGEN   3392
#define XCD_BAR_WORDS 3456
#define XB_SPIN_CAP (1u << 22)
#define LAS __attribute__((address_space(3)))
DI unsigned xb_ld(unsigned* p)              { return __hip_atomic_load(p, __ATOMIC_RELAXED, __HIP_MEMORY_SCOPE_AGENT); }
DI unsigned xb_add(unsigned* p, unsigned v) { return __hip_atomic_fetch_add(p, v, __ATOMIC_RELAXED, __HIP_MEMORY_SCOPE_AGENT); }
DI unsigned xb_xcc_id() { return (unsigned)__builtin_amdgcn_s_getreg((3 << 11) | 20) & 0xFu; }
#define XB_SPIN(cond, bar) do { unsigned _sp = 0; while (cond) { __builtin_amdgcn_s_sleep(1); \
    if ((++_sp & 255u) == 0u) { if (xb_ld(&(bar)[XB_TMO])) break; if (_sp > XB_SPIN_CAP) { atomicAdd(&(bar)[XB_TMO], 1u); break; } } } } while (0)
struct XcdBarrier { unsigned* bar; unsigned x; volatile LAS unsigned* st; };
DI XcdBarrier xcd_barrier_post(unsigned* bar, volatile LAS unsigned* st) {
    XcdBarrier b; b.bar = bar; b.x = xb_xcc_id(); b.st = st;
    if (threadIdx.x == 0) (void)xb_add(&bar[XB_XCNT(b.x)], 1u);
    return b;
}
DI void xcd_barrier_complete(unsigned* bar, unsigned x, unsigned& nloc, unsigned& nx) {
    const unsigned G = gridDim.x * gridDim.y * gridDim.z;
    unsigned sum, cnt, mine, sp = 0u;
    for (;;) {
        sum = 0u; cnt = 0u; mine = 0u;
#pragma unroll
        for (unsigned j = 0; j < 16; ++j) { const unsigned c = xb_ld(&bar[XB_XCNT(j)]); sum += c; cnt += (c > 0u) ? 1u : 0u; mine = (j == x) ? c : mine; }
        if (sum == G) break;
        __builtin_amdgcn_s_sleep(1);
        if ((++sp & 255u) == 0u) { if (xb_ld(&bar[XB_TMO])) break; if (sp > XB_SPIN_CAP) { atomicAdd(&bar[XB_TMO], 1u); break; } }
    }
    nloc = mine > 0u ? mine : 1u; nx = cnt > 0u ? cnt : 1u;
}
DI void xcd_barrier(const XcdBarrier& b) {
    asm volatile("s_waitcnt vmcnt(0)" ::: "memory");
    __syncthreads();
    if (threadIdx.x == 0) {
        unsigned* bar = b.bar;
        __builtin_amdgcn_s_waitcnt(0);
        unsigned nloc = b.st[0], nx = b.st[1];
        if (nloc == 0u) { xcd_barrier_complete(bar, b.x, nloc, nx); b.st[0] = nloc; b.st[1] = nx; }
        const unsigned old = xb_add(&bar[XB_XSUB(b.x)], 1u);
        const unsigned gen = old / nloc;
        if (old + 1u == (gen + 1u) * nloc) {
            __builtin_amdgcn_fence(__ATOMIC_RELEASE, "agent");
            asm volatile("s_waitcnt vmcnt(0)" ::: "memory");
            const unsigned og = xb_add(&bar[XB_TOP], 1u);
            const unsigned tg = og / nx;
            if (og + 1u == (tg + 1u) * nx) xb_add(&bar[XB_TOPGEN], 1u);
            else XB_SPIN(xb_ld(&bar[XB_TOPGEN]) == tg, bar);
            __builtin_amdgcn_fence(__ATOMIC_ACQUIRE, "agent");
            xb_add(&bar[XB_XGEN(b.x)], 1u);
            asm volatile("s_waitcnt vmcnt(0)" ::: "memory");
        } else {
            XB_SPIN(xb_ld(&bar[XB_XGEN(b.x)]) == gen, bar);
            __builtin_amdgcn_fence(__ATOMIC_ACQUIRE, "agent");
            asm volatile("s_waitcnt vmcnt(0)" ::: "memory");
        }
    }
    __syncthreads();
}

constexpr int NPHASE = 7;
__global__ void __launch_bounds__(NTHREADS, 2) mega_fwd(Params p) {
    extern __shared__ __attribute__((aligned(16))) unsigned char lds[];
    cg::grid_group grid = cg::this_grid();
    const int lo = p.ph_lo, hi = p.ph_hi;
    volatile LAS unsigned* xbst = (volatile LAS unsigned*)(LAS unsigned char*)(lds + LDS_BYTES - 16);
#ifndef REP_MASK
#define REP_MASK 0
#endif
#ifndef P2_PROBE_MODE
#define P2_PROBE_MODE 15
#endif
#ifndef PH_MASK
#define PH_MASK 127
#endif
    if (lo == 0x7fffffff) grid.sync();
    if (threadIdx.x == 0) { xbst[0] = 0u; xbst[1] = 0u; }
    __syncthreads();
    XcdBarrier xb = xcd_barrier_post((unsigned*)(p.ws + WS_BAR), xbst);
#define GSYNC() xcd_barrier(xb)
    p0_prep(p, lds);
    GSYNC();
#define RUN_PHASE(k, call) { call; if ((REP_MASK >> (k)) & 1) { GSYNC(); call; } }
#if PH_MASK & 2
    RUN_PHASE(1, p1_inproj(p, lds))
#endif
    GSYNC();
#if PH_MASK & 4
#if (REP_MASK >> 2) & 1
    p2a_indexer(p, lds); GSYNC(); p2_attention<P2_PROBE_MODE>(p, lds, 1); GSYNC();
#endif
    p2a_indexer(p, lds);
    GSYNC();
    p2_attention<15>(p, lds, 0);
#endif
    GSYNC();
#if PH_MASK & 8
    RUN_PHASE(3, p3_outproj(p, lds))
#endif
    GSYNC();
#if PH_MASK & 16
    RUN_PHASE(4, p3b_ln1(p))
#endif
    GSYNC();
#if PH_MASK & 32
    RUN_PHASE(5, p4_peer_query(p, lds))
#endif
    GSYNC();
#if PH_MASK & 64
    RUN_PHASE(6, p5_gather(p))
#endif
}

#ifndef MK_N_LAUNCHES
#define MK_N_LAUNCHES 1
#endif

extern "C" void kernel_launch(void* const* d_in, const int* in_sizes, int n_in, void* d_out, int out_size, void* d_ws, size_t ws_size, hipStream_t stream) {
    static int grid_blocks = 0;
    if (grid_blocks == 0) {
        if (n_in != 14 || out_size != NTOK * D_MODEL || ws_size < WS_END) {
            fprintf(stderr, "kernel_launch: unexpected problem (n_in %d, out %d, ws %zu, need %zu)\n", n_in, out_size, ws_size, (size_t)WS_END); grid_blocks = -1; return;
        }
        int dev = 0, cus = 0, per_cu = 0;
        hipGetDevice(&dev);
        hipDeviceGetAttribute(&cus, hipDeviceAttributeMultiprocessorCount, dev);
        if (hipFuncSetAttribute((const void*)mega_fwd, hipFuncAttributeMaxDynamicSharedMemorySize, LDS_BYTES) != hipSuccess) { fprintf(stderr, "kernel_launch: hipFuncSetAttribute failed\n"); }
        if (hipOccupancyMaxActiveBlocksPerMultiprocessor(&per_cu, (const void*)mega_fwd, NTHREADS, LDS_BYTES) != hipSuccess || per_cu < 1) { fprintf(stderr, "kernel_launch: occupancy query failed\n"); per_cu = 1; }
        if (per_cu > 2) per_cu = 2;
        (void)hipGetLastError();
        grid_blocks = cus * per_cu;
        fprintf(stderr, "kernel_launch: %d CUs x %d blocks\n", cus, per_cu);
    }
    if (grid_blocks < 0) return;
    Params p{};
    p.x = (const float*)d_in[0]; p.w_in = (const float*)d_in[1]; p.idx_k_g = (const float*)d_in[2]; p.idx_k_b = (const float*)d_in[3]; p.sinks = (const float*)d_in[4];
    p.w_o = (const float*)d_in[5]; p.ln1_g = (const float*)d_in[6]; p.ln1_b = (const float*)d_in[7]; p.peer_wq = (const float*)d_in[8]; p.peer_subkeys = (const float*)d_in[9];
    p.peer_u = (const float*)d_in[10]; p.peer_v = (const float*)d_in[11]; p.ln2_g = (const float*)d_in[12]; p.ln2_b = (const float*)d_in[13];
    p.out = (float*)d_out; p.ws = (unsigned char*)d_ws;
    p.ph_lo = 0; p.ph_hi = NPHASE;
    if (hipMemsetAsync((unsigned char*)d_ws + WS_BAR, 0, XCD_BAR_WORDS * 4, stream) != hipSuccess) { fprintf(stderr, "kernel_launch: memset of the barrier words failed\n"); return; }
    void* args[] = {&p};
    hipError_t e = hipLaunchCooperativeKernel((const void*)mega_fwd, dim3(grid_blocks), dim3(NTHREADS), args, LDS_BYTES, stream);
    if (e != hipSuccess) fprintf(stderr, "cooperative launch failed: %s (grid %d)\n", hipGetErrorString(e), grid_blocks);
}
```

```cpp
#include <hip/hip_runtime.h>
#include <hip/hip_cooperative_groups.h>
#include <cstdio>
#include <cstdint>
namespace cg = cooperative_groups;

typedef unsigned short bf16_t;
typedef short bf16x8 __attribute__((ext_vector_type(8)));
typedef float f32x4 __attribute__((ext_vector_type(4)));
typedef float f32x16 __attribute__((ext_vector_type(16)));
typedef unsigned u32x4 __attribute__((ext_vector_type(4)));
typedef unsigned u32x2 __attribute__((ext_vector_type(2)));
#define DI __device__ __forceinline__

constexpr int D_MODEL = 1024, BATCH = 8, SEQ = 4096, NTOK = BATCH * SEQ;
constexpr int NMIX = 1732, NMIX_PAD = 1792;
constexpr int PEER_N = 2048;
constexpr float ALPHA = 1.189207115002721f;
constexpr float LN_EPS = 1e-5f;
constexpr int NTHREADS = 256;
constexpr int LDS_BYTES = 77824;

constexpr size_t MB = 1024 * 1024;
constexpr size_t WS_CTL   = 0;
constexpr size_t WS_BAR   = 65536;
constexpr size_t WS_ROPE  = 1 * MB;
constexpr size_t WS_WINT  = 2 * MB;
constexpr size_t WS_WOT   = 6 * MB;
constexpr size_t WS_WQT   = 8 * MB;
constexpr size_t WS_SK    = 12 * MB;
constexpr size_t WS_UT    = 13 * MB;
constexpr size_t WS_VT    = 29 * MB;
constexpr size_t WS_SU    = 45 * MB;
constexpr size_t WS_SV    = 46 * MB;
constexpr size_t WS_XB    = 77 * MB;
constexpr size_t WS_QA    = 141 * MB;
constexpr size_t WS_KA    = 173 * MB;
constexpr size_t WS_VA    = 181 * MB;
constexpr size_t WS_QB    = 189 * MB;
constexpr size_t WS_KB    = 221 * MB;
constexpr size_t WS_VB    = 225 * MB;
constexpr size_t WS_QI    = 229 * MB;
constexpr size_t WS_KI    = 245 * MB;
constexpr size_t WS_WI    = 249 * MB;
constexpr size_t WS_ATT   = 250 * MB;
constexpr size_t WS_PE    = 314 * MB;
constexpr size_t WS_PG    = 322 * MB;
constexpr size_t WS_PS    = 338 * MB;
constexpr size_t WS_END   = 354 * MB;

struct Params {
    const float* x; const float* w_in; const float* idx_k_g; const float* idx_k_b; const float* sinks; const float* w_o;
    const float* ln1_g; const float* ln1_b; const float* peer_wq; const float* peer_subkeys; const float* peer_u; const float* peer_v;
    const float* ln2_g; const float* ln2_b;
    float* out; unsigned char* ws;
    int ph_lo, ph_hi;
};

DI unsigned f2bf(float x) { unsigned u = __float_as_uint(x); u += 0x7fffu + ((u >> 16) & 1u); return u >> 16; }
DI unsigned pack_bf16(float lo, float hi) { return f2bf(lo) | (f2bf(hi) << 16); }
DI float bf_lo(unsigned w) { return __uint_as_float(w << 16); }
DI float bf_hi(unsigned w) { return __uint_as_float(w & 0xffff0000u); }
DI bf16x8 as_bf16x8(u32x4 v) { return __builtin_bit_cast(bf16x8, v); }
DI u32x4 ldg16(const void* p) { return *(const u32x4*)p; }
DI f32x4 mfma16(bf16x8 a, bf16x8 b, f32x4 c) { return __builtin_amdgcn_mfma_f32_16x16x32_bf16(a, b, c, 0, 0, 0); }
DI f32x16 mfma32(bf16x8 a, bf16x8 b, f32x16 c) { return __builtin_amdgcn_mfma_f32_32x32x16_bf16(a, b, c, 0, 0, 0); }
DI float wave_sum(float v) {
#pragma unroll
    for (int o = 32; o >= 1; o >>= 1) v += __shfl_xor(v, o);
    return v;
}

DI void glds16(const void* src, void* lds_dst) { __builtin_amdgcn_global_load_lds((const unsigned*)src, (__attribute__((address_space(3))) unsigned*)lds_dst, 16, 0, 0); }
DI void gemm_128x128(const bf16_t* __restrict__ X, int ldx, const bf16_t* __restrict__ Wt, int ldw, int K, unsigned char* lds, f32x4 (&acc)[4][4]) {
    int tid = threadIdx.x; asm volatile("" : "+v"(tid));
    const int lane = tid & 63, wave = tid >> 6, wm = wave >> 1, wn = wave & 1, c = lane & 15, g = lane >> 4;
    const int lrow = tid >> 3, lch = tid & 7;
    const bf16_t* xp = X + (size_t)lrow * ldx + ((lch ^ (lrow & 7)) * 8);
    const bf16_t* wp = Wt + (size_t)lrow * ldw + ((lch ^ (lrow & 7)) * 8);
    unsigned char* dst0 = lds + tid * 16;
#pragma unroll
    for (int m = 0; m < 4; ++m)
#pragma unroll
        for (int n = 0; n < 4; ++n) acc[m][n] = (f32x4){0.f, 0.f, 0.f, 0.f};
    const int nk = K / 64;
    __syncthreads();
#pragma unroll
    for (int i = 0; i < 4; ++i) { glds16(xp + (size_t)(32 * i) * ldx, dst0 + i * 4096); glds16(wp + (size_t)(32 * i) * ldw, dst0 + 16384 + i * 4096); }
    asm volatile("s_waitcnt vmcnt(0)" ::: "memory");
    __syncthreads();
    for (int kt = 0; kt < nk; ++kt) {
        const unsigned char* Xs = lds + (kt & 1) * 32768; const unsigned char* Ws = Xs + 16384;
        if (kt + 1 < nk) {
            unsigned char* d = dst0 + ((kt + 1) & 1) * 32768;
#pragma unroll
            for (int i = 0; i < 4; ++i) { glds16(xp + (size_t)(32 * i) * ldx + (kt + 1) * 64, d + i * 4096); glds16(wp + (size_t)(32 * i) * ldw + (kt + 1) * 64, d + 16384 + i * 4096); }
        }
#pragma unroll
        for (int s = 0; s < 2; ++s) {
            bf16x8 xf[4], wf[4];
#pragma unroll
            for (int m = 0; m < 4; ++m) { const int row = wm * 64 + m * 16 + c; xf[m] = as_bf16x8(*(const u32x4*)(Xs + row * 128 + (((4 * s + g) ^ (c & 7)) << 4))); }
#pragma unroll
            for (int n = 0; n < 4; ++n) { const int row = wn * 64 + n * 16 + c; wf[n] = as_bf16x8(*(const u32x4*)(Ws + row * 128 + (((4 * s + g) ^ (c & 7)) << 4))); }
#pragma unroll
            for (int m = 0; m < 4; ++m)
#pragma unroll
                for (int n = 0; n < 4; ++n) acc[m][n] = mfma16(wf[n], xf[m], acc[m][n]);
        }
        asm volatile("s_waitcnt vmcnt(0)" ::: "memory");
        __syncthreads();
    }
}

DI bool tile_of(int k, int NT, int MT, int& mt, int& nt) {
    const int G = gridDim.x, bid = blockIdx.x;
    if (((G | MT) & 7) == 0) {
        const int idx = (bid >> 3) + k * (G >> 3);
        if (idx >= (MT >> 3) * NT) return false;
        mt = (idx / NT) * 8 + (bid & 7); nt = idx % NT;
    } else {
        const int t = bid + k * G;
        if (t >= MT * NT) return false;
        mt = t / NT; nt = t % NT;
    }
    return true;
}

DI void p0_prep(const Params& p, unsigned char* lds) {
    const int tid = threadIdx.x, nb = gridDim.x, bid = blockIdx.x;
    const size_t gtid = (size_t)bid * NTHREADS + tid, gsz = (size_t)nb * NTHREADS;
    unsigned char* ws = p.ws;
    {
        float* ct = (float*)(ws + WS_ROPE); float* stb = ct + SEQ * 32;
        for (size_t i = gtid; i < (size_t)SEQ * 32; i += gsz) {
            const int pos = (int)(i >> 5), fi = (int)(i & 31);
            const float inv = powf(10000.0f, -(float)(2 * fi) / 64.0f);
            const float ang = (float)pos * inv;
            ct[i] = cosf(ang); stb[i] = sinf(ang);
        }
    }
    auto conv = [&](const float* src, bf16_t* dst, size_t n) {
        for (size_t i = gtid * 8; i < n; i += gsz * 8) {
            const f32x4 a = *(const f32x4*)(src + i), b = *(const f32x4*)(src + i + 4);
            u32x4 o; o.x = pack_bf16(a.x, a.y); o.y = pack_bf16(a.z, a.w); o.z = pack_bf16(b.x, b.y); o.w = pack_bf16(b.z, b.w);
            *(u32x4*)(dst + i) = o;
        }
    };
    conv(p.x, (bf16_t*)(ws + WS_XB), (size_t)NTOK * D_MODEL);
    conv(p.peer_subkeys, (bf16_t*)(ws + WS_SK), (size_t)8 * 2 * 128 * 128);
    float* tl = (float*)lds;
    auto transp = [&](const float* src, bf16_t* dst, int N, int Npad) {
        const int tn = Npad / 64, tk = 1024 / 64;
        for (int t = bid; t < tn * tk; t += nb) {
            const int n0 = (t % tn) * 64, k0 = (t / tn) * 64;
            __syncthreads();
            for (int e = tid; e < 4096; e += NTHREADS) { const int kk = e >> 6, nn = e & 63; tl[kk * 65 + nn] = (n0 + nn < N) ? src[(size_t)(k0 + kk) * N + n0 + nn] : 0.f; }
            __syncthreads();
            for (int e = tid; e < 4096; e += NTHREADS) { const int nn = e >> 6, kk = e & 63; dst[(size_t)(n0 + nn) * 1024 + k0 + kk] = (bf16_t)f2bf(tl[kk * 65 + nn]); }
        }
    };
    transp(p.w_in, (bf16_t*)(ws + WS_WINT), NMIX, NMIX_PAD);
}

DI void p0_late(const Params& p, unsigned char* lds) {
    const int tid = threadIdx.x, nb = gridDim.x, bid = blockIdx.x;
    unsigned char* ws = p.ws;
    {
        const int lane = tid & 63, gw = bid * 4 + (tid >> 6), nw = nb * 4;
        for (int row = gw; row < 2 * 16384; row += nw) {
            const bool isv = row >= 16384; const int e = isv ? row - 16384 : row;
            const float* src = (isv ? p.peer_v : p.peer_u) + (size_t)e * 1024 + lane * 16;
            f32x4 v[4]; float mx = 0.f;
#pragma unroll
            for (int i = 0; i < 4; ++i) { v[i] = *(const f32x4*)(src + 4 * i); mx = fmaxf(mx, fmaxf(fmaxf(fabsf(v[i][0]), fabsf(v[i][1])), fmaxf(fabsf(v[i][2]), fabsf(v[i][3])))); }
#pragma unroll
            for (int o = 32; o >= 1; o >>= 1) mx = fmaxf(mx, __shfl_xor(mx, o));
            const float sc = mx > 0.f ? mx * (1.0f / 5.99f) : 1.0f, inv = mx > 0.f ? 5.99f / mx : 1.0f;
            u32x2 o2;
#pragma unroll
            for (int k = 0; k < 2; ++k) {
                unsigned w = 0;
                w = __builtin_amdgcn_cvt_scalef32_pk_fp4_f32(w, v[2 * k][0] * inv, v[2 * k][1] * inv, 1.0f, 0);
                w = __builtin_amdgcn_cvt_scalef32_pk_fp4_f32(w, v[2 * k][2] * inv, v[2 * k][3] * inv, 1.0f, 1);
                w = __builtin_amdgcn_cvt_scalef32_pk_fp4_f32(w, v[2 * k + 1][0] * inv, v[2 * k + 1][1] * inv, 1.0f, 2);
                w = __builtin_amdgcn_cvt_scalef32_pk_fp4_f32(w, v[2 * k + 1][2] * inv, v[2 * k + 1][3] * inv, 1.0f, 3);
                o2[k] = w;
            }
            *(u32x2*)(ws + (isv ? WS_VT : WS_UT) + (size_t)e * 512 + lane * 8) = o2;
            if (lane == 0) ((float*)(ws + (isv ? WS_SV : WS_SU)))[e] = sc;
        }
    }
    float* tl = (float*)lds;
    auto transp = [&](const float* src, bf16_t* dst, int N, int Npad) {
        const int tn = Npad / 64, tk = 1024 / 64;
        for (int t = bid; t < tn * tk; t += nb) {
            const int n0 = (t % tn) * 64, k0 = (t / tn) * 64;
            __syncthreads();
            for (int e = tid; e < 4096; e += NTHREADS) { const int kk = e >> 6, nn = e & 63; tl[kk * 65 + nn] = (n0 + nn < N) ? src[(size_t)(k0 + kk) * N + n0 + nn] : 0.f; }
            __syncthreads();
            for (int e = tid; e < 4096; e += NTHREADS) { const int nn = e >> 6, kk = e & 63; dst[(size_t)(n0 + nn) * 1024 + k0 + kk] = (bf16_t)f2bf(tl[kk * 65 + nn]); }
        }
    };
    transp(p.w_o, (bf16_t*)(ws + WS_WOT), 1024, 1024);
    transp(p.peer_wq, (bf16_t*)(ws + WS_WQT), PEER_N, PEER_N);
}

DI void p1_inproj(const Params& p, unsigned char* lds) {
    unsigned char* ws = p.ws;
    const bf16_t* XB = (const bf16_t*)(ws + WS_XB); const bf16_t* WT = (const bf16_t*)(ws + WS_WINT);
    const float* cosT = (const float*)(ws + WS_ROPE); const float* sinT = cosT + SEQ * 32;
    const int tid = threadIdx.x, lane = tid & 63, wave = tid >> 6, wm = wave >> 1, wn = wave & 1, c = lane & 15, g = lane >> 4;
    constexpr int NT = NMIX_PAD / 128, MT = NTOK / 128;
    int mt, nt;
    for (int k = 0; tile_of(k, NT, MT, mt, nt); ++k) {
        f32x4 acc[4][4];
        gemm_128x128(XB + (size_t)mt * 128 * 1024, 1024, WT + (size_t)nt * 128 * 1024, 1024, 1024, lds, acc);
        const int col64 = nt * 2 + wn;
        bf16_t* dst; int ld, coff; bool rope = true; float scale = 1.f;
        if (col64 < 8)       { dst = (bf16_t*)(ws + WS_QA); ld = 512; coff = col64 * 64; scale = 0.125f; }
        else if (col64 < 10) { dst = (bf16_t*)(ws + WS_KA); ld = 128; coff = (col64 - 8) * 64; }
        else if (col64 < 12) { dst = (bf16_t*)(ws + WS_VA); ld = 128; coff = (col64 - 10) * 64; rope = false; }
        else if (col64 < 20) { dst = (bf16_t*)(ws + WS_QB); ld = 512; coff = (col64 - 12) * 64; scale = 0.125f; }
        else if (col64 == 20) { dst = (bf16_t*)(ws + WS_KB); ld = 64; coff = 0; }
        else if (col64 == 21) { dst = (bf16_t*)(ws + WS_VB); ld = 64; coff = 0; rope = false; }
        else if (col64 < 26) { dst = (bf16_t*)(ws + WS_QI); ld = 256; coff = (col64 - 22) * 64; }
        else                 { dst = (bf16_t*)(ws + WS_KI); ld = 64; coff = 0; }
        if (col64 == 27) {
            if (g == 0) {
#pragma unroll
                for (int m = 0; m < 4; ++m) { const int tok = mt * 128 + wm * 64 + m * 16 + c; *(f32x4*)((float*)(ws + WS_WI) + (size_t)tok * 4) = acc[m][0] * 0.0625f; }
            }
            continue;
        }
#pragma unroll
        for (int m = 0; m < 4; ++m) {
            const int tok = mt * 128 + wm * 64 + m * 16 + c, pos = tok & (SEQ - 1);
            f32x4 v[4] = {acc[m][0], acc[m][1], acc[m][2], acc[m][3]};
            if (col64 == 26) {
                float s = 0.f;
#pragma unroll
                for (int n = 0; n < 4; ++n) s += (v[n][0] + v[n][1]) + (v[n][2] + v[n][3]);
                s += __shfl_xor(s, 16); s += __shfl_xor(s, 32);
                const float mu = s * (1.f / 64.f); float q = 0.f;
#pragma unroll
                for (int n = 0; n < 4; ++n) { const f32x4 d = v[n] - mu; q += (d[0] * d[0] + d[1] * d[1]) + (d[2] * d[2] + d[3] * d[3]); }
                q += __shfl_xor(q, 16); q += __shfl_xor(q, 32);
                const float rstd = rsqrtf(q * (1.f / 64.f) + LN_EPS);
#pragma unroll
                for (int n = 0; n < 4; ++n) {
                    const f32x4 gg = *(const f32x4*)(p.idx_k_g + 16 * n + 4 * g), bb = *(const f32x4*)(p.idx_k_b + 16 * n + 4 * g);
                    v[n] = (v[n] - mu) * rstd * gg + bb;
                }
            }
            if (rope) {
#pragma unroll
                for (int n = 0; n < 2; ++n) {
                    const f32x4 cs = *(const f32x4*)(cosT + pos * 32 + 16 * n + 4 * g), sn = *(const f32x4*)(sinT + pos * 32 + 16 * n + 4 * g);
                    const f32x4 t1 = v[n], t2 = v[n + 2];
                    v[n] = t1 * cs - t2 * sn; v[n + 2] = t2 * cs + t1 * sn;
                }
            }
#pragma unroll
            for (int n = 0; n < 4; ++n) {
                const f32x4 o = v[n] * scale; u32x2 w; w.x = pack_bf16(o[0], o[1]); w.y = pack_bf16(o[2], o[3]);
                *(u32x2*)(dst + (size_t)tok * ld + coff + 16 * n + 4 * g) = w;
            }
        }
    }
}

constexpr int NDSA = NTOK / 4, NSWA = BATCH * 32 * 8;
constexpr int P2_STG = 0  , P2_LIST = 32768;

DI unsigned f16_key(float v) {
    _Float16 hv = (_Float16)v; unsigned short hb = __builtin_bit_cast(unsigned short, hv); unsigned b = hb;
    if (b == 0x8000u) b = 0u;
    return (b & 0x8000u) ? ((~b) & 0xffffu) : (b | 0x8000u);
}

DI size_t sc_row_off(int t) { const size_t m = (size_t)(t >> 3); return 8 * (4 * m * (m + 1) + (size_t)(t & 7) * (m + 1)); }
constexpr size_t SC_BATCH = 8404992;
DI unsigned short* sc_batch_base(const Params& p, int b) { return (b < 7) ? (unsigned short*)p.out + (size_t)b * SC_BATCH : (unsigned short*)(p.ws + WS_XB); }

DI void p2a_indexer(const Params& p, unsigned char* lds) {
    unsigned char* ws = p.ws;
    const bf16_t* QI = (const bf16_t*)(ws + WS_QI); const bf16_t* KI = (const bf16_t*)(ws + WS_KI); const float* WI = (const float*)(ws + WS_WI);
    const int G = gridDim.x, bi = blockIdx.x;
    for (int it = 0; it < 2; ++it) {
        const int item = (it == 0) ? bi : 1023 - bi;
        for (int id = (G == 512) ? item : bi + it * G; id < 1024; id += (G == 512) ? 1024 : 2 * G) {
            int tid = threadIdx.x; asm volatile("" : "+v"(tid));
            const int lane = tid & 63, wave = tid >> 6, c = lane & 15, g = lane >> 4, lrow = tid >> 3, lch = tid & 7;
            const int b = id >> 7, t0 = (id & 127) * 32, tokw = b * SEQ + t0 + 8 * wave;
            unsigned short* scb = sc_batch_base(p, b);
            bf16x8 af[2][2]; f32x4 wv[2];
#pragma unroll
            for (int rt = 0; rt < 2; ++rt) {
#pragma unroll
                for (int s2 = 0; s2 < 2; ++s2) af[rt][s2] = as_bf16x8(ldg16(QI + (size_t)(tokw + 4 * rt + (c >> 2)) * 256 + (c & 3) * 64 + 32 * s2 + 8 * g));
                wv[rt] = *(const f32x4*)(WI + (size_t)(tokw + 4 * rt + g) * 4);
            }
            asm volatile("" :: "v"(af[0][0]), "v"(af[0][1]), "v"(af[1][0]), "v"(af[1][1]), "v"(wv[0]), "v"(wv[1]));
            const int nkt = ((t0 + 31) >> 7) + 1;
            const unsigned char* kib = (const unsigned char*)(KI + (size_t)b * SEQ * 64);
            unsigned char* dst0 = lds + tid * 16;
            auto stage = [&](int kt, int buf) {
#pragma unroll
                for (int i = 0; i < 4; ++i) {
                    const int row = lrow + 32 * i;
                    glds16(kib + (size_t)(kt * 128 + row) * 128 + ((lch ^ ((row >> 3) & 7)) << 4), dst0 + buf * 16384 + i * 4096);
                }
            };
            __syncthreads();
            stage(0, 0);
            asm volatile("s_waitcnt vmcnt(0)" ::: "memory");
            __syncthreads();
            for (int kt = 0; kt < nkt; ++kt) {
                const unsigned char* Ks = lds + (kt & 1) * 16384;
                if (kt + 1 < nkt) stage(kt + 1, (kt + 1) & 1);
                unsigned res[2][4];
#pragma unroll
                for (int ct = 0; ct < 8; ++ct) {
                    const int row = 8 * c + ct;
                    const bf16x8 k0 = as_bf16x8(*(const u32x4*)(Ks + row * 128 + ((g ^ (c & 7)) << 4)));
                    const bf16x8 k1 = as_bf16x8(*(const u32x4*)(Ks + row * 128 + (((4 + g) ^ (c & 7)) << 4)));
#pragma unroll
                    for (int rt = 0; rt < 2; ++rt) {
                        f32x4 d = mfma16(af[rt][0], k0, (f32x4){0.f, 0.f, 0.f, 0.f});
                        d = mfma16(af[rt][1], k1, d);
                        const float sv = wv[rt][0] * fmaxf(d[0], 0.f) + wv[rt][1] * fmaxf(d[1], 0.f) + wv[rt][2] * fmaxf(d[2], 0.f) + wv[rt][3] * fmaxf(d[3], 0.f);
                        const int key = kt * 128 + row, tq = t0 + 8 * wave + 4 * rt + g;
                        const unsigned kv = (key <= tq) ? f16_key(sv) : 0u;
                        if (ct & 1) res[rt][ct >> 1] |= kv << 16; else res[rt][ct >> 1] = kv;
                    }
                }
#pragma unroll
                for (int rt = 0; rt < 2; ++rt) {
                    const int tq = t0 + 8 * wave + 4 * rt + g;
                    if (16 * kt + c <= (tq >> 3)) {
                        u32x4 w; w.x = res[rt][0]; w.y = res[rt][1]; w.z = res[rt][2]; w.w = res[rt][3];
                        *(u32x4*)(scb + sc_row_off(tq) + kt * 128 + 8 * c) = w;
                    }
                }
                asm volatile("s_waitcnt vmcnt(0)" ::: "memory");
                __syncthreads();
            }
        }
    }
    p0_late(p, lds);
}

template <int MODE> DI void p2_dsa_item(const Params& p, unsigned char* lds, int b, int tb) {
    unsigned char* ws = p.ws;
    const bf16_t* QI = (const bf16_t*)(ws + WS_QI); const bf16_t* KI = (const bf16_t*)(ws + WS_KI); const float* WI = (const float*)(ws + WS_WI);
    const bf16_t* QB = (const bf16_t*)(ws + WS_QB); const bf16_t* KB = (const bf16_t*)(ws + WS_KB); const bf16_t* VB = (const bf16_t*)(ws + WS_VB);
    bf16_t* ATT = (bf16_t*)(ws + WS_ATT);
    int tid = threadIdx.x; asm volatile("" : "+v"(tid));
    const int lane = tid & 63, wave = __builtin_amdgcn_readfirstlane(tid >> 6), c = lane & 15, g = lane >> 4;
    const int t0 = tb * 4, tok0 = b * SEQ + t0;
    unsigned char* stg = lds + P2_STG + wave * 8192;
    unsigned* hist = (unsigned*)stg;
    unsigned short* list = (unsigned short*)(lds + P2_LIST) + wave * 256;
    const int tok = tok0 + wave;
    if (!(MODE & 2)) return;
    const int n = t0 + wave + 1;
    const int L = n < 256 ? n : 256;
    const unsigned short* myk = sc_batch_base(p, b) + sc_row_off(t0 + wave);
    if (n <= 256) {
        for (int i = lane; i < n; i += 64) list[i] = (unsigned short)i;
    } else {
        u32x4 kk[8];
#pragma unroll
        for (int i = 0; i < 8; ++i) kk[i] = (512 * i + 8 * lane < n) ? ldg16(myk + 512 * i + 8 * lane) : (u32x4){0u, 0u, 0u, 0u};
#pragma unroll
        for (int i = 0; i < 4; ++i) *(u32x4*)(hist + lane * 16 + i * 4) = (u32x4){0u, 0u, 0u, 0u};
#pragma unroll
        for (int i = 0; i < 8; ++i) {
            if (512 * i < n) {
#pragma unroll
                for (int w = 0; w < 4; ++w) { const unsigned wd = kk[i][w]; atomicAdd(&hist[(wd & 0xffffu) >> 6], 1u); atomicAdd(&hist[wd >> 22], 1u); }
            }
        }
        unsigned h[16];
#pragma unroll
        for (int i = 0; i < 4; ++i) { const u32x4 t = *(const u32x4*)(hist + lane * 16 + i * 4); h[4 * i] = t.x; h[4 * i + 1] = t.y; h[4 * i + 2] = t.z; h[4 * i + 3] = t.w; }
#pragma unroll
        for (int i = 0; i < 4; ++i) *(u32x4*)(hist + lane * 16 + i * 4) = (u32x4){0u, 0u, 0u, 0u};
        unsigned sl = 0;
#pragma unroll
        for (int i = 0; i < 16; ++i) sl += h[i];
        unsigned pre = sl;
#pragma unroll
        for (int o = 1; o < 64; o <<= 1) { const unsigned t = __shfl_up(pre, o); if (lane >= o) pre += t; }
        const unsigned tot = __shfl(pre, 63);
        const unsigned suf = tot - pre;
        int found = -1; unsigned cab = 0, cum = suf;
#pragma unroll
        for (int j = 15; j >= 0; --j) { const bool hit = (found < 0) && (cum + h[j] >= 256u); if (hit) { found = lane * 16 + j; cab = cum; } cum += h[j]; }
        const bool mine = (suf < 256u) && (suf + sl >= 256u);
        const unsigned long long mm = __ballot(mine);
        const int src = __ffsll((long long)mm) - 1;
        const unsigned bstar = (unsigned)__shfl(found, src), cabove = __shfl(cab, src);
        const unsigned r1 = 256u - cabove;
#pragma unroll
        for (int i = 0; i < 8; ++i) {
            if (512 * i < n) {
#pragma unroll
                for (int w = 0; w < 4; ++w) {
                    const unsigned wd = kk[i][w];
                    if (((wd & 0xffffu) >> 6) == bstar) atomicAdd(&hist[wd & 63u], 1u);
                    if ((wd >> 22) == bstar) atomicAdd(&hist[(wd >> 16) & 63u], 1u);
                }
            }
        }
        const unsigned cnt = hist[lane];
        hist[lane] = 0u;
        unsigned pre2 = cnt;
#pragma unroll
        for (int o = 1; o < 64; o <<= 1) { const unsigned t = __shfl_up(pre2, o); if (lane >= o) pre2 += t; }
        const unsigned tot2 = __shfl(pre2, 63);
        const unsigned suf2 = tot2 - pre2;
        const bool mine2 = (suf2 < r1) && (suf2 + cnt >= r1);
        const unsigned long long mm2 = __ballot(mine2);
        const int src2 = __ffsll((long long)mm2) - 1;
        const unsigned T = (bstar << 6) | (unsigned)src2;
        const unsigned req = r1 - __shfl(suf2, src2);
        const unsigned toteq = __shfl(cnt, src2);
        const bool alleq = (req == toteq);
        const unsigned Tt = alleq ? T : T + 1u;
        unsigned cg = 0;
#pragma unroll
        for (int i = 0; i < 8; ++i)
#pragma unroll
            for (int w = 0; w < 4; ++w) { const unsigned wd = kk[i][w]; cg += ((wd & 0xffffu) >= Tt) ? 1u : 0u; cg += ((wd >> 16) >= Tt) ? 1u : 0u; }
        unsigned pre3 = cg;
#pragma unroll
        for (int o = 1; o < 64; o <<= 1) { const unsigned t = __shfl_up(pre3, o); if (lane >= o) pre3 += t; }
        unsigned off = pre3 - cg;
#pragma unroll
        for (int i = 0; i < 8; ++i)
#pragma unroll
            for (int w = 0; w < 4; ++w) {
                const unsigned wd = kk[i][w]; const int idx = 512 * i + 8 * lane + 2 * w;
                if ((wd & 0xffffu) >= Tt) { list[off & 255u] = (unsigned short)idx; ++off; }
                if ((wd >> 16) >= Tt) { list[off & 255u] = (unsigned short)(idx + 1); ++off; }
            }
        if (!alleq) {
            const unsigned cgt = 256u - req; unsigned eq_run = 0;
            for (int base = 0; base < n; base += 64) {
                const int i = base + lane; const unsigned m = (i < n) ? myk[i] : 0u;
                const bool eq = (m == T);
                const unsigned long long eqm = __ballot(eq);
                const unsigned rank = eq_run + __builtin_amdgcn_mbcnt_hi((unsigned)(eqm >> 32), __builtin_amdgcn_mbcnt_lo((unsigned)eqm, 0u));
                if (eq && rank < req) list[cgt + rank] = (unsigned short)i;
                eq_run += (unsigned)__popcll(eqm);
            }
        }
    }
    if (!(MODE & 4)) return;
    bf16x8 qf[2], sel[2];
#pragma unroll
    for (int s = 0; s < 2; ++s) {
        u32x4 t = (u32x4){0u, 0u, 0u, 0u};
        if (c < 8) t = ldg16(QB + (size_t)tok * 512 + c * 64 + 32 * s + 8 * g);
        qf[s] = as_bf16x8(t);
#pragma unroll
        for (int j = 0; j < 8; ++j) sel[s][j] = (8 * g + j == 16 * s + c) ? (short)0x3F80 : (short)0;
    }
    f32x4 st[16];
    const unsigned char* kbb = (const unsigned char*)(KB + (size_t)b * SEQ * 64); const unsigned char* vbb = (const unsigned char*)(VB + (size_t)b * SEQ * 64);
    const int lr = lane >> 3, lc = lane & 7;
    const unsigned st_off = lr * 128 + ((lc ^ lr) << 4);
    auto loadg = [&](const unsigned char* base, int T0, u32x4 (&dst)[8]) {
#pragma unroll
        for (int i = 0; i < 8; ++i) {
            const int idx = T0 * 16 + i * 8 + lr; const unsigned kid = (idx < L) ? (unsigned)list[idx] : 0u;
            dst[i] = ldg16(base + kid * 128u + lc * 16u);
        }
    };
    auto stage = [&](const u32x4 (&src)[8]) {
#pragma unroll
        for (int i = 0; i < 8; ++i) *(u32x4*)(stg + i * 1024 + st_off) = src[i];
    };
    auto frag = [&](int u, int s2) -> bf16x8 { return as_bf16x8(*(const u32x4*)(stg + (16 * u + c) * 128 + (((4 * s2 + g) ^ (c & 7)) << 4))); };
    auto scoreK = [&](int T0) {
#pragma unroll
        for (int T = 0; T < 4; ++T) {
            f32x4 d = mfma16(frag(T, 0), qf[0], (f32x4){0.f, 0.f, 0.f, 0.f});
            st[T0 + T] = mfma16(frag(T, 1), qf[1], d);
        }
    };
    u32x4 rA[8], rB[8], rC[8], rD[8];
    loadg(kbb, 0, rA); loadg(kbb, 4, rB); loadg(kbb, 8, rC); loadg(kbb, 12, rD);
    __builtin_amdgcn_sched_barrier(0);
    stage(rA); scoreK(0);
    stage(rB); scoreK(4);
    __builtin_amdgcn_sched_barrier(0);
    loadg(vbb, 0, rA); loadg(vbb, 4, rB);
    stage(rC); scoreK(8);
    stage(rD); scoreK(12);
    __builtin_amdgcn_sched_barrier(0);
    float mx = -3.0e38f;
    {
        const int lrem = L - 4 * g;
#pragma unroll
        for (int T = 0; T < 16; ++T)
#pragma unroll
            for (int r = 0; r < 4; ++r) { const float sv = (T * 16 + r < lrem) ? st[T][r] : -3.0e38f; st[T][r] = sv; mx = fmaxf(mx, sv); }
    }
    mx = fmaxf(mx, __shfl_xor(mx, 16)); mx = fmaxf(mx, __shfl_xor(mx, 32));
    float lsum = 0.f;
#pragma unroll
    for (int T = 0; T < 16; ++T)
#pragma unroll
        for (int r = 0; r < 4; ++r) { const float e = __expf(st[T][r] - mx); st[T][r] = e; lsum += e; }
    lsum += __shfl_xor(lsum, 16); lsum += __shfl_xor(lsum, 32);
    const float rl = 1.0f / lsum;
    u32x4 pfv[8];
#pragma unroll
    for (int u = 0; u < 8; ++u) {
        const int Ta = 2 * u, Tb = Ta + 1;
        pfv[u].x = pack_bf16(st[Ta][0] * rl, st[Ta][1] * rl); pfv[u].y = pack_bf16(st[Ta][2] * rl, st[Ta][3] * rl);
        pfv[u].z = pack_bf16(st[Tb][0] * rl, st[Tb][1] * rl); pfv[u].w = pack_bf16(st[Tb][2] * rl, st[Tb][3] * rl);
    }
    __builtin_amdgcn_sched_barrier(0);
    f32x4 O[4];
#pragma unroll
    for (int cb = 0; cb < 4; ++cb) O[cb] = (f32x4){0.f, 0.f, 0.f, 0.f};
    auto pv = [&](int T0) {
#pragma unroll
        for (int u = 0; u < 2; ++u) {
            const u32x4 pf = pfv[(T0 >> 1) + u];
#pragma unroll
            for (int cb = 0; cb < 4; ++cb) {
                const f32x4 z = (f32x4){0.f, 0.f, 0.f, 0.f};
                const f32x4 v0 = mfma16(frag(2 * u, cb >> 1), sel[cb & 1], z), v1 = mfma16(frag(2 * u + 1, cb >> 1), sel[cb & 1], z);
                u32x4 vf; vf.x = pack_bf16(v0[0], v0[1]); vf.y = pack_bf16(v0[2], v0[3]); vf.z = pack_bf16(v1[0], v1[1]); vf.w = pack_bf16(v1[2], v1[3]);
                O[cb] = mfma16(as_bf16x8(pf), as_bf16x8(vf), O[cb]);
            }
        }
    };
    loadg(vbb, 8, rC); loadg(vbb, 12, rD);
    __builtin_amdgcn_sched_barrier(0);
    stage(rA); pv(0);
    stage(rB); pv(4);
    __builtin_amdgcn_sched_barrier(0);
    stage(rC); pv(8);
    stage(rD); pv(12);
    if (g < 2) {
#pragma unroll
        for (int cb = 0; cb < 4; ++cb)
#pragma unroll
            for (int r = 0; r < 4; ++r) ATT[(size_t)tok * 1024 + 512 + (4 * g + r) * 64 + 16 * cb + c] = (bf16_t)f2bf(O[cb][r]);
    }
}

DI void p2_swa_item(const Params& p, int item2) {
    unsigned char* ws = p.ws;
    const bf16_t* QA = (const bf16_t*)(ws + WS_QA); const bf16_t* KA = (const bf16_t*)(ws + WS_KA); const bf16_t* VA = (const bf16_t*)(ws + WS_VA);
    bf16_t* ATT = (bf16_t*)(ws + WS_ATT);
    int tid = threadIdx.x; asm volatile("" : "+v"(tid));
    const int lane = tid & 63, wave = __builtin_amdgcn_readfirstlane(tid >> 6), r = lane & 31, h = lane >> 5;
    const int hq = item2 & 7, blk = (item2 >> 3) & 31, b = item2 >> 8, kvh = hq >> 2;
    const int qi = 32 * wave + r, tokq = b * SEQ + blk * 128 + qi;
    bf16x8 qf[4], sel[2];
#pragma unroll
    for (int s = 0; s < 4; ++s) qf[s] = as_bf16x8(ldg16(QA + (size_t)tokq * 512 + hq * 64 + 16 * s + 8 * h));
#pragma unroll
    for (int x = 0; x < 2; ++x)
#pragma unroll
        for (int j = 0; j < 8; ++j) sel[x][j] = (8 * h + j + 16 * x == r) ? (short)0x3F80 : (short)0;
    const float sink = p.sinks[hq];
    f32x16 ST[5];
#pragma unroll
    for (int ti = 0; ti < 5; ++ti) {
        const int sj = 32 * (wave + ti) + r; int pos = blk * 128 - 128 + sj; pos = pos < 0 ? 0 : pos;
        const bf16_t* kp = KA + (size_t)(b * SEQ + pos) * 128 + kvh * 64 + 8 * h;
        f32x16 d; for (int i = 0; i < 16; ++i) d[i] = 0.f;
#pragma unroll
        for (int s = 0; s < 4; ++s) d = mfma32(as_bf16x8(ldg16(kp + 16 * s)), qf[s], d);
        ST[ti] = d;
    }
    float mx = sink;
    {
        const int lo = r + 1 - 4 * h;
        const int lo0 = (blk > 0) ? lo : (lo > 128 - 32 * wave - 4 * h ? lo : 128 - 32 * wave - 4 * h);
#pragma unroll
        for (int ti = 0; ti < 5; ++ti)
#pragma unroll
            for (int reg = 0; reg < 16; ++reg) {
                const int e = 32 * ti + (reg & 3) + 8 * (reg >> 2);
                const float sv = (e >= lo0 && e < lo + 128) ? ST[ti][reg] : -3.0e38f; ST[ti][reg] = sv; mx = fmaxf(mx, sv);
            }
    }
    mx = fmaxf(mx, __shfl_xor(mx, 32));
    float lsum = 0.f;
#pragma unroll
    for (int ti = 0; ti < 5; ++ti)
#pragma unroll
        for (int reg = 0; reg < 16; ++reg) { const float e = __expf(ST[ti][reg] - mx); ST[ti][reg] = e; lsum += e; }
    lsum += __shfl_xor(lsum, 32);
    lsum += __expf(sink - mx);
    const float rl = 1.0f / lsum;
    f32x16 OT[2];
    for (int i = 0; i < 16; ++i) { OT[0][i] = 0.f; OT[1][i] = 0.f; }
#pragma unroll
    for (int ti = 0; ti < 5; ++ti) {
        const int sj = 32 * (wave + ti) + r; int pos = blk * 128 - 128 + sj; pos = pos < 0 ? 0 : pos;
        const bf16_t* vp = VA + (size_t)(b * SEQ + pos) * 128 + kvh * 64 + 8 * h;
        bf16x8 vf[4];
#pragma unroll
        for (int s = 0; s < 4; ++s) vf[s] = as_bf16x8(ldg16(vp + 16 * s));
        u32x4 pb[2];
#pragma unroll
        for (int s2 = 0; s2 < 2; ++s2) {
            pb[s2].x = pack_bf16(ST[ti][8 * s2 + 0] * rl, ST[ti][8 * s2 + 1] * rl); pb[s2].y = pack_bf16(ST[ti][8 * s2 + 2] * rl, ST[ti][8 * s2 + 3] * rl);
            pb[s2].z = pack_bf16(ST[ti][8 * s2 + 4] * rl, ST[ti][8 * s2 + 5] * rl); pb[s2].w = pack_bf16(ST[ti][8 * s2 + 6] * rl, ST[ti][8 * s2 + 7] * rl);
        }
#pragma unroll
        for (int db = 0; db < 2; ++db) {
            f32x16 vt; for (int i = 0; i < 16; ++i) vt[i] = 0.f;
            vt = mfma32(vf[2 * db], sel[0], vt); vt = mfma32(vf[2 * db + 1], sel[1], vt);
#pragma unroll
            for (int s2 = 0; s2 < 2; ++s2) {
                u32x4 va; va.x = pack_bf16(vt[8 * s2 + 0], vt[8 * s2 + 1]); va.y = pack_bf16(vt[8 * s2 + 2], vt[8 * s2 + 3]);
                va.z = pack_bf16(vt[8 * s2 + 4], vt[8 * s2 + 5]); va.w = pack_bf16(vt[8 * s2 + 6], vt[8 * s2 + 7]);
                OT[db] = mfma32(as_bf16x8(va), as_bf16x8(pb[s2]), OT[db]);
            }
        }
    }
#pragma unroll
    for (int db = 0; db < 2; ++db)
#pragma unroll
        for (int q4 = 0; q4 < 4; ++q4) {
            u32x2 w; w.x = pack_bf16(OT[db][4 * q4], OT[db][4 * q4 + 1]); w.y = pack_bf16(OT[db][4 * q4 + 2], OT[db][4 * q4 + 3]);
            *(u32x2*)(ATT + (size_t)tokq * 1024 + hq * 64 + 32 * db + 8 * q4 + 4 * h) = w;
        }
}

template <int MODE> DI void p2_attention(const Params& p, unsigned char* lds, int cidx = 0) {
    const int G = gridDim.x, bi = blockIdx.x, rounds = (1024 + G - 1) / G;
    for (int b = 0; b < BATCH; ++b)
        for (int r = 0; r < rounds; ++r) {
            const int idx = (r & 1) ? r * G + (G - 1 - bi) : r * G + bi;
            if (idx < 1024) p2_dsa_item<MODE>(p, lds, b, 1023 - idx);
        }
    if (MODE & 8) for (int item2 = bi; item2 < NSWA; item2 += G) p2_swa_item(p, item2);
}

DI void p3_outproj(const Params& p, unsigned char* lds) {
    unsigned char* ws = p.ws;
    const bf16_t* ATT = (const bf16_t*)(ws + WS_ATT); const bf16_t* WT = (const bf16_t*)(ws + WS_WOT);
    const int tid = threadIdx.x, lane = tid & 63, wave = tid >> 6, wm = wave >> 1, wn = wave & 1, c = lane & 15, g = lane >> 4;
    constexpr int NT = 8, MT = NTOK / 128;
    int mt, nt;
    for (int k = 0; tile_of(k, NT, MT, mt, nt); ++k) {
        f32x4 acc[4][4];
        gemm_128x128(ATT + (size_t)mt * 128 * 1024, 1024, WT + (size_t)nt * 128 * 1024, 1024, 1024, lds, acc);
#pragma unroll
        for (int m = 0; m < 4; ++m) {
            const int tok = mt * 128 + wm * 64 + m * 16 + c;
#pragma unroll
            for (int n = 0; n < 4; ++n) {
                const size_t o = (size_t)tok * 1024 + nt * 128 + wn * 64 + 16 * n + 4 * g;
                const f32x4 xv = *(const f32x4*)(p.x + o);
                const f32x4 hv = xv * ALPHA + acc[m][n];
                u32x2 w; w.x = pack_bf16(hv[0], hv[1]); w.y = pack_bf16(hv[2], hv[3]);
                *(u32x2*)((bf16_t*)p.out + o) = w;
            }
        }
    }
}

DI void p3b_ln1(const Params& p) {
    bf16_t* H1B = (bf16_t*)(p.ws + WS_XB); const bf16_t* HP = (const bf16_t*)p.out;
    const int lane = threadIdx.x & 63, gw = blockIdx.x * 4 + (threadIdx.x >> 6), nw = gridDim.x * 4;
    for (int row = gw; row < NTOK; row += nw) {
        const u32x4 ra = ldg16(HP + (size_t)row * 1024 + lane * 16), rb = ldg16(HP + (size_t)row * 1024 + lane * 16 + 8);
        float v[16];
        v[0] = bf_lo(ra.x); v[1] = bf_hi(ra.x); v[2] = bf_lo(ra.y); v[3] = bf_hi(ra.y); v[4] = bf_lo(ra.z); v[5] = bf_hi(ra.z); v[6] = bf_lo(ra.w); v[7] = bf_hi(ra.w);
        v[8] = bf_lo(rb.x); v[9] = bf_hi(rb.x); v[10] = bf_lo(rb.y); v[11] = bf_hi(rb.y); v[12] = bf_lo(rb.z); v[13] = bf_hi(rb.z); v[14] = bf_lo(rb.w); v[15] = bf_hi(rb.w);
        float s = 0.f;
#pragma unroll
        for (int i = 0; i < 16; ++i) s += v[i];
        const float mu = wave_sum(s) * (1.f / 1024.f); float q = 0.f;
#pragma unroll
        for (int i = 0; i < 16; ++i) { const float d = v[i] - mu; q = fmaf(d, d, q); }
        const float rstd = rsqrtf(wave_sum(q) * (1.f / 1024.f) + LN_EPS);
        u32x4 oa, ob;
#pragma unroll
        for (int k4 = 0; k4 < 4; ++k4) {
            const int col = lane * 16 + k4 * 4;
            const f32x4 gg = *(const f32x4*)(p.ln1_g + col), bb = *(const f32x4*)(p.ln1_b + col);
            float o[4];
#pragma unroll
            for (int e = 0; e < 4; ++e) o[e] = (v[k4 * 4 + e] - mu) * rstd * gg[e] + bb[e];
            const unsigned w0 = pack_bf16(o[0], o[1]), w1 = pack_bf16(o[2], o[3]);
            if (k4 == 0) { oa.x = w0; oa.y = w1; } else if (k4 == 1) { oa.z = w0; oa.w = w1; } else if (k4 == 2) { ob.x = w0; ob.y = w1; } else { ob.z = w0; ob.w = w1; }
        }
        *(u32x4*)(H1B + (size_t)row * 1024 + lane * 16) = oa; *(u32x4*)(H1B + (size_t)row * 1024 + lane * 16 + 8) = ob;
    }
}

DI int f2key(float v) { const int b = __float_as_int(v); return b ^ ((b >> 31) & 0x7fffffff); }
DI float key2f(int k) { return __int_as_float(k ^ ((k >> 31) & 0x7fffffff)); }
DI void ce_desc(int& a, int& b) { const int hi = a > b ? a : b, lo = a > b ? b : a; a = hi; b = lo; }
DI void bitonic_merge16(int (&k)[16]) {
#pragma unroll
    for (int d = 8; d >= 1; d >>= 1)
#pragma unroll
        for (int i = 0; i < 16; ++i) if ((i & d) == 0) ce_desc(k[i], k[i | d]);
}
DI void bitonic_sort16(int (&k)[16]) {
#pragma unroll
    for (int sz = 2; sz <= 16; sz <<= 1) {
#pragma unroll
        for (int i = 0; i < 16; ++i) { const int j = i ^ (sz - 1); if (j > i) ce_desc(k[i], k[j]); }
#pragma unroll
        for (int d = sz >> 2; d >= 1; d >>= 1)
#pragma unroll
            for (int i = 0; i < 16; ++i) if ((i & d) == 0) ce_desc(k[i], k[i | d]);
    }
}
DI void top16_merge(int (&t)[16], const int (&sdesc)[16]) {
#pragma unroll
    for (int i = 0; i < 16; ++i) t[i] = t[i] > sdesc[15 - i] ? t[i] : sdesc[15 - i];
    bitonic_merge16(t);
}
constexpr int P4_QS = 32768, P4_SS_STRIDE = 132, P4_ST0 = 67584  , P4_M = 0  , P4_ST1 = 8704  ;

DI void p4_peer_query(const Params& p, unsigned char* lds) {
    unsigned char* ws = p.ws;
    const bf16_t* H1B = (const bf16_t*)(ws + WS_XB); const bf16_t* WQT = (const bf16_t*)(ws + WS_WQT); const bf16_t* SK = (const bf16_t*)(ws + WS_SK);
    unsigned short* PE = (unsigned short*)(ws + WS_PE); float* PG = (float*)(ws + WS_PG); float* PS = (float*)(ws + WS_PS);
    const float* SU = (const float*)(ws + WS_SU); const float* SV = (const float*)(ws + WS_SV);
    float* Ss = (float*)lds;
    float* st0 = (float*)(lds + P4_ST0); float* mbuf = (float*)(lds + P4_M); float* st1 = (float*)(lds + P4_ST1);
    constexpr int MT = NTOK / 128;
    int mt, head;
    for (int k = 0; tile_of(k, 8, MT, mt, head); ++k) {
        int tid = threadIdx.x; asm volatile("" : "+v"(tid));
        const int lane = tid & 63, wave = tid >> 6, wm = wave >> 1, wn = wave & 1, c = lane & 15, g = lane >> 4;
        const int lrow = tid >> 3, lch = tid & 7;
        const int srow = tid & 127, shalf = tid >> 7;
#pragma unroll 1
        for (int ph = 0; ph < 2; ++ph) {
            f32x4 acc[4][4];
            gemm_128x128(H1B + (size_t)mt * 128 * 1024, 1024, WQT + (size_t)(head * 256 + ph * 128) * 1024, 1024, 1024, lds, acc);
            __syncthreads();
#pragma unroll
            for (int m = 0; m < 4; ++m)
#pragma unroll
                for (int n = 0; n < 4; ++n) {
                    const int row = wm * 64 + m * 16 + c;
                    u32x2 w; w.x = pack_bf16(acc[m][n][0], acc[m][n][1]); w.y = pack_bf16(acc[m][n][2], acc[m][n][3]);
                    *(u32x2*)(lds + P4_QS + wn * 16384 + row * 128 + (((2 * n + (g >> 1)) ^ (row & 7)) << 4) + (g & 1) * 8) = w;
                }
            {
                const bf16_t* sp = SK + (size_t)((head * 2 + ph) * 128 + lrow) * 128 + lch * 8;
#pragma unroll
                for (int k2 = 0; k2 < 2; ++k2)
#pragma unroll
                    for (int i = 0; i < 4; ++i) *(u32x4*)(lds + k2 * 16384 + (lrow + 32 * i) * 128 + ((lch ^ (lrow & 7)) << 4)) = ldg16(sp + (size_t)(32 * i) * 128 + k2 * 64);
            }
            __syncthreads();
            f32x4 a2[4][4];
#pragma unroll
            for (int m = 0; m < 4; ++m)
#pragma unroll
                for (int n = 0; n < 4; ++n) a2[m][n] = (f32x4){0.f, 0.f, 0.f, 0.f};
#pragma unroll
            for (int k2 = 0; k2 < 2; ++k2)
#pragma unroll
                for (int s = 0; s < 2; ++s) {
                    bf16x8 xf[4], wf[4];
#pragma unroll
                    for (int m = 0; m < 4; ++m) { const int row = wm * 64 + m * 16 + c; xf[m] = as_bf16x8(*(const u32x4*)(lds + P4_QS + k2 * 16384 + row * 128 + (((4 * s + g) ^ (c & 7)) << 4))); }
#pragma unroll
                    for (int n = 0; n < 4; ++n) { const int row = wn * 64 + n * 16 + c; wf[n] = as_bf16x8(*(const u32x4*)(lds + k2 * 16384 + row * 128 + (((4 * s + g) ^ (c & 7)) << 4))); }
#pragma unroll
                    for (int m = 0; m < 4; ++m)
#pragma unroll
                        for (int n = 0; n < 4; ++n) a2[m][n] = mfma16(wf[n], xf[m], a2[m][n]);
                }
            __syncthreads();
#pragma unroll
            for (int m = 0; m < 4; ++m)
#pragma unroll
                for (int n = 0; n < 4; ++n) {
                    const int key0 = wn * 64 + 16 * n + 4 * g;
                    u32x4 w;
#pragma unroll
                    for (int r = 0; r < 4; ++r) w[r] = (unsigned)f2key(__uint_as_float((__float_as_uint(a2[m][n][r]) & 0xFFFFFF80u) | (unsigned)(key0 + r)));
                    *(u32x4*)(Ss + (wm * 64 + m * 16 + c) * P4_SS_STRIDE + key0) = w;
                }
            __syncthreads();
            int tv[16];
            {
                const int* rowp = (const int*)Ss + srow * P4_SS_STRIDE + shalf * 64;
#pragma unroll
                for (int bt = 0; bt < 4; ++bt) {
                    int bk[16];
#pragma unroll
                    for (int j = 0; j < 4; ++j) { const u32x4 v = *(const u32x4*)(rowp + 16 * bt + 4 * j); bk[4 * j] = (int)v.x; bk[4 * j + 1] = (int)v.y; bk[4 * j + 2] = (int)v.z; bk[4 * j + 3] = (int)v.w; }
                    bitonic_sort16(bk);
                    if (bt == 0) {
#pragma unroll
                        for (int j = 0; j < 16; ++j) tv[j] = bk[j];
                    } else top16_merge(tv, bk);
                }
            }
            __syncthreads();
            int* mbi = (int*)mbuf;
            if (shalf == 1) {
#pragma unroll
                for (int j = 0; j < 16; ++j) mbi[srow * 17 + j] = tv[j];
            }
            __syncthreads();
            if (shalf == 0) {
                int* dst = (int*)((ph == 0) ? st0 : st1);
                int ob[16];
#pragma unroll
                for (int j = 0; j < 16; ++j) ob[j] = mbi[srow * 17 + j];
                top16_merge(tv, ob);
#pragma unroll
                for (int j = 0; j < 16; ++j) dst[srow * 17 + j] = tv[j];
            }
        }
        __syncthreads();
        int cv[16];
        {
            const int* st0i = (const int*)st0; const int* st1i = (const int*)st1;
            float v2[16];
#pragma unroll
            for (int b = 0; b < 16; ++b) v2[b] = key2f(st1i[srow * 17 + b]);
#pragma unroll
            for (int a8 = 0; a8 < 8; ++a8) {
                const int a = shalf * 8 + a8; const float va = key2f(st0i[srow * 17 + a]);
                int bk[16];
#pragma unroll
                for (int b = 0; b < 16; ++b) bk[b] = (f2key(va + v2[b]) & (int)0xFFFFFF00) | (a * 16 + 15 - b);
                if (a8 == 0) {
#pragma unroll
                    for (int j = 0; j < 16; ++j) cv[j] = bk[j];
                } else top16_merge(cv, bk);
            }
        }
        __syncthreads();
        int* mbi = (int*)mbuf;
        if (shalf == 1) {
#pragma unroll
            for (int j = 0; j < 16; ++j) mbi[srow * 17 + j] = cv[j];
        }
        __syncthreads();
        if (shalf == 0) {
            const int* st0i = (const int*)st0; const int* st1i = (const int*)st1;
            int fk[16]; float fv[16];
#pragma unroll
            for (int j = 0; j < 16; ++j) { const int o = mbi[srow * 17 + 15 - j]; fk[j] = cv[j] > o ? cv[j] : o; fv[j] = key2f(fk[j]); }
            float cmax = fv[0];
#pragma unroll
            for (int j = 1; j < 16; ++j) cmax = fmaxf(cmax, fv[j]);
            float den = 0.f; float ev[16];
#pragma unroll
            for (int j = 0; j < 16; ++j) { ev[j] = __expf(fv[j] - cmax); den += ev[j]; }
            const float rden = 1.0f / den;
            const size_t ob = (size_t)(mt * 128 + srow) * 128 + head * 16;
#pragma unroll
            for (int j = 0; j < 16; ++j) {
                const unsigned cde = (unsigned)fk[j] & 0xFFu;
                const unsigned a = cde >> 4, b = 15u - (cde & 15u);
                const unsigned i1 = __float_as_uint(key2f(st0i[srow * 17 + a])) & 0x7Fu, i2 = __float_as_uint(key2f(st1i[srow * 17 + b])) & 0x7Fu;
                const int e = (int)(i1 * 128u + i2);
                PE[ob + j] = (unsigned short)e; PG[ob + j] = ev[j] * rden * SV[e]; PS[ob + j] = SU[e];
            }
        }
        __syncthreads();
    }
}

DI float gelu_exact(float z) { return 0.5f * z * (1.0f + erff(z * 0.70710678118654752f)); }
DI float rdlane(float v, int l) { return __int_as_float(__builtin_amdgcn_readlane(__float_as_int(v), l)); }

typedef float f32x2 __attribute__((ext_vector_type(2)));
DI void p5_gather(const Params& p) {
    unsigned char* ws = p.ws;
    const bf16_t* H1B = (const bf16_t*)(ws + WS_XB); const unsigned char* UT = ws + WS_UT; const unsigned char* VT = ws + WS_VT;
    const unsigned short* PE = (const unsigned short*)(ws + WS_PE); const float* PG = (const float*)(ws + WS_PG); const float* PS = (const float*)(ws + WS_PS);
    const int lane = threadIdx.x & 63, gw = blockIdx.x * 4 + (threadIdx.x >> 6), nw = gridDim.x * 4;
    const bool b5 = (lane & 32) != 0, b4 = (lane & 16) != 0, b3 = (lane & 8) != 0, b2 = (lane & 4) != 0, b1 = (lane & 2) != 0;
    for (int tok = gw; tok < NTOK; tok += nw) {
        float x[16], acc[16];
        {
            const u32x4 xa = ldg16(H1B + (size_t)tok * 1024 + lane * 16), xb = ldg16(H1B + (size_t)tok * 1024 + lane * 16 + 8);
            x[0] = bf_lo(xa.x); x[1] = bf_hi(xa.x); x[2] = bf_lo(xa.y); x[3] = bf_hi(xa.y); x[4] = bf_lo(xa.z); x[5] = bf_hi(xa.z); x[6] = bf_lo(xa.w); x[7] = bf_hi(xa.w);
            x[8] = bf_lo(xb.x); x[9] = bf_hi(xb.x); x[10] = bf_lo(xb.y); x[11] = bf_hi(xb.y); x[12] = bf_lo(xb.z); x[13] = bf_hi(xb.z); x[14] = bf_lo(xb.w); x[15] = bf_hi(xb.w);
        }
#pragma unroll
        for (int i = 0; i < 16; ++i) acc[i] = 0.f;
        const int pe_lo = (int)PE[(size_t)tok * 128 + lane], pe_hi = (int)PE[(size_t)tok * 128 + 64 + lane];
        const float pg_lo = PG[(size_t)tok * 128 + lane], pg_hi = PG[(size_t)tok * 128 + 64 + lane];
        const float ps_lo = PS[(size_t)tok * 128 + lane], ps_hi = PS[(size_t)tok * 128 + 64 + lane];
#pragma unroll 1
        for (int hb = 0; hb < 4; ++hb) {
            const int pes = hb < 2 ? pe_lo : pe_hi; const float pgs = hb < 2 ? pg_lo : pg_hi, pss = hb < 2 ? ps_lo : ps_hi;
            const int lb = (hb & 1) * 32;
            float d[32];
#pragma unroll
            for (int j = 0; j < 32; ++j) {
                const int e = __builtin_amdgcn_readlane(pes, lb + j);
                const u32x2 uw = *(const u32x2*)(UT + (size_t)e * 512 + lane * 8);
                float s = 0.f;
#define P5_DOT(k, bs) { const f32x2 f = __builtin_amdgcn_cvt_scalef32_pk_f32_fp4(uw[k], 1.0f, bs); s = fmaf(x[8 * (k) + 2 * (bs)], f.x, s); s = fmaf(x[8 * (k) + 2 * (bs) + 1], f.y, s); }
                P5_DOT(0, 0) P5_DOT(0, 1) P5_DOT(0, 2) P5_DOT(0, 3) P5_DOT(1, 0) P5_DOT(1, 1) P5_DOT(1, 2) P5_DOT(1, 3)
                d[j] = s;
            }
            float r16[16], r8[8], r4[4], r2[2], r1;
#pragma unroll
            for (int j = 0; j < 16; ++j) { const float keep = b5 ? d[j + 16] : d[j], send = b5 ? d[j] : d[j + 16]; r16[j] = keep + __shfl_xor(send, 32); }
#pragma unroll
            for (int j = 0; j < 8; ++j) { const float keep = b4 ? r16[j + 8] : r16[j], send = b4 ? r16[j] : r16[j + 8]; r8[j] = keep + __shfl_xor(send, 16); }
#pragma unroll
            for (int j = 0; j < 4; ++j) { const float keep = b3 ? r8[j + 4] : r8[j], send = b3 ? r8[j] : r8[j + 4]; r4[j] = keep + __shfl_xor(send, 8); }
#pragma unroll
            for (int j = 0; j < 2; ++j) { const float keep = b2 ? r4[j + 2] : r4[j], send = b2 ? r4[j] : r4[j + 2]; r2[j] = keep + __shfl_xor(send, 4); }
            { const float keep = b1 ? r2[1] : r2[0], send = b1 ? r2[0] : r2[1]; r1 = keep + __shfl_xor(send, 2); }
            r1 += __shfl_xor(r1, 1);
            const int mine = lb + ((lane >> 1) & 31);
            const float coef = gelu_exact(r1 * __shfl(pss, mine)) * __shfl(pgs, mine);
#pragma unroll
            for (int j = 0; j < 32; ++j) {
                const int e = __builtin_amdgcn_readlane(pes, lb + j);
                const float cj = rdlane(coef, 2 * j);
                const u32x2 vw = *(const u32x2*)(VT + (size_t)e * 512 + lane * 8);
#define P5_AXPY(k, bs) { const f32x2 f = __builtin_amdgcn_cvt_scalef32_pk_f32_fp4(vw[k], 1.0f, bs); acc[8 * (k) + 2 * (bs)] = fmaf(cj, f.x, acc[8 * (k) + 2 * (bs)]); acc[8 * (k) + 2 * (bs) + 1] = fmaf(cj, f.y, acc[8 * (k) + 2 * (bs) + 1]); }
                P5_AXPY(0, 0) P5_AXPY(0, 1) P5_AXPY(0, 2) P5_AXPY(0, 3) P5_AXPY(1, 0) P5_AXPY(1, 1) P5_AXPY(1, 2) P5_AXPY(1, 3)
            }
        }
        float s = 0.f;
#pragma unroll
        for (int i = 0; i < 16; ++i) { acc[i] = fmaf(ALPHA, x[i], acc[i]); s += acc[i]; }
        const float mu = wave_sum(s) * (1.f / 1024.f); float q = 0.f;
#pragma unroll
        for (int i = 0; i < 16; ++i) { const float dd = acc[i] - mu; q = fmaf(dd, dd, q); }
        const float rstd = rsqrtf(wave_sum(q) * (1.f / 1024.f) + LN_EPS);
#pragma unroll
        for (int k4 = 0; k4 < 4; ++k4) {
            const int col = lane * 16 + k4 * 4;
            const f32x4 gg = *(const f32x4*)(p.ln2_g + col), bb = *(const f32x4*)(p.ln2_b + col);
            f32x4 o;
#pragma unroll
            for (int e = 0; e < 4; ++e) o[e] = (acc[k4 * 4 + e] - mu) * rstd * gg[e] + bb[e];
            *(f32x4*)(p.out + (size_t)tok * 1024 + col) = o;
        }
    }
}

#define XB_TMO      128
#define XB_XCNT(j)  (256  + 64 * (j))
#define XB_XSUB(j)  (1280 + 64 * (j))
#define XB_XGEN(j)  (2304 + 64 * (j))
#define XB_TOP      3328
#define XB_TOPGEN   3392
#define XCD_BAR_WORDS 3456
#define XB_SPIN_CAP (1u << 22)
#define LAS __attribute__((address_space(3)))
DI unsigned xb_ld(unsigned* p)              { return __hip_atomic_load(p, __ATOMIC_RELAXED, __HIP_MEMORY_SCOPE_AGENT); }
DI unsigned xb_add(unsigned* p, unsigned v) { return __hip_atomic_fetch_add(p, v, __ATOMIC_RELAXED, __HIP_MEMORY_SCOPE_AGENT); }
DI unsigned xb_xcc_id() { return (unsigned)__builtin_amdgcn_s_getreg((3 << 11) | 20) & 0xFu; }
#define XB_SPIN(cond, bar) do { unsigned _sp = 0; while (cond) { __builtin_amdgcn_s_sleep(1); \
    if ((++_sp & 255u) == 0u) { if (xb_ld(&(bar)[XB_TMO])) break; if (_sp > XB_SPIN_CAP) { atomicAdd(&(bar)[XB_TMO], 1u); break; } } } } while (0)
struct XcdBarrier { unsigned* bar; unsigned x; volatile LAS unsigned* st; };
DI XcdBarrier xcd_barrier_post(unsigned* bar, volatile LAS unsigned* st) {
    XcdBarrier b; b.bar = bar; b.x = xb_xcc_id(); b.st = st;
    if (threadIdx.x == 0) (void)xb_add(&bar[XB_XCNT(b.x)], 1u);
    return b;
}
DI void xcd_barrier_complete(unsigned* bar, unsigned x, unsigned& nloc, unsigned& nx) {
    const unsigned G = gridDim.x * gridDim.y * gridDim.z;
    unsigned sum, cnt, mine, sp = 0u;
    for (;;) {
        sum = 0u; cnt = 0u; mine = 0u;
#pragma unroll
        for (unsigned j = 0; j < 16; ++j) { const unsigned c = xb_ld(&bar[XB_XCNT(j)]); sum += c; cnt += (c > 0u) ? 1u : 0u; mine = (j == x) ? c : mine; }
        if (sum == G) break;
        __builtin_amdgcn_s_sleep(1);
        if ((++sp & 255u) == 0u) { if (xb_ld(&bar[XB_TMO])) break; if (sp > XB_SPIN_CAP) { atomicAdd(&bar[XB_TMO], 1u); break; } }
    }
    nloc = mine > 0u ? mine : 1u; nx = cnt > 0u ? cnt : 1u;
}
DI void xcd_barrier(const XcdBarrier& b) {
    asm volatile("s_waitcnt vmcnt(0)" ::: "memory");
    __syncthreads();
    if (threadIdx.x == 0) {
        unsigned* bar = b.bar;
        __builtin_amdgcn_s_waitcnt(0);
        unsigned nloc = b.st[0], nx = b.st[1];
        if (nloc == 0u) { xcd_barrier_complete(bar, b.x, nloc, nx); b.st[0] = nloc; b.st[1] = nx; }
        const unsigned old = xb_add(&bar[XB_XSUB(b.x)], 1u);
        const unsigned gen = old / nloc;
        if (old + 1u == (gen + 1u) * nloc) {
            __builtin_amdgcn_fence(__ATOMIC_RELEASE, "agent");
            asm volatile("s_waitcnt vmcnt(0)" ::: "memory");
            const unsigned og = xb_add(&bar[XB_TOP], 1u);
            const unsigned tg = og / nx;
            if (og + 1u == (tg + 1u) * nx) xb_add(&bar[XB_TOPGEN], 1u);
            else XB_SPIN(xb_ld(&bar[XB_TOPGEN]) == tg, bar);
            __builtin_amdgcn_fence(__ATOMIC_ACQUIRE, "agent");
            xb_add(&bar[XB_XGEN(b.x)], 1u);
            asm volatile("s_waitcnt vmcnt(0)" ::: "memory");
        } else {
            XB_SPIN(xb_ld(&bar[XB_XGEN(b.x)]) == gen, bar);
            __builtin_amdgcn_fence(__ATOMIC_ACQUIRE, "agent");
            asm volatile("s_waitcnt vmcnt(0)" ::: "memory");
        }
    }
    __syncthreads();
}

constexpr int NPHASE = 7;
__global__ void __launch_bounds__(NTHREADS, 2) mega_fwd(Params p) {
    extern __shared__ __attribute__((aligned(16))) unsigned char lds[];
    cg::grid_group grid = cg::this_grid();
    const int lo = p.ph_lo, hi = p.ph_hi;
    volatile LAS unsigned* xbst = (volatile LAS unsigned*)(LAS unsigned char*)(lds + LDS_BYTES - 16);
#ifndef REP_MASK
#define REP_MASK 0
#endif
#ifndef P2_PROBE_MODE
#define P2_PROBE_MODE 15
#endif
#ifndef PH_MASK
#define PH_MASK 127
#endif
    if (lo == 0x7fffffff) grid.sync();
    if (threadIdx.x == 0) { xbst[0] = 0u; xbst[1] = 0u; }
    __syncthreads();
    XcdBarrier xb = xcd_barrier_post((unsigned*)(p.ws + WS_BAR), xbst);
#define GSYNC() xcd_barrier(xb)
    p0_prep(p, lds);
    GSYNC();
#define RUN_PHASE(k, call) { call; if ((REP_MASK >> (k)) & 1) { GSYNC(); call; } }
#if PH_MASK & 2
    RUN_PHASE(1, p1_inproj(p, lds))
#endif
    GSYNC();
#if PH_MASK & 4
#if (REP_MASK >> 2) & 1
    p2a_indexer(p, lds); GSYNC(); p2_attention<P2_PROBE_MODE>(p, lds, 1); GSYNC();
#endif
    p2a_indexer(p, lds);
    GSYNC();
    p2_attention<15>(p, lds, 0);
#endif
    GSYNC();
#if PH_MASK & 8
    RUN_PHASE(3, p3_outproj(p, lds))
#endif
    GSYNC();
#if PH_MASK & 16
    RUN_PHASE(4, p3b_ln1(p))
#endif
    GSYNC();
#if PH_MASK & 32
    RUN_PHASE(5, p4_peer_query(p, lds))
#endif
    GSYNC();
#if PH_MASK & 64
    RUN_PHASE(6, p5_gather(p))
#endif
}

#ifndef MK_N_LAUNCHES
#define MK_N_LAUNCHES 1
#endif

extern "C" void kernel_launch(void* const* d_in, const int* in_sizes, int n_in, void* d_out, int out_size, void* d_ws, size_t ws_size, hipStream_t stream) {
    static int grid_blocks = 0;
    if (grid_blocks == 0) {
        if (n_in != 14 || out_size != NTOK * D_MODEL || ws_size < WS_END) {
            fprintf(stderr, "kernel_launch: unexpected problem (n_in %d, out %d, ws %zu, need %zu)\n", n_in, out_size, ws_size, (size_t)WS_END); grid_blocks = -1; return;
        }
        int dev = 0, cus = 0, per_cu = 0;
        hipGetDevice(&dev);
        hipDeviceGetAttribute(&cus, hipDeviceAttributeMultiprocessorCount, dev);
        if (hipFuncSetAttribute((const void*)mega_fwd, hipFuncAttributeMaxDynamicSharedMemorySize, LDS_BYTES) != hipSuccess) { fprintf(stderr, "kernel_launch: hipFuncSetAttribute failed\n"); }
        if (hipOccupancyMaxActiveBlocksPerMultiprocessor(&per_cu, (const void*)mega_fwd, NTHREADS, LDS_BYTES) != hipSuccess || per_cu < 1) { fprintf(stderr, "kernel_launch: occupancy query failed\n"); per_cu = 1; }
        if (per_cu > 2) per_cu = 2;
        (void)hipGetLastError();
        grid_blocks = cus * per_cu;
        fprintf(stderr, "kernel_launch: %d CUs x %d blocks\n", cus, per_cu);
    }
    if (grid_blocks < 0) return;
    Params p{};
    p.x = (const float*)d_in[0]; p.w_in = (const float*)d_in[1]; p.idx_k_g = (const float*)d_in[2]; p.idx_k_b = (const float*)d_in[3]; p.sinks = (const float*)d_in[4];
    p.w_o = (const float*)d_in[5]; p.ln1_g = (const float*)d_in[6]; p.ln1_b = (const float*)d_in[7]; p.peer_wq = (const float*)d_in[8]; p.peer_subkeys = (const float*)d_in[9];
    p.peer_u = (const float*)d_in[10]; p.peer_v = (const float*)d_in[11]; p.ln2_g = (const float*)d_in[12]; p.ln2_b = (const float*)d_in[13];
    p.out = (float*)d_out; p.ws = (unsigned char*)d_ws;
    p.ph_lo = 0; p.ph_hi = NPHASE;
    if (hipMemsetAsync((unsigned char*)d_ws + WS_BAR, 0, XCD_BAR_WORDS * 4, stream) != hipSuccess) { fprintf(stderr, "kernel_launch: memset of the barrier words failed\n"); return; }
    void* args[] = {&p};
    hipError_t e = hipLaunchCooperativeKernel((const void*)mega_fwd, dim3(grid_blocks), dim3(NTHREADS), args, LDS_BYTES, stream);
    if (e != hipSuccess) fprintf(stderr, "cooperative launch failed: %s (grid %d)\n", hipGetErrorString(e), grid_blocks);
}
```

```cpp
#include <hip/hip_runtime.h>
#include <hip/hip_cooperative_groups.h>
#include <cstdio>
#include <cstdint>
namespace cg = cooperative_groups;

typedef unsigned short bf16_t;
typedef short bf16x8 __attribute__((ext_vector_type(8)));
typedef float f32x4 __attribute__((ext_vector_type(4)));
typedef float f32x16 __attribute__((ext_vector_type(16)));
typedef unsigned u32x4 __attribute__((ext_vector_type(4)));
typedef unsigned u32x2 __attribute__((ext_vector_type(2)));
#define DI __device__ __forceinline__

constexpr int D_MODEL = 1024, BATCH = 8, SEQ = 4096, NTOK = BATCH * SEQ;
constexpr int NMIX = 1732, NMIX_PAD = 1792;
constexpr int PEER_N = 2048;
constexpr float ALPHA = 1.189207115002721f;
constexpr float LN_EPS = 1e-5f;
constexpr int NTHREADS = 256;
constexpr int LDS_BYTES = 77824;

constexpr size_t MB = 1024 * 1024;
constexpr size_t WS_CTL   = 0;
constexpr size_t WS_BAR   = 65536;
constexpr size_t WS_ROPE  = 1 * MB;
constexpr size_t WS_WINT  = 2 * MB;
constexpr size_t WS_WOT   = 6 * MB;
constexpr size_t WS_WQT   = 8 * MB;
constexpr size_t WS_SK    = 12 * MB;
constexpr size_t WS_UT    = 13 * MB;
constexpr size_t WS_VT    = 29 * MB;
constexpr size_t WS_SU    = 45 * MB;
constexpr size_t WS_SV    = 46 * MB;
constexpr size_t WS_XB    = 77 * MB;
constexpr size_t WS_QA    = 141 * MB;
constexpr size_t WS_KA    = 173 * MB;
constexpr size_t WS_VA    = 181 * MB;
constexpr size_t WS_QB    = 189 * MB;
constexpr size_t WS_KB    = 221 * MB;
constexpr size_t WS_VB    = 225 * MB;
constexpr size_t WS_QI    = 229 * MB;
constexpr size_t WS_KI    = 245 * MB;
constexpr size_t WS_WI    = 249 * MB;
constexpr size_t WS_ATT   = 250 * MB;
constexpr size_t WS_PE    = 314 * MB;
constexpr size_t WS_PG    = 322 * MB;
constexpr size_t WS_PS    = 338 * MB;
constexpr size_t WS_END   = 354 * MB;

struct Params {
    const float* x; const float* w_in; const float* idx_k_g; const float* idx_k_b; const float* sinks; const float* w_o;
    const float* ln1_g; const float* ln1_b; const float* peer_wq; const float* peer_subkeys; const float* peer_u; const float* peer_v;
    const float* ln2_g; const float* ln2_b;
    float* out; unsigned char* ws;
    int ph_lo, ph_hi;
};

typedef float f32x2 __attribute__((ext_vector_type(2)));
typedef __bf16 bf16x2_t __attribute__((ext_vector_type(2)));
DI unsigned pack_bf16(float lo, float hi) { const f32x2 v = {lo, hi}; return __builtin_bit_cast(unsigned, __builtin_convertvector(v, bf16x2_t)); }
DI unsigned f2bf(float x) { return pack_bf16(x, 0.f) & 0xffffu; }
DI float bf_lo(unsigned w) { return __uint_as_float(w << 16); }
DI float bf_hi(unsigned w) { return __uint_as_float(w & 0xffff0000u); }
DI bf16x8 as_bf16x8(u32x4 v) { return __builtin_bit_cast(bf16x8, v); }
DI u32x4 ldg16(const void* p) { return *(const u32x4*)p; }
DI f32x4 mfma16(bf16x8 a, bf16x8 b, f32x4 c) { return __builtin_amdgcn_mfma_f32_16x16x32_bf16(a, b, c, 0, 0, 0); }
DI f32x16 mfma32(bf16x8 a, bf16x8 b, f32x16 c) { return __builtin_amdgcn_mfma_f32_32x32x16_bf16(a, b, c, 0, 0, 0); }
DI float wave_sum(float v) {
#pragma unroll
    for (int o = 32; o >= 1; o >>= 1) v += __shfl_xor(v, o);
    return v;
}

DI void glds16(const void* src, void* lds_dst) { __builtin_amdgcn_global_load_lds((const unsigned*)src, (__attribute__((address_space(3))) unsigned*)lds_dst, 16, 0, 0); }
DI void gemm_128x128(const bf16_t* __restrict__ X, int ldx, const bf16_t* __restrict__ Wt, int ldw, int K, unsigned char* lds, f32x4 (&acc)[4][4]) {
    int tid = threadIdx.x; asm volatile("" : "+v"(tid));
    const int lane = tid & 63, wave = tid >> 6, wm = wave >> 1, wn = wave & 1, c = lane & 15, g = lane >> 4;
    const int lrow = tid >> 3, lch = tid & 7;
    const bf16_t* xp = X + (size_t)lrow * ldx + ((lch ^ (lrow & 7)) * 8);
    const bf16_t* wp = Wt + (size_t)lrow * ldw + ((lch ^ (lrow & 7)) * 8);
    unsigned char* dst0 = lds + tid * 16;
#pragma unroll
    for (int m = 0; m < 4; ++m)
#pragma unroll
        for (int n = 0; n < 4; ++n) acc[m][n] = (f32x4){0.f, 0.f, 0.f, 0.f};
    const int nk = K / 64;
    __syncthreads();
#pragma unroll
    for (int i = 0; i < 4; ++i) { glds16(xp + (size_t)(32 * i) * ldx, dst0 + i * 4096); glds16(wp + (size_t)(32 * i) * ldw, dst0 + 16384 + i * 4096); }
    asm volatile("s_waitcnt vmcnt(0)" ::: "memory");
    __syncthreads();
    for (int kt = 0; kt < nk; ++kt) {
        const unsigned char* Xs = lds + (kt & 1) * 32768; const unsigned char* Ws = Xs + 16384;
        if (kt + 1 < nk) {
            unsigned char* d = dst0 + ((kt + 1) & 1) * 32768;
#pragma unroll
            for (int i = 0; i < 4; ++i) { glds16(xp + (size_t)(32 * i) * ldx + (kt + 1) * 64, d + i * 4096); glds16(wp + (size_t)(32 * i) * ldw + (kt + 1) * 64, d + 16384 + i * 4096); }
        }
#pragma unroll
        for (int s = 0; s < 2; ++s) {
            bf16x8 xf[4], wf[4];
#pragma unroll
            for (int m = 0; m < 4; ++m) { const int row = wm * 64 + m * 16 + c; xf[m] = as_bf16x8(*(const u32x4*)(Xs + row * 128 + (((4 * s + g) ^ (c & 7)) << 4))); }
#pragma unroll
            for (int n = 0; n < 4; ++n) { const int row = wn * 64 + n * 16 + c; wf[n] = as_bf16x8(*(const u32x4*)(Ws + row * 128 + (((4 * s + g) ^ (c & 7)) << 4))); }
#pragma unroll
            for (int m = 0; m < 4; ++m)
#pragma unroll
                for (int n = 0; n < 4; ++n) acc[m][n] = mfma16(wf[n], xf[m], acc[m][n]);
        }
        asm volatile("s_waitcnt vmcnt(0)" ::: "memory");
        __syncthreads();
    }
}

DI bool tile_of(int k, int NT, int MT, int& mt, int& nt) {
    const int G = gridDim.x, bid = blockIdx.x;
    if (((G | MT) & 7) == 0) {
        const int idx = (bid >> 3) + k * (G >> 3);
        if (idx >= (MT >> 3) * NT) return false;
        mt = (idx / NT) * 8 + (bid & 7); nt = idx % NT;
    } else {
        const int t = bid + k * G;
        if (t >= MT * NT) return false;
        mt = t / NT; nt = t % NT;
    }
    return true;
}

DI void p0_prep(const Params& p, unsigned char* lds) {
    const int tid = threadIdx.x, nb = gridDim.x, bid = blockIdx.x;
    const size_t gtid = (size_t)bid * NTHREADS + tid, gsz = (size_t)nb * NTHREADS;
    unsigned char* ws = p.ws;
    {
        float* ct = (float*)(ws + WS_ROPE); float* stb = ct + SEQ * 32;
        for (size_t i = gtid; i < (size_t)SEQ * 32; i += gsz) {
            const int pos = (int)(i >> 5), fi = (int)(i & 31);
            const float inv = powf(10000.0f, -(float)(2 * fi) / 64.0f);
            const float ang = (float)pos * inv;
            ct[i] = cosf(ang); stb[i] = sinf(ang);
        }
    }
    auto conv = [&](const float* src, bf16_t* dst, size_t n) {
        for (size_t i = gtid * 8; i < n; i += gsz * 8) {
            const f32x4 a = *(const f32x4*)(src + i), b = *(const f32x4*)(src + i + 4);
            u32x4 o; o.x = pack_bf16(a.x, a.y); o.y = pack_bf16(a.z, a.w); o.z = pack_bf16(b.x, b.y); o.w = pack_bf16(b.z, b.w);
            *(u32x4*)(dst + i) = o;
        }
    };
    conv(p.x, (bf16_t*)(ws + WS_XB), (size_t)NTOK * D_MODEL);
    conv(p.peer_subkeys, (bf16_t*)(ws + WS_SK), (size_t)8 * 2 * 128 * 128);
    float* tl = (float*)lds;
    auto transp = [&](const float* src, bf16_t* dst, int N, int Npad) {
        const int tn = Npad / 64, tk = 1024 / 64;
        for (int t = bid; t < tn * tk; t += nb) {
            const int n0 = (t % tn) * 64, k0 = (t / tn) * 64;
            __syncthreads();
            for (int e = tid; e < 4096; e += NTHREADS) { const int kk = e >> 6, nn = e & 63; tl[kk * 65 + nn] = (n0 + nn < N) ? src[(size_t)(k0 + kk) * N + n0 + nn] : 0.f; }
            __syncthreads();
            for (int e = tid; e < 4096; e += NTHREADS) { const int nn = e >> 6, kk = e & 63; dst[(size_t)(n0 + nn) * 1024 + k0 + kk] = (bf16_t)f2bf(tl[kk * 65 + nn]); }
        }
    };
    transp(p.w_in, (bf16_t*)(ws + WS_WINT), NMIX, NMIX_PAD);
}

DI void p0_late(const Params& p, unsigned char* lds) {
    const int tid = threadIdx.x, nb = gridDim.x, bid = blockIdx.x;
    unsigned char* ws = p.ws;
    {
        const int lane = tid & 63, gw = bid * 4 + (tid >> 6), nw = nb * 4;
        for (int row0 = gw * 4; row0 < 2 * 16384; row0 += nw * 4) {
            f32x4 v[4][4];
#pragma unroll
            for (int r = 0; r < 4; ++r) {
                const int row = row0 + r; const bool isv = row >= 16384; const int e = isv ? row - 16384 : row;
                const float* src = (isv ? p.peer_v : p.peer_u) + (size_t)e * 1024 + lane * 16;
#pragma unroll
                for (int i = 0; i < 4; ++i) v[r][i] = *(const f32x4*)(src + 4 * i);
            }
#pragma unroll
            for (int r = 0; r < 4; ++r) {
                const int row = row0 + r; const bool isv = row >= 16384; const int e = isv ? row - 16384 : row;
                float mx = 0.f;
#pragma unroll
                for (int i = 0; i < 4; ++i) mx = fmaxf(mx, fmaxf(fmaxf(fabsf(v[r][i][0]), fabsf(v[r][i][1])), fmaxf(fabsf(v[r][i][2]), fabsf(v[r][i][3]))));
#pragma unroll
                for (int o = 32; o >= 1; o >>= 1) mx = fmaxf(mx, __shfl_xor(mx, o));
                const float sc = mx > 0.f ? mx * (1.0f / 5.99f) : 1.0f, inv = mx > 0.f ? 5.99f / mx : 1.0f;
                u32x2 o2;
#pragma unroll
                for (int k = 0; k < 2; ++k) {
                    unsigned w = 0;
                    w = __builtin_amdgcn_cvt_scalef32_pk_fp4_f32(w, v[r][2 * k][0] * inv, v[r][2 * k][1] * inv, 1.0f, 0);
                    w = __builtin_amdgcn_cvt_scalef32_pk_fp4_f32(w, v[r][2 * k][2] * inv, v[r][2 * k][3] * inv, 1.0f, 1);
                    w = __builtin_amdgcn_cvt_scalef32_pk_fp4_f32(w, v[r][2 * k + 1][0] * inv, v[r][2 * k + 1][1] * inv, 1.0f, 2);
                    w = __builtin_amdgcn_cvt_scalef32_pk_fp4_f32(w, v[r][2 * k + 1][2] * inv, v[r][2 * k + 1][3] * inv, 1.0f, 3);
                    o2[k] = w;
                }
                *(u32x2*)(ws + (isv ? WS_VT : WS_UT) + (size_t)e * 512 + lane * 8) = o2;
                if (lane == 0) ((float*)(ws + (isv ? WS_SV : WS_SU)))[e] = sc;
            }
        }
    }
    float* tl = (float*)lds;
    auto transp = [&](const float* src, bf16_t* dst, int N, int Npad) {
        const int tn = Npad / 64, tk = 1024 / 64;
        for (int t = bid; t < tn * tk; t += nb) {
            const int n0 = (t % tn) * 64, k0 = (t / tn) * 64;
            __syncthreads();
            for (int e = tid; e < 4096; e += NTHREADS) { const int kk = e >> 6, nn = e & 63; tl[kk * 65 + nn] = (n0 + nn < N) ? src[(size_t)(k0 + kk) * N + n0 + nn] : 0.f; }
            __syncthreads();
            for (int e = tid; e < 4096; e += NTHREADS) { const int nn = e >> 6, kk = e & 63; dst[(size_t)(n0 + nn) * 1024 + k0 + kk] = (bf16_t)f2bf(tl[kk * 65 + nn]); }
        }
    };
    transp(p.w_o, (bf16_t*)(ws + WS_WOT), 1024, 1024);
    transp(p.peer_wq, (bf16_t*)(ws + WS_WQT), PEER_N, PEER_N);
}

DI void p1_inproj(const Params& p, unsigned char* lds) {
    unsigned char* ws = p.ws;
    const bf16_t* XB = (const bf16_t*)(ws + WS_XB); const bf16_t* WT = (const bf16_t*)(ws + WS_WINT);
    const float* cosT = (const float*)(ws + WS_ROPE); const float* sinT = cosT + SEQ * 32;
    const int tid = threadIdx.x, lane = tid & 63, wave = tid >> 6, wm = wave >> 1, wn = wave & 1, c = lane & 15, g = lane >> 4;
    constexpr int NT = NMIX_PAD / 128, MT = NTOK / 128;
    int mt, nt;
    for (int k = 0; tile_of(k, NT, MT, mt, nt); ++k) {
        f32x4 acc[4][4];
        gemm_128x128(XB + (size_t)mt * 128 * 1024, 1024, WT + (size_t)nt * 128 * 1024, 1024, 1024, lds, acc);
        const int col64 = nt * 2 + wn;
        bf16_t* dst; int ld, coff; bool rope = true; float scale = 1.f;
        if (col64 < 8)       { dst = (bf16_t*)(ws + WS_QA); ld = 512; coff = col64 * 64; scale = 0.125f; }
        else if (col64 < 10) { dst = (bf16_t*)(ws + WS_KA); ld = 128; coff = (col64 - 8) * 64; }
        else if (col64 < 12) { dst = (bf16_t*)(ws + WS_VA); ld = 128; coff = (col64 - 10) * 64; rope = false; }
        else if (col64 < 20) { dst = (bf16_t*)(ws + WS_QB); ld = 512; coff = (col64 - 12) * 64; scale = 0.125f; }
        else if (col64 == 20) { dst = (bf16_t*)(ws + WS_KB); ld = 64; coff = 0; }
        else if (col64 == 21) { dst = (bf16_t*)(ws + WS_VB); ld = 64; coff = 0; rope = false; }
        else if (col64 < 26) { dst = (bf16_t*)(ws + WS_QI); ld = 256; coff = (col64 - 22) * 64; }
        else                 { dst = (bf16_t*)(ws + WS_KI); ld = 64; coff = 0; }
        if (col64 == 27) {
            if (g == 0) {
#pragma unroll
                for (int m = 0; m < 4; ++m) { const int tok = mt * 128 + wm * 64 + m * 16 + c; *(f32x4*)((float*)(ws + WS_WI) + (size_t)tok * 4) = acc[m][0] * 0.0625f; }
            }
            continue;
        }
#pragma unroll
        for (int m = 0; m < 4; ++m) {
            const int tok = mt * 128 + wm * 64 + m * 16 + c, pos = tok & (SEQ - 1);
            f32x4 v[4] = {acc[m][0], acc[m][1], acc[m][2], acc[m][3]};
            if (col64 == 26) {
                float s = 0.f;
#pragma unroll
                for (int n = 0; n < 4; ++n) s += (v[n][0] + v[n][1]) + (v[n][2] + v[n][3]);
                s += __shfl_xor(s, 16); s += __shfl_xor(s, 32);
                const float mu = s * (1.f / 64.f); float q = 0.f;
#pragma unroll
                for (int n = 0; n < 4; ++n) { const f32x4 d = v[n] - mu; q += (d[0] * d[0] + d[1] * d[1]) + (d[2] * d[2] + d[3] * d[3]); }
                q += __shfl_xor(q, 16); q += __shfl_xor(q, 32);
                const float rstd = rsqrtf(q * (1.f / 64.f) + LN_EPS);
#pragma unroll
                for (int n = 0; n < 4; ++n) {
                    const f32x4 gg = *(const f32x4*)(p.idx_k_g + 16 * n + 4 * g), bb = *(const f32x4*)(p.idx_k_b + 16 * n + 4 * g);
                    v[n] = (v[n] - mu) * rstd * gg + bb;
                }
            }
            if (rope) {
#pragma unroll
                for (int n = 0; n < 2; ++n) {
                    const f32x4 cs = *(const f32x4*)(cosT + pos * 32 + 16 * n + 4 * g), sn = *(const f32x4*)(sinT + pos * 32 + 16 * n + 4 * g);
                    const f32x4 t1 = v[n], t2 = v[n + 2];
                    v[n] = t1 * cs - t2 * sn; v[n + 2] = t2 * cs + t1 * sn;
                }
            }
#pragma unroll
            for (int n = 0; n < 4; ++n) {
                const f32x4 o = v[n] * scale; u32x2 w; w.x = pack_bf16(o[0], o[1]); w.y = pack_bf16(o[2], o[3]);
                *(u32x2*)(dst + (size_t)tok * ld + coff + 16 * n + 4 * g) = w;
            }
        }
    }
}

constexpr int NDSA = NTOK / 4, NSWA = BATCH * 32 * 8;
constexpr int P2_STG = 0  , P2_LIST = 32768;

DI unsigned f16_key(float v) {
    _Float16 hv = (_Float16)v; unsigned short hb = __builtin_bit_cast(unsigned short, hv); unsigned b = hb;
    if (b == 0x8000u) b = 0u;
    return (b & 0x8000u) ? ((~b) & 0xffffu) : (b | 0x8000u);
}

DI size_t sc_row_off(int t) { const size_t m = (size_t)(t >> 3); return 8 * (4 * m * (m + 1) + (size_t)(t & 7) * (m + 1)); }
constexpr size_t SC_BATCH = 8404992;
DI unsigned short* sc_batch_base(const Params& p, int b) { return (b < 7) ? (unsigned short*)p.out + (size_t)b * SC_BATCH : (unsigned short*)(p.ws + WS_XB); }

DI void p2a_indexer(const Params& p, unsigned char* lds) {
    unsigned char* ws = p.ws;
    const bf16_t* QI = (const bf16_t*)(ws + WS_QI); const bf16_t* KI = (const bf16_t*)(ws + WS_KI); const float* WI = (const float*)(ws + WS_WI);
    const int G = gridDim.x, bi = blockIdx.x;
    for (int it = 0; it < 2; ++it) {
        const int item = (it == 0) ? bi : 1023 - bi;
        for (int id = (G == 512) ? item : bi + it * G; id < 1024; id += (G == 512) ? 1024 : 2 * G) {
            int tid = threadIdx.x; asm volatile("" : "+v"(tid));
            const int lane = tid & 63, wave = tid >> 6, c = lane & 15, g = lane >> 4, lrow = tid >> 3, lch = tid & 7;
            const int b = id >> 7, t0 = (id & 127) * 32, tokw = b * SEQ + t0 + 8 * wave;
            unsigned short* scb = sc_batch_base(p, b);
            bf16x8 af[2][2]; f32x4 wv[2];
#pragma unroll
            for (int rt = 0; rt < 2; ++rt) {
#pragma unroll
                for (int s2 = 0; s2 < 2; ++s2) af[rt][s2] = as_bf16x8(ldg16(QI + (size_t)(tokw + 4 * rt + (c >> 2)) * 256 + (c & 3) * 64 + 32 * s2 + 8 * g));
                wv[rt] = *(const f32x4*)(WI + (size_t)(tokw + 4 * rt + g) * 4);
            }
            asm volatile("" :: "v"(af[0][0]), "v"(af[0][1]), "v"(af[1][0]), "v"(af[1][1]), "v"(wv[0]), "v"(wv[1]));
            const int nkt = ((t0 + 31) >> 7) + 1;
            const unsigned char* kib = (const unsigned char*)(KI + (size_t)b * SEQ * 64);
            unsigned char* dst0 = lds + tid * 16;
            auto stage = [&](int kt, int buf) {
#pragma unroll
                for (int i = 0; i < 4; ++i) {
                    const int row = lrow + 32 * i;
                    glds16(kib + (size_t)(kt * 128 + row) * 128 + ((lch ^ ((row >> 3) & 7)) << 4), dst0 + buf * 16384 + i * 4096);
                }
            };
            __syncthreads();
            stage(0, 0);
            asm volatile("s_waitcnt vmcnt(0)" ::: "memory");
            __syncthreads();
            for (int kt = 0; kt < nkt; ++kt) {
                const unsigned char* Ks = lds + (kt & 1) * 16384;
                if (kt + 1 < nkt) stage(kt + 1, (kt + 1) & 1);
                unsigned res[2][4];
#pragma unroll
                for (int ct = 0; ct < 8; ++ct) {
                    const int row = 8 * c + ct;
                    const bf16x8 k0 = as_bf16x8(*(const u32x4*)(Ks + row * 128 + ((g ^ (c & 7)) << 4)));
                    const bf16x8 k1 = as_bf16x8(*(const u32x4*)(Ks + row * 128 + (((4 + g) ^ (c & 7)) << 4)));
#pragma unroll
                    for (int rt = 0; rt < 2; ++rt) {
                        f32x4 d = mfma16(af[rt][0], k0, (f32x4){0.f, 0.f, 0.f, 0.f});
                        d = mfma16(af[rt][1], k1, d);
                        const float sv = wv[rt][0] * fmaxf(d[0], 0.f) + wv[rt][1] * fmaxf(d[1], 0.f) + wv[rt][2] * fmaxf(d[2], 0.f) + wv[rt][3] * fmaxf(d[3], 0.f);
                        const int key = kt * 128 + row, tq = t0 + 8 * wave + 4 * rt + g;
                        const unsigned kv = (key <= tq) ? f16_key(sv) : 0u;
                        if (ct & 1) res[rt][ct >> 1] |= kv << 16; else res[rt][ct >> 1] = kv;
                    }
                }
#pragma unroll
                for (int rt = 0; rt < 2; ++rt) {
                    const int tq = t0 + 8 * wave + 4 * rt + g;
                    if (16 * kt + c <= (tq >> 3)) {
                        u32x4 w; w.x = res[rt][0]; w.y = res[rt][1]; w.z = res[rt][2]; w.w = res[rt][3];
                        *(u32x4*)(scb + sc_row_off(tq) + kt * 128 + 8 * c) = w;
                    }
                }
                asm volatile("s_waitcnt vmcnt(0)" ::: "memory");
                __syncthreads();
            }
        }
    }
    p0_late(p, lds);
}

template <int MODE> DI void p2_dsa_item(const Params& p, unsigned char* lds, int b, int tb) {
    unsigned char* ws = p.ws;
    const bf16_t* QI = (const bf16_t*)(ws + WS_QI); const bf16_t* KI = (const bf16_t*)(ws + WS_KI); const float* WI = (const float*)(ws + WS_WI);
    const bf16_t* QB = (const bf16_t*)(ws + WS_QB); const bf16_t* KB = (const bf16_t*)(ws + WS_KB); const bf16_t* VB = (const bf16_t*)(ws + WS_VB);
    bf16_t* ATT = (bf16_t*)(ws + WS_ATT);
    int tid = threadIdx.x; asm volatile("" : "+v"(tid));
    const int lane = tid & 63, wave = __builtin_amdgcn_readfirstlane(tid >> 6), c = lane & 15, g = lane >> 4;
    const int t0 = tb * 4, tok0 = b * SEQ + t0;
    unsigned char* stg = lds + P2_STG + wave * 8192;
    unsigned* hist = (unsigned*)stg;
    unsigned short* list = (unsigned short*)(lds + P2_LIST) + wave * 256;
    const int tok = tok0 + wave;
    if (!(MODE & 2)) return;
    const int n = t0 + wave + 1;
    const int L = n < 256 ? n : 256;
    const unsigned short* myk = sc_batch_base(p, b) + sc_row_off(t0 + wave);
    if (n <= 256) {
        for (int i = lane; i < n; i += 64) list[i] = (unsigned short)i;
    } else {
        u32x4 kk[8];
#pragma unroll
        for (int i = 0; i < 8; ++i) kk[i] = (512 * i + 8 * lane < n) ? ldg16(myk + 512 * i + 8 * lane) : (u32x4){0u, 0u, 0u, 0u};
#pragma unroll
        for (int i = 0; i < 4; ++i) *(u32x4*)(hist + lane * 16 + i * 4) = (u32x4){0u, 0u, 0u, 0u};
#pragma unroll
        for (int i = 0; i < 8; ++i) {
            if (512 * i < n) {
#pragma unroll
                for (int w = 0; w < 4; ++w) { const unsigned wd = kk[i][w]; atomicAdd(&hist[(wd & 0xffffu) >> 6], 1u); atomicAdd(&hist[wd >> 22], 1u); }
            }
        }
        unsigned h[16];
#pragma unroll
        for (int i = 0; i < 4; ++i) { const u32x4 t = *(const u32x4*)(hist + lane * 16 + i * 4); h[4 * i] = t.x; h[4 * i + 1] = t.y; h[4 * i + 2] = t.z; h[4 * i + 3] = t.w; }
#pragma unroll
        for (int i = 0; i < 4; ++i) *(u32x4*)(hist + lane * 16 + i * 4) = (u32x4){0u, 0u, 0u, 0u};
        unsigned sl = 0;
#pragma unroll
        for (int i = 0; i < 16; ++i) sl += h[i];
        unsigned pre = sl;
#pragma unroll
        for (int o = 1; o < 64; o <<= 1) { const unsigned t = __shfl_up(pre, o); if (lane >= o) pre += t; }
        const unsigned tot = __shfl(pre, 63);
        const unsigned suf = tot - pre;
        int found = -1; unsigned cab = 0, cum = suf;
#pragma unroll
        for (int j = 15; j >= 0; --j) { const bool hit = (found < 0) && (cum + h[j] >= 256u); if (hit) { found = lane * 16 + j; cab = cum; } cum += h[j]; }
        const bool mine = (suf < 256u) && (suf + sl >= 256u);
        const unsigned long long mm = __ballot(mine);
        const int src = __ffsll((long long)mm) - 1;
        const unsigned bstar = (unsigned)__shfl(found, src), cabove = __shfl(cab, src);
        const unsigned r1 = 256u - cabove;
#pragma unroll
        for (int i = 0; i < 8; ++i) {
            if (512 * i < n) {
#pragma unroll
                for (int w = 0; w < 4; ++w) {
                    const unsigned wd = kk[i][w];
                    if (((wd & 0xffffu) >> 6) == bstar) atomicAdd(&hist[wd & 63u], 1u);
                    if ((wd >> 22) == bstar) atomicAdd(&hist[(wd >> 16) & 63u], 1u);
                }
            }
        }
        const unsigned cnt = hist[lane];
        hist[lane] = 0u;
        unsigned pre2 = cnt;
#pragma unroll
        for (int o = 1; o < 64; o <<= 1) { const unsigned t = __shfl_up(pre2, o); if (lane >= o) pre2 += t; }
        const unsigned tot2 = __shfl(pre2, 63);
        const unsigned suf2 = tot2 - pre2;
        const bool mine2 = (suf2 < r1) && (suf2 + cnt >= r1);
        const unsigned long long mm2 = __ballot(mine2);
        const int src2 = __ffsll((long long)mm2) - 1;
        const unsigned T = (bstar << 6) | (unsigned)src2;
        const unsigned req = r1 - __shfl(suf2, src2);
        const unsigned toteq = __shfl(cnt, src2);
        const bool alleq = (req == toteq);
        const unsigned Tt = alleq ? T : T + 1u;
        unsigned cg = 0;
#pragma unroll
        for (int i = 0; i < 8; ++i)
#pragma unroll
            for (int w = 0; w < 4; ++w) { const unsigned wd = kk[i][w]; cg += ((wd & 0xffffu) >= Tt) ? 1u : 0u; cg += ((wd >> 16) >= Tt) ? 1u : 0u; }
        unsigned pre3 = cg;
#pragma unroll
        for (int o = 1; o < 64; o <<= 1) { const unsigned t = __shfl_up(pre3, o); if (lane >= o) pre3 += t; }
        unsigned off = pre3 - cg;
#pragma unroll
        for (int i = 0; i < 8; ++i)
#pragma unroll
            for (int w = 0; w < 4; ++w) {
                const unsigned wd = kk[i][w]; const int idx = 512 * i + 8 * lane + 2 * w;
                if ((wd & 0xffffu) >= Tt) { list[off & 255u] = (unsigned short)idx; ++off; }
                if ((wd >> 16) >= Tt) { list[off & 255u] = (unsigned short)(idx + 1); ++off; }
            }
        if (!alleq) {
            const unsigned cgt = 256u - req; unsigned eq_run = 0;
            for (int base = 0; base < n; base += 64) {
                const int i = base + lane; const unsigned m = (i < n) ? myk[i] : 0u;
                const bool eq = (m == T);
                const unsigned long long eqm = __ballot(eq);
                const unsigned rank = eq_run + __builtin_amdgcn_mbcnt_hi((unsigned)(eqm >> 32), __builtin_amdgcn_mbcnt_lo((unsigned)eqm, 0u));
                if (eq && rank < req) list[cgt + rank] = (unsigned short)i;
                eq_run += (unsigned)__popcll(eqm);
            }
        }
    }
    if (!(MODE & 4)) return;
    bf16x8 qf[2], sel[2];
#pragma unroll
    for (int s = 0; s < 2; ++s) {
        u32x4 t = (u32x4){0u, 0u, 0u, 0u};
        if (c < 8) t = ldg16(QB + (size_t)tok * 512 + c * 64 + 32 * s + 8 * g);
        qf[s] = as_bf16x8(t);
#pragma unroll
        for (int j = 0; j < 8; ++j) sel[s][j] = (8 * g + j == 16 * s + c) ? (short)0x3F80 : (short)0;
    }
    f32x4 st[16];
    const unsigned char* kbb = (const unsigned char*)(KB + (size_t)b * SEQ * 64); const unsigned char* vbb = (const unsigned char*)(VB + (size_t)b * SEQ * 64);
    const int lr = lane >> 3, lc = lane & 7;
    const unsigned st_off = lr * 128 + ((lc ^ lr) << 4);
    auto loadg = [&](const unsigned char* base, int T0, u32x4 (&dst)[8]) {
#pragma unroll
        for (int i = 0; i < 8; ++i) {
            const int idx = T0 * 16 + i * 8 + lr; const unsigned kid = (idx < L) ? (unsigned)list[idx] : 0u;
            dst[i] = ldg16(base + kid * 128u + lc * 16u);
        }
    };
    auto stage = [&](const u32x4 (&src)[8]) {
#pragma unroll
        for (int i = 0; i < 8; ++i) *(u32x4*)(stg + i * 1024 + st_off) = src[i];
    };
    auto frag = [&](int u, int s2) -> bf16x8 { return as_bf16x8(*(const u32x4*)(stg + (16 * u + c) * 128 + (((4 * s2 + g) ^ (c & 7)) << 4))); };
    auto scoreK = [&](int T0) {
#pragma unroll
        for (int T = 0; T < 4; ++T) {
            f32x4 d = mfma16(frag(T, 0), qf[0], (f32x4){0.f, 0.f, 0.f, 0.f});
            st[T0 + T] = mfma16(frag(T, 1), qf[1], d);
        }
    };
    u32x4 rA[8], rB[8], rC[8], rD[8];
    loadg(kbb, 0, rA); loadg(kbb, 4, rB); loadg(kbb, 8, rC); loadg(kbb, 12, rD);
    __builtin_amdgcn_sched_barrier(0);
    stage(rA); scoreK(0);
    stage(rB); scoreK(4);
    __builtin_amdgcn_sched_barrier(0);
    loadg(vbb, 0, rA); loadg(vbb, 4, rB);
    stage(rC); scoreK(8);
    stage(rD); scoreK(12);
    __builtin_amdgcn_sched_barrier(0);
    float mx = -3.0e38f;
    {
        const int lrem = L - 4 * g;
#pragma unroll
        for (int T = 0; T < 16; ++T)
#pragma unroll
            for (int r = 0; r < 4; ++r) { const float sv = (T * 16 + r < lrem) ? st[T][r] : -3.0e38f; st[T][r] = sv; mx = fmaxf(mx, sv); }
    }
    mx = fmaxf(mx, __shfl_xor(mx, 16)); mx = fmaxf(mx, __shfl_xor(mx, 32));
    float lsum = 0.f;
#pragma unroll
    for (int T = 0; T < 16; ++T)
#pragma unroll
        for (int r = 0; r < 4; ++r) { const float e = __expf(st[T][r] - mx); st[T][r] = e; lsum += e; }
    lsum += __shfl_xor(lsum, 16); lsum += __shfl_xor(lsum, 32);
    const float rl = 1.0f / lsum;
    u32x4 pfv[8];
#pragma unroll
    for (int u = 0; u < 8; ++u) {
        const int Ta = 2 * u, Tb = Ta + 1;
        pfv[u].x = pack_bf16(st[Ta][0] * rl, st[Ta][1] * rl); pfv[u].y = pack_bf16(st[Ta][2] * rl, st[Ta][3] * rl);
        pfv[u].z = pack_bf16(st[Tb][0] * rl, st[Tb][1] * rl); pfv[u].w = pack_bf16(st[Tb][2] * rl, st[Tb][3] * rl);
    }
    __builtin_amdgcn_sched_barrier(0);
    f32x4 O[4];
#pragma unroll
    for (int cb = 0; cb < 4; ++cb) O[cb] = (f32x4){0.f, 0.f, 0.f, 0.f};
    auto pv = [&](int T0) {
#pragma unroll
        for (int u = 0; u < 2; ++u) {
            const u32x4 pf = pfv[(T0 >> 1) + u];
#pragma unroll
            for (int cb = 0; cb < 4; ++cb) {
                const f32x4 z = (f32x4){0.f, 0.f, 0.f, 0.f};
                const f32x4 v0 = mfma16(frag(2 * u, cb >> 1), sel[cb & 1], z), v1 = mfma16(frag(2 * u + 1, cb >> 1), sel[cb & 1], z);
                u32x4 vf; vf.x = pack_bf16(v0[0], v0[1]); vf.y = pack_bf16(v0[2], v0[3]); vf.z = pack_bf16(v1[0], v1[1]); vf.w = pack_bf16(v1[2], v1[3]);
                O[cb] = mfma16(as_bf16x8(pf), as_bf16x8(vf), O[cb]);
            }
        }
    };
    loadg(vbb, 8, rC); loadg(vbb, 12, rD);
    __builtin_amdgcn_sched_barrier(0);
    stage(rA); pv(0);
    stage(rB); pv(4);
    __builtin_amdgcn_sched_barrier(0);
    stage(rC); pv(8);
    stage(rD); pv(12);
    if (g < 2) {
#pragma unroll
        for (int cb = 0; cb < 4; ++cb)
#pragma unroll
            for (int r = 0; r < 4; ++r) ATT[(size_t)tok * 1024 + 512 + (4 * g + r) * 64 + 16 * cb + c] = (bf16_t)f2bf(O[cb][r]);
    }
}

DI void p2_swa_item(const Params& p, int item2) {
    unsigned char* ws = p.ws;
    const bf16_t* QA = (const bf16_t*)(ws + WS_QA); const bf16_t* KA = (const bf16_t*)(ws + WS_KA); const bf16_t* VA = (const bf16_t*)(ws + WS_VA);
    bf16_t* ATT = (bf16_t*)(ws + WS_ATT);
    int tid = threadIdx.x; asm volatile("" : "+v"(tid));
    const int lane = tid & 63, wave = __builtin_amdgcn_readfirstlane(tid >> 6), r = lane & 31, h = lane >> 5;
    const int hq = item2 & 7, blk = (item2 >> 3) & 31, b = item2 >> 8, kvh = hq >> 2;
    const int qi = 32 * wave + r, tokq = b * SEQ + blk * 128 + qi;
    bf16x8 qf[4], sel[2];
#pragma unroll
    for (int s = 0; s < 4; ++s) qf[s] = as_bf16x8(ldg16(QA + (size_t)tokq * 512 + hq * 64 + 16 * s + 8 * h));
#pragma unroll
    for (int x = 0; x < 2; ++x)
#pragma unroll
        for (int j = 0; j < 8; ++j) sel[x][j] = (8 * h + j + 16 * x == r) ? (short)0x3F80 : (short)0;
    const float sink = p.sinks[hq];
    f32x16 ST[5];
#pragma unroll
    for (int ti = 0; ti < 5; ++ti) {
        const int sj = 32 * (wave + ti) + r; int pos = blk * 128 - 128 + sj; pos = pos < 0 ? 0 : pos;
        const bf16_t* kp = KA + (size_t)(b * SEQ + pos) * 128 + kvh * 64 + 8 * h;
        f32x16 d; for (int i = 0; i < 16; ++i) d[i] = 0.f;
#pragma unroll
        for (int s = 0; s < 4; ++s) d = mfma32(as_bf16x8(ldg16(kp + 16 * s)), qf[s], d);
        ST[ti] = d;
    }
    float mx = sink;
    {
        const int lo = r + 1 - 4 * h;
        const int lo0 = (blk > 0) ? lo : (lo > 128 - 32 * wave - 4 * h ? lo : 128 - 32 * wave - 4 * h);
#pragma unroll
        for (int ti = 0; ti < 5; ++ti)
#pragma unroll
            for (int reg = 0; reg < 16; ++reg) {
                const int e = 32 * ti + (reg & 3) + 8 * (reg >> 2);
                const float sv = (e >= lo0 && e < lo + 128) ? ST[ti][reg] : -3.0e38f; ST[ti][reg] = sv; mx = fmaxf(mx, sv);
            }
    }
    mx = fmaxf(mx, __shfl_xor(mx, 32));
    float lsum = 0.f;
#pragma unroll
    for (int ti = 0; ti < 5; ++ti)
#pragma unroll
        for (int reg = 0; reg < 16; ++reg) { const float e = __expf(ST[ti][reg] - mx); ST[ti][reg] = e; lsum += e; }
    lsum += __shfl_xor(lsum, 32);
    lsum += __expf(sink - mx);
    const float rl = 1.0f / lsum;
    f32x16 OT[2];
    for (int i = 0; i < 16; ++i) { OT[0][i] = 0.f; OT[1][i] = 0.f; }
#pragma unroll
    for (int ti = 0; ti < 5; ++ti) {
        const int sj = 32 * (wave + ti) + r; int pos = blk * 128 - 128 + sj; pos = pos < 0 ? 0 : pos;
        const bf16_t* vp = VA + (size_t)(b * SEQ + pos) * 128 + kvh * 64 + 8 * h;
        bf16x8 vf[4];
#pragma unroll
        for (int s = 0; s < 4; ++s) vf[s] = as_bf16x8(ldg16(vp + 16 * s));
        u32x4 pb[2];
#pragma unroll
        for (int s2 = 0; s2 < 2; ++s2) {
            pb[s2].x = pack_bf16(ST[ti][8 * s2 + 0] * rl, ST[ti][8 * s2 + 1] * rl); pb[s2].y = pack_bf16(ST[ti][8 * s2 + 2] * rl, ST[ti][8 * s2 + 3] * rl);
            pb[s2].z = pack_bf16(ST[ti][8 * s2 + 4] * rl, ST[ti][8 * s2 + 5] * rl); pb[s2].w = pack_bf16(ST[ti][8 * s2 + 6] * rl, ST[ti][8 * s2 + 7] * rl);
        }
#pragma unroll
        for (int db = 0; db < 2; ++db) {
            f32x16 vt; for (int i = 0; i < 16; ++i) vt[i] = 0.f;
            vt = mfma32(vf[2 * db], sel[0], vt); vt = mfma32(vf[2 * db + 1], sel[1], vt);
#pragma unroll
            for (int s2 = 0; s2 < 2; ++s2) {
                u32x4 va; va.x = pack_bf16(vt[8 * s2 + 0], vt[8 * s2 + 1]); va.y = pack_bf16(vt[8 * s2 + 2], vt[8 * s2 + 3]);
                va.z = pack_bf16(vt[8 * s2 + 4], vt[8 * s2 + 5]); va.w = pack_bf16(vt[8 * s2 + 6], vt[8 * s2 + 7]);
                OT[db] = mfma32(as_bf16x8(va), as_bf16x8(pb[s2]), OT[db]);
            }
        }
    }
#pragma unroll
    for (int db = 0; db < 2; ++db)
#pragma unroll
        for (int q4 = 0; q4 < 4; ++q4) {
            u32x2 w; w.x = pack_bf16(OT[db][4 * q4], OT[db][4 * q4 + 1]); w.y = pack_bf16(OT[db][4 * q4 + 2], OT[db][4 * q4 + 3]);
            *(u32x2*)(ATT + (size_t)tokq * 1024 + hq * 64 + 32 * db + 8 * q4 + 4 * h) = w;
        }
}

template <int MODE> DI void p2_attention(const Params& p, unsigned char* lds, int cidx = 0) {
    const int G = gridDim.x, bi = blockIdx.x, rounds = (1024 + G - 1) / G;
    for (int b = 0; b < BATCH; ++b)
        for (int r = 0; r < rounds; ++r) {
            const int idx = (r & 1) ? r * G + (G - 1 - bi) : r * G + bi;
            if (idx < 1024) p2_dsa_item<MODE>(p, lds, b, 1023 - idx);
        }
    if (MODE & 8) for (int item2 = bi; item2 < NSWA; item2 += G) p2_swa_item(p, item2);
}

DI void p3_outproj(const Params& p, unsigned char* lds) {
    unsigned char* ws = p.ws;
    const bf16_t* ATT = (const bf16_t*)(ws + WS_ATT); const bf16_t* WT = (const bf16_t*)(ws + WS_WOT);
    const int tid = threadIdx.x, lane = tid & 63, wave = tid >> 6, wm = wave >> 1, wn = wave & 1, c = lane & 15, g = lane >> 4;
    constexpr int NT = 8, MT = NTOK / 128;
    int mt, nt;
    for (int k = 0; tile_of(k, NT, MT, mt, nt); ++k) {
        f32x4 acc[4][4];
        gemm_128x128(ATT + (size_t)mt * 128 * 1024, 1024, WT + (size_t)nt * 128 * 1024, 1024, 1024, lds, acc);
#pragma unroll
        for (int m = 0; m < 4; ++m) {
            const int tok = mt * 128 + wm * 64 + m * 16 + c;
#pragma unroll
            for (int n = 0; n < 4; ++n) {
                const size_t o = (size_t)tok * 1024 + nt * 128 + wn * 64 + 16 * n + 4 * g;
                const f32x4 xv = *(const f32x4*)(p.x + o);
                const f32x4 hv = xv * ALPHA + acc[m][n];
                u32x2 w; w.x = pack_bf16(hv[0], hv[1]); w.y = pack_bf16(hv[2], hv[3]);
                *(u32x2*)((bf16_t*)p.out + o) = w;
            }
        }
    }
}

DI void p3b_ln1(const Params& p) {
    bf16_t* H1B = (bf16_t*)(p.ws + WS_XB); const bf16_t* HP = (const bf16_t*)p.out;
    const int lane = threadIdx.x & 63, gw = blockIdx.x * 4 + (threadIdx.x >> 6), nw = gridDim.x * 4;
    for (int row = gw; row < NTOK; row += nw) {
        const u32x4 ra = ldg16(HP + (size_t)row * 1024 + lane * 16), rb = ldg16(HP + (size_t)row * 1024 + lane * 16 + 8);
        float v[16];
        v[0] = bf_lo(ra.x); v[1] = bf_hi(ra.x); v[2] = bf_lo(ra.y); v[3] = bf_hi(ra.y); v[4] = bf_lo(ra.z); v[5] = bf_hi(ra.z); v[6] = bf_lo(ra.w); v[7] = bf_hi(ra.w);
        v[8] = bf_lo(rb.x); v[9] = bf_hi(rb.x); v[10] = bf_lo(rb.y); v[11] = bf_hi(rb.y); v[12] = bf_lo(rb.z); v[13] = bf_hi(rb.z); v[14] = bf_lo(rb.w); v[15] = bf_hi(rb.w);
        float s = 0.f;
#pragma unroll
        for (int i = 0; i < 16; ++i) s += v[i];
        const float mu = wave_sum(s) * (1.f / 1024.f); float q = 0.f;
#pragma unroll
        for (int i = 0; i < 16; ++i) { const float d = v[i] - mu; q = fmaf(d, d, q); }
        const float rstd = rsqrtf(wave_sum(q) * (1.f / 1024.f) + LN_EPS);
        u32x4 oa, ob;
#pragma unroll
        for (int k4 = 0; k4 < 4; ++k4) {
            const int col = lane * 16 + k4 * 4;
            const f32x4 gg = *(const f32x4*)(p.ln1_g + col), bb = *(const f32x4*)(p.ln1_b + col);
            float o[4];
#pragma unroll
            for (int e = 0; e < 4; ++e) o[e] = (v[k4 * 4 + e] - mu) * rstd * gg[e] + bb[e];
            const unsigned w0 = pack_bf16(o[0], o[1]), w1 = pack_bf16(o[2], o[3]);
            if (k4 == 0) { oa.x = w0; oa.y = w1; } else if (k4 == 1) { oa.z = w0; oa.w = w1; } else if (k4 == 2) { ob.x = w0; ob.y = w1; } else { ob.z = w0; ob.w = w1; }
        }
        *(u32x4*)(H1B + (size_t)row * 1024 + lane * 16) = oa; *(u32x4*)(H1B + (size_t)row * 1024 + lane * 16 + 8) = ob;
    }
}

DI int f2key(float v) { const int b = __float_as_int(v); return b ^ ((b >> 31) & 0x7fffffff); }
DI float key2f(int k) { return __int_as_float(k ^ ((k >> 31) & 0x7fffffff)); }
DI void ce_desc(int& a, int& b) { const int hi = a > b ? a : b, lo = a > b ? b : a; a = hi; b = lo; }
DI void bitonic_merge16(int (&k)[16]) {
#pragma unroll
    for (int d = 8; d >= 1; d >>= 1)
#pragma unroll
        for (int i = 0; i < 16; ++i) if ((i & d) == 0) ce_desc(k[i], k[i | d]);
}
DI void bitonic_sort16(int (&k)[16]) {
#pragma unroll
    for (int sz = 2; sz <= 16; sz <<= 1) {
#pragma unroll
        for (int i = 0; i < 16; ++i) { const int j = i ^ (sz - 1); if (j > i) ce_desc(k[i], k[j]); }
#pragma unroll
        for (int d = sz >> 2; d >= 1; d >>= 1)
#pragma unroll
            for (int i = 0; i < 16; ++i) if ((i & d) == 0) ce_desc(k[i], k[i | d]);
    }
}
DI void top16_merge(int (&t)[16], const int (&sdesc)[16]) {
#pragma unroll
    for (int i = 0; i < 16; ++i) t[i] = t[i] > sdesc[15 - i] ? t[i] : sdesc[15 - i];
    bitonic_merge16(t);
}
constexpr int P4_QS = 32768, P4_SS_STRIDE = 132, P4_ST0 = 67584  , P4_M = 0  , P4_ST1 = 8704  ;

DI void p4_peer_query(const Params& p, unsigned char* lds) {
    unsigned char* ws = p.ws;
    const bf16_t* H1B = (const bf16_t*)(ws + WS_XB); const bf16_t* WQT = (const bf16_t*)(ws + WS_WQT); const bf16_t* SK = (const bf16_t*)(ws + WS_SK);
    unsigned short* PE = (unsigned short*)(ws + WS_PE); float* PG = (float*)(ws + WS_PG); float* PS = (float*)(ws + WS_PS);
    const float* SU = (const float*)(ws + WS_SU); const float* SV = (const float*)(ws + WS_SV);
    float* Ss = (float*)lds;
    float* st0 = (float*)(lds + P4_ST0); float* mbuf = (float*)(lds + P4_M); float* st1 = (float*)(lds + P4_ST1);
    constexpr int MT = NTOK / 128;
    int mt, head;
    for (int k = 0; tile_of(k, 8, MT, mt, head); ++k) {
        int tid = threadIdx.x; asm volatile("" : "+v"(tid));
        const int lane = tid & 63, wave = tid >> 6, wm = wave >> 1, wn = wave & 1, c = lane & 15, g = lane >> 4;
        const int lrow = tid >> 3, lch = tid & 7;
        const int srow = tid & 127, shalf = tid >> 7;
#pragma unroll 1
        for (int ph = 0; ph < 2; ++ph) {
            f32x4 acc[4][4];
            gemm_128x128(H1B + (size_t)mt * 128 * 1024, 1024, WQT + (size_t)(head * 256 + ph * 128) * 1024, 1024, 1024, lds, acc);
            __syncthreads();
#pragma unroll
            for (int m = 0; m < 4; ++m)
#pragma unroll
                for (int n = 0; n < 4; ++n) {
                    const int row = wm * 64 + m * 16 + c;
                    u32x2 w; w.x = pack_bf16(acc[m][n][0], acc[m][n][1]); w.y = pack_bf16(acc[m][n][2], acc[m][n][3]);
                    *(u32x2*)(lds + P4_QS + wn * 16384 + row * 128 + (((2 * n + (g >> 1)) ^ (row & 7)) << 4) + (g & 1) * 8) = w;
                }
            {
                const bf16_t* sp = SK + (size_t)((head * 2 + ph) * 128 + lrow) * 128 + lch * 8;
#pragma unroll
                for (int k2 = 0; k2 < 2; ++k2)
#pragma unroll
                    for (int i = 0; i < 4; ++i) *(u32x4*)(lds + k2 * 16384 + (lrow + 32 * i) * 128 + ((lch ^ (lrow & 7)) << 4)) = ldg16(sp + (size_t)(32 * i) * 128 + k2 * 64);
            }
            __syncthreads();
            f32x4 a2[4][4];
#pragma unroll
            for (int m = 0; m < 4; ++m)
#pragma unroll
                for (int n = 0; n < 4; ++n) a2[m][n] = (f32x4){0.f, 0.f, 0.f, 0.f};
#pragma unroll
            for (int k2 = 0; k2 < 2; ++k2)
#pragma unroll
                for (int s = 0; s < 2; ++s) {
                    bf16x8 xf[4], wf[4];
#pragma unroll
                    for (int m = 0; m < 4; ++m) { const int row = wm * 64 + m * 16 + c; xf[m] = as_bf16x8(*(const u32x4*)(lds + P4_QS + k2 * 16384 + row * 128 + (((4 * s + g) ^ (c & 7)) << 4))); }
#pragma unroll
                    for (int n = 0; n < 4; ++n) { const int row = wn * 64 + n * 16 + c; wf[n] = as_bf16x8(*(const u32x4*)(lds + k2 * 16384 + row * 128 + (((4 * s + g) ^ (c & 7)) << 4))); }
#pragma unroll
                    for (int m = 0; m < 4; ++m)
#pragma unroll
                        for (int n = 0; n < 4; ++n) a2[m][n] = mfma16(wf[n], xf[m], a2[m][n]);
                }
            __syncthreads();
#pragma unroll
            for (int m = 0; m < 4; ++m)
#pragma unroll
                for (int n = 0; n < 4; ++n) {
                    const int key0 = wn * 64 + 16 * n + 4 * g;
                    u32x4 w;
#pragma unroll
                    for (int r = 0; r < 4; ++r) w[r] = (unsigned)f2key(__uint_as_float((__float_as_uint(a2[m][n][r]) & 0xFFFFFF80u) | (unsigned)(key0 + r)));
                    *(u32x4*)(Ss + (wm * 64 + m * 16 + c) * P4_SS_STRIDE + key0) = w;
                }
            __syncthreads();
            int tv[16];
            {
                const int* rowp = (const int*)Ss + srow * P4_SS_STRIDE + shalf * 64;
#pragma unroll
                for (int bt = 0; bt < 4; ++bt) {
                    int bk[16];
#pragma unroll
                    for (int j = 0; j < 4; ++j) { const u32x4 v = *(const u32x4*)(rowp + 16 * bt + 4 * j); bk[4 * j] = (int)v.x; bk[4 * j + 1] = (int)v.y; bk[4 * j + 2] = (int)v.z; bk[4 * j + 3] = (int)v.w; }
                    bitonic_sort16(bk);
                    if (bt == 0) {
#pragma unroll
                        for (int j = 0; j < 16; ++j) tv[j] = bk[j];
                    } else top16_merge(tv, bk);
                }
            }
            __syncthreads();
            int* mbi = (int*)mbuf;
            if (shalf == 1) {
#pragma unroll
                for (int j = 0; j < 16; ++j) mbi[srow * 17 + j] = tv[j];
            }
            __syncthreads();
            if (shalf == 0) {
                int* dst = (int*)((ph == 0) ? st0 : st1);
                int ob[16];
#pragma unroll
                for (int j = 0; j < 16; ++j) ob[j] = mbi[srow * 17 + j];
                top16_merge(tv, ob);
#pragma unroll
                for (int j = 0; j < 16; ++j) dst[srow * 17 + j] = tv[j];
            }
        }
        __syncthreads();
        int cv[16];
        {
            const int* st0i = (const int*)st0; const int* st1i = (const int*)st1;
            float v2[16];
#pragma unroll
            for (int b = 0; b < 16; ++b) v2[b] = key2f(st1i[srow * 17 + b]);
#pragma unroll
            for (int a8 = 0; a8 < 8; ++a8) {
                const int a = shalf * 8 + a8; const float va = key2f(st0i[srow * 17 + a]);
                int bk[16];
#pragma unroll
                for (int b = 0; b < 16; ++b) bk[b] = (f2key(va + v2[b]) & (int)0xFFFFFF00) | (a * 16 + 15 - b);
                if (a8 == 0) {
#pragma unroll
                    for (int j = 0; j < 16; ++j) cv[j] = bk[j];
                } else top16_merge(cv, bk);
            }
        }
        __syncthreads();
        int* mbi = (int*)mbuf;
        if (shalf == 1) {
#pragma unroll
            for (int j = 0; j < 16; ++j) mbi[srow * 17 + j] = cv[j];
        }
        __syncthreads();
        if (shalf == 0) {
            const int* st0i = (const int*)st0; const int* st1i = (const int*)st1;
            int fk[16]; float fv[16];
#pragma unroll
            for (int j = 0; j < 16; ++j) { const int o = mbi[srow * 17 + 15 - j]; fk[j] = cv[j] > o ? cv[j] : o; fv[j] = key2f(fk[j]); }
            float cmax = fv[0];
#pragma unroll
            for (int j = 1; j < 16; ++j) cmax = fmaxf(cmax, fv[j]);
            float den = 0.f; float ev[16];
#pragma unroll
            for (int j = 0; j < 16; ++j) { ev[j] = __expf(fv[j] - cmax); den += ev[j]; }
            const float rden = 1.0f / den;
            const size_t ob = (size_t)(mt * 128 + srow) * 128 + head * 16;
#pragma unroll
            for (int j = 0; j < 16; ++j) {
                const unsigned cde = (unsigned)fk[j] & 0xFFu;
                const unsigned a = cde >> 4, b = 15u - (cde & 15u);
                const unsigned i1 = __float_as_uint(key2f(st0i[srow * 17 + a])) & 0x7Fu, i2 = __float_as_uint(key2f(st1i[srow * 17 + b])) & 0x7Fu;
                const int e = (int)(i1 * 128u + i2);
                PE[ob + j] = (unsigned short)e; PG[ob + j] = ev[j] * rden * SV[e]; PS[ob + j] = SU[e];
            }
        }
        __syncthreads();
    }
}

DI float gelu_exact(float z) { return 0.5f * z * (1.0f + erff(z * 0.70710678118654752f)); }
DI float rdlane(float v, int l) { return __int_as_float(__builtin_amdgcn_readlane(__float_as_int(v), l)); }

DI void p5_gather(const Params& p) {
    unsigned char* ws = p.ws;
    const bf16_t* H1B = (const bf16_t*)(ws + WS_XB); const unsigned char* UT = ws + WS_UT; const unsigned char* VT = ws + WS_VT;
    const unsigned short* PE = (const unsigned short*)(ws + WS_PE); const float* PG = (const float*)(ws + WS_PG); const float* PS = (const float*)(ws + WS_PS);
    const int lane = threadIdx.x & 63, gw = blockIdx.x * 4 + (threadIdx.x >> 6), nw = gridDim.x * 4;
    const bool b5 = (lane & 32) != 0, b4 = (lane & 16) != 0, b3 = (lane & 8) != 0, b2 = (lane & 4) != 0, b1 = (lane & 2) != 0;
    for (int tok = gw; tok < NTOK; tok += nw) {
        float x[16], acc[16];
        {
            const u32x4 xa = ldg16(H1B + (size_t)tok * 1024 + lane * 16), xb = ldg16(H1B + (size_t)tok * 1024 + lane * 16 + 8);
            x[0] = bf_lo(xa.x); x[1] = bf_hi(xa.x); x[2] = bf_lo(xa.y); x[3] = bf_hi(xa.y); x[4] = bf_lo(xa.z); x[5] = bf_hi(xa.z); x[6] = bf_lo(xa.w); x[7] = bf_hi(xa.w);
            x[8] = bf_lo(xb.x); x[9] = bf_hi(xb.x); x[10] = bf_lo(xb.y); x[11] = bf_hi(xb.y); x[12] = bf_lo(xb.z); x[13] = bf_hi(xb.z); x[14] = bf_lo(xb.w); x[15] = bf_hi(xb.w);
        }
#pragma unroll
        for (int i = 0; i < 16; ++i) acc[i] = 0.f;
        const int pe_lo = (int)PE[(size_t)tok * 128 + lane], pe_hi = (int)PE[(size_t)tok * 128 + 64 + lane];
        const float pg_lo = PG[(size_t)tok * 128 + lane], pg_hi = PG[(size_t)tok * 128 + 64 + lane];
        const float ps_lo = PS[(size_t)tok * 128 + lane], ps_hi = PS[(size_t)tok * 128 + 64 + lane];
#pragma unroll 1
        for (int hb = 0; hb < 4; ++hb) {
            const int pes = hb < 2 ? pe_lo : pe_hi; const float pgs = hb < 2 ? pg_lo : pg_hi, pss = hb < 2 ? ps_lo : ps_hi;
            const int lb = (hb & 1) * 32;
            float d[32];
            u32x2 uw[32];
#pragma unroll
            for (int j = 0; j < 32; ++j) { const int e = __builtin_amdgcn_readlane(pes, lb + j); uw[j] = *(const u32x2*)(UT + (size_t)e * 512 + lane * 8); }
#pragma unroll
            for (int j4 = 0; j4 < 8; ++j4) {
                f32x2 a0 = {0.f, 0.f}, a1 = {0.f, 0.f}, a2 = {0.f, 0.f}, a3 = {0.f, 0.f};
#define P5_DOT4(k, bs) { const f32x2 xx = {x[8 * (k) + 2 * (bs)], x[8 * (k) + 2 * (bs) + 1]}; \
                    const f32x2 f0 = __builtin_amdgcn_cvt_scalef32_pk_f32_fp4(uw[4 * j4][k], 1.0f, bs), f1 = __builtin_amdgcn_cvt_scalef32_pk_f32_fp4(uw[4 * j4 + 1][k], 1.0f, bs); \
                    const f32x2 f2 = __builtin_amdgcn_cvt_scalef32_pk_f32_fp4(uw[4 * j4 + 2][k], 1.0f, bs), f3 = __builtin_amdgcn_cvt_scalef32_pk_f32_fp4(uw[4 * j4 + 3][k], 1.0f, bs); \
                    a0 = xx * f0 + a0; a1 = xx * f1 + a1; a2 = xx * f2 + a2; a3 = xx * f3 + a3; }
                P5_DOT4(0, 0) P5_DOT4(0, 1) P5_DOT4(0, 2) P5_DOT4(0, 3) P5_DOT4(1, 0) P5_DOT4(1, 1) P5_DOT4(1, 2) P5_DOT4(1, 3)
                d[4 * j4] = a0.x + a0.y; d[4 * j4 + 1] = a1.x + a1.y; d[4 * j4 + 2] = a2.x + a2.y; d[4 * j4 + 3] = a3.x + a3.y;
            }
            float r16[16], r8[8], r4[4], r2[2], r1;
#pragma unroll
            for (int j = 0; j < 16; ++j) { const float keep = b5 ? d[j + 16] : d[j], send = b5 ? d[j] : d[j + 16]; r16[j] = keep + __shfl_xor(send, 32); }
#pragma unroll
            for (int j = 0; j < 8; ++j) { const float keep = b4 ? r16[j + 8] : r16[j], send = b4 ? r16[j] : r16[j + 8]; r8[j] = keep + __shfl_xor(send, 16); }
#pragma unroll
            for (int j = 0; j < 4; ++j) { const float keep = b3 ? r8[j + 4] : r8[j], send = b3 ? r8[j] : r8[j + 4]; r4[j] = keep + __shfl_xor(send, 8); }
#pragma unroll
            for (int j = 0; j < 2; ++j) { const float keep = b2 ? r4[j + 2] : r4[j], send = b2 ? r4[j] : r4[j + 2]; r2[j] = keep + __shfl_xor(send, 4); }
            { const float keep = b1 ? r2[1] : r2[0], send = b1 ? r2[0] : r2[1]; r1 = keep + __shfl_xor(send, 2); }
            r1 += __shfl_xor(r1, 1);
            const int mine = lb + ((lane >> 1) & 31);
            const float coef = gelu_exact(r1 * __shfl(pss, mine)) * __shfl(pgs, mine);
#pragma unroll
            for (int j = 0; j < 32; ++j) {
                const int e = __builtin_amdgcn_readlane(pes, lb + j);
                const float cj = rdlane(coef, 2 * j);
                const u32x2 vw = *(const u32x2*)(VT + (size_t)e * 512 + lane * 8);
#define P5_AXPY(k, bs) { const f32x2 f = __builtin_amdgcn_cvt_scalef32_pk_f32_fp4(vw[k], 1.0f, bs); acc[8 * (k) + 2 * (bs)] = fmaf(cj, f.x, acc[8 * (k) + 2 * (bs)]); acc[8 * (k) + 2 * (bs) + 1] = fmaf(cj, f.y, acc[8 * (k) + 2 * (bs) + 1]); }
                P5_AXPY(0, 0) P5_AXPY(0, 1) P5_AXPY(0, 2) P5_AXPY(0, 3) P5_AXPY(1, 0) P5_AXPY(1, 1) P5_AXPY(1, 2) P5_AXPY(1, 3)
            }
        }
        float s = 0.f;
#pragma unroll
        for (int i = 0; i < 16; ++i) { acc[i] = fmaf(ALPHA, x[i], acc[i]); s += acc[i]; }
        const float mu = wave_sum(s) * (1.f / 1024.f); float q = 0.f;
#pragma unroll
        for (int i = 0; i < 16; ++i) { const float dd = acc[i] - mu; q = fmaf(dd, dd, q); }
        const float rstd = rsqrtf(wave_sum(q) * (1.f / 1024.f) + LN_EPS);
#pragma unroll
        for (int k4 = 0; k4 < 4; ++k4) {
            const int col = lane * 16 + k4 * 4;
            const f32x4 gg = *(const f32x4*)(p.ln2_g + col), bb = *(const f32x4*)(p.ln2_b + col);
            f32x4 o;
#pragma unroll
            for (int e = 0; e < 4; ++e) o[e] = (acc[k4 * 4 + e] - mu) * rstd * gg[e] + bb[e];
            *(f32x4*)(p.out + (size_t)tok * 1024 + col) = o;
        }
    }
}

#define XB_TMO      128
#define XB_XCNT(j)  (256  + 64 * (j))
#define XB_XSUB(j)  (1280 + 64 * (j))
#define XB_XGEN(j)  (2304 + 64 * (j))
#define XB_TOP      3328
#define XB_TOPGEN   3392
#define XCD_BAR_WORDS 3456
#define XB_SPIN_CAP (1u << 22)
#define LAS __attribute__((address_space(3)))
DI unsigned xb_ld(unsigned* p)              { return __hip_atomic_load(p, __ATOMIC_RELAXED, __HIP_MEMORY_SCOPE_AGENT); }
DI unsigned xb_add(unsigned* p, unsigned v) { return __hip_atomic_fetch_add(p, v, __ATOMIC_RELAXED, __HIP_MEMORY_SCOPE_AGENT); }
DI unsigned xb_xcc_id() { return (unsigned)__builtin_amdgcn_s_getreg((3 << 11) | 20) & 0xFu; }
#define XB_SPIN(cond, bar) do { unsigned _sp = 0; while (cond) { __builtin_amdgcn_s_sleep(1); \
    if ((++_sp & 255u) == 0u) { if (xb_ld(&(bar)[XB_TMO])) break; if (_sp > XB_SPIN_CAP) { atomicAdd(&(bar)[XB_TMO], 1u); break; } } } } while (0)
struct XcdBarrier { unsigned* bar; unsigned x; volatile LAS unsigned* st; };
DI XcdBarrier xcd_barrier_post(unsigned* bar, volatile LAS unsigned* st) {
    XcdBarrier b; b.bar = bar; b.x = xb_xcc_id(); b.st = st;
    if (threadIdx.x == 0) (void)xb_add(&bar[XB_XCNT(b.x)], 1u);
    return b;
}
DI void xcd_barrier_complete(unsigned* bar, unsigned x, unsigned& nloc, unsigned& nx) {
    const unsigned G = gridDim.x * gridDim.y * gridDim.z;
    unsigned sum, cnt, mine, sp = 0u;
    for (;;) {
        sum = 0u; cnt = 0u; mine = 0u;
#pragma unroll
        for (unsigned j = 0; j < 16; ++j) { const unsigned c = xb_ld(&bar[XB_XCNT(j)]); sum += c; cnt += (c > 0u) ? 1u : 0u; mine = (j == x) ? c : mine; }
        if (sum == G) break;
        __builtin_amdgcn_s_sleep(1);
        if ((++sp & 255u) == 0u) { if (xb_ld(&bar[XB_TMO])) break; if (sp > XB_SPIN_CAP) { atomicAdd(&bar[XB_TMO], 1u); break; } }
    }
    nloc = mine > 0u ? mine : 1u; nx = cnt > 0u ? cnt : 1u;
}
DI void xcd_barrier(const XcdBarrier& b) {
    asm volatile("s_waitcnt vmcnt(0)" ::: "memory");
    __syncthreads();
    if (threadIdx.x == 0) {
        unsigned* bar = b.bar;
        __builtin_amdgcn_s_waitcnt(0);
        unsigned nloc = b.st[0], nx = b.st[1];
        if (nloc == 0u) { xcd_barrier_complete(bar, b.x, nloc, nx); b.st[0] = nloc; b.st[1] = nx; }
        const unsigned old = xb_add(&bar[XB_XSUB(b.x)], 1u);
        const unsigned gen = old / nloc;
        if (old + 1u == (gen + 1u) * nloc) {
            __builtin_amdgcn_fence(__ATOMIC_RELEASE, "agent");
            asm volatile("s_waitcnt vmcnt(0)" ::: "memory");
            const unsigned og = xb_add(&bar[XB_TOP], 1u);
            const unsigned tg = og / nx;
            if (og + 1u == (tg + 1u) * nx) xb_add(&bar[XB_TOPGEN], 1u);
            else XB_SPIN(xb_ld(&bar[XB_TOPGEN]) == tg, bar);
            __builtin_amdgcn_fence(__ATOMIC_ACQUIRE, "agent");
            xb_add(&bar[XB_XGEN(b.x)], 1u);
            asm volatile("s_waitcnt vmcnt(0)" ::: "memory");
        } else {
            XB_SPIN(xb_ld(&bar[XB_XGEN(b.x)]) == gen, bar);
            __builtin_amdgcn_fence(__ATOMIC_ACQUIRE, "agent");
            asm volatile("s_waitcnt vmcnt(0)" ::: "memory");
        }
    }
    __syncthreads();
}

constexpr int NPHASE = 7;
__global__ void __launch_bounds__(NTHREADS, 2) mega_fwd(Params p) {
    extern __shared__ __attribute__((aligned(16))) unsigned char lds[];
    cg::grid_group grid = cg::this_grid();
    const int lo = p.ph_lo, hi = p.ph_hi;
    volatile LAS unsigned* xbst = (volatile LAS unsigned*)(LAS unsigned char*)(lds + LDS_BYTES - 16);
#ifndef REP_MASK
#define REP_MASK 0
#endif
#ifndef P2_PROBE_MODE
#define P2_PROBE_MODE 15
#endif
#ifndef PH_MASK
#define PH_MASK 127
#endif
    if (lo == 0x7fffffff) grid.sync();
    if (threadIdx.x == 0) { xbst[0] = 0u; xbst[1] = 0u; }
    __syncthreads();
    XcdBarrier xb = xcd_barrier_post((unsigned*)(p.ws + WS_BAR), xbst);
#define GSYNC() xcd_barrier(xb)
    p0_prep(p, lds);
    GSYNC();
#define RUN_PHASE(k, call) { call; if ((REP_MASK >> (k)) & 1) { GSYNC(); call; } }
#if PH_MASK & 2
    RUN_PHASE(1, p1_inproj(p, lds))
#endif
    GSYNC();
#if PH_MASK & 4
#if (REP_MASK >> 2) & 1
    p2a_indexer(p, lds); GSYNC(); p2_attention<P2_PROBE_MODE>(p, lds, 1); GSYNC();
#endif
    p2a_indexer(p, lds);
    GSYNC();
    p2_attention<15>(p, lds, 0);
#endif
    GSYNC();
#if PH_MASK & 8
    RUN_PHASE(3, p3_outproj(p, lds))
#endif
    GSYNC();
#if PH_MASK & 16
    RUN_PHASE(4, p3b_ln1(p))
#endif
    GSYNC();
#if PH_MASK & 32
    RUN_PHASE(5, p4_peer_query(p, lds))
#endif
    GSYNC();
#if PH_MASK & 64
    RUN_PHASE(6, p5_gather(p))
#endif
}

#ifndef MK_N_LAUNCHES
#define MK_N_LAUNCHES 1
#endif

extern "C" void kernel_launch(void* const* d_in, const int* in_sizes, int n_in, void* d_out, int out_size, void* d_ws, size_t ws_size, hipStream_t stream) {
    static int grid_blocks = 0;
    if (grid_blocks == 0) {
        if (n_in != 14 || out_size != NTOK * D_MODEL || ws_size < WS_END) {
            fprintf(stderr, "kernel_launch: unexpected problem (n_in %d, out %d, ws %zu, need %zu)\n", n_in, out_size, ws_size, (size_t)WS_END); grid_blocks = -1; return;
        }
        int dev = 0, cus = 0, per_cu = 0;
        hipGetDevice(&dev);
        hipDeviceGetAttribute(&cus, hipDeviceAttributeMultiprocessorCount, dev);
        if (hipFuncSetAttribute((const void*)mega_fwd, hipFuncAttributeMaxDynamicSharedMemorySize, LDS_BYTES) != hipSuccess) { fprintf(stderr, "kernel_launch: hipFuncSetAttribute failed\n"); }
        if (hipOccupancyMaxActiveBlocksPerMultiprocessor(&per_cu, (const void*)mega_fwd, NTHREADS, LDS_BYTES) != hipSuccess || per_cu < 1) { fprintf(stderr, "kernel_launch: occupancy query failed\n"); per_cu = 1; }
        if (per_cu > 2) per_cu = 2;
        (void)hipGetLastError();
        grid_blocks = cus * per_cu;
        fprintf(stderr, "kernel_launch: %d CUs x %d blocks\n", cus, per_cu);
    }
    if (grid_blocks < 0) return;
    Params p{};
    p.x = (const float*)d_in[0]; p.w_in = (const float*)d_in[1]; p.idx_k_g = (const float*)d_in[2]; p.idx_k_b = (const float*)d_in[3]; p.sinks = (const float*)d_in[4];
    p.w_o = (const float*)d_in[5]; p.ln1_g = (const float*)d_in[6]; p.ln1_b = (const float*)d_in[7]; p.peer_wq = (const float*)d_in[8]; p.peer_subkeys = (const float*)d_in[9];
    p.peer_u = (const float*)d_in[10]; p.peer_v = (const float*)d_in[11]; p.ln2_g = (const float*)d_in[12]; p.ln2_b = (const float*)d_in[13];
    p.out = (float*)d_out; p.ws = (unsigned char*)d_ws;
    p.ph_lo = 0; p.ph_hi = NPHASE;
    if (hipMemsetAsync((unsigned char*)d_ws + WS_BAR, 0, XCD_BAR_WORDS * 4, stream) != hipSuccess) { fprintf(stderr, "kernel_launch: memset of the barrier words failed\n"); return; }
    void* args[] = {&p};
    hipError_t e = hipLaunchCooperativeKernel((const void*)mega_fwd, dim3(grid_blocks), dim3(NTHREADS), args, LDS_BYTES, stream);
    if (e != hipSuccess) fprintf(stderr, "cooperative launch failed: %s (grid %d)\n", hipGetErrorString(e), grid_blocks);
}
```

```cpp
#include <hip/hip_runtime.h>
#include <hip/hip_cooperative_groups.h>
#include <cstdio>
#include <cstdint>
namespace cg = cooperative_groups;

typedef unsigned short bf16_t;
typedef short bf16x8 __attribute__((ext_vector_type(8)));
typedef float f32x4 __attribute__((ext_vector_type(4)));
typedef float f32x16 __attribute__((ext_vector_type(16)));
typedef unsigned u32x4 __attribute__((ext_vector_type(4)));
typedef unsigned u32x2 __attribute__((ext_vector_type(2)));
#define DI __device__ __forceinline__

constexpr int D_MODEL = 1024, BATCH = 8, SEQ = 4096, NTOK = BATCH * SEQ;
constexpr int NMIX = 1732, NMIX_PAD = 1792;
constexpr int PEER_N = 2048;
constexpr float ALPHA = 1.189207115002721f;
constexpr float LN_EPS = 1e-5f;
constexpr int NTHREADS = 256;
constexpr int LDS_BYTES = 77824;

constexpr size_t MB = 1024 * 1024;
constexpr size_t WS_CTL   = 0;
constexpr size_t WS_BAR   = 65536;
constexpr size_t WS_ROPE  = 1 * MB;
constexpr size_t WS_WINT  = 2 * MB;
constexpr size_t WS_WOT   = 6 * MB;
constexpr size_t WS_WQT   = 8 * MB;
constexpr size_t WS_SK    = 12 * MB;
constexpr size_t WS_UT    = 13 * MB;
constexpr size_t WS_VT    = 29 * MB;
constexpr size_t WS_SU    = 45 * MB;
constexpr size_t WS_SV    = 46 * MB;
constexpr size_t WS_XB    = 77 * MB;
constexpr size_t WS_QA    = 141 * MB;
constexpr size_t WS_KA    = 173 * MB;
constexpr size_t WS_VA    = 181 * MB;
constexpr size_t WS_QB    = 189 * MB;
constexpr size_t WS_KB    = 221 * MB;
constexpr size_t WS_VB    = 225 * MB;
constexpr size_t WS_QI    = 229 * MB;
constexpr size_t WS_KI    = 245 * MB;
constexpr size_t WS_WI    = 249 * MB;
constexpr size_t WS_ATT   = 250 * MB;
constexpr size_t WS_PE    = 314 * MB;
constexpr size_t WS_PG    = 322 * MB;
constexpr size_t WS_PS    = 338 * MB;
constexpr size_t WS_END   = 354 * MB;

struct Params {
    const float* x; const float* w_in; const float* idx_k_g; const float* idx_k_b; const float* sinks; const float* w_o;
    const float* ln1_g; const float* ln1_b; const float* peer_wq; const float* peer_subkeys; const float* peer_u; const float* peer_v;
    const float* ln2_g; const float* ln2_b;
    float* out; unsigned char* ws;
    int ph_lo, ph_hi;
};

typedef float f32x2 __attribute__((ext_vector_type(2)));
typedef __bf16 bf16x2_t __attribute__((ext_vector_type(2)));
DI unsigned pack_bf16(float lo, float hi) { const f32x2 v = {lo, hi}; return __builtin_bit_cast(unsigned, __builtin_convertvector(v, bf16x2_t)); }
DI unsigned f2bf(float x) { return pack_bf16(x, 0.f) & 0xffffu; }
DI float bf_lo(unsigned w) { return __uint_as_float(w << 16); }
DI float bf_hi(unsigned w) { return __uint_as_float(w & 0xffff0000u); }
DI bf16x8 as_bf16x8(u32x4 v) { return __builtin_bit_cast(bf16x8, v); }
DI u32x4 ldg16(const void* p) { return *(const u32x4*)p; }
DI f32x4 mfma16(bf16x8 a, bf16x8 b, f32x4 c) { return __builtin_amdgcn_mfma_f32_16x16x32_bf16(a, b, c, 0, 0, 0); }
DI f32x16 mfma32(bf16x8 a, bf16x8 b, f32x16 c) { return __builtin_amdgcn_mfma_f32_32x32x16_bf16(a, b, c, 0, 0, 0); }
DI float wave_sum(float v) {
#pragma unroll
    for (int o = 32; o >= 1; o >>= 1) v += __shfl_xor(v, o);
    return v;
}

DI void glds16(const void* src, void* lds_dst) { __builtin_amdgcn_global_load_lds((const unsigned*)src, (__attribute__((address_space(3))) unsigned*)lds_dst, 16, 0, 0); }
DI void gemm_128x128(const bf16_t* __restrict__ X, int ldx, const bf16_t* __restrict__ Wt, int ldw, int K, unsigned char* lds, f32x4 (&acc)[4][4]) {
    int tid = threadIdx.x; asm volatile("" : "+v"(tid));
    const int lane = tid & 63, wave = tid >> 6, wm = wave >> 1, wn = wave & 1, c = lane & 15, g = lane >> 4;
    const int lrow = tid >> 3, lch = tid & 7;
    const bf16_t* xp = X + (size_t)lrow * ldx + ((lch ^ (lrow & 7)) * 8);
    const bf16_t* wp = Wt + (size_t)lrow * ldw + ((lch ^ (lrow & 7)) * 8);
    unsigned char* dst0 = lds + tid * 16;
#pragma unroll
    for (int m = 0; m < 4; ++m)
#pragma unroll
        for (int n = 0; n < 4; ++n) acc[m][n] = (f32x4){0.f, 0.f, 0.f, 0.f};
    const int nk = K / 64;
    __syncthreads();
#pragma unroll
    for (int i = 0; i < 4; ++i) { glds16(xp + (size_t)(32 * i) * ldx, dst0 + i * 4096); glds16(wp + (size_t)(32 * i) * ldw, dst0 + 16384 + i * 4096); }
    asm volatile("s_waitcnt vmcnt(0)" ::: "memory");
    __syncthreads();
    for (int kt = 0; kt < nk; ++kt) {
        const unsigned char* Xs = lds + (kt & 1) * 32768; const unsigned char* Ws = Xs + 16384;
        if (kt + 1 < nk) {
            unsigned char* d = dst0 + ((kt + 1) & 1) * 32768;
#pragma unroll
            for (int i = 0; i < 4; ++i) { glds16(xp + (size_t)(32 * i) * ldx + (kt + 1) * 64, d + i * 4096); glds16(wp + (size_t)(32 * i) * ldw + (kt + 1) * 64, d + 16384 + i * 4096); }
        }
#pragma unroll
        for (int s = 0; s < 2; ++s) {
            bf16x8 xf[4], wf[4];
#pragma unroll
            for (int m = 0; m < 4; ++m) { const int row = wm * 64 + m * 16 + c; xf[m] = as_bf16x8(*(const u32x4*)(Xs + row * 128 + (((4 * s + g) ^ (c & 7)) << 4))); }
#pragma unroll
            for (int n = 0; n < 4; ++n) { const int row = wn * 64 + n * 16 + c; wf[n] = as_bf16x8(*(const u32x4*)(Ws + row * 128 + (((4 * s + g) ^ (c & 7)) << 4))); }
#pragma unroll
            for (int m = 0; m < 4; ++m)
#pragma unroll
                for (int n = 0; n < 4; ++n) acc[m][n] = mfma16(wf[n], xf[m], acc[m][n]);
        }
        asm volatile("s_waitcnt vmcnt(0)" ::: "memory");
        __syncthreads();
    }
}

DI bool tile_of(int k, int NT, int MT, int& mt, int& nt) {
    const int G = gridDim.x, bid = blockIdx.x;
    if (((G | MT) & 7) == 0) {
        const int idx = (bid >> 3) + k * (G >> 3);
        if (idx >= (MT >> 3) * NT) return false;
        mt = (idx / NT) * 8 + (bid & 7); nt = idx % NT;
    } else {
        const int t = bid + k * G;
        if (t >= MT * NT) return false;
        mt = t / NT; nt = t % NT;
    }
    return true;
}

DI void p0_prep(const Params& p, unsigned char* lds) {
    const int tid = threadIdx.x, nb = gridDim.x, bid = blockIdx.x;
    const size_t gtid = (size_t)bid * NTHREADS + tid, gsz = (size_t)nb * NTHREADS;
    unsigned char* ws = p.ws;
    {
        float* ct = (float*)(ws + WS_ROPE); float* stb = ct + SEQ * 32;
        for (size_t i = gtid; i < (size_t)SEQ * 32; i += gsz) {
            const int pos = (int)(i >> 5), fi = (int)(i & 31);
            const float inv = powf(10000.0f, -(float)(2 * fi) / 64.0f);
            const float ang = (float)pos * inv;
            ct[i] = cosf(ang); stb[i] = sinf(ang);
        }
    }
    auto conv = [&](const float* src, bf16_t* dst, size_t n) {
        for (size_t i = gtid * 8; i < n; i += gsz * 8) {
            const f32x4 a = *(const f32x4*)(src + i), b = *(const f32x4*)(src + i + 4);
            u32x4 o; o.x = pack_bf16(a.x, a.y); o.y = pack_bf16(a.z, a.w); o.z = pack_bf16(b.x, b.y); o.w = pack_bf16(b.z, b.w);
            *(u32x4*)(dst + i) = o;
        }
    };
    conv(p.x, (bf16_t*)(ws + WS_XB), (size_t)NTOK * D_MODEL);
    conv(p.peer_subkeys, (bf16_t*)(ws + WS_SK), (size_t)8 * 2 * 128 * 128);
    float* tl = (float*)lds;
    auto transp = [&](const float* src, bf16_t* dst, int N, int Npad) {
        const int tn = Npad / 64, tk = 1024 / 64;
        for (int t = bid; t < tn * tk; t += nb) {
            const int n0 = (t % tn) * 64, k0 = (t / tn) * 64;
            __syncthreads();
            for (int e = tid; e < 4096; e += NTHREADS) { const int kk = e >> 6, nn = e & 63; tl[kk * 65 + nn] = (n0 + nn < N) ? src[(size_t)(k0 + kk) * N + n0 + nn] : 0.f; }
            __syncthreads();
            for (int e = tid; e < 4096; e += NTHREADS) { const int nn = e >> 6, kk = e & 63; dst[(size_t)(n0 + nn) * 1024 + k0 + kk] = (bf16_t)f2bf(tl[kk * 65 + nn]); }
        }
    };
    transp(p.w_in, (bf16_t*)(ws + WS_WINT), NMIX, NMIX_PAD);
}

DI void p0_late(const Params& p, unsigned char* lds) {
    const int tid = threadIdx.x, nb = gridDim.x, bid = blockIdx.x;
    unsigned char* ws = p.ws;
    {
        const int lane = tid & 63, gw = bid * 4 + (tid >> 6), nw = nb * 4;
        for (int row0 = gw * 4; row0 < 2 * 16384; row0 += nw * 4) {
            f32x4 v[4][4];
#pragma unroll
            for (int r = 0; r < 4; ++r) {
                const int row = row0 + r; const bool isv = row >= 16384; const int e = isv ? row - 16384 : row;
                const float* src = (isv ? p.peer_v : p.peer_u) + (size_t)e * 1024 + lane * 16;
#pragma unroll
                for (int i = 0; i < 4; ++i) v[r][i] = *(const f32x4*)(src + 4 * i);
            }
#pragma unroll
            for (int r = 0; r < 4; ++r) {
                const int row = row0 + r; const bool isv = row >= 16384; const int e = isv ? row - 16384 : row;
                float mx = 0.f;
#pragma unroll
                for (int i = 0; i < 4; ++i) mx = fmaxf(mx, fmaxf(fmaxf(fabsf(v[r][i][0]), fabsf(v[r][i][1])), fmaxf(fabsf(v[r][i][2]), fabsf(v[r][i][3]))));
#pragma unroll
                for (int o = 32; o >= 1; o >>= 1) mx = fmaxf(mx, __shfl_xor(mx, o));
                const float sc = mx > 0.f ? mx * (1.0f / 5.99f) : 1.0f, inv = mx > 0.f ? 5.99f / mx : 1.0f;
                u32x2 o2;
#pragma unroll
                for (int k = 0; k < 2; ++k) {
                    unsigned w = 0;
                    w = __builtin_amdgcn_cvt_scalef32_pk_fp4_f32(w, v[r][2 * k][0] * inv, v[r][2 * k][1] * inv, 1.0f, 0);
                    w = __builtin_amdgcn_cvt_scalef32_pk_fp4_f32(w, v[r][2 * k][2] * inv, v[r][2 * k][3] * inv, 1.0f, 1);
                    w = __builtin_amdgcn_cvt_scalef32_pk_fp4_f32(w, v[r][2 * k + 1][0] * inv, v[r][2 * k + 1][1] * inv, 1.0f, 2);
                    w = __builtin_amdgcn_cvt_scalef32_pk_fp4_f32(w, v[r][2 * k + 1][2] * inv, v[r][2 * k + 1][3] * inv, 1.0f, 3);
                    o2[k] = w;
                }
                *(u32x2*)(ws + (isv ? WS_VT : WS_UT) + (size_t)e * 512 + lane * 8) = o2;
                if (lane == 0) ((float*)(ws + (isv ? WS_SV : WS_SU)))[e] = sc;
            }
        }
    }
    float* tl = (float*)lds;
    auto transp = [&](const float* src, bf16_t* dst, int N, int Npad) {
        const int tn = Npad / 64, tk = 1024 / 64;
        for (int t = bid; t < tn * tk; t += nb) {
            const int n0 = (t % tn) * 64, k0 = (t / tn) * 64;
            __syncthreads();
            for (int e = tid; e < 4096; e += NTHREADS) { const int kk = e >> 6, nn = e & 63; tl[kk * 65 + nn] = (n0 + nn < N) ? src[(size_t)(k0 + kk) * N + n0 + nn] : 0.f; }
            __syncthreads();
            for (int e = tid; e < 4096; e += NTHREADS) { const int nn = e >> 6, kk = e & 63; dst[(size_t)(n0 + nn) * 1024 + k0 + kk] = (bf16_t)f2bf(tl[kk * 65 + nn]); }
        }
    };
    transp(p.w_o, (bf16_t*)(ws + WS_WOT), 1024, 1024);
    transp(p.peer_wq, (bf16_t*)(ws + WS_WQT), PEER_N, PEER_N);
}

DI void p1_inproj(const Params& p, unsigned char* lds) {
    unsigned char* ws = p.ws;
    const bf16_t* XB = (const bf16_t*)(ws + WS_XB); const bf16_t* WT = (const bf16_t*)(ws + WS_WINT);
    const float* cosT = (const float*)(ws + WS_ROPE); const float* sinT = cosT + SEQ * 32;
    const int tid = threadIdx.x, lane = tid & 63, wave = tid >> 6, wm = wave >> 1, wn = wave & 1, c = lane & 15, g = lane >> 4;
    constexpr int NT = NMIX_PAD / 128, MT = NTOK / 128;
    int mt, nt;
    for (int k = 0; tile_of(k, NT, MT, mt, nt); ++k) {
        f32x4 acc[4][4];
        gemm_128x128(XB + (size_t)mt * 128 * 1024, 1024, WT + (size_t)nt * 128 * 1024, 1024, 1024, lds, acc);
        const int col64 = nt * 2 + wn;
        bf16_t* dst; int ld, coff; bool rope = true; float scale = 1.f;
        if (col64 < 8)       { dst = (bf16_t*)(ws + WS_QA); ld = 512; coff = col64 * 64; scale = 0.125f; }
        else if (col64 < 10) { dst = (bf16_t*)(ws + WS_KA); ld = 128; coff = (col64 - 8) * 64; }
        else if (col64 < 12) { dst = (bf16_t*)(ws + WS_VA); ld = 128; coff = (col64 - 10) * 64; rope = false; }
        else if (col64 < 20) { dst = (bf16_t*)(ws + WS_QB); ld = 512; coff = (col64 - 12) * 64; scale = 0.125f; }
        else if (col64 == 20) { dst = (bf16_t*)(ws + WS_KB); ld = 64; coff = 0; }
        else if (col64 == 21) { dst = (bf16_t*)(ws + WS_VB); ld = 64; coff = 0; rope = false; }
        else if (col64 < 26) { dst = (bf16_t*)(ws + WS_QI); ld = 256; coff = (col64 - 22) * 64; }
        else                 { dst = (bf16_t*)(ws + WS_KI); ld = 64; coff = 0; }
        if (col64 == 27) {
            if (g == 0) {
#pragma unroll
                for (int m = 0; m < 4; ++m) { const int tok = mt * 128 + wm * 64 + m * 16 + c; *(f32x4*)((float*)(ws + WS_WI) + (size_t)tok * 4) = acc[m][0] * 0.0625f; }
            }
            continue;
        }
#pragma unroll
        for (int m = 0; m < 4; ++m) {
            const int tok = mt * 128 + wm * 64 + m * 16 + c, pos = tok & (SEQ - 1);
            f32x4 v[4] = {acc[m][0], acc[m][1], acc[m][2], acc[m][3]};
            if (col64 == 26) {
                float s = 0.f;
#pragma unroll
                for (int n = 0; n < 4; ++n) s += (v[n][0] + v[n][1]) + (v[n][2] + v[n][3]);
                s += __shfl_xor(s, 16); s += __shfl_xor(s, 32);
                const float mu = s * (1.f / 64.f); float q = 0.f;
#pragma unroll
                for (int n = 0; n < 4; ++n) { const f32x4 d = v[n] - mu; q += (d[0] * d[0] + d[1] * d[1]) + (d[2] * d[2] + d[3] * d[3]); }
                q += __shfl_xor(q, 16); q += __shfl_xor(q, 32);
                const float rstd = rsqrtf(q * (1.f / 64.f) + LN_EPS);
#pragma unroll
                for (int n = 0; n < 4; ++n) {
                    const f32x4 gg = *(const f32x4*)(p.idx_k_g + 16 * n + 4 * g), bb = *(const f32x4*)(p.idx_k_b + 16 * n + 4 * g);
                    v[n] = (v[n] - mu) * rstd * gg + bb;
                }
            }
            if (rope) {
#pragma unroll
                for (int n = 0; n < 2; ++n) {
                    const f32x4 cs = *(const f32x4*)(cosT + pos * 32 + 16 * n + 4 * g), sn = *(const f32x4*)(sinT + pos * 32 + 16 * n + 4 * g);
                    const f32x4 t1 = v[n], t2 = v[n + 2];
                    v[n] = t1 * cs - t2 * sn; v[n + 2] = t2 * cs + t1 * sn;
                }
            }
#pragma unroll
            for (int n = 0; n < 4; ++n) {
                const f32x4 o = v[n] * scale; u32x2 w; w.x = pack_bf16(o[0], o[1]); w.y = pack_bf16(o[2], o[3]);
                *(u32x2*)(dst + (size_t)tok * ld + coff + 16 * n + 4 * g) = w;
            }
        }
    }
}

constexpr int NDSA = NTOK / 4, NSWA = BATCH * 32 * 8;
constexpr int P2_STG = 0  , P2_LIST = 32768;

DI unsigned f16_key(float v) {
    _Float16 hv = (_Float16)v; unsigned short hb = __builtin_bit_cast(unsigned short, hv); unsigned b = hb;
    if (b == 0x8000u) b = 0u;
    return (b & 0x8000u) ? ((~b) & 0xffffu) : (b | 0x8000u);
}

DI size_t sc_row_off(int t) { const size_t m = (size_t)(t >> 3); return 8 * (4 * m * (m + 1) + (size_t)(t & 7) * (m + 1)); }
constexpr size_t SC_BATCH = 8404992;
DI unsigned short* sc_batch_base(const Params& p, int b) { return (b < 7) ? (unsigned short*)p.out + (size_t)b * SC_BATCH : (unsigned short*)(p.ws + WS_XB); }

DI void p2a_indexer(const Params& p, unsigned char* lds) {
    unsigned char* ws = p.ws;
    const bf16_t* QI = (const bf16_t*)(ws + WS_QI); const bf16_t* KI = (const bf16_t*)(ws + WS_KI); const float* WI = (const float*)(ws + WS_WI);
    const int G = gridDim.x, bi = blockIdx.x;
    for (int it = 0; it < 2; ++it) {
        const int item = (it == 0) ? bi : 1023 - bi;
        for (int id = (G == 512) ? item : bi + it * G; id < 1024; id += (G == 512) ? 1024 : 2 * G) {
            int tid = threadIdx.x; asm volatile("" : "+v"(tid));
            const int lane = tid & 63, wave = tid >> 6, c = lane & 15, g = lane >> 4, lrow = tid >> 3, lch = tid & 7;
            const int b = id >> 7, t0 = (id & 127) * 32, tokw = b * SEQ + t0 + 8 * wave;
            unsigned short* scb = sc_batch_base(p, b);
            bf16x8 af[2][2]; f32x4 wv[2];
#pragma unroll
            for (int rt = 0; rt < 2; ++rt) {
#pragma unroll
                for (int s2 = 0; s2 < 2; ++s2) af[rt][s2] = as_bf16x8(ldg16(QI + (size_t)(tokw + 4 * rt + (c >> 2)) * 256 + (c & 3) * 64 + 32 * s2 + 8 * g));
                wv[rt] = *(const f32x4*)(WI + (size_t)(tokw + 4 * rt + g) * 4);
            }
            asm volatile("" :: "v"(af[0][0]), "v"(af[0][1]), "v"(af[1][0]), "v"(af[1][1]), "v"(wv[0]), "v"(wv[1]));
            const int nkt = ((t0 + 31) >> 7) + 1;
            const unsigned char* kib = (const unsigned char*)(KI + (size_t)b * SEQ * 64);
            unsigned char* dst0 = lds + tid * 16;
            auto stage = [&](int kt, int buf) {
#pragma unroll
                for (int i = 0; i < 4; ++i) {
                    const int row = lrow + 32 * i;
                    glds16(kib + (size_t)(kt * 128 + row) * 128 + ((lch ^ ((row >> 3) & 7)) << 4), dst0 + buf * 16384 + i * 4096);
                }
            };
            __syncthreads();
            stage(0, 0); if (nkt > 1) stage(1, 1);
            for (int kt = 0; kt < nkt; ++kt) {
                if (kt + 1 < nkt) asm volatile("s_waitcnt vmcnt(4)" ::: "memory");
                else asm volatile("s_waitcnt vmcnt(0)" ::: "memory");
                asm volatile("s_waitcnt lgkmcnt(0)" ::: "memory");
                __builtin_amdgcn_s_barrier();
                if (kt + 2 < nkt) stage(kt + 2, (kt + 2) % 3);
                const unsigned char* Ks = lds + (kt % 3) * 16384;
                unsigned res[2][4];
#pragma unroll
                for (int ct = 0; ct < 8; ++ct) {
                    const int row = 8 * c + ct;
                    const bf16x8 k0 = as_bf16x8(*(const u32x4*)(Ks + row * 128 + ((g ^ (c & 7)) << 4)));
                    const bf16x8 k1 = as_bf16x8(*(const u32x4*)(Ks + row * 128 + (((4 + g) ^ (c & 7)) << 4)));
#pragma unroll
                    for (int rt = 0; rt < 2; ++rt) {
                        f32x4 d = mfma16(af[rt][0], k0, (f32x4){0.f, 0.f, 0.f, 0.f});
                        d = mfma16(af[rt][1], k1, d);
                        const float sv = wv[rt][0] * fmaxf(d[0], 0.f) + wv[rt][1] * fmaxf(d[1], 0.f) + wv[rt][2] * fmaxf(d[2], 0.f) + wv[rt][3] * fmaxf(d[3], 0.f);
                        const int key = kt * 128 + row, tq = t0 + 8 * wave + 4 * rt + g;
                        const unsigned kv = (key <= tq) ? f16_key(sv) : 0u;
                        if (ct & 1) res[rt][ct >> 1] |= kv << 16; else res[rt][ct >> 1] = kv;
                    }
                }
#pragma unroll
                for (int rt = 0; rt < 2; ++rt) {
                    const int tq = t0 + 8 * wave + 4 * rt + g;
                    if (16 * kt + c <= (tq >> 3)) {
                        u32x4 w; w.x = res[rt][0]; w.y = res[rt][1]; w.z = res[rt][2]; w.w = res[rt][3];
                        *(u32x4*)(scb + sc_row_off(tq) + kt * 128 + 8 * c) = w;
                    }
                }
            }
        }
    }
    __syncthreads();
    p0_late(p, lds);
}

template <int MODE> DI void p2_dsa_item(const Params& p, unsigned char* lds, int b, int tb) {
    unsigned char* ws = p.ws;
    const bf16_t* QI = (const bf16_t*)(ws + WS_QI); const bf16_t* KI = (const bf16_t*)(ws + WS_KI); const float* WI = (const float*)(ws + WS_WI);
    const bf16_t* QB = (const bf16_t*)(ws + WS_QB); const bf16_t* KB = (const bf16_t*)(ws + WS_KB); const bf16_t* VB = (const bf16_t*)(ws + WS_VB);
    bf16_t* ATT = (bf16_t*)(ws + WS_ATT);
    int tid = threadIdx.x; asm volatile("" : "+v"(tid));
    const int lane = tid & 63, wave = __builtin_amdgcn_readfirstlane(tid >> 6), c = lane & 15, g = lane >> 4;
    const int t0 = tb * 4, tok0 = b * SEQ + t0;
    unsigned char* stg = lds + P2_STG + wave * 8192;
    unsigned* hist = (unsigned*)stg;
    unsigned short* list = (unsigned short*)(lds + P2_LIST) + wave * 256;
    const int tok = tok0 + wave;
    if (!(MODE & 2)) return;
    const int n = t0 + wave + 1;
    const int L = n < 256 ? n : 256;
    const unsigned short* myk = sc_batch_base(p, b) + sc_row_off(t0 + wave);
    if (n <= 256) {
        for (int i = lane; i < n; i += 64) list[i] = (unsigned short)i;
    } else {
        u32x4 kk[8];
#pragma unroll
        for (int i = 0; i < 8; ++i) kk[i] = (512 * i + 8 * lane < n) ? ldg16(myk + 512 * i + 8 * lane) : (u32x4){0u, 0u, 0u, 0u};
#pragma unroll
        for (int i = 0; i < 4; ++i) *(u32x4*)(hist + lane * 16 + i * 4) = (u32x4){0u, 0u, 0u, 0u};
#pragma unroll
        for (int i = 0; i < 8; ++i) {
            if (512 * i < n) {
#pragma unroll
                for (int w = 0; w < 4; ++w) { const unsigned wd = kk[i][w]; atomicAdd(&hist[(wd & 0xffffu) >> 6], 1u); atomicAdd(&hist[wd >> 22], 1u); }
            }
        }
        unsigned h[16];
#pragma unroll
        for (int i = 0; i < 4; ++i) { const u32x4 t = *(const u32x4*)(hist + lane * 16 + i * 4); h[4 * i] = t.x; h[4 * i + 1] = t.y; h[4 * i + 2] = t.z; h[4 * i + 3] = t.w; }
#pragma unroll
        for (int i = 0; i < 4; ++i) *(u32x4*)(hist + lane * 16 + i * 4) = (u32x4){0u, 0u, 0u, 0u};
        unsigned sl = 0;
#pragma unroll
        for (int i = 0; i < 16; ++i) sl += h[i];
        unsigned pre = sl;
#pragma unroll
        for (int o = 1; o < 64; o <<= 1) { const unsigned t = __shfl_up(pre, o); if (lane >= o) pre += t; }
        const unsigned tot = __shfl(pre, 63);
        const unsigned suf = tot - pre;
        int found = -1; unsigned cab = 0, cum = suf;
#pragma unroll
        for (int j = 15; j >= 0; --j) { const bool hit = (found < 0) && (cum + h[j] >= 256u); if (hit) { found = lane * 16 + j; cab = cum; } cum += h[j]; }
        const bool mine = (suf < 256u) && (suf + sl >= 256u);
        const unsigned long long mm = __ballot(mine);
        const int src = __ffsll((long long)mm) - 1;
        const unsigned bstar = (unsigned)__shfl(found, src), cabove = __shfl(cab, src);
        const unsigned r1 = 256u - cabove;
#pragma unroll
        for (int i = 0; i < 8; ++i) {
            if (512 * i < n) {
#pragma unroll
                for (int w = 0; w < 4; ++w) {
                    const unsigned wd = kk[i][w];
                    if (((wd & 0xffffu) >> 6) == bstar) atomicAdd(&hist[wd & 63u], 1u);
                    if ((wd >> 22) == bstar) atomicAdd(&hist[(wd >> 16) & 63u], 1u);
                }
            }
        }
        const unsigned cnt = hist[lane];
        hist[lane] = 0u;
        unsigned pre2 = cnt;
#pragma unroll
        for (int o = 1; o < 64; o <<= 1) { const unsigned t = __shfl_up(pre2, o); if (lane >= o) pre2 += t; }
        const unsigned tot2 = __shfl(pre2, 63);
        const unsigned suf2 = tot2 - pre2;
        const bool mine2 = (suf2 < r1) && (suf2 + cnt >= r1);
        const unsigned long long mm2 = __ballot(mine2);
        const int src2 = __ffsll((long long)mm2) - 1;
        const unsigned T = (bstar << 6) | (unsigned)src2;
        const unsigned req = r1 - __shfl(suf2, src2);
        const unsigned toteq = __shfl(cnt, src2);
        const bool alleq = (req == toteq);
        const unsigned Tt = alleq ? T : T + 1u;
        unsigned cg = 0;
#pragma unroll
        for (int i = 0; i < 8; ++i)
#pragma unroll
            for (int w = 0; w < 4; ++w) { const unsigned wd = kk[i][w]; cg += ((wd & 0xffffu) >= Tt) ? 1u : 0u; cg += ((wd >> 16) >= Tt) ? 1u : 0u; }
        unsigned pre3 = cg;
#pragma unroll
        for (int o = 1; o < 64; o <<= 1) { const unsigned t = __shfl_up(pre3, o); if (lane >= o) pre3 += t; }
        unsigned off = pre3 - cg;
#pragma unroll
        for (int i = 0; i < 8; ++i)
#pragma unroll
            for (int w = 0; w < 4; ++w) {
                const unsigned wd = kk[i][w]; const int idx = 512 * i + 8 * lane + 2 * w;
                if ((wd & 0xffffu) >= Tt) { list[off & 255u] = (unsigned short)idx; ++off; }
                if ((wd >> 16) >= Tt) { list[off & 255u] = (unsigned short)(idx + 1); ++off; }
            }
        if (!alleq) {
            const unsigned cgt = 256u - req; unsigned eq_run = 0;
            for (int base = 0; base < n; base += 64) {
                const int i = base + lane; const unsigned m = (i < n) ? myk[i] : 0u;
                const bool eq = (m == T);
                const unsigned long long eqm = __ballot(eq);
                const unsigned rank = eq_run + __builtin_amdgcn_mbcnt_hi((unsigned)(eqm >> 32), __builtin_amdgcn_mbcnt_lo((unsigned)eqm, 0u));
                if (eq && rank < req) list[cgt + rank] = (unsigned short)i;
                eq_run += (unsigned)__popcll(eqm);
            }
        }
    }
    if (!(MODE & 4)) return;
    bf16x8 qf[2], sel[2];
#pragma unroll
    for (int s = 0; s < 2; ++s) {
        u32x4 t = (u32x4){0u, 0u, 0u, 0u};
        if (c < 8) t = ldg16(QB + (size_t)tok * 512 + c * 64 + 32 * s + 8 * g);
        qf[s] = as_bf16x8(t);
#pragma unroll
        for (int j = 0; j < 8; ++j) sel[s][j] = (8 * g + j == 16 * s + c) ? (short)0x3F80 : (short)0;
    }
    f32x4 st[16];
    const unsigned char* kbb = (const unsigned char*)(KB + (size_t)b * SEQ * 64); const unsigned char* vbb = (const unsigned char*)(VB + (size_t)b * SEQ * 64);
    const int lr = lane >> 3, lc = lane & 7;
    const unsigned st_off = lr * 128 + ((lc ^ lr) << 4);
    auto loadg = [&](const unsigned char* base, int T0, u32x4 (&dst)[8]) {
#pragma unroll
        for (int i = 0; i < 8; ++i) {
            const int idx = T0 * 16 + i * 8 + lr; const unsigned kid = (idx < L) ? (unsigned)list[idx] : 0u;
            dst[i] = ldg16(base + kid * 128u + lc * 16u);
        }
    };
    auto stage = [&](const u32x4 (&src)[8]) {
#pragma unroll
        for (int i = 0; i < 8; ++i) *(u32x4*)(stg + i * 1024 + st_off) = src[i];
    };
    auto frag = [&](int u, int s2) -> bf16x8 { return as_bf16x8(*(const u32x4*)(stg + (16 * u + c) * 128 + (((4 * s2 + g) ^ (c & 7)) << 4))); };
    auto scoreK = [&](int T0) {
#pragma unroll
        for (int T = 0; T < 4; ++T) {
            f32x4 d = mfma16(frag(T, 0), qf[0], (f32x4){0.f, 0.f, 0.f, 0.f});
            st[T0 + T] = mfma16(frag(T, 1), qf[1], d);
        }
    };
    u32x4 rA[8], rB[8], rC[8], rD[8];
    loadg(kbb, 0, rA); loadg(kbb, 4, rB); loadg(kbb, 8, rC); loadg(kbb, 12, rD);
    __builtin_amdgcn_sched_barrier(0);
    stage(rA); scoreK(0);
    stage(rB); scoreK(4);
    __builtin_amdgcn_sched_barrier(0);
    loadg(vbb, 0, rA); loadg(vbb, 4, rB);
    stage(rC); scoreK(8);
    stage(rD); scoreK(12);
    __builtin_amdgcn_sched_barrier(0);
    float mx = -3.0e38f;
    {
        const int lrem = L - 4 * g;
#pragma unroll
        for (int T = 0; T < 16; ++T)
#pragma unroll
            for (int r = 0; r < 4; ++r) { const float sv = (T * 16 + r < lrem) ? st[T][r] : -3.0e38f; st[T][r] = sv; mx = fmaxf(mx, sv); }
    }
    mx = fmaxf(mx, __shfl_xor(mx, 16)); mx = fmaxf(mx, __shfl_xor(mx, 32));
    float lsum = 0.f;
#pragma unroll
    for (int T = 0; T < 16; ++T)
#pragma unroll
        for (int r = 0; r < 4; ++r) { const float e = __expf(st[T][r] - mx); st[T][r] = e; lsum += e; }
    lsum += __shfl_xor(lsum, 16); lsum += __shfl_xor(lsum, 32);
    const float rl = 1.0f / lsum;
    u32x4 pfv[8];
#pragma unroll
    for (int u = 0; u < 8; ++u) {
        const int Ta = 2 * u, Tb = Ta + 1;
        pfv[u].x = pack_bf16(st[Ta][0] * rl, st[Ta][1] * rl); pfv[u].y = pack_bf16(st[Ta][2] * rl, st[Ta][3] * rl);
        pfv[u].z = pack_bf16(st[Tb][0] * rl, st[Tb][1] * rl); pfv[u].w = pack_bf16(st[Tb][2] * rl, st[Tb][3] * rl);
    }
    __builtin_amdgcn_sched_barrier(0);
    f32x4 O[4];
#pragma unroll
    for (int cb = 0; cb < 4; ++cb) O[cb] = (f32x4){0.f, 0.f, 0.f, 0.f};
    auto pv = [&](int T0) {
#pragma unroll
        for (int u = 0; u < 2; ++u) {
            const u32x4 pf = pfv[(T0 >> 1) + u];
#pragma unroll
            for (int cb = 0; cb < 4; ++cb) {
                const f32x4 z = (f32x4){0.f, 0.f, 0.f, 0.f};
                const f32x4 v0 = mfma16(frag(2 * u, cb >> 1), sel[cb & 1], z), v1 = mfma16(frag(2 * u + 1, cb >> 1), sel[cb & 1], z);
                u32x4 vf; vf.x = pack_bf16(v0[0], v0[1]); vf.y = pack_bf16(v0[2], v0[3]); vf.z = pack_bf16(v1[0], v1[1]); vf.w = pack_bf16(v1[2], v1[3]);
                O[cb] = mfma16(as_bf16x8(pf), as_bf16x8(vf), O[cb]);
            }
        }
    };
    loadg(vbb, 8, rC); loadg(vbb, 12, rD);
    __builtin_amdgcn_sched_barrier(0);
    stage(rA); pv(0);
    stage(rB); pv(4);
    __builtin_amdgcn_sched_barrier(0);
    stage(rC); pv(8);
    stage(rD); pv(12);
    if (g < 2) {
#pragma unroll
        for (int cb = 0; cb < 4; ++cb)
#pragma unroll
            for (int r = 0; r < 4; ++r) ATT[(size_t)tok * 1024 + 512 + (4 * g + r) * 64 + 16 * cb + c] = (bf16_t)f2bf(O[cb][r]);
    }
}

DI void p2_swa_item(const Params& p, int item2) {
    unsigned char* ws = p.ws;
    const bf16_t* QA = (const bf16_t*)(ws + WS_QA); const bf16_t* KA = (const bf16_t*)(ws + WS_KA); const bf16_t* VA = (const bf16_t*)(ws + WS_VA);
    bf16_t* ATT = (bf16_t*)(ws + WS_ATT);
    int tid = threadIdx.x; asm volatile("" : "+v"(tid));
    const int lane = tid & 63, wave = __builtin_amdgcn_readfirstlane(tid >> 6), r = lane & 31, h = lane >> 5;
    const int hq = item2 & 7, blk = (item2 >> 3) & 31, b = item2 >> 8, kvh = hq >> 2;
    const int qi = 32 * wave + r, tokq = b * SEQ + blk * 128 + qi;
    bf16x8 qf[4], sel[2];
#pragma unroll
    for (int s = 0; s < 4; ++s) qf[s] = as_bf16x8(ldg16(QA + (size_t)tokq * 512 + hq * 64 + 16 * s + 8 * h));
#pragma unroll
    for (int x = 0; x < 2; ++x)
#pragma unroll
        for (int j = 0; j < 8; ++j) sel[x][j] = (8 * h + j + 16 * x == r) ? (short)0x3F80 : (short)0;
    const float sink = p.sinks[hq];
    f32x16 ST[5];
#pragma unroll
    for (int ti = 0; ti < 5; ++ti) {
        const int sj = 32 * (wave + ti) + r; int pos = blk * 128 - 128 + sj; pos = pos < 0 ? 0 : pos;
        const bf16_t* kp = KA + (size_t)(b * SEQ + pos) * 128 + kvh * 64 + 8 * h;
        f32x16 d; for (int i = 0; i < 16; ++i) d[i] = 0.f;
#pragma unroll
        for (int s = 0; s < 4; ++s) d = mfma32(as_bf16x8(ldg16(kp + 16 * s)), qf[s], d);
        ST[ti] = d;
    }
    float mx = sink;
    {
        const int lo = r + 1 - 4 * h;
        const int lo0 = (blk > 0) ? lo : (lo > 128 - 32 * wave - 4 * h ? lo : 128 - 32 * wave - 4 * h);
#pragma unroll
        for (int ti = 0; ti < 5; ++ti)
#pragma unroll
            for (int reg = 0; reg < 16; ++reg) {
                const int e = 32 * ti + (reg & 3) + 8 * (reg >> 2);
                const float sv = (e >= lo0 && e < lo + 128) ? ST[ti][reg] : -3.0e38f; ST[ti][reg] = sv; mx = fmaxf(mx, sv);
            }
    }
    mx = fmaxf(mx, __shfl_xor(mx, 32));
    float lsum = 0.f;
#pragma unroll
    for (int ti = 0; ti < 5; ++ti)
#pragma unroll
        for (int reg = 0; reg < 16; ++reg) { const float e = __expf(ST[ti][reg] - mx); ST[ti][reg] = e; lsum += e; }
    lsum += __shfl_xor(lsum, 32);
    lsum += __expf(sink - mx);
    const float rl = 1.0f / lsum;
    f32x16 OT[2];
    for (int i = 0; i < 16; ++i) { OT[0][i] = 0.f; OT[1][i] = 0.f; }
#pragma unroll
    for (int ti = 0; ti < 5; ++ti) {
        const int sj = 32 * (wave + ti) + r; int pos = blk * 128 - 128 + sj; pos = pos < 0 ? 0 : pos;
        const bf16_t* vp = VA + (size_t)(b * SEQ + pos) * 128 + kvh * 64 + 8 * h;
        bf16x8 vf[4];
#pragma unroll
        for (int s = 0; s < 4; ++s) vf[s] = as_bf16x8(ldg16(vp + 16 * s));
        u32x4 pb[2];
#pragma unroll
        for (int s2 = 0; s2 < 2; ++s2) {
            pb[s2].x = pack_bf16(ST[ti][8 * s2 + 0] * rl, ST[ti][8 * s2 + 1] * rl); pb[s2].y = pack_bf16(ST[ti][8 * s2 + 2] * rl, ST[ti][8 * s2 + 3] * rl);
            pb[s2].z = pack_bf16(ST[ti][8 * s2 + 4] * rl, ST[ti][8 * s2 + 5] * rl); pb[s2].w = pack_bf16(ST[ti][8 * s2 + 6] * rl, ST[ti][8 * s2 + 7] * rl);
        }
#pragma unroll
        for (int db = 0; db < 2; ++db) {
            f32x16 vt; for (int i = 0; i < 16; ++i) vt[i] = 0.f;
            vt = mfma32(vf[2 * db], sel[0], vt); vt = mfma32(vf[2 * db + 1], sel[1], vt);
#pragma unroll
            for (int s2 = 0; s2 < 2; ++s2) {
                u32x4 va; va.x = pack_bf16(vt[8 * s2 + 0], vt[8 * s2 + 1]); va.y = pack_bf16(vt[8 * s2 + 2], vt[8 * s2 + 3]);
                va.z = pack_bf16(vt[8 * s2 + 4], vt[8 * s2 + 5]); va.w = pack_bf16(vt[8 * s2 + 6], vt[8 * s2 + 7]);
                OT[db] = mfma32(as_bf16x8(va), as_bf16x8(pb[s2]), OT[db]);
            }
        }
    }
#pragma unroll
    for (int db = 0; db < 2; ++db)
#pragma unroll
        for (int q4 = 0; q4 < 4; ++q4) {
            u32x2 w; w.x = pack_bf16(OT[db][4 * q4], OT[db][4 * q4 + 1]); w.y = pack_bf16(OT[db][4 * q4 + 2], OT[db][4 * q4 + 3]);
            *(u32x2*)(ATT + (size_t)tokq * 1024 + hq * 64 + 32 * db + 8 * q4 + 4 * h) = w;
        }
}

template <int MODE> DI void p2_attention(const Params& p, unsigned char* lds, int cidx = 0) {
    const int G = gridDim.x, bi = blockIdx.x, rounds = (1024 + G - 1) / G;
    for (int b = 0; b < BATCH; ++b)
        for (int r = 0; r < rounds; ++r) {
            const int idx = (r & 1) ? r * G + (G - 1 - bi) : r * G + bi;
            if (idx < 1024) p2_dsa_item<MODE>(p, lds, b, 1023 - idx);
        }
    if (MODE & 8) for (int item2 = bi; item2 < NSWA; item2 += G) p2_swa_item(p, item2);
}

DI void p3_outproj(const Params& p, unsigned char* lds) {
    unsigned char* ws = p.ws;
    const bf16_t* ATT = (const bf16_t*)(ws + WS_ATT); const bf16_t* WT = (const bf16_t*)(ws + WS_WOT);
    const int tid = threadIdx.x, lane = tid & 63, wave = tid >> 6, wm = wave >> 1, wn = wave & 1, c = lane & 15, g = lane >> 4;
    constexpr int NT = 8, MT = NTOK / 128;
    int mt, nt;
    for (int k = 0; tile_of(k, NT, MT, mt, nt); ++k) {
        f32x4 acc[4][4];
        gemm_128x128(ATT + (size_t)mt * 128 * 1024, 1024, WT + (size_t)nt * 128 * 1024, 1024, 1024, lds, acc);
#pragma unroll
        for (int m = 0; m < 4; ++m) {
            const int tok = mt * 128 + wm * 64 + m * 16 + c;
#pragma unroll
            for (int n = 0; n < 4; ++n) {
                const size_t o = (size_t)tok * 1024 + nt * 128 + wn * 64 + 16 * n + 4 * g;
                const f32x4 xv = *(const f32x4*)(p.x + o);
                const f32x4 hv = xv * ALPHA + acc[m][n];
                u32x2 w; w.x = pack_bf16(hv[0], hv[1]); w.y = pack_bf16(hv[2], hv[3]);
                *(u32x2*)((bf16_t*)p.out + o) = w;
            }
        }
    }
}

DI void p3b_ln1(const Params& p) {
    bf16_t* H1B = (bf16_t*)(p.ws + WS_XB); const bf16_t* HP = (const bf16_t*)p.out;
    const int lane = threadIdx.x & 63, gw = blockIdx.x * 4 + (threadIdx.x >> 6), nw = gridDim.x * 4;
    for (int row = gw; row < NTOK; row += nw) {
        const u32x4 ra = ldg16(HP + (size_t)row * 1024 + lane * 16), rb = ldg16(HP + (size_t)row * 1024 + lane * 16 + 8);
        float v[16];
        v[0] = bf_lo(ra.x); v[1] = bf_hi(ra.x); v[2] = bf_lo(ra.y); v[3] = bf_hi(ra.y); v[4] = bf_lo(ra.z); v[5] = bf_hi(ra.z); v[6] = bf_lo(ra.w); v[7] = bf_hi(ra.w);
        v[8] = bf_lo(rb.x); v[9] = bf_hi(rb.x); v[10] = bf_lo(rb.y); v[11] = bf_hi(rb.y); v[12] = bf_lo(rb.z); v[13] = bf_hi(rb.z); v[14] = bf_lo(rb.w); v[15] = bf_hi(rb.w);
        float s = 0.f;
#pragma unroll
        for (int i = 0; i < 16; ++i) s += v[i];
        const float mu = wave_sum(s) * (1.f / 1024.f); float q = 0.f;
#pragma unroll
        for (int i = 0; i < 16; ++i) { const float d = v[i] - mu; q = fmaf(d, d, q); }
        const float rstd = rsqrtf(wave_sum(q) * (1.f / 1024.f) + LN_EPS);
        u32x4 oa, ob;
#pragma unroll
        for (int k4 = 0; k4 < 4; ++k4) {
            const int col = lane * 16 + k4 * 4;
            const f32x4 gg = *(const f32x4*)(p.ln1_g + col), bb = *(const f32x4*)(p.ln1_b + col);
            float o[4];
#pragma unroll
            for (int e = 0; e < 4; ++e) o[e] = (v[k4 * 4 + e] - mu) * rstd * gg[e] + bb[e];
            const unsigned w0 = pack_bf16(o[0], o[1]), w1 = pack_bf16(o[2], o[3]);
            if (k4 == 0) { oa.x = w0; oa.y = w1; } else if (k4 == 1) { oa.z = w0; oa.w = w1; } else if (k4 == 2) { ob.x = w0; ob.y = w1; } else { ob.z = w0; ob.w = w1; }
        }
        *(u32x4*)(H1B + (size_t)row * 1024 + lane * 16) = oa; *(u32x4*)(H1B + (size_t)row * 1024 + lane * 16 + 8) = ob;
    }
}

DI int f2key(float v) { const int b = __float_as_int(v); return b ^ ((b >> 31) & 0x7fffffff); }
DI float key2f(int k) { return __int_as_float(k ^ ((k >> 31) & 0x7fffffff)); }
DI void ce_desc(int& a, int& b) { const int hi = a > b ? a : b, lo = a > b ? b : a; a = hi; b = lo; }
DI void bitonic_merge16(int (&k)[16]) {
#pragma unroll
    for (int d = 8; d >= 1; d >>= 1)
#pragma unroll
        for (int i = 0; i < 16; ++i) if ((i & d) == 0) ce_desc(k[i], k[i | d]);
}
DI void bitonic_sort16(int (&k)[16]) {
#pragma unroll
    for (int sz = 2; sz <= 16; sz <<= 1) {
#pragma unroll
        for (int i = 0; i < 16; ++i) { const int j = i ^ (sz - 1); if (j > i) ce_desc(k[i], k[j]); }
#pragma unroll
        for (int d = sz >> 2; d >= 1; d >>= 1)
#pragma unroll
            for (int i = 0; i < 16; ++i) if ((i & d) == 0) ce_desc(k[i], k[i | d]);
    }
}
DI void top16_merge(int (&t)[16], const int (&sdesc)[16]) {
#pragma unroll
    for (int i = 0; i < 16; ++i) t[i] = t[i] > sdesc[15 - i] ? t[i] : sdesc[15 - i];
    bitonic_merge16(t);
}
constexpr int P4_QS = 32768, P4_SS_STRIDE = 132, P4_ST0 = 67584  , P4_M = 0  , P4_ST1 = 8704  ;

DI void p4_peer_query(const Params& p, unsigned char* lds) {
    unsigned char* ws = p.ws;
    const bf16_t* H1B = (const bf16_t*)(ws + WS_XB); const bf16_t* WQT = (const bf16_t*)(ws + WS_WQT); const bf16_t* SK = (const bf16_t*)(ws + WS_SK);
    unsigned short* PE = (unsigned short*)(ws + WS_PE); float* PG = (float*)(ws + WS_PG); float* PS = (float*)(ws + WS_PS);
    const float* SU = (const float*)(ws + WS_SU); const float* SV = (const float*)(ws + WS_SV);
    float* Ss = (float*)lds;
    float* st0 = (float*)(lds + P4_ST0); float* mbuf = (float*)(lds + P4_M); float* st1 = (float*)(lds + P4_ST1);
    constexpr int MT = NTOK / 128;
    int mt, head;
    for (int k = 0; tile_of(k, 8, MT, mt, head); ++k) {
        int tid = threadIdx.x; asm volatile("" : "+v"(tid));
        const int lane = tid & 63, wave = tid >> 6, wm = wave >> 1, wn = wave & 1, c = lane & 15, g = lane >> 4;
        const int lrow = tid >> 3, lch = tid & 7;
        const int srow = tid & 127, shalf = tid >> 7;
#pragma unroll 1
        for (int ph = 0; ph < 2; ++ph) {
            f32x4 acc[4][4];
            gemm_128x128(H1B + (size_t)mt * 128 * 1024, 1024, WQT + (size_t)(head * 256 + ph * 128) * 1024, 1024, 1024, lds, acc);
            __syncthreads();
#pragma unroll
            for (int m = 0; m < 4; ++m)
#pragma unroll
                for (int n = 0; n < 4; ++n) {
                    const int row = wm * 64 + m * 16 + c;
                    u32x2 w; w.x = pack_bf16(acc[m][n][0], acc[m][n][1]); w.y = pack_bf16(acc[m][n][2], acc[m][n][3]);
                    *(u32x2*)(lds + P4_QS + wn * 16384 + row * 128 + (((2 * n + (g >> 1)) ^ (row & 7)) << 4) + (g & 1) * 8) = w;
                }
            {
                const bf16_t* sp = SK + (size_t)((head * 2 + ph) * 128 + lrow) * 128 + lch * 8;
#pragma unroll
                for (int k2 = 0; k2 < 2; ++k2)
#pragma unroll
                    for (int i = 0; i < 4; ++i) *(u32x4*)(lds + k2 * 16384 + (lrow + 32 * i) * 128 + ((lch ^ (lrow & 7)) << 4)) = ldg16(sp + (size_t)(32 * i) * 128 + k2 * 64);
            }
            __syncthreads();
            f32x4 a2[4][4];
#pragma unroll
            for (int m = 0; m < 4; ++m)
#pragma unroll
                for (int n = 0; n < 4; ++n) a2[m][n] = (f32x4){0.f, 0.f, 0.f, 0.f};
#pragma unroll
            for (int k2 = 0; k2 < 2; ++k2)
#pragma unroll
                for (int s = 0; s < 2; ++s) {
                    bf16x8 xf[4], wf[4];
#pragma unroll
                    for (int m = 0; m < 4; ++m) { const int row = wm * 64 + m * 16 + c; xf[m] = as_bf16x8(*(const u32x4*)(lds + P4_QS + k2 * 16384 + row * 128 + (((4 * s + g) ^ (c & 7)) << 4))); }
#pragma unroll
                    for (int n = 0; n < 4; ++n) { const int row = wn * 64 + n * 16 + c; wf[n] = as_bf16x8(*(const u32x4*)(lds + k2 * 16384 + row * 128 + (((4 * s + g) ^ (c & 7)) << 4))); }
#pragma unroll
                    for (int m = 0; m < 4; ++m)
#pragma unroll
                        for (int n = 0; n < 4; ++n) a2[m][n] = mfma16(wf[n], xf[m], a2[m][n]);
                }
            __syncthreads();
#pragma unroll
            for (int m = 0; m < 4; ++m)
#pragma unroll
                for (int n = 0; n < 4; ++n) {
                    const int key0 = wn * 64 + 16 * n + 4 * g;
                    u32x4 w;
#pragma unroll
                    for (int r = 0; r < 4; ++r) w[r] = (unsigned)f2key(__uint_as_float((__float_as_uint(a2[m][n][r]) & 0xFFFFFF80u) | (unsigned)(key0 + r)));
                    *(u32x4*)(Ss + (wm * 64 + m * 16 + c) * P4_SS_STRIDE + key0) = w;
                }
            __syncthreads();
            int tv[16];
            {
                const int* rowp = (const int*)Ss + srow * P4_SS_STRIDE + shalf * 64;
#pragma unroll
                for (int bt = 0; bt < 4; ++bt) {
                    int bk[16];
#pragma unroll
                    for (int j = 0; j < 4; ++j) { const u32x4 v = *(const u32x4*)(rowp + 16 * bt + 4 * j); bk[4 * j] = (int)v.x; bk[4 * j + 1] = (int)v.y; bk[4 * j + 2] = (int)v.z; bk[4 * j + 3] = (int)v.w; }
                    bitonic_sort16(bk);
                    if (bt == 0) {
#pragma unroll
                        for (int j = 0; j < 16; ++j) tv[j] = bk[j];
                    } else top16_merge(tv, bk);
                }
            }
            __syncthreads();
            int* mbi = (int*)mbuf;
            if (shalf == 1) {
#pragma unroll
                for (int j = 0; j < 16; ++j) mbi[srow * 17 + j] = tv[j];
            }
            __syncthreads();
            if (shalf == 0) {
                int* dst = (int*)((ph == 0) ? st0 : st1);
                int ob[16];
#pragma unroll
                for (int j = 0; j < 16; ++j) ob[j] = mbi[srow * 17 + j];
                top16_merge(tv, ob);
#pragma unroll
                for (int j = 0; j < 16; ++j) dst[srow * 17 + j] = tv[j];
            }
        }
        __syncthreads();
        int cv[16];
        {
            const int* st0i = (const int*)st0; const int* st1i = (const int*)st1;
            float v2[16];
#pragma unroll
            for (int b = 0; b < 16; ++b) v2[b] = key2f(st1i[srow * 17 + b]);
#pragma unroll
            for (int a8 = 0; a8 < 8; ++a8) {
                const int a = shalf * 8 + a8; const float va = key2f(st0i[srow * 17 + a]);
                int bk[16];
#pragma unroll
                for (int b = 0; b < 16; ++b) bk[b] = (f2key(va + v2[b]) & (int)0xFFFFFF00) | (a * 16 + 15 - b);
                if (a8 == 0) {
#pragma unroll
                    for (int j = 0; j < 16; ++j) cv[j] = bk[j];
                } else top16_merge(cv, bk);
            }
        }
        __syncthreads();
        int* mbi = (int*)mbuf;
        if (shalf == 1) {
#pragma unroll
            for (int j = 0; j < 16; ++j) mbi[srow * 17 + j] = cv[j];
        }
        __syncthreads();
        if (shalf == 0) {
            const int* st0i = (const int*)st0; const int* st1i = (const int*)st1;
            int fk[16]; float fv[16];
#pragma unroll
            for (int j = 0; j < 16; ++j) { const int o = mbi[srow * 17 + 15 - j]; fk[j] = cv[j] > o ? cv[j] : o; fv[j] = key2f(fk[j]); }
            float cmax = fv[0];
#pragma unroll
            for (int j = 1; j < 16; ++j) cmax = fmaxf(cmax, fv[j]);
            float den = 0.f; float ev[16];
#pragma unroll
            for (int j = 0; j < 16; ++j) { ev[j] = __expf(fv[j] - cmax); den += ev[j]; }
            const float rden = 1.0f / den;
            const size_t ob = (size_t)(mt * 128 + srow) * 128 + head * 16;
#pragma unroll
            for (int j = 0; j < 16; ++j) {
                const unsigned cde = (unsigned)fk[j] & 0xFFu;
                const unsigned a = cde >> 4, b = 15u - (cde & 15u);
                const unsigned i1 = __float_as_uint(key2f(st0i[srow * 17 + a])) & 0x7Fu, i2 = __float_as_uint(key2f(st1i[srow * 17 + b])) & 0x7Fu;
                const int e = (int)(i1 * 128u + i2);
                PE[ob + j] = (unsigned short)e; PG[ob + j] = ev[j] * rden * SV[e]; PS[ob + j] = SU[e];
            }
        }
        __syncthreads();
    }
}

DI float gelu_exact(float z) { return 0.5f * z * (1.0f + erff(z * 0.70710678118654752f)); }
DI float rdlane(float v, int l) { return __int_as_float(__builtin_amdgcn_readlane(__float_as_int(v), l)); }

DI void p5_gather(const Params& p) {
    unsigned char* ws = p.ws;
    const bf16_t* H1B = (const bf16_t*)(ws + WS_XB); const unsigned char* UT = ws + WS_UT; const unsigned char* VT = ws + WS_VT;
    const unsigned short* PE = (const unsigned short*)(ws + WS_PE); const float* PG = (const float*)(ws + WS_PG); const float* PS = (const float*)(ws + WS_PS);
    const int lane = threadIdx.x & 63, gw = blockIdx.x * 4 + (threadIdx.x >> 6), nw = gridDim.x * 4;
    const bool b5 = (lane & 32) != 0, b4 = (lane & 16) != 0, b3 = (lane & 8) != 0, b2 = (lane & 4) != 0, b1 = (lane & 2) != 0;
    for (int tok = gw; tok < NTOK; tok += nw) {
        float x[16], acc[16];
        {
            const u32x4 xa = ldg16(H1B + (size_t)tok * 1024 + lane * 16), xb = ldg16(H1B + (size_t)tok * 1024 + lane * 16 + 8);
            x[0] = bf_lo(xa.x); x[1] = bf_hi(xa.x); x[2] = bf_lo(xa.y); x[3] = bf_hi(xa.y); x[4] = bf_lo(xa.z); x[5] = bf_hi(xa.z); x[6] = bf_lo(xa.w); x[7] = bf_hi(xa.w);
            x[8] = bf_lo(xb.x); x[9] = bf_hi(xb.x); x[10] = bf_lo(xb.y); x[11] = bf_hi(xb.y); x[12] = bf_lo(xb.z); x[13] = bf_hi(xb.z); x[14] = bf_lo(xb.w); x[15] = bf_hi(xb.w);
        }
#pragma unroll
        for (int i = 0; i < 16; ++i) acc[i] = 0.f;
        const int pe_lo = (int)PE[(size_t)tok * 128 + lane], pe_hi = (int)PE[(size_t)tok * 128 + 64 + lane];
        const float pg_lo = PG[(size_t)tok * 128 + lane], pg_hi = PG[(size_t)tok * 128 + 64 + lane];
        const float ps_lo = PS[(size_t)tok * 128 + lane], ps_hi = PS[(size_t)tok * 128 + 64 + lane];
#pragma unroll 1
        for (int hb = 0; hb < 4; ++hb) {
            const int pes = hb < 2 ? pe_lo : pe_hi; const float pgs = hb < 2 ? pg_lo : pg_hi, pss = hb < 2 ? ps_lo : ps_hi;
            const int lb = (hb & 1) * 32;
            float d[32];
            u32x2 uw[32];
#pragma unroll
            for (int j = 0; j < 32; ++j) { const int e = __builtin_amdgcn_readlane(pes, lb + j); uw[j] = *(const u32x2*)(UT + (size_t)e * 512 + lane * 8); }
#pragma unroll
            for (int j4 = 0; j4 < 8; ++j4) {
                f32x2 a0 = {0.f, 0.f}, a1 = {0.f, 0.f}, a2 = {0.f, 0.f}, a3 = {0.f, 0.f};
#define P5_DOT4(k, bs) { const f32x2 xx = {x[8 * (k) + 2 * (bs)], x[8 * (k) + 2 * (bs) + 1]}; \
                    const f32x2 f0 = __builtin_amdgcn_cvt_scalef32_pk_f32_fp4(uw[4 * j4][k], 1.0f, bs), f1 = __builtin_amdgcn_cvt_scalef32_pk_f32_fp4(uw[4 * j4 + 1][k], 1.0f, bs); \
                    const f32x2 f2 = __builtin_amdgcn_cvt_scalef32_pk_f32_fp4(uw[4 * j4 + 2][k], 1.0f, bs), f3 = __builtin_amdgcn_cvt_scalef32_pk_f32_fp4(uw[4 * j4 + 3][k], 1.0f, bs); \
                    a0 = xx * f0 + a0; a1 = xx * f1 + a1; a2 = xx * f2 + a2; a3 = xx * f3 + a3; }
                P5_DOT4(0, 0) P5_DOT4(0, 1) P5_DOT4(0, 2) P5_DOT4(0, 3) P5_DOT4(1, 0) P5_DOT4(1, 1) P5_DOT4(1, 2) P5_DOT4(1, 3)
                d[4 * j4] = a0.x + a0.y; d[4 * j4 + 1] = a1.x + a1.y; d[4 * j4 + 2] = a2.x + a2.y; d[4 * j4 + 3] = a3.x + a3.y;
            }
            float r16[16], r8[8], r4[4], r2[2], r1;
#pragma unroll
            for (int j = 0; j < 16; ++j) { const float keep = b5 ? d[j + 16] : d[j], send = b5 ? d[j] : d[j + 16]; r16[j] = keep + __shfl_xor(send, 32); }
#pragma unroll
            for (int j = 0; j < 8; ++j) { const float keep = b4 ? r16[j + 8] : r16[j], send = b4 ? r16[j] : r16[j + 8]; r8[j] = keep + __shfl_xor(send, 16); }
#pragma unroll
            for (int j = 0; j < 4; ++j) { const float keep = b3 ? r8[j + 4] : r8[j], send = b3 ? r8[j] : r8[j + 4]; r4[j] = keep + __shfl_xor(send, 8); }
#pragma unroll
            for (int j = 0; j < 2; ++j) { const float keep = b2 ? r4[j + 2] : r4[j], send = b2 ? r4[j] : r4[j + 2]; r2[j] = keep + __shfl_xor(send, 4); }
            { const float keep = b1 ? r2[1] : r2[0], send = b1 ? r2[0] : r2[1]; r1 = keep + __shfl_xor(send, 2); }
            r1 += __shfl_xor(r1, 1);
            const int mine = lb + ((lane >> 1) & 31);
            const float coef = gelu_exact(r1 * __shfl(pss, mine)) * __shfl(pgs, mine);
#pragma unroll
            for (int j = 0; j < 32; ++j) {
                const int e = __builtin_amdgcn_readlane(pes, lb + j);
                const float cj = rdlane(coef, 2 * j);
                const u32x2 vw = *(const u32x2*)(VT + (size_t)e * 512 + lane * 8);
#define P5_AXPY(k, bs) { const f32x2 f = __builtin_amdgcn_cvt_scalef32_pk_f32_fp4(vw[k], 1.0f, bs); acc[8 * (k) + 2 * (bs)] = fmaf(cj, f.x, acc[8 * (k) + 2 * (bs)]); acc[8 * (k) + 2 * (bs) + 1] = fmaf(cj, f.y, acc[8 * (k) + 2 * (bs) + 1]); }
                P5_AXPY(0, 0) P5_AXPY(0, 1) P5_AXPY(0, 2) P5_AXPY(0, 3) P5_AXPY(1, 0) P5_AXPY(1, 1) P5_AXPY(1, 2) P5_AXPY(1, 3)
            }
        }
        float s = 0.f;
#pragma unroll
        for (int i = 0; i < 16; ++i) { acc[i] = fmaf(ALPHA, x[i], acc[i]); s += acc[i]; }
        const float mu = wave_sum(s) * (1.f / 1024.f); float q = 0.f;
#pragma unroll
        for (int i = 0; i < 16; ++i) { const float dd = acc[i] - mu; q = fmaf(dd, dd, q); }
        const float rstd = rsqrtf(wave_sum(q) * (1.f / 1024.f) + LN_EPS);
#pragma unroll
        for (int k4 = 0; k4 < 4; ++k4) {
            const int col = lane * 16 + k4 * 4;
            const f32x4 gg = *(const f32x4*)(p.ln2_g + col), bb = *(const f32x4*)(p.ln2_b + col);
            f32x4 o;
#pragma unroll
            for (int e = 0; e < 4; ++e) o[e] = (acc[k4 * 4 + e] - mu) * rstd * gg[e] + bb[e];
            *(f32x4*)(p.out + (size_t)tok * 1024 + col) = o;
        }
    }
}

#define XB_TMO      128
#define XB_XCNT(j)  (256  + 64 * (j))
#define XB_XSUB(j)  (1280 + 64 * (j))
#define XB_XGEN(j)  (2304 + 64 * (j))
#define XB_TOP      3328
#define XB_TOPGEN   3392
#define XCD_BAR_WORDS 3456
#define XB_SPIN_CAP (1u << 22)
#define LAS __attribute__((address_space(3)))
DI unsigned xb_ld(unsigned* p)              { return __hip_atomic_load(p, __ATOMIC_RELAXED, __HIP_MEMORY_SCOPE_AGENT); }
DI unsigned xb_add(unsigned* p, unsigned v) { return __hip_atomic_fetch_add(p, v, __ATOMIC_RELAXED, __HIP_MEMORY_SCOPE_AGENT); }
DI unsigned xb_xcc_id() { return (unsigned)__builtin_amdgcn_s_getreg((3 << 11) | 20) & 0xFu; }
#define XB_SPIN(cond, bar) do { unsigned _sp = 0; while (cond) { __builtin_amdgcn_s_sleep(1); \
    if ((++_sp & 255u) == 0u) { if (xb_ld(&(bar)[XB_TMO])) break; if (_sp > XB_SPIN_CAP) { atomicAdd(&(bar)[XB_TMO], 1u); break; } } } } while (0)
struct XcdBarrier { unsigned* bar; unsigned x; volatile LAS unsigned* st; };
DI XcdBarrier xcd_barrier_post(unsigned* bar, volatile LAS unsigned* st) {
    XcdBarrier b; b.bar = bar; b.x = xb_xcc_id(); b.st = st;
    if (threadIdx.x == 0) (void)xb_add(&bar[XB_XCNT(b.x)], 1u);
    return b;
}
DI void xcd_barrier_complete(unsigned* bar, unsigned x, unsigned& nloc, unsigned& nx) {
    const unsigned G = gridDim.x * gridDim.y * gridDim.z;
    unsigned sum, cnt, mine, sp = 0u;
    for (;;) {
        sum = 0u; cnt = 0u; mine = 0u;
#pragma unroll
        for (unsigned j = 0; j < 16; ++j) { const unsigned c = xb_ld(&bar[XB_XCNT(j)]); sum += c; cnt += (c > 0u) ? 1u : 0u; mine = (j == x) ? c : mine; }
        if (sum == G) break;
        __builtin_amdgcn_s_sleep(1);
        if ((++sp & 255u) == 0u) { if (xb_ld(&bar[XB_TMO])) break; if (sp > XB_SPIN_CAP) { atomicAdd(&bar[XB_TMO], 1u); break; } }
    }
    nloc = mine > 0u ? mine : 1u; nx = cnt > 0u ? cnt : 1u;
}
DI void xcd_barrier(const XcdBarrier& b) {
    asm volatile("s_waitcnt vmcnt(0)" ::: "memory");
    __syncthreads();
    if (threadIdx.x == 0) {
        unsigned* bar = b.bar;
        __builtin_amdgcn_s_waitcnt(0);
        unsigned nloc = b.st[0], nx = b.st[1];
        if (nloc == 0u) { xcd_barrier_complete(bar, b.x, nloc, nx); b.st[0] = nloc; b.st[1] = nx; }
        const unsigned old = xb_add(&bar[XB_XSUB(b.x)], 1u);
        const unsigned gen = old / nloc;
        if (old + 1u == (gen + 1u) * nloc) {
            __builtin_amdgcn_fence(__ATOMIC_RELEASE, "agent");
            asm volatile("s_waitcnt vmcnt(0)" ::: "memory");
            const unsigned og = xb_add(&bar[XB_TOP], 1u);
            const unsigned tg = og / nx;
            if (og + 1u == (tg + 1u) * nx) xb_add(&bar[XB_TOPGEN], 1u);
            else XB_SPIN(xb_ld(&bar[XB_TOPGEN]) == tg, bar);
            __builtin_amdgcn_fence(__ATOMIC_ACQUIRE, "agent");
            xb_add(&bar[XB_XGEN(b.x)], 1u);
            asm volatile("s_waitcnt vmcnt(0)" ::: "memory");
        } else {
            XB_SPIN(xb_ld(&bar[XB_XGEN(b.x)]) == gen, bar);
            __builtin_amdgcn_fence(__ATOMIC_ACQUIRE, "agent");
            asm volatile("s_waitcnt vmcnt(0)" ::: "memory");
        }
    }
    __syncthreads();
}

constexpr int NPHASE = 7;
__global__ void __launch_bounds__(NTHREADS, 2) mega_fwd(Params p) {
    extern __shared__ __attribute__((aligned(16))) unsigned char lds[];
    cg::grid_group grid = cg::this_grid();
    const int lo = p.ph_lo, hi = p.ph_hi;
    volatile LAS unsigned* xbst = (volatile LAS unsigned*)(LAS unsigned char*)(lds + LDS_BYTES - 16);
#ifndef REP_MASK
#define REP_MASK 0
#endif
#ifndef P2_PROBE_MODE
#define P2_PROBE_MODE 15
#endif
#ifndef PH_MASK
#define PH_MASK 127
#endif
    if (lo == 0x7fffffff) grid.sync();
    if (threadIdx.x == 0) { xbst[0] = 0u; xbst[1] = 0u; }
    __syncthreads();
    XcdBarrier xb = xcd_barrier_post((unsigned*)(p.ws + WS_BAR), xbst);
#define GSYNC() xcd_barrier(xb)
    p0_prep(p, lds);
    GSYNC();
#define RUN_PHASE(k, call) { call; if ((REP_MASK >> (k)) & 1) { GSYNC(); call; } }
#if PH_MASK & 2
    RUN_PHASE(1, p1_inproj(p, lds))
#endif
    GSYNC();
#if PH_MASK & 4
#if (REP_MASK >> 2) & 1
    p2a_indexer(p, lds); GSYNC(); p2_attention<P2_PROBE_MODE>(p, lds, 1); GSYNC();
#endif
    p2a_indexer(p, lds);
    GSYNC();
    p2_attention<15>(p, lds, 0);
#endif
    GSYNC();
#if PH_MASK & 8
    RUN_PHASE(3, p3_outproj(p, lds))
#endif
    GSYNC();
#if PH_MASK & 16
    RUN_PHASE(4, p3b_ln1(p))
#endif
    GSYNC();
#if PH_MASK & 32
    RUN_PHASE(5, p4_peer_query(p, lds))
#endif
    GSYNC();
#if PH_MASK & 64
    RUN_PHASE(6, p5_gather(p))
#endif
}

#ifndef MK_N_LAUNCHES
#define MK_N_LAUNCHES 1
#endif

extern "C" void kernel_launch(void* const* d_in, const int* in_sizes, int n_in, void* d_out, int out_size, void* d_ws, size_t ws_size, hipStream_t stream) {
    static int grid_blocks = 0;
    if (grid_blocks == 0) {
        if (n_in != 14 || out_size != NTOK * D_MODEL || ws_size < WS_END) {
            fprintf(stderr, "kernel_launch: unexpected problem (n_in %d, out %d, ws %zu, need %zu)\n", n_in, out_size, ws_size, (size_t)WS_END); grid_blocks = -1; return;
        }
        int dev = 0, cus = 0, per_cu = 0;
        hipGetDevice(&dev);
        hipDeviceGetAttribute(&cus, hipDeviceAttributeMultiprocessorCount, dev);
        if (hipFuncSetAttribute((const void*)mega_fwd, hipFuncAttributeMaxDynamicSharedMemorySize, LDS_BYTES) != hipSuccess) { fprintf(stderr, "kernel_launch: hipFuncSetAttribute failed\n"); }
        if (hipOccupancyMaxActiveBlocksPerMultiprocessor(&per_cu, (const void*)mega_fwd, NTHREADS, LDS_BYTES) != hipSuccess || per_cu < 1) { fprintf(stderr, "kernel_launch: occupancy query failed\n"); per_cu = 1; }
        if (per_cu > 2) per_cu = 2;
        (void)hipGetLastError();
        grid_blocks = cus * per_cu;
        fprintf(stderr, "kernel_launch: %d CUs x %d blocks\n", cus, per_cu);
    }
    if (grid_blocks < 0) return;
    Params p{};
    p.x = (const float*)d_in[0]; p.w_in = (const float*)d_in[1]; p.idx_k_g = (const float*)d_in[2]; p.idx_k_b = (const float*)d_in[3]; p.sinks = (const float*)d_in[4];
    p.w_o = (const float*)d_in[5]; p.ln1_g = (const float*)d_in[6]; p.ln1_b = (const float*)d_in[7]; p.peer_wq = (const float*)d_in[8]; p.peer_subkeys = (const float*)d_in[9];
    p.peer_u = (const float*)d_in[10]; p.peer_v = (const float*)d_in[11]; p.ln2_g = (const float*)d_in[12]; p.ln2_b = (const float*)d_in[13];
    p.out = (float*)d_out; p.ws = (unsigned char*)d_ws;
    p.ph_lo = 0; p.ph_hi = NPHASE;
    if (hipMemsetAsync((unsigned char*)d_ws + WS_BAR, 0, XCD_BAR_WORDS * 4, stream) != hipSuccess) { fprintf(stderr, "kernel_launch: memset of the barrier words failed\n"); return; }
    void* args[] = {&p};
    hipError_t e = hipLaunchCooperativeKernel((const void*)mega_fwd, dim3(grid_blocks), dim3(NTHREADS), args, LDS_BYTES, stream);
    if (e != hipSuccess) fprintf(stderr, "cooperative launch failed: %s (grid %d)\n", hipGetErrorString(e), grid_blocks);
}
```

```cpp
#include <hip/hip_runtime.h>
#include <hip/hip_cooperative_groups.h>
#include <cstdio>
#include <cstdint>
namespace cg = cooperative_groups;

typedef unsigned short bf16_t;
typedef short bf16x8 __attribute__((ext_vector_type(8)));
typedef float f32x4 __attribute__((ext_vector_type(4)));
typedef float f32x16 __attribute__((ext_vector_type(16)));
typedef unsigned u32x4 __attribute__((ext_vector_type(4)));
typedef unsigned u32x2 __attribute__((ext_vector_type(2)));
#define DI __device__ __forceinline__

constexpr int D_MODEL = 1024, BATCH = 8, SEQ = 4096, NTOK = BATCH * SEQ;
constexpr int NMIX = 1732, NMIX_PAD = 1792;
constexpr int PEER_N = 2048;
constexpr float ALPHA = 1.189207115002721f;
constexpr float LN_EPS = 1e-5f;
constexpr int NTHREADS = 256;
constexpr int LDS_BYTES = 77824;

constexpr size_t MB = 1024 * 1024;
constexpr size_t WS_CTL   = 0;
constexpr size_t WS_BAR   = 65536;
constexpr size_t WS_ROPE  = 1 * MB;
constexpr size_t WS_WINT  = 2 * MB;
constexpr size_t WS_WOT   = 6 * MB;
constexpr size_t WS_WQT   = 8 * MB;
constexpr size_t WS_SK    = 12 * MB;
constexpr size_t WS_UT    = 13 * MB;
constexpr size_t WS_VT    = 29 * MB;
constexpr size_t WS_SU    = 45 * MB;
constexpr size_t WS_SV    = 46 * MB;
constexpr size_t WS_XB    = 77 * MB;
constexpr size_t WS_QA    = 141 * MB;
constexpr size_t WS_KA    = 173 * MB;
constexpr size_t WS_VA    = 181 * MB;
constexpr size_t WS_QB    = 189 * MB;
constexpr size_t WS_KB    = 221 * MB;
constexpr size_t WS_VB    = 225 * MB;
constexpr size_t WS_QI    = 229 * MB;
constexpr size_t WS_KI    = 245 * MB;
constexpr size_t WS_WI    = 249 * MB;
constexpr size_t WS_ATT   = 250 * MB;
constexpr size_t WS_PE    = 314 * MB;
constexpr size_t WS_PG    = 322 * MB;
constexpr size_t WS_PS    = 338 * MB;
constexpr size_t WS_END   = 354 * MB;

struct Params {
    const float* x; const float* w_in; const float* idx_k_g; const float* idx_k_b; const float* sinks; const float* w_o;
    const float* ln1_g; const float* ln1_b; const float* peer_wq; const float* peer_subkeys; const float* peer_u; const float* peer_v;
    const float* ln2_g; const float* ln2_b;
    float* out; unsigned char* ws;
    int ph_lo, ph_hi;
};

typedef float f32x2 __attribute__((ext_vector_type(2)));
typedef __bf16 bf16x2_t __attribute__((ext_vector_type(2)));
DI unsigned pack_bf16(float lo, float hi) { const f32x2 v = {lo, hi}; return __builtin_bit_cast(unsigned, __builtin_convertvector(v, bf16x2_t)); }
DI unsigned f2bf(float x) { return pack_bf16(x, 0.f) & 0xffffu; }
DI float bf_lo(unsigned w) { return __uint_as_float(w << 16); }
DI float bf_hi(unsigned w) { return __uint_as_float(w & 0xffff0000u); }
DI bf16x8 as_bf16x8(u32x4 v) { return __builtin_bit_cast(bf16x8, v); }
DI u32x4 ldg16(const void* p) { return *(const u32x4*)p; }
DI f32x4 mfma16(bf16x8 a, bf16x8 b, f32x4 c) { return __builtin_amdgcn_mfma_f32_16x16x32_bf16(a, b, c, 0, 0, 0); }
DI f32x16 mfma32(bf16x8 a, bf16x8 b, f32x16 c) { return __builtin_amdgcn_mfma_f32_32x32x16_bf16(a, b, c, 0, 0, 0); }
DI float wave_sum(float v) {
#pragma unroll
    for (int o = 32; o >= 1; o >>= 1) v += __shfl_xor(v, o);
    return v;
}

DI void glds16(const void* src, void* lds_dst) { __builtin_amdgcn_global_load_lds((const unsigned*)src, (__attribute__((address_space(3))) unsigned*)lds_dst, 16, 0, 0); }
DI void gemm_128x128(const bf16_t* __restrict__ X, int ldx, const bf16_t* __restrict__ Wt, int ldw, int K, unsigned char* lds, f32x4 (&acc)[4][4]) {
    int tid = threadIdx.x; asm volatile("" : "+v"(tid));
    const int lane = tid & 63, wave = tid >> 6, wm = wave >> 1, wn = wave & 1, c = lane & 15, g = lane >> 4;
    const int lrow = tid >> 3, lch = tid & 7;
    const bf16_t* xp = X + (size_t)lrow * ldx + ((lch ^ (lrow & 7)) * 8);
    const bf16_t* wp = Wt + (size_t)lrow * ldw + ((lch ^ (lrow & 7)) * 8);
    unsigned char* dst0 = lds + tid * 16;
#pragma unroll
    for (int m = 0; m < 4; ++m)
#pragma unroll
        for (int n = 0; n < 4; ++n) acc[m][n] = (f32x4){0.f, 0.f, 0.f, 0.f};
    const int nk = K / 64;
    __syncthreads();
#pragma unroll
    for (int i = 0; i < 4; ++i) { glds16(xp + (size_t)(32 * i) * ldx, dst0 + i * 4096); glds16(wp + (size_t)(32 * i) * ldw, dst0 + 16384 + i * 4096); }
    asm volatile("s_waitcnt vmcnt(0)" ::: "memory");
    __syncthreads();
    for (int kt = 0; kt < nk; ++kt) {
        const unsigned char* Xs = lds + (kt & 1) * 32768; const unsigned char* Ws = Xs + 16384;
        if (kt + 1 < nk) {
            unsigned char* d = dst0 + ((kt + 1) & 1) * 32768;
#pragma unroll
            for (int i = 0; i < 4; ++i) { glds16(xp + (size_t)(32 * i) * ldx + (kt + 1) * 64, d + i * 4096); glds16(wp + (size_t)(32 * i) * ldw + (kt + 1) * 64, d + 16384 + i * 4096); }
        }
#pragma unroll
        for (int s = 0; s < 2; ++s) {
            bf16x8 xf[4], wf[4];
#pragma unroll
            for (int m = 0; m < 4; ++m) { const int row = wm * 64 + m * 16 + c; xf[m] = as_bf16x8(*(const u32x4*)(Xs + row * 128 + (((4 * s + g) ^ (c & 7)) << 4))); }
#pragma unroll
            for (int n = 0; n < 4; ++n) { const int row = wn * 64 + n * 16 + c; wf[n] = as_bf16x8(*(const u32x4*)(Ws + row * 128 + (((4 * s + g) ^ (c & 7)) << 4))); }
#pragma unroll
            for (int m = 0; m < 4; ++m)
#pragma unroll
                for (int n = 0; n < 4; ++n) acc[m][n] = mfma16(wf[n], xf[m], acc[m][n]);
        }
        asm volatile("s_waitcnt vmcnt(0)" ::: "memory");
        __syncthreads();
    }
}

DI bool tile_of(int k, int NT, int MT, int& mt, int& nt) {
    const int G = gridDim.x, bid = blockIdx.x;
    if (((G | MT) & 7) == 0) {
        const int idx = (bid >> 3) + k * (G >> 3);
        if (idx >= (MT >> 3) * NT) return false;
        mt = (idx / NT) * 8 + (bid & 7); nt = idx % NT;
    } else {
        const int t = bid + k * G;
        if (t >= MT * NT) return false;
        mt = t / NT; nt = t % NT;
    }
    return true;
}

DI void p0_prep(const Params& p, unsigned char* lds) {
    const int tid = threadIdx.x, nb = gridDim.x, bid = blockIdx.x;
    const size_t gtid = (size_t)bid * NTHREADS + tid, gsz = (size_t)nb * NTHREADS;
    unsigned char* ws = p.ws;
    {
        float* ct = (float*)(ws + WS_ROPE); float* stb = ct + SEQ * 32;
        for (size_t i = gtid; i < (size_t)SEQ * 32; i += gsz) {
            const int pos = (int)(i >> 5), fi = (int)(i & 31);
            const float inv = powf(10000.0f, -(float)(2 * fi) / 64.0f);
            const float ang = (float)pos * inv;
            ct[i] = cosf(ang); stb[i] = sinf(ang);
        }
    }
    auto conv = [&](const float* src, bf16_t* dst, size_t n) {
        for (size_t i = gtid * 8; i < n; i += gsz * 8) {
            const f32x4 a = *(const f32x4*)(src + i), b = *(const f32x4*)(src + i + 4);
            u32x4 o; o.x = pack_bf16(a.x, a.y); o.y = pack_bf16(a.z, a.w); o.z = pack_bf16(b.x, b.y); o.w = pack_bf16(b.z, b.w);
            *(u32x4*)(dst + i) = o;
        }
    };
    conv(p.x, (bf16_t*)(ws + WS_XB), (size_t)NTOK * D_MODEL);
    conv(p.peer_subkeys, (bf16_t*)(ws + WS_SK), (size_t)8 * 2 * 128 * 128);
    float* tl = (float*)lds;
    auto transp = [&](const float* src, bf16_t* dst, int N, int Npad) {
        const int tn = Npad / 64, tk = 1024 / 64;
        for (int t = bid; t < tn * tk; t += nb) {
            const int n0 = (t % tn) * 64, k0 = (t / tn) * 64;
            __syncthreads();
            for (int e = tid; e < 4096; e += NTHREADS) { const int kk = e >> 6, nn = e & 63; tl[kk * 65 + nn] = (n0 + nn < N) ? src[(size_t)(k0 + kk) * N + n0 + nn] : 0.f; }
            __syncthreads();
            for (int e = tid; e < 4096; e += NTHREADS) { const int nn = e >> 6, kk = e & 63; dst[(size_t)(n0 + nn) * 1024 + k0 + kk] = (bf16_t)f2bf(tl[kk * 65 + nn]); }
        }
    };
    transp(p.w_in, (bf16_t*)(ws + WS_WINT), NMIX, NMIX_PAD);
}

DI void p0_late(const Params& p, unsigned char* lds) {
    const int tid = threadIdx.x, nb = gridDim.x, bid = blockIdx.x;
    unsigned char* ws = p.ws;
    {
        const int lane = tid & 63, gw = bid * 4 + (tid >> 6), nw = nb * 4;
        for (int row0 = gw * 4; row0 < 2 * 16384; row0 += nw * 4) {
            f32x4 v[4][4];
#pragma unroll
            for (int r = 0; r < 4; ++r) {
                const int row = row0 + r; const bool isv = row >= 16384; const int e = isv ? row - 16384 : row;
                const float* src = (isv ? p.peer_v : p.peer_u) + (size_t)e * 1024 + lane * 16;
#pragma unroll
                for (int i = 0; i < 4; ++i) v[r][i] = *(const f32x4*)(src + 4 * i);
            }
#pragma unroll
            for (int r = 0; r < 4; ++r) {
                const int row = row0 + r; const bool isv = row >= 16384; const int e = isv ? row - 16384 : row;
                float mx = 0.f;
#pragma unroll
                for (int i = 0; i < 4; ++i) mx = fmaxf(mx, fmaxf(fmaxf(fabsf(v[r][i][0]), fabsf(v[r][i][1])), fmaxf(fabsf(v[r][i][2]), fabsf(v[r][i][3]))));
#pragma unroll
                for (int o = 32; o >= 1; o >>= 1) mx = fmaxf(mx, __shfl_xor(mx, o));
                const float sc = mx > 0.f ? mx * (1.0f / 5.99f) : 1.0f, inv = mx > 0.f ? 5.99f / mx : 1.0f;
                u32x2 o2;
#pragma unroll
                for (int k = 0; k < 2; ++k) {
                    unsigned w = 0;
                    w = __builtin_amdgcn_cvt_scalef32_pk_fp4_f32(w, v[r][2 * k][0] * inv, v[r][2 * k][1] * inv, 1.0f, 0);
                    w = __builtin_amdgcn_cvt_scalef32_pk_fp4_f32(w, v[r][2 * k][2] * inv, v[r][2 * k][3] * inv, 1.0f, 1);
                    w = __builtin_amdgcn_cvt_scalef32_pk_fp4_f32(w, v[r][2 * k + 1][0] * inv, v[r][2 * k + 1][1] * inv, 1.0f, 2);
                    w = __builtin_amdgcn_cvt_scalef32_pk_fp4_f32(w, v[r][2 * k + 1][2] * inv, v[r][2 * k + 1][3] * inv, 1.0f, 3);
                    o2[k] = w;
                }
                *(u32x2*)(ws + (isv ? WS_VT : WS_UT) + (size_t)e * 512 + lane * 8) = o2;
                if (lane == 0) ((float*)(ws + (isv ? WS_SV : WS_SU)))[e] = sc;
            }
        }
    }
    float* tl = (float*)lds;
    auto transp = [&](const float* src, bf16_t* dst, int N, int Npad) {
        const int tn = Npad / 64, tk = 1024 / 64;
        for (int t = bid; t < tn * tk; t += nb) {
            const int n0 = (t % tn) * 64, k0 = (t / tn) * 64;
            __syncthreads();
            for (int e = tid; e < 4096; e += NTHREADS) { const int kk = e >> 6, nn = e & 63; tl[kk * 65 + nn] = (n0 + nn < N) ? src[(size_t)(k0 + kk) * N + n0 + nn] : 0.f; }
            __syncthreads();
            for (int e = tid; e < 4096; e += NTHREADS) { const int nn = e >> 6, kk = e & 63; dst[(size_t)(n0 + nn) * 1024 + k0 + kk] = (bf16_t)f2bf(tl[kk * 65 + nn]); }
        }
    };
    transp(p.w_o, (bf16_t*)(ws + WS_WOT), 1024, 1024);
    transp(p.peer_wq, (bf16_t*)(ws + WS_WQT), PEER_N, PEER_N);
}

DI void p1_inproj(const Params& p, unsigned char* lds) {
    unsigned char* ws = p.ws;
    const bf16_t* XB = (const bf16_t*)(ws + WS_XB); const bf16_t* WT = (const bf16_t*)(ws + WS_WINT);
    const float* cosT = (const float*)(ws + WS_ROPE); const float* sinT = cosT + SEQ * 32;
    const int tid = threadIdx.x, lane = tid & 63, wave = tid >> 6, wm = wave >> 1, wn = wave & 1, c = lane & 15, g = lane >> 4;
    constexpr int NT = NMIX_PAD / 128, MT = NTOK / 128;
    int mt, nt;
    for (int k = 0; tile_of(k, NT, MT, mt, nt); ++k) {
        f32x4 acc[4][4];
        gemm_128x128(XB + (size_t)mt * 128 * 1024, 1024, WT + (size_t)nt * 128 * 1024, 1024, 1024, lds, acc);
        const int col64 = nt * 2 + wn;
        bf16_t* dst; int ld, coff; bool rope = true; float scale = 1.f;
        if (col64 < 8)       { dst = (bf16_t*)(ws + WS_QA); ld = 512; coff = col64 * 64; scale = 0.125f; }
        else if (col64 < 10) { dst = (bf16_t*)(ws + WS_KA); ld = 128; coff = (col64 - 8) * 64; }
        else if (col64 < 12) { dst = (bf16_t*)(ws + WS_VA); ld = 128; coff = (col64 - 10) * 64; rope = false; }
        else if (col64 < 20) { dst = (bf16_t*)(ws + WS_QB); ld = 512; coff = (col64 - 12) * 64; scale = 0.125f; }
        else if (col64 == 20) { dst = (bf16_t*)(ws + WS_KB); ld = 64; coff = 0; }
        else if (col64 == 21) { dst = (bf16_t*)(ws + WS_VB); ld = 64; coff = 0; rope = false; }
        else if (col64 < 26) { dst = (bf16_t*)(ws + WS_QI); ld = 256; coff = (col64 - 22) * 64; }
        else                 { dst = (bf16_t*)(ws + WS_KI); ld = 64; coff = 0; }
        if (col64 == 27) {
            if (g == 0) {
#pragma unroll
                for (int m = 0; m < 4; ++m) { const int tok = mt * 128 + wm * 64 + m * 16 + c; *(f32x4*)((float*)(ws + WS_WI) + (size_t)tok * 4) = acc[m][0] * 0.0625f; }
            }
            continue;
        }
#pragma unroll
        for (int m = 0; m < 4; ++m) {
            const int tok = mt * 128 + wm * 64 + m * 16 + c, pos = tok & (SEQ - 1);
            f32x4 v[4] = {acc[m][0], acc[m][1], acc[m][2], acc[m][3]};
            if (col64 == 26) {
                float s = 0.f;
#pragma unroll
                for (int n = 0; n < 4; ++n) s += (v[n][0] + v[n][1]) + (v[n][2] + v[n][3]);
                s += __shfl_xor(s, 16); s += __shfl_xor(s, 32);
                const float mu = s * (1.f / 64.f); float q = 0.f;
#pragma unroll
                for (int n = 0; n < 4; ++n) { const f32x4 d = v[n] - mu; q += (d[0] * d[0] + d[1] * d[1]) + (d[2] * d[2] + d[3] * d[3]); }
                q += __shfl_xor(q, 16); q += __shfl_xor(q, 32);
                const float rstd = rsqrtf(q * (1.f / 64.f) + LN_EPS);
#pragma unroll
                for (int n = 0; n < 4; ++n) {
                    const f32x4 gg = *(const f32x4*)(p.idx_k_g + 16 * n + 4 * g), bb = *(const f32x4*)(p.idx_k_b + 16 * n + 4 * g);
                    v[n] = (v[n] - mu) * rstd * gg + bb;
                }
            }
            if (rope) {
#pragma unroll
                for (int n = 0; n < 2; ++n) {
                    const f32x4 cs = *(const f32x4*)(cosT + pos * 32 + 16 * n + 4 * g), sn = *(const f32x4*)(sinT + pos * 32 + 16 * n + 4 * g);
                    const f32x4 t1 = v[n], t2 = v[n + 2];
                    v[n] = t1 * cs - t2 * sn; v[n + 2] = t2 * cs + t1 * sn;
                }
            }
#pragma unroll
            for (int n = 0; n < 4; ++n) {
                const f32x4 o = v[n] * scale; u32x2 w; w.x = pack_bf16(o[0], o[1]); w.y = pack_bf16(o[2], o[3]);
                *(u32x2*)(dst + (size_t)tok * ld + coff + 16 * n + 4 * g) = w;
            }
        }
    }
}

constexpr int NDSA = NTOK / 4, NSWA = BATCH * 32 * 8;
constexpr int P2_STG = 0  , P2_LIST = 32768;

DI unsigned f16_key(float v) {
    _Float16 hv = (_Float16)v; unsigned short hb = __builtin_bit_cast(unsigned short, hv); unsigned b = hb;
    if (b == 0x8000u) b = 0u;
    return (b & 0x8000u) ? ((~b) & 0xffffu) : (b | 0x8000u);
}

DI size_t sc_row_off(int t) { const size_t m = (size_t)(t >> 3); return 8 * (4 * m * (m + 1) + (size_t)(t & 7) * (m + 1)); }
constexpr size_t SC_BATCH = 8404992;
DI unsigned short* sc_batch_base(const Params& p, int b) { return (b < 7) ? (unsigned short*)p.out + (size_t)b * SC_BATCH : (unsigned short*)(p.ws + WS_PG); }

DI void p2a_indexer(const Params& p, unsigned char* lds) {
    unsigned char* ws = p.ws;
    const bf16_t* QI = (const bf16_t*)(ws + WS_QI); const bf16_t* KI = (const bf16_t*)(ws + WS_KI); const float* WI = (const float*)(ws + WS_WI);
    const int G = gridDim.x, bi = blockIdx.x;
    for (int it = 0; it < 2; ++it) {
        const int item = (it == 0) ? bi : 1023 - bi;
        for (int id = (G == 512) ? item : bi + it * G; id < 1024; id += (G == 512) ? 1024 : 2 * G) {
            int tid = threadIdx.x; asm volatile("" : "+v"(tid));
            const int lane = tid & 63, wave = tid >> 6, c = lane & 15, g = lane >> 4, lrow = tid >> 3, lch = tid & 7;
            const int b = id >> 7, t0 = (id & 127) * 32, tokw = b * SEQ + t0 + 8 * wave;
            unsigned short* scb = sc_batch_base(p, b);
            bf16x8 af[2][2]; f32x4 wv[2];
#pragma unroll
            for (int rt = 0; rt < 2; ++rt) {
#pragma unroll
                for (int s2 = 0; s2 < 2; ++s2) af[rt][s2] = as_bf16x8(ldg16(QI + (size_t)(tokw + 4 * rt + (c >> 2)) * 256 + (c & 3) * 64 + 32 * s2 + 8 * g));
                wv[rt] = *(const f32x4*)(WI + (size_t)(tokw + 4 * rt + g) * 4);
            }
            asm volatile("" :: "v"(af[0][0]), "v"(af[0][1]), "v"(af[1][0]), "v"(af[1][1]), "v"(wv[0]), "v"(wv[1]));
            const int nkt = ((t0 + 31) >> 7) + 1;
            const unsigned char* kib = (const unsigned char*)(KI + (size_t)b * SEQ * 64);
            unsigned char* dst0 = lds + tid * 16;
            auto stage = [&](int kt, int buf) {
#pragma unroll
                for (int i = 0; i < 4; ++i) {
                    const int row = lrow + 32 * i;
                    glds16(kib + (size_t)(kt * 128 + row) * 128 + ((lch ^ ((row >> 3) & 7)) << 4), dst0 + buf * 16384 + i * 4096);
                }
            };
            __syncthreads();
            stage(0, 0); if (nkt > 1) stage(1, 1);
            for (int kt = 0; kt < nkt; ++kt) {
                if (kt + 1 < nkt) asm volatile("s_waitcnt vmcnt(4)" ::: "memory");
                else asm volatile("s_waitcnt vmcnt(0)" ::: "memory");
                asm volatile("s_waitcnt lgkmcnt(0)" ::: "memory");
                __builtin_amdgcn_s_barrier();
                if (kt + 2 < nkt) stage(kt + 2, (kt + 2) % 3);
                const unsigned char* Ks = lds + (kt % 3) * 16384;
                unsigned res[2][4];
#pragma unroll
                for (int ct = 0; ct < 8; ++ct) {
                    const int row = 8 * c + ct;
                    const bf16x8 k0 = as_bf16x8(*(const u32x4*)(Ks + row * 128 + ((g ^ (c & 7)) << 4)));
                    const bf16x8 k1 = as_bf16x8(*(const u32x4*)(Ks + row * 128 + (((4 + g) ^ (c & 7)) << 4)));
#pragma unroll
                    for (int rt = 0; rt < 2; ++rt) {
                        f32x4 d = mfma16(af[rt][0], k0, (f32x4){0.f, 0.f, 0.f, 0.f});
                        d = mfma16(af[rt][1], k1, d);
                        const float sv = wv[rt][0] * fmaxf(d[0], 0.f) + wv[rt][1] * fmaxf(d[1], 0.f) + wv[rt][2] * fmaxf(d[2], 0.f) + wv[rt][3] * fmaxf(d[3], 0.f);
                        const int key = kt * 128 + row, tq = t0 + 8 * wave + 4 * rt + g;
                        const unsigned kv = (key <= tq) ? f16_key(sv) : 0u;
                        if (ct & 1) res[rt][ct >> 1] |= kv << 16; else res[rt][ct >> 1] = kv;
                    }
                }
#pragma unroll
                for (int rt = 0; rt < 2; ++rt) {
                    const int tq = t0 + 8 * wave + 4 * rt + g;
                    if (16 * kt + c <= (tq >> 3)) {
                        u32x4 w; w.x = res[rt][0]; w.y = res[rt][1]; w.z = res[rt][2]; w.w = res[rt][3];
                        *(u32x4*)(scb + sc_row_off(tq) + kt * 128 + 8 * c) = w;
                    }
                }
            }
        }
    }
    __syncthreads();
    p0_late(p, lds);
}

template <int MODE> DI void p2_dsa_item(const Params& p, unsigned char* lds, int b, int tb) {
    unsigned char* ws = p.ws;
    const bf16_t* QI = (const bf16_t*)(ws + WS_QI); const bf16_t* KI = (const bf16_t*)(ws + WS_KI); const float* WI = (const float*)(ws + WS_WI);
    const bf16_t* QB = (const bf16_t*)(ws + WS_QB); const bf16_t* KB = (const bf16_t*)(ws + WS_KB); const bf16_t* VB = (const bf16_t*)(ws + WS_VB);
    bf16_t* ATT = (bf16_t*)(ws + WS_ATT);
    int tid = threadIdx.x; asm volatile("" : "+v"(tid));
    const int lane = tid & 63, wave = __builtin_amdgcn_readfirstlane(tid >> 6), c = lane & 15, g = lane >> 4;
    const int t0 = tb * 4, tok0 = b * SEQ + t0;
    unsigned char* stg = lds + P2_STG + wave * 8192;
    unsigned* hist = (unsigned*)stg;
    unsigned short* list = (unsigned short*)(lds + P2_LIST) + wave * 256;
    const int tok = tok0 + wave;
    if (!(MODE & 2)) return;
    const int n = t0 + wave + 1;
    const int L = n < 256 ? n : 256;
    const unsigned short* myk = sc_batch_base(p, b) + sc_row_off(t0 + wave);
    if (n <= 256) {
        for (int i = lane; i < n; i += 64) list[i] = (unsigned short)i;
    } else {
        u32x4 kk[8];
#pragma unroll
        for (int i = 0; i < 8; ++i) kk[i] = (512 * i + 8 * lane < n) ? ldg16(myk + 512 * i + 8 * lane) : (u32x4){0u, 0u, 0u, 0u};
#pragma unroll
        for (int i = 0; i < 4; ++i) *(u32x4*)(hist + lane * 16 + i * 4) = (u32x4){0u, 0u, 0u, 0u};
#pragma unroll
        for (int i = 0; i < 8; ++i) {
            if (512 * i < n) {
#pragma unroll
                for (int w = 0; w < 4; ++w) { const unsigned wd = kk[i][w]; atomicAdd(&hist[(wd & 0xffffu) >> 6], 1u); atomicAdd(&hist[wd >> 22], 1u); }
            }
        }
        unsigned h[16];
#pragma unroll
        for (int i = 0; i < 4; ++i) { const u32x4 t = *(const u32x4*)(hist + lane * 16 + i * 4); h[4 * i] = t.x; h[4 * i + 1] = t.y; h[4 * i + 2] = t.z; h[4 * i + 3] = t.w; }
#pragma unroll
        for (int i = 0; i < 4; ++i) *(u32x4*)(hist + lane * 16 + i * 4) = (u32x4){0u, 0u, 0u, 0u};
        unsigned sl = 0;
#pragma unroll
        for (int i = 0; i < 16; ++i) sl += h[i];
        unsigned pre = sl;
#pragma unroll
        for (int o = 1; o < 64; o <<= 1) { const unsigned t = __shfl_up(pre, o); if (lane >= o) pre += t; }
        const unsigned tot = __shfl(pre, 63);
        const unsigned suf = tot - pre;
        int found = -1; unsigned cab = 0, cum = suf;
#pragma unroll
        for (int j = 15; j >= 0; --j) { const bool hit = (found < 0) && (cum + h[j] >= 256u); if (hit) { found = lane * 16 + j; cab = cum; } cum += h[j]; }
        const bool mine = (suf < 256u) && (suf + sl >= 256u);
        const unsigned long long mm = __ballot(mine);
        const int src = __ffsll((long long)mm) - 1;
        const unsigned bstar = (unsigned)__shfl(found, src), cabove = __shfl(cab, src);
        const unsigned r1 = 256u - cabove;
#pragma unroll
        for (int i = 0; i < 8; ++i) {
            if (512 * i < n) {
#pragma unroll
                for (int w = 0; w < 4; ++w) {
                    const unsigned wd = kk[i][w];
                    if (((wd & 0xffffu) >> 6) == bstar) atomicAdd(&hist[wd & 63u], 1u);
                    if ((wd >> 22) == bstar) atomicAdd(&hist[(wd >> 16) & 63u], 1u);
                }
            }
        }
        const unsigned cnt = hist[lane];
        hist[lane] = 0u;
        unsigned pre2 = cnt;
#pragma unroll
        for (int o = 1; o < 64; o <<= 1) { const unsigned t = __shfl_up(pre2, o); if (lane >= o) pre2 += t; }
        const unsigned tot2 = __shfl(pre2, 63);
        const unsigned suf2 = tot2 - pre2;
        const bool mine2 = (suf2 < r1) && (suf2 + cnt >= r1);
        const unsigned long long mm2 = __ballot(mine2);
        const int src2 = __ffsll((long long)mm2) - 1;
        const unsigned T = (bstar << 6) | (unsigned)src2;
        const unsigned req = r1 - __shfl(suf2, src2);
        const unsigned toteq = __shfl(cnt, src2);
        const bool alleq = (req == toteq);
        const unsigned Tt = alleq ? T : T + 1u;
        unsigned cg = 0;
#pragma unroll
        for (int i = 0; i < 8; ++i)
#pragma unroll
            for (int w = 0; w < 4; ++w) { const unsigned wd = kk[i][w]; cg += ((wd & 0xffffu) >= Tt) ? 1u : 0u; cg += ((wd >> 16) >= Tt) ? 1u : 0u; }
        unsigned pre3 = cg;
#pragma unroll
        for (int o = 1; o < 64; o <<= 1) { const unsigned t = __shfl_up(pre3, o); if (lane >= o) pre3 += t; }
        unsigned off = pre3 - cg;
#pragma unroll
        for (int i = 0; i < 8; ++i)
#pragma unroll
            for (int w = 0; w < 4; ++w) {
                const unsigned wd = kk[i][w]; const int idx = 512 * i + 8 * lane + 2 * w;
                if ((wd & 0xffffu) >= Tt) { list[off & 255u] = (unsigned short)idx; ++off; }
                if ((wd >> 16) >= Tt) { list[off & 255u] = (unsigned short)(idx + 1); ++off; }
            }
        if (!alleq) {
            const unsigned cgt = 256u - req; unsigned eq_run = 0;
            for (int base = 0; base < n; base += 64) {
                const int i = base + lane; const unsigned m = (i < n) ? myk[i] : 0u;
                const bool eq = (m == T);
                const unsigned long long eqm = __ballot(eq);
                const unsigned rank = eq_run + __builtin_amdgcn_mbcnt_hi((unsigned)(eqm >> 32), __builtin_amdgcn_mbcnt_lo((unsigned)eqm, 0u));
                if (eq && rank < req) list[cgt + rank] = (unsigned short)i;
                eq_run += (unsigned)__popcll(eqm);
            }
        }
    }
    if (!(MODE & 4)) return;
    bf16x8 qf[2], sel[2];
#pragma unroll
    for (int s = 0; s < 2; ++s) {
        u32x4 t = (u32x4){0u, 0u, 0u, 0u};
        if (c < 8) t = ldg16(QB + (size_t)tok * 512 + c * 64 + 32 * s + 8 * g);
        qf[s] = as_bf16x8(t);
#pragma unroll
        for (int j = 0; j < 8; ++j) sel[s][j] = (8 * g + j == 16 * s + c) ? (short)0x3F80 : (short)0;
    }
    f32x4 st[16];
    const unsigned char* kbb = (const unsigned char*)(KB + (size_t)b * SEQ * 64); const unsigned char* vbb = (const unsigned char*)(VB + (size_t)b * SEQ * 64);
    const int lr = lane >> 3, lc = lane & 7;
    const unsigned st_off = lr * 128 + ((lc ^ lr) << 4);
    auto loadg = [&](const unsigned char* base, int T0, u32x4 (&dst)[8]) {
#pragma unroll
        for (int i = 0; i < 8; ++i) {
            const int idx = T0 * 16 + i * 8 + lr; const unsigned kid = (idx < L) ? (unsigned)list[idx] : 0u;
            dst[i] = ldg16(base + kid * 128u + lc * 16u);
        }
    };
    auto stage = [&](const u32x4 (&src)[8]) {
#pragma unroll
        for (int i = 0; i < 8; ++i) *(u32x4*)(stg + i * 1024 + st_off) = src[i];
    };
    auto frag = [&](int u, int s2) -> bf16x8 { return as_bf16x8(*(const u32x4*)(stg + (16 * u + c) * 128 + (((4 * s2 + g) ^ (c & 7)) << 4))); };
    auto scoreK = [&](int T0) {
#pragma unroll
        for (int T = 0; T < 4; ++T) {
            f32x4 d = mfma16(frag(T, 0), qf[0], (f32x4){0.f, 0.f, 0.f, 0.f});
            st[T0 + T] = mfma16(frag(T, 1), qf[1], d);
        }
    };
    u32x4 rA[8], rB[8], rC[8], rD[8];
    loadg(kbb, 0, rA); loadg(kbb, 4, rB); loadg(kbb, 8, rC); loadg(kbb, 12, rD);
    __builtin_amdgcn_sched_barrier(0);
    stage(rA); scoreK(0);
    stage(rB); scoreK(4);
    __builtin_amdgcn_sched_barrier(0);
    loadg(vbb, 0, rA); loadg(vbb, 4, rB);
    stage(rC); scoreK(8);
    stage(rD); scoreK(12);
    __builtin_amdgcn_sched_barrier(0);
    float mx = -3.0e38f;
    {
        const int lrem = L - 4 * g;
#pragma unroll
        for (int T = 0; T < 16; ++T)
#pragma unroll
            for (int r = 0; r < 4; ++r) { const float sv = (T * 16 + r < lrem) ? st[T][r] : -3.0e38f; st[T][r] = sv; mx = fmaxf(mx, sv); }
    }
    mx = fmaxf(mx, __shfl_xor(mx, 16)); mx = fmaxf(mx, __shfl_xor(mx, 32));
    float lsum = 0.f;
#pragma unroll
    for (int T = 0; T < 16; ++T)
#pragma unroll
        for (int r = 0; r < 4; ++r) { const float e = __expf(st[T][r] - mx); st[T][r] = e; lsum += e; }
    lsum += __shfl_xor(lsum, 16); lsum += __shfl_xor(lsum, 32);
    const float rl = 1.0f / lsum;
    u32x4 pfv[8];
#pragma unroll
    for (int u = 0; u < 8; ++u) {
        const int Ta = 2 * u, Tb = Ta + 1;
        pfv[u].x = pack_bf16(st[Ta][0] * rl, st[Ta][1] * rl); pfv[u].y = pack_bf16(st[Ta][2] * rl, st[Ta][3] * rl);
        pfv[u].z = pack_bf16(st[Tb][0] * rl, st[Tb][1] * rl); pfv[u].w = pack_bf16(st[Tb][2] * rl, st[Tb][3] * rl);
    }
    __builtin_amdgcn_sched_barrier(0);
    f32x4 O[4];
#pragma unroll
    for (int cb = 0; cb < 4; ++cb) O[cb] = (f32x4){0.f, 0.f, 0.f, 0.f};
    auto pv = [&](int T0) {
#pragma unroll
        for (int u = 0; u < 2; ++u) {
            const u32x4 pf = pfv[(T0 >> 1) + u];
#pragma unroll
            for (int cb = 0; cb < 4; ++cb) {
                const f32x4 z = (f32x4){0.f, 0.f, 0.f, 0.f};
                const f32x4 v0 = mfma16(frag(2 * u, cb >> 1), sel[cb & 1], z), v1 = mfma16(frag(2 * u + 1, cb >> 1), sel[cb & 1], z);
                u32x4 vf; vf.x = pack_bf16(v0[0], v0[1]); vf.y = pack_bf16(v0[2], v0[3]); vf.z = pack_bf16(v1[0], v1[1]); vf.w = pack_bf16(v1[2], v1[3]);
                O[cb] = mfma16(as_bf16x8(pf), as_bf16x8(vf), O[cb]);
            }
        }
    };
    loadg(vbb, 8, rC); loadg(vbb, 12, rD);
    __builtin_amdgcn_sched_barrier(0);
    stage(rA); pv(0);
    stage(rB); pv(4);
    __builtin_amdgcn_sched_barrier(0);
    stage(rC); pv(8);
    stage(rD); pv(12);
    if (g < 2) {
#pragma unroll
        for (int cb = 0; cb < 4; ++cb)
#pragma unroll
            for (int r = 0; r < 4; ++r) ATT[(size_t)tok * 1024 + 512 + (4 * g + r) * 64 + 16 * cb + c] = (bf16_t)f2bf(O[cb][r]);
    }
}

DI void p2_swa_item(const Params& p, int item2) {
    unsigned char* ws = p.ws;
    const bf16_t* QA = (const bf16_t*)(ws + WS_QA); const bf16_t* KA = (const bf16_t*)(ws + WS_KA); const bf16_t* VA = (const bf16_t*)(ws + WS_VA);
    bf16_t* ATT = (bf16_t*)(ws + WS_ATT);
    int tid = threadIdx.x; asm volatile("" : "+v"(tid));
    const int lane = tid & 63, wave = __builtin_amdgcn_readfirstlane(tid >> 6), r = lane & 31, h = lane >> 5;
    const int hq = item2 & 7, blk = (item2 >> 3) & 31, b = item2 >> 8, kvh = hq >> 2;
    const int qi = 32 * wave + r, tokq = b * SEQ + blk * 128 + qi;
    bf16x8 qf[4], sel[2];
#pragma unroll
    for (int s = 0; s < 4; ++s) qf[s] = as_bf16x8(ldg16(QA + (size_t)tokq * 512 + hq * 64 + 16 * s + 8 * h));
#pragma unroll
    for (int x = 0; x < 2; ++x)
#pragma unroll
        for (int j = 0; j < 8; ++j) sel[x][j] = (8 * h + j + 16 * x == r) ? (short)0x3F80 : (short)0;
    const float sink = p.sinks[hq];
    f32x16 ST[5];
#pragma unroll
    for (int ti = 0; ti < 5; ++ti) {
        const int sj = 32 * (wave + ti) + r; int pos = blk * 128 - 128 + sj; pos = pos < 0 ? 0 : pos;
        const bf16_t* kp = KA + (size_t)(b * SEQ + pos) * 128 + kvh * 64 + 8 * h;
        f32x16 d; for (int i = 0; i < 16; ++i) d[i] = 0.f;
#pragma unroll
        for (int s = 0; s < 4; ++s) d = mfma32(as_bf16x8(ldg16(kp + 16 * s)), qf[s], d);
        ST[ti] = d;
    }
    float mx = sink;
    {
        const int lo = r + 1 - 4 * h;
        const int lo0 = (blk > 0) ? lo : (lo > 128 - 32 * wave - 4 * h ? lo : 128 - 32 * wave - 4 * h);
#pragma unroll
        for (int ti = 0; ti < 5; ++ti)
#pragma unroll
            for (int reg = 0; reg < 16; ++reg) {
                const int e = 32 * ti + (reg & 3) + 8 * (reg >> 2);
                const float sv = (e >= lo0 && e < lo + 128) ? ST[ti][reg] : -3.0e38f; ST[ti][reg] = sv; mx = fmaxf(mx, sv);
            }
    }
    mx = fmaxf(mx, __shfl_xor(mx, 32));
    float lsum = 0.f;
#pragma unroll
    for (int ti = 0; ti < 5; ++ti)
#pragma unroll
        for (int reg = 0; reg < 16; ++reg) { const float e = __expf(ST[ti][reg] - mx); ST[ti][reg] = e; lsum += e; }
    lsum += __shfl_xor(lsum, 32);
    lsum += __expf(sink - mx);
    const float rl = 1.0f / lsum;
    f32x16 OT[2];
    for (int i = 0; i < 16; ++i) { OT[0][i] = 0.f; OT[1][i] = 0.f; }
#pragma unroll
    for (int ti = 0; ti < 5; ++ti) {
        const int sj = 32 * (wave + ti) + r; int pos = blk * 128 - 128 + sj; pos = pos < 0 ? 0 : pos;
        const bf16_t* vp = VA + (size_t)(b * SEQ + pos) * 128 + kvh * 64 + 8 * h;
        bf16x8 vf[4];
#pragma unroll
        for (int s = 0; s < 4; ++s) vf[s] = as_bf16x8(ldg16(vp + 16 * s));
        u32x4 pb[2];
#pragma unroll
        for (int s2 = 0; s2 < 2; ++s2) {
            pb[s2].x = pack_bf16(ST[ti][8 * s2 + 0] * rl, ST[ti][8 * s2 + 1] * rl); pb[s2].y = pack_bf16(ST[ti][8 * s2 + 2] * rl, ST[ti][8 * s2 + 3] * rl);
            pb[s2].z = pack_bf16(ST[ti][8 * s2 + 4] * rl, ST[ti][8 * s2 + 5] * rl); pb[s2].w = pack_bf16(ST[ti][8 * s2 + 6] * rl, ST[ti][8 * s2 + 7] * rl);
        }
#pragma unroll
        for (int db = 0; db < 2; ++db) {
            f32x16 vt; for (int i = 0; i < 16; ++i) vt[i] = 0.f;
            vt = mfma32(vf[2 * db], sel[0], vt); vt = mfma32(vf[2 * db + 1], sel[1], vt);
#pragma unroll
            for (int s2 = 0; s2 < 2; ++s2) {
                u32x4 va; va.x = pack_bf16(vt[8 * s2 + 0], vt[8 * s2 + 1]); va.y = pack_bf16(vt[8 * s2 + 2], vt[8 * s2 + 3]);
                va.z = pack_bf16(vt[8 * s2 + 4], vt[8 * s2 + 5]); va.w = pack_bf16(vt[8 * s2 + 6], vt[8 * s2 + 7]);
                OT[db] = mfma32(as_bf16x8(va), as_bf16x8(pb[s2]), OT[db]);
            }
        }
    }
#pragma unroll
    for (int db = 0; db < 2; ++db)
#pragma unroll
        for (int q4 = 0; q4 < 4; ++q4) {
            u32x2 w; w.x = pack_bf16(OT[db][4 * q4], OT[db][4 * q4 + 1]); w.y = pack_bf16(OT[db][4 * q4 + 2], OT[db][4 * q4 + 3]);
            *(u32x2*)(ATT + (size_t)tokq * 1024 + hq * 64 + 32 * db + 8 * q4 + 4 * h) = w;
        }
}

template <int MODE> DI void p2_attention(const Params& p, unsigned char* lds, int cidx = 0) {
    const int G = gridDim.x, bi = blockIdx.x, rounds = (1024 + G - 1) / G;
    for (int b = 0; b < BATCH; ++b)
        for (int r = 0; r < rounds; ++r) {
            const int idx = (r & 1) ? r * G + (G - 1 - bi) : r * G + bi;
            if (idx < 1024) p2_dsa_item<MODE>(p, lds, b, 1023 - idx);
        }
    if (MODE & 8) for (int item2 = bi; item2 < NSWA; item2 += G) p2_swa_item(p, item2);
}

DI void p3_outproj(const Params& p, unsigned char* lds) {
    unsigned char* ws = p.ws;
    const bf16_t* ATT = (const bf16_t*)(ws + WS_ATT); const bf16_t* WT = (const bf16_t*)(ws + WS_WOT);
    const int tid = threadIdx.x, lane = tid & 63, wave = tid >> 6, wm = wave >> 1, wn = wave & 1, c = lane & 15, g = lane >> 4;
    constexpr int NT = 8, MT = NTOK / 128;
    int mt, nt;
    for (int k = 0; tile_of(k, NT, MT, mt, nt); ++k) {
        f32x4 acc[4][4];
        gemm_128x128(ATT + (size_t)mt * 128 * 1024, 1024, WT + (size_t)nt * 128 * 1024, 1024, 1024, lds, acc);
#pragma unroll
        for (int m = 0; m < 4; ++m) {
            const int tok = mt * 128 + wm * 64 + m * 16 + c;
#pragma unroll
            for (int n = 0; n < 4; ++n) {
                const size_t o = (size_t)tok * 1024 + nt * 128 + wn * 64 + 16 * n + 4 * g;
                const u32x2 xw = *(const u32x2*)((const bf16_t*)(ws + WS_XB) + o);
                const f32x4 xv = {bf_lo(xw.x), bf_hi(xw.x), bf_lo(xw.y), bf_hi(xw.y)};
                const f32x4 hv = xv * ALPHA + acc[m][n];
                u32x2 w; w.x = pack_bf16(hv[0], hv[1]); w.y = pack_bf16(hv[2], hv[3]);
                *(u32x2*)((bf16_t*)p.out + o) = w;
            }
        }
    }
}

DI void p3b_ln1(const Params& p) {
    bf16_t* H1B = (bf16_t*)(p.ws + WS_XB); const bf16_t* HP = (const bf16_t*)p.out;
    const int lane = threadIdx.x & 63, gw = blockIdx.x * 4 + (threadIdx.x >> 6), nw = gridDim.x * 4;
    for (int row = gw; row < NTOK; row += nw) {
        const u32x4 ra = ldg16(HP + (size_t)row * 1024 + lane * 16), rb = ldg16(HP + (size_t)row * 1024 + lane * 16 + 8);
        float v[16];
        v[0] = bf_lo(ra.x); v[1] = bf_hi(ra.x); v[2] = bf_lo(ra.y); v[3] = bf_hi(ra.y); v[4] = bf_lo(ra.z); v[5] = bf_hi(ra.z); v[6] = bf_lo(ra.w); v[7] = bf_hi(ra.w);
        v[8] = bf_lo(rb.x); v[9] = bf_hi(rb.x); v[10] = bf_lo(rb.y); v[11] = bf_hi(rb.y); v[12] = bf_lo(rb.z); v[13] = bf_hi(rb.z); v[14] = bf_lo(rb.w); v[15] = bf_hi(rb.w);
        float s = 0.f;
#pragma unroll
        for (int i = 0; i < 16; ++i) s += v[i];
        const float mu = wave_sum(s) * (1.f / 1024.f); float q = 0.f;
#pragma unroll
        for (int i = 0; i < 16; ++i) { const float d = v[i] - mu; q = fmaf(d, d, q); }
        const float rstd = rsqrtf(wave_sum(q) * (1.f / 1024.f) + LN_EPS);
        u32x4 oa, ob;
#pragma unroll
        for (int k4 = 0; k4 < 4; ++k4) {
            const int col = lane * 16 + k4 * 4;
            const f32x4 gg = *(const f32x4*)(p.ln1_g + col), bb = *(const f32x4*)(p.ln1_b + col);
            float o[4];
#pragma unroll
            for (int e = 0; e < 4; ++e) o[e] = (v[k4 * 4 + e] - mu) * rstd * gg[e] + bb[e];
            const unsigned w0 = pack_bf16(o[0], o[1]), w1 = pack_bf16(o[2], o[3]);
            if (k4 == 0) { oa.x = w0; oa.y = w1; } else if (k4 == 1) { oa.z = w0; oa.w = w1; } else if (k4 == 2) { ob.x = w0; ob.y = w1; } else { ob.z = w0; ob.w = w1; }
        }
        *(u32x4*)(H1B + (size_t)row * 1024 + lane * 16) = oa; *(u32x4*)(H1B + (size_t)row * 1024 + lane * 16 + 8) = ob;
    }
}

DI int f2key(float v) { const int b = __float_as_int(v); return b ^ ((b >> 31) & 0x7fffffff); }
DI float key2f(int k) { return __int_as_float(k ^ ((k >> 31) & 0x7fffffff)); }
DI void ce_desc(int& a, int& b) { const int hi = a > b ? a : b, lo = a > b ? b : a; a = hi; b = lo; }
DI void bitonic_merge16(int (&k)[16]) {
#pragma unroll
    for (int d = 8; d >= 1; d >>= 1)
#pragma unroll
        for (int i = 0; i < 16; ++i) if ((i & d) == 0) ce_desc(k[i], k[i | d]);
}
DI void bitonic_sort16(int (&k)[16]) {
#pragma unroll
    for (int sz = 2; sz <= 16; sz <<= 1) {
#pragma unroll
        for (int i = 0; i < 16; ++i) { const int j = i ^ (sz - 1); if (j > i) ce_desc(k[i], k[j]); }
#pragma unroll
        for (int d = sz >> 2; d >= 1; d >>= 1)
#pragma unroll
            for (int i = 0; i < 16; ++i) if ((i & d) == 0) ce_desc(k[i], k[i | d]);
    }
}
DI void top16_merge(int (&t)[16], const int (&sdesc)[16]) {
#pragma unroll
    for (int i = 0; i < 16; ++i) t[i] = t[i] > sdesc[15 - i] ? t[i] : sdesc[15 - i];
    bitonic_merge16(t);
}
constexpr int P4_QS = 32768, P4_SS_STRIDE = 132, P4_ST0 = 67584  , P4_M = 0  , P4_ST1 = 8704  ;

DI void p4_peer_query(const Params& p, unsigned char* lds) {
    unsigned char* ws = p.ws;
    const bf16_t* H1B = (const bf16_t*)(ws + WS_XB); const bf16_t* WQT = (const bf16_t*)(ws + WS_WQT); const bf16_t* SK = (const bf16_t*)(ws + WS_SK);
    unsigned short* PE = (unsigned short*)(ws + WS_PE); float* PG = (float*)(ws + WS_PG); float* PS = (float*)(ws + WS_PS);
    const float* SU = (const float*)(ws + WS_SU); const float* SV = (const float*)(ws + WS_SV);
    float* Ss = (float*)lds;
    float* st0 = (float*)(lds + P4_ST0); float* mbuf = (float*)(lds + P4_M); float* st1 = (float*)(lds + P4_ST1);
    constexpr int MT = NTOK / 128;
    int mt, head;
    for (int k = 0; tile_of(k, 8, MT, mt, head); ++k) {
        int tid = threadIdx.x; asm volatile("" : "+v"(tid));
        const int lane = tid & 63, wave = tid >> 6, wm = wave >> 1, wn = wave & 1, c = lane & 15, g = lane >> 4;
        const int lrow = tid >> 3, lch = tid & 7;
        const int srow = tid & 127, shalf = tid >> 7;
#pragma unroll 1
        for (int ph = 0; ph < 2; ++ph) {
            f32x4 acc[4][4];
            gemm_128x128(H1B + (size_t)mt * 128 * 1024, 1024, WQT + (size_t)(head * 256 + ph * 128) * 1024, 1024, 1024, lds, acc);
            __syncthreads();
#pragma unroll
            for (int m = 0; m < 4; ++m)
#pragma unroll
                for (int n = 0; n < 4; ++n) {
                    const int row = wm * 64 + m * 16 + c;
                    u32x2 w; w.x = pack_bf16(acc[m][n][0], acc[m][n][1]); w.y = pack_bf16(acc[m][n][2], acc[m][n][3]);
                    *(u32x2*)(lds + P4_QS + wn * 16384 + row * 128 + (((2 * n + (g >> 1)) ^ (row & 7)) << 4) + (g & 1) * 8) = w;
                }
            {
                const bf16_t* sp = SK + (size_t)((head * 2 + ph) * 128 + lrow) * 128 + lch * 8;
#pragma unroll
                for (int k2 = 0; k2 < 2; ++k2)
#pragma unroll
                    for (int i = 0; i < 4; ++i) *(u32x4*)(lds + k2 * 16384 + (lrow + 32 * i) * 128 + ((lch ^ (lrow & 7)) << 4)) = ldg16(sp + (size_t)(32 * i) * 128 + k2 * 64);
            }
            __syncthreads();
            f32x4 a2[4][4];
#pragma unroll
            for (int m = 0; m < 4; ++m)
#pragma unroll
                for (int n = 0; n < 4; ++n) a2[m][n] = (f32x4){0.f, 0.f, 0.f, 0.f};
#pragma unroll
            for (int k2 = 0; k2 < 2; ++k2)
#pragma unroll
                for (int s = 0; s < 2; ++s) {
                    bf16x8 xf[4], wf[4];
#pragma unroll
                    for (int m = 0; m < 4; ++m) { const int row = wm * 64 + m * 16 + c; xf[m] = as_bf16x8(*(const u32x4*)(lds + P4_QS + k2 * 16384 + row * 128 + (((4 * s + g) ^ (c & 7)) << 4))); }
#pragma unroll
                    for (int n = 0; n < 4; ++n) { const int row = wn * 64 + n * 16 + c; wf[n] = as_bf16x8(*(const u32x4*)(lds + k2 * 16384 + row * 128 + (((4 * s + g) ^ (c & 7)) << 4))); }
#pragma unroll
                    for (int m = 0; m < 4; ++m)
#pragma unroll
                        for (int n = 0; n < 4; ++n) a2[m][n] = mfma16(wf[n], xf[m], a2[m][n]);
                }
            __syncthreads();
#pragma unroll
            for (int m = 0; m < 4; ++m)
#pragma unroll
                for (int n = 0; n < 4; ++n) {
                    const int key0 = wn * 64 + 16 * n + 4 * g;
                    u32x4 w;
#pragma unroll
                    for (int r = 0; r < 4; ++r) w[r] = (unsigned)f2key(__uint_as_float((__float_as_uint(a2[m][n][r]) & 0xFFFFFF80u) | (unsigned)(key0 + r)));
                    *(u32x4*)(Ss + (wm * 64 + m * 16 + c) * P4_SS_STRIDE + key0) = w;
                }
            __syncthreads();
            int tv[16];
            {
                const int* rowp = (const int*)Ss + srow * P4_SS_STRIDE + shalf * 64;
#pragma unroll
                for (int bt = 0; bt < 4; ++bt) {
                    int bk[16];
#pragma unroll
                    for (int j = 0; j < 4; ++j) { const u32x4 v = *(const u32x4*)(rowp + 16 * bt + 4 * j); bk[4 * j] = (int)v.x; bk[4 * j + 1] = (int)v.y; bk[4 * j + 2] = (int)v.z; bk[4 * j + 3] = (int)v.w; }
                    bitonic_sort16(bk);
                    if (bt == 0) {
#pragma unroll
                        for (int j = 0; j < 16; ++j) tv[j] = bk[j];
                    } else top16_merge(tv, bk);
                }
            }
            __syncthreads();
            int* mbi = (int*)mbuf;
            if (shalf == 1) {
#pragma unroll
                for (int j = 0; j < 16; ++j) mbi[srow * 17 + j] = tv[j];
            }
            __syncthreads();
            if (shalf == 0) {
                int* dst = (int*)((ph == 0) ? st0 : st1);
                int ob[16];
#pragma unroll
                for (int j = 0; j < 16; ++j) ob[j] = mbi[srow * 17 + j];
                top16_merge(tv, ob);
#pragma unroll
                for (int j = 0; j < 16; ++j) dst[srow * 17 + j] = tv[j];
            }
        }
        __syncthreads();
        int cv[16];
        {
            const int* st0i = (const int*)st0; const int* st1i = (const int*)st1;
            float v2[16];
#pragma unroll
            for (int b = 0; b < 16; ++b) v2[b] = key2f(st1i[srow * 17 + b]);
#pragma unroll
            for (int a8 = 0; a8 < 8; ++a8) {
                const int a = shalf * 8 + a8; const float va = key2f(st0i[srow * 17 + a]);
                int bk[16];
#pragma unroll
                for (int b = 0; b < 16; ++b) bk[b] = (f2key(va + v2[b]) & (int)0xFFFFFF00) | (a * 16 + 15 - b);
                if (a8 == 0) {
#pragma unroll
                    for (int j = 0; j < 16; ++j) cv[j] = bk[j];
                } else top16_merge(cv, bk);
            }
        }
        __syncthreads();
        int* mbi = (int*)mbuf;
        if (shalf == 1) {
#pragma unroll
            for (int j = 0; j < 16; ++j) mbi[srow * 17 + j] = cv[j];
        }
        __syncthreads();
        if (shalf == 0) {
            const int* st0i = (const int*)st0; const int* st1i = (const int*)st1;
            int fk[16]; float fv[16];
#pragma unroll
            for (int j = 0; j < 16; ++j) { const int o = mbi[srow * 17 + 15 - j]; fk[j] = cv[j] > o ? cv[j] : o; fv[j] = key2f(fk[j]); }
            float cmax = fv[0];
#pragma unroll
            for (int j = 1; j < 16; ++j) cmax = fmaxf(cmax, fv[j]);
            float den = 0.f; float ev[16];
#pragma unroll
            for (int j = 0; j < 16; ++j) { ev[j] = __expf(fv[j] - cmax); den += ev[j]; }
            const float rden = 1.0f / den;
            const size_t ob = (size_t)(mt * 128 + srow) * 128 + head * 16;
#pragma unroll
            for (int j = 0; j < 16; ++j) {
                const unsigned cde = (unsigned)fk[j] & 0xFFu;
                const unsigned a = cde >> 4, b = 15u - (cde & 15u);
                const unsigned i1 = __float_as_uint(key2f(st0i[srow * 17 + a])) & 0x7Fu, i2 = __float_as_uint(key2f(st1i[srow * 17 + b])) & 0x7Fu;
                const int e = (int)(i1 * 128u + i2);
                PE[ob + j] = (unsigned short)e; PG[ob + j] = ev[j] * rden * SV[e]; PS[ob + j] = SU[e];
            }
        }
        __syncthreads();
    }
}

DI float gelu_exact(float z) { return 0.5f * z * (1.0f + erff(z * 0.70710678118654752f)); }
DI float rdlane(float v, int l) { return __int_as_float(__builtin_amdgcn_readlane(__float_as_int(v), l)); }

DI void p5_gather(const Params& p) {
    unsigned char* ws = p.ws;
    const bf16_t* H1B = (const bf16_t*)(ws + WS_XB); const unsigned char* UT = ws + WS_UT; const unsigned char* VT = ws + WS_VT;
    const unsigned short* PE = (const unsigned short*)(ws + WS_PE); const float* PG = (const float*)(ws + WS_PG); const float* PS = (const float*)(ws + WS_PS);
    const int lane = threadIdx.x & 63, gw = blockIdx.x * 4 + (threadIdx.x >> 6), nw = gridDim.x * 4;
    const bool b5 = (lane & 32) != 0, b4 = (lane & 16) != 0, b3 = (lane & 8) != 0, b2 = (lane & 4) != 0, b1 = (lane & 2) != 0;
    for (int tok = gw; tok < NTOK; tok += nw) {
        float x[16], acc[16];
        {
            const u32x4 xa = ldg16(H1B + (size_t)tok * 1024 + lane * 16), xb = ldg16(H1B + (size_t)tok * 1024 + lane * 16 + 8);
            x[0] = bf_lo(xa.x); x[1] = bf_hi(xa.x); x[2] = bf_lo(xa.y); x[3] = bf_hi(xa.y); x[4] = bf_lo(xa.z); x[5] = bf_hi(xa.z); x[6] = bf_lo(xa.w); x[7] = bf_hi(xa.w);
            x[8] = bf_lo(xb.x); x[9] = bf_hi(xb.x); x[10] = bf_lo(xb.y); x[11] = bf_hi(xb.y); x[12] = bf_lo(xb.z); x[13] = bf_hi(xb.z); x[14] = bf_lo(xb.w); x[15] = bf_hi(xb.w);
        }
#pragma unroll
        for (int i = 0; i < 16; ++i) acc[i] = 0.f;
        const int pe_lo = (int)PE[(size_t)tok * 128 + lane], pe_hi = (int)PE[(size_t)tok * 128 + 64 + lane];
        const float pg_lo = PG[(size_t)tok * 128 + lane], pg_hi = PG[(size_t)tok * 128 + 64 + lane];
        const float ps_lo = PS[(size_t)tok * 128 + lane], ps_hi = PS[(size_t)tok * 128 + 64 + lane];
#pragma unroll 1
        for (int hb = 0; hb < 4; ++hb) {
            const int pes = hb < 2 ? pe_lo : pe_hi; const float pgs = hb < 2 ? pg_lo : pg_hi, pss = hb < 2 ? ps_lo : ps_hi;
            const int lb = (hb & 1) * 32;
            float d[32];
            u32x2 uw[32];
#pragma unroll
            for (int j = 0; j < 32; ++j) { const int e = __builtin_amdgcn_readlane(pes, lb + j); uw[j] = *(const u32x2*)(UT + (size_t)e * 512 + lane * 8); }
#pragma unroll
            for (int j4 = 0; j4 < 8; ++j4) {
                f32x2 a0 = {0.f, 0.f}, a1 = {0.f, 0.f}, a2 = {0.f, 0.f}, a3 = {0.f, 0.f};
#define P5_DOT4(k, bs) { const f32x2 xx = {x[8 * (k) + 2 * (bs)], x[8 * (k) + 2 * (bs) + 1]}; \
                    const f32x2 f0 = __builtin_amdgcn_cvt_scalef32_pk_f32_fp4(uw[4 * j4][k], 1.0f, bs), f1 = __builtin_amdgcn_cvt_scalef32_pk_f32_fp4(uw[4 * j4 + 1][k], 1.0f, bs); \
                    const f32x2 f2 = __builtin_amdgcn_cvt_scalef32_pk_f32_fp4(uw[4 * j4 + 2][k], 1.0f, bs), f3 = __builtin_amdgcn_cvt_scalef32_pk_f32_fp4(uw[4 * j4 + 3][k], 1.0f, bs); \
                    a0 = xx * f0 + a0; a1 = xx * f1 + a1; a2 = xx * f2 + a2; a3 = xx * f3 + a3; }
                P5_DOT4(0, 0) P5_DOT4(0, 1) P5_DOT4(0, 2) P5_DOT4(0, 3) P5_DOT4(1, 0) P5_DOT4(1, 1) P5_DOT4(1, 2) P5_DOT4(1, 3)
                d[4 * j4] = a0.x + a0.y; d[4 * j4 + 1] = a1.x + a1.y; d[4 * j4 + 2] = a2.x + a2.y; d[4 * j4 + 3] = a3.x + a3.y;
            }
            float r16[16], r8[8], r4[4], r2[2], r1;
#pragma unroll
            for (int j = 0; j < 16; ++j) { const float keep = b5 ? d[j + 16] : d[j], send = b5 ? d[j] : d[j + 16]; r16[j] = keep + __shfl_xor(send, 32); }
#pragma unroll
            for (int j = 0; j < 8; ++j) { const float keep = b4 ? r16[j + 8] : r16[j], send = b4 ? r16[j] : r16[j + 8]; r8[j] = keep + __shfl_xor(send, 16); }
#pragma unroll
            for (int j = 0; j < 4; ++j) { const float keep = b3 ? r8[j + 4] : r8[j], send = b3 ? r8[j] : r8[j + 4]; r4[j] = keep + __shfl_xor(send, 8); }
#pragma unroll
            for (int j = 0; j < 2; ++j) { const float keep = b2 ? r4[j + 2] : r4[j], send = b2 ? r4[j] : r4[j + 2]; r2[j] = keep + __shfl_xor(send, 4); }
            { const float keep = b1 ? r2[1] : r2[0], send = b1 ? r2[0] : r2[1]; r1 = keep + __shfl_xor(send, 2); }
            r1 += __shfl_xor(r1, 1);
            const int mine = lb + ((lane >> 1) & 31);
            const float coef = gelu_exact(r1 * __shfl(pss, mine)) * __shfl(pgs, mine);
#pragma unroll
            for (int j = 0; j < 32; ++j) {
                const int e = __builtin_amdgcn_readlane(pes, lb + j);
                const float cj = rdlane(coef, 2 * j);
                const u32x2 vw = *(const u32x2*)(VT + (size_t)e * 512 + lane * 8);
#define P5_AXPY(k, bs) { const f32x2 f = __builtin_amdgcn_cvt_scalef32_pk_f32_fp4(vw[k], 1.0f, bs); acc[8 * (k) + 2 * (bs)] = fmaf(cj, f.x, acc[8 * (k) + 2 * (bs)]); acc[8 * (k) + 2 * (bs) + 1] = fmaf(cj, f.y, acc[8 * (k) + 2 * (bs) + 1]); }
                P5_AXPY(0, 0) P5_AXPY(0, 1) P5_AXPY(0, 2) P5_AXPY(0, 3) P5_AXPY(1, 0) P5_AXPY(1, 1) P5_AXPY(1, 2) P5_AXPY(1, 3)
            }
        }
        float s = 0.f;
#pragma unroll
        for (int i = 0; i < 16; ++i) { acc[i] = fmaf(ALPHA, x[i], acc[i]); s += acc[i]; }
        const float mu = wave_sum(s) * (1.f / 1024.f); float q = 0.f;
#pragma unroll
        for (int i = 0; i < 16; ++i) { const float dd = acc[i] - mu; q = fmaf(dd, dd, q); }
        const float rstd = rsqrtf(wave_sum(q) * (1.f / 1024.f) + LN_EPS);
#pragma unroll
        for (int k4 = 0; k4 < 4; ++k4) {
            const int col = lane * 16 + k4 * 4;
            const f32x4 gg = *(const f32x4*)(p.ln2_g + col), bb = *(const f32x4*)(p.ln2_b + col);
            f32x4 o;
#pragma unroll
            for (int e = 0; e < 4; ++e) o[e] = (acc[k4 * 4 + e] - mu) * rstd * gg[e] + bb[e];
            *(f32x4*)(p.out + (size_t)tok * 1024 + col) = o;
        }
    }
}

#define XB_TMO      128
#define XB_XCNT(j)  (256  + 64 * (j))
#define XB_XSUB(j)  (1280 + 64 * (j))
#define XB_XGEN(j)  (2304 + 64 * (j))
#define XB_TOP      3328
#define XB_TOPGEN   3392
#define XCD_BAR_WORDS 3456
#define XB_SPIN_CAP (1u << 22)
#define LAS __attribute__((address_space(3)))
DI unsigned xb_ld(unsigned* p)              { return __hip_atomic_load(p, __ATOMIC_RELAXED, __HIP_MEMORY_SCOPE_AGENT); }
DI unsigned xb_add(unsigned* p, unsigned v) { return __hip_atomic_fetch_add(p, v, __ATOMIC_RELAXED, __HIP_MEMORY_SCOPE_AGENT); }
DI unsigned xb_xcc_id() { return (unsigned)__builtin_amdgcn_s_getreg((3 << 11) | 20) & 0xFu; }
#define XB_SPIN(cond, bar) do { unsigned _sp = 0; while (cond) { __builtin_amdgcn_s_sleep(1); \
    if ((++_sp & 255u) == 0u) { if (xb_ld(&(bar)[XB_TMO])) break; if (_sp > XB_SPIN_CAP) { atomicAdd(&(bar)[XB_TMO], 1u); break; } } } } while (0)
struct XcdBarrier { unsigned* bar; unsigned x; volatile LAS unsigned* st; };
DI XcdBarrier xcd_barrier_post(unsigned* bar, volatile LAS unsigned* st) {
    XcdBarrier b; b.bar = bar; b.x = xb_xcc_id(); b.st = st;
    if (threadIdx.x == 0) (void)xb_add(&bar[XB_XCNT(b.x)], 1u);
    return b;
}
DI void xcd_barrier_complete(unsigned* bar, unsigned x, unsigned& nloc, unsigned& nx) {
    const unsigned G = gridDim.x * gridDim.y * gridDim.z;
    unsigned sum, cnt, mine, sp = 0u;
    for (;;) {
        sum = 0u; cnt = 0u; mine = 0u;
#pragma unroll
        for (unsigned j = 0; j < 16; ++j) { const unsigned c = xb_ld(&bar[XB_XCNT(j)]); sum += c; cnt += (c > 0u) ? 1u : 0u; mine = (j == x) ? c : mine; }
        if (sum == G) break;
        __builtin_amdgcn_s_sleep(1);
        if ((++sp & 255u) == 0u) { if (xb_ld(&bar[XB_TMO])) break; if (sp > XB_SPIN_CAP) { atomicAdd(&bar[XB_TMO], 1u); break; } }
    }
    nloc = mine > 0u ? mine : 1u; nx = cnt > 0u ? cnt : 1u;
}
DI void xcd_barrier(const XcdBarrier& b) {
    asm volatile("s_waitcnt vmcnt(0)" ::: "memory");
    __syncthreads();
    if (threadIdx.x == 0) {
        unsigned* bar = b.bar;
        __builtin_amdgcn_s_waitcnt(0);
        unsigned nloc = b.st[0], nx = b.st[1];
        if (nloc == 0u) { xcd_barrier_complete(bar, b.x, nloc, nx); b.st[0] = nloc; b.st[1] = nx; }
        const unsigned old = xb_add(&bar[XB_XSUB(b.x)], 1u);
        const unsigned gen = old / nloc;
        if (old + 1u == (gen + 1u) * nloc) {
            __builtin_amdgcn_fence(__ATOMIC_RELEASE, "agent");
            asm volatile("s_waitcnt vmcnt(0)" ::: "memory");
            const unsigned og = xb_add(&bar[XB_TOP], 1u);
            const unsigned tg = og / nx;
            if (og + 1u == (tg + 1u) * nx) xb_add(&bar[XB_TOPGEN], 1u);
            else XB_SPIN(xb_ld(&bar[XB_TOPGEN]) == tg, bar);
            __builtin_amdgcn_fence(__ATOMIC_ACQUIRE, "agent");
            xb_add(&bar[XB_XGEN(b.x)], 1u);
            asm volatile("s_waitcnt vmcnt(0)" ::: "memory");
        } else {
            XB_SPIN(xb_ld(&bar[XB_XGEN(b.x)]) == gen, bar);
            __builtin_amdgcn_fence(__ATOMIC_ACQUIRE, "agent");
            asm volatile("s_waitcnt vmcnt(0)" ::: "memory");
        }
    }
    __syncthreads();
}

constexpr int NPHASE = 7;
__global__ void __launch_bounds__(NTHREADS, 2) mega_fwd(Params p) {
    extern __shared__ __attribute__((aligned(16))) unsigned char lds[];
    cg::grid_group grid = cg::this_grid();
    const int lo = p.ph_lo, hi = p.ph_hi;
    volatile LAS unsigned* xbst = (volatile LAS unsigned*)(LAS unsigned char*)(lds + LDS_BYTES - 16);
#ifndef REP_MASK
#define REP_MASK 0
#endif
#ifndef P2_PROBE_MODE
#define P2_PROBE_MODE 15
#endif
#ifndef PH_MASK
#define PH_MASK 127
#endif
    if (lo == 0x7fffffff) grid.sync();
    if (threadIdx.x == 0) { xbst[0] = 0u; xbst[1] = 0u; }
    __syncthreads();
    XcdBarrier xb = xcd_barrier_post((unsigned*)(p.ws + WS_BAR), xbst);
#define GSYNC() xcd_barrier(xb)
    p0_prep(p, lds);
    GSYNC();
#define RUN_PHASE(k, call) { call; if ((REP_MASK >> (k)) & 1) { GSYNC(); call; } }
#if PH_MASK & 2
    RUN_PHASE(1, p1_inproj(p, lds))
#endif
    GSYNC();
#if PH_MASK & 4
#if (REP_MASK >> 2) & 1
    p2a_indexer(p, lds); GSYNC(); p2_attention<P2_PROBE_MODE>(p, lds, 1); GSYNC();
#endif
    p2a_indexer(p, lds);
    GSYNC();
    p2_attention<15>(p, lds, 0);
#endif
    GSYNC();
#if PH_MASK & 8
    RUN_PHASE(3, p3_outproj(p, lds))
#endif
    GSYNC();
#if PH_MASK & 16
    RUN_PHASE(4, p3b_ln1(p))
#endif
    GSYNC();
#if PH_MASK & 32
    RUN_PHASE(5, p4_peer_query(p, lds))
#endif
    GSYNC();
#if PH_MASK & 64
    RUN_PHASE(6, p5_gather(p))
#endif
}

#ifndef MK_N_LAUNCHES
#define MK_N_LAUNCHES 1
#endif

extern "C" void kernel_launch(void* const* d_in, const int* in_sizes, int n_in, void* d_out, int out_size, void* d_ws, size_t ws_size, hipStream_t stream) {
    static int grid_blocks = 0;
    if (grid_blocks == 0) {
        if (n_in != 14 || out_size != NTOK * D_MODEL || ws_size < WS_END) {
            fprintf(stderr, "kernel_launch: unexpected problem (n_in %d, out %d, ws %zu, need %zu)\n", n_in, out_size, ws_size, (size_t)WS_END); grid_blocks = -1; return;
        }
        int dev = 0, cus = 0, per_cu = 0;
        hipGetDevice(&dev);
        hipDeviceGetAttribute(&cus, hipDeviceAttributeMultiprocessorCount, dev);
        if (hipFuncSetAttribute((const void*)mega_fwd, hipFuncAttributeMaxDynamicSharedMemorySize, LDS_BYTES) != hipSuccess) { fprintf(stderr, "kernel_launch: hipFuncSetAttribute failed\n"); }
        if (hipOccupancyMaxActiveBlocksPerMultiprocessor(&per_cu, (const void*)mega_fwd, NTHREADS, LDS_BYTES) != hipSuccess || per_cu < 1) { fprintf(stderr, "kernel_launch: occupancy query failed\n"); per_cu = 1; }
        if (per_cu > 2) per_cu = 2;
        (void)hipGetLastError();
        grid_blocks = cus * per_cu;
        fprintf(stderr, "kernel_launch: %d CUs x %d blocks\n", cus, per_cu);
    }
    if (grid_blocks < 0) return;
    Params p{};
    p.x = (const float*)d_in[0]; p.w_in = (const float*)d_in[1]; p.idx_k_g = (const float*)d_in[2]; p.idx_k_b = (const float*)d_in[3]; p.sinks = (const float*)d_in[4];
    p.w_o = (const float*)d_in[5]; p.ln1_g = (const float*)d_in[6]; p.ln1_b = (const float*)d_in[7]; p.peer_wq = (const float*)d_in[8]; p.peer_subkeys = (const float*)d_in[9];
    p.peer_u = (const float*)d_in[10]; p.peer_v = (const float*)d_in[11]; p.ln2_g = (const float*)d_in[12]; p.ln2_b = (const float*)d_in[13];
    p.out = (float*)d_out; p.ws = (unsigned char*)d_ws;
    p.ph_lo = 0; p.ph_hi = NPHASE;
    if (hipMemsetAsync((unsigned char*)d_ws + WS_BAR, 0, XCD_BAR_WORDS * 4, stream) != hipSuccess) { fprintf(stderr, "kernel_launch: memset of the barrier words failed\n"); return; }
    void* args[] = {&p};
    hipError_t e = hipLaunchCooperativeKernel((const void*)mega_fwd, dim3(grid_blocks), dim3(NTHREADS), args, LDS_BYTES, stream);
    if (e != hipSuccess) fprintf(stderr, "cooperative launch failed: %s (grid %d)\n", hipGetErrorString(e), grid_blocks);
}
```

```cpp
#include <hip/hip_runtime.h>
#include <hip/hip_cooperative_groups.h>
#include <cstdio>
#include <cstdint>
namespace cg = cooperative_groups;

typedef unsigned short bf16_t;
typedef short bf16x8 __attribute__((ext_vector_type(8)));
typedef float f32x4 __attribute__((ext_vector_type(4)));
typedef float f32x16 __attribute__((ext_vector_type(16)));
typedef unsigned u32x4 __attribute__((ext_vector_type(4)));
typedef unsigned u32x2 __attribute__((ext_vector_type(2)));
#define DI __device__ __forceinline__

constexpr int D_MODEL = 1024, BATCH = 8, SEQ = 4096, NTOK = BATCH * SEQ;
constexpr int NMIX = 1732, NMIX_PAD = 1792;
constexpr int PEER_N = 2048;
constexpr float ALPHA = 1.189207115002721f;
constexpr float LN_EPS = 1e-5f;
constexpr int NTHREADS = 256;
constexpr int LDS_BYTES = 77824;

constexpr size_t MB = 1024 * 1024;
constexpr size_t WS_CTL   = 0;
constexpr size_t WS_BAR   = 65536;
constexpr size_t WS_ROPE  = 1 * MB;
constexpr size_t WS_WINT  = 2 * MB;
constexpr size_t WS_WOT   = 6 * MB;
constexpr size_t WS_WQT   = 8 * MB;
constexpr size_t WS_SK    = 12 * MB;
constexpr size_t WS_UT    = 13 * MB;
constexpr size_t WS_VT    = 29 * MB;
constexpr size_t WS_SU    = 45 * MB;
constexpr size_t WS_SV    = 46 * MB;
constexpr size_t WS_SX    = 47 * MB;
constexpr size_t WS_XB    = 77 * MB;
constexpr size_t WS_QA    = 141 * MB;
constexpr size_t WS_KA    = 173 * MB;
constexpr size_t WS_VA    = 181 * MB;
constexpr size_t WS_QB    = 189 * MB;
constexpr size_t WS_KB    = 221 * MB;
constexpr size_t WS_VB    = 225 * MB;
constexpr size_t WS_QI    = 229 * MB;
constexpr size_t WS_KI    = 245 * MB;
constexpr size_t WS_WI    = 249 * MB;
constexpr size_t WS_ATT   = 250 * MB;
constexpr size_t WS_PE    = 314 * MB;
constexpr size_t WS_PG    = 322 * MB;
constexpr size_t WS_PS    = 338 * MB;
constexpr size_t WS_END   = 354 * MB;

struct Params {
    const float* x; const float* w_in; const float* idx_k_g; const float* idx_k_b; const float* sinks; const float* w_o;
    const float* ln1_g; const float* ln1_b; const float* peer_wq; const float* peer_subkeys; const float* peer_u; const float* peer_v;
    const float* ln2_g; const float* ln2_b;
    float* out; unsigned char* ws;
    int ph_lo, ph_hi;
};

typedef float f32x2 __attribute__((ext_vector_type(2)));
typedef __bf16 bf16x2_t __attribute__((ext_vector_type(2)));
DI unsigned pack_bf16(float lo, float hi) { const f32x2 v = {lo, hi}; return __builtin_bit_cast(unsigned, __builtin_convertvector(v, bf16x2_t)); }
DI unsigned f2bf(float x) { return pack_bf16(x, 0.f) & 0xffffu; }
DI float bf_lo(unsigned w) { return __uint_as_float(w << 16); }
DI float bf_hi(unsigned w) { return __uint_as_float(w & 0xffff0000u); }
DI bf16x8 as_bf16x8(u32x4 v) { return __builtin_bit_cast(bf16x8, v); }
DI u32x4 ldg16(const void* p) { return *(const u32x4*)p; }
DI f32x4 mfma16(bf16x8 a, bf16x8 b, f32x4 c) { return __builtin_amdgcn_mfma_f32_16x16x32_bf16(a, b, c, 0, 0, 0); }
DI f32x16 mfma32(bf16x8 a, bf16x8 b, f32x16 c) { return __builtin_amdgcn_mfma_f32_32x32x16_bf16(a, b, c, 0, 0, 0); }
DI float wave_sum(float v) {
#pragma unroll
    for (int o = 32; o >= 1; o >>= 1) v += __shfl_xor(v, o);
    return v;
}

DI void glds16(const void* src, void* lds_dst) { __builtin_amdgcn_global_load_lds((const unsigned*)src, (__attribute__((address_space(3))) unsigned*)lds_dst, 16, 0, 0); }
DI void gemm_128x128(const bf16_t* __restrict__ X, int ldx, const bf16_t* __restrict__ Wt, int ldw, int K, unsigned char* lds, f32x4 (&acc)[4][4]) {
    int tid = threadIdx.x; asm volatile("" : "+v"(tid));
    const int lane = tid & 63, wave = tid >> 6, wm = wave >> 1, wn = wave & 1, c = lane & 15, g = lane >> 4;
    const int lrow = tid >> 3, lch = tid & 7;
    const bf16_t* xp = X + (size_t)lrow * ldx + ((lch ^ (lrow & 7)) * 8);
    const bf16_t* wp = Wt + (size_t)lrow * ldw + ((lch ^ (lrow & 7)) * 8);
    unsigned char* dst0 = lds + tid * 16;
#pragma unroll
    for (int m = 0; m < 4; ++m)
#pragma unroll
        for (int n = 0; n < 4; ++n) acc[m][n] = (f32x4){0.f, 0.f, 0.f, 0.f};
    const int nk = K / 64;
    __syncthreads();
#pragma unroll
    for (int i = 0; i < 4; ++i) { glds16(xp + (size_t)(32 * i) * ldx, dst0 + i * 4096); glds16(wp + (size_t)(32 * i) * ldw, dst0 + 16384 + i * 4096); }
    asm volatile("s_waitcnt vmcnt(0)" ::: "memory");
    __syncthreads();
    for (int kt = 0; kt < nk; ++kt) {
        const unsigned char* Xs = lds + (kt & 1) * 32768; const unsigned char* Ws = Xs + 16384;
        if (kt + 1 < nk) {
            unsigned char* d = dst0 + ((kt + 1) & 1) * 32768;
#pragma unroll
            for (int i = 0; i < 4; ++i) { glds16(xp + (size_t)(32 * i) * ldx + (kt + 1) * 64, d + i * 4096); glds16(wp + (size_t)(32 * i) * ldw + (kt + 1) * 64, d + 16384 + i * 4096); }
        }
#pragma unroll
        for (int s = 0; s < 2; ++s) {
            bf16x8 xf[4], wf[4];
#pragma unroll
            for (int m = 0; m < 4; ++m) { const int row = wm * 64 + m * 16 + c; xf[m] = as_bf16x8(*(const u32x4*)(Xs + row * 128 + (((4 * s + g) ^ (c & 7)) << 4))); }
#pragma unroll
            for (int n = 0; n < 4; ++n) { const int row = wn * 64 + n * 16 + c; wf[n] = as_bf16x8(*(const u32x4*)(Ws + row * 128 + (((4 * s + g) ^ (c & 7)) << 4))); }
#pragma unroll
            for (int m = 0; m < 4; ++m)
#pragma unroll
                for (int n = 0; n < 4; ++n) acc[m][n] = mfma16(wf[n], xf[m], acc[m][n]);
        }
        asm volatile("s_waitcnt vmcnt(0)" ::: "memory");
        __syncthreads();
    }
}

DI bool tile_of(int k, int NT, int MT, int& mt, int& nt) {
    const int G = gridDim.x, bid = blockIdx.x;
    if (((G | MT) & 7) == 0) {
        const int idx = (bid >> 3) + k * (G >> 3);
        if (idx >= (MT >> 3) * NT) return false;
        mt = (idx / NT) * 8 + (bid & 7); nt = idx % NT;
    } else {
        const int t = bid + k * G;
        if (t >= MT * NT) return false;
        mt = t / NT; nt = t % NT;
    }
    return true;
}

DI void p0_prep(const Params& p, unsigned char* lds) {
    const int tid = threadIdx.x, nb = gridDim.x, bid = blockIdx.x;
    const size_t gtid = (size_t)bid * NTHREADS + tid, gsz = (size_t)nb * NTHREADS;
    unsigned char* ws = p.ws;
    {
        float* ct = (float*)(ws + WS_ROPE); float* stb = ct + SEQ * 32;
        for (size_t i = gtid; i < (size_t)SEQ * 32; i += gsz) {
            const int pos = (int)(i >> 5), fi = (int)(i & 31);
            const float inv = powf(10000.0f, -(float)(2 * fi) / 64.0f);
            const float ang = (float)pos * inv;
            ct[i] = cosf(ang); stb[i] = sinf(ang);
        }
    }
    auto conv = [&](const float* src, bf16_t* dst, size_t n) {
        for (size_t i = gtid * 8; i < n; i += gsz * 8) {
            const f32x4 a = *(const f32x4*)(src + i), b = *(const f32x4*)(src + i + 4);
            u32x4 o; o.x = pack_bf16(a.x, a.y); o.y = pack_bf16(a.z, a.w); o.z = pack_bf16(b.x, b.y); o.w = pack_bf16(b.z, b.w);
            *(u32x4*)(dst + i) = o;
        }
    };
    conv(p.x, (bf16_t*)(ws + WS_XB), (size_t)NTOK * D_MODEL);
    conv(p.peer_subkeys, (bf16_t*)(ws + WS_SK), (size_t)8 * 2 * 128 * 128);
    float* tl = (float*)lds;
    auto transp = [&](const float* src, bf16_t* dst, int N, int Npad) {
        const int tn = Npad / 64, tk = 1024 / 64;
        for (int t = bid; t < tn * tk; t += nb) {
            const int n0 = (t % tn) * 64, k0 = (t / tn) * 64;
            __syncthreads();
            for (int e = tid; e < 4096; e += NTHREADS) { const int kk = e >> 6, nn = e & 63; tl[kk * 65 + nn] = (n0 + nn < N) ? src[(size_t)(k0 + kk) * N + n0 + nn] : 0.f; }
            __syncthreads();
            for (int e = tid; e < 4096; e += NTHREADS) { const int nn = e >> 6, kk = e & 63; dst[(size_t)(n0 + nn) * 1024 + k0 + kk] = (bf16_t)f2bf(tl[kk * 65 + nn]); }
        }
    };
    transp(p.w_in, (bf16_t*)(ws + WS_WINT), NMIX, NMIX_PAD);
}

DI void p0_late(const Params& p, unsigned char* lds) {
    const int tid = threadIdx.x, nb = gridDim.x, bid = blockIdx.x;
    unsigned char* ws = p.ws;
    {
        const int lane = tid & 63, gw = bid * 4 + (tid >> 6), nw = nb * 4;
        for (int row0 = gw * 4; row0 < 2 * 16384; row0 += nw * 4) {
            f32x4 v[4][4];
#pragma unroll
            for (int r = 0; r < 4; ++r) {
                const int row = row0 + r; const bool isv = row >= 16384; const int e = isv ? row - 16384 : row;
                const float* src = (isv ? p.peer_v : p.peer_u) + (size_t)e * 1024 + lane * 16;
#pragma unroll
                for (int i = 0; i < 4; ++i) v[r][i] = *(const f32x4*)(src + 4 * i);
            }
#pragma unroll
            for (int r = 0; r < 4; ++r) {
                const int row = row0 + r; const bool isv = row >= 16384; const int e = isv ? row - 16384 : row;
                float mx = 0.f;
#pragma unroll
                for (int i = 0; i < 4; ++i) mx = fmaxf(mx, fmaxf(fmaxf(fabsf(v[r][i][0]), fabsf(v[r][i][1])), fmaxf(fabsf(v[r][i][2]), fabsf(v[r][i][3]))));
#pragma unroll
                for (int o = 32; o >= 1; o >>= 1) mx = fmaxf(mx, __shfl_xor(mx, o));
                const float sc = mx > 0.f ? mx * (1.0f / 5.99f) : 1.0f, inv = mx > 0.f ? 5.99f / mx : 1.0f;
                u32x2 o2;
#pragma unroll
                for (int k = 0; k < 2; ++k) {
                    unsigned w = 0;
                    w = __builtin_amdgcn_cvt_scalef32_pk_fp4_f32(w, v[r][2 * k][0] * inv, v[r][2 * k][1] * inv, 1.0f, 0);
                    w = __builtin_amdgcn_cvt_scalef32_pk_fp4_f32(w, v[r][2 * k][2] * inv, v[r][2 * k][3] * inv, 1.0f, 1);
                    w = __builtin_amdgcn_cvt_scalef32_pk_fp4_f32(w, v[r][2 * k + 1][0] * inv, v[r][2 * k + 1][1] * inv, 1.0f, 2);
                    w = __builtin_amdgcn_cvt_scalef32_pk_fp4_f32(w, v[r][2 * k + 1][2] * inv, v[r][2 * k + 1][3] * inv, 1.0f, 3);
                    o2[k] = w;
                }
                *(u32x2*)(ws + (isv ? WS_VT : WS_UT) + (size_t)e * 512 + lane * 8) = o2;
                if (lane == 0) ((float*)(ws + (isv ? WS_SV : WS_SU)))[e] = sc;
            }
        }
    }
    float* tl = (float*)lds;
    auto transp = [&](const float* src, bf16_t* dst, int N, int Npad) {
        const int tn = Npad / 64, tk = 1024 / 64;
        for (int t = bid; t < tn * tk; t += nb) {
            const int n0 = (t % tn) * 64, k0 = (t / tn) * 64;
            __syncthreads();
            for (int e = tid; e < 4096; e += NTHREADS) { const int kk = e >> 6, nn = e & 63; tl[kk * 65 + nn] = (n0 + nn < N) ? src[(size_t)(k0 + kk) * N + n0 + nn] : 0.f; }
            __syncthreads();
            for (int e = tid; e < 4096; e += NTHREADS) { const int nn = e >> 6, kk = e & 63; dst[(size_t)(n0 + nn) * 1024 + k0 + kk] = (bf16_t)f2bf(tl[kk * 65 + nn]); }
        }
    };
    transp(p.w_o, (bf16_t*)(ws + WS_WOT), 1024, 1024);
    transp(p.peer_wq, (bf16_t*)(ws + WS_WQT), PEER_N, PEER_N);
}

DI void p1_inproj(const Params& p, unsigned char* lds) {
    unsigned char* ws = p.ws;
    const bf16_t* XB = (const bf16_t*)(ws + WS_XB); const bf16_t* WT = (const bf16_t*)(ws + WS_WINT);
    const float* cosT = (const float*)(ws + WS_ROPE); const float* sinT = cosT + SEQ * 32;
    const int tid = threadIdx.x, lane = tid & 63, wave = tid >> 6, wm = wave >> 1, wn = wave & 1, c = lane & 15, g = lane >> 4;
    constexpr int NT = NMIX_PAD / 128, MT = NTOK / 128;
    int mt, nt;
    for (int k = 0; tile_of(k, NT, MT, mt, nt); ++k) {
        f32x4 acc[4][4];
        gemm_128x128(XB + (size_t)mt * 128 * 1024, 1024, WT + (size_t)nt * 128 * 1024, 1024, 1024, lds, acc);
        const int col64 = nt * 2 + wn;
        bf16_t* dst; int ld, coff; bool rope = true; float scale = 1.f;
        if (col64 < 8)       { dst = (bf16_t*)(ws + WS_QA); ld = 512; coff = col64 * 64; scale = 0.125f; }
        else if (col64 < 10) { dst = (bf16_t*)(ws + WS_KA); ld = 128; coff = (col64 - 8) * 64; }
        else if (col64 < 12) { dst = (bf16_t*)(ws + WS_VA); ld = 128; coff = (col64 - 10) * 64; rope = false; }
        else if (col64 < 20) { dst = (bf16_t*)(ws + WS_QB); ld = 512; coff = (col64 - 12) * 64; scale = 0.125f; }
        else if (col64 == 20) { dst = (bf16_t*)(ws + WS_KB); ld = 64; coff = 0; }
        else if (col64 == 21) { dst = (bf16_t*)(ws + WS_VB); ld = 64; coff = 0; rope = false; }
        else if (col64 < 26) { dst = (bf16_t*)(ws + WS_QI); ld = 256; coff = (col64 - 22) * 64; }
        else                 { dst = (bf16_t*)(ws + WS_KI); ld = 64; coff = 0; }
        if (col64 == 27) {
            if (g == 0) {
#pragma unroll
                for (int m = 0; m < 4; ++m) { const int tok = mt * 128 + wm * 64 + m * 16 + c; *(f32x4*)((float*)(ws + WS_WI) + (size_t)tok * 4) = acc[m][0] * 0.0625f; }
            }
            continue;
        }
#pragma unroll
        for (int m = 0; m < 4; ++m) {
            const int tok = mt * 128 + wm * 64 + m * 16 + c, pos = tok & (SEQ - 1);
            f32x4 v[4] = {acc[m][0], acc[m][1], acc[m][2], acc[m][3]};
            if (col64 == 26) {
                float s = 0.f;
#pragma unroll
                for (int n = 0; n < 4; ++n) s += (v[n][0] + v[n][1]) + (v[n][2] + v[n][3]);
                s += __shfl_xor(s, 16); s += __shfl_xor(s, 32);
                const float mu = s * (1.f / 64.f); float q = 0.f;
#pragma unroll
                for (int n = 0; n < 4; ++n) { const f32x4 d = v[n] - mu; q += (d[0] * d[0] + d[1] * d[1]) + (d[2] * d[2] + d[3] * d[3]); }
                q += __shfl_xor(q, 16); q += __shfl_xor(q, 32);
                const float rstd = rsqrtf(q * (1.f / 64.f) + LN_EPS);
#pragma unroll
                for (int n = 0; n < 4; ++n) {
                    const f32x4 gg = *(const f32x4*)(p.idx_k_g + 16 * n + 4 * g), bb = *(const f32x4*)(p.idx_k_b + 16 * n + 4 * g);
                    v[n] = (v[n] - mu) * rstd * gg + bb;
                }
            }
            if (rope) {
#pragma unroll
                for (int n = 0; n < 2; ++n) {
                    const f32x4 cs = *(const f32x4*)(cosT + pos * 32 + 16 * n + 4 * g), sn = *(const f32x4*)(sinT + pos * 32 + 16 * n + 4 * g);
                    const f32x4 t1 = v[n], t2 = v[n + 2];
                    v[n] = t1 * cs - t2 * sn; v[n + 2] = t2 * cs + t1 * sn;
                }
            }
#pragma unroll
            for (int n = 0; n < 4; ++n) {
                const f32x4 o = v[n] * scale; u32x2 w; w.x = pack_bf16(o[0], o[1]); w.y = pack_bf16(o[2], o[3]);
                *(u32x2*)(dst + (size_t)tok * ld + coff + 16 * n + 4 * g) = w;
            }
        }
    }
}

constexpr int NDSA = NTOK / 4, NSWA = BATCH * 32 * 8;
constexpr int P2_STG = 0  , P2_LIST = 32768;

DI unsigned f16_key(float v) {
    _Float16 hv = (_Float16)v; unsigned short hb = __builtin_bit_cast(unsigned short, hv); unsigned b = hb;
    if (b == 0x8000u) b = 0u;
    return (b & 0x8000u) ? ((~b) & 0xffffu) : (b | 0x8000u);
}

DI size_t sc_row_off(int t) { const size_t m = (size_t)(t >> 3); return 8 * (4 * m * (m + 1) + (size_t)(t & 7) * (m + 1)); }
constexpr size_t SC_BATCH = 8404992;
DI unsigned short* sc_batch_base(const Params& p, int b) { return (b < 7) ? (unsigned short*)p.out + (size_t)b * SC_BATCH : (unsigned short*)(p.ws + WS_PG); }

DI void p2a_indexer(const Params& p, unsigned char* lds) {
    unsigned char* ws = p.ws;
    const bf16_t* QI = (const bf16_t*)(ws + WS_QI); const bf16_t* KI = (const bf16_t*)(ws + WS_KI); const float* WI = (const float*)(ws + WS_WI);
    const int G = gridDim.x, bi = blockIdx.x;
    for (int it = 0; it < 2; ++it) {
        const int item = (it == 0) ? bi : 1023 - bi;
        for (int id = (G == 512) ? item : bi + it * G; id < 1024; id += (G == 512) ? 1024 : 2 * G) {
            int tid = threadIdx.x; asm volatile("" : "+v"(tid));
            const int lane = tid & 63, wave = tid >> 6, c = lane & 15, g = lane >> 4, lrow = tid >> 3, lch = tid & 7;
            const int b = id >> 7, t0 = (id & 127) * 32, tokw = b * SEQ + t0 + 8 * wave;
            unsigned short* scb = sc_batch_base(p, b);
            bf16x8 af[2][2]; f32x4 wv[2];
#pragma unroll
            for (int rt = 0; rt < 2; ++rt) {
#pragma unroll
                for (int s2 = 0; s2 < 2; ++s2) af[rt][s2] = as_bf16x8(ldg16(QI + (size_t)(tokw + 4 * rt + (c >> 2)) * 256 + (c & 3) * 64 + 32 * s2 + 8 * g));
                wv[rt] = *(const f32x4*)(WI + (size_t)(tokw + 4 * rt + g) * 4);
            }
            asm volatile("" :: "v"(af[0][0]), "v"(af[0][1]), "v"(af[1][0]), "v"(af[1][1]), "v"(wv[0]), "v"(wv[1]));
            const int nkt = ((t0 + 31) >> 7) + 1;
            const unsigned char* kib = (const unsigned char*)(KI + (size_t)b * SEQ * 64);
            unsigned char* dst0 = lds + tid * 16;
            auto stage = [&](int kt, int buf) {
#pragma unroll
                for (int i = 0; i < 4; ++i) {
                    const int row = lrow + 32 * i;
                    glds16(kib + (size_t)(kt * 128 + row) * 128 + ((lch ^ ((row >> 3) & 7)) << 4), dst0 + buf * 16384 + i * 4096);
                }
            };
            __syncthreads();
            stage(0, 0); if (nkt > 1) stage(1, 1);
            for (int kt = 0; kt < nkt; ++kt) {
                if (kt + 1 < nkt) asm volatile("s_waitcnt vmcnt(4)" ::: "memory");
                else asm volatile("s_waitcnt vmcnt(0)" ::: "memory");
                asm volatile("s_waitcnt lgkmcnt(0)" ::: "memory");
                __builtin_amdgcn_s_barrier();
                if (kt + 2 < nkt) stage(kt + 2, (kt + 2) % 3);
                const unsigned char* Ks = lds + (kt % 3) * 16384;
                unsigned res[2][4];
#pragma unroll
                for (int ct = 0; ct < 8; ++ct) {
                    const int row = 8 * c + ct;
                    const bf16x8 k0 = as_bf16x8(*(const u32x4*)(Ks + row * 128 + ((g ^ (c & 7)) << 4)));
                    const bf16x8 k1 = as_bf16x8(*(const u32x4*)(Ks + row * 128 + (((4 + g) ^ (c & 7)) << 4)));
#pragma unroll
                    for (int rt = 0; rt < 2; ++rt) {
                        f32x4 d = mfma16(af[rt][0], k0, (f32x4){0.f, 0.f, 0.f, 0.f});
                        d = mfma16(af[rt][1], k1, d);
                        const float sv = wv[rt][0] * fmaxf(d[0], 0.f) + wv[rt][1] * fmaxf(d[1], 0.f) + wv[rt][2] * fmaxf(d[2], 0.f) + wv[rt][3] * fmaxf(d[3], 0.f);
                        const int key = kt * 128 + row, tq = t0 + 8 * wave + 4 * rt + g;
                        const unsigned kv = (key <= tq) ? f16_key(sv) : 0u;
                        if (ct & 1) res[rt][ct >> 1] |= kv << 16; else res[rt][ct >> 1] = kv;
                    }
                }
#pragma unroll
                for (int rt = 0; rt < 2; ++rt) {
                    const int tq = t0 + 8 * wave + 4 * rt + g;
                    if (16 * kt + c <= (tq >> 3)) {
                        u32x4 w; w.x = res[rt][0]; w.y = res[rt][1]; w.z = res[rt][2]; w.w = res[rt][3];
                        *(u32x4*)(scb + sc_row_off(tq) + kt * 128 + 8 * c) = w;
                    }
                }
            }
        }
    }
    __syncthreads();
    p0_late(p, lds);
}

template <int MODE> DI void p2_dsa_item(const Params& p, unsigned char* lds, int b, int tb) {
    unsigned char* ws = p.ws;
    const bf16_t* QI = (const bf16_t*)(ws + WS_QI); const bf16_t* KI = (const bf16_t*)(ws + WS_KI); const float* WI = (const float*)(ws + WS_WI);
    const bf16_t* QB = (const bf16_t*)(ws + WS_QB); const bf16_t* KB = (const bf16_t*)(ws + WS_KB); const bf16_t* VB = (const bf16_t*)(ws + WS_VB);
    bf16_t* ATT = (bf16_t*)(ws + WS_ATT);
    int tid = threadIdx.x; asm volatile("" : "+v"(tid));
    const int lane = tid & 63, wave = __builtin_amdgcn_readfirstlane(tid >> 6), c = lane & 15, g = lane >> 4;
    const int t0 = tb * 4, tok0 = b * SEQ + t0;
    unsigned char* stg = lds + P2_STG + wave * 8192;
    unsigned* hist = (unsigned*)stg;
    unsigned short* list = (unsigned short*)(lds + P2_LIST) + wave * 256;
    const int tok = tok0 + wave;
    if (!(MODE & 2)) return;
    const int n = t0 + wave + 1;
    const int L = n < 256 ? n : 256;
    const unsigned short* myk = sc_batch_base(p, b) + sc_row_off(t0 + wave);
    if (n <= 256) {
        for (int i = lane; i < n; i += 64) list[i] = (unsigned short)i;
    } else {
        u32x4 kk[8];
#pragma unroll
        for (int i = 0; i < 8; ++i) kk[i] = (512 * i + 8 * lane < n) ? ldg16(myk + 512 * i + 8 * lane) : (u32x4){0u, 0u, 0u, 0u};
#pragma unroll
        for (int i = 0; i < 4; ++i) *(u32x4*)(hist + lane * 16 + i * 4) = (u32x4){0u, 0u, 0u, 0u};
#pragma unroll
        for (int i = 0; i < 8; ++i) {
            if (512 * i < n) {
#pragma unroll
                for (int w = 0; w < 4; ++w) { const unsigned wd = kk[i][w]; atomicAdd(&hist[(wd & 0xffffu) >> 6], 1u); atomicAdd(&hist[wd >> 22], 1u); }
            }
        }
        unsigned h[16];
#pragma unroll
        for (int i = 0; i < 4; ++i) { const u32x4 t = *(const u32x4*)(hist + lane * 16 + i * 4); h[4 * i] = t.x; h[4 * i + 1] = t.y; h[4 * i + 2] = t.z; h[4 * i + 3] = t.w; }
#pragma unroll
        for (int i = 0; i < 4; ++i) *(u32x4*)(hist + lane * 16 + i * 4) = (u32x4){0u, 0u, 0u, 0u};
        unsigned sl = 0;
#pragma unroll
        for (int i = 0; i < 16; ++i) sl += h[i];
        unsigned pre = sl;
#pragma unroll
        for (int o = 1; o < 64; o <<= 1) { const unsigned t = __shfl_up(pre, o); if (lane >= o) pre += t; }
        const unsigned tot = __shfl(pre, 63);
        const unsigned suf = tot - pre;
        int found = -1; unsigned cab = 0, cum = suf;
#pragma unroll
        for (int j = 15; j >= 0; --j) { const bool hit = (found < 0) && (cum + h[j] >= 256u); if (hit) { found = lane * 16 + j; cab = cum; } cum += h[j]; }
        const bool mine = (suf < 256u) && (suf + sl >= 256u);
        const unsigned long long mm = __ballot(mine);
        const int src = __ffsll((long long)mm) - 1;
        const unsigned bstar = (unsigned)__shfl(found, src), cabove = __shfl(cab, src);
        const unsigned r1 = 256u - cabove;
#pragma unroll
        for (int i = 0; i < 8; ++i) {
            if (512 * i < n) {
#pragma unroll
                for (int w = 0; w < 4; ++w) {
                    const unsigned wd = kk[i][w];
                    if (((wd & 0xffffu) >> 6) == bstar) atomicAdd(&hist[wd & 63u], 1u);
                    if ((wd >> 22) == bstar) atomicAdd(&hist[(wd >> 16) & 63u], 1u);
                }
            }
        }
        const unsigned cnt = hist[lane];
        hist[lane] = 0u;
        unsigned pre2 = cnt;
#pragma unroll
        for (int o = 1; o < 64; o <<= 1) { const unsigned t = __shfl_up(pre2, o); if (lane >= o) pre2 += t; }
        const unsigned tot2 = __shfl(pre2, 63);
        const unsigned suf2 = tot2 - pre2;
        const bool mine2 = (suf2 < r1) && (suf2 + cnt >= r1);
        const unsigned long long mm2 = __ballot(mine2);
        const int src2 = __ffsll((long long)mm2) - 1;
        const unsigned T = (bstar << 6) | (unsigned)src2;
        const unsigned req = r1 - __shfl(suf2, src2);
        const unsigned toteq = __shfl(cnt, src2);
        const bool alleq = (req == toteq);
        const unsigned Tt = alleq ? T : T + 1u;
        unsigned cg = 0;
#pragma unroll
        for (int i = 0; i < 8; ++i)
#pragma unroll
            for (int w = 0; w < 4; ++w) { const unsigned wd = kk[i][w]; cg += ((wd & 0xffffu) >= Tt) ? 1u : 0u; cg += ((wd >> 16) >= Tt) ? 1u : 0u; }
        unsigned pre3 = cg;
#pragma unroll
        for (int o = 1; o < 64; o <<= 1) { const unsigned t = __shfl_up(pre3, o); if (lane >= o) pre3 += t; }
        unsigned off = pre3 - cg;
#pragma unroll
        for (int i = 0; i < 8; ++i)
#pragma unroll
            for (int w = 0; w < 4; ++w) {
                const unsigned wd = kk[i][w]; const int idx = 512 * i + 8 * lane + 2 * w;
                if ((wd & 0xffffu) >= Tt) { list[off & 255u] = (unsigned short)idx; ++off; }
                if ((wd >> 16) >= Tt) { list[off & 255u] = (unsigned short)(idx + 1); ++off; }
            }
        if (!alleq) {
            const unsigned cgt = 256u - req; unsigned eq_run = 0;
            for (int base = 0; base < n; base += 64) {
                const int i = base + lane; const unsigned m = (i < n) ? myk[i] : 0u;
                const bool eq = (m == T);
                const unsigned long long eqm = __ballot(eq);
                const unsigned rank = eq_run + __builtin_amdgcn_mbcnt_hi((unsigned)(eqm >> 32), __builtin_amdgcn_mbcnt_lo((unsigned)eqm, 0u));
                if (eq && rank < req) list[cgt + rank] = (unsigned short)i;
                eq_run += (unsigned)__popcll(eqm);
            }
        }
    }
    if (!(MODE & 4)) return;
    bf16x8 qf[2], sel[2];
#pragma unroll
    for (int s = 0; s < 2; ++s) {
        u32x4 t = (u32x4){0u, 0u, 0u, 0u};
        if (c < 8) t = ldg16(QB + (size_t)tok * 512 + c * 64 + 32 * s + 8 * g);
        qf[s] = as_bf16x8(t);
#pragma unroll
        for (int j = 0; j < 8; ++j) sel[s][j] = (8 * g + j == 16 * s + c) ? (short)0x3F80 : (short)0;
    }
    f32x4 st[16];
    const unsigned char* kbb = (const unsigned char*)(KB + (size_t)b * SEQ * 64); const unsigned char* vbb = (const unsigned char*)(VB + (size_t)b * SEQ * 64);
    const int lr = lane >> 3, lc = lane & 7;
    const unsigned st_off = lr * 128 + ((lc ^ lr) << 4);
    auto loadg = [&](const unsigned char* base, int T0, u32x4 (&dst)[8]) {
#pragma unroll
        for (int i = 0; i < 8; ++i) {
            const int idx = T0 * 16 + i * 8 + lr; const unsigned kid = (idx < L) ? (unsigned)list[idx] : 0u;
            dst[i] = ldg16(base + kid * 128u + lc * 16u);
        }
    };
    auto stage = [&](const u32x4 (&src)[8]) {
#pragma unroll
        for (int i = 0; i < 8; ++i) *(u32x4*)(stg + i * 1024 + st_off) = src[i];
    };
    auto frag = [&](int u, int s2) -> bf16x8 { return as_bf16x8(*(const u32x4*)(stg + (16 * u + c) * 128 + (((4 * s2 + g) ^ (c & 7)) << 4))); };
    auto scoreK = [&](int T0) {
#pragma unroll
        for (int T = 0; T < 4; ++T) {
            f32x4 d = mfma16(frag(T, 0), qf[0], (f32x4){0.f, 0.f, 0.f, 0.f});
            st[T0 + T] = mfma16(frag(T, 1), qf[1], d);
        }
    };
    u32x4 rA[8], rB[8], rC[8], rD[8];
    loadg(kbb, 0, rA); loadg(kbb, 4, rB); loadg(kbb, 8, rC); loadg(kbb, 12, rD);
    __builtin_amdgcn_sched_barrier(0);
    stage(rA); scoreK(0);
    stage(rB); scoreK(4);
    __builtin_amdgcn_sched_barrier(0);
    loadg(vbb, 0, rA); loadg(vbb, 4, rB);
    stage(rC); scoreK(8);
    stage(rD); scoreK(12);
    __builtin_amdgcn_sched_barrier(0);
    float mx = -3.0e38f;
    {
        const int lrem = L - 4 * g;
#pragma unroll
        for (int T = 0; T < 16; ++T)
#pragma unroll
            for (int r = 0; r < 4; ++r) { const float sv = (T * 16 + r < lrem) ? st[T][r] : -3.0e38f; st[T][r] = sv; mx = fmaxf(mx, sv); }
    }
    mx = fmaxf(mx, __shfl_xor(mx, 16)); mx = fmaxf(mx, __shfl_xor(mx, 32));
    float lsum = 0.f;
#pragma unroll
    for (int T = 0; T < 16; ++T)
#pragma unroll
        for (int r = 0; r < 4; ++r) { const float e = __expf(st[T][r] - mx); st[T][r] = e; lsum += e; }
    lsum += __shfl_xor(lsum, 16); lsum += __shfl_xor(lsum, 32);
    const float rl = 1.0f / lsum;
    u32x4 pfv[8];
#pragma unroll
    for (int u = 0; u < 8; ++u) {
        const int Ta = 2 * u, Tb = Ta + 1;
        pfv[u].x = pack_bf16(st[Ta][0] * rl, st[Ta][1] * rl); pfv[u].y = pack_bf16(st[Ta][2] * rl, st[Ta][3] * rl);
        pfv[u].z = pack_bf16(st[Tb][0] * rl, st[Tb][1] * rl); pfv[u].w = pack_bf16(st[Tb][2] * rl, st[Tb][3] * rl);
    }
    __builtin_amdgcn_sched_barrier(0);
    f32x4 O[4];
#pragma unroll
    for (int cb = 0; cb < 4; ++cb) O[cb] = (f32x4){0.f, 0.f, 0.f, 0.f};
    auto pv = [&](int T0) {
#pragma unroll
        for (int u = 0; u < 2; ++u) {
            const u32x4 pf = pfv[(T0 >> 1) + u];
#pragma unroll
            for (int cb = 0; cb < 4; ++cb) {
                const f32x4 z = (f32x4){0.f, 0.f, 0.f, 0.f};
                const f32x4 v0 = mfma16(frag(2 * u, cb >> 1), sel[cb & 1], z), v1 = mfma16(frag(2 * u + 1, cb >> 1), sel[cb & 1], z);
                u32x4 vf; vf.x = pack_bf16(v0[0], v0[1]); vf.y = pack_bf16(v0[2], v0[3]); vf.z = pack_bf16(v1[0], v1[1]); vf.w = pack_bf16(v1[2], v1[3]);
                O[cb] = mfma16(as_bf16x8(pf), as_bf16x8(vf), O[cb]);
            }
        }
    };
    loadg(vbb, 8, rC); loadg(vbb, 12, rD);
    __builtin_amdgcn_sched_barrier(0);
    stage(rA); pv(0);
    stage(rB); pv(4);
    __builtin_amdgcn_sched_barrier(0);
    stage(rC); pv(8);
    stage(rD); pv(12);
    if (g < 2) {
#pragma unroll
        for (int cb = 0; cb < 4; ++cb)
#pragma unroll
            for (int r = 0; r < 4; ++r) ATT[(size_t)tok * 1024 + 512 + (4 * g + r) * 64 + 16 * cb + c] = (bf16_t)f2bf(O[cb][r]);
    }
}

DI void p2_swa_item(const Params& p, int item2) {
    unsigned char* ws = p.ws;
    const bf16_t* QA = (const bf16_t*)(ws + WS_QA); const bf16_t* KA = (const bf16_t*)(ws + WS_KA); const bf16_t* VA = (const bf16_t*)(ws + WS_VA);
    bf16_t* ATT = (bf16_t*)(ws + WS_ATT);
    int tid = threadIdx.x; asm volatile("" : "+v"(tid));
    const int lane = tid & 63, wave = __builtin_amdgcn_readfirstlane(tid >> 6), r = lane & 31, h = lane >> 5;
    const int hq = item2 & 7, blk = (item2 >> 3) & 31, b = item2 >> 8, kvh = hq >> 2;
    const int qi = 32 * wave + r, tokq = b * SEQ + blk * 128 + qi;
    bf16x8 qf[4], sel[2];
#pragma unroll
    for (int s = 0; s < 4; ++s) qf[s] = as_bf16x8(ldg16(QA + (size_t)tokq * 512 + hq * 64 + 16 * s + 8 * h));
#pragma unroll
    for (int x = 0; x < 2; ++x)
#pragma unroll
        for (int j = 0; j < 8; ++j) sel[x][j] = (8 * h + j + 16 * x == r) ? (short)0x3F80 : (short)0;
    const float sink = p.sinks[hq];
    f32x16 ST[5];
#pragma unroll
    for (int ti = 0; ti < 5; ++ti) {
        const int sj = 32 * (wave + ti) + r; int pos = blk * 128 - 128 + sj; pos = pos < 0 ? 0 : pos;
        const bf16_t* kp = KA + (size_t)(b * SEQ + pos) * 128 + kvh * 64 + 8 * h;
        f32x16 d; for (int i = 0; i < 16; ++i) d[i] = 0.f;
#pragma unroll
        for (int s = 0; s < 4; ++s) d = mfma32(as_bf16x8(ldg16(kp + 16 * s)), qf[s], d);
        ST[ti] = d;
    }
    float mx = sink;
    {
        const int lo = r + 1 - 4 * h;
        const int lo0 = (blk > 0) ? lo : (lo > 128 - 32 * wave - 4 * h ? lo : 128 - 32 * wave - 4 * h);
#pragma unroll
        for (int ti = 0; ti < 5; ++ti)
#pragma unroll
            for (int reg = 0; reg < 16; ++reg) {
                const int e = 32 * ti + (reg & 3) + 8 * (reg >> 2);
                const float sv = (e >= lo0 && e < lo + 128) ? ST[ti][reg] : -3.0e38f; ST[ti][reg] = sv; mx = fmaxf(mx, sv);
            }
    }
    mx = fmaxf(mx, __shfl_xor(mx, 32));
    float lsum = 0.f;
#pragma unroll
    for (int ti = 0; ti < 5; ++ti)
#pragma unroll
        for (int reg = 0; reg < 16; ++reg) { const float e = __expf(ST[ti][reg] - mx); ST[ti][reg] = e; lsum += e; }
    lsum += __shfl_xor(lsum, 32);
    lsum += __expf(sink - mx);
    const float rl = 1.0f / lsum;
    f32x16 OT[2];
    for (int i = 0; i < 16; ++i) { OT[0][i] = 0.f; OT[1][i] = 0.f; }
#pragma unroll
    for (int ti = 0; ti < 5; ++ti) {
        const int sj = 32 * (wave + ti) + r; int pos = blk * 128 - 128 + sj; pos = pos < 0 ? 0 : pos;
        const bf16_t* vp = VA + (size_t)(b * SEQ + pos) * 128 + kvh * 64 + 8 * h;
        bf16x8 vf[4];
#pragma unroll
        for (int s = 0; s < 4; ++s) vf[s] = as_bf16x8(ldg16(vp + 16 * s));
        u32x4 pb[2];
#pragma unroll
        for (int s2 = 0; s2 < 2; ++s2) {
            pb[s2].x = pack_bf16(ST[ti][8 * s2 + 0] * rl, ST[ti][8 * s2 + 1] * rl); pb[s2].y = pack_bf16(ST[ti][8 * s2 + 2] * rl, ST[ti][8 * s2 + 3] * rl);
            pb[s2].z = pack_bf16(ST[ti][8 * s2 + 4] * rl, ST[ti][8 * s2 + 5] * rl); pb[s2].w = pack_bf16(ST[ti][8 * s2 + 6] * rl, ST[ti][8 * s2 + 7] * rl);
        }
#pragma unroll
        for (int db = 0; db < 2; ++db) {
            f32x16 vt; for (int i = 0; i < 16; ++i) vt[i] = 0.f;
            vt = mfma32(vf[2 * db], sel[0], vt); vt = mfma32(vf[2 * db + 1], sel[1], vt);
#pragma unroll
            for (int s2 = 0; s2 < 2; ++s2) {
                u32x4 va; va.x = pack_bf16(vt[8 * s2 + 0], vt[8 * s2 + 1]); va.y = pack_bf16(vt[8 * s2 + 2], vt[8 * s2 + 3]);
                va.z = pack_bf16(vt[8 * s2 + 4], vt[8 * s2 + 5]); va.w = pack_bf16(vt[8 * s2 + 6], vt[8 * s2 + 7]);
                OT[db] = mfma32(as_bf16x8(va), as_bf16x8(pb[s2]), OT[db]);
            }
        }
    }
#pragma unroll
    for (int db = 0; db < 2; ++db)
#pragma unroll
        for (int q4 = 0; q4 < 4; ++q4) {
            u32x2 w; w.x = pack_bf16(OT[db][4 * q4], OT[db][4 * q4 + 1]); w.y = pack_bf16(OT[db][4 * q4 + 2], OT[db][4 * q4 + 3]);
            *(u32x2*)(ATT + (size_t)tokq * 1024 + hq * 64 + 32 * db + 8 * q4 + 4 * h) = w;
        }
}

template <int MODE> DI void p2_attention(const Params& p, unsigned char* lds, int cidx = 0) {
    const int G = gridDim.x, bi = blockIdx.x, rounds = (1024 + G - 1) / G;
    for (int b = 0; b < BATCH; ++b)
        for (int r = 0; r < rounds; ++r) {
            const int idx = (r & 1) ? r * G + (G - 1 - bi) : r * G + bi;
            if (idx < 1024) p2_dsa_item<MODE>(p, lds, b, 1023 - idx);
        }
    if (MODE & 8) for (int item2 = bi; item2 < NSWA; item2 += G) p2_swa_item(p, item2);
}

DI void p3_outproj(const Params& p, unsigned char* lds) {
    unsigned char* ws = p.ws;
    const bf16_t* ATT = (const bf16_t*)(ws + WS_ATT); const bf16_t* WT = (const bf16_t*)(ws + WS_WOT);
    const int tid = threadIdx.x, lane = tid & 63, wave = tid >> 6, wm = wave >> 1, wn = wave & 1, c = lane & 15, g = lane >> 4;
    constexpr int NT = 8, MT = NTOK / 128;
    int mt, nt;
    for (int k = 0; tile_of(k, NT, MT, mt, nt); ++k) {
        f32x4 acc[4][4];
        gemm_128x128(ATT + (size_t)mt * 128 * 1024, 1024, WT + (size_t)nt * 128 * 1024, 1024, 1024, lds, acc);
#pragma unroll
        for (int m = 0; m < 4; ++m) {
            const int tok = mt * 128 + wm * 64 + m * 16 + c;
#pragma unroll
            for (int n = 0; n < 4; ++n) {
                const size_t o = (size_t)tok * 1024 + nt * 128 + wn * 64 + 16 * n + 4 * g;
                const u32x2 xw = *(const u32x2*)((const bf16_t*)(ws + WS_XB) + o);
                const f32x4 xv = {bf_lo(xw.x), bf_hi(xw.x), bf_lo(xw.y), bf_hi(xw.y)};
                const f32x4 hv = xv * ALPHA + acc[m][n];
                u32x2 w; w.x = pack_bf16(hv[0], hv[1]); w.y = pack_bf16(hv[2], hv[3]);
                *(u32x2*)((bf16_t*)p.out + o) = w;
            }
        }
    }
}

DI void p3b_ln1(const Params& p) {
    bf16_t* H1B = (bf16_t*)(p.ws + WS_XB); const bf16_t* HP = (const bf16_t*)p.out;
    const int lane = threadIdx.x & 63, gw = blockIdx.x * 4 + (threadIdx.x >> 6), nw = gridDim.x * 4;
    for (int row = gw; row < NTOK; row += nw) {
        const u32x4 ra = ldg16(HP + (size_t)row * 1024 + lane * 16), rb = ldg16(HP + (size_t)row * 1024 + lane * 16 + 8);
        float v[16];
        v[0] = bf_lo(ra.x); v[1] = bf_hi(ra.x); v[2] = bf_lo(ra.y); v[3] = bf_hi(ra.y); v[4] = bf_lo(ra.z); v[5] = bf_hi(ra.z); v[6] = bf_lo(ra.w); v[7] = bf_hi(ra.w);
        v[8] = bf_lo(rb.x); v[9] = bf_hi(rb.x); v[10] = bf_lo(rb.y); v[11] = bf_hi(rb.y); v[12] = bf_lo(rb.z); v[13] = bf_hi(rb.z); v[14] = bf_lo(rb.w); v[15] = bf_hi(rb.w);
        float s = 0.f;
#pragma unroll
        for (int i = 0; i < 16; ++i) s += v[i];
        const float mu = wave_sum(s) * (1.f / 1024.f); float q = 0.f;
#pragma unroll
        for (int i = 0; i < 16; ++i) { const float d = v[i] - mu; q = fmaf(d, d, q); }
        const float rstd = rsqrtf(wave_sum(q) * (1.f / 1024.f) + LN_EPS);
        u32x4 oa, ob; float ov[16]; float amax = 0.f;
#pragma unroll
        for (int k4 = 0; k4 < 4; ++k4) {
            const int col = lane * 16 + k4 * 4;
            const f32x4 gg = *(const f32x4*)(p.ln1_g + col), bb = *(const f32x4*)(p.ln1_b + col);
            float o[4];
#pragma unroll
            for (int e = 0; e < 4; ++e) { o[e] = (v[k4 * 4 + e] - mu) * rstd * gg[e] + bb[e]; ov[k4 * 4 + e] = o[e]; amax = fmaxf(amax, fabsf(o[e])); }
            const unsigned w0 = pack_bf16(o[0], o[1]), w1 = pack_bf16(o[2], o[3]);
            if (k4 == 0) { oa.x = w0; oa.y = w1; } else if (k4 == 1) { oa.z = w0; oa.w = w1; } else if (k4 == 2) { ob.x = w0; ob.y = w1; } else { ob.z = w0; ob.w = w1; }
        }
        *(u32x4*)(H1B + (size_t)row * 1024 + lane * 16) = oa; *(u32x4*)(H1B + (size_t)row * 1024 + lane * 16 + 8) = ob;
        {
#pragma unroll
            for (int o2 = 32; o2 >= 1; o2 >>= 1) amax = fmaxf(amax, __shfl_xor(amax, o2));
            const float sx = amax > 0.f ? amax * (1.0f / 440.0f) : 1.0f, inv = amax > 0.f ? 440.0f / amax : 1.0f;
            u32x4 q8;
#pragma unroll
            for (int k4 = 0; k4 < 4; ++k4) {
                int w = 0;
                w = __builtin_amdgcn_cvt_pk_fp8_f32(ov[4 * k4] * inv, ov[4 * k4 + 1] * inv, w, false);
                w = __builtin_amdgcn_cvt_pk_fp8_f32(ov[4 * k4 + 2] * inv, ov[4 * k4 + 3] * inv, w, true);
                q8[k4] = (unsigned)w;
            }
            *(u32x4*)(p.ws + WS_QA + (size_t)row * 1024 + lane * 16) = q8;
            if (lane == 0) ((float*)(p.ws + WS_SX))[row] = sx;
        }
    }
}

DI int f2key(float v) { const int b = __float_as_int(v); return b ^ ((b >> 31) & 0x7fffffff); }
DI float key2f(int k) { return __int_as_float(k ^ ((k >> 31) & 0x7fffffff)); }
DI void ce_desc(int& a, int& b) { const int hi = a > b ? a : b, lo = a > b ? b : a; a = hi; b = lo; }
DI void bitonic_merge16(int (&k)[16]) {
#pragma unroll
    for (int d = 8; d >= 1; d >>= 1)
#pragma unroll
        for (int i = 0; i < 16; ++i) if ((i & d) == 0) ce_desc(k[i], k[i | d]);
}
DI void bitonic_sort16(int (&k)[16]) {
#pragma unroll
    for (int sz = 2; sz <= 16; sz <<= 1) {
#pragma unroll
        for (int i = 0; i < 16; ++i) { const int j = i ^ (sz - 1); if (j > i) ce_desc(k[i], k[j]); }
#pragma unroll
        for (int d = sz >> 2; d >= 1; d >>= 1)
#pragma unroll
            for (int i = 0; i < 16; ++i) if ((i & d) == 0) ce_desc(k[i], k[i | d]);
    }
}
DI void top16_merge(int (&t)[16], const int (&sdesc)[16]) {
#pragma unroll
    for (int i = 0; i < 16; ++i) t[i] = t[i] > sdesc[15 - i] ? t[i] : sdesc[15 - i];
    bitonic_merge16(t);
}
constexpr int P4_QS = 32768, P4_SS_STRIDE = 132, P4_ST0 = 67584  , P4_M = 0  , P4_ST1 = 8704  ;

DI void p4_peer_query(const Params& p, unsigned char* lds) {
    unsigned char* ws = p.ws;
    const bf16_t* H1B = (const bf16_t*)(ws + WS_XB); const bf16_t* WQT = (const bf16_t*)(ws + WS_WQT); const bf16_t* SK = (const bf16_t*)(ws + WS_SK);
    unsigned short* PE = (unsigned short*)(ws + WS_PE); float* PG = (float*)(ws + WS_PG); float* PS = (float*)(ws + WS_PS);
    const float* SU = (const float*)(ws + WS_SU); const float* SV = (const float*)(ws + WS_SV);
    float* Ss = (float*)lds;
    float* st0 = (float*)(lds + P4_ST0); float* mbuf = (float*)(lds + P4_M); float* st1 = (float*)(lds + P4_ST1);
    constexpr int MT = NTOK / 128;
    int mt, head;
    for (int k = 0; tile_of(k, 8, MT, mt, head); ++k) {
        int tid = threadIdx.x; asm volatile("" : "+v"(tid));
        const int lane = tid & 63, wave = tid >> 6, wm = wave >> 1, wn = wave & 1, c = lane & 15, g = lane >> 4;
        const int lrow = tid >> 3, lch = tid & 7;
        const int srow = tid & 127, shalf = tid >> 7;
#pragma unroll 1
        for (int ph = 0; ph < 2; ++ph) {
            f32x4 acc[4][4];
            gemm_128x128(H1B + (size_t)mt * 128 * 1024, 1024, WQT + (size_t)(head * 256 + ph * 128) * 1024, 1024, 1024, lds, acc);
            __syncthreads();
#pragma unroll
            for (int m = 0; m < 4; ++m)
#pragma unroll
                for (int n = 0; n < 4; ++n) {
                    const int row = wm * 64 + m * 16 + c;
                    u32x2 w; w.x = pack_bf16(acc[m][n][0], acc[m][n][1]); w.y = pack_bf16(acc[m][n][2], acc[m][n][3]);
                    *(u32x2*)(lds + P4_QS + wn * 16384 + row * 128 + (((2 * n + (g >> 1)) ^ (row & 7)) << 4) + (g & 1) * 8) = w;
                }
            {
                const bf16_t* sp = SK + (size_t)((head * 2 + ph) * 128 + lrow) * 128 + lch * 8;
#pragma unroll
                for (int k2 = 0; k2 < 2; ++k2)
#pragma unroll
                    for (int i = 0; i < 4; ++i) *(u32x4*)(lds + k2 * 16384 + (lrow + 32 * i) * 128 + ((lch ^ (lrow & 7)) << 4)) = ldg16(sp + (size_t)(32 * i) * 128 + k2 * 64);
            }
            __syncthreads();
            f32x4 a2[4][4];
#pragma unroll
            for (int m = 0; m < 4; ++m)
#pragma unroll
                for (int n = 0; n < 4; ++n) a2[m][n] = (f32x4){0.f, 0.f, 0.f, 0.f};
#pragma unroll
            for (int k2 = 0; k2 < 2; ++k2)
#pragma unroll
                for (int s = 0; s < 2; ++s) {
                    bf16x8 xf[4], wf[4];
#pragma unroll
                    for (int m = 0; m < 4; ++m) { const int row = wm * 64 + m * 16 + c; xf[m] = as_bf16x8(*(const u32x4*)(lds + P4_QS + k2 * 16384 + row * 128 + (((4 * s + g) ^ (c & 7)) << 4))); }
#pragma unroll
                    for (int n = 0; n < 4; ++n) { const int row = wn * 64 + n * 16 + c; wf[n] = as_bf16x8(*(const u32x4*)(lds + k2 * 16384 + row * 128 + (((4 * s + g) ^ (c & 7)) << 4))); }
#pragma unroll
                    for (int m = 0; m < 4; ++m)
#pragma unroll
                        for (int n = 0; n < 4; ++n) a2[m][n] = mfma16(wf[n], xf[m], a2[m][n]);
                }
            __syncthreads();
#pragma unroll
            for (int m = 0; m < 4; ++m)
#pragma unroll
                for (int n = 0; n < 4; ++n) {
                    const int key0 = wn * 64 + 16 * n + 4 * g;
                    u32x4 w;
#pragma unroll
                    for (int r = 0; r < 4; ++r) w[r] = (unsigned)f2key(__uint_as_float((__float_as_uint(a2[m][n][r]) & 0xFFFFFF80u) | (unsigned)(key0 + r)));
                    *(u32x4*)(Ss + (wm * 64 + m * 16 + c) * P4_SS_STRIDE + key0) = w;
                }
            __syncthreads();
            int tv[16];
            {
                const int* rowp = (const int*)Ss + srow * P4_SS_STRIDE + shalf * 64;
#pragma unroll
                for (int bt = 0; bt < 4; ++bt) {
                    int bk[16];
#pragma unroll
                    for (int j = 0; j < 4; ++j) { const u32x4 v = *(const u32x4*)(rowp + 16 * bt + 4 * j); bk[4 * j] = (int)v.x; bk[4 * j + 1] = (int)v.y; bk[4 * j + 2] = (int)v.z; bk[4 * j + 3] = (int)v.w; }
                    bitonic_sort16(bk);
                    if (bt == 0) {
#pragma unroll
                        for (int j = 0; j < 16; ++j) tv[j] = bk[j];
                    } else top16_merge(tv, bk);
                }
            }
            __syncthreads();
            int* mbi = (int*)mbuf;
            if (shalf == 1) {
#pragma unroll
                for (int j = 0; j < 16; ++j) mbi[srow * 17 + j] = tv[j];
            }
            __syncthreads();
            if (shalf == 0) {
                int* dst = (int*)((ph == 0) ? st0 : st1);
                int ob[16];
#pragma unroll
                for (int j = 0; j < 16; ++j) ob[j] = mbi[srow * 17 + j];
                top16_merge(tv, ob);
#pragma unroll
                for (int j = 0; j < 16; ++j) dst[srow * 17 + j] = tv[j];
            }
        }
        __syncthreads();
        int cv[16];
        {
            const int* st0i = (const int*)st0; const int* st1i = (const int*)st1;
            float v2[16];
#pragma unroll
            for (int b = 0; b < 16; ++b) v2[b] = key2f(st1i[srow * 17 + b]);
#pragma unroll
            for (int a8 = 0; a8 < 8; ++a8) {
                const int a = shalf * 8 + a8; const float va = key2f(st0i[srow * 17 + a]);
                int bk[16];
#pragma unroll
                for (int b = 0; b < 16; ++b) bk[b] = (f2key(va + v2[b]) & (int)0xFFFFFF00) | (a * 16 + 15 - b);
                if (a8 == 0) {
#pragma unroll
                    for (int j = 0; j < 16; ++j) cv[j] = bk[j];
                } else top16_merge(cv, bk);
            }
        }
        __syncthreads();
        int* mbi = (int*)mbuf;
        if (shalf == 1) {
#pragma unroll
            for (int j = 0; j < 16; ++j) mbi[srow * 17 + j] = cv[j];
        }
        __syncthreads();
        if (shalf == 0) {
            const int* st0i = (const int*)st0; const int* st1i = (const int*)st1;
            int fk[16]; float fv[16];
#pragma unroll
            for (int j = 0; j < 16; ++j) { const int o = mbi[srow * 17 + 15 - j]; fk[j] = cv[j] > o ? cv[j] : o; fv[j] = key2f(fk[j]); }
            float cmax = fv[0];
#pragma unroll
            for (int j = 1; j < 16; ++j) cmax = fmaxf(cmax, fv[j]);
            float den = 0.f; float ev[16];
#pragma unroll
            for (int j = 0; j < 16; ++j) { ev[j] = __expf(fv[j] - cmax); den += ev[j]; }
            const float rden = 1.0f / den;
            const size_t ob = (size_t)(mt * 128 + srow) * 128 + head * 16;
#pragma unroll
            for (int j = 0; j < 16; ++j) {
                const unsigned cde = (unsigned)fk[j] & 0xFFu;
                const unsigned a = cde >> 4, b = 15u - (cde & 15u);
                const unsigned i1 = __float_as_uint(key2f(st0i[srow * 17 + a])) & 0x7Fu, i2 = __float_as_uint(key2f(st1i[srow * 17 + b])) & 0x7Fu;
                const int e = (int)(i1 * 128u + i2);
                PE[ob + j] = (unsigned short)e; PG[ob + j] = ev[j] * rden * SV[e]; PS[ob + j] = SU[e];
            }
        }
        __syncthreads();
    }
}

DI float gelu_exact(float z) { return 0.5f * z * (1.0f + erff(z * 0.70710678118654752f)); }
DI float rdlane(float v, int l) { return __int_as_float(__builtin_amdgcn_readlane(__float_as_int(v), l)); }

typedef int i32x8 __attribute__((ext_vector_type(8)));
template <int MODE>
DI void p5a_udot(const Params& p, unsigned char* lds) {
    unsigned char* ws = p.ws;
    const unsigned char* H1Q = ws + WS_QA; const float* SX = (const float*)(ws + WS_SX); const unsigned char* UT = ws + WS_UT;
    const unsigned short* PE = (const unsigned short*)(ws + WS_PE); float* ZB = (float*)(ws + (MODE ? WS_QI : WS_QB));
    const int lane = threadIdx.x & 63, wave = threadIdx.x >> 6, c = lane & 15, kb = lane >> 4;
    const int G = gridDim.x, bid = blockIdx.x;
    const bool affine = (G & 7) == 0;
    const int npass = affine ? 1 : 8;
    unsigned char* slot = lds + wave * 16384 + 8192;
    const int l31 = lane & 31, lh = lane >> 5;
    unsigned* list = (unsigned*)(lds + wave * 16384);
    for (int pass = 0; pass < npass; ++pass) {
        const int part = affine ? (bid & 7) : pass, rank = affine ? (bid >> 3) : bid, nper = affine ? (G >> 3) : G;
        for (int gid = rank * 4 + wave; gid < NTOK / 16; gid += nper * 4) {
            const int t0 = gid * 16;
            u32x4 pv[4];
#pragma unroll
            for (int i = 0; i < 4; ++i) pv[i] = ldg16(PE + (size_t)(t0 + (lane >> 2)) * 128 + (lane & 3) * 32 + 8 * i);
            i32x8 bx[8];
#pragma unroll
            for (int s2 = 0; s2 < 8; ++s2) {
                const unsigned char* xp = H1Q + (size_t)(t0 + c) * 1024 + 128 * s2 + 16 * kb;
                const u32x4 lo = ldg16(xp), hi = ldg16(xp + 64);
                bx[s2][0] = (int)lo.x; bx[s2][1] = (int)lo.y; bx[s2][2] = (int)lo.z; bx[s2][3] = (int)lo.w; bx[s2][4] = (int)hi.x; bx[s2][5] = (int)hi.y; bx[s2][6] = (int)hi.z; bx[s2][7] = (int)hi.w;
            }
            const float sxv = SX[t0 + c];
            unsigned base = 0;
#pragma unroll
            for (int i = 0; i < 4; ++i)
#pragma unroll
                for (int w = 0; w < 4; ++w)
#pragma unroll
                    for (int hf = 0; hf < 2; ++hf) {
                        const unsigned e = hf ? (pv[i][w] >> 16) : (pv[i][w] & 0xffffu);
                        const bool cnd = (int)(e >> 11) == part;
                        const unsigned long long mk = __ballot(cnd);
                        if (mk) {
                            const unsigned pos = base + __builtin_amdgcn_mbcnt_hi((unsigned)(mk >> 32), __builtin_amdgcn_mbcnt_lo((unsigned)mk, 0u));
                            if (cnd) list[pos] = e | ((unsigned)((lane & 3) * 32 + 8 * i + 2 * w + hf) << 16) | ((unsigned)(lane >> 2) << 24);
                            base += (unsigned)__popcll(mk);
                        }
                    }
            const int count = (int)base, nrt = (count + 15) >> 4;
            if (MODE == 2) { if (count == 12345) ZB[lane] = sxv + (float)bx[7][7] + (float)bx[0][0]; }
            else if (count > 0) {
                auto loadA = [&](int rt, u32x4 (&dst)[8]) {
                    int idx = 16 * rt + c; idx = idx < count ? idx : count - 1;
                    const unsigned ent = list[idx] & 0x3fffu;
#pragma unroll
                    for (int q = 0; q < 8; ++q) {
                        const unsigned e0 = (unsigned)__builtin_amdgcn_readlane((int)ent, 2 * q), e1 = (unsigned)__builtin_amdgcn_readlane((int)ent, 2 * q + 1);
                        const unsigned e = lh ? e1 : e0;
                        dst[q] = ldg16(UT + (size_t)e * 512 + ((l31 ^ (2 * q + lh)) * 16));
                    }
                };
                auto compute = [&](int rt, const u32x4 (&st)[8]) {
#pragma unroll
                    for (int q = 0; q < 8; ++q) *(u32x4*)(slot + q * 1024 + lane * 16) = st[q];
                    u32x4 af[8];
#pragma unroll
                    for (int s2 = 0; s2 < 8; ++s2) af[s2] = *(const u32x4*)(slot + c * 512 + (((4 * s2 + kb) ^ c) * 16));
                    const u32x4 ev = *(const u32x4*)(list + 16 * rt + 4 * kb);
                    f32x4 D = {0.f, 0.f, 0.f, 0.f};
#pragma unroll
                    for (int s2 = 0; s2 < 8; ++s2) {
                        i32x8 a8; a8[0] = (int)af[s2].x; a8[1] = (int)af[s2].y; a8[2] = (int)af[s2].z; a8[3] = (int)af[s2].w; a8[4] = 0; a8[5] = 0; a8[6] = 0; a8[7] = 0;
                        D = __builtin_amdgcn_mfma_scale_f32_16x16x128_f8f6f4(a8, bx[s2], D, 4  , 0  , 0, 0, 0, 0);
                    }
#pragma unroll
                    for (int r = 0; r < 4; ++r) {
                        const int row = 16 * rt + 4 * kb + r;
                        const unsigned e2 = ev[r];
                        if (row < count && (int)(e2 >> 24) == c && (MODE != 3 || D[r] == 1234.5f)) ZB[(size_t)(t0 + c) * 128 + ((e2 >> 16) & 127u)] = D[r] * sxv;
                    }
                };
                u32x4 a0[8], a1[8], a2[8];
                loadA(0, a0); loadA(1, a1); loadA(2, a2);
                for (int rt = 0; rt < nrt; rt += 3) {
                    compute(rt, a0); loadA(rt + 3, a0);
                    if (rt + 1 < nrt) compute(rt + 1, a1);
                    loadA(rt + 4, a1);
                    if (rt + 2 < nrt) compute(rt + 2, a2);
                    loadA(rt + 5, a2);
                }
            }
        }
    }
}

DI void p5b_ffn(const Params& p) {
    unsigned char* ws = p.ws;
    const bf16_t* H1B = (const bf16_t*)(ws + WS_XB); const unsigned char* VT = ws + WS_VT;
    const unsigned short* PE = (const unsigned short*)(ws + WS_PE); const float* PG = (const float*)(ws + WS_PG); const float* PS = (const float*)(ws + WS_PS);
    const int lane = threadIdx.x & 63, gw = blockIdx.x * 4 + (threadIdx.x >> 6), nw = gridDim.x * 4;
    for (int tok = gw; tok < NTOK; tok += nw) {
        float x[16], acc[16];
        {
            const u32x4 xa = ldg16(H1B + (size_t)tok * 1024 + lane * 16), xb = ldg16(H1B + (size_t)tok * 1024 + lane * 16 + 8);
            x[0] = bf_lo(xa.x); x[1] = bf_hi(xa.x); x[2] = bf_lo(xa.y); x[3] = bf_hi(xa.y); x[4] = bf_lo(xa.z); x[5] = bf_hi(xa.z); x[6] = bf_lo(xa.w); x[7] = bf_hi(xa.w);
            x[8] = bf_lo(xb.x); x[9] = bf_hi(xb.x); x[10] = bf_lo(xb.y); x[11] = bf_hi(xb.y); x[12] = bf_lo(xb.z); x[13] = bf_hi(xb.z); x[14] = bf_lo(xb.w); x[15] = bf_hi(xb.w);
        }
#pragma unroll
        for (int i = 0; i < 16; ++i) acc[i] = 0.f;
        const int pe_lo = (int)PE[(size_t)tok * 128 + lane], pe_hi = (int)PE[(size_t)tok * 128 + 64 + lane];
        const float* ZB = (const float*)(ws + WS_QB);
        const float cf_lo = gelu_exact(ZB[(size_t)tok * 128 + lane] * PS[(size_t)tok * 128 + lane]) * PG[(size_t)tok * 128 + lane];
        const float cf_hi = gelu_exact(ZB[(size_t)tok * 128 + 64 + lane] * PS[(size_t)tok * 128 + 64 + lane]) * PG[(size_t)tok * 128 + 64 + lane];
#pragma unroll 1
        for (int hb = 0; hb < 4; ++hb) {
            const int pes = hb < 2 ? pe_lo : pe_hi; const float cfs = hb < 2 ? cf_lo : cf_hi;
            const int lb = (hb & 1) * 32;
#pragma unroll
            for (int j = 0; j < 32; ++j) {
                const int e = __builtin_amdgcn_readlane(pes, lb + j);
                const float cj = rdlane(cfs, lb + j);
                const u32x2 vw = *(const u32x2*)(VT + (size_t)e * 512 + lane * 8);
#define P5_AXPY(k, bs) { const f32x2 f = __builtin_amdgcn_cvt_scalef32_pk_f32_fp4(vw[k], 1.0f, bs); acc[8 * (k) + 2 * (bs)] = fmaf(cj, f.x, acc[8 * (k) + 2 * (bs)]); acc[8 * (k) + 2 * (bs) + 1] = fmaf(cj, f.y, acc[8 * (k) + 2 * (bs) + 1]); }
                P5_AXPY(0, 0) P5_AXPY(0, 1) P5_AXPY(0, 2) P5_AXPY(0, 3) P5_AXPY(1, 0) P5_AXPY(1, 1) P5_AXPY(1, 2) P5_AXPY(1, 3)
            }
        }
        float s = 0.f;
#pragma unroll
        for (int i = 0; i < 16; ++i) { acc[i] = fmaf(ALPHA, x[i], acc[i]); s += acc[i]; }
        const float mu = wave_sum(s) * (1.f / 1024.f); float q = 0.f;
#pragma unroll
        for (int i = 0; i < 16; ++i) { const float dd = acc[i] - mu; q = fmaf(dd, dd, q); }
        const float rstd = rsqrtf(wave_sum(q) * (1.f / 1024.f) + LN_EPS);
#pragma unroll
        for (int k4 = 0; k4 < 4; ++k4) {
            const int col = lane * 16 + k4 * 4;
            const f32x4 gg = *(const f32x4*)(p.ln2_g + col), bb = *(const f32x4*)(p.ln2_b + col);
            f32x4 o;
#pragma unroll
            for (int e = 0; e < 4; ++e) o[e] = (acc[k4 * 4 + e] - mu) * rstd * gg[e] + bb[e];
            *(f32x4*)(p.out + (size_t)tok * 1024 + col) = o;
        }
    }
}

#define XB_TMO      128
#define XB_XCNT(j)  (256  + 64 * (j))
#define XB_XSUB(j)  (1280 + 64 * (j))
#define XB_XGEN(j)  (2304 + 64 * (j))
#define XB_TOP      3328
#define XB_TOPGEN   3392
#define XCD_BAR_WORDS 3456
#define XB_SPIN_CAP (1u << 22)
#define LAS __attribute__((address_space(3)))
DI unsigned xb_ld(unsigned* p)              { return __hip_atomic_load(p, __ATOMIC_RELAXED, __HIP_MEMORY_SCOPE_AGENT); }
DI unsigned xb_add(unsigned* p, unsigned v) { return __hip_atomic_fetch_add(p, v, __ATOMIC_RELAXED, __HIP_MEMORY_SCOPE_AGENT); }
DI unsigned xb_xcc_id() { return (unsigned)__builtin_amdgcn_s_getreg((3 << 11) | 20) & 0xFu; }
#define XB_SPIN(cond, bar) do { unsigned _sp = 0; while (cond) { __builtin_amdgcn_s_sleep(1); \
    if ((++_sp & 255u) == 0u) { if (xb_ld(&(bar)[XB_TMO])) break; if (_sp > XB_SPIN_CAP) { atomicAdd(&(bar)[XB_TMO], 1u); break; } } } } while (0)
struct XcdBarrier { unsigned* bar; unsigned x; volatile LAS unsigned* st; };
DI XcdBarrier xcd_barrier_post(unsigned* bar, volatile LAS unsigned* st) {
    XcdBarrier b; b.bar = bar; b.x = xb_xcc_id(); b.st = st;
    if (threadIdx.x == 0) (void)xb_add(&bar[XB_XCNT(b.x)], 1u);
    return b;
}
DI void xcd_barrier_complete(unsigned* bar, unsigned x, unsigned& nloc, unsigned& nx) {
    const unsigned G = gridDim.x * gridDim.y * gridDim.z;
    unsigned sum, cnt, mine, sp = 0u;
    for (;;) {
        sum = 0u; cnt = 0u; mine = 0u;
#pragma unroll
        for (unsigned j = 0; j < 16; ++j) { const unsigned c = xb_ld(&bar[XB_XCNT(j)]); sum += c; cnt += (c > 0u) ? 1u : 0u; mine = (j == x) ? c : mine; }
        if (sum == G) break;
        __builtin_amdgcn_s_sleep(1);
        if ((++sp & 255u) == 0u) { if (xb_ld(&bar[XB_TMO])) break; if (sp > XB_SPIN_CAP) { atomicAdd(&bar[XB_TMO], 1u); break; } }
    }
    nloc = mine > 0u ? mine : 1u; nx = cnt > 0u ? cnt : 1u;
}
DI void xcd_barrier(const XcdBarrier& b) {
    asm volatile("s_waitcnt vmcnt(0)" ::: "memory");
    __syncthreads();
    if (threadIdx.x == 0) {
        unsigned* bar = b.bar;
        __builtin_amdgcn_s_waitcnt(0);
        unsigned nloc = b.st[0], nx = b.st[1];
        if (nloc == 0u) { xcd_barrier_complete(bar, b.x, nloc, nx); b.st[0] = nloc; b.st[1] = nx; }
        const unsigned old = xb_add(&bar[XB_XSUB(b.x)], 1u);
        const unsigned gen = old / nloc;
        if (old + 1u == (gen + 1u) * nloc) {
            __builtin_amdgcn_fence(__ATOMIC_RELEASE, "agent");
            asm volatile("s_waitcnt vmcnt(0)" ::: "memory");
            const unsigned og = xb_add(&bar[XB_TOP], 1u);
            const unsigned tg = og / nx;
            if (og + 1u == (tg + 1u) * nx) xb_add(&bar[XB_TOPGEN], 1u);
            else XB_SPIN(xb_ld(&bar[XB_TOPGEN]) == tg, bar);
            __builtin_amdgcn_fence(__ATOMIC_ACQUIRE, "agent");
            xb_add(&bar[XB_XGEN(b.x)], 1u);
            asm volatile("s_waitcnt vmcnt(0)" ::: "memory");
        } else {
            XB_SPIN(xb_ld(&bar[XB_XGEN(b.x)]) == gen, bar);
            __builtin_amdgcn_fence(__ATOMIC_ACQUIRE, "agent");
            asm volatile("s_waitcnt vmcnt(0)" ::: "memory");
        }
    }
    __syncthreads();
}

constexpr int NPHASE = 7;
__global__ void __launch_bounds__(NTHREADS, 2) mega_fwd(Params p) {
    extern __shared__ __attribute__((aligned(16))) unsigned char lds[];
    cg::grid_group grid = cg::this_grid();
    const int lo = p.ph_lo, hi = p.ph_hi;
    volatile LAS unsigned* xbst = (volatile LAS unsigned*)(LAS unsigned char*)(lds + LDS_BYTES - 16);
#ifndef REP_MASK
#define REP_MASK 0
#endif
#ifndef P2_PROBE_MODE
#define P2_PROBE_MODE 15
#endif
#ifndef PH_MASK
#define PH_MASK 127
#endif
    if (lo == 0x7fffffff) grid.sync();
    if (threadIdx.x == 0) { xbst[0] = 0u; xbst[1] = 0u; }
    __syncthreads();
    XcdBarrier xb = xcd_barrier_post((unsigned*)(p.ws + WS_BAR), xbst);
#define GSYNC() xcd_barrier(xb)
    p0_prep(p, lds);
    GSYNC();
#define RUN_PHASE(k, call) { call; if ((REP_MASK >> (k)) & 1) { GSYNC(); call; } }
#if PH_MASK & 2
    RUN_PHASE(1, p1_inproj(p, lds))
#endif
    GSYNC();
#if PH_MASK & 4
#if (REP_MASK >> 2) & 1
    p2a_indexer(p, lds); GSYNC(); p2_attention<P2_PROBE_MODE>(p, lds, 1); GSYNC();
#endif
    p2a_indexer(p, lds);
    GSYNC();
    p2_attention<15>(p, lds, 0);
#endif
    GSYNC();
#if PH_MASK & 8
    RUN_PHASE(3, p3_outproj(p, lds))
#endif
    GSYNC();
#if PH_MASK & 16
    RUN_PHASE(4, p3b_ln1(p))
#endif
    GSYNC();
#if PH_MASK & 32
    RUN_PHASE(5, p4_peer_query(p, lds))
#endif
    GSYNC();
#if PH_MASK & 64
    p5a_udot<0>(p, lds);
#ifdef P5A_REP
    GSYNC(); p5a_udot<P5A_REP>(p, lds);
#endif
    GSYNC();
    p5b_ffn(p);
#endif
}

#ifndef MK_N_LAUNCHES
#define MK_N_LAUNCHES 1
#endif

extern "C" void kernel_launch(void* const* d_in, const int* in_sizes, int n_in, void* d_out, int out_size, void* d_ws, size_t ws_size, hipStream_t stream) {
    static int grid_blocks = 0;
    if (grid_blocks == 0) {
        if (n_in != 14 || out_size != NTOK * D_MODEL || ws_size < WS_END) {
            fprintf(stderr, "kernel_launch: unexpected problem (n_in %d, out %d, ws %zu, need %zu)\n", n_in, out_size, ws_size, (size_t)WS_END); grid_blocks = -1; return;
        }
        int dev = 0, cus = 0, per_cu = 0;
        hipGetDevice(&dev);
        hipDeviceGetAttribute(&cus, hipDeviceAttributeMultiprocessorCount, dev);
        if (hipFuncSetAttribute((const void*)mega_fwd, hipFuncAttributeMaxDynamicSharedMemorySize, LDS_BYTES) != hipSuccess) { fprintf(stderr, "kernel_launch: hipFuncSetAttribute failed\n"); }
        if (hipOccupancyMaxActiveBlocksPerMultiprocessor(&per_cu, (const void*)mega_fwd, NTHREADS, LDS_BYTES) != hipSuccess || per_cu < 1) { fprintf(stderr, "kernel_launch: occupancy query failed\n"); per_cu = 1; }
        if (per_cu > 2) per_cu = 2;
        (void)hipGetLastError();
        grid_blocks = cus * per_cu;
        fprintf(stderr, "kernel_launch: %d CUs x %d blocks\n", cus, per_cu);
    }
    if (grid_blocks < 0) return;
    Params p{};
    p.x = (const float*)d_in[0]; p.w_in = (const float*)d_in[1]; p.idx_k_g = (const float*)d_in[2]; p.idx_k_b = (const float*)d_in[3]; p.sinks = (const float*)d_in[4];
    p.w_o = (const float*)d_in[5]; p.ln1_g = (const float*)d_in[6]; p.ln1_b = (const float*)d_in[7]; p.peer_wq = (const float*)d_in[8]; p.peer_subkeys = (const float*)d_in[9];
    p.peer_u = (const float*)d_in[10]; p.peer_v = (const float*)d_in[11]; p.ln2_g = (const float*)d_in[12]; p.ln2_b = (const float*)d_in[13];
    p.out = (float*)d_out; p.ws = (unsigned char*)d_ws;
    p.ph_lo = 0; p.ph_hi = NPHASE;
    if (hipMemsetAsync((unsigned char*)d_ws + WS_BAR, 0, XCD_BAR_WORDS * 4, stream) != hipSuccess) { fprintf(stderr, "kernel_launch: memset of the barrier words failed\n"); return; }
    void* args[] = {&p};
    hipError_t e = hipLaunchCooperativeKernel((const void*)mega_fwd, dim3(grid_blocks), dim3(NTHREADS), args, LDS_BYTES, stream);
    if (e != hipSuccess) fprintf(stderr, "cooperative launch failed: %s (grid %d)\n", hipGetErrorString(e), grid_blocks);
}
```

```cpp
#include <hip/hip_runtime.h>
#include <hip/hip_cooperative_groups.h>
#include <cstdio>
#include <cstdint>
namespace cg = cooperative_groups;

typedef unsigned short bf16_t;
typedef short bf16x8 __attribute__((ext_vector_type(8)));
typedef float f32x4 __attribute__((ext_vector_type(4)));
typedef float f32x16 __attribute__((ext_vector_type(16)));
typedef unsigned u32x4 __attribute__((ext_vector_type(4)));
typedef unsigned u32x2 __attribute__((ext_vector_type(2)));
#define DI __device__ __forceinline__

constexpr int D_MODEL = 1024, BATCH = 8, SEQ = 4096, NTOK = BATCH * SEQ;
constexpr int NMIX = 1732, NMIX_PAD = 1792;
constexpr int PEER_N = 2048;
constexpr float ALPHA = 1.189207115002721f;
constexpr float LN_EPS = 1e-5f;
constexpr int NTHREADS = 256;
constexpr int LDS_BYTES = 77824;

constexpr size_t MB = 1024 * 1024;
constexpr size_t WS_CTL   = 0;
constexpr size_t WS_BAR   = 65536;
constexpr size_t WS_ROPE  = 1 * MB;
constexpr size_t WS_WINT  = 2 * MB;
constexpr size_t WS_WOT   = 6 * MB;
constexpr size_t WS_WQT   = 8 * MB;
constexpr size_t WS_SK    = 12 * MB;
constexpr size_t WS_UT    = 13 * MB;
constexpr size_t WS_VT    = 29 * MB;
constexpr size_t WS_SU    = 45 * MB;
constexpr size_t WS_SV    = 46 * MB;
constexpr size_t WS_SX    = 47 * MB;
constexpr size_t WS_XB    = 77 * MB;
constexpr size_t WS_QA    = 141 * MB;
constexpr size_t WS_KA    = 173 * MB;
constexpr size_t WS_VA    = 181 * MB;
constexpr size_t WS_QB    = 189 * MB;
constexpr size_t WS_KB    = 221 * MB;
constexpr size_t WS_VB    = 225 * MB;
constexpr size_t WS_QI    = 229 * MB;
constexpr size_t WS_KI    = 245 * MB;
constexpr size_t WS_WI    = 249 * MB;
constexpr size_t WS_ATT   = 250 * MB;
constexpr size_t WS_PE    = 314 * MB;
constexpr size_t WS_PG    = 322 * MB;
constexpr size_t WS_PS    = 338 * MB;
constexpr size_t WS_END   = 354 * MB;

struct Params {
    const float* x; const float* w_in; const float* idx_k_g; const float* idx_k_b; const float* sinks; const float* w_o;
    const float* ln1_g; const float* ln1_b; const float* peer_wq; const float* peer_subkeys; const float* peer_u; const float* peer_v;
    const float* ln2_g; const float* ln2_b;
    float* out; unsigned char* ws;
    int ph_lo, ph_hi;
};

typedef float f32x2 __attribute__((ext_vector_type(2)));
typedef __bf16 bf16x2_t __attribute__((ext_vector_type(2)));
DI unsigned pack_bf16(float lo, float hi) { const f32x2 v = {lo, hi}; return __builtin_bit_cast(unsigned, __builtin_convertvector(v, bf16x2_t)); }
DI unsigned f2bf(float x) { return pack_bf16(x, 0.f) & 0xffffu; }
DI float bf_lo(unsigned w) { return __uint_as_float(w << 16); }
DI float bf_hi(unsigned w) { return __uint_as_float(w & 0xffff0000u); }
DI bf16x8 as_bf16x8(u32x4 v) { return __builtin_bit_cast(bf16x8, v); }
DI u32x4 ldg16(const void* p) { return *(const u32x4*)p; }
DI f32x4 mfma16(bf16x8 a, bf16x8 b, f32x4 c) { return __builtin_amdgcn_mfma_f32_16x16x32_bf16(a, b, c, 0, 0, 0); }
DI f32x16 mfma32(bf16x8 a, bf16x8 b, f32x16 c) { return __builtin_amdgcn_mfma_f32_32x32x16_bf16(a, b, c, 0, 0, 0); }
DI float wave_sum(float v) {
#pragma unroll
    for (int o = 32; o >= 1; o >>= 1) v += __shfl_xor(v, o);
    return v;
}

DI void glds16(const void* src, void* lds_dst) { __builtin_amdgcn_global_load_lds((const unsigned*)src, (__attribute__((address_space(3))) unsigned*)lds_dst, 16, 0, 0); }
DI void gemm_128x128(const bf16_t* __restrict__ X, int ldx, const bf16_t* __restrict__ Wt, int ldw, int K, unsigned char* lds, f32x4 (&acc)[4][4]) {
    int tid = threadIdx.x; asm volatile("" : "+v"(tid));
    const int lane = tid & 63, wave = tid >> 6, wm = wave >> 1, wn = wave & 1, c = lane & 15, g = lane >> 4;
    const int lrow = tid >> 3, lch = tid & 7;
    const bf16_t* xp = X + (size_t)lrow * ldx + ((lch ^ (lrow & 7)) * 8);
    const bf16_t* wp = Wt + (size_t)lrow * ldw + ((lch ^ (lrow & 7)) * 8);
    unsigned char* dst0 = lds + tid * 16;
#pragma unroll
    for (int m = 0; m < 4; ++m)
#pragma unroll
        for (int n = 0; n < 4; ++n) acc[m][n] = (f32x4){0.f, 0.f, 0.f, 0.f};
    const int nk = K / 64;
    __syncthreads();
#pragma unroll
    for (int i = 0; i < 4; ++i) { glds16(xp + (size_t)(32 * i) * ldx, dst0 + i * 4096); glds16(wp + (size_t)(32 * i) * ldw, dst0 + 16384 + i * 4096); }
    asm volatile("s_waitcnt vmcnt(0)" ::: "memory");
    __syncthreads();
    for (int kt = 0; kt < nk; ++kt) {
        const unsigned char* Xs = lds + (kt & 1) * 32768; const unsigned char* Ws = Xs + 16384;
        if (kt + 1 < nk) {
            unsigned char* d = dst0 + ((kt + 1) & 1) * 32768;
#pragma unroll
            for (int i = 0; i < 4; ++i) { glds16(xp + (size_t)(32 * i) * ldx + (kt + 1) * 64, d + i * 4096); glds16(wp + (size_t)(32 * i) * ldw + (kt + 1) * 64, d + 16384 + i * 4096); }
        }
#pragma unroll
        for (int s = 0; s < 2; ++s) {
            bf16x8 xf[4], wf[4];
#pragma unroll
            for (int m = 0; m < 4; ++m) { const int row = wm * 64 + m * 16 + c; xf[m] = as_bf16x8(*(const u32x4*)(Xs + row * 128 + (((4 * s + g) ^ (c & 7)) << 4))); }
#pragma unroll
            for (int n = 0; n < 4; ++n) { const int row = wn * 64 + n * 16 + c; wf[n] = as_bf16x8(*(const u32x4*)(Ws + row * 128 + (((4 * s + g) ^ (c & 7)) << 4))); }
#pragma unroll
            for (int m = 0; m < 4; ++m)
#pragma unroll
                for (int n = 0; n < 4; ++n) acc[m][n] = mfma16(wf[n], xf[m], acc[m][n]);
        }
        asm volatile("s_waitcnt vmcnt(0)" ::: "memory");
        __syncthreads();
    }
}

DI bool tile_of(int k, int NT, int MT, int& mt, int& nt) {
    const int G = gridDim.x, bid = blockIdx.x;
    if (((G | MT) & 7) == 0) {
        const int idx = (bid >> 3) + k * (G >> 3);
        if (idx >= (MT >> 3) * NT) return false;
        mt = (idx / NT) * 8 + (bid & 7); nt = idx % NT;
    } else {
        const int t = bid + k * G;
        if (t >= MT * NT) return false;
        mt = t / NT; nt = t % NT;
    }
    return true;
}

DI void p0_prep(const Params& p, unsigned char* lds) {
    const int tid = threadIdx.x, nb = gridDim.x, bid = blockIdx.x;
    const size_t gtid = (size_t)bid * NTHREADS + tid, gsz = (size_t)nb * NTHREADS;
    unsigned char* ws = p.ws;
    {
        float* ct = (float*)(ws + WS_ROPE); float* stb = ct + SEQ * 32;
        for (size_t i = gtid; i < (size_t)SEQ * 32; i += gsz) {
            const int pos = (int)(i >> 5), fi = (int)(i & 31);
            const float inv = powf(10000.0f, -(float)(2 * fi) / 64.0f);
            const float ang = (float)pos * inv;
            ct[i] = cosf(ang); stb[i] = sinf(ang);
        }
    }
    auto conv = [&](const float* src, bf16_t* dst, size_t n) {
        for (size_t i = gtid * 8; i < n; i += gsz * 8) {
            const f32x4 a = *(const f32x4*)(src + i), b = *(const f32x4*)(src + i + 4);
            u32x4 o; o.x = pack_bf16(a.x, a.y); o.y = pack_bf16(a.z, a.w); o.z = pack_bf16(b.x, b.y); o.w = pack_bf16(b.z, b.w);
            *(u32x4*)(dst + i) = o;
        }
    };
    conv(p.x, (bf16_t*)(ws + WS_XB), (size_t)NTOK * D_MODEL);
    conv(p.peer_subkeys, (bf16_t*)(ws + WS_SK), (size_t)8 * 2 * 128 * 128);
    float* tl = (float*)lds;
    auto transp = [&](const float* src, bf16_t* dst, int N, int Npad) {
        const int tn = Npad / 64, tk = 1024 / 64;
        for (int t = bid; t < tn * tk; t += nb) {
            const int n0 = (t % tn) * 64, k0 = (t / tn) * 64;
            __syncthreads();
            for (int e = tid; e < 4096; e += NTHREADS) { const int kk = e >> 6, nn = e & 63; tl[kk * 65 + nn] = (n0 + nn < N) ? src[(size_t)(k0 + kk) * N + n0 + nn] : 0.f; }
            __syncthreads();
            for (int e = tid; e < 4096; e += NTHREADS) { const int nn = e >> 6, kk = e & 63; dst[(size_t)(n0 + nn) * 1024 + k0 + kk] = (bf16_t)f2bf(tl[kk * 65 + nn]); }
        }
    };
    transp(p.w_in, (bf16_t*)(ws + WS_WINT), NMIX, NMIX_PAD);
}

DI void p0_late(const Params& p, unsigned char* lds) {
    const int tid = threadIdx.x, nb = gridDim.x, bid = blockIdx.x;
    unsigned char* ws = p.ws;
    {
        const int lane = tid & 63, gw = bid * 4 + (tid >> 6), nw = nb * 4;
        for (int row0 = gw * 4; row0 < 2 * 16384; row0 += nw * 4) {
            f32x4 v[4][4];
#pragma unroll
            for (int r = 0; r < 4; ++r) {
                const int row = row0 + r; const bool isv = row >= 16384; const int e = isv ? row - 16384 : row;
                const float* src = (isv ? p.peer_v : p.peer_u) + (size_t)e * 1024 + lane * 16;
#pragma unroll
                for (int i = 0; i < 4; ++i) v[r][i] = *(const f32x4*)(src + 4 * i);
            }
#pragma unroll
            for (int r = 0; r < 4; ++r) {
                const int row = row0 + r; const bool isv = row >= 16384; const int e = isv ? row - 16384 : row;
                float mx = 0.f;
#pragma unroll
                for (int i = 0; i < 4; ++i) mx = fmaxf(mx, fmaxf(fmaxf(fabsf(v[r][i][0]), fabsf(v[r][i][1])), fmaxf(fabsf(v[r][i][2]), fabsf(v[r][i][3]))));
#pragma unroll
                for (int o = 32; o >= 1; o >>= 1) mx = fmaxf(mx, __shfl_xor(mx, o));
                const float sc = mx > 0.f ? mx * (1.0f / 5.99f) : 1.0f, inv = mx > 0.f ? 5.99f / mx : 1.0f;
                u32x2 o2;
#pragma unroll
                for (int k = 0; k < 2; ++k) {
                    unsigned w = 0;
                    w = __builtin_amdgcn_cvt_scalef32_pk_fp4_f32(w, v[r][2 * k][0] * inv, v[r][2 * k][1] * inv, 1.0f, 0);
                    w = __builtin_amdgcn_cvt_scalef32_pk_fp4_f32(w, v[r][2 * k][2] * inv, v[r][2 * k][3] * inv, 1.0f, 1);
                    w = __builtin_amdgcn_cvt_scalef32_pk_fp4_f32(w, v[r][2 * k + 1][0] * inv, v[r][2 * k + 1][1] * inv, 1.0f, 2);
                    w = __builtin_amdgcn_cvt_scalef32_pk_fp4_f32(w, v[r][2 * k + 1][2] * inv, v[r][2 * k + 1][3] * inv, 1.0f, 3);
                    o2[k] = w;
                }
                *(u32x2*)(ws + (isv ? WS_VT : WS_UT) + (size_t)e * 512 + lane * 8) = o2;
                if (lane == 0) ((float*)(ws + (isv ? WS_SV : WS_SU)))[e] = sc;
            }
        }
    }
    float* tl = (float*)lds;
    auto transp = [&](const float* src, bf16_t* dst, int N, int Npad) {
        const int tn = Npad / 64, tk = 1024 / 64;
        for (int t = bid; t < tn * tk; t += nb) {
            const int n0 = (t % tn) * 64, k0 = (t / tn) * 64;
            __syncthreads();
            for (int e = tid; e < 4096; e += NTHREADS) { const int kk = e >> 6, nn = e & 63; tl[kk * 65 + nn] = (n0 + nn < N) ? src[(size_t)(k0 + kk) * N + n0 + nn] : 0.f; }
            __syncthreads();
            for (int e = tid; e < 4096; e += NTHREADS) { const int nn = e >> 6, kk = e & 63; dst[(size_t)(n0 + nn) * 1024 + k0 + kk] = (bf16_t)f2bf(tl[kk * 65 + nn]); }
        }
    };
    transp(p.w_o, (bf16_t*)(ws + WS_WOT), 1024, 1024);
    transp(p.peer_wq, (bf16_t*)(ws + WS_WQT), PEER_N, PEER_N);
}

DI void p1_inproj(const Params& p, unsigned char* lds) {
    unsigned char* ws = p.ws;
    const bf16_t* XB = (const bf16_t*)(ws + WS_XB); const bf16_t* WT = (const bf16_t*)(ws + WS_WINT);
    const float* cosT = (const float*)(ws + WS_ROPE); const float* sinT = cosT + SEQ * 32;
    const int tid = threadIdx.x, lane = tid & 63, wave = tid >> 6, wm = wave >> 1, wn = wave & 1, c = lane & 15, g = lane >> 4;
    constexpr int NT = NMIX_PAD / 128, MT = NTOK / 128;
    int mt, nt;
    for (int k = 0; tile_of(k, NT, MT, mt, nt); ++k) {
        f32x4 acc[4][4];
        gemm_128x128(XB + (size_t)mt * 128 * 1024, 1024, WT + (size_t)nt * 128 * 1024, 1024, 1024, lds, acc);
        const int col64 = nt * 2 + wn;
        bf16_t* dst; int ld, coff; bool rope = true; float scale = 1.f;
        if (col64 < 8)       { dst = (bf16_t*)(ws + WS_QA); ld = 512; coff = col64 * 64; scale = 0.125f; }
        else if (col64 < 10) { dst = (bf16_t*)(ws + WS_KA); ld = 128; coff = (col64 - 8) * 64; }
        else if (col64 < 12) { dst = (bf16_t*)(ws + WS_VA); ld = 128; coff = (col64 - 10) * 64; rope = false; }
        else if (col64 < 20) { dst = (bf16_t*)(ws + WS_QB); ld = 512; coff = (col64 - 12) * 64; scale = 0.125f; }
        else if (col64 == 20) { dst = (bf16_t*)(ws + WS_KB); ld = 64; coff = 0; }
        else if (col64 == 21) { dst = (bf16_t*)(ws + WS_VB); ld = 64; coff = 0; rope = false; }
        else if (col64 < 26) { dst = (bf16_t*)(ws + WS_QI); ld = 256; coff = (col64 - 22) * 64; }
        else                 { dst = (bf16_t*)(ws + WS_KI); ld = 64; coff = 0; }
        if (col64 == 27) {
            if (g == 0) {
#pragma unroll
                for (int m = 0; m < 4; ++m) { const int tok = mt * 128 + wm * 64 + m * 16 + c; *(f32x4*)((float*)(ws + WS_WI) + (size_t)tok * 4) = acc[m][0] * 0.0625f; }
            }
            continue;
        }
#pragma unroll
        for (int m = 0; m < 4; ++m) {
            const int tok = mt * 128 + wm * 64 + m * 16 + c, pos = tok & (SEQ - 1);
            f32x4 v[4] = {acc[m][0], acc[m][1], acc[m][2], acc[m][3]};
            if (col64 == 26) {
                float s = 0.f;
#pragma unroll
                for (int n = 0; n < 4; ++n) s += (v[n][0] + v[n][1]) + (v[n][2] + v[n][3]);
                s += __shfl_xor(s, 16); s += __shfl_xor(s, 32);
                const float mu = s * (1.f / 64.f); float q = 0.f;
#pragma unroll
                for (int n = 0; n < 4; ++n) { const f32x4 d = v[n] - mu; q += (d[0] * d[0] + d[1] * d[1]) + (d[2] * d[2] + d[3] * d[3]); }
                q += __shfl_xor(q, 16); q += __shfl_xor(q, 32);
                const float rstd = rsqrtf(q * (1.f / 64.f) + LN_EPS);
#pragma unroll
                for (int n = 0; n < 4; ++n) {
                    const f32x4 gg = *(const f32x4*)(p.idx_k_g + 16 * n + 4 * g), bb = *(const f32x4*)(p.idx_k_b + 16 * n + 4 * g);
                    v[n] = (v[n] - mu) * rstd * gg + bb;
                }
            }
            if (rope) {
#pragma unroll
                for (int n = 0; n < 2; ++n) {
                    const f32x4 cs = *(const f32x4*)(cosT + pos * 32 + 16 * n + 4 * g), sn = *(const f32x4*)(sinT + pos * 32 + 16 * n + 4 * g);
                    const f32x4 t1 = v[n], t2 = v[n + 2];
                    v[n] = t1 * cs - t2 * sn; v[n + 2] = t2 * cs + t1 * sn;
                }
            }
#pragma unroll
            for (int n = 0; n < 4; ++n) {
                const f32x4 o = v[n] * scale; u32x2 w; w.x = pack_bf16(o[0], o[1]); w.y = pack_bf16(o[2], o[3]);
                *(u32x2*)(dst + (size_t)tok * ld + coff + 16 * n + 4 * g) = w;
            }
        }
    }
}

constexpr int NDSA = NTOK / 4, NSWA = BATCH * 32 * 8;
constexpr int P2_STG = 0  , P2_LIST = 32768;

DI unsigned f16_key(float v) {
    _Float16 hv = (_Float16)v; unsigned short hb = __builtin_bit_cast(unsigned short, hv); unsigned b = hb;
    if (b == 0x8000u) b = 0u;
    return (b & 0x8000u) ? ((~b) & 0xffffu) : (b | 0x8000u);
}

DI size_t sc_row_off(int t) { const size_t m = (size_t)(t >> 3); return 8 * (4 * m * (m + 1) + (size_t)(t & 7) * (m + 1)); }
constexpr size_t SC_BATCH = 8404992;
DI unsigned short* sc_batch_base(const Params& p, int b) { return (b < 7) ? (unsigned short*)p.out + (size_t)b * SC_BATCH : (unsigned short*)(p.ws + WS_PG); }

DI void p2a_indexer(const Params& p, unsigned char* lds) {
    unsigned char* ws = p.ws;
    const bf16_t* QI = (const bf16_t*)(ws + WS_QI); const bf16_t* KI = (const bf16_t*)(ws + WS_KI); const float* WI = (const float*)(ws + WS_WI);
    const int G = gridDim.x, bi = blockIdx.x;
    for (int it = 0; it < 2; ++it) {
        const int item = (it == 0) ? bi : 1023 - bi;
        for (int id = (G == 512) ? item : bi + it * G; id < 1024; id += (G == 512) ? 1024 : 2 * G) {
            int tid = threadIdx.x; asm volatile("" : "+v"(tid));
            const int lane = tid & 63, wave = tid >> 6, c = lane & 15, g = lane >> 4, lrow = tid >> 3, lch = tid & 7;
            const int b = id >> 7, t0 = (id & 127) * 32, tokw = b * SEQ + t0 + 8 * wave;
            unsigned short* scb = sc_batch_base(p, b);
            bf16x8 af[2][2]; f32x4 wv[2];
#pragma unroll
            for (int rt = 0; rt < 2; ++rt) {
#pragma unroll
                for (int s2 = 0; s2 < 2; ++s2) af[rt][s2] = as_bf16x8(ldg16(QI + (size_t)(tokw + 4 * rt + (c >> 2)) * 256 + (c & 3) * 64 + 32 * s2 + 8 * g));
                wv[rt] = *(const f32x4*)(WI + (size_t)(tokw + 4 * rt + g) * 4);
            }
            asm volatile("" :: "v"(af[0][0]), "v"(af[0][1]), "v"(af[1][0]), "v"(af[1][1]), "v"(wv[0]), "v"(wv[1]));
            const int nkt = ((t0 + 31) >> 7) + 1;
            const unsigned char* kib = (const unsigned char*)(KI + (size_t)b * SEQ * 64);
            unsigned char* dst0 = lds + tid * 16;
            auto stage = [&](int kt, int buf) {
#pragma unroll
                for (int i = 0; i < 4; ++i) {
                    const int row = lrow + 32 * i;
                    glds16(kib + (size_t)(kt * 128 + row) * 128 + ((lch ^ ((row >> 3) & 7)) << 4), dst0 + buf * 16384 + i * 4096);
                }
            };
            __syncthreads();
            stage(0, 0); if (nkt > 1) stage(1, 1);
            for (int kt = 0; kt < nkt; ++kt) {
                if (kt + 1 < nkt) asm volatile("s_waitcnt vmcnt(4)" ::: "memory");
                else asm volatile("s_waitcnt vmcnt(0)" ::: "memory");
                asm volatile("s_waitcnt lgkmcnt(0)" ::: "memory");
                __builtin_amdgcn_s_barrier();
                if (kt + 2 < nkt) stage(kt + 2, (kt + 2) % 3);
                const unsigned char* Ks = lds + (kt % 3) * 16384;
                unsigned res[2][4];
#pragma unroll
                for (int ct = 0; ct < 8; ++ct) {
                    const int row = 8 * c + ct;
                    const bf16x8 k0 = as_bf16x8(*(const u32x4*)(Ks + row * 128 + ((g ^ (c & 7)) << 4)));
                    const bf16x8 k1 = as_bf16x8(*(const u32x4*)(Ks + row * 128 + (((4 + g) ^ (c & 7)) << 4)));
#pragma unroll
                    for (int rt = 0; rt < 2; ++rt) {
                        f32x4 d = mfma16(af[rt][0], k0, (f32x4){0.f, 0.f, 0.f, 0.f});
                        d = mfma16(af[rt][1], k1, d);
                        const float sv = wv[rt][0] * fmaxf(d[0], 0.f) + wv[rt][1] * fmaxf(d[1], 0.f) + wv[rt][2] * fmaxf(d[2], 0.f) + wv[rt][3] * fmaxf(d[3], 0.f);
                        const int key = kt * 128 + row, tq = t0 + 8 * wave + 4 * rt + g;
                        const unsigned kv = (key <= tq) ? f16_key(sv) : 0u;
                        if (ct & 1) res[rt][ct >> 1] |= kv << 16; else res[rt][ct >> 1] = kv;
                    }
                }
#pragma unroll
                for (int rt = 0; rt < 2; ++rt) {
                    const int tq = t0 + 8 * wave + 4 * rt + g;
                    if (16 * kt + c <= (tq >> 3)) {
                        u32x4 w; w.x = res[rt][0]; w.y = res[rt][1]; w.z = res[rt][2]; w.w = res[rt][3];
                        *(u32x4*)(scb + sc_row_off(tq) + kt * 128 + 8 * c) = w;
                    }
                }
            }
        }
    }
    __syncthreads();
    p0_late(p, lds);
}

template <int MODE> DI void p2_dsa_item(const Params& p, unsigned char* lds, int b, int tb) {
    unsigned char* ws = p.ws;
    const bf16_t* QI = (const bf16_t*)(ws + WS_QI); const bf16_t* KI = (const bf16_t*)(ws + WS_KI); const float* WI = (const float*)(ws + WS_WI);
    const bf16_t* QB = (const bf16_t*)(ws + WS_QB); const bf16_t* KB = (const bf16_t*)(ws + WS_KB); const bf16_t* VB = (const bf16_t*)(ws + WS_VB);
    bf16_t* ATT = (bf16_t*)(ws + WS_ATT);
    int tid = threadIdx.x; asm volatile("" : "+v"(tid));
    const int lane = tid & 63, wave = __builtin_amdgcn_readfirstlane(tid >> 6), c = lane & 15, g = lane >> 4;
    const int t0 = tb * 4, tok0 = b * SEQ + t0;
    unsigned char* stg = lds + P2_STG + wave * 8192;
    unsigned* hist = (unsigned*)stg;
    unsigned short* list = (unsigned short*)(lds + P2_LIST) + wave * 256;
    const int tok = tok0 + wave;
    if (!(MODE & 2)) return;
    const int n = t0 + wave + 1;
    const int L = n < 256 ? n : 256;
    const unsigned short* myk = sc_batch_base(p, b) + sc_row_off(t0 + wave);
    if (n <= 256) {
        for (int i = lane; i < n; i += 64) list[i] = (unsigned short)i;
    } else {
        u32x4 kk[8];
#pragma unroll
        for (int i = 0; i < 8; ++i) kk[i] = (512 * i + 8 * lane < n) ? ldg16(myk + 512 * i + 8 * lane) : (u32x4){0u, 0u, 0u, 0u};
#pragma unroll
        for (int i = 0; i < 4; ++i) *(u32x4*)(hist + lane * 16 + i * 4) = (u32x4){0u, 0u, 0u, 0u};
#pragma unroll
        for (int i = 0; i < 8; ++i) {
            if (512 * i < n) {
#pragma unroll
                for (int w = 0; w < 4; ++w) { const unsigned wd = kk[i][w]; atomicAdd(&hist[(wd & 0xffffu) >> 6], 1u); atomicAdd(&hist[wd >> 22], 1u); }
            }
        }
        unsigned h[16];
#pragma unroll
        for (int i = 0; i < 4; ++i) { const u32x4 t = *(const u32x4*)(hist + lane * 16 + i * 4); h[4 * i] = t.x; h[4 * i + 1] = t.y; h[4 * i + 2] = t.z; h[4 * i + 3] = t.w; }
#pragma unroll
        for (int i = 0; i < 4; ++i) *(u32x4*)(hist + lane * 16 + i * 4) = (u32x4){0u, 0u, 0u, 0u};
        unsigned sl = 0;
#pragma unroll
        for (int i = 0; i < 16; ++i) sl += h[i];
        unsigned pre = sl;
#pragma unroll
        for (int o = 1; o < 64; o <<= 1) { const unsigned t = __shfl_up(pre, o); if (lane >= o) pre += t; }
        const unsigned tot = __shfl(pre, 63);
        const unsigned suf = tot - pre;
        int found = -1; unsigned cab = 0, cum = suf;
#pragma unroll
        for (int j = 15; j >= 0; --j) { const bool hit = (found < 0) && (cum + h[j] >= 256u); if (hit) { found = lane * 16 + j; cab = cum; } cum += h[j]; }
        const bool mine = (suf < 256u) && (suf + sl >= 256u);
        const unsigned long long mm = __ballot(mine);
        const int src = __ffsll((long long)mm) - 1;
        const unsigned bstar = (unsigned)__shfl(found, src), cabove = __shfl(cab, src);
        const unsigned r1 = 256u - cabove;
#pragma unroll
        for (int i = 0; i < 8; ++i) {
            if (512 * i < n) {
#pragma unroll
                for (int w = 0; w < 4; ++w) {
                    const unsigned wd = kk[i][w];
                    if (((wd & 0xffffu) >> 6) == bstar) atomicAdd(&hist[wd & 63u], 1u);
                    if ((wd >> 22) == bstar) atomicAdd(&hist[(wd >> 16) & 63u], 1u);
                }
            }
        }
        const unsigned cnt = hist[lane];
        hist[lane] = 0u;
        unsigned pre2 = cnt;
#pragma unroll
        for (int o = 1; o < 64; o <<= 1) { const unsigned t = __shfl_up(pre2, o); if (lane >= o) pre2 += t; }
        const unsigned tot2 = __shfl(pre2, 63);
        const unsigned suf2 = tot2 - pre2;
        const bool mine2 = (suf2 < r1) && (suf2 + cnt >= r1);
        const unsigned long long mm2 = __ballot(mine2);
        const int src2 = __ffsll((long long)mm2) - 1;
        const unsigned T = (bstar << 6) | (unsigned)src2;
        const unsigned req = r1 - __shfl(suf2, src2);
        const unsigned toteq = __shfl(cnt, src2);
        const bool alleq = (req == toteq);
        const unsigned Tt = alleq ? T : T + 1u;
        unsigned cg = 0;
#pragma unroll
        for (int i = 0; i < 8; ++i)
#pragma unroll
            for (int w = 0; w < 4; ++w) { const unsigned wd = kk[i][w]; cg += ((wd & 0xffffu) >= Tt) ? 1u : 0u; cg += ((wd >> 16) >= Tt) ? 1u : 0u; }
        unsigned pre3 = cg;
#pragma unroll
        for (int o = 1; o < 64; o <<= 1) { const unsigned t = __shfl_up(pre3, o); if (lane >= o) pre3 += t; }
        unsigned off = pre3 - cg;
#pragma unroll
        for (int i = 0; i < 8; ++i)
#pragma unroll
            for (int w = 0; w < 4; ++w) {
                const unsigned wd = kk[i][w]; const int idx = 512 * i + 8 * lane + 2 * w;
                if ((wd & 0xffffu) >= Tt) { list[off & 255u] = (unsigned short)idx; ++off; }
                if ((wd >> 16) >= Tt) { list[off & 255u] = (unsigned short)(idx + 1); ++off; }
            }
        if (!alleq) {
            const unsigned cgt = 256u - req; unsigned eq_run = 0;
            for (int base = 0; base < n; base += 64) {
                const int i = base + lane; const unsigned m = (i < n) ? myk[i] : 0u;
                const bool eq = (m == T);
                const unsigned long long eqm = __ballot(eq);
                const unsigned rank = eq_run + __builtin_amdgcn_mbcnt_hi((unsigned)(eqm >> 32), __builtin_amdgcn_mbcnt_lo((unsigned)eqm, 0u));
                if (eq && rank < req) list[cgt + rank] = (unsigned short)i;
                eq_run += (unsigned)__popcll(eqm);
            }
        }
    }
    if (!(MODE & 4)) return;
    bf16x8 qf[2], sel[2];
#pragma unroll
    for (int s = 0; s < 2; ++s) {
        u32x4 t = (u32x4){0u, 0u, 0u, 0u};
        if (c < 8) t = ldg16(QB + (size_t)tok * 512 + c * 64 + 32 * s + 8 * g);
        qf[s] = as_bf16x8(t);
#pragma unroll
        for (int j = 0; j < 8; ++j) sel[s][j] = (8 * g + j == 16 * s + c) ? (short)0x3F80 : (short)0;
    }
    f32x4 st[16];
    const unsigned char* kbb = (const unsigned char*)(KB + (size_t)b * SEQ * 64); const unsigned char* vbb = (const unsigned char*)(VB + (size_t)b * SEQ * 64);
    const int lr = lane >> 3, lc = lane & 7;
    const unsigned st_off = lr * 128 + ((lc ^ lr) << 4);
    auto loadg = [&](const unsigned char* base, int T0, u32x4 (&dst)[8]) {
#pragma unroll
        for (int i = 0; i < 8; ++i) {
            const int idx = T0 * 16 + i * 8 + lr; const unsigned kid = (idx < L) ? (unsigned)list[idx] : 0u;
            dst[i] = ldg16(base + kid * 128u + lc * 16u);
        }
    };
    auto stage = [&](const u32x4 (&src)[8]) {
#pragma unroll
        for (int i = 0; i < 8; ++i) *(u32x4*)(stg + i * 1024 + st_off) = src[i];
    };
    auto frag = [&](int u, int s2) -> bf16x8 { return as_bf16x8(*(const u32x4*)(stg + (16 * u + c) * 128 + (((4 * s2 + g) ^ (c & 7)) << 4))); };
    auto scoreK = [&](int T0) {
#pragma unroll
        for (int T = 0; T < 4; ++T) {
            f32x4 d = mfma16(frag(T, 0), qf[0], (f32x4){0.f, 0.f, 0.f, 0.f});
            st[T0 + T] = mfma16(frag(T, 1), qf[1], d);
        }
    };
    u32x4 rA[8], rB[8], rC[8], rD[8];
    loadg(kbb, 0, rA); loadg(kbb, 4, rB); loadg(kbb, 8, rC); loadg(kbb, 12, rD);
    __builtin_amdgcn_sched_barrier(0);
    stage(rA); scoreK(0);
    stage(rB); scoreK(4);
    __builtin_amdgcn_sched_barrier(0);
    loadg(vbb, 0, rA); loadg(vbb, 4, rB);
    stage(rC); scoreK(8);
    stage(rD); scoreK(12);
    __builtin_amdgcn_sched_barrier(0);
    float mx = -3.0e38f;
    {
        const int lrem = L - 4 * g;
#pragma unroll
        for (int T = 0; T < 16; ++T)
#pragma unroll
            for (int r = 0; r < 4; ++r) { const float sv = (T * 16 + r < lrem) ? st[T][r] : -3.0e38f; st[T][r] = sv; mx = fmaxf(mx, sv); }
    }
    mx = fmaxf(mx, __shfl_xor(mx, 16)); mx = fmaxf(mx, __shfl_xor(mx, 32));
    float lsum = 0.f;
#pragma unroll
    for (int T = 0; T < 16; ++T)
#pragma unroll
        for (int r = 0; r < 4; ++r) { const float e = __expf(st[T][r] - mx); st[T][r] = e; lsum += e; }
    lsum += __shfl_xor(lsum, 16); lsum += __shfl_xor(lsum, 32);
    const float rl = 1.0f / lsum;
    u32x4 pfv[8];
#pragma unroll
    for (int u = 0; u < 8; ++u) {
        const int Ta = 2 * u, Tb = Ta + 1;
        pfv[u].x = pack_bf16(st[Ta][0] * rl, st[Ta][1] * rl); pfv[u].y = pack_bf16(st[Ta][2] * rl, st[Ta][3] * rl);
        pfv[u].z = pack_bf16(st[Tb][0] * rl, st[Tb][1] * rl); pfv[u].w = pack_bf16(st[Tb][2] * rl, st[Tb][3] * rl);
    }
    __builtin_amdgcn_sched_barrier(0);
    f32x4 O[4];
#pragma unroll
    for (int cb = 0; cb < 4; ++cb) O[cb] = (f32x4){0.f, 0.f, 0.f, 0.f};
    auto pv = [&](int T0) {
#pragma unroll
        for (int u = 0; u < 2; ++u) {
            const u32x4 pf = pfv[(T0 >> 1) + u];
#pragma unroll
            for (int cb = 0; cb < 4; ++cb) {
                const f32x4 z = (f32x4){0.f, 0.f, 0.f, 0.f};
                const f32x4 v0 = mfma16(frag(2 * u, cb >> 1), sel[cb & 1], z), v1 = mfma16(frag(2 * u + 1, cb >> 1), sel[cb & 1], z);
                u32x4 vf; vf.x = pack_bf16(v0[0], v0[1]); vf.y = pack_bf16(v0[2], v0[3]); vf.z = pack_bf16(v1[0], v1[1]); vf.w = pack_bf16(v1[2], v1[3]);
                O[cb] = mfma16(as_bf16x8(pf), as_bf16x8(vf), O[cb]);
            }
        }
    };
    loadg(vbb, 8, rC); loadg(vbb, 12, rD);
    __builtin_amdgcn_sched_barrier(0);
    stage(rA); pv(0);
    stage(rB); pv(4);
    __builtin_amdgcn_sched_barrier(0);
    stage(rC); pv(8);
    stage(rD); pv(12);
    if (g < 2) {
#pragma unroll
        for (int cb = 0; cb < 4; ++cb)
#pragma unroll
            for (int r = 0; r < 4; ++r) ATT[(size_t)tok * 1024 + 512 + (4 * g + r) * 64 + 16 * cb + c] = (bf16_t)f2bf(O[cb][r]);
    }
}

DI void p2_swa_item(const Params& p, int item2) {
    unsigned char* ws = p.ws;
    const bf16_t* QA = (const bf16_t*)(ws + WS_QA); const bf16_t* KA = (const bf16_t*)(ws + WS_KA); const bf16_t* VA = (const bf16_t*)(ws + WS_VA);
    bf16_t* ATT = (bf16_t*)(ws + WS_ATT);
    int tid = threadIdx.x; asm volatile("" : "+v"(tid));
    const int lane = tid & 63, wave = __builtin_amdgcn_readfirstlane(tid >> 6), r = lane & 31, h = lane >> 5;
    const int hq = item2 & 7, blk = (item2 >> 3) & 31, b = item2 >> 8, kvh = hq >> 2;
    const int qi = 32 * wave + r, tokq = b * SEQ + blk * 128 + qi;
    bf16x8 qf[4], sel[2];
#pragma unroll
    for (int s = 0; s < 4; ++s) qf[s] = as_bf16x8(ldg16(QA + (size_t)tokq * 512 + hq * 64 + 16 * s + 8 * h));
#pragma unroll
    for (int x = 0; x < 2; ++x)
#pragma unroll
        for (int j = 0; j < 8; ++j) sel[x][j] = (8 * h + j + 16 * x == r) ? (short)0x3F80 : (short)0;
    const float sink = p.sinks[hq];
    f32x16 ST[5];
#pragma unroll
    for (int ti = 0; ti < 5; ++ti) {
        const int sj = 32 * (wave + ti) + r; int pos = blk * 128 - 128 + sj; pos = pos < 0 ? 0 : pos;
        const bf16_t* kp = KA + (size_t)(b * SEQ + pos) * 128 + kvh * 64 + 8 * h;
        f32x16 d; for (int i = 0; i < 16; ++i) d[i] = 0.f;
#pragma unroll
        for (int s = 0; s < 4; ++s) d = mfma32(as_bf16x8(ldg16(kp + 16 * s)), qf[s], d);
        ST[ti] = d;
    }
    float mx = sink;
    {
        const int lo = r + 1 - 4 * h;
        const int lo0 = (blk > 0) ? lo : (lo > 128 - 32 * wave - 4 * h ? lo : 128 - 32 * wave - 4 * h);
#pragma unroll
        for (int ti = 0; ti < 5; ++ti)
#pragma unroll
            for (int reg = 0; reg < 16; ++reg) {
                const int e = 32 * ti + (reg & 3) + 8 * (reg >> 2);
                const float sv = (e >= lo0 && e < lo + 128) ? ST[ti][reg] : -3.0e38f; ST[ti][reg] = sv; mx = fmaxf(mx, sv);
            }
    }
    mx = fmaxf(mx, __shfl_xor(mx, 32));
    float lsum = 0.f;
#pragma unroll
    for (int ti = 0; ti < 5; ++ti)
#pragma unroll
        for (int reg = 0; reg < 16; ++reg) { const float e = __expf(ST[ti][reg] - mx); ST[ti][reg] = e; lsum += e; }
    lsum += __shfl_xor(lsum, 32);
    lsum += __expf(sink - mx);
    const float rl = 1.0f / lsum;
    f32x16 OT[2];
    for (int i = 0; i < 16; ++i) { OT[0][i] = 0.f; OT[1][i] = 0.f; }
#pragma unroll
    for (int ti = 0; ti < 5; ++ti) {
        const int sj = 32 * (wave + ti) + r; int pos = blk * 128 - 128 + sj; pos = pos < 0 ? 0 : pos;
        const bf16_t* vp = VA + (size_t)(b * SEQ + pos) * 128 + kvh * 64 + 8 * h;
        bf16x8 vf[4];
#pragma unroll
        for (int s = 0; s < 4; ++s) vf[s] = as_bf16x8(ldg16(vp + 16 * s));
        u32x4 pb[2];
#pragma unroll
        for (int s2 = 0; s2 < 2; ++s2) {
            pb[s2].x = pack_bf16(ST[ti][8 * s2 + 0] * rl, ST[ti][8 * s2 + 1] * rl); pb[s2].y = pack_bf16(ST[ti][8 * s2 + 2] * rl, ST[ti][8 * s2 + 3] * rl);
            pb[s2].z = pack_bf16(ST[ti][8 * s2 + 4] * rl, ST[ti][8 * s2 + 5] * rl); pb[s2].w = pack_bf16(ST[ti][8 * s2 + 6] * rl, ST[ti][8 * s2 + 7] * rl);
        }
#pragma unroll
        for (int db = 0; db < 2; ++db) {
            f32x16 vt; for (int i = 0; i < 16; ++i) vt[i] = 0.f;
            vt = mfma32(vf[2 * db], sel[0], vt); vt = mfma32(vf[2 * db + 1], sel[1], vt);
#pragma unroll
            for (int s2 = 0; s2 < 2; ++s2) {
                u32x4 va; va.x = pack_bf16(vt[8 * s2 + 0], vt[8 * s2 + 1]); va.y = pack_bf16(vt[8 * s2 + 2], vt[8 * s2 + 3]);
                va.z = pack_bf16(vt[8 * s2 + 4], vt[8 * s2 + 5]); va.w = pack_bf16(vt[8 * s2 + 6], vt[8 * s2 + 7]);
                OT[db] = mfma32(as_bf16x8(va), as_bf16x8(pb[s2]), OT[db]);
            }
        }
    }
#pragma unroll
    for (int db = 0; db < 2; ++db)
#pragma unroll
        for (int q4 = 0; q4 < 4; ++q4) {
            u32x2 w; w.x = pack_bf16(OT[db][4 * q4], OT[db][4 * q4 + 1]); w.y = pack_bf16(OT[db][4 * q4 + 2], OT[db][4 * q4 + 3]);
            *(u32x2*)(ATT + (size_t)tokq * 1024 + hq * 64 + 32 * db + 8 * q4 + 4 * h) = w;
        }
}

template <int MODE> DI void p2_attention(const Params& p, unsigned char* lds, int cidx = 0) {
    const int G = gridDim.x, bi = blockIdx.x, rounds = (1024 + G - 1) / G;
    for (int b = 0; b < BATCH; ++b)
        for (int r = 0; r < rounds; ++r) {
            const int idx = (r & 1) ? r * G + (G - 1 - bi) : r * G + bi;
            if (idx < 1024) p2_dsa_item<MODE>(p, lds, b, 1023 - idx);
        }
    if (MODE & 8) for (int item2 = bi; item2 < NSWA; item2 += G) p2_swa_item(p, item2);
}

DI void p3_outproj(const Params& p, unsigned char* lds) {
    unsigned char* ws = p.ws;
    const bf16_t* ATT = (const bf16_t*)(ws + WS_ATT); const bf16_t* WT = (const bf16_t*)(ws + WS_WOT);
    const int tid = threadIdx.x, lane = tid & 63, wave = tid >> 6, wm = wave >> 1, wn = wave & 1, c = lane & 15, g = lane >> 4;
    constexpr int NT = 8, MT = NTOK / 128;
    int mt, nt;
    for (int k = 0; tile_of(k, NT, MT, mt, nt); ++k) {
        f32x4 acc[4][4];
        gemm_128x128(ATT + (size_t)mt * 128 * 1024, 1024, WT + (size_t)nt * 128 * 1024, 1024, 1024, lds, acc);
#pragma unroll
        for (int m = 0; m < 4; ++m) {
            const int tok = mt * 128 + wm * 64 + m * 16 + c;
#pragma unroll
            for (int n = 0; n < 4; ++n) {
                const size_t o = (size_t)tok * 1024 + nt * 128 + wn * 64 + 16 * n + 4 * g;
                const u32x2 xw = *(const u32x2*)((const bf16_t*)(ws + WS_XB) + o);
                const f32x4 xv = {bf_lo(xw.x), bf_hi(xw.x), bf_lo(xw.y), bf_hi(xw.y)};
                const f32x4 hv = xv * ALPHA + acc[m][n];
                u32x2 w; w.x = pack_bf16(hv[0], hv[1]); w.y = pack_bf16(hv[2], hv[3]);
                *(u32x2*)((bf16_t*)p.out + o) = w;
            }
        }
    }
}

DI void p3b_ln1(const Params& p) {
    bf16_t* H1B = (bf16_t*)(p.ws + WS_XB); const bf16_t* HP = (const bf16_t*)p.out;
    const int lane = threadIdx.x & 63, gw = blockIdx.x * 4 + (threadIdx.x >> 6), nw = gridDim.x * 4;
    for (int row = gw; row < NTOK; row += nw) {
        const u32x4 ra = ldg16(HP + (size_t)row * 1024 + lane * 16), rb = ldg16(HP + (size_t)row * 1024 + lane * 16 + 8);
        float v[16];
        v[0] = bf_lo(ra.x); v[1] = bf_hi(ra.x); v[2] = bf_lo(ra.y); v[3] = bf_hi(ra.y); v[4] = bf_lo(ra.z); v[5] = bf_hi(ra.z); v[6] = bf_lo(ra.w); v[7] = bf_hi(ra.w);
        v[8] = bf_lo(rb.x); v[9] = bf_hi(rb.x); v[10] = bf_lo(rb.y); v[11] = bf_hi(rb.y); v[12] = bf_lo(rb.z); v[13] = bf_hi(rb.z); v[14] = bf_lo(rb.w); v[15] = bf_hi(rb.w);
        float s = 0.f;
#pragma unroll
        for (int i = 0; i < 16; ++i) s += v[i];
        const float mu = wave_sum(s) * (1.f / 1024.f); float q = 0.f;
#pragma unroll
        for (int i = 0; i < 16; ++i) { const float d = v[i] - mu; q = fmaf(d, d, q); }
        const float rstd = rsqrtf(wave_sum(q) * (1.f / 1024.f) + LN_EPS);
        u32x4 oa, ob; float ov[16]; float amax = 0.f;
#pragma unroll
        for (int k4 = 0; k4 < 4; ++k4) {
            const int col = lane * 16 + k4 * 4;
            const f32x4 gg = *(const f32x4*)(p.ln1_g + col), bb = *(const f32x4*)(p.ln1_b + col);
            float o[4];
#pragma unroll
            for (int e = 0; e < 4; ++e) { o[e] = (v[k4 * 4 + e] - mu) * rstd * gg[e] + bb[e]; ov[k4 * 4 + e] = o[e]; amax = fmaxf(amax, fabsf(o[e])); }
            const unsigned w0 = pack_bf16(o[0], o[1]), w1 = pack_bf16(o[2], o[3]);
            if (k4 == 0) { oa.x = w0; oa.y = w1; } else if (k4 == 1) { oa.z = w0; oa.w = w1; } else if (k4 == 2) { ob.x = w0; ob.y = w1; } else { ob.z = w0; ob.w = w1; }
        }
        *(u32x4*)(H1B + (size_t)row * 1024 + lane * 16) = oa; *(u32x4*)(H1B + (size_t)row * 1024 + lane * 16 + 8) = ob;
        {
#pragma unroll
            for (int o2 = 32; o2 >= 1; o2 >>= 1) amax = fmaxf(amax, __shfl_xor(amax, o2));
            const float sx = amax > 0.f ? amax * (1.0f / 440.0f) : 1.0f, inv = amax > 0.f ? 440.0f / amax : 1.0f;
            u32x4 q8;
#pragma unroll
            for (int k4 = 0; k4 < 4; ++k4) {
                int w = 0;
                w = __builtin_amdgcn_cvt_pk_fp8_f32(ov[4 * k4] * inv, ov[4 * k4 + 1] * inv, w, false);
                w = __builtin_amdgcn_cvt_pk_fp8_f32(ov[4 * k4 + 2] * inv, ov[4 * k4 + 3] * inv, w, true);
                q8[k4] = (unsigned)w;
            }
            *(u32x4*)(p.ws + WS_QA + (size_t)row * 1024 + lane * 16) = q8;
            if (lane == 0) ((float*)(p.ws + WS_SX))[row] = sx;
        }
    }
}

DI int f2key(float v) { const int b = __float_as_int(v); return b ^ ((b >> 31) & 0x7fffffff); }
DI float key2f(int k) { return __int_as_float(k ^ ((k >> 31) & 0x7fffffff)); }
DI void ce_desc(int& a, int& b) { const int hi = a > b ? a : b, lo = a > b ? b : a; a = hi; b = lo; }
DI void bitonic_merge16(int (&k)[16]) {
#pragma unroll
    for (int d = 8; d >= 1; d >>= 1)
#pragma unroll
        for (int i = 0; i < 16; ++i) if ((i & d) == 0) ce_desc(k[i], k[i | d]);
}
DI void bitonic_sort16(int (&k)[16]) {
#pragma unroll
    for (int sz = 2; sz <= 16; sz <<= 1) {
#pragma unroll
        for (int i = 0; i < 16; ++i) { const int j = i ^ (sz - 1); if (j > i) ce_desc(k[i], k[j]); }
#pragma unroll
        for (int d = sz >> 2; d >= 1; d >>= 1)
#pragma unroll
            for (int i = 0; i < 16; ++i) if ((i & d) == 0) ce_desc(k[i], k[i | d]);
    }
}
DI void top16_merge(int (&t)[16], const int (&sdesc)[16]) {
#pragma unroll
    for (int i = 0; i < 16; ++i) t[i] = t[i] > sdesc[15 - i] ? t[i] : sdesc[15 - i];
    bitonic_merge16(t);
}
constexpr int P4_QS = 32768, P4_SS_STRIDE = 132, P4_ST0 = 67584  , P4_M = 0  , P4_ST1 = 8704  ;

DI void p4_peer_query(const Params& p, unsigned char* lds) {
    unsigned char* ws = p.ws;
    const bf16_t* H1B = (const bf16_t*)(ws + WS_XB); const bf16_t* WQT = (const bf16_t*)(ws + WS_WQT); const bf16_t* SK = (const bf16_t*)(ws + WS_SK);
    unsigned short* PE = (unsigned short*)(ws + WS_PE); float* PG = (float*)(ws + WS_PG); float* PS = (float*)(ws + WS_PS);
    const float* SU = (const float*)(ws + WS_SU); const float* SV = (const float*)(ws + WS_SV);
    float* Ss = (float*)lds;
    float* st0 = (float*)(lds + P4_ST0); float* mbuf = (float*)(lds + P4_M); float* st1 = (float*)(lds + P4_ST1);
    constexpr int MT = NTOK / 128;
    int mt, head;
    for (int k = 0; tile_of(k, 8, MT, mt, head); ++k) {
        int tid = threadIdx.x; asm volatile("" : "+v"(tid));
        const int lane = tid & 63, wave = tid >> 6, wm = wave >> 1, wn = wave & 1, c = lane & 15, g = lane >> 4;
        const int lrow = tid >> 3, lch = tid & 7;
        const int srow = tid & 127, shalf = tid >> 7;
#pragma unroll 1
        for (int ph = 0; ph < 2; ++ph) {
            f32x4 acc[4][4];
            gemm_128x128(H1B + (size_t)mt * 128 * 1024, 1024, WQT + (size_t)(head * 256 + ph * 128) * 1024, 1024, 1024, lds, acc);
            __syncthreads();
#pragma unroll
            for (int m = 0; m < 4; ++m)
#pragma unroll
                for (int n = 0; n < 4; ++n) {
                    const int row = wm * 64 + m * 16 + c;
                    u32x2 w; w.x = pack_bf16(acc[m][n][0], acc[m][n][1]); w.y = pack_bf16(acc[m][n][2], acc[m][n][3]);
                    *(u32x2*)(lds + P4_QS + wn * 16384 + row * 128 + (((2 * n + (g >> 1)) ^ (row & 7)) << 4) + (g & 1) * 8) = w;
                }
            {
                const bf16_t* sp = SK + (size_t)((head * 2 + ph) * 128 + lrow) * 128 + lch * 8;
#pragma unroll
                for (int k2 = 0; k2 < 2; ++k2)
#pragma unroll
                    for (int i = 0; i < 4; ++i) *(u32x4*)(lds + k2 * 16384 + (lrow + 32 * i) * 128 + ((lch ^ (lrow & 7)) << 4)) = ldg16(sp + (size_t)(32 * i) * 128 + k2 * 64);
            }
            __syncthreads();
            f32x4 a2[4][4];
#pragma unroll
            for (int m = 0; m < 4; ++m)
#pragma unroll
                for (int n = 0; n < 4; ++n) a2[m][n] = (f32x4){0.f, 0.f, 0.f, 0.f};
#pragma unroll
            for (int k2 = 0; k2 < 2; ++k2)
#pragma unroll
                for (int s = 0; s < 2; ++s) {
                    bf16x8 xf[4], wf[4];
#pragma unroll
                    for (int m = 0; m < 4; ++m) { const int row = wm * 64 + m * 16 + c; xf[m] = as_bf16x8(*(const u32x4*)(lds + P4_QS + k2 * 16384 + row * 128 + (((4 * s + g) ^ (c & 7)) << 4))); }
#pragma unroll
                    for (int n = 0; n < 4; ++n) { const int row = wn * 64 + n * 16 + c; wf[n] = as_bf16x8(*(const u32x4*)(lds + k2 * 16384 + row * 128 + (((4 * s + g) ^ (c & 7)) << 4))); }
#pragma unroll
                    for (int m = 0; m < 4; ++m)
#pragma unroll
                        for (int n = 0; n < 4; ++n) a2[m][n] = mfma16(wf[n], xf[m], a2[m][n]);
                }
            __syncthreads();
#pragma unroll
            for (int m = 0; m < 4; ++m)
#pragma unroll
                for (int n = 0; n < 4; ++n) {
                    const int key0 = wn * 64 + 16 * n + 4 * g;
                    u32x4 w;
#pragma unroll
                    for (int r = 0; r < 4; ++r) w[r] = (unsigned)f2key(__uint_as_float((__float_as_uint(a2[m][n][r]) & 0xFFFFFF80u) | (unsigned)(key0 + r)));
                    *(u32x4*)(Ss + (wm * 64 + m * 16 + c) * P4_SS_STRIDE + key0) = w;
                }
            __syncthreads();
            int tv[16];
            {
                const int* rowp = (const int*)Ss + srow * P4_SS_STRIDE + shalf * 64;
#pragma unroll
                for (int bt = 0; bt < 4; ++bt) {
                    int bk[16];
#pragma unroll
                    for (int j = 0; j < 4; ++j) { const u32x4 v = *(const u32x4*)(rowp + 16 * bt + 4 * j); bk[4 * j] = (int)v.x; bk[4 * j + 1] = (int)v.y; bk[4 * j + 2] = (int)v.z; bk[4 * j + 3] = (int)v.w; }
                    bitonic_sort16(bk);
                    if (bt == 0) {
#pragma unroll
                        for (int j = 0; j < 16; ++j) tv[j] = bk[j];
                    } else top16_merge(tv, bk);
                }
            }
            __syncthreads();
            int* mbi = (int*)mbuf;
            if (shalf == 1) {
#pragma unroll
                for (int j = 0; j < 16; ++j) mbi[srow * 17 + j] = tv[j];
            }
            __syncthreads();
            if (shalf == 0) {
                int* dst = (int*)((ph == 0) ? st0 : st1);
                int ob[16];
#pragma unroll
                for (int j = 0; j < 16; ++j) ob[j] = mbi[srow * 17 + j];
                top16_merge(tv, ob);
#pragma unroll
                for (int j = 0; j < 16; ++j) dst[srow * 17 + j] = tv[j];
            }
        }
        __syncthreads();
        int cv[16];
        {
            const int* st0i = (const int*)st0; const int* st1i = (const int*)st1;
            float v2[16];
#pragma unroll
            for (int b = 0; b < 16; ++b) v2[b] = key2f(st1i[srow * 17 + b]);
#pragma unroll
            for (int a8 = 0; a8 < 8; ++a8) {
                const int a = shalf * 8 + a8; const float va = key2f(st0i[srow * 17 + a]);
                int bk[16];
#pragma unroll
                for (int b = 0; b < 16; ++b) bk[b] = (f2key(va + v2[b]) & (int)0xFFFFFF00) | (a * 16 + 15 - b);
                if (a8 == 0) {
#pragma unroll
                    for (int j = 0; j < 16; ++j) cv[j] = bk[j];
                } else top16_merge(cv, bk);
            }
        }
        __syncthreads();
        int* mbi = (int*)mbuf;
        if (shalf == 1) {
#pragma unroll
            for (int j = 0; j < 16; ++j) mbi[srow * 17 + j] = cv[j];
        }
        __syncthreads();
        if (shalf == 0) {
            const int* st0i = (const int*)st0; const int* st1i = (const int*)st1;
            int fk[16]; float fv[16];
#pragma unroll
            for (int j = 0; j < 16; ++j) { const int o = mbi[srow * 17 + 15 - j]; fk[j] = cv[j] > o ? cv[j] : o; fv[j] = key2f(fk[j]); }
            float cmax = fv[0];
#pragma unroll
            for (int j = 1; j < 16; ++j) cmax = fmaxf(cmax, fv[j]);
            float den = 0.f; float ev[16];
#pragma unroll
            for (int j = 0; j < 16; ++j) { ev[j] = __expf(fv[j] - cmax); den += ev[j]; }
            const float rden = 1.0f / den;
            const size_t ob = (size_t)(mt * 128 + srow) * 128 + head * 16;
#pragma unroll
            for (int j = 0; j < 16; ++j) {
                const unsigned cde = (unsigned)fk[j] & 0xFFu;
                const unsigned a = cde >> 4, b = 15u - (cde & 15u);
                const unsigned i1 = __float_as_uint(key2f(st0i[srow * 17 + a])) & 0x7Fu, i2 = __float_as_uint(key2f(st1i[srow * 17 + b])) & 0x7Fu;
                const int e = (int)(i1 * 128u + i2);
                PE[ob + j] = (unsigned short)e; PG[ob + j] = ev[j] * rden * SV[e]; PS[ob + j] = SU[e];
            }
        }
        __syncthreads();
    }
}

DI float gelu_exact(float z) { return 0.5f * z * (1.0f + erff(z * 0.70710678118654752f)); }
DI float rdlane(float v, int l) { return __int_as_float(__builtin_amdgcn_readlane(__float_as_int(v), l)); }

typedef int i32x8 __attribute__((ext_vector_type(8)));
constexpr int P5A_LIST_BYTES = (2048 + 128) * 4, P5A_WAVE_LDS = P5A_LIST_BYTES + 8192;
template <int MODE>
DI void p5a_udot(const Params& p, unsigned char* lds) {
    unsigned char* ws = p.ws;
    const unsigned char* H1Q = ws + WS_QA; const unsigned char* UT = ws + WS_UT;
    const unsigned short* PE = (const unsigned short*)(ws + WS_PE); float* ZB = (float*)(ws + (MODE ? WS_QI : WS_QB));
    const int lane = threadIdx.x & 63, wave = threadIdx.x >> 6, c = lane & 15, kb = lane >> 4;
    const int G = gridDim.x, bid = blockIdx.x;
    const bool affine = (G & 7) == 0;
    const int npass = affine ? 1 : 4;
    unsigned* list = (unsigned*)(lds + wave * P5A_WAVE_LDS);
    unsigned char* slot = lds + wave * P5A_WAVE_LDS + P5A_LIST_BYTES;
    const int l31 = lane & 31, lh = lane >> 5;
    unsigned cq[8];
#pragma unroll
    for (int q = 0; q < 8; ++q) cq[q] = (unsigned)((l31 ^ (q + 8 * lh)) * 16);
    for (int pass = 0; pass < npass; ++pass) {
        const int part = affine ? (bid & 3) : pass, rank = affine ? (bid >> 2) : bid, nper = affine ? (G >> 2) : G;
        const unsigned char* UTp = UT + (size_t)part * (4096 * 512);
        for (int gid = rank * 4 + wave; gid < NTOK / 16; gid += nper * 4) {
            const int t0 = gid * 16;
            u32x4 pv[4];
#pragma unroll
            for (int i = 0; i < 4; ++i) pv[i] = ldg16(PE + (size_t)(t0 + (lane >> 2)) * 128 + (lane & 3) * 32 + 8 * i);
            i32x8 ax[8];
#pragma unroll
            for (int s2 = 0; s2 < 8; ++s2) {
                const unsigned char* xp = H1Q + (size_t)(t0 + c) * 1024 + 128 * s2 + 16 * kb;
                const u32x4 lo = ldg16(xp), hi = ldg16(xp + 64);
                ax[s2][0] = (int)lo.x; ax[s2][1] = (int)lo.y; ax[s2][2] = (int)lo.z; ax[s2][3] = (int)lo.w; ax[s2][4] = (int)hi.x; ax[s2][5] = (int)hi.y; ax[s2][6] = (int)hi.z; ax[s2][7] = (int)hi.w;
            }
            unsigned base = 0;
            const unsigned zl = (unsigned)((lane >> 2) * 128 + (lane & 3) * 32) << 21;
#pragma unroll
            for (int i = 0; i < 4; ++i)
#pragma unroll
                for (int w = 0; w < 4; ++w)
#pragma unroll
                    for (int hf = 0; hf < 2; ++hf) {
                        const unsigned e = hf ? (pv[i][w] >> 16) : (pv[i][w] & 0xffffu);
                        const bool cnd = (int)(e >> 12) == part;
                        const unsigned long long mk = __ballot(cnd);
                        if (mk) {
                            const unsigned pos = base + __builtin_amdgcn_mbcnt_hi((unsigned)(mk >> 32), __builtin_amdgcn_mbcnt_lo((unsigned)mk, 0u));
                            if (cnd) list[pos] = ((e & 4095u) << 9) | (zl + ((unsigned)(8 * i + 2 * w + hf) << 21));
                            base += (unsigned)__popcll(mk);
                        }
                    }
            const int count = (int)base, nrt = (count + 15) >> 4;
            if (MODE == 2) { if (count == 12345) ZB[lane] = (float)ax[7][7] + (float)ax[0][0]; }
            else if (count > 0) {
                {
                    const unsigned last = list[count - 1];
                    list[count + lane] = last; list[count + 64 + lane] = last;
                }
                float* ZBg = ZB + (size_t)t0 * 128;
                auto loadA = [&](int rt, u32x4 (&dst)[8]) {
                    const u32x4 ea = *(const u32x4*)(list + 16 * rt + 8 * lh), eb = *(const u32x4*)(list + 16 * rt + 8 * lh + 4);
#pragma unroll
                    for (int q = 0; q < 8; ++q) {
                        const unsigned ent = q < 4 ? ea[q & 3] : eb[q & 3];
                        dst[q] = ldg16(UTp + ((ent & 0x1ffe00u) | cq[q]));
                    }
                };
                auto compute = [&](int rt, const u32x4 (&st)[8]) {
#pragma unroll
                    for (int q = 0; q < 8; ++q) *(u32x4*)(slot + q * 512 + lh * 4096 + l31 * 16) = st[q];
                    u32x4 bf[8];
#pragma unroll
                    for (int s2 = 0; s2 < 8; ++s2) bf[s2] = *(const u32x4*)(slot + c * 512 + (((4 * s2 + kb) ^ c) * 16));
                    const unsigned ent = list[16 * rt + c];
                    f32x4 D = {0.f, 0.f, 0.f, 0.f};
#pragma unroll
                    for (int s2 = 0; s2 < 8; ++s2) {
                        i32x8 b8; b8[0] = (int)bf[s2].x; b8[1] = (int)bf[s2].y; b8[2] = (int)bf[s2].z; b8[3] = (int)bf[s2].w; b8[4] = 0; b8[5] = 0; b8[6] = 0; b8[7] = 0;
                        D = __builtin_amdgcn_mfma_scale_f32_16x16x128_f8f6f4(ax[s2], b8, D, 0  , 4  , 0, 0, 0, 0);
                    }
                    const unsigned zoff = ent >> 21, tk = zoff >> 7;
                    const float val = (tk & 2u) ? ((tk & 1u) ? D[3] : D[2]) : ((tk & 1u) ? D[1] : D[0]);
                    if ((int)(tk >> 2) == kb && 16 * rt + c < count && (MODE != 3 || val == 1234.5f)) ZBg[zoff] = val;
                };
                u32x4 a0[8], a1[8], a2[8];
                loadA(0, a0); loadA(1, a1); loadA(2, a2);
                for (int rt = 0; rt < nrt; rt += 3) {
                    compute(rt, a0); loadA(rt + 3, a0);
                    if (rt + 1 < nrt) compute(rt + 1, a1);
                    loadA(rt + 4, a1);
                    if (rt + 2 < nrt) compute(rt + 2, a2);
                    loadA(rt + 5, a2);
                }
            }
        }
    }
}

DI void p5b_ffn(const Params& p) {
    unsigned char* ws = p.ws;
    const bf16_t* H1B = (const bf16_t*)(ws + WS_XB); const unsigned char* VT = ws + WS_VT;
    const unsigned short* PE = (const unsigned short*)(ws + WS_PE); const float* PG = (const float*)(ws + WS_PG); const float* PS = (const float*)(ws + WS_PS);
    const int lane = threadIdx.x & 63, gw = blockIdx.x * 4 + (threadIdx.x >> 6), nw = gridDim.x * 4;
    for (int tok = gw; tok < NTOK; tok += nw) {
        float x[16], acc[16];
        {
            const u32x4 xa = ldg16(H1B + (size_t)tok * 1024 + lane * 16), xb = ldg16(H1B + (size_t)tok * 1024 + lane * 16 + 8);
            x[0] = bf_lo(xa.x); x[1] = bf_hi(xa.x); x[2] = bf_lo(xa.y); x[3] = bf_hi(xa.y); x[4] = bf_lo(xa.z); x[5] = bf_hi(xa.z); x[6] = bf_lo(xa.w); x[7] = bf_hi(xa.w);
            x[8] = bf_lo(xb.x); x[9] = bf_hi(xb.x); x[10] = bf_lo(xb.y); x[11] = bf_hi(xb.y); x[12] = bf_lo(xb.z); x[13] = bf_hi(xb.z); x[14] = bf_lo(xb.w); x[15] = bf_hi(xb.w);
        }
#pragma unroll
        for (int i = 0; i < 16; ++i) acc[i] = 0.f;
        const int pe_lo = (int)PE[(size_t)tok * 128 + lane], pe_hi = (int)PE[(size_t)tok * 128 + 64 + lane];
        const float* ZB = (const float*)(ws + WS_QB);
        const float sxt = ((const float*)(ws + WS_SX))[tok];
        const float cf_lo = gelu_exact(ZB[(size_t)tok * 128 + lane] * PS[(size_t)tok * 128 + lane] * sxt) * PG[(size_t)tok * 128 + lane];
        const float cf_hi = gelu_exact(ZB[(size_t)tok * 128 + 64 + lane] * PS[(size_t)tok * 128 + 64 + lane] * sxt) * PG[(size_t)tok * 128 + 64 + lane];
#pragma unroll 1
        for (int hb = 0; hb < 4; ++hb) {
            const int pes = hb < 2 ? pe_lo : pe_hi; const float cfs = hb < 2 ? cf_lo : cf_hi;
            const int lb = (hb & 1) * 32;
#pragma unroll
            for (int j = 0; j < 32; ++j) {
                const int e = __builtin_amdgcn_readlane(pes, lb + j);
                const float cj = rdlane(cfs, lb + j);
                const u32x2 vw = *(const u32x2*)(VT + (size_t)e * 512 + lane * 8);
#define P5_AXPY(k, bs) { const f32x2 f = __builtin_amdgcn_cvt_scalef32_pk_f32_fp4(vw[k], 1.0f, bs); acc[8 * (k) + 2 * (bs)] = fmaf(cj, f.x, acc[8 * (k) + 2 * (bs)]); acc[8 * (k) + 2 * (bs) + 1] = fmaf(cj, f.y, acc[8 * (k) + 2 * (bs) + 1]); }
                P5_AXPY(0, 0) P5_AXPY(0, 1) P5_AXPY(0, 2) P5_AXPY(0, 3) P5_AXPY(1, 0) P5_AXPY(1, 1) P5_AXPY(1, 2) P5_AXPY(1, 3)
            }
        }
        float s = 0.f;
#pragma unroll
        for (int i = 0; i < 16; ++i) { acc[i] = fmaf(ALPHA, x[i], acc[i]); s += acc[i]; }
        const float mu = wave_sum(s) * (1.f / 1024.f); float q = 0.f;
#pragma unroll
        for (int i = 0; i < 16; ++i) { const float dd = acc[i] - mu; q = fmaf(dd, dd, q); }
        const float rstd = rsqrtf(wave_sum(q) * (1.f / 1024.f) + LN_EPS);
#pragma unroll
        for (int k4 = 0; k4 < 4; ++k4) {
            const int col = lane * 16 + k4 * 4;
            const f32x4 gg = *(const f32x4*)(p.ln2_g + col), bb = *(const f32x4*)(p.ln2_b + col);
            f32x4 o;
#pragma unroll
            for (int e = 0; e < 4; ++e) o[e] = (acc[k4 * 4 + e] - mu) * rstd * gg[e] + bb[e];
            *(f32x4*)(p.out + (size_t)tok * 1024 + col) = o;
        }
    }
}

#define XB_TMO      128
#define XB_XCNT(j)  (256  + 64 * (j))
#define XB_XSUB(j)  (1280 + 64 * (j))
#define XB_XGEN(j)  (2304 + 64 * (j))
#define XB_TOP      3328
#define XB_TOPGEN   3392
#define XCD_BAR_WORDS 3456
#define XB_SPIN_CAP (1u << 22)
#define LAS __attribute__((address_space(3)))
DI unsigned xb_ld(unsigned* p)              { return __hip_atomic_load(p, __ATOMIC_RELAXED, __HIP_MEMORY_SCOPE_AGENT); }
DI unsigned xb_add(unsigned* p, unsigned v) { return __hip_atomic_fetch_add(p, v, __ATOMIC_RELAXED, __HIP_MEMORY_SCOPE_AGENT); }
DI unsigned xb_xcc_id() { return (unsigned)__builtin_amdgcn_s_getreg((3 << 11) | 20) & 0xFu; }
#define XB_SPIN(cond, bar) do { unsigned _sp = 0; while (cond) { __builtin_amdgcn_s_sleep(1); \
    if ((++_sp & 255u) == 0u) { if (xb_ld(&(bar)[XB_TMO])) break; if (_sp > XB_SPIN_CAP) { atomicAdd(&(bar)[XB_TMO], 1u); break; } } } } while (0)
struct XcdBarrier { unsigned* bar; unsigned x; volatile LAS unsigned* st; };
DI XcdBarrier xcd_barrier_post(unsigned* bar, volatile LAS unsigned* st) {
    XcdBarrier b; b.bar = bar; b.x = xb_xcc_id(); b.st = st;
    if (threadIdx.x == 0) (void)xb_add(&bar[XB_XCNT(b.x)], 1u);
    return b;
}
DI void xcd_barrier_complete(unsigned* bar, unsigned x, unsigned& nloc, unsigned& nx) {
    const unsigned G = gridDim.x * gridDim.y * gridDim.z;
    unsigned sum, cnt, mine, sp = 0u;
    for (;;) {
        sum = 0u; cnt = 0u; mine = 0u;
#pragma unroll
        for (unsigned j = 0; j < 16; ++j) { const unsigned c = xb_ld(&bar[XB_XCNT(j)]); sum += c; cnt += (c > 0u) ? 1u : 0u; mine = (j == x) ? c : mine; }
        if (sum == G) break;
        __builtin_amdgcn_s_sleep(1);
        if ((++sp & 255u) == 0u) { if (xb_ld(&bar[XB_TMO])) break; if (sp > XB_SPIN_CAP) { atomicAdd(&bar[XB_TMO], 1u); break; } }
    }
    nloc = mine > 0u ? mine : 1u; nx = cnt > 0u ? cnt : 1u;
}
DI void xcd_barrier(const XcdBarrier& b) {
    asm volatile("s_waitcnt vmcnt(0)" ::: "memory");
    __syncthreads();
    if (threadIdx.x == 0) {
        unsigned* bar = b.bar;
        __builtin_amdgcn_s_waitcnt(0);
        unsigned nloc = b.st[0], nx = b.st[1];
        if (nloc == 0u) { xcd_barrier_complete(bar, b.x, nloc, nx); b.st[0] = nloc; b.st[1] = nx; }
        const unsigned old = xb_add(&bar[XB_XSUB(b.x)], 1u);
        const unsigned gen = old / nloc;
        if (old + 1u == (gen + 1u) * nloc) {
            __builtin_amdgcn_fence(__ATOMIC_RELEASE, "agent");
            asm volatile("s_waitcnt vmcnt(0)" ::: "memory");
            const unsigned og = xb_add(&bar[XB_TOP], 1u);
            const unsigned tg = og / nx;
            if (og + 1u == (tg + 1u) * nx) xb_add(&bar[XB_TOPGEN], 1u);
            else XB_SPIN(xb_ld(&bar[XB_TOPGEN]) == tg, bar);
            __builtin_amdgcn_fence(__ATOMIC_ACQUIRE, "agent");
            xb_add(&bar[XB_XGEN(b.x)], 1u);
            asm volatile("s_waitcnt vmcnt(0)" ::: "memory");
        } else {
            XB_SPIN(xb_ld(&bar[XB_XGEN(b.x)]) == gen, bar);
            __builtin_amdgcn_fence(__ATOMIC_ACQUIRE, "agent");
            asm volatile("s_waitcnt vmcnt(0)" ::: "memory");
        }
    }
    __syncthreads();
}

constexpr int NPHASE = 7;
__global__ void __launch_bounds__(NTHREADS, 2) mega_fwd(Params p) {
    extern __shared__ __attribute__((aligned(16))) unsigned char lds[];
    cg::grid_group grid = cg::this_grid();
    const int lo = p.ph_lo, hi = p.ph_hi;
    volatile LAS unsigned* xbst = (volatile LAS unsigned*)(LAS unsigned char*)(lds + LDS_BYTES - 16);
#ifndef REP_MASK
#define REP_MASK 0
#endif
#ifndef P2_PROBE_MODE
#define P2_PROBE_MODE 15
#endif
#ifndef PH_MASK
#define PH_MASK 127
#endif
    if (lo == 0x7fffffff) grid.sync();
    if (threadIdx.x == 0) { xbst[0] = 0u; xbst[1] = 0u; }
    __syncthreads();
    XcdBarrier xb = xcd_barrier_post((unsigned*)(p.ws + WS_BAR), xbst);
#define GSYNC() xcd_barrier(xb)
#if REP_MASK & 1
    p0_prep(p, lds); GSYNC();
#endif
    p0_prep(p, lds);
    GSYNC();
#define RUN_PHASE(k, call) { call; if ((REP_MASK >> (k)) & 1) { GSYNC(); call; } }
#if PH_MASK & 2
    RUN_PHASE(1, p1_inproj(p, lds))
#endif
    GSYNC();
#if PH_MASK & 4
#if (REP_MASK >> 2) & 1
    p2a_indexer(p, lds); GSYNC(); p2_attention<P2_PROBE_MODE>(p, lds, 1); GSYNC();
#endif
    p2a_indexer(p, lds);
    GSYNC();
    p2_attention<15>(p, lds, 0);
#endif
    GSYNC();
#if PH_MASK & 8
    RUN_PHASE(3, p3_outproj(p, lds))
#endif
    GSYNC();
#if PH_MASK & 16
    RUN_PHASE(4, p3b_ln1(p))
#endif
    GSYNC();
#if PH_MASK & 32
    RUN_PHASE(5, p4_peer_query(p, lds))
#endif
    GSYNC();
#if PH_MASK & 64
    p5a_udot<0>(p, lds);
#ifdef P5A_REP
    GSYNC(); p5a_udot<P5A_REP>(p, lds);
#endif
    GSYNC();
    p5b_ffn(p);
#endif
}

#ifndef MK_N_LAUNCHES
#define MK_N_LAUNCHES 1
#endif

extern "C" void kernel_launch(void* const* d_in, const int* in_sizes, int n_in, void* d_out, int out_size, void* d_ws, size_t ws_size, hipStream_t stream) {
    static int grid_blocks = 0;
    if (grid_blocks == 0) {
        if (n_in != 14 || out_size != NTOK * D_MODEL || ws_size < WS_END) {
            fprintf(stderr, "kernel_launch: unexpected problem (n_in %d, out %d, ws %zu, need %zu)\n", n_in, out_size, ws_size, (size_t)WS_END); grid_blocks = -1; return;
        }
        int dev = 0, cus = 0, per_cu = 0;
        hipGetDevice(&dev);
        hipDeviceGetAttribute(&cus, hipDeviceAttributeMultiprocessorCount, dev);
        if (hipFuncSetAttribute((const void*)mega_fwd, hipFuncAttributeMaxDynamicSharedMemorySize, LDS_BYTES) != hipSuccess) { fprintf(stderr, "kernel_launch: hipFuncSetAttribute failed\n"); }
        if (hipOccupancyMaxActiveBlocksPerMultiprocessor(&per_cu, (const void*)mega_fwd, NTHREADS, LDS_BYTES) != hipSuccess || per_cu < 1) { fprintf(stderr, "kernel_launch: occupancy query failed\n"); per_cu = 1; }
        if (per_cu > 2) per_cu = 2;
        (void)hipGetLastError();
        grid_blocks = cus * per_cu;
        fprintf(stderr, "kernel_launch: %d CUs x %d blocks\n", cus, per_cu);
    }
    if (grid_blocks < 0) return;
    Params p{};
    p.x = (const float*)d_in[0]; p.w_in = (const float*)d_in[1]; p.idx_k_g = (const float*)d_in[2]; p.idx_k_b = (const float*)d_in[3]; p.sinks = (const float*)d_in[4];
    p.w_o = (const float*)d_in[5]; p.ln1_g = (const float*)d_in[6]; p.ln1_b = (const float*)d_in[7]; p.peer_wq = (const float*)d_in[8]; p.peer_subkeys = (const float*)d_in[9];
    p.peer_u = (const float*)d_in[10]; p.peer_v = (const float*)d_in[11]; p.ln2_g = (const float*)d_in[12]; p.ln2_b = (const float*)d_in[13];
    p.out = (float*)d_out; p.ws = (unsigned char*)d_ws;
    p.ph_lo = 0; p.ph_hi = NPHASE;
    if (hipMemsetAsync((unsigned char*)d_ws + WS_BAR, 0, XCD_BAR_WORDS * 4, stream) != hipSuccess) { fprintf(stderr, "kernel_launch: memset of the barrier words failed\n"); return; }
    void* args[] = {&p};
    hipError_t e = hipLaunchCooperativeKernel((const void*)mega_fwd, dim3(grid_blocks), dim3(NTHREADS), args, LDS_BYTES, stream);
    if (e != hipSuccess) fprintf(stderr, "cooperative launch failed: %s (grid %d)\n", hipGetErrorString(e), grid_blocks);
}
```

```cpp
#include <hip/hip_runtime.h>
#include <hip/hip_cooperative_groups.h>
#include <cstdio>
#include <cstdint>
namespace cg = cooperative_groups;

typedef unsigned short bf16_t;
typedef short bf16x8 __attribute__((ext_vector_type(8)));
typedef float f32x4 __attribute__((ext_vector_type(4)));
typedef float f32x16 __attribute__((ext_vector_type(16)));
typedef unsigned u32x4 __attribute__((ext_vector_type(4)));
typedef unsigned u32x2 __attribute__((ext_vector_type(2)));
typedef int i32x8 __attribute__((ext_vector_type(8)));
#define DI __device__ __forceinline__

constexpr int D_MODEL = 1024, BATCH = 8, SEQ = 4096, NTOK = BATCH * SEQ;
constexpr int NMIX = 1732, NMIX_PAD = 1792;
constexpr int PEER_N = 2048;
constexpr float ALPHA = 1.189207115002721f;
constexpr float LN_EPS = 1e-5f;
constexpr int NTHREADS = 256;
constexpr int LDS_BYTES = 77824;

constexpr size_t MB = 1024 * 1024;
constexpr size_t WS_CTL   = 0;
constexpr size_t WS_AMAX  = 65536 + 16384;
constexpr size_t WS_BAR   = 65536;
constexpr size_t WS_ROPE  = 1 * MB;
constexpr size_t WS_WINT  = 2 * MB;
constexpr size_t WS_WOT   = 6 * MB;
constexpr size_t WS_WQT   = 8 * MB;
constexpr size_t WS_SK    = 12 * MB;
constexpr size_t WS_UT    = 13 * MB;
constexpr size_t WS_VT    = 29 * MB;
constexpr size_t WS_SU    = 45 * MB;
constexpr size_t WS_SV    = 46 * MB;
constexpr size_t WS_SX    = 47 * MB;
constexpr size_t WS_XB    = 77 * MB;
constexpr size_t WS_QA    = 141 * MB;
constexpr size_t WS_KA    = 173 * MB;
constexpr size_t WS_VA    = 181 * MB;
constexpr size_t WS_QB    = 189 * MB;
constexpr size_t WS_KB    = 221 * MB;
constexpr size_t WS_VB    = 225 * MB;
constexpr size_t WS_QI    = 229 * MB;
constexpr size_t WS_KI    = 245 * MB;
constexpr size_t WS_WI    = 249 * MB;
constexpr size_t WS_ATT   = 250 * MB;
constexpr size_t WS_PE    = 314 * MB;
constexpr size_t WS_PG    = 322 * MB;
constexpr size_t WS_PS    = 338 * MB;
constexpr size_t WS_END   = 354 * MB;

struct Params {
    const float* x; const float* w_in; const float* idx_k_g; const float* idx_k_b; const float* sinks; const float* w_o;
    const float* ln1_g; const float* ln1_b; const float* peer_wq; const float* peer_subkeys; const float* peer_u; const float* peer_v;
    const float* ln2_g; const float* ln2_b;
    float* out; unsigned char* ws;
    int ph_lo, ph_hi;
};

typedef float f32x2 __attribute__((ext_vector_type(2)));
typedef __bf16 bf16x2_t __attribute__((ext_vector_type(2)));
DI unsigned pack_bf16(float lo, float hi) { const f32x2 v = {lo, hi}; return __builtin_bit_cast(unsigned, __builtin_convertvector(v, bf16x2_t)); }
DI unsigned f2bf(float x) { return pack_bf16(x, 0.f) & 0xffffu; }
DI float bf_lo(unsigned w) { return __uint_as_float(w << 16); }
DI float bf_hi(unsigned w) { return __uint_as_float(w & 0xffff0000u); }
DI bf16x8 as_bf16x8(u32x4 v) { return __builtin_bit_cast(bf16x8, v); }
DI u32x4 ldg16(const void* p) { return *(const u32x4*)p; }
DI f32x4 mfma16(bf16x8 a, bf16x8 b, f32x4 c) { return __builtin_amdgcn_mfma_f32_16x16x32_bf16(a, b, c, 0, 0, 0); }
DI f32x16 mfma32(bf16x8 a, bf16x8 b, f32x16 c) { return __builtin_amdgcn_mfma_f32_32x32x16_bf16(a, b, c, 0, 0, 0); }
DI float wave_sum(float v) {
#pragma unroll
    for (int o = 32; o >= 1; o >>= 1) v += __shfl_xor(v, o);
    return v;
}

DI void glds16(const void* src, void* lds_dst) { __builtin_amdgcn_global_load_lds((const unsigned*)src, (__attribute__((address_space(3))) unsigned*)lds_dst, 16, 0, 0); }
DI void gemm_128x128(const bf16_t* __restrict__ X, int ldx, const bf16_t* __restrict__ Wt, int ldw, int K, unsigned char* lds, f32x4 (&acc)[4][4]) {
    int tid = threadIdx.x; asm volatile("" : "+v"(tid));
    const int lane = tid & 63, wave = tid >> 6, wm = wave >> 1, wn = wave & 1, c = lane & 15, g = lane >> 4;
    const int lrow = tid >> 3, lch = tid & 7;
    const bf16_t* xp = X + (size_t)lrow * ldx + ((lch ^ (lrow & 7)) * 8);
    const bf16_t* wp = Wt + (size_t)lrow * ldw + ((lch ^ (lrow & 7)) * 8);
    unsigned char* dst0 = lds + tid * 16;
#pragma unroll
    for (int m = 0; m < 4; ++m)
#pragma unroll
        for (int n = 0; n < 4; ++n) acc[m][n] = (f32x4){0.f, 0.f, 0.f, 0.f};
    const int nk = K / 64;
    __syncthreads();
#pragma unroll
    for (int i = 0; i < 4; ++i) { glds16(xp + (size_t)(32 * i) * ldx, dst0 + i * 4096); glds16(wp + (size_t)(32 * i) * ldw, dst0 + 16384 + i * 4096); }
    asm volatile("s_waitcnt vmcnt(0)" ::: "memory");
    __syncthreads();
    for (int kt = 0; kt < nk; ++kt) {
        const unsigned char* Xs = lds + (kt & 1) * 32768; const unsigned char* Ws = Xs + 16384;
        if (kt + 1 < nk) {
            unsigned char* d = dst0 + ((kt + 1) & 1) * 32768;
#pragma unroll
            for (int i = 0; i < 4; ++i) { glds16(xp + (size_t)(32 * i) * ldx + (kt + 1) * 64, d + i * 4096); glds16(wp + (size_t)(32 * i) * ldw + (kt + 1) * 64, d + 16384 + i * 4096); }
        }
#pragma unroll
        for (int s = 0; s < 2; ++s) {
            bf16x8 xf[4], wf[4];
#pragma unroll
            for (int m = 0; m < 4; ++m) { const int row = wm * 64 + m * 16 + c; xf[m] = as_bf16x8(*(const u32x4*)(Xs + row * 128 + (((4 * s + g) ^ (c & 7)) << 4))); }
#pragma unroll
            for (int n = 0; n < 4; ++n) { const int row = wn * 64 + n * 16 + c; wf[n] = as_bf16x8(*(const u32x4*)(Ws + row * 128 + (((4 * s + g) ^ (c & 7)) << 4))); }
#pragma unroll
            for (int m = 0; m < 4; ++m)
#pragma unroll
                for (int n = 0; n < 4; ++n) acc[m][n] = mfma16(wf[n], xf[m], acc[m][n]);
        }
        asm volatile("s_waitcnt vmcnt(0)" ::: "memory");
        __syncthreads();
    }
}

DI void gemm8_128x128(const unsigned char* __restrict__ X, int ldx, const unsigned char* __restrict__ Wt, int ldw, int K, unsigned char* lds, f32x4 (&acc)[4][4]) {
    int tid = threadIdx.x; asm volatile("" : "+v"(tid));
    const int lane = tid & 63, wave = tid >> 6, wm = wave >> 1, wn = wave & 1, c = lane & 15, g = lane >> 4;
    const int lrow = tid >> 3, lch = tid & 7;
    const unsigned char* xp = X + (size_t)lrow * ldx + ((lch ^ (lrow & 7)) * 16);
    const unsigned char* wp = Wt + (size_t)lrow * ldw + ((lch ^ (lrow & 7)) * 16);
    unsigned char* dst0 = lds + tid * 16;
#pragma unroll
    for (int m = 0; m < 4; ++m)
#pragma unroll
        for (int n = 0; n < 4; ++n) acc[m][n] = (f32x4){0.f, 0.f, 0.f, 0.f};
    const int nk = K / 128;
    __syncthreads();
#pragma unroll
    for (int i = 0; i < 4; ++i) { glds16(xp + (size_t)(32 * i) * ldx, dst0 + i * 4096); glds16(wp + (size_t)(32 * i) * ldw, dst0 + 16384 + i * 4096); }
    asm volatile("s_waitcnt vmcnt(0)" ::: "memory");
    __syncthreads();
    for (int kt = 0; kt < nk; ++kt) {
        const unsigned char* Xs = lds + (kt & 1) * 32768; const unsigned char* Ws = Xs + 16384;
        if (kt + 1 < nk) {
            unsigned char* d = dst0 + ((kt + 1) & 1) * 32768;
#pragma unroll
            for (int i = 0; i < 4; ++i) { glds16(xp + (size_t)(32 * i) * ldx + (kt + 1) * 128, d + i * 4096); glds16(wp + (size_t)(32 * i) * ldw + (kt + 1) * 128, d + 16384 + i * 4096); }
        }
        i32x8 xf[4], wf[4];
#pragma unroll
        for (int m = 0; m < 4; ++m) {
            const int row = wm * 64 + m * 16 + c;
            const u32x4 lo = *(const u32x4*)(Xs + row * 128 + ((g ^ (c & 7)) << 4)), hi = *(const u32x4*)(Xs + row * 128 + (((4 + g) ^ (c & 7)) << 4));
            xf[m][0] = (int)lo.x; xf[m][1] = (int)lo.y; xf[m][2] = (int)lo.z; xf[m][3] = (int)lo.w; xf[m][4] = (int)hi.x; xf[m][5] = (int)hi.y; xf[m][6] = (int)hi.z; xf[m][7] = (int)hi.w;
        }
#pragma unroll
        for (int n = 0; n < 4; ++n) {
            const int row = wn * 64 + n * 16 + c;
            const u32x4 lo = *(const u32x4*)(Ws + row * 128 + ((g ^ (c & 7)) << 4)), hi = *(const u32x4*)(Ws + row * 128 + (((4 + g) ^ (c & 7)) << 4));
            wf[n][0] = (int)lo.x; wf[n][1] = (int)lo.y; wf[n][2] = (int)lo.z; wf[n][3] = (int)lo.w; wf[n][4] = (int)hi.x; wf[n][5] = (int)hi.y; wf[n][6] = (int)hi.z; wf[n][7] = (int)hi.w;
        }
#pragma unroll
        for (int m = 0; m < 4; ++m)
#pragma unroll
            for (int n = 0; n < 4; ++n) acc[m][n] = __builtin_amdgcn_mfma_scale_f32_16x16x128_f8f6f4(wf[n], xf[m], acc[m][n], 0, 0, 0, 0, 0, 0);
        asm volatile("s_waitcnt vmcnt(0)" ::: "memory");
        __syncthreads();
    }
}

DI bool tile_of(int k, int NT, int MT, int& mt, int& nt) {
    const int G = gridDim.x, bid = blockIdx.x;
    if (((G | MT) & 7) == 0) {
        const int idx = (bid >> 3) + k * (G >> 3);
        if (idx >= (MT >> 3) * NT) return false;
        mt = (idx / NT) * 8 + (bid & 7); nt = idx % NT;
    } else {
        const int t = bid + k * G;
        if (t >= MT * NT) return false;
        mt = t / NT; nt = t % NT;
    }
    return true;
}

DI void p0_prep(const Params& p, unsigned char* lds) {
    const int tid = threadIdx.x, nb = gridDim.x, bid = blockIdx.x;
    const size_t gtid = (size_t)bid * NTHREADS + tid, gsz = (size_t)nb * NTHREADS;
    unsigned char* ws = p.ws;
    {
        float* ct = (float*)(ws + WS_ROPE); float* stb = ct + SEQ * 32;
        for (size_t i = gtid; i < (size_t)SEQ * 32; i += gsz) {
            const int pos = (int)(i >> 5), fi = (int)(i & 31);
            const float inv = powf(10000.0f, -(float)(2 * fi) / 64.0f);
            const float ang = (float)pos * inv;
            ct[i] = cosf(ang); stb[i] = sinf(ang);
        }
    }
    auto conv = [&](const float* src, bf16_t* dst, size_t n) {
        for (size_t i = gtid * 8; i < n; i += gsz * 8) {
            const f32x4 a = *(const f32x4*)(src + i), b = *(const f32x4*)(src + i + 4);
            u32x4 o; o.x = pack_bf16(a.x, a.y); o.y = pack_bf16(a.z, a.w); o.z = pack_bf16(b.x, b.y); o.w = pack_bf16(b.z, b.w);
            *(u32x4*)(dst + i) = o;
        }
    };
    {
        float m = 0.f;
        for (size_t i = gtid * 4; i < (size_t)1024 * 1024; i += gsz * 4) { const f32x4 v = *(const f32x4*)(p.w_o + i); m = fmaxf(m, fmaxf(fmaxf(fabsf(v[0]), fabsf(v[1])), fmaxf(fabsf(v[2]), fabsf(v[3])))); }
#pragma unroll
        for (int o = 32; o >= 1; o >>= 1) m = fmaxf(m, __shfl_xor(m, o));
        if ((tid & 63) == 0 && m > 0.f) atomicMax((unsigned*)(ws + WS_AMAX), __float_as_uint(m));
    }
    conv(p.x, (bf16_t*)(ws + WS_XB), (size_t)NTOK * D_MODEL);
    conv(p.peer_subkeys, (bf16_t*)(ws + WS_SK), (size_t)8 * 2 * 128 * 128);
    float* tl = (float*)lds;
    auto transp = [&](const float* src, bf16_t* dst, int N, int Npad) {
        const int tn = Npad / 64, tk = 1024 / 64;
        for (int t = bid; t < tn * tk; t += nb) {
            const int n0 = (t % tn) * 64, k0 = (t / tn) * 64;
            __syncthreads();
            for (int e = tid; e < 4096; e += NTHREADS) { const int kk = e >> 6, nn = e & 63; tl[kk * 65 + nn] = (n0 + nn < N) ? src[(size_t)(k0 + kk) * N + n0 + nn] : 0.f; }
            __syncthreads();
            for (int e = tid; e < 4096; e += NTHREADS) { const int nn = e >> 6, kk = e & 63; dst[(size_t)(n0 + nn) * 1024 + k0 + kk] = (bf16_t)f2bf(tl[kk * 65 + nn]); }
        }
    };
    transp(p.w_in, (bf16_t*)(ws + WS_WINT), NMIX, NMIX_PAD);
}

DI void p0_late(const Params& p, unsigned char* lds) {
    const int tid = threadIdx.x, nb = gridDim.x, bid = blockIdx.x;
    unsigned char* ws = p.ws;
    {
        const int lane = tid & 63, gw = bid * 4 + (tid >> 6), nw = nb * 4;
        for (int row0 = gw * 4; row0 < 2 * 16384; row0 += nw * 4) {
            f32x4 v[4][4];
#pragma unroll
            for (int r = 0; r < 4; ++r) {
                const int row = row0 + r; const bool isv = row >= 16384; const int e = isv ? row - 16384 : row;
                const float* src = (isv ? p.peer_v : p.peer_u) + (size_t)e * 1024 + lane * 16;
#pragma unroll
                for (int i = 0; i < 4; ++i) v[r][i] = *(const f32x4*)(src + 4 * i);
            }
#pragma unroll
            for (int r = 0; r < 4; ++r) {
                const int row = row0 + r; const bool isv = row >= 16384; const int e = isv ? row - 16384 : row;
                float mx = 0.f;
#pragma unroll
                for (int i = 0; i < 4; ++i) mx = fmaxf(mx, fmaxf(fmaxf(fabsf(v[r][i][0]), fabsf(v[r][i][1])), fmaxf(fabsf(v[r][i][2]), fabsf(v[r][i][3]))));
#pragma unroll
                for (int o = 32; o >= 1; o >>= 1) mx = fmaxf(mx, __shfl_xor(mx, o));
                const float sc = mx > 0.f ? mx * (1.0f / 5.99f) : 1.0f, inv = mx > 0.f ? 5.99f / mx : 1.0f;
                u32x2 o2;
#pragma unroll
                for (int k = 0; k < 2; ++k) {
                    unsigned w = 0;
                    w = __builtin_amdgcn_cvt_scalef32_pk_fp4_f32(w, v[r][2 * k][0] * inv, v[r][2 * k][1] * inv, 1.0f, 0);
                    w = __builtin_amdgcn_cvt_scalef32_pk_fp4_f32(w, v[r][2 * k][2] * inv, v[r][2 * k][3] * inv, 1.0f, 1);
                    w = __builtin_amdgcn_cvt_scalef32_pk_fp4_f32(w, v[r][2 * k + 1][0] * inv, v[r][2 * k + 1][1] * inv, 1.0f, 2);
                    w = __builtin_amdgcn_cvt_scalef32_pk_fp4_f32(w, v[r][2 * k + 1][2] * inv, v[r][2 * k + 1][3] * inv, 1.0f, 3);
                    o2[k] = w;
                }
                *(u32x2*)(ws + (isv ? WS_VT : WS_UT) + (size_t)e * 512 + lane * 8) = o2;
                if (lane == 0) ((float*)(ws + (isv ? WS_SV : WS_SU)))[e] = sc;
            }
        }
    }
    float* tl = (float*)lds;
    auto transp = [&](const float* src, bf16_t* dst, int N, int Npad) {
        const int tn = Npad / 64, tk = 1024 / 64;
        for (int t = bid; t < tn * tk; t += nb) {
            const int n0 = (t % tn) * 64, k0 = (t / tn) * 64;
            __syncthreads();
            for (int e = tid; e < 4096; e += NTHREADS) { const int kk = e >> 6, nn = e & 63; tl[kk * 65 + nn] = (n0 + nn < N) ? src[(size_t)(k0 + kk) * N + n0 + nn] : 0.f; }
            __syncthreads();
            for (int e = tid; e < 4096; e += NTHREADS) { const int nn = e >> 6, kk = e & 63; dst[(size_t)(n0 + nn) * 1024 + k0 + kk] = (bf16_t)f2bf(tl[kk * 65 + nn]); }
        }
    };
    {
        const float amax = __uint_as_float(*(const unsigned*)(ws + WS_AMAX)), sw = amax > 0.f ? 439.f / amax : 1.f;
        unsigned char* dst8 = ws + WS_WOT;
        for (int t = bid; t < 16 * 16; t += nb) {
            const int n0 = (t % 16) * 64, k0 = (t / 16) * 64;
            __syncthreads();
            for (int e = tid; e < 4096; e += NTHREADS) { const int kk = e >> 6, nn = e & 63; tl[kk * 65 + nn] = p.w_o[(size_t)(k0 + kk) * 1024 + n0 + nn]; }
            __syncthreads();
            for (int e = tid; e < 1024; e += NTHREADS) {
                const int nn = e >> 4, kq = (e & 15) * 4;
                int pk = __builtin_amdgcn_cvt_pk_fp8_f32(tl[kq * 65 + nn] * sw, tl[(kq + 1) * 65 + nn] * sw, 0, false);
                pk = __builtin_amdgcn_cvt_pk_fp8_f32(tl[(kq + 2) * 65 + nn] * sw, tl[(kq + 3) * 65 + nn] * sw, pk, true);
                *(int*)(dst8 + (size_t)(n0 + nn) * 1024 + k0 + kq) = pk;
            }
        }
    }
    transp(p.peer_wq, (bf16_t*)(ws + WS_WQT), PEER_N, PEER_N);
}

DI void p1_inproj(const Params& p, unsigned char* lds) {
    unsigned char* ws = p.ws;
    const bf16_t* XB = (const bf16_t*)(ws + WS_XB); const bf16_t* WT = (const bf16_t*)(ws + WS_WINT);
    const float* cosT = (const float*)(ws + WS_ROPE); const float* sinT = cosT + SEQ * 32;
    const int tid = threadIdx.x, lane = tid & 63, wave = tid >> 6, wm = wave >> 1, wn = wave & 1, c = lane & 15, g = lane >> 4;
    constexpr int NT = NMIX_PAD / 128, MT = NTOK / 128;
    int mt, nt;
    for (int k = 0; tile_of(k, NT, MT, mt, nt); ++k) {
        f32x4 acc[4][4];
        gemm_128x128(XB + (size_t)mt * 128 * 1024, 1024, WT + (size_t)nt * 128 * 1024, 1024, 1024, lds, acc);
        const int col64 = nt * 2 + wn;
        bf16_t* dst; int ld, coff; bool rope = true; float scale = 1.f; float vmax = 0.f;
        if (col64 < 8)       { dst = (bf16_t*)(ws + WS_QA); ld = 512; coff = col64 * 64; scale = 0.125f; }
        else if (col64 < 10) { dst = (bf16_t*)(ws + WS_KA); ld = 128; coff = (col64 - 8) * 64; }
        else if (col64 < 12) { dst = (bf16_t*)(ws + WS_VA); ld = 128; coff = (col64 - 10) * 64; rope = false; }
        else if (col64 < 20) { dst = (bf16_t*)(ws + WS_QB); ld = 512; coff = (col64 - 12) * 64; scale = 0.125f; }
        else if (col64 == 20) { dst = (bf16_t*)(ws + WS_KB); ld = 64; coff = 0; }
        else if (col64 == 21) { dst = (bf16_t*)(ws + WS_VB); ld = 64; coff = 0; rope = false; }
        else if (col64 < 26) { dst = (bf16_t*)(ws + WS_QI); ld = 256; coff = (col64 - 22) * 64; }
        else                 { dst = (bf16_t*)(ws + WS_KI); ld = 64; coff = 0; }
        if (col64 == 27) {
            if (g == 0) {
#pragma unroll
                for (int m = 0; m < 4; ++m) { const int tok = mt * 128 + wm * 64 + m * 16 + c; *(f32x4*)((float*)(ws + WS_WI) + (size_t)tok * 4) = acc[m][0] * 0.0625f; }
            }
            continue;
        }
#pragma unroll
        for (int m = 0; m < 4; ++m) {
            const int tok = mt * 128 + wm * 64 + m * 16 + c, pos = tok & (SEQ - 1);
            f32x4 v[4] = {acc[m][0], acc[m][1], acc[m][2], acc[m][3]};
            if (col64 == 26) {
                float s = 0.f;
#pragma unroll
                for (int n = 0; n < 4; ++n) s += (v[n][0] + v[n][1]) + (v[n][2] + v[n][3]);
                s += __shfl_xor(s, 16); s += __shfl_xor(s, 32);
                const float mu = s * (1.f / 64.f); float q = 0.f;
#pragma unroll
                for (int n = 0; n < 4; ++n) { const f32x4 d = v[n] - mu; q += (d[0] * d[0] + d[1] * d[1]) + (d[2] * d[2] + d[3] * d[3]); }
                q += __shfl_xor(q, 16); q += __shfl_xor(q, 32);
                const float rstd = rsqrtf(q * (1.f / 64.f) + LN_EPS);
#pragma unroll
                for (int n = 0; n < 4; ++n) {
                    const f32x4 gg = *(const f32x4*)(p.idx_k_g + 16 * n + 4 * g), bb = *(const f32x4*)(p.idx_k_b + 16 * n + 4 * g);
                    v[n] = (v[n] - mu) * rstd * gg + bb;
                }
            }
            if (rope) {
#pragma unroll
                for (int n = 0; n < 2; ++n) {
                    const f32x4 cs = *(const f32x4*)(cosT + pos * 32 + 16 * n + 4 * g), sn = *(const f32x4*)(sinT + pos * 32 + 16 * n + 4 * g);
                    const f32x4 t1 = v[n], t2 = v[n + 2];
                    v[n] = t1 * cs - t2 * sn; v[n + 2] = t2 * cs + t1 * sn;
                }
            }
#pragma unroll
            for (int n = 0; n < 4; ++n) {
                const f32x4 o = v[n] * scale; u32x2 w; w.x = pack_bf16(o[0], o[1]); w.y = pack_bf16(o[2], o[3]);
                *(u32x2*)(dst + (size_t)tok * ld + coff + 16 * n + 4 * g) = w;
                if (!rope) vmax = fmaxf(vmax, fmaxf(fmaxf(fabsf(o[0]), fabsf(o[1])), fmaxf(fabsf(o[2]), fabsf(o[3]))));
            }
        }
        if (!rope) {
#pragma unroll
            for (int o = 32; o >= 1; o >>= 1) vmax = fmaxf(vmax, __shfl_xor(vmax, o));
            if (lane == 0 && vmax > 0.f) atomicMax((unsigned*)(ws + WS_AMAX) + 1, __float_as_uint(vmax));
        }
    }
}

constexpr int NDSA = NTOK / 4, NSWA = BATCH * 32 * 8;
constexpr int P2_STG = 0  , P2_LIST = 32768;

DI unsigned f16_key(float v) {
    _Float16 hv = (_Float16)v; unsigned short hb = __builtin_bit_cast(unsigned short, hv); unsigned b = hb;
    if (b == 0x8000u) b = 0u;
    return (b & 0x8000u) ? ((~b) & 0xffffu) : (b | 0x8000u);
}

DI size_t sc_row_off(int t) { const size_t m = (size_t)(t >> 3); return 8 * (4 * m * (m + 1) + (size_t)(t & 7) * (m + 1)); }
constexpr size_t SC_BATCH = 8404992;
DI unsigned short* sc_batch_base(const Params& p, int b) { return (b < 7) ? (unsigned short*)p.out + (size_t)b * SC_BATCH : (unsigned short*)(p.ws + WS_PG); }

DI void p2a_indexer(const Params& p, unsigned char* lds) {
    unsigned char* ws = p.ws;
    const bf16_t* QI = (const bf16_t*)(ws + WS_QI); const bf16_t* KI = (const bf16_t*)(ws + WS_KI); const float* WI = (const float*)(ws + WS_WI);
    const int G = gridDim.x, bi = blockIdx.x;
    for (int it = 0; it < 2; ++it) {
        const int item = (it == 0) ? bi : 1023 - bi;
        for (int id = (G == 512) ? item : bi + it * G; id < 1024; id += (G == 512) ? 1024 : 2 * G) {
            int tid = threadIdx.x; asm volatile("" : "+v"(tid));
            const int lane = tid & 63, wave = tid >> 6, c = lane & 15, g = lane >> 4, lrow = tid >> 3, lch = tid & 7;
            const int b = id >> 7, t0 = (id & 127) * 32, tokw = b * SEQ + t0 + 8 * wave;
            unsigned short* scb = sc_batch_base(p, b);
            bf16x8 af[2][2]; f32x4 wv[2];
#pragma unroll
            for (int rt = 0; rt < 2; ++rt) {
#pragma unroll
                for (int s2 = 0; s2 < 2; ++s2) af[rt][s2] = as_bf16x8(ldg16(QI + (size_t)(tokw + 4 * rt + (c >> 2)) * 256 + (c & 3) * 64 + 32 * s2 + 8 * g));
                wv[rt] = *(const f32x4*)(WI + (size_t)(tokw + 4 * rt + g) * 4);
            }
            asm volatile("" :: "v"(af[0][0]), "v"(af[0][1]), "v"(af[1][0]), "v"(af[1][1]), "v"(wv[0]), "v"(wv[1]));
            const int nkt = ((t0 + 31) >> 7) + 1;
            const unsigned char* kib = (const unsigned char*)(KI + (size_t)b * SEQ * 64);
            unsigned char* dst0 = lds + tid * 16;
            auto stage = [&](int kt, int buf) {
#pragma unroll
                for (int i = 0; i < 4; ++i) {
                    const int row = lrow + 32 * i;
                    glds16(kib + (size_t)(kt * 128 + row) * 128 + ((lch ^ ((row >> 3) & 7)) << 4), dst0 + buf * 16384 + i * 4096);
                }
            };
            __syncthreads();
            stage(0, 0); if (nkt > 1) stage(1, 1);
            for (int kt = 0; kt < nkt; ++kt) {
                if (kt + 1 < nkt) asm volatile("s_waitcnt vmcnt(4)" ::: "memory");
                else asm volatile("s_waitcnt vmcnt(0)" ::: "memory");
                asm volatile("s_waitcnt lgkmcnt(0)" ::: "memory");
                __builtin_amdgcn_s_barrier();
                if (kt + 2 < nkt) stage(kt + 2, (kt + 2) % 3);
                const unsigned char* Ks = lds + (kt % 3) * 16384;
                unsigned res[2][4];
#pragma unroll
                for (int ct = 0; ct < 8; ++ct) {
                    const int row = 8 * c + ct;
                    const bf16x8 k0 = as_bf16x8(*(const u32x4*)(Ks + row * 128 + ((g ^ (c & 7)) << 4)));
                    const bf16x8 k1 = as_bf16x8(*(const u32x4*)(Ks + row * 128 + (((4 + g) ^ (c & 7)) << 4)));
#pragma unroll
                    for (int rt = 0; rt < 2; ++rt) {
                        f32x4 d = mfma16(af[rt][0], k0, (f32x4){0.f, 0.f, 0.f, 0.f});
                        d = mfma16(af[rt][1], k1, d);
                        const float sv = wv[rt][0] * fmaxf(d[0], 0.f) + wv[rt][1] * fmaxf(d[1], 0.f) + wv[rt][2] * fmaxf(d[2], 0.f) + wv[rt][3] * fmaxf(d[3], 0.f);
                        const int key = kt * 128 + row, tq = t0 + 8 * wave + 4 * rt + g;
                        const unsigned kv = (key <= tq) ? f16_key(sv) : 0u;
                        if (ct & 1) res[rt][ct >> 1] |= kv << 16; else res[rt][ct >> 1] = kv;
                    }
                }
#pragma unroll
                for (int rt = 0; rt < 2; ++rt) {
                    const int tq = t0 + 8 * wave + 4 * rt + g;
                    if (16 * kt + c <= (tq >> 3)) {
                        u32x4 w; w.x = res[rt][0]; w.y = res[rt][1]; w.z = res[rt][2]; w.w = res[rt][3];
                        *(u32x4*)(scb + sc_row_off(tq) + kt * 128 + 8 * c) = w;
                    }
                }
            }
        }
    }
    __syncthreads();
    p0_late(p, lds);
}

template <int MODE> DI void p2_dsa_item(const Params& p, unsigned char* lds, int b, int tb) {
    unsigned char* ws = p.ws;
    const bf16_t* QI = (const bf16_t*)(ws + WS_QI); const bf16_t* KI = (const bf16_t*)(ws + WS_KI); const float* WI = (const float*)(ws + WS_WI);
    const bf16_t* QB = (const bf16_t*)(ws + WS_QB); const bf16_t* KB = (const bf16_t*)(ws + WS_KB); const bf16_t* VB = (const bf16_t*)(ws + WS_VB);
    unsigned char* ATT8 = ws + WS_ATT;
    const float sa8 = 439.f / fmaxf(__uint_as_float(*(const unsigned*)(ws + WS_AMAX + 4)), 1e-30f);
    int tid = threadIdx.x; asm volatile("" : "+v"(tid));
    const int lane = tid & 63, wave = __builtin_amdgcn_readfirstlane(tid >> 6), c = lane & 15, g = lane >> 4;
    const int t0 = tb * 4, tok0 = b * SEQ + t0;
    unsigned char* stg = lds + P2_STG + wave * 8192;
    unsigned* hist = (unsigned*)stg;
    unsigned short* list = (unsigned short*)(lds + P2_LIST) + wave * 256;
    const int tok = tok0 + wave;
    if (!(MODE & 2)) return;
    const int n = t0 + wave + 1;
    const int L = n < 256 ? n : 256;
    const unsigned short* myk = sc_batch_base(p, b) + sc_row_off(t0 + wave);
    if (n <= 256) {
        for (int i = lane; i < n; i += 64) list[i] = (unsigned short)i;
    } else {
        u32x4 kk[8];
#pragma unroll
        for (int i = 0; i < 8; ++i) kk[i] = (512 * i + 8 * lane < n) ? ldg16(myk + 512 * i + 8 * lane) : (u32x4){0u, 0u, 0u, 0u};
#pragma unroll
        for (int i = 0; i < 4; ++i) *(u32x4*)(hist + lane * 16 + i * 4) = (u32x4){0u, 0u, 0u, 0u};
#pragma unroll
        for (int i = 0; i < 8; ++i) {
            if (512 * i < n) {
#pragma unroll
                for (int w = 0; w < 4; ++w) { const unsigned wd = kk[i][w]; atomicAdd(&hist[(wd & 0xffffu) >> 6], 1u); atomicAdd(&hist[wd >> 22], 1u); }
            }
        }
        unsigned h[16];
#pragma unroll
        for (int i = 0; i < 4; ++i) { const u32x4 t = *(const u32x4*)(hist + lane * 16 + i * 4); h[4 * i] = t.x; h[4 * i + 1] = t.y; h[4 * i + 2] = t.z; h[4 * i + 3] = t.w; }
#pragma unroll
        for (int i = 0; i < 4; ++i) *(u32x4*)(hist + lane * 16 + i * 4) = (u32x4){0u, 0u, 0u, 0u};
        unsigned sl = 0;
#pragma unroll
        for (int i = 0; i < 16; ++i) sl += h[i];
        unsigned pre = sl;
#pragma unroll
        for (int o = 1; o < 64; o <<= 1) { const unsigned t = __shfl_up(pre, o); if (lane >= o) pre += t; }
        const unsigned tot = __shfl(pre, 63);
        const unsigned suf = tot - pre;
        int found = -1; unsigned cab = 0, cum = suf;
#pragma unroll
        for (int j = 15; j >= 0; --j) { const bool hit = (found < 0) && (cum + h[j] >= 256u); if (hit) { found = lane * 16 + j; cab = cum; } cum += h[j]; }
        const bool mine = (suf < 256u) && (suf + sl >= 256u);
        const unsigned long long mm = __ballot(mine);
        const int src = __ffsll((long long)mm) - 1;
        const unsigned bstar = (unsigned)__shfl(found, src), cabove = __shfl(cab, src);
        const unsigned r1 = 256u - cabove;
#pragma unroll
        for (int i = 0; i < 8; ++i) {
            if (512 * i < n) {
#pragma unroll
                for (int w = 0; w < 4; ++w) {
                    const unsigned wd = kk[i][w];
                    if (((wd & 0xffffu) >> 6) == bstar) atomicAdd(&hist[wd & 63u], 1u);
                    if ((wd >> 22) == bstar) atomicAdd(&hist[(wd >> 16) & 63u], 1u);
                }
            }
        }
        const unsigned cnt = hist[lane];
        hist[lane] = 0u;
        unsigned pre2 = cnt;
#pragma unroll
        for (int o = 1; o < 64; o <<= 1) { const unsigned t = __shfl_up(pre2, o); if (lane >= o) pre2 += t; }
        const unsigned tot2 = __shfl(pre2, 63);
        const unsigned suf2 = tot2 - pre2;
        const bool mine2 = (suf2 < r1) && (suf2 + cnt >= r1);
        const unsigned long long mm2 = __ballot(mine2);
        const int src2 = __ffsll((long long)mm2) - 1;
        const unsigned T = (bstar << 6) | (unsigned)src2;
        const unsigned req = r1 - __shfl(suf2, src2);
        const unsigned toteq = __shfl(cnt, src2);
        const bool alleq = (req == toteq);
        const unsigned Tt = alleq ? T : T + 1u;
        unsigned cg = 0;
#pragma unroll
        for (int i = 0; i < 8; ++i)
#pragma unroll
            for (int w = 0; w < 4; ++w) { const unsigned wd = kk[i][w]; cg += ((wd & 0xffffu) >= Tt) ? 1u : 0u; cg += ((wd >> 16) >= Tt) ? 1u : 0u; }
        unsigned pre3 = cg;
#pragma unroll
        for (int o = 1; o < 64; o <<= 1) { const unsigned t = __shfl_up(pre3, o); if (lane >= o) pre3 += t; }
        unsigned off = pre3 - cg;
#pragma unroll
        for (int i = 0; i < 8; ++i)
#pragma unroll
            for (int w = 0; w < 4; ++w) {
                const unsigned wd = kk[i][w]; const int idx = 512 * i + 8 * lane + 2 * w;
                if ((wd & 0xffffu) >= Tt) { list[off & 255u] = (unsigned short)idx; ++off; }
                if ((wd >> 16) >= Tt) { list[off & 255u] = (unsigned short)(idx + 1); ++off; }
            }
        if (!alleq) {
            const unsigned cgt = 256u - req; unsigned eq_run = 0;
            for (int base = 0; base < n; base += 64) {
                const int i = base + lane; const unsigned m = (i < n) ? myk[i] : 0u;
                const bool eq = (m == T);
                const unsigned long long eqm = __ballot(eq);
                const unsigned rank = eq_run + __builtin_amdgcn_mbcnt_hi((unsigned)(eqm >> 32), __builtin_amdgcn_mbcnt_lo((unsigned)eqm, 0u));
                if (eq && rank < req) list[cgt + rank] = (unsigned short)i;
                eq_run += (unsigned)__popcll(eqm);
            }
        }
    }
    if (!(MODE & 4)) return;
    bf16x8 qf[2], sel[2];
#pragma unroll
    for (int s = 0; s < 2; ++s) {
        u32x4 t = (u32x4){0u, 0u, 0u, 0u};
        if (c < 8) t = ldg16(QB + (size_t)tok * 512 + c * 64 + 32 * s + 8 * g);
        qf[s] = as_bf16x8(t);
#pragma unroll
        for (int j = 0; j < 8; ++j) sel[s][j] = (8 * g + j == 16 * s + c) ? (short)0x3F80 : (short)0;
    }
    f32x4 st[16];
    const unsigned char* kbb = (const unsigned char*)(KB + (size_t)b * SEQ * 64); const unsigned char* vbb = (const unsigned char*)(VB + (size_t)b * SEQ * 64);
    const int lr = lane >> 3, lc = lane & 7;
    const unsigned st_off = lr * 128 + ((lc ^ lr) << 4);
    auto loadg = [&](const unsigned char* base, int T0, u32x4 (&dst)[8]) {
#pragma unroll
        for (int i = 0; i < 8; ++i) {
            const int idx = T0 * 16 + i * 8 + lr; const unsigned kid = (idx < L) ? (unsigned)list[idx] : 0u;
            dst[i] = ldg16(base + kid * 128u + lc * 16u);
        }
    };
    auto stage = [&](const u32x4 (&src)[8]) {
#pragma unroll
        for (int i = 0; i < 8; ++i) *(u32x4*)(stg + i * 1024 + st_off) = src[i];
    };
    auto frag = [&](int u, int s2) -> bf16x8 { return as_bf16x8(*(const u32x4*)(stg + (16 * u + c) * 128 + (((4 * s2 + g) ^ (c & 7)) << 4))); };
    auto scoreK = [&](int T0) {
#pragma unroll
        for (int T = 0; T < 4; ++T) {
            f32x4 d = mfma16(frag(T, 0), qf[0], (f32x4){0.f, 0.f, 0.f, 0.f});
            st[T0 + T] = mfma16(frag(T, 1), qf[1], d);
        }
    };
    u32x4 rA[8], rB[8], rC[8], rD[8];
    loadg(kbb, 0, rA); loadg(kbb, 4, rB); loadg(kbb, 8, rC); loadg(kbb, 12, rD);
    __builtin_amdgcn_sched_barrier(0);
    stage(rA); scoreK(0);
    stage(rB); scoreK(4);
    __builtin_amdgcn_sched_barrier(0);
    loadg(vbb, 0, rA); loadg(vbb, 4, rB);
    stage(rC); scoreK(8);
    stage(rD); scoreK(12);
    __builtin_amdgcn_sched_barrier(0);
    float mx = -3.0e38f;
    {
        const int lrem = L - 4 * g;
#pragma unroll
        for (int T = 0; T < 16; ++T)
#pragma unroll
            for (int r = 0; r < 4; ++r) { const float sv = (T * 16 + r < lrem) ? st[T][r] : -3.0e38f; st[T][r] = sv; mx = fmaxf(mx, sv); }
    }
    mx = fmaxf(mx, __shfl_xor(mx, 16)); mx = fmaxf(mx, __shfl_xor(mx, 32));
    float lsum = 0.f;
#pragma unroll
    for (int T = 0; T < 16; ++T)
#pragma unroll
        for (int r = 0; r < 4; ++r) { const float e = __expf(st[T][r] - mx); st[T][r] = e; lsum += e; }
    lsum += __shfl_xor(lsum, 16); lsum += __shfl_xor(lsum, 32);
    const float rl = 1.0f / lsum;
    u32x4 pfv[8];
#pragma unroll
    for (int u = 0; u < 8; ++u) {
        const int Ta = 2 * u, Tb = Ta + 1;
        pfv[u].x = pack_bf16(st[Ta][0] * rl, st[Ta][1] * rl); pfv[u].y = pack_bf16(st[Ta][2] * rl, st[Ta][3] * rl);
        pfv[u].z = pack_bf16(st[Tb][0] * rl, st[Tb][1] * rl); pfv[u].w = pack_bf16(st[Tb][2] * rl, st[Tb][3] * rl);
    }
    __builtin_amdgcn_sched_barrier(0);
    f32x4 O[4];
#pragma unroll
    for (int cb = 0; cb < 4; ++cb) O[cb] = (f32x4){0.f, 0.f, 0.f, 0.f};
    auto pv = [&](int T0) {
#pragma unroll
        for (int u = 0; u < 2; ++u) {
            const u32x4 pf = pfv[(T0 >> 1) + u];
#pragma unroll
            for (int cb = 0; cb < 4; ++cb) {
                const f32x4 z = (f32x4){0.f, 0.f, 0.f, 0.f};
                const f32x4 v0 = mfma16(frag(2 * u, cb >> 1), sel[cb & 1], z), v1 = mfma16(frag(2 * u + 1, cb >> 1), sel[cb & 1], z);
                u32x4 vf; vf.x = pack_bf16(v0[0], v0[1]); vf.y = pack_bf16(v0[2], v0[3]); vf.z = pack_bf16(v1[0], v1[1]); vf.w = pack_bf16(v1[2], v1[3]);
                O[cb] = mfma16(as_bf16x8(pf), as_bf16x8(vf), O[cb]);
            }
        }
    };
    loadg(vbb, 8, rC); loadg(vbb, 12, rD);
    __builtin_amdgcn_sched_barrier(0);
    stage(rA); pv(0);
    stage(rB); pv(4);
    __builtin_amdgcn_sched_barrier(0);
    stage(rC); pv(8);
    stage(rD); pv(12);
    if (g < 2) {
#pragma unroll
        for (int cb = 0; cb < 4; ++cb)
#pragma unroll
            for (int r = 0; r < 4; ++r) ATT8[(size_t)tok * 1024 + 512 + (4 * g + r) * 64 + 16 * cb + c] = (unsigned char)__builtin_amdgcn_cvt_pk_fp8_f32(O[cb][r] * sa8, 0.f, 0, false);
    }
}

DI void p2_swa_item(const Params& p, int item2) {
    unsigned char* ws = p.ws;
    const bf16_t* QA = (const bf16_t*)(ws + WS_QA); const bf16_t* KA = (const bf16_t*)(ws + WS_KA); const bf16_t* VA = (const bf16_t*)(ws + WS_VA);
    unsigned char* ATT8 = ws + WS_ATT;
    const float sa8 = 439.f / fmaxf(__uint_as_float(*(const unsigned*)(ws + WS_AMAX + 4)), 1e-30f);
    int tid = threadIdx.x; asm volatile("" : "+v"(tid));
    const int lane = tid & 63, wave = __builtin_amdgcn_readfirstlane(tid >> 6), r = lane & 31, h = lane >> 5;
    const int hq = item2 & 7, blk = (item2 >> 3) & 31, b = item2 >> 8, kvh = hq >> 2;
    const int qi = 32 * wave + r, tokq = b * SEQ + blk * 128 + qi;
    bf16x8 qf[4], sel[2];
#pragma unroll
    for (int s = 0; s < 4; ++s) qf[s] = as_bf16x8(ldg16(QA + (size_t)tokq * 512 + hq * 64 + 16 * s + 8 * h));
#pragma unroll
    for (int x = 0; x < 2; ++x)
#pragma unroll
        for (int j = 0; j < 8; ++j) sel[x][j] = (8 * h + j + 16 * x == r) ? (short)0x3F80 : (short)0;
    const float sink = p.sinks[hq];
    f32x16 ST[5];
#pragma unroll
    for (int ti = 0; ti < 5; ++ti) {
        const int sj = 32 * (wave + ti) + r; int pos = blk * 128 - 128 + sj; pos = pos < 0 ? 0 : pos;
        const bf16_t* kp = KA + (size_t)(b * SEQ + pos) * 128 + kvh * 64 + 8 * h;
        f32x16 d; for (int i = 0; i < 16; ++i) d[i] = 0.f;
#pragma unroll
        for (int s = 0; s < 4; ++s) d = mfma32(as_bf16x8(ldg16(kp + 16 * s)), qf[s], d);
        ST[ti] = d;
    }
    float mx = sink;
    {
        const int lo = r + 1 - 4 * h;
        const int lo0 = (blk > 0) ? lo : (lo > 128 - 32 * wave - 4 * h ? lo : 128 - 32 * wave - 4 * h);
#pragma unroll
        for (int ti = 0; ti < 5; ++ti)
#pragma unroll
            for (int reg = 0; reg < 16; ++reg) {
                const int e = 32 * ti + (reg & 3) + 8 * (reg >> 2);
                const float sv = (e >= lo0 && e < lo + 128) ? ST[ti][reg] : -3.0e38f; ST[ti][reg] = sv; mx = fmaxf(mx, sv);
            }
    }
    mx = fmaxf(mx, __shfl_xor(mx, 32));
    float lsum = 0.f;
#pragma unroll
    for (int ti = 0; ti < 5; ++ti)
#pragma unroll
        for (int reg = 0; reg < 16; ++reg) { const float e = __expf(ST[ti][reg] - mx); ST[ti][reg] = e; lsum += e; }
    lsum += __shfl_xor(lsum, 32);
    lsum += __expf(sink - mx);
    const float rl = 1.0f / lsum;
    f32x16 OT[2];
    for (int i = 0; i < 16; ++i) { OT[0][i] = 0.f; OT[1][i] = 0.f; }
#pragma unroll
    for (int ti = 0; ti < 5; ++ti) {
        const int sj = 32 * (wave + ti) + r; int pos = blk * 128 - 128 + sj; pos = pos < 0 ? 0 : pos;
        const bf16_t* vp = VA + (size_t)(b * SEQ + pos) * 128 + kvh * 64 + 8 * h;
        bf16x8 vf[4];
#pragma unroll
        for (int s = 0; s < 4; ++s) vf[s] = as_bf16x8(ldg16(vp + 16 * s));
        u32x4 pb[2];
#pragma unroll
        for (int s2 = 0; s2 < 2; ++s2) {
            pb[s2].x = pack_bf16(ST[ti][8 * s2 + 0] * rl, ST[ti][8 * s2 + 1] * rl); pb[s2].y = pack_bf16(ST[ti][8 * s2 + 2] * rl, ST[ti][8 * s2 + 3] * rl);
            pb[s2].z = pack_bf16(ST[ti][8 * s2 + 4] * rl, ST[ti][8 * s2 + 5] * rl); pb[s2].w = pack_bf16(ST[ti][8 * s2 + 6] * rl, ST[ti][8 * s2 + 7] * rl);
        }
#pragma unroll
        for (int db = 0; db < 2; ++db) {
            f32x16 vt; for (int i = 0; i < 16; ++i) vt[i] = 0.f;
            vt = mfma32(vf[2 * db], sel[0], vt); vt = mfma32(vf[2 * db + 1], sel[1], vt);
#pragma unroll
            for (int s2 = 0; s2 < 2; ++s2) {
                u32x4 va; va.x = pack_bf16(vt[8 * s2 + 0], vt[8 * s2 + 1]); va.y = pack_bf16(vt[8 * s2 + 2], vt[8 * s2 + 3]);
                va.z = pack_bf16(vt[8 * s2 + 4], vt[8 * s2 + 5]); va.w = pack_bf16(vt[8 * s2 + 6], vt[8 * s2 + 7]);
                OT[db] = mfma32(as_bf16x8(va), as_bf16x8(pb[s2]), OT[db]);
            }
        }
    }
#pragma unroll
    for (int db = 0; db < 2; ++db)
#pragma unroll
        for (int q4 = 0; q4 < 4; ++q4) {
            int pk = __builtin_amdgcn_cvt_pk_fp8_f32(OT[db][4 * q4] * sa8, OT[db][4 * q4 + 1] * sa8, 0, false);
            pk = __builtin_amdgcn_cvt_pk_fp8_f32(OT[db][4 * q4 + 2] * sa8, OT[db][4 * q4 + 3] * sa8, pk, true);
            *(int*)(ATT8 + (size_t)tokq * 1024 + hq * 64 + 32 * db + 8 * q4 + 4 * h) = pk;
        }
}

template <int MODE> DI void p2_attention(const Params& p, unsigned char* lds, int cidx = 0) {
    const int G = gridDim.x, bi = blockIdx.x, rounds = (1024 + G - 1) / G;
    for (int b = 0; b < BATCH; ++b)
        for (int r = 0; r < rounds; ++r) {
            const int idx = (r & 1) ? r * G + (G - 1 - bi) : r * G + bi;
            if (idx < 1024) p2_dsa_item<MODE>(p, lds, b, 1023 - idx);
        }
    if (MODE & 8) for (int item2 = bi; item2 < NSWA; item2 += G) p2_swa_item(p, item2);
}

DI void p3_outproj(const Params& p, unsigned char* lds) {
    unsigned char* ws = p.ws;
    const unsigned char* ATT8 = ws + WS_ATT; const unsigned char* WT8 = ws + WS_WOT;
    const float desc = (fmaxf(__uint_as_float(*(const unsigned*)(ws + WS_AMAX + 4)), 1e-30f) * (1.f / 439.f)) * (fmaxf(__uint_as_float(*(const unsigned*)(ws + WS_AMAX)), 1e-30f) * (1.f / 439.f));
    const int tid = threadIdx.x, lane = tid & 63, wave = tid >> 6, wm = wave >> 1, wn = wave & 1, c = lane & 15, g = lane >> 4;
    constexpr int NT = 8, MT = NTOK / 128;
    int mt, nt;
    for (int k = 0; tile_of(k, NT, MT, mt, nt); ++k) {
        f32x4 acc[4][4];
        gemm8_128x128(ATT8 + (size_t)mt * 128 * 1024, 1024, WT8 + (size_t)nt * 128 * 1024, 1024, 1024, lds, acc);
#pragma unroll
        for (int m = 0; m < 4; ++m) {
            const int tok = mt * 128 + wm * 64 + m * 16 + c;
#pragma unroll
            for (int n = 0; n < 4; ++n) {
                const size_t o = (size_t)tok * 1024 + nt * 128 + wn * 64 + 16 * n + 4 * g;
                const u32x2 xw = *(const u32x2*)((const bf16_t*)(ws + WS_XB) + o);
                const f32x4 xv = {bf_lo(xw.x), bf_hi(xw.x), bf_lo(xw.y), bf_hi(xw.y)};
                const f32x4 hv = xv * ALPHA + acc[m][n] * desc;
                u32x2 w; w.x = pack_bf16(hv[0], hv[1]); w.y = pack_bf16(hv[2], hv[3]);
                *(u32x2*)((bf16_t*)p.out + o) = w;
            }
        }
    }
}

DI void p3b_ln1(const Params& p) {
    bf16_t* H1B = (bf16_t*)(p.ws + WS_XB); const bf16_t* HP = (const bf16_t*)p.out;
    const int lane = threadIdx.x & 63, gw = blockIdx.x * 4 + (threadIdx.x >> 6), nw = gridDim.x * 4;
    for (int row = gw; row < NTOK; row += nw) {
        const u32x4 ra = ldg16(HP + (size_t)row * 1024 + lane * 16), rb = ldg16(HP + (size_t)row * 1024 + lane * 16 + 8);
        float v[16];
        v[0] = bf_lo(ra.x); v[1] = bf_hi(ra.x); v[2] = bf_lo(ra.y); v[3] = bf_hi(ra.y); v[4] = bf_lo(ra.z); v[5] = bf_hi(ra.z); v[6] = bf_lo(ra.w); v[7] = bf_hi(ra.w);
        v[8] = bf_lo(rb.x); v[9] = bf_hi(rb.x); v[10] = bf_lo(rb.y); v[11] = bf_hi(rb.y); v[12] = bf_lo(rb.z); v[13] = bf_hi(rb.z); v[14] = bf_lo(rb.w); v[15] = bf_hi(rb.w);
        float s = 0.f;
#pragma unroll
        for (int i = 0; i < 16; ++i) s += v[i];
        const float mu = wave_sum(s) * (1.f / 1024.f); float q = 0.f;
#pragma unroll
        for (int i = 0; i < 16; ++i) { const float d = v[i] - mu; q = fmaf(d, d, q); }
        const float rstd = rsqrtf(wave_sum(q) * (1.f / 1024.f) + LN_EPS);
        u32x4 oa, ob; float ov[16]; float amax = 0.f;
#pragma unroll
        for (int k4 = 0; k4 < 4; ++k4) {
            const int col = lane * 16 + k4 * 4;
            const f32x4 gg = *(const f32x4*)(p.ln1_g + col), bb = *(const f32x4*)(p.ln1_b + col);
            float o[4];
#pragma unroll
            for (int e = 0; e < 4; ++e) { o[e] = (v[k4 * 4 + e] - mu) * rstd * gg[e] + bb[e]; ov[k4 * 4 + e] = o[e]; amax = fmaxf(amax, fabsf(o[e])); }
            const unsigned w0 = pack_bf16(o[0], o[1]), w1 = pack_bf16(o[2], o[3]);
            if (k4 == 0) { oa.x = w0; oa.y = w1; } else if (k4 == 1) { oa.z = w0; oa.w = w1; } else if (k4 == 2) { ob.x = w0; ob.y = w1; } else { ob.z = w0; ob.w = w1; }
        }
        *(u32x4*)(H1B + (size_t)row * 1024 + lane * 16) = oa; *(u32x4*)(H1B + (size_t)row * 1024 + lane * 16 + 8) = ob;
        {
#pragma unroll
            for (int o2 = 32; o2 >= 1; o2 >>= 1) amax = fmaxf(amax, __shfl_xor(amax, o2));
            const float sx = amax > 0.f ? amax * (1.0f / 440.0f) : 1.0f, inv = amax > 0.f ? 440.0f / amax : 1.0f;
            u32x4 q8;
#pragma unroll
            for (int k4 = 0; k4 < 4; ++k4) {
                int w = 0;
                w = __builtin_amdgcn_cvt_pk_fp8_f32(ov[4 * k4] * inv, ov[4 * k4 + 1] * inv, w, false);
                w = __builtin_amdgcn_cvt_pk_fp8_f32(ov[4 * k4 + 2] * inv, ov[4 * k4 + 3] * inv, w, true);
                q8[k4] = (unsigned)w;
            }
            *(u32x4*)(p.ws + WS_QA + (size_t)row * 1024 + lane * 16) = q8;
            if (lane == 0) ((float*)(p.ws + WS_SX))[row] = sx;
        }
    }
}

DI int f2key(float v) { const int b = __float_as_int(v); return b ^ ((b >> 31) & 0x7fffffff); }
DI float key2f(int k) { return __int_as_float(k ^ ((k >> 31) & 0x7fffffff)); }
DI void ce_desc(int& a, int& b) { const int hi = a > b ? a : b, lo = a > b ? b : a; a = hi; b = lo; }
DI void bitonic_merge16(int (&k)[16]) {
#pragma unroll
    for (int d = 8; d >= 1; d >>= 1)
#pragma unroll
        for (int i = 0; i < 16; ++i) if ((i & d) == 0) ce_desc(k[i], k[i | d]);
}
DI void bitonic_sort16(int (&k)[16]) {
#pragma unroll
    for (int sz = 2; sz <= 16; sz <<= 1) {
#pragma unroll
        for (int i = 0; i < 16; ++i) { const int j = i ^ (sz - 1); if (j > i) ce_desc(k[i], k[j]); }
#pragma unroll
        for (int d = sz >> 2; d >= 1; d >>= 1)
#pragma unroll
            for (int i = 0; i < 16; ++i) if ((i & d) == 0) ce_desc(k[i], k[i | d]);
    }
}
DI void top16_merge(int (&t)[16], const int (&sdesc)[16]) {
#pragma unroll
    for (int i = 0; i < 16; ++i) t[i] = t[i] > sdesc[15 - i] ? t[i] : sdesc[15 - i];
    bitonic_merge16(t);
}
constexpr int P4_QS = 32768, P4_SS_STRIDE = 132, P4_ST0 = 67584  , P4_M = 0  , P4_ST1 = 8704  ;

DI void p4_peer_query(const Params& p, unsigned char* lds) {
    unsigned char* ws = p.ws;
    const bf16_t* H1B = (const bf16_t*)(ws + WS_XB); const bf16_t* WQT = (const bf16_t*)(ws + WS_WQT); const bf16_t* SK = (const bf16_t*)(ws + WS_SK);
    unsigned short* PE = (unsigned short*)(ws + WS_PE); float* PG = (float*)(ws + WS_PG); float* PS = (float*)(ws + WS_PS);
    const float* SU = (const float*)(ws + WS_SU); const float* SV = (const float*)(ws + WS_SV);
    float* Ss = (float*)lds;
    float* st0 = (float*)(lds + P4_ST0); float* mbuf = (float*)(lds + P4_M); float* st1 = (float*)(lds + P4_ST1);
    constexpr int MT = NTOK / 128;
    int mt, head;
    for (int k = 0; tile_of(k, 8, MT, mt, head); ++k) {
        int tid = threadIdx.x; asm volatile("" : "+v"(tid));
        const int lane = tid & 63, wave = tid >> 6, wm = wave >> 1, wn = wave & 1, c = lane & 15, g = lane >> 4;
        const int lrow = tid >> 3, lch = tid & 7;
        const int srow = tid & 127, shalf = tid >> 7;
#pragma unroll 1
        for (int ph = 0; ph < 2; ++ph) {
            f32x4 acc[4][4];
            gemm_128x128(H1B + (size_t)mt * 128 * 1024, 1024, WQT + (size_t)(head * 256 + ph * 128) * 1024, 1024, 1024, lds, acc);
            __syncthreads();
#pragma unroll
            for (int m = 0; m < 4; ++m)
#pragma unroll
                for (int n = 0; n < 4; ++n) {
                    const int row = wm * 64 + m * 16 + c;
                    u32x2 w; w.x = pack_bf16(acc[m][n][0], acc[m][n][1]); w.y = pack_bf16(acc[m][n][2], acc[m][n][3]);
                    *(u32x2*)(lds + P4_QS + wn * 16384 + row * 128 + (((2 * n + (g >> 1)) ^ (row & 7)) << 4) + (g & 1) * 8) = w;
                }
            {
                const bf16_t* sp = SK + (size_t)((head * 2 + ph) * 128 + lrow) * 128 + lch * 8;
#pragma unroll
                for (int k2 = 0; k2 < 2; ++k2)
#pragma unroll
                    for (int i = 0; i < 4; ++i) *(u32x4*)(lds + k2 * 16384 + (lrow + 32 * i) * 128 + ((lch ^ (lrow & 7)) << 4)) = ldg16(sp + (size_t)(32 * i) * 128 + k2 * 64);
            }
            __syncthreads();
            f32x4 a2[4][4];
#pragma unroll
            for (int m = 0; m < 4; ++m)
#pragma unroll
                for (int n = 0; n < 4; ++n) a2[m][n] = (f32x4){0.f, 0.f, 0.f, 0.f};
#pragma unroll
            for (int k2 = 0; k2 < 2; ++k2)
#pragma unroll
                for (int s = 0; s < 2; ++s) {
                    bf16x8 xf[4], wf[4];
#pragma unroll
                    for (int m = 0; m < 4; ++m) { const int row = wm * 64 + m * 16 + c; xf[m] = as_bf16x8(*(const u32x4*)(lds + P4_QS + k2 * 16384 + row * 128 + (((4 * s + g) ^ (c & 7)) << 4))); }
#pragma unroll
                    for (int n = 0; n < 4; ++n) { const int row = wn * 64 + n * 16 + c; wf[n] = as_bf16x8(*(const u32x4*)(lds + k2 * 16384 + row * 128 + (((4 * s + g) ^ (c & 7)) << 4))); }
#pragma unroll
                    for (int m = 0; m < 4; ++m)
#pragma unroll
                        for (int n = 0; n < 4; ++n) a2[m][n] = mfma16(wf[n], xf[m], a2[m][n]);
                }
            __syncthreads();
#pragma unroll
            for (int m = 0; m < 4; ++m)
#pragma unroll
                for (int n = 0; n < 4; ++n) {
                    const int key0 = wn * 64 + 16 * n + 4 * g;
                    u32x4 w;
#pragma unroll
                    for (int r = 0; r < 4; ++r) w[r] = (unsigned)f2key(__uint_as_float((__float_as_uint(a2[m][n][r]) & 0xFFFFFF80u) | (unsigned)(key0 + r)));
                    *(u32x4*)(Ss + (wm * 64 + m * 16 + c) * P4_SS_STRIDE + key0) = w;
                }
            __syncthreads();
            int tv[16];
            {
                const int* rowp = (const int*)Ss + srow * P4_SS_STRIDE + shalf * 64;
#pragma unroll
                for (int bt = 0; bt < 4; ++bt) {
                    int bk[16];
#pragma unroll
                    for (int j = 0; j < 4; ++j) { const u32x4 v = *(const u32x4*)(rowp + 16 * bt + 4 * j); bk[4 * j] = (int)v.x; bk[4 * j + 1] = (int)v.y; bk[4 * j + 2] = (int)v.z; bk[4 * j + 3] = (int)v.w; }
                    bitonic_sort16(bk);
                    if (bt == 0) {
#pragma unroll
                        for (int j = 0; j < 16; ++j) tv[j] = bk[j];
                    } else top16_merge(tv, bk);
                }
            }
            __syncthreads();
            int* mbi = (int*)mbuf;
            if (shalf == 1) {
#pragma unroll
                for (int j = 0; j < 16; ++j) mbi[srow * 17 + j] = tv[j];
            }
            __syncthreads();
            if (shalf == 0) {
                int* dst = (int*)((ph == 0) ? st0 : st1);
                int ob[16];
#pragma unroll
                for (int j = 0; j < 16; ++j) ob[j] = mbi[srow * 17 + j];
                top16_merge(tv, ob);
#pragma unroll
                for (int j = 0; j < 16; ++j) dst[srow * 17 + j] = tv[j];
            }
        }
        __syncthreads();
        int cv[16];
        {
            const int* st0i = (const int*)st0; const int* st1i = (const int*)st1;
            float v2[16];
#pragma unroll
            for (int b = 0; b < 16; ++b) v2[b] = key2f(st1i[srow * 17 + b]);
#pragma unroll
            for (int a8 = 0; a8 < 8; ++a8) {
                const int a = shalf * 8 + a8; const float va = key2f(st0i[srow * 17 + a]);
                int bk[16];
#pragma unroll
                for (int b = 0; b < 16; ++b) bk[b] = (f2key(va + v2[b]) & (int)0xFFFFFF00) | (a * 16 + 15 - b);
                if (a8 == 0) {
#pragma unroll
                    for (int j = 0; j < 16; ++j) cv[j] = bk[j];
                } else top16_merge(cv, bk);
            }
        }
        __syncthreads();
        int* mbi = (int*)mbuf;
        if (shalf == 1) {
#pragma unroll
            for (int j = 0; j < 16; ++j) mbi[srow * 17 + j] = cv[j];
        }
        __syncthreads();
        if (shalf == 0) {
            const int* st0i = (const int*)st0; const int* st1i = (const int*)st1;
            int fk[16]; float fv[16];
#pragma unroll
            for (int j = 0; j < 16; ++j) { const int o = mbi[srow * 17 + 15 - j]; fk[j] = cv[j] > o ? cv[j] : o; fv[j] = key2f(fk[j]); }
            float cmax = fv[0];
#pragma unroll
            for (int j = 1; j < 16; ++j) cmax = fmaxf(cmax, fv[j]);
            float den = 0.f; float ev[16];
#pragma unroll
            for (int j = 0; j < 16; ++j) { ev[j] = __expf(fv[j] - cmax); den += ev[j]; }
            const float rden = 1.0f / den;
            const size_t ob = (size_t)(mt * 128 + srow) * 128 + head * 16;
#pragma unroll
            for (int j = 0; j < 16; ++j) {
                const unsigned cde = (unsigned)fk[j] & 0xFFu;
                const unsigned a = cde >> 4, b = 15u - (cde & 15u);
                const unsigned i1 = __float_as_uint(key2f(st0i[srow * 17 + a])) & 0x7Fu, i2 = __float_as_uint(key2f(st1i[srow * 17 + b])) & 0x7Fu;
                const int e = (int)(i1 * 128u + i2);
                PE[ob + j] = (unsigned short)e; PG[ob + j] = ev[j] * rden * SV[e]; PS[ob + j] = SU[e];
            }
        }
        __syncthreads();
    }
}

DI float gelu_exact(float z) { return 0.5f * z * (1.0f + erff(z * 0.70710678118654752f)); }
DI float rdlane(float v, int l) { return __int_as_float(__builtin_amdgcn_readlane(__float_as_int(v), l)); }

constexpr int P5A_LIST_BYTES = (2048 + 128) * 4, P5A_WAVE_LDS = P5A_LIST_BYTES + 8192;
template <int MODE>
DI void p5a_udot(const Params& p, unsigned char* lds) {
    unsigned char* ws = p.ws;
    const unsigned char* H1Q = ws + WS_QA; const unsigned char* UT = ws + WS_UT;
    const unsigned short* PE = (const unsigned short*)(ws + WS_PE); float* ZB = (float*)(ws + (MODE ? WS_QI : WS_QB));
    const int lane = threadIdx.x & 63, wave = threadIdx.x >> 6, c = lane & 15, kb = lane >> 4;
    const int G = gridDim.x, bid = blockIdx.x;
    const bool affine = (G & 7) == 0;
    const int npass = affine ? 1 : 4;
    unsigned* list = (unsigned*)(lds + wave * P5A_WAVE_LDS);
    unsigned char* slot = lds + wave * P5A_WAVE_LDS + P5A_LIST_BYTES;
    const int l31 = lane & 31, lh = lane >> 5;
    unsigned cq[8];
#pragma unroll
    for (int q = 0; q < 8; ++q) cq[q] = (unsigned)((l31 ^ (q + 8 * lh)) * 16);
    for (int pass = 0; pass < npass; ++pass) {
        const int part = affine ? (bid & 3) : pass, rank = affine ? (bid >> 2) : bid, nper = affine ? (G >> 2) : G;
        const unsigned char* UTp = UT + (size_t)part * (4096 * 512);
        for (int gid = rank * 4 + wave; gid < NTOK / 16; gid += nper * 4) {
            const int t0 = gid * 16;
            u32x4 pv[4];
#pragma unroll
            for (int i = 0; i < 4; ++i) pv[i] = ldg16(PE + (size_t)(t0 + (lane >> 2)) * 128 + (lane & 3) * 32 + 8 * i);
            i32x8 ax[8];
#pragma unroll
            for (int s2 = 0; s2 < 8; ++s2) {
                const unsigned char* xp = H1Q + (size_t)(t0 + c) * 1024 + 128 * s2 + 16 * kb;
                const u32x4 lo = ldg16(xp), hi = ldg16(xp + 64);
                ax[s2][0] = (int)lo.x; ax[s2][1] = (int)lo.y; ax[s2][2] = (int)lo.z; ax[s2][3] = (int)lo.w; ax[s2][4] = (int)hi.x; ax[s2][5] = (int)hi.y; ax[s2][6] = (int)hi.z; ax[s2][7] = (int)hi.w;
            }
            unsigned base = 0;
            const unsigned zl = (unsigned)((lane >> 2) * 128 + (lane & 3) * 32) << 21;
#pragma unroll
            for (int i = 0; i < 4; ++i)
#pragma unroll
                for (int w = 0; w < 4; ++w)
#pragma unroll
                    for (int hf = 0; hf < 2; ++hf) {
                        const unsigned e = hf ? (pv[i][w] >> 16) : (pv[i][w] & 0xffffu);
                        const bool cnd = (int)(e >> 12) == part;
                        const unsigned long long mk = __ballot(cnd);
                        if (mk) {
                            const unsigned pos = base + __builtin_amdgcn_mbcnt_hi((unsigned)(mk >> 32), __builtin_amdgcn_mbcnt_lo((unsigned)mk, 0u));
                            if (cnd) list[pos] = ((e & 4095u) << 9) | (zl + ((unsigned)(8 * i + 2 * w + hf) << 21));
                            base += (unsigned)__popcll(mk);
                        }
                    }
            const int count = (int)base, nrt = (count + 15) >> 4;
            if (MODE == 2) { if (count == 12345) ZB[lane] = (float)ax[7][7] + (float)ax[0][0]; }
            else if (count > 0) {
                {
                    const unsigned last = list[count - 1];
                    list[count + lane] = last; list[count + 64 + lane] = last;
                }
                float* ZBg = ZB + (size_t)t0 * 128;
                auto loadA = [&](int rt, u32x4 (&dst)[8]) {
                    const u32x4 ea = *(const u32x4*)(list + 16 * rt + 8 * lh), eb = *(const u32x4*)(list + 16 * rt + 8 * lh + 4);
#pragma unroll
                    for (int q = 0; q < 8; ++q) {
                        const unsigned ent = q < 4 ? ea[q & 3] : eb[q & 3];
                        dst[q] = ldg16(UTp + ((ent & 0x1ffe00u) | cq[q]));
                    }
                };
                auto compute = [&](int rt, const u32x4 (&st)[8]) {
#pragma unroll
                    for (int q = 0; q < 8; ++q) *(u32x4*)(slot + q * 512 + lh * 4096 + l31 * 16) = st[q];
                    u32x4 bf[8];
#pragma unroll
                    for (int s2 = 0; s2 < 8; ++s2) bf[s2] = *(const u32x4*)(slot + c * 512 + (((4 * s2 + kb) ^ c) * 16));
                    const unsigned ent = list[16 * rt + c];
                    f32x4 D = {0.f, 0.f, 0.f, 0.f};
#pragma unroll
                    for (int s2 = 0; s2 < 8; ++s2) {
                        i32x8 b8; b8[0] = (int)bf[s2].x; b8[1] = (int)bf[s2].y; b8[2] = (int)bf[s2].z; b8[3] = (int)bf[s2].w; b8[4] = 0; b8[5] = 0; b8[6] = 0; b8[7] = 0;
                        D = __builtin_amdgcn_mfma_scale_f32_16x16x128_f8f6f4(ax[s2], b8, D, 0  , 4  , 0, 0, 0, 0);
                    }
                    const unsigned zoff = ent >> 21, tk = zoff >> 7;
                    const float val = (tk & 2u) ? ((tk & 1u) ? D[3] : D[2]) : ((tk & 1u) ? D[1] : D[0]);
                    if ((int)(tk >> 2) == kb && 16 * rt + c < count && (MODE != 3 || val == 1234.5f)) ZBg[zoff] = val;
                };
                u32x4 a0[8], a1[8], a2[8];
                loadA(0, a0); loadA(1, a1); loadA(2, a2);
                for (int rt = 0; rt < nrt; rt += 3) {
                    compute(rt, a0); loadA(rt + 3, a0);
                    if (rt + 1 < nrt) compute(rt + 1, a1);
                    loadA(rt + 4, a1);
                    if (rt + 2 < nrt) compute(rt + 2, a2);
                    loadA(rt + 5, a2);
                }
            }
        }
    }
}

DI void p5b_ffn(const Params& p) {
    unsigned char* ws = p.ws;
    const bf16_t* H1B = (const bf16_t*)(ws + WS_XB); const unsigned char* VT = ws + WS_VT;
    const unsigned short* PE = (const unsigned short*)(ws + WS_PE); const float* PG = (const float*)(ws + WS_PG); const float* PS = (const float*)(ws + WS_PS);
    const int lane = threadIdx.x & 63, gw = blockIdx.x * 4 + (threadIdx.x >> 6), nw = gridDim.x * 4;
    for (int tok = gw; tok < NTOK; tok += nw) {
        float x[16], acc[16];
        {
            const u32x4 xa = ldg16(H1B + (size_t)tok * 1024 + lane * 16), xb = ldg16(H1B + (size_t)tok * 1024 + lane * 16 + 8);
            x[0] = bf_lo(xa.x); x[1] = bf_hi(xa.x); x[2] = bf_lo(xa.y); x[3] = bf_hi(xa.y); x[4] = bf_lo(xa.z); x[5] = bf_hi(xa.z); x[6] = bf_lo(xa.w); x[7] = bf_hi(xa.w);
            x[8] = bf_lo(xb.x); x[9] = bf_hi(xb.x); x[10] = bf_lo(xb.y); x[11] = bf_hi(xb.y); x[12] = bf_lo(xb.z); x[13] = bf_hi(xb.z); x[14] = bf_lo(xb.w); x[15] = bf_hi(xb.w);
        }
#pragma unroll
        for (int i = 0; i < 16; ++i) acc[i] = 0.f;
        const int pe_lo = (int)PE[(size_t)tok * 128 + lane], pe_hi = (int)PE[(size_t)tok * 128 + 64 + lane];
        const float* ZB = (const float*)(ws + WS_QB);
        const float sxt = ((const float*)(ws + WS_SX))[tok];
        const float cf_lo = gelu_exact(ZB[(size_t)tok * 128 + lane] * PS[(size_t)tok * 128 + lane] * sxt) * PG[(size_t)tok * 128 + lane];
        const float cf_hi = gelu_exact(ZB[(size_t)tok * 128 + 64 + lane] * PS[(size_t)tok * 128 + 64 + lane] * sxt) * PG[(size_t)tok * 128 + 64 + lane];
#pragma unroll 1
        for (int hb = 0; hb < 4; ++hb) {
            const int pes = hb < 2 ? pe_lo : pe_hi; const float cfs = hb < 2 ? cf_lo : cf_hi;
            const int lb = (hb & 1) * 32;
#pragma unroll
            for (int j = 0; j < 32; ++j) {
                const int e = __builtin_amdgcn_readlane(pes, lb + j);
                const float cj = rdlane(cfs, lb + j);
                const u32x2 vw = *(const u32x2*)(VT + (size_t)e * 512 + lane * 8);
#define P5_AXPY(k, bs) { const f32x2 f = __builtin_amdgcn_cvt_scalef32_pk_f32_fp4(vw[k], 1.0f, bs); acc[8 * (k) + 2 * (bs)] = fmaf(cj, f.x, acc[8 * (k) + 2 * (bs)]); acc[8 * (k) + 2 * (bs) + 1] = fmaf(cj, f.y, acc[8 * (k) + 2 * (bs) + 1]); }
                P5_AXPY(0, 0) P5_AXPY(0, 1) P5_AXPY(0, 2) P5_AXPY(0, 3) P5_AXPY(1, 0) P5_AXPY(1, 1) P5_AXPY(1, 2) P5_AXPY(1, 3)
            }
        }
        float s = 0.f;
#pragma unroll
        for (int i = 0; i < 16; ++i) { acc[i] = fmaf(ALPHA, x[i], acc[i]); s += acc[i]; }
        const float mu = wave_sum(s) * (1.f / 1024.f); float q = 0.f;
#pragma unroll
        for (int i = 0; i < 16; ++i) { const float dd = acc[i] - mu; q = fmaf(dd, dd, q); }
        const float rstd = rsqrtf(wave_sum(q) * (1.f / 1024.f) + LN_EPS);
#pragma unroll
        for (int k4 = 0; k4 < 4; ++k4) {
            const int col = lane * 16 + k4 * 4;
            const f32x4 gg = *(const f32x4*)(p.ln2_g + col), bb = *(const f32x4*)(p.ln2_b + col);
            f32x4 o;
#pragma unroll
            for (int e = 0; e < 4; ++e) o[e] = (acc[k4 * 4 + e] - mu) * rstd * gg[e] + bb[e];
            *(f32x4*)(p.out + (size_t)tok * 1024 + col) = o;
        }
    }
}

#define XB_TMO      128
#define XB_XCNT(j)  (256  + 64 * (j))
#define XB_XSUB(j)  (1280 + 64 * (j))
#define XB_XGEN(j)  (2304 + 64 * (j))
#define XB_TOP      3328
#define XB_TOPGEN   3392
#define XCD_BAR_WORDS 3456
#define XB_SPIN_CAP (1u << 22)
#define LAS __attribute__((address_space(3)))
DI unsigned xb_ld(unsigned* p)              { return __hip_atomic_load(p, __ATOMIC_RELAXED, __HIP_MEMORY_SCOPE_AGENT); }
DI unsigned xb_add(unsigned* p, unsigned v) { return __hip_atomic_fetch_add(p, v, __ATOMIC_RELAXED, __HIP_MEMORY_SCOPE_AGENT); }
DI unsigned xb_xcc_id() { return (unsigned)__builtin_amdgcn_s_getreg((3 << 11) | 20) & 0xFu; }
#define XB_SPIN(cond, bar) do { unsigned _sp = 0; while (cond) { __builtin_amdgcn_s_sleep(1); \
    if ((++_sp & 255u) == 0u) { if (xb_ld(&(bar)[XB_TMO])) break; if (_sp > XB_SPIN_CAP) { atomicAdd(&(bar)[XB_TMO], 1u); break; } } } } while (0)
struct XcdBarrier { unsigned* bar; unsigned x; volatile LAS unsigned* st; };
DI XcdBarrier xcd_barrier_post(unsigned* bar, volatile LAS unsigned* st) {
    XcdBarrier b; b.bar = bar; b.x = xb_xcc_id(); b.st = st;
    if (threadIdx.x == 0) (void)xb_add(&bar[XB_XCNT(b.x)], 1u);
    return b;
}
DI void xcd_barrier_complete(unsigned* bar, unsigned x, unsigned& nloc, unsigned& nx) {
    const unsigned G = gridDim.x * gridDim.y * gridDim.z;
    unsigned sum, cnt, mine, sp = 0u;
    for (;;) {
        sum = 0u; cnt = 0u; mine = 0u;
#pragma unroll
        for (unsigned j = 0; j < 16; ++j) { const unsigned c = xb_ld(&bar[XB_XCNT(j)]); sum += c; cnt += (c > 0u) ? 1u : 0u; mine = (j == x) ? c : mine; }
        if (sum == G) break;
        __builtin_amdgcn_s_sleep(1);
        if ((++sp & 255u) == 0u) { if (xb_ld(&bar[XB_TMO])) break; if (sp > XB_SPIN_CAP) { atomicAdd(&bar[XB_TMO], 1u); break; } }
    }
    nloc = mine > 0u ? mine : 1u; nx = cnt > 0u ? cnt : 1u;
}
DI void xcd_barrier(const XcdBarrier& b) {
    asm volatile("s_waitcnt vmcnt(0)" ::: "memory");
    __syncthreads();
    if (threadIdx.x == 0) {
        unsigned* bar = b.bar;
        __builtin_amdgcn_s_waitcnt(0);
        unsigned nloc = b.st[0], nx = b.st[1];
        if (nloc == 0u) { xcd_barrier_complete(bar, b.x, nloc, nx); b.st[0] = nloc; b.st[1] = nx; }
        const unsigned old = xb_add(&bar[XB_XSUB(b.x)], 1u);
        const unsigned gen = old / nloc;
        if (old + 1u == (gen + 1u) * nloc) {
            __builtin_amdgcn_fence(__ATOMIC_RELEASE, "agent");
            asm volatile("s_waitcnt vmcnt(0)" ::: "memory");
            const unsigned og = xb_add(&bar[XB_TOP], 1u);
            const unsigned tg = og / nx;
            if (og + 1u == (tg + 1u) * nx) xb_add(&bar[XB_TOPGEN], 1u);
            else XB_SPIN(xb_ld(&bar[XB_TOPGEN]) == tg, bar);
            __builtin_amdgcn_fence(__ATOMIC_ACQUIRE, "agent");
            xb_add(&bar[XB_XGEN(b.x)], 1u);
            asm volatile("s_waitcnt vmcnt(0)" ::: "memory");
        } else {
            XB_SPIN(xb_ld(&bar[XB_XGEN(b.x)]) == gen, bar);
            __builtin_amdgcn_fence(__ATOMIC_ACQUIRE, "agent");
            asm volatile("s_waitcnt vmcnt(0)" ::: "memory");
        }
    }
    __syncthreads();
}

constexpr int NPHASE = 7;
__global__ void __launch_bounds__(NTHREADS, 2) mega_fwd(Params p) {
    extern __shared__ __attribute__((aligned(16))) unsigned char lds[];
    cg::grid_group grid = cg::this_grid();
    const int lo = p.ph_lo, hi = p.ph_hi;
    volatile LAS unsigned* xbst = (volatile LAS unsigned*)(LAS unsigned char*)(lds + LDS_BYTES - 16);
#ifndef REP_MASK
#define REP_MASK 0
#endif
#ifndef P2_PROBE_MODE
#define P2_PROBE_MODE 15
#endif
#ifndef PH_MASK
#define PH_MASK 127
#endif
    if (lo == 0x7fffffff) grid.sync();
    if (threadIdx.x == 0) { xbst[0] = 0u; xbst[1] = 0u; }
    __syncthreads();
    XcdBarrier xb = xcd_barrier_post((unsigned*)(p.ws + WS_BAR), xbst);
#define GSYNC() xcd_barrier(xb)
#if REP_MASK & 1
    p0_prep(p, lds); GSYNC();
#endif
    p0_prep(p, lds);
    GSYNC();
#define RUN_PHASE(k, call) { call; if ((REP_MASK >> (k)) & 1) { GSYNC(); call; } }
#if PH_MASK & 2
    RUN_PHASE(1, p1_inproj(p, lds))
#endif
    GSYNC();
#if PH_MASK & 4
#if (REP_MASK >> 2) & 1
    p2a_indexer(p, lds); GSYNC(); p2_attention<P2_PROBE_MODE>(p, lds, 1); GSYNC();
#endif
    p2a_indexer(p, lds);
    GSYNC();
    p2_attention<15>(p, lds, 0);
#endif
    GSYNC();
#if PH_MASK & 8
    RUN_PHASE(3, p3_outproj(p, lds))
#endif
    GSYNC();
#if PH_MASK & 16
    RUN_PHASE(4, p3b_ln1(p))
#endif
    GSYNC();
#if PH_MASK & 32
    RUN_PHASE(5, p4_peer_query(p, lds))
#endif
    GSYNC();
#if PH_MASK & 64
    p5a_udot<0>(p, lds);
#ifdef P5A_REP
    GSYNC(); p5a_udot<P5A_REP>(p, lds);
#endif
    GSYNC();
    p5b_ffn(p);
#endif
}

#ifndef MK_N_LAUNCHES
#define MK_N_LAUNCHES 1
#endif

extern "C" void kernel_launch(void* const* d_in, const int* in_sizes, int n_in, void* d_out, int out_size, void* d_ws, size_t ws_size, hipStream_t stream) {
    static int grid_blocks = 0;
    if (grid_blocks == 0) {
        if (n_in != 14 || out_size != NTOK * D_MODEL || ws_size < WS_END) {
            fprintf(stderr, "kernel_launch: unexpected problem (n_in %d, out %d, ws %zu, need %zu)\n", n_in, out_size, ws_size, (size_t)WS_END); grid_blocks = -1; return;
        }
        int dev = 0, cus = 0, per_cu = 0;
        hipGetDevice(&dev);
        hipDeviceGetAttribute(&cus, hipDeviceAttributeMultiprocessorCount, dev);
        if (hipFuncSetAttribute((const void*)mega_fwd, hipFuncAttributeMaxDynamicSharedMemorySize, LDS_BYTES) != hipSuccess) { fprintf(stderr, "kernel_launch: hipFuncSetAttribute failed\n"); }
        if (hipOccupancyMaxActiveBlocksPerMultiprocessor(&per_cu, (const void*)mega_fwd, NTHREADS, LDS_BYTES) != hipSuccess || per_cu < 1) { fprintf(stderr, "kernel_launch: occupancy query failed\n"); per_cu = 1; }
        if (per_cu > 2) per_cu = 2;
        (void)hipGetLastError();
        grid_blocks = cus * per_cu;
        fprintf(stderr, "kernel_launch: %d CUs x %d blocks\n", cus, per_cu);
    }
    if (grid_blocks < 0) return;
    Params p{};
    p.x = (const float*)d_in[0]; p.w_in = (const float*)d_in[1]; p.idx_k_g = (const float*)d_in[2]; p.idx_k_b = (const float*)d_in[3]; p.sinks = (const float*)d_in[4];
    p.w_o = (const float*)d_in[5]; p.ln1_g = (const float*)d_in[6]; p.ln1_b = (const float*)d_in[7]; p.peer_wq = (const float*)d_in[8]; p.peer_subkeys = (const float*)d_in[9];
    p.peer_u = (const float*)d_in[10]; p.peer_v = (const float*)d_in[11]; p.ln2_g = (const float*)d_in[12]; p.ln2_b = (const float*)d_in[13];
    p.out = (float*)d_out; p.ws = (unsigned char*)d_ws;
    p.ph_lo = 0; p.ph_hi = NPHASE;
    if (hipMemsetAsync((unsigned char*)d_ws + WS_BAR, 0, 16384 + 64, stream) != hipSuccess) { fprintf(stderr, "kernel_launch: memset of the barrier words failed\n"); return; }
    void* args[] = {&p};
    hipError_t e = hipLaunchCooperativeKernel((const void*)mega_fwd, dim3(grid_blocks), dim3(NTHREADS), args, LDS_BYTES, stream);
    if (e != hipSuccess) fprintf(stderr, "cooperative launch failed: %s (grid %d)\n", hipGetErrorString(e), grid_blocks);
}
```

```cpp
#include <hip/hip_runtime.h>
#include <hip/hip_cooperative_groups.h>
#include <cstdio>
#include <cstdint>
namespace cg = cooperative_groups;

typedef unsigned short bf16_t;
typedef short bf16x8 __attribute__((ext_vector_type(8)));
typedef float f32x4 __attribute__((ext_vector_type(4)));
typedef float f32x16 __attribute__((ext_vector_type(16)));
typedef unsigned u32x4 __attribute__((ext_vector_type(4)));
typedef unsigned u32x2 __attribute__((ext_vector_type(2)));
typedef int i32x8 __attribute__((ext_vector_type(8)));
#define DI __device__ __forceinline__

constexpr int D_MODEL = 1024, BATCH = 8, SEQ = 4096, NTOK = BATCH * SEQ;
constexpr int NMIX = 1732, NMIX_PAD = 1792;
constexpr int P1_F8_COLS = 1408;
constexpr int PEER_N = 2048;
constexpr float ALPHA = 1.189207115002721f;
constexpr float LN_EPS = 1e-5f;
constexpr int NTHREADS = 256;
constexpr int LDS_BYTES = 77824;

constexpr size_t MB = 1024 * 1024;
constexpr size_t WS_CTL   = 0;
constexpr size_t WS_AMAX  = 65536 + 16384;
constexpr size_t WS_BAR   = 65536;
constexpr size_t WS_ROPE  = 1 * MB;
constexpr size_t WS_WINT  = 2 * MB;
constexpr size_t WS_WOT   = 6 * MB;
constexpr size_t WS_WQT   = 8 * MB;
constexpr size_t WS_SK    = 12 * MB;
constexpr size_t WS_UT    = 13 * MB;
constexpr size_t WS_VT    = 29 * MB;
constexpr size_t WS_SU    = 45 * MB;
constexpr size_t WS_SV    = 46 * MB;
constexpr size_t WS_SXR   = 47 * MB + 262144;
constexpr size_t WS_SWN   = 47 * MB + 524288;
constexpr size_t WS_X8    = 282 * MB;
constexpr size_t WS_SX    = 47 * MB;
constexpr size_t WS_XB    = 77 * MB;
constexpr size_t WS_QA    = 141 * MB;
constexpr size_t WS_KA    = 173 * MB;
constexpr size_t WS_VA    = 181 * MB;
constexpr size_t WS_QB    = 189 * MB;
constexpr size_t WS_KB    = 221 * MB;
constexpr size_t WS_VB    = 225 * MB;
constexpr size_t WS_QI    = 229 * MB;
constexpr size_t WS_KI    = 245 * MB;
constexpr size_t WS_WI    = 249 * MB;
constexpr size_t WS_ATT   = 250 * MB;
constexpr size_t WS_PE    = 314 * MB;
constexpr size_t WS_PG    = 322 * MB;
constexpr size_t WS_PS    = 338 * MB;
constexpr size_t WS_END   = 354 * MB;

struct Params {
    const float* x; const float* w_in; const float* idx_k_g; const float* idx_k_b; const float* sinks; const float* w_o;
    const float* ln1_g; const float* ln1_b; const float* peer_wq; const float* peer_subkeys; const float* peer_u; const float* peer_v;
    const float* ln2_g; const float* ln2_b;
    float* out; unsigned char* ws;
    int ph_lo, ph_hi;
};

typedef float f32x2 __attribute__((ext_vector_type(2)));
typedef __bf16 bf16x2_t __attribute__((ext_vector_type(2)));
DI unsigned pack_bf16(float lo, float hi) { const f32x2 v = {lo, hi}; return __builtin_bit_cast(unsigned, __builtin_convertvector(v, bf16x2_t)); }
DI unsigned f2bf(float x) { return pack_bf16(x, 0.f) & 0xffffu; }
DI float bf_lo(unsigned w) { return __uint_as_float(w << 16); }
DI float bf_hi(unsigned w) { return __uint_as_float(w & 0xffff0000u); }
DI bf16x8 as_bf16x8(u32x4 v) { return __builtin_bit_cast(bf16x8, v); }
DI u32x4 ldg16(const void* p) { return *(const u32x4*)p; }
DI f32x4 mfma16(bf16x8 a, bf16x8 b, f32x4 c) { return __builtin_amdgcn_mfma_f32_16x16x32_bf16(a, b, c, 0, 0, 0); }
DI f32x16 mfma32(bf16x8 a, bf16x8 b, f32x16 c) { return __builtin_amdgcn_mfma_f32_32x32x16_bf16(a, b, c, 0, 0, 0); }
DI float wave_sum(float v) {
#pragma unroll
    for (int o = 32; o >= 1; o >>= 1) v += __shfl_xor(v, o);
    return v;
}

DI void glds16(const void* src, void* lds_dst) { __builtin_amdgcn_global_load_lds((const unsigned*)src, (__attribute__((address_space(3))) unsigned*)lds_dst, 16, 0, 0); }
DI void gemm_128x128(const bf16_t* __restrict__ X, int ldx, const bf16_t* __restrict__ Wt, int ldw, int K, unsigned char* lds, f32x4 (&acc)[4][4]) {
    int tid = threadIdx.x; asm volatile("" : "+v"(tid));
    const int lane = tid & 63, wave = tid >> 6, wm = wave >> 1, wn = wave & 1, c = lane & 15, g = lane >> 4;
    const int lrow = tid >> 3, lch = tid & 7;
    const bf16_t* xp = X + (size_t)lrow * ldx + ((lch ^ (lrow & 7)) * 8);
    const bf16_t* wp = Wt + (size_t)lrow * ldw + ((lch ^ (lrow & 7)) * 8);
    unsigned char* dst0 = lds + tid * 16;
#pragma unroll
    for (int m = 0; m < 4; ++m)
#pragma unroll
        for (int n = 0; n < 4; ++n) acc[m][n] = (f32x4){0.f, 0.f, 0.f, 0.f};
    const int nk = K / 64;
    __syncthreads();
#pragma unroll
    for (int i = 0; i < 4; ++i) { glds16(xp + (size_t)(32 * i) * ldx, dst0 + i * 4096); glds16(wp + (size_t)(32 * i) * ldw, dst0 + 16384 + i * 4096); }
    asm volatile("s_waitcnt vmcnt(0)" ::: "memory");
    __syncthreads();
    for (int kt = 0; kt < nk; ++kt) {
        const unsigned char* Xs = lds + (kt & 1) * 32768; const unsigned char* Ws = Xs + 16384;
        if (kt + 1 < nk) {
            unsigned char* d = dst0 + ((kt + 1) & 1) * 32768;
#pragma unroll
            for (int i = 0; i < 4; ++i) { glds16(xp + (size_t)(32 * i) * ldx + (kt + 1) * 64, d + i * 4096); glds16(wp + (size_t)(32 * i) * ldw + (kt + 1) * 64, d + 16384 + i * 4096); }
        }
#pragma unroll
        for (int s = 0; s < 2; ++s) {
            bf16x8 xf[4], wf[4];
#pragma unroll
            for (int m = 0; m < 4; ++m) { const int row = wm * 64 + m * 16 + c; xf[m] = as_bf16x8(*(const u32x4*)(Xs + row * 128 + (((4 * s + g) ^ (c & 7)) << 4))); }
#pragma unroll
            for (int n = 0; n < 4; ++n) { const int row = wn * 64 + n * 16 + c; wf[n] = as_bf16x8(*(const u32x4*)(Ws + row * 128 + (((4 * s + g) ^ (c & 7)) << 4))); }
#pragma unroll
            for (int m = 0; m < 4; ++m)
#pragma unroll
                for (int n = 0; n < 4; ++n) acc[m][n] = mfma16(wf[n], xf[m], acc[m][n]);
        }
        asm volatile("s_waitcnt vmcnt(0)" ::: "memory");
        __syncthreads();
    }
}

DI void gemm8_128x128(const unsigned char* __restrict__ X, int ldx, const unsigned char* __restrict__ Wt, int ldw, int K, unsigned char* lds, f32x4 (&acc)[4][4]) {
    int tid = threadIdx.x; asm volatile("" : "+v"(tid));
    const int lane = tid & 63, wave = tid >> 6, wm = wave >> 1, wn = wave & 1, c = lane & 15, g = lane >> 4;
    const int lrow = tid >> 3, lch = tid & 7;
    const unsigned char* xp = X + (size_t)lrow * ldx + ((lch ^ (lrow & 7)) * 16);
    const unsigned char* wp = Wt + (size_t)lrow * ldw + ((lch ^ (lrow & 7)) * 16);
    unsigned char* dst0 = lds + tid * 16;
#pragma unroll
    for (int m = 0; m < 4; ++m)
#pragma unroll
        for (int n = 0; n < 4; ++n) acc[m][n] = (f32x4){0.f, 0.f, 0.f, 0.f};
    const int nk = K / 128;
    __syncthreads();
#pragma unroll
    for (int i = 0; i < 4; ++i) { glds16(xp + (size_t)(32 * i) * ldx, dst0 + i * 4096); glds16(wp + (size_t)(32 * i) * ldw, dst0 + 16384 + i * 4096); }
    asm volatile("s_waitcnt vmcnt(0)" ::: "memory");
    __syncthreads();
    for (int kt = 0; kt < nk; ++kt) {
        const unsigned char* Xs = lds + (kt & 1) * 32768; const unsigned char* Ws = Xs + 16384;
        if (kt + 1 < nk) {
            unsigned char* d = dst0 + ((kt + 1) & 1) * 32768;
#pragma unroll
            for (int i = 0; i < 4; ++i) { glds16(xp + (size_t)(32 * i) * ldx + (kt + 1) * 128, d + i * 4096); glds16(wp + (size_t)(32 * i) * ldw + (kt + 1) * 128, d + 16384 + i * 4096); }
        }
        i32x8 xf[4], wf[4];
#pragma unroll
        for (int m = 0; m < 4; ++m) {
            const int row = wm * 64 + m * 16 + c;
            const u32x4 lo = *(const u32x4*)(Xs + row * 128 + ((g ^ (c & 7)) << 4)), hi = *(const u32x4*)(Xs + row * 128 + (((4 + g) ^ (c & 7)) << 4));
            xf[m][0] = (int)lo.x; xf[m][1] = (int)lo.y; xf[m][2] = (int)lo.z; xf[m][3] = (int)lo.w; xf[m][4] = (int)hi.x; xf[m][5] = (int)hi.y; xf[m][6] = (int)hi.z; xf[m][7] = (int)hi.w;
        }
#pragma unroll
        for (int n = 0; n < 4; ++n) {
            const int row = wn * 64 + n * 16 + c;
            const u32x4 lo = *(const u32x4*)(Ws + row * 128 + ((g ^ (c & 7)) << 4)), hi = *(const u32x4*)(Ws + row * 128 + (((4 + g) ^ (c & 7)) << 4));
            wf[n][0] = (int)lo.x; wf[n][1] = (int)lo.y; wf[n][2] = (int)lo.z; wf[n][3] = (int)lo.w; wf[n][4] = (int)hi.x; wf[n][5] = (int)hi.y; wf[n][6] = (int)hi.z; wf[n][7] = (int)hi.w;
        }
#pragma unroll
        for (int m = 0; m < 4; ++m)
#pragma unroll
            for (int n = 0; n < 4; ++n) acc[m][n] = __builtin_amdgcn_mfma_scale_f32_16x16x128_f8f6f4(wf[n], xf[m], acc[m][n], 0, 0, 0, 0, 0, 0);
        asm volatile("s_waitcnt vmcnt(0)" ::: "memory");
        __syncthreads();
    }
}

DI bool tile_of(int k, int NT, int MT, int& mt, int& nt) {
    const int G = gridDim.x, bid = blockIdx.x;
    if (((G | MT) & 7) == 0) {
        const int idx = (bid >> 3) + k * (G >> 3);
        if (idx >= (MT >> 3) * NT) return false;
        mt = (idx / NT) * 8 + (bid & 7); nt = idx % NT;
    } else {
        const int t = bid + k * G;
        if (t >= MT * NT) return false;
        mt = t / NT; nt = t % NT;
    }
    return true;
}

DI void p0_prep(const Params& p, unsigned char* lds) {
    const int tid = threadIdx.x, nb = gridDim.x, bid = blockIdx.x;
    const size_t gtid = (size_t)bid * NTHREADS + tid, gsz = (size_t)nb * NTHREADS;
    unsigned char* ws = p.ws;
    constexpr int W_ITEMS = (P1_F8_COLS / 64) * 4 + ((NMIX_PAD - P1_F8_COLS) / 64) * 16;
    const int nwb = nb >= 8 ? (nb / 2 < W_ITEMS ? nb / 2 : W_ITEMS) : nb, nxb = nb >= 8 ? nb - nwb : nb;
    const bool xrole = nb < 8 || bid < nxb, wrole = nb < 8 || bid >= nxb;
    const int wbid = nb >= 8 ? bid - nxb : bid;
    {
        float* ct = (float*)(ws + WS_ROPE); float* stb = ct + SEQ * 32;
        for (size_t i = gtid; i < (size_t)SEQ * 32; i += gsz) {
            const int pos = (int)(i >> 5), fi = (int)(i & 31);
            const float inv = powf(10000.0f, -(float)(2 * fi) / 64.0f);
            const float ang = (float)pos * inv;
            ct[i] = cosf(ang); stb[i] = sinf(ang);
        }
    }
    auto conv = [&](const float* src, bf16_t* dst, size_t n) {
        for (size_t i = gtid * 8; i < n; i += gsz * 8) {
            const f32x4 a = *(const f32x4*)(src + i), b = *(const f32x4*)(src + i + 4);
            u32x4 o; o.x = pack_bf16(a.x, a.y); o.y = pack_bf16(a.z, a.w); o.z = pack_bf16(b.x, b.y); o.w = pack_bf16(b.z, b.w);
            *(u32x4*)(dst + i) = o;
        }
    };
    {
        float m = 0.f;
        for (size_t i = gtid * 4; i < (size_t)1024 * 1024; i += gsz * 4) { const f32x4 v = *(const f32x4*)(p.w_o + i); m = fmaxf(m, fmaxf(fmaxf(fabsf(v[0]), fabsf(v[1])), fmaxf(fabsf(v[2]), fabsf(v[3])))); }
#pragma unroll
        for (int o = 32; o >= 1; o >>= 1) m = fmaxf(m, __shfl_xor(m, o));
        if ((tid & 63) == 0 && m > 0.f) atomicMax((unsigned*)(ws + WS_AMAX), __float_as_uint(m));
    }
    if (xrole) {
        const int lane = tid & 63, gw = bid * 4 + (tid >> 6), nw = nxb * 4;
        bf16_t* XBo = (bf16_t*)(ws + WS_XB); unsigned char* X8o = ws + WS_X8; float* SXRo = (float*)(ws + WS_SXR);
        for (int row0 = gw * 4; row0 < NTOK; row0 += nw * 4) {
            f32x4 v[4][4];
#pragma unroll
            for (int r = 0; r < 4; ++r)
#pragma unroll
                for (int i = 0; i < 4; ++i) v[r][i] = *(const f32x4*)(p.x + (size_t)(row0 + r) * 1024 + lane * 16 + 4 * i);
#pragma unroll
            for (int r = 0; r < 4; ++r) {
                const int row = row0 + r;
                float m = 0.f;
#pragma unroll
                for (int i = 0; i < 4; ++i) m = fmaxf(m, fmaxf(fmaxf(fabsf(v[r][i][0]), fabsf(v[r][i][1])), fmaxf(fabsf(v[r][i][2]), fabsf(v[r][i][3]))));
#pragma unroll
                for (int o = 32; o >= 1; o >>= 1) m = fmaxf(m, __shfl_xor(m, o));
                const float sc = m > 0.f ? 439.f / m : 1.f;
                u32x4 o0, o1, q8;
                o0.x = pack_bf16(v[r][0][0], v[r][0][1]); o0.y = pack_bf16(v[r][0][2], v[r][0][3]); o0.z = pack_bf16(v[r][1][0], v[r][1][1]); o0.w = pack_bf16(v[r][1][2], v[r][1][3]);
                o1.x = pack_bf16(v[r][2][0], v[r][2][1]); o1.y = pack_bf16(v[r][2][2], v[r][2][3]); o1.z = pack_bf16(v[r][3][0], v[r][3][1]); o1.w = pack_bf16(v[r][3][2], v[r][3][3]);
#pragma unroll
                for (int i = 0; i < 4; ++i) {
                    int pk = __builtin_amdgcn_cvt_pk_fp8_f32(v[r][i][0] * sc, v[r][i][1] * sc, 0, false);
                    pk = __builtin_amdgcn_cvt_pk_fp8_f32(v[r][i][2] * sc, v[r][i][3] * sc, pk, true);
                    q8[i] = (unsigned)pk;
                }
                *(u32x4*)(XBo + (size_t)row * 1024 + lane * 16) = o0; *(u32x4*)(XBo + (size_t)row * 1024 + lane * 16 + 8) = o1;
                *(u32x4*)(X8o + (size_t)row * 1024 + lane * 16) = q8;
                if (lane == 0) SXRo[row] = m > 0.f ? m * (1.f / 439.f) : 1.f;
            }
        }
    }
    conv(p.peer_subkeys, (bf16_t*)(ws + WS_SK), (size_t)8 * 2 * 128 * 128);
    float* tl = (float*)lds;
    auto transp = [&](const float* src, bf16_t* dst, int N, int Npad, int nt0) {
        const int tn = Npad / 64 - nt0, tk = 1024 / 64;
        for (int t = wbid - (P1_F8_COLS / 64) * 4; t < tn * tk; t += nwb) {
            if (t < 0) continue;
            const int n0 = (nt0 + t % tn) * 64, k0 = (t / tn) * 64;
            __syncthreads();
            for (int e = tid; e < 4096; e += NTHREADS) { const int kk = e >> 6, nn = e & 63; tl[kk * 65 + nn] = (n0 + nn < N) ? src[(size_t)(k0 + kk) * N + n0 + nn] : 0.f; }
            __syncthreads();
            for (int e = tid; e < 4096; e += NTHREADS) { const int nn = e >> 6, kk = e & 63; dst[(size_t)(n0 + nn) * 1024 + k0 + kk] = (bf16_t)f2bf(tl[kk * 65 + nn]); }
        }
    };
    if (wrole) transp(p.w_in, (bf16_t*)(ws + WS_WINT), NMIX, NMIX_PAD, P1_F8_COLS / 64);
    if (wrole) {
        unsigned char* w8 = ws + WS_WINT; float* swn = (float*)(ws + WS_SWN);
        float* cm = (float*)lds + 64 * 65;
        for (int item = wbid; item < (P1_F8_COLS / 64) * 4; item += nwb) {
            const int n0 = (item >> 2) * 64, kpart = item & 3;
            {
                const int n4 = (tid & 15) * 4, kq = tid >> 4;
                f32x4 m4 = {0.f, 0.f, 0.f, 0.f};
#pragma unroll 8
                for (int k2 = kq; k2 < 1024; k2 += 16) {
                    const f32x4 v = *(const f32x4*)(p.w_in + (size_t)k2 * NMIX + n0 + n4);
                    m4[0] = fmaxf(m4[0], fabsf(v[0])); m4[1] = fmaxf(m4[1], fabsf(v[1])); m4[2] = fmaxf(m4[2], fabsf(v[2])); m4[3] = fmaxf(m4[3], fabsf(v[3]));
                }
                __syncthreads();
                *(f32x4*)(cm + kq * 64 + n4) = m4;
                __syncthreads();
                if (tid < 64) {
                    float a = 0.f;
#pragma unroll
                    for (int r = 0; r < 16; ++r) a = fmaxf(a, cm[r * 64 + tid]);
                    cm[1024 + tid] = a > 0.f ? 439.f / a : 1.f;
                    if (kpart == 0) swn[n0 + tid] = a > 0.f ? a * (1.f / 439.f) : 1.f;
                }
            }
            for (int k0 = kpart * 256; k0 < kpart * 256 + 256; k0 += 64) {
                __syncthreads();
                for (int e = tid; e < 4096; e += NTHREADS) { const int kk = e >> 6, n2 = e & 63; tl[kk * 65 + n2] = p.w_in[(size_t)(k0 + kk) * NMIX + n0 + n2]; }
                __syncthreads();
                for (int e = tid; e < 1024; e += NTHREADS) {
                    const int n2 = e >> 4, kq4 = (e & 15) * 4; const float sc = cm[1024 + n2];
                    int pk = __builtin_amdgcn_cvt_pk_fp8_f32(tl[kq4 * 65 + n2] * sc, tl[(kq4 + 1) * 65 + n2] * sc, 0, false);
                    pk = __builtin_amdgcn_cvt_pk_fp8_f32(tl[(kq4 + 2) * 65 + n2] * sc, tl[(kq4 + 3) * 65 + n2] * sc, pk, true);
                    *(int*)(w8 + (size_t)(n0 + n2) * 1024 + k0 + kq4) = pk;
                }
            }
        }
    }
}

DI void p0_late(const Params& p, unsigned char* lds) {
    const int tid = threadIdx.x, nb = gridDim.x, bid = blockIdx.x;
    unsigned char* ws = p.ws;
    {
        const int lane = tid & 63, gw = bid * 4 + (tid >> 6), nw = nb * 4;
        for (int row0 = gw * 4; row0 < 2 * 16384; row0 += nw * 4) {
            f32x4 v[4][4];
#pragma unroll
            for (int r = 0; r < 4; ++r) {
                const int row = row0 + r; const bool isv = row >= 16384; const int e = isv ? row - 16384 : row;
                const float* src = (isv ? p.peer_v : p.peer_u) + (size_t)e * 1024 + lane * 16;
#pragma unroll
                for (int i = 0; i < 4; ++i) v[r][i] = *(const f32x4*)(src + 4 * i);
            }
#pragma unroll
            for (int r = 0; r < 4; ++r) {
                const int row = row0 + r; const bool isv = row >= 16384; const int e = isv ? row - 16384 : row;
                float mx = 0.f;
#pragma unroll
                for (int i = 0; i < 4; ++i) mx = fmaxf(mx, fmaxf(fmaxf(fabsf(v[r][i][0]), fabsf(v[r][i][1])), fmaxf(fabsf(v[r][i][2]), fabsf(v[r][i][3]))));
#pragma unroll
                for (int o = 32; o >= 1; o >>= 1) mx = fmaxf(mx, __shfl_xor(mx, o));
                const float sc = mx > 0.f ? mx * (1.0f / 5.99f) : 1.0f, inv = mx > 0.f ? 5.99f / mx : 1.0f;
                u32x2 o2;
#pragma unroll
                for (int k = 0; k < 2; ++k) {
                    unsigned w = 0;
                    w = __builtin_amdgcn_cvt_scalef32_pk_fp4_f32(w, v[r][2 * k][0] * inv, v[r][2 * k][1] * inv, 1.0f, 0);
                    w = __builtin_amdgcn_cvt_scalef32_pk_fp4_f32(w, v[r][2 * k][2] * inv, v[r][2 * k][3] * inv, 1.0f, 1);
                    w = __builtin_amdgcn_cvt_scalef32_pk_fp4_f32(w, v[r][2 * k + 1][0] * inv, v[r][2 * k + 1][1] * inv, 1.0f, 2);
                    w = __builtin_amdgcn_cvt_scalef32_pk_fp4_f32(w, v[r][2 * k + 1][2] * inv, v[r][2 * k + 1][3] * inv, 1.0f, 3);
                    o2[k] = w;
                }
                *(u32x2*)(ws + (isv ? WS_VT : WS_UT) + (size_t)e * 512 + lane * 8) = o2;
                if (lane == 0) ((float*)(ws + (isv ? WS_SV : WS_SU)))[e] = sc;
            }
        }
    }
    float* tl = (float*)lds;
    auto transp = [&](const float* src, bf16_t* dst, int N, int Npad) {
        const int tn = Npad / 64, tk = 1024 / 64;
        for (int t = bid; t < tn * tk; t += nb) {
            const int n0 = (t % tn) * 64, k0 = (t / tn) * 64;
            __syncthreads();
            for (int e = tid; e < 4096; e += NTHREADS) { const int kk = e >> 6, nn = e & 63; tl[kk * 65 + nn] = (n0 + nn < N) ? src[(size_t)(k0 + kk) * N + n0 + nn] : 0.f; }
            __syncthreads();
            for (int e = tid; e < 4096; e += NTHREADS) { const int nn = e >> 6, kk = e & 63; dst[(size_t)(n0 + nn) * 1024 + k0 + kk] = (bf16_t)f2bf(tl[kk * 65 + nn]); }
        }
    };
    {
        const float amax = __uint_as_float(*(const unsigned*)(ws + WS_AMAX)), sw = amax > 0.f ? 439.f / amax : 1.f;
        unsigned char* dst8 = ws + WS_WOT;
        for (int t = bid; t < 16 * 16; t += nb) {
            const int n0 = (t % 16) * 64, k0 = (t / 16) * 64;
            __syncthreads();
            for (int e = tid; e < 4096; e += NTHREADS) { const int kk = e >> 6, nn = e & 63; tl[kk * 65 + nn] = p.w_o[(size_t)(k0 + kk) * 1024 + n0 + nn]; }
            __syncthreads();
            for (int e = tid; e < 1024; e += NTHREADS) {
                const int nn = e >> 4, kq = (e & 15) * 4;
                int pk = __builtin_amdgcn_cvt_pk_fp8_f32(tl[kq * 65 + nn] * sw, tl[(kq + 1) * 65 + nn] * sw, 0, false);
                pk = __builtin_amdgcn_cvt_pk_fp8_f32(tl[(kq + 2) * 65 + nn] * sw, tl[(kq + 3) * 65 + nn] * sw, pk, true);
                *(int*)(dst8 + (size_t)(n0 + nn) * 1024 + k0 + kq) = pk;
            }
        }
    }
    transp(p.peer_wq, (bf16_t*)(ws + WS_WQT), PEER_N, PEER_N);
}

DI void p1_inproj(const Params& p, unsigned char* lds) {
    unsigned char* ws = p.ws;
    const bf16_t* XB = (const bf16_t*)(ws + WS_XB); const bf16_t* WT = (const bf16_t*)(ws + WS_WINT);
    const float* cosT = (const float*)(ws + WS_ROPE); const float* sinT = cosT + SEQ * 32;
    const int tid = threadIdx.x, lane = tid & 63, wave = tid >> 6, wm = wave >> 1, wn = wave & 1, c = lane & 15, g = lane >> 4;
    constexpr int NT = NMIX_PAD / 128, MT = NTOK / 128;
    int mt, nt;
    for (int k = 0; tile_of(k, NT, MT, mt, nt); ++k) {
        f32x4 acc[4][4];
        const bool f8 = nt < P1_F8_COLS / 128;
        if (f8) gemm8_128x128(ws + WS_X8 + (size_t)mt * 128 * 1024, 1024, ws + WS_WINT + (size_t)nt * 128 * 1024, 1024, 1024, lds, acc);
        else gemm_128x128(XB + (size_t)mt * 128 * 1024, 1024, WT + (size_t)nt * 128 * 1024, 1024, 1024, lds, acc);
        f32x4 swn4[4];
#pragma unroll
        for (int n = 0; n < 4; ++n) swn4[n] = f8 ? *(const f32x4*)((const float*)(ws + WS_SWN) + nt * 128 + wn * 64 + 16 * n + 4 * g) : (f32x4){1.f, 1.f, 1.f, 1.f};
        const int col64 = nt * 2 + wn;
        bf16_t* dst; int ld, coff; bool rope = true; float scale = 1.f; float vmax = 0.f;
        if (col64 < 8)       { dst = (bf16_t*)(ws + WS_QA); ld = 512; coff = col64 * 64; scale = 0.125f; }
        else if (col64 < 10) { dst = (bf16_t*)(ws + WS_KA); ld = 128; coff = (col64 - 8) * 64; }
        else if (col64 < 12) { dst = (bf16_t*)(ws + WS_VA); ld = 128; coff = (col64 - 10) * 64; rope = false; }
        else if (col64 < 20) { dst = (bf16_t*)(ws + WS_QB); ld = 512; coff = (col64 - 12) * 64; scale = 0.125f; }
        else if (col64 == 20) { dst = (bf16_t*)(ws + WS_KB); ld = 64; coff = 0; }
        else if (col64 == 21) { dst = (bf16_t*)(ws + WS_VB); ld = 64; coff = 0; rope = false; }
        else if (col64 < 26) { dst = (bf16_t*)(ws + WS_QI); ld = 256; coff = (col64 - 22) * 64; }
        else                 { dst = (bf16_t*)(ws + WS_KI); ld = 64; coff = 0; }
        if (col64 == 27) {
            if (g == 0) {
#pragma unroll
                for (int m = 0; m < 4; ++m) { const int tok = mt * 128 + wm * 64 + m * 16 + c; *(f32x4*)((float*)(ws + WS_WI) + (size_t)tok * 4) = acc[m][0] * 0.0625f; }
            }
            continue;
        }
#pragma unroll
        for (int m = 0; m < 4; ++m) {
            const int tok = mt * 128 + wm * 64 + m * 16 + c, pos = tok & (SEQ - 1);
            const float sxr = f8 ? ((const float*)(ws + WS_SXR))[tok] : 1.f;
            f32x4 v[4] = {acc[m][0] * (swn4[0] * sxr), acc[m][1] * (swn4[1] * sxr), acc[m][2] * (swn4[2] * sxr), acc[m][3] * (swn4[3] * sxr)};
            if (col64 == 26) {
                float s = 0.f;
#pragma unroll
                for (int n = 0; n < 4; ++n) s += (v[n][0] + v[n][1]) + (v[n][2] + v[n][3]);
                s += __shfl_xor(s, 16); s += __shfl_xor(s, 32);
                const float mu = s * (1.f / 64.f); float q = 0.f;
#pragma unroll
                for (int n = 0; n < 4; ++n) { const f32x4 d = v[n] - mu; q += (d[0] * d[0] + d[1] * d[1]) + (d[2] * d[2] + d[3] * d[3]); }
                q += __shfl_xor(q, 16); q += __shfl_xor(q, 32);
                const float rstd = rsqrtf(q * (1.f / 64.f) + LN_EPS);
#pragma unroll
                for (int n = 0; n < 4; ++n) {
                    const f32x4 gg = *(const f32x4*)(p.idx_k_g + 16 * n + 4 * g), bb = *(const f32x4*)(p.idx_k_b + 16 * n + 4 * g);
                    v[n] = (v[n] - mu) * rstd * gg + bb;
                }
            }
            if (rope) {
#pragma unroll
                for (int n = 0; n < 2; ++n) {
                    const f32x4 cs = *(const f32x4*)(cosT + pos * 32 + 16 * n + 4 * g), sn = *(const f32x4*)(sinT + pos * 32 + 16 * n + 4 * g);
                    const f32x4 t1 = v[n], t2 = v[n + 2];
                    v[n] = t1 * cs - t2 * sn; v[n + 2] = t2 * cs + t1 * sn;
                }
            }
#pragma unroll
            for (int n = 0; n < 4; ++n) {
                const f32x4 o = v[n] * scale; u32x2 w; w.x = pack_bf16(o[0], o[1]); w.y = pack_bf16(o[2], o[3]);
                *(u32x2*)(dst + (size_t)tok * ld + coff + 16 * n + 4 * g) = w;
                if (!rope) vmax = fmaxf(vmax, fmaxf(fmaxf(fabsf(o[0]), fabsf(o[1])), fmaxf(fabsf(o[2]), fabsf(o[3]))));
            }
        }
        if (!rope) {
#pragma unroll
            for (int o = 32; o >= 1; o >>= 1) vmax = fmaxf(vmax, __shfl_xor(vmax, o));
            if (lane == 0 && vmax > 0.f) atomicMax((unsigned*)(ws + WS_AMAX) + 1, __float_as_uint(vmax));
        }
    }
}

constexpr int NDSA = NTOK / 4, NSWA = BATCH * 32 * 8;
constexpr int P2_STG = 0  , P2_LIST = 32768;

DI unsigned f16_key(float v) {
    _Float16 hv = (_Float16)v; unsigned short hb = __builtin_bit_cast(unsigned short, hv); unsigned b = hb;
    if (b == 0x8000u) b = 0u;
    return (b & 0x8000u) ? ((~b) & 0xffffu) : (b | 0x8000u);
}

DI size_t sc_row_off(int t) { const size_t m = (size_t)(t >> 3); return 8 * (4 * m * (m + 1) + (size_t)(t & 7) * (m + 1)); }
constexpr size_t SC_BATCH = 8404992;
DI unsigned short* sc_batch_base(const Params& p, int b) { return (b < 7) ? (unsigned short*)p.out + (size_t)b * SC_BATCH : (unsigned short*)(p.ws + WS_PG); }

DI void p2a_indexer(const Params& p, unsigned char* lds) {
    unsigned char* ws = p.ws;
    const bf16_t* QI = (const bf16_t*)(ws + WS_QI); const bf16_t* KI = (const bf16_t*)(ws + WS_KI); const float* WI = (const float*)(ws + WS_WI);
    const int G = gridDim.x, bi = blockIdx.x;
    for (int it = 0; it < 2; ++it) {
        const int item = (it == 0) ? bi : 1023 - bi;
        for (int id = (G == 512) ? item : bi + it * G; id < 1024; id += (G == 512) ? 1024 : 2 * G) {
            int tid = threadIdx.x; asm volatile("" : "+v"(tid));
            const int lane = tid & 63, wave = tid >> 6, c = lane & 15, g = lane >> 4, lrow = tid >> 3, lch = tid & 7;
            const int b = id >> 7, t0 = (id & 127) * 32, tokw = b * SEQ + t0 + 8 * wave;
            unsigned short* scb = sc_batch_base(p, b);
            bf16x8 af[2][2]; f32x4 wv[2];
#pragma unroll
            for (int rt = 0; rt < 2; ++rt) {
#pragma unroll
                for (int s2 = 0; s2 < 2; ++s2) af[rt][s2] = as_bf16x8(ldg16(QI + (size_t)(tokw + 4 * rt + (c >> 2)) * 256 + (c & 3) * 64 + 32 * s2 + 8 * g));
                wv[rt] = *(const f32x4*)(WI + (size_t)(tokw + 4 * rt + g) * 4);
            }
            asm volatile("" :: "v"(af[0][0]), "v"(af[0][1]), "v"(af[1][0]), "v"(af[1][1]), "v"(wv[0]), "v"(wv[1]));
            const int nkt = ((t0 + 31) >> 7) + 1;
            const unsigned char* kib = (const unsigned char*)(KI + (size_t)b * SEQ * 64);
            unsigned char* dst0 = lds + tid * 16;
            auto stage = [&](int kt, int buf) {
#pragma unroll
                for (int i = 0; i < 4; ++i) {
                    const int row = lrow + 32 * i;
                    glds16(kib + (size_t)(kt * 128 + row) * 128 + ((lch ^ ((row >> 3) & 7)) << 4), dst0 + buf * 16384 + i * 4096);
                }
            };
            __syncthreads();
            stage(0, 0); if (nkt > 1) stage(1, 1);
            for (int kt = 0; kt < nkt; ++kt) {
                if (kt + 1 < nkt) asm volatile("s_waitcnt vmcnt(4)" ::: "memory");
                else asm volatile("s_waitcnt vmcnt(0)" ::: "memory");
                asm volatile("s_waitcnt lgkmcnt(0)" ::: "memory");
                __builtin_amdgcn_s_barrier();
                if (kt + 2 < nkt) stage(kt + 2, (kt + 2) % 3);
                const unsigned char* Ks = lds + (kt % 3) * 16384;
                unsigned res[2][4];
#pragma unroll
                for (int ct = 0; ct < 8; ++ct) {
                    const int row = 8 * c + ct;
                    const bf16x8 k0 = as_bf16x8(*(const u32x4*)(Ks + row * 128 + ((g ^ (c & 7)) << 4)));
                    const bf16x8 k1 = as_bf16x8(*(const u32x4*)(Ks + row * 128 + (((4 + g) ^ (c & 7)) << 4)));
#pragma unroll
                    for (int rt = 0; rt < 2; ++rt) {
                        f32x4 d = mfma16(af[rt][0], k0, (f32x4){0.f, 0.f, 0.f, 0.f});
                        d = mfma16(af[rt][1], k1, d);
                        const float sv = wv[rt][0] * fmaxf(d[0], 0.f) + wv[rt][1] * fmaxf(d[1], 0.f) + wv[rt][2] * fmaxf(d[2], 0.f) + wv[rt][3] * fmaxf(d[3], 0.f);
                        const int key = kt * 128 + row, tq = t0 + 8 * wave + 4 * rt + g;
                        const unsigned kv = (key <= tq) ? f16_key(sv) : 0u;
                        if (ct & 1) res[rt][ct >> 1] |= kv << 16; else res[rt][ct >> 1] = kv;
                    }
                }
#pragma unroll
                for (int rt = 0; rt < 2; ++rt) {
                    const int tq = t0 + 8 * wave + 4 * rt + g;
                    if (16 * kt + c <= (tq >> 3)) {
                        u32x4 w; w.x = res[rt][0]; w.y = res[rt][1]; w.z = res[rt][2]; w.w = res[rt][3];
                        *(u32x4*)(scb + sc_row_off(tq) + kt * 128 + 8 * c) = w;
                    }
                }
            }
        }
    }
    __syncthreads();
    p0_late(p, lds);
}

template <int MODE> DI void p2_dsa_item(const Params& p, unsigned char* lds, int b, int tb) {
    unsigned char* ws = p.ws;
    const bf16_t* QI = (const bf16_t*)(ws + WS_QI); const bf16_t* KI = (const bf16_t*)(ws + WS_KI); const float* WI = (const float*)(ws + WS_WI);
    const bf16_t* QB = (const bf16_t*)(ws + WS_QB); const bf16_t* KB = (const bf16_t*)(ws + WS_KB); const bf16_t* VB = (const bf16_t*)(ws + WS_VB);
    unsigned char* ATT8 = ws + WS_ATT;
    const float sa8 = 439.f / fmaxf(__uint_as_float(*(const unsigned*)(ws + WS_AMAX + 4)), 1e-30f);
    int tid = threadIdx.x; asm volatile("" : "+v"(tid));
    const int lane = tid & 63, wave = __builtin_amdgcn_readfirstlane(tid >> 6), c = lane & 15, g = lane >> 4;
    const int t0 = tb * 4, tok0 = b * SEQ + t0;
    unsigned char* stg = lds + P2_STG + wave * 8192;
    unsigned* hist = (unsigned*)stg;
    unsigned short* list = (unsigned short*)(lds + P2_LIST) + wave * 256;
    const int tok = tok0 + wave;
    if (!(MODE & 2)) return;
    const int n = t0 + wave + 1;
    const int L = n < 256 ? n : 256;
    const unsigned short* myk = sc_batch_base(p, b) + sc_row_off(t0 + wave);
    if (n <= 256) {
        for (int i = lane; i < n; i += 64) list[i] = (unsigned short)i;
    } else {
        u32x4 kk[8];
#pragma unroll
        for (int i = 0; i < 8; ++i) kk[i] = (512 * i + 8 * lane < n) ? ldg16(myk + 512 * i + 8 * lane) : (u32x4){0u, 0u, 0u, 0u};
#pragma unroll
        for (int i = 0; i < 4; ++i) *(u32x4*)(hist + lane * 16 + i * 4) = (u32x4){0u, 0u, 0u, 0u};
#pragma unroll
        for (int i = 0; i < 8; ++i) {
            if (512 * i < n) {
#pragma unroll
                for (int w = 0; w < 4; ++w) { const unsigned wd = kk[i][w]; atomicAdd(&hist[(wd & 0xffffu) >> 6], 1u); atomicAdd(&hist[wd >> 22], 1u); }
            }
        }
        unsigned h[16];
#pragma unroll
        for (int i = 0; i < 4; ++i) { const u32x4 t = *(const u32x4*)(hist + lane * 16 + i * 4); h[4 * i] = t.x; h[4 * i + 1] = t.y; h[4 * i + 2] = t.z; h[4 * i + 3] = t.w; }
#pragma unroll
        for (int i = 0; i < 4; ++i) *(u32x4*)(hist + lane * 16 + i * 4) = (u32x4){0u, 0u, 0u, 0u};
        unsigned sl = 0;
#pragma unroll
        for (int i = 0; i < 16; ++i) sl += h[i];
        unsigned pre = sl;
#pragma unroll
        for (int o = 1; o < 64; o <<= 1) { const unsigned t = __shfl_up(pre, o); if (lane >= o) pre += t; }
        const unsigned tot = __shfl(pre, 63);
        const unsigned suf = tot - pre;
        int found = -1; unsigned cab = 0, cum = suf;
#pragma unroll
        for (int j = 15; j >= 0; --j) { const bool hit = (found < 0) && (cum + h[j] >= 256u); if (hit) { found = lane * 16 + j; cab = cum; } cum += h[j]; }
        const bool mine = (suf < 256u) && (suf + sl >= 256u);
        const unsigned long long mm = __ballot(mine);
        const int src = __ffsll((long long)mm) - 1;
        const unsigned bstar = (unsigned)__shfl(found, src), cabove = __shfl(cab, src);
        const unsigned r1 = 256u - cabove;
#pragma unroll
        for (int i = 0; i < 8; ++i) {
            if (512 * i < n) {
#pragma unroll
                for (int w = 0; w < 4; ++w) {
                    const unsigned wd = kk[i][w];
                    if (((wd & 0xffffu) >> 6) == bstar) atomicAdd(&hist[wd & 63u], 1u);
                    if ((wd >> 22) == bstar) atomicAdd(&hist[(wd >> 16) & 63u], 1u);
                }
            }
        }
        const unsigned cnt = hist[lane];
        hist[lane] = 0u;
        unsigned pre2 = cnt;
#pragma unroll
        for (int o = 1; o < 64; o <<= 1) { const unsigned t = __shfl_up(pre2, o); if (lane >= o) pre2 += t; }
        const unsigned tot2 = __shfl(pre2, 63);
        const unsigned suf2 = tot2 - pre2;
        const bool mine2 = (suf2 < r1) && (suf2 + cnt >= r1);
        const unsigned long long mm2 = __ballot(mine2);
        const int src2 = __ffsll((long long)mm2) - 1;
        const unsigned T = (bstar << 6) | (unsigned)src2;
        const unsigned req = r1 - __shfl(suf2, src2);
        const unsigned toteq = __shfl(cnt, src2);
        const bool alleq = (req == toteq);
        const unsigned Tt = alleq ? T : T + 1u;
        unsigned cg = 0;
#pragma unroll
        for (int i = 0; i < 8; ++i)
#pragma unroll
            for (int w = 0; w < 4; ++w) { const unsigned wd = kk[i][w]; cg += ((wd & 0xffffu) >= Tt) ? 1u : 0u; cg += ((wd >> 16) >= Tt) ? 1u : 0u; }
        unsigned pre3 = cg;
#pragma unroll
        for (int o = 1; o < 64; o <<= 1) { const unsigned t = __shfl_up(pre3, o); if (lane >= o) pre3 += t; }
        unsigned off = pre3 - cg;
#pragma unroll
        for (int i = 0; i < 8; ++i)
#pragma unroll
            for (int w = 0; w < 4; ++w) {
                const unsigned wd = kk[i][w]; const int idx = 512 * i + 8 * lane + 2 * w;
                if ((wd & 0xffffu) >= Tt) { list[off & 255u] = (unsigned short)idx; ++off; }
                if ((wd >> 16) >= Tt) { list[off & 255u] = (unsigned short)(idx + 1); ++off; }
            }
        if (!alleq) {
            const unsigned cgt = 256u - req; unsigned eq_run = 0;
            for (int base = 0; base < n; base += 64) {
                const int i = base + lane; const unsigned m = (i < n) ? myk[i] : 0u;
                const bool eq = (m == T);
                const unsigned long long eqm = __ballot(eq);
                const unsigned rank = eq_run + __builtin_amdgcn_mbcnt_hi((unsigned)(eqm >> 32), __builtin_amdgcn_mbcnt_lo((unsigned)eqm, 0u));
                if (eq && rank < req) list[cgt + rank] = (unsigned short)i;
                eq_run += (unsigned)__popcll(eqm);
            }
        }
    }
    if (!(MODE & 4)) return;
    bf16x8 qf[2], sel[2];
#pragma unroll
    for (int s = 0; s < 2; ++s) {
        u32x4 t = (u32x4){0u, 0u, 0u, 0u};
        if (c < 8) t = ldg16(QB + (size_t)tok * 512 + c * 64 + 32 * s + 8 * g);
        qf[s] = as_bf16x8(t);
#pragma unroll
        for (int j = 0; j < 8; ++j) sel[s][j] = (8 * g + j == 16 * s + c) ? (short)0x3F80 : (short)0;
    }
    f32x4 st[16];
    const unsigned char* kbb = (const unsigned char*)(KB + (size_t)b * SEQ * 64); const unsigned char* vbb = (const unsigned char*)(VB + (size_t)b * SEQ * 64);
    const int lr = lane >> 3, lc = lane & 7;
    const unsigned st_off = lr * 128 + ((lc ^ lr) << 4);
    auto loadg = [&](const unsigned char* base, int T0, u32x4 (&dst)[8]) {
#pragma unroll
        for (int i = 0; i < 8; ++i) {
            const int idx = T0 * 16 + i * 8 + lr; const unsigned kid = (idx < L) ? (unsigned)list[idx] : 0u;
            dst[i] = ldg16(base + kid * 128u + lc * 16u);
        }
    };
    auto stage = [&](const u32x4 (&src)[8]) {
#pragma unroll
        for (int i = 0; i < 8; ++i) *(u32x4*)(stg + i * 1024 + st_off) = src[i];
    };
    auto frag = [&](int u, int s2) -> bf16x8 { return as_bf16x8(*(const u32x4*)(stg + (16 * u + c) * 128 + (((4 * s2 + g) ^ (c & 7)) << 4))); };
    auto scoreK = [&](int T0) {
#pragma unroll
        for (int T = 0; T < 4; ++T) {
            f32x4 d = mfma16(frag(T, 0), qf[0], (f32x4){0.f, 0.f, 0.f, 0.f});
            st[T0 + T] = mfma16(frag(T, 1), qf[1], d);
        }
    };
    u32x4 rA[8], rB[8], rC[8], rD[8];
    loadg(kbb, 0, rA); loadg(kbb, 4, rB); loadg(kbb, 8, rC); loadg(kbb, 12, rD);
    __builtin_amdgcn_sched_barrier(0);
    stage(rA); scoreK(0);
    stage(rB); scoreK(4);
    __builtin_amdgcn_sched_barrier(0);
    loadg(vbb, 0, rA); loadg(vbb, 4, rB);
    stage(rC); scoreK(8);
    stage(rD); scoreK(12);
    __builtin_amdgcn_sched_barrier(0);
    float mx = -3.0e38f;
    {
        const int lrem = L - 4 * g;
#pragma unroll
        for (int T = 0; T < 16; ++T)
#pragma unroll
            for (int r = 0; r < 4; ++r) { const float sv = (T * 16 + r < lrem) ? st[T][r] : -3.0e38f; st[T][r] = sv; mx = fmaxf(mx, sv); }
    }
    mx = fmaxf(mx, __shfl_xor(mx, 16)); mx = fmaxf(mx, __shfl_xor(mx, 32));
    float lsum = 0.f;
#pragma unroll
    for (int T = 0; T < 16; ++T)
#pragma unroll
        for (int r = 0; r < 4; ++r) { const float e = __expf(st[T][r] - mx); st[T][r] = e; lsum += e; }
    lsum += __shfl_xor(lsum, 16); lsum += __shfl_xor(lsum, 32);
    const float rl = 1.0f / lsum;
    u32x4 pfv[8];
#pragma unroll
    for (int u = 0; u < 8; ++u) {
        const int Ta = 2 * u, Tb = Ta + 1;
        pfv[u].x = pack_bf16(st[Ta][0] * rl, st[Ta][1] * rl); pfv[u].y = pack_bf16(st[Ta][2] * rl, st[Ta][3] * rl);
        pfv[u].z = pack_bf16(st[Tb][0] * rl, st[Tb][1] * rl); pfv[u].w = pack_bf16(st[Tb][2] * rl, st[Tb][3] * rl);
    }
    __builtin_amdgcn_sched_barrier(0);
    f32x4 O[4];
#pragma unroll
    for (int cb = 0; cb < 4; ++cb) O[cb] = (f32x4){0.f, 0.f, 0.f, 0.f};
    auto pv = [&](int T0) {
#pragma unroll
        for (int u = 0; u < 2; ++u) {
            const u32x4 pf = pfv[(T0 >> 1) + u];
#pragma unroll
            for (int cb = 0; cb < 4; ++cb) {
                const f32x4 z = (f32x4){0.f, 0.f, 0.f, 0.f};
                const f32x4 v0 = mfma16(frag(2 * u, cb >> 1), sel[cb & 1], z), v1 = mfma16(frag(2 * u + 1, cb >> 1), sel[cb & 1], z);
                u32x4 vf; vf.x = pack_bf16(v0[0], v0[1]); vf.y = pack_bf16(v0[2], v0[3]); vf.z = pack_bf16(v1[0], v1[1]); vf.w = pack_bf16(v1[2], v1[3]);
                O[cb] = mfma16(as_bf16x8(pf), as_bf16x8(vf), O[cb]);
            }
        }
    };
    loadg(vbb, 8, rC); loadg(vbb, 12, rD);
    __builtin_amdgcn_sched_barrier(0);
    stage(rA); pv(0);
    stage(rB); pv(4);
    __builtin_amdgcn_sched_barrier(0);
    stage(rC); pv(8);
    stage(rD); pv(12);
    if (g < 2) {
#pragma unroll
        for (int cb = 0; cb < 4; ++cb)
#pragma unroll
            for (int r = 0; r < 4; ++r) ATT8[(size_t)tok * 1024 + 512 + (4 * g + r) * 64 + 16 * cb + c] = (unsigned char)__builtin_amdgcn_cvt_pk_fp8_f32(O[cb][r] * sa8, 0.f, 0, false);
    }
}

DI void p2_swa_item(const Params& p, int item2) {
    unsigned char* ws = p.ws;
    const bf16_t* QA = (const bf16_t*)(ws + WS_QA); const bf16_t* KA = (const bf16_t*)(ws + WS_KA); const bf16_t* VA = (const bf16_t*)(ws + WS_VA);
    unsigned char* ATT8 = ws + WS_ATT;
    const float sa8 = 439.f / fmaxf(__uint_as_float(*(const unsigned*)(ws + WS_AMAX + 4)), 1e-30f);
    int tid = threadIdx.x; asm volatile("" : "+v"(tid));
    const int lane = tid & 63, wave = __builtin_amdgcn_readfirstlane(tid >> 6), r = lane & 31, h = lane >> 5;
    const int hq = item2 & 7, blk = (item2 >> 3) & 31, b = item2 >> 8, kvh = hq >> 2;
    const int qi = 32 * wave + r, tokq = b * SEQ + blk * 128 + qi;
    bf16x8 qf[4], sel[2];
#pragma unroll
    for (int s = 0; s < 4; ++s) qf[s] = as_bf16x8(ldg16(QA + (size_t)tokq * 512 + hq * 64 + 16 * s + 8 * h));
#pragma unroll
    for (int x = 0; x < 2; ++x)
#pragma unroll
        for (int j = 0; j < 8; ++j) sel[x][j] = (8 * h + j + 16 * x == r) ? (short)0x3F80 : (short)0;
    const float sink = p.sinks[hq];
    f32x16 ST[5];
#pragma unroll
    for (int ti = 0; ti < 5; ++ti) {
        const int sj = 32 * (wave + ti) + r; int pos = blk * 128 - 128 + sj; pos = pos < 0 ? 0 : pos;
        const bf16_t* kp = KA + (size_t)(b * SEQ + pos) * 128 + kvh * 64 + 8 * h;
        f32x16 d; for (int i = 0; i < 16; ++i) d[i] = 0.f;
#pragma unroll
        for (int s = 0; s < 4; ++s) d = mfma32(as_bf16x8(ldg16(kp + 16 * s)), qf[s], d);
        ST[ti] = d;
    }
    float mx = sink;
    {
        const int lo = r + 1 - 4 * h;
        const int lo0 = (blk > 0) ? lo : (lo > 128 - 32 * wave - 4 * h ? lo : 128 - 32 * wave - 4 * h);
#pragma unroll
        for (int ti = 0; ti < 5; ++ti)
#pragma unroll
            for (int reg = 0; reg < 16; ++reg) {
                const int e = 32 * ti + (reg & 3) + 8 * (reg >> 2);
                const float sv = (e >= lo0 && e < lo + 128) ? ST[ti][reg] : -3.0e38f; ST[ti][reg] = sv; mx = fmaxf(mx, sv);
            }
    }
    mx = fmaxf(mx, __shfl_xor(mx, 32));
    float lsum = 0.f;
#pragma unroll
    for (int ti = 0; ti < 5; ++ti)
#pragma unroll
        for (int reg = 0; reg < 16; ++reg) { const float e = __expf(ST[ti][reg] - mx); ST[ti][reg] = e; lsum += e; }
    lsum += __shfl_xor(lsum, 32);
    lsum += __expf(sink - mx);
    const float rl = 1.0f / lsum;
    f32x16 OT[2];
    for (int i = 0; i < 16; ++i) { OT[0][i] = 0.f; OT[1][i] = 0.f; }
#pragma unroll
    for (int ti = 0; ti < 5; ++ti) {
        const int sj = 32 * (wave + ti) + r; int pos = blk * 128 - 128 + sj; pos = pos < 0 ? 0 : pos;
        const bf16_t* vp = VA + (size_t)(b * SEQ + pos) * 128 + kvh * 64 + 8 * h;
        bf16x8 vf[4];
#pragma unroll
        for (int s = 0; s < 4; ++s) vf[s] = as_bf16x8(ldg16(vp + 16 * s));
        u32x4 pb[2];
#pragma unroll
        for (int s2 = 0; s2 < 2; ++s2) {
            pb[s2].x = pack_bf16(ST[ti][8 * s2 + 0] * rl, ST[ti][8 * s2 + 1] * rl); pb[s2].y = pack_bf16(ST[ti][8 * s2 + 2] * rl, ST[ti][8 * s2 + 3] * rl);
            pb[s2].z = pack_bf16(ST[ti][8 * s2 + 4] * rl, ST[ti][8 * s2 + 5] * rl); pb[s2].w = pack_bf16(ST[ti][8 * s2 + 6] * rl, ST[ti][8 * s2 + 7] * rl);
        }
#pragma unroll
        for (int db = 0; db < 2; ++db) {
            f32x16 vt; for (int i = 0; i < 16; ++i) vt[i] = 0.f;
            vt = mfma32(vf[2 * db], sel[0], vt); vt = mfma32(vf[2 * db + 1], sel[1], vt);
#pragma unroll
            for (int s2 = 0; s2 < 2; ++s2) {
                u32x4 va; va.x = pack_bf16(vt[8 * s2 + 0], vt[8 * s2 + 1]); va.y = pack_bf16(vt[8 * s2 + 2], vt[8 * s2 + 3]);
                va.z = pack_bf16(vt[8 * s2 + 4], vt[8 * s2 + 5]); va.w = pack_bf16(vt[8 * s2 + 6], vt[8 * s2 + 7]);
                OT[db] = mfma32(as_bf16x8(va), as_bf16x8(pb[s2]), OT[db]);
            }
        }
    }
#pragma unroll
    for (int db = 0; db < 2; ++db)
#pragma unroll
        for (int q4 = 0; q4 < 4; ++q4) {
            int pk = __builtin_amdgcn_cvt_pk_fp8_f32(OT[db][4 * q4] * sa8, OT[db][4 * q4 + 1] * sa8, 0, false);
            pk = __builtin_amdgcn_cvt_pk_fp8_f32(OT[db][4 * q4 + 2] * sa8, OT[db][4 * q4 + 3] * sa8, pk, true);
            *(int*)(ATT8 + (size_t)tokq * 1024 + hq * 64 + 32 * db + 8 * q4 + 4 * h) = pk;
        }
}

template <int MODE> DI void p2_attention(const Params& p, unsigned char* lds, int cidx = 0) {
    const int G = gridDim.x, bi = blockIdx.x, rounds = (1024 + G - 1) / G;
    for (int b = 0; b < BATCH; ++b)
        for (int r = 0; r < rounds; ++r) {
            const int idx = (r & 1) ? r * G + (G - 1 - bi) : r * G + bi;
            if (idx < 1024) p2_dsa_item<MODE>(p, lds, b, 1023 - idx);
        }
    if (MODE & 8) for (int item2 = bi; item2 < NSWA; item2 += G) p2_swa_item(p, item2);
}

DI void p3_outproj(const Params& p, unsigned char* lds) {
    unsigned char* ws = p.ws;
    const unsigned char* ATT8 = ws + WS_ATT; const unsigned char* WT8 = ws + WS_WOT;
    const float desc = (fmaxf(__uint_as_float(*(const unsigned*)(ws + WS_AMAX + 4)), 1e-30f) * (1.f / 439.f)) * (fmaxf(__uint_as_float(*(const unsigned*)(ws + WS_AMAX)), 1e-30f) * (1.f / 439.f));
    const int tid = threadIdx.x, lane = tid & 63, wave = tid >> 6, wm = wave >> 1, wn = wave & 1, c = lane & 15, g = lane >> 4;
    constexpr int NT = 8, MT = NTOK / 128;
    int mt, nt;
    for (int k = 0; tile_of(k, NT, MT, mt, nt); ++k) {
        f32x4 acc[4][4];
        gemm8_128x128(ATT8 + (size_t)mt * 128 * 1024, 1024, WT8 + (size_t)nt * 128 * 1024, 1024, 1024, lds, acc);
#pragma unroll
        for (int m = 0; m < 4; ++m) {
            const int tok = mt * 128 + wm * 64 + m * 16 + c;
#pragma unroll
            for (int n = 0; n < 4; ++n) {
                const size_t o = (size_t)tok * 1024 + nt * 128 + wn * 64 + 16 * n + 4 * g;
                const u32x2 xw = *(const u32x2*)((const bf16_t*)(ws + WS_XB) + o);
                const f32x4 xv = {bf_lo(xw.x), bf_hi(xw.x), bf_lo(xw.y), bf_hi(xw.y)};
                const f32x4 hv = xv * ALPHA + acc[m][n] * desc;
                u32x2 w; w.x = pack_bf16(hv[0], hv[1]); w.y = pack_bf16(hv[2], hv[3]);
                *(u32x2*)((bf16_t*)p.out + o) = w;
            }
        }
    }
}

DI void p3b_ln1(const Params& p) {
    bf16_t* H1B = (bf16_t*)(p.ws + WS_XB); const bf16_t* HP = (const bf16_t*)p.out;
    const int lane = threadIdx.x & 63, gw = blockIdx.x * 4 + (threadIdx.x >> 6), nw = gridDim.x * 4;
    for (int row = gw; row < NTOK; row += nw) {
        const u32x4 ra = ldg16(HP + (size_t)row * 1024 + lane * 16), rb = ldg16(HP + (size_t)row * 1024 + lane * 16 + 8);
        float v[16];
        v[0] = bf_lo(ra.x); v[1] = bf_hi(ra.x); v[2] = bf_lo(ra.y); v[3] = bf_hi(ra.y); v[4] = bf_lo(ra.z); v[5] = bf_hi(ra.z); v[6] = bf_lo(ra.w); v[7] = bf_hi(ra.w);
        v[8] = bf_lo(rb.x); v[9] = bf_hi(rb.x); v[10] = bf_lo(rb.y); v[11] = bf_hi(rb.y); v[12] = bf_lo(rb.z); v[13] = bf_hi(rb.z); v[14] = bf_lo(rb.w); v[15] = bf_hi(rb.w);
        float s = 0.f;
#pragma unroll
        for (int i = 0; i < 16; ++i) s += v[i];
        const float mu = wave_sum(s) * (1.f / 1024.f); float q = 0.f;
#pragma unroll
        for (int i = 0; i < 16; ++i) { const float d = v[i] - mu; q = fmaf(d, d, q); }
        const float rstd = rsqrtf(wave_sum(q) * (1.f / 1024.f) + LN_EPS);
        u32x4 oa, ob; float ov[16]; float amax = 0.f;
#pragma unroll
        for (int k4 = 0; k4 < 4; ++k4) {
            const int col = lane * 16 + k4 * 4;
            const f32x4 gg = *(const f32x4*)(p.ln1_g + col), bb = *(const f32x4*)(p.ln1_b + col);
            float o[4];
#pragma unroll
            for (int e = 0; e < 4; ++e) { o[e] = (v[k4 * 4 + e] - mu) * rstd * gg[e] + bb[e]; ov[k4 * 4 + e] = o[e]; amax = fmaxf(amax, fabsf(o[e])); }
            const unsigned w0 = pack_bf16(o[0], o[1]), w1 = pack_bf16(o[2], o[3]);
            if (k4 == 0) { oa.x = w0; oa.y = w1; } else if (k4 == 1) { oa.z = w0; oa.w = w1; } else if (k4 == 2) { ob.x = w0; ob.y = w1; } else { ob.z = w0; ob.w = w1; }
        }
        *(u32x4*)(H1B + (size_t)row * 1024 + lane * 16) = oa; *(u32x4*)(H1B + (size_t)row * 1024 + lane * 16 + 8) = ob;
        {
#pragma unroll
            for (int o2 = 32; o2 >= 1; o2 >>= 1) amax = fmaxf(amax, __shfl_xor(amax, o2));
            const float sx = amax > 0.f ? amax * (1.0f / 440.0f) : 1.0f, inv = amax > 0.f ? 440.0f / amax : 1.0f;
            u32x4 q8;
#pragma unroll
            for (int k4 = 0; k4 < 4; ++k4) {
                int w = 0;
                w = __builtin_amdgcn_cvt_pk_fp8_f32(ov[4 * k4] * inv, ov[4 * k4 + 1] * inv, w, false);
                w = __builtin_amdgcn_cvt_pk_fp8_f32(ov[4 * k4 + 2] * inv, ov[4 * k4 + 3] * inv, w, true);
                q8[k4] = (unsigned)w;
            }
            *(u32x4*)(p.ws + WS_QA + (size_t)row * 1024 + lane * 16) = q8;
            if (lane == 0) ((float*)(p.ws + WS_SX))[row] = sx;
        }
    }
}

DI int f2key(float v) { const int b = __float_as_int(v); return b ^ ((b >> 31) & 0x7fffffff); }
DI float key2f(int k) { return __int_as_float(k ^ ((k >> 31) & 0x7fffffff)); }
DI void ce_desc(int& a, int& b) { const int hi = a > b ? a : b, lo = a > b ? b : a; a = hi; b = lo; }
DI void bitonic_merge16(int (&k)[16]) {
#pragma unroll
    for (int d = 8; d >= 1; d >>= 1)
#pragma unroll
        for (int i = 0; i < 16; ++i) if ((i & d) == 0) ce_desc(k[i], k[i | d]);
}
DI void bitonic_sort16(int (&k)[16]) {
#pragma unroll
    for (int sz = 2; sz <= 16; sz <<= 1) {
#pragma unroll
        for (int i = 0; i < 16; ++i) { const int j = i ^ (sz - 1); if (j > i) ce_desc(k[i], k[j]); }
#pragma unroll
        for (int d = sz >> 2; d >= 1; d >>= 1)
#pragma unroll
            for (int i = 0; i < 16; ++i) if ((i & d) == 0) ce_desc(k[i], k[i | d]);
    }
}
DI void top16_merge(int (&t)[16], const int (&sdesc)[16]) {
#pragma unroll
    for (int i = 0; i < 16; ++i) t[i] = t[i] > sdesc[15 - i] ? t[i] : sdesc[15 - i];
    bitonic_merge16(t);
}
constexpr int P4_QS = 32768, P4_SS_STRIDE = 132, P4_ST0 = 67584  , P4_M = 0  , P4_ST1 = 8704  ;

DI void p4_peer_query(const Params& p, unsigned char* lds) {
    unsigned char* ws = p.ws;
    const bf16_t* H1B = (const bf16_t*)(ws + WS_XB); const bf16_t* WQT = (const bf16_t*)(ws + WS_WQT); const bf16_t* SK = (const bf16_t*)(ws + WS_SK);
    unsigned short* PE = (unsigned short*)(ws + WS_PE); float* PG = (float*)(ws + WS_PG); float* PS = (float*)(ws + WS_PS);
    const float* SU = (const float*)(ws + WS_SU); const float* SV = (const float*)(ws + WS_SV);
    float* Ss = (float*)lds;
    float* st0 = (float*)(lds + P4_ST0); float* mbuf = (float*)(lds + P4_M); float* st1 = (float*)(lds + P4_ST1);
    constexpr int MT = NTOK / 128;
    int mt, head;
    for (int k = 0; tile_of(k, 8, MT, mt, head); ++k) {
        int tid = threadIdx.x; asm volatile("" : "+v"(tid));
        const int lane = tid & 63, wave = tid >> 6, wm = wave >> 1, wn = wave & 1, c = lane & 15, g = lane >> 4;
        const int lrow = tid >> 3, lch = tid & 7;
        const int srow = tid & 127, shalf = tid >> 7;
#pragma unroll 1
        for (int ph = 0; ph < 2; ++ph) {
            f32x4 acc[4][4];
            gemm_128x128(H1B + (size_t)mt * 128 * 1024, 1024, WQT + (size_t)(head * 256 + ph * 128) * 1024, 1024, 1024, lds, acc);
            __syncthreads();
#pragma unroll
            for (int m = 0; m < 4; ++m)
#pragma unroll
                for (int n = 0; n < 4; ++n) {
                    const int row = wm * 64 + m * 16 + c;
                    u32x2 w; w.x = pack_bf16(acc[m][n][0], acc[m][n][1]); w.y = pack_bf16(acc[m][n][2], acc[m][n][3]);
                    *(u32x2*)(lds + P4_QS + wn * 16384 + row * 128 + (((2 * n + (g >> 1)) ^ (row & 7)) << 4) + (g & 1) * 8) = w;
                }
            {
                const bf16_t* sp = SK + (size_t)((head * 2 + ph) * 128 + lrow) * 128 + lch * 8;
#pragma unroll
                for (int k2 = 0; k2 < 2; ++k2)
#pragma unroll
                    for (int i = 0; i < 4; ++i) *(u32x4*)(lds + k2 * 16384 + (lrow + 32 * i) * 128 + ((lch ^ (lrow & 7)) << 4)) = ldg16(sp + (size_t)(32 * i) * 128 + k2 * 64);
            }
            __syncthreads();
            f32x4 a2[4][4];
#pragma unroll
            for (int m = 0; m < 4; ++m)
#pragma unroll
                for (int n = 0; n < 4; ++n) a2[m][n] = (f32x4){0.f, 0.f, 0.f, 0.f};
#pragma unroll
            for (int k2 = 0; k2 < 2; ++k2)
#pragma unroll
                for (int s = 0; s < 2; ++s) {
                    bf16x8 xf[4], wf[4];
#pragma unroll
                    for (int m = 0; m < 4; ++m) { const int row = wm * 64 + m * 16 + c; xf[m] = as_bf16x8(*(const u32x4*)(lds + P4_QS + k2 * 16384 + row * 128 + (((4 * s + g) ^ (c & 7)) << 4))); }
#pragma unroll
                    for (int n = 0; n < 4; ++n) { const int row = wn * 64 + n * 16 + c; wf[n] = as_bf16x8(*(const u32x4*)(lds + k2 * 16384 + row * 128 + (((4 * s + g) ^ (c & 7)) << 4))); }
#pragma unroll
                    for (int m = 0; m < 4; ++m)
#pragma unroll
                        for (int n = 0; n < 4; ++n) a2[m][n] = mfma16(wf[n], xf[m], a2[m][n]);
                }
            __syncthreads();
#pragma unroll
            for (int m = 0; m < 4; ++m)
#pragma unroll
                for (int n = 0; n < 4; ++n) {
                    const int key0 = wn * 64 + 16 * n + 4 * g;
                    u32x4 w;
#pragma unroll
                    for (int r = 0; r < 4; ++r) w[r] = (unsigned)f2key(__uint_as_float((__float_as_uint(a2[m][n][r]) & 0xFFFFFF80u) | (unsigned)(key0 + r)));
                    *(u32x4*)(Ss + (wm * 64 + m * 16 + c) * P4_SS_STRIDE + key0) = w;
                }
            __syncthreads();
            int tv[16];
            {
                const int* rowp = (const int*)Ss + srow * P4_SS_STRIDE + shalf * 64;
#pragma unroll
                for (int bt = 0; bt < 4; ++bt) {
                    int bk[16];
#pragma unroll
                    for (int j = 0; j < 4; ++j) { const u32x4 v = *(const u32x4*)(rowp + 16 * bt + 4 * j); bk[4 * j] = (int)v.x; bk[4 * j + 1] = (int)v.y; bk[4 * j + 2] = (int)v.z; bk[4 * j + 3] = (int)v.w; }
                    bitonic_sort16(bk);
                    if (bt == 0) {
#pragma unroll
                        for (int j = 0; j < 16; ++j) tv[j] = bk[j];
                    } else top16_merge(tv, bk);
                }
            }
            __syncthreads();
            int* mbi = (int*)mbuf;
            if (shalf == 1) {
#pragma unroll
                for (int j = 0; j < 16; ++j) mbi[srow * 17 + j] = tv[j];
            }
            __syncthreads();
            if (shalf == 0) {
                int* dst = (int*)((ph == 0) ? st0 : st1);
                int ob[16];
#pragma unroll
                for (int j = 0; j < 16; ++j) ob[j] = mbi[srow * 17 + j];
                top16_merge(tv, ob);
#pragma unroll
                for (int j = 0; j < 16; ++j) dst[srow * 17 + j] = tv[j];
            }
        }
        __syncthreads();
        int cv[16];
        {
            const int* st0i = (const int*)st0; const int* st1i = (const int*)st1;
            float v2[16];
#pragma unroll
            for (int b = 0; b < 16; ++b) v2[b] = key2f(st1i[srow * 17 + b]);
#pragma unroll
            for (int a8 = 0; a8 < 8; ++a8) {
                const int a = shalf * 8 + a8; const float va = key2f(st0i[srow * 17 + a]);
                int bk[16];
#pragma unroll
                for (int b = 0; b < 16; ++b) bk[b] = (f2key(va + v2[b]) & (int)0xFFFFFF00) | (a * 16 + 15 - b);
                if (a8 == 0) {
#pragma unroll
                    for (int j = 0; j < 16; ++j) cv[j] = bk[j];
                } else top16_merge(cv, bk);
            }
        }
        __syncthreads();
        int* mbi = (int*)mbuf;
        if (shalf == 1) {
#pragma unroll
            for (int j = 0; j < 16; ++j) mbi[srow * 17 + j] = cv[j];
        }
        __syncthreads();
        if (shalf == 0) {
            const int* st0i = (const int*)st0; const int* st1i = (const int*)st1;
            int fk[16]; float fv[16];
#pragma unroll
            for (int j = 0; j < 16; ++j) { const int o = mbi[srow * 17 + 15 - j]; fk[j] = cv[j] > o ? cv[j] : o; fv[j] = key2f(fk[j]); }
            float cmax = fv[0];
#pragma unroll
            for (int j = 1; j < 16; ++j) cmax = fmaxf(cmax, fv[j]);
            float den = 0.f; float ev[16];
#pragma unroll
            for (int j = 0; j < 16; ++j) { ev[j] = __expf(fv[j] - cmax); den += ev[j]; }
            const float rden = 1.0f / den;
            const size_t ob = (size_t)(mt * 128 + srow) * 128 + head * 16;
#pragma unroll
            for (int j = 0; j < 16; ++j) {
                const unsigned cde = (unsigned)fk[j] & 0xFFu;
                const unsigned a = cde >> 4, b = 15u - (cde & 15u);
                const unsigned i1 = __float_as_uint(key2f(st0i[srow * 17 + a])) & 0x7Fu, i2 = __float_as_uint(key2f(st1i[srow * 17 + b])) & 0x7Fu;
                const int e = (int)(i1 * 128u + i2);
                PE[ob + j] = (unsigned short)e; PG[ob + j] = ev[j] * rden * SV[e]; PS[ob + j] = SU[e];
            }
        }
        __syncthreads();
    }
}

DI float gelu_exact(float z) { return 0.5f * z * (1.0f + erff(z * 0.70710678118654752f)); }
DI float rdlane(float v, int l) { return __int_as_float(__builtin_amdgcn_readlane(__float_as_int(v), l)); }

constexpr int P5A_LIST_BYTES = (2048 + 128) * 4, P5A_WAVE_LDS = P5A_LIST_BYTES + 8192;
template <int MODE>
DI void p5a_udot(const Params& p, unsigned char* lds) {
    unsigned char* ws = p.ws;
    const unsigned char* H1Q = ws + WS_QA; const unsigned char* UT = ws + WS_UT;
    const unsigned short* PE = (const unsigned short*)(ws + WS_PE); float* ZB = (float*)(ws + (MODE ? WS_QI : WS_QB));
    const int lane = threadIdx.x & 63, wave = threadIdx.x >> 6, c = lane & 15, kb = lane >> 4;
    const int G = gridDim.x, bid = blockIdx.x;
    const bool affine = (G & 7) == 0;
    const int npass = affine ? 1 : 4;
    unsigned* list = (unsigned*)(lds + wave * P5A_WAVE_LDS);
    unsigned char* slot = lds + wave * P5A_WAVE_LDS + P5A_LIST_BYTES;
    const int l31 = lane & 31, lh = lane >> 5;
    unsigned cq[8];
#pragma unroll
    for (int q = 0; q < 8; ++q) cq[q] = (unsigned)((l31 ^ (q + 8 * lh)) * 16);
    for (int pass = 0; pass < npass; ++pass) {
        const int part = affine ? (bid & 3) : pass, rank = affine ? (bid >> 2) : bid, nper = affine ? (G >> 2) : G;
        const unsigned char* UTp = UT + (size_t)part * (4096 * 512);
        for (int gid = rank * 4 + wave; gid < NTOK / 16; gid += nper * 4) {
            const int t0 = gid * 16;
            u32x4 pv[4];
#pragma unroll
            for (int i = 0; i < 4; ++i) pv[i] = ldg16(PE + (size_t)(t0 + (lane >> 2)) * 128 + (lane & 3) * 32 + 8 * i);
            i32x8 ax[8];
#pragma unroll
            for (int s2 = 0; s2 < 8; ++s2) {
                const unsigned char* xp = H1Q + (size_t)(t0 + c) * 1024 + 128 * s2 + 16 * kb;
                const u32x4 lo = ldg16(xp), hi = ldg16(xp + 64);
                ax[s2][0] = (int)lo.x; ax[s2][1] = (int)lo.y; ax[s2][2] = (int)lo.z; ax[s2][3] = (int)lo.w; ax[s2][4] = (int)hi.x; ax[s2][5] = (int)hi.y; ax[s2][6] = (int)hi.z; ax[s2][7] = (int)hi.w;
            }
            unsigned base = 0;
            const unsigned zl = (unsigned)((lane >> 2) * 128 + (lane & 3) * 32) << 21;
#pragma unroll
            for (int i = 0; i < 4; ++i)
#pragma unroll
                for (int w = 0; w < 4; ++w)
#pragma unroll
                    for (int hf = 0; hf < 2; ++hf) {
                        const unsigned e = hf ? (pv[i][w] >> 16) : (pv[i][w] & 0xffffu);
                        const bool cnd = (int)(e >> 12) == part;
                        const unsigned long long mk = __ballot(cnd);
                        if (mk) {
                            const unsigned pos = base + __builtin_amdgcn_mbcnt_hi((unsigned)(mk >> 32), __builtin_amdgcn_mbcnt_lo((unsigned)mk, 0u));
                            if (cnd) list[pos] = ((e & 4095u) << 9) | (zl + ((unsigned)(8 * i + 2 * w + hf) << 21));
                            base += (unsigned)__popcll(mk);
                        }
                    }
            const int count = (int)base, nrt = (count + 15) >> 4;
            if (MODE == 2) { if (count == 12345) ZB[lane] = (float)ax[7][7] + (float)ax[0][0]; }
            else if (count > 0) {
                {
                    const unsigned last = list[count - 1];
                    list[count + lane] = last; list[count + 64 + lane] = last;
                }
                float* ZBg = ZB + (size_t)t0 * 128;
                auto loadA = [&](int rt, u32x4 (&dst)[8]) {
                    const u32x4 ea = *(const u32x4*)(list + 16 * rt + 8 * lh), eb = *(const u32x4*)(list + 16 * rt + 8 * lh + 4);
#pragma unroll
                    for (int q = 0; q < 8; ++q) {
                        const unsigned ent = q < 4 ? ea[q & 3] : eb[q & 3];
                        dst[q] = ldg16(UTp + ((ent & 0x1ffe00u) | cq[q]));
                    }
                };
                auto compute = [&](int rt, const u32x4 (&st)[8]) {
#pragma unroll
                    for (int q = 0; q < 8; ++q) *(u32x4*)(slot + q * 512 + lh * 4096 + l31 * 16) = st[q];
                    u32x4 bf[8];
#pragma unroll
                    for (int s2 = 0; s2 < 8; ++s2) bf[s2] = *(const u32x4*)(slot + c * 512 + (((4 * s2 + kb) ^ c) * 16));
                    const unsigned ent = list[16 * rt + c];
                    f32x4 D = {0.f, 0.f, 0.f, 0.f};
#pragma unroll
                    for (int s2 = 0; s2 < 8; ++s2) {
                        i32x8 b8; b8[0] = (int)bf[s2].x; b8[1] = (int)bf[s2].y; b8[2] = (int)bf[s2].z; b8[3] = (int)bf[s2].w; b8[4] = 0; b8[5] = 0; b8[6] = 0; b8[7] = 0;
                        D = __builtin_amdgcn_mfma_scale_f32_16x16x128_f8f6f4(ax[s2], b8, D, 0  , 4  , 0, 0, 0, 0);
                    }
                    const unsigned zoff = ent >> 21, tk = zoff >> 7;
                    const float val = (tk & 2u) ? ((tk & 1u) ? D[3] : D[2]) : ((tk & 1u) ? D[1] : D[0]);
                    if ((int)(tk >> 2) == kb && 16 * rt + c < count && (MODE != 3 || val == 1234.5f)) ZBg[zoff] = val;
                };
                u32x4 a0[8], a1[8], a2[8];
                loadA(0, a0); loadA(1, a1); loadA(2, a2);
                for (int rt = 0; rt < nrt; rt += 3) {
                    compute(rt, a0); loadA(rt + 3, a0);
                    if (rt + 1 < nrt) compute(rt + 1, a1);
                    loadA(rt + 4, a1);
                    if (rt + 2 < nrt) compute(rt + 2, a2);
                    loadA(rt + 5, a2);
                }
            }
        }
    }
}

DI void p5b_ffn(const Params& p) {
    unsigned char* ws = p.ws;
    const bf16_t* H1B = (const bf16_t*)(ws + WS_XB); const unsigned char* VT = ws + WS_VT;
    const unsigned short* PE = (const unsigned short*)(ws + WS_PE); const float* PG = (const float*)(ws + WS_PG); const float* PS = (const float*)(ws + WS_PS);
    const int lane = threadIdx.x & 63, gw = blockIdx.x * 4 + (threadIdx.x >> 6), nw = gridDim.x * 4;
    for (int tok = gw; tok < NTOK; tok += nw) {
        float x[16], acc[16];
        {
            const u32x4 xa = ldg16(H1B + (size_t)tok * 1024 + lane * 16), xb = ldg16(H1B + (size_t)tok * 1024 + lane * 16 + 8);
            x[0] = bf_lo(xa.x); x[1] = bf_hi(xa.x); x[2] = bf_lo(xa.y); x[3] = bf_hi(xa.y); x[4] = bf_lo(xa.z); x[5] = bf_hi(xa.z); x[6] = bf_lo(xa.w); x[7] = bf_hi(xa.w);
            x[8] = bf_lo(xb.x); x[9] = bf_hi(xb.x); x[10] = bf_lo(xb.y); x[11] = bf_hi(xb.y); x[12] = bf_lo(xb.z); x[13] = bf_hi(xb.z); x[14] = bf_lo(xb.w); x[15] = bf_hi(xb.w);
        }
#pragma unroll
        for (int i = 0; i < 16; ++i) acc[i] = 0.f;
        const int pe_lo = (int)PE[(size_t)tok * 128 + lane], pe_hi = (int)PE[(size_t)tok * 128 + 64 + lane];
        const float* ZB = (const float*)(ws + WS_QB);
        const float sxt = ((const float*)(ws + WS_SX))[tok];
        const float cf_lo = gelu_exact(ZB[(size_t)tok * 128 + lane] * PS[(size_t)tok * 128 + lane] * sxt) * PG[(size_t)tok * 128 + lane];
        const float cf_hi = gelu_exact(ZB[(size_t)tok * 128 + 64 + lane] * PS[(size_t)tok * 128 + 64 + lane] * sxt) * PG[(size_t)tok * 128 + 64 + lane];
#pragma unroll 1
        for (int hb = 0; hb < 4; ++hb) {
            const int pes = hb < 2 ? pe_lo : pe_hi; const float cfs = hb < 2 ? cf_lo : cf_hi;
            const int lb = (hb & 1) * 32;
#pragma unroll
            for (int j = 0; j < 32; ++j) {
                const int e = __builtin_amdgcn_readlane(pes, lb + j);
                const float cj = rdlane(cfs, lb + j);
                const u32x2 vw = *(const u32x2*)(VT + (size_t)e * 512 + lane * 8);
#define P5_AXPY(k, bs) { const f32x2 f = __builtin_amdgcn_cvt_scalef32_pk_f32_fp4(vw[k], 1.0f, bs); acc[8 * (k) + 2 * (bs)] = fmaf(cj, f.x, acc[8 * (k) + 2 * (bs)]); acc[8 * (k) + 2 * (bs) + 1] = fmaf(cj, f.y, acc[8 * (k) + 2 * (bs) + 1]); }
                P5_AXPY(0, 0) P5_AXPY(0, 1) P5_AXPY(0, 2) P5_AXPY(0, 3) P5_AXPY(1, 0) P5_AXPY(1, 1) P5_AXPY(1, 2) P5_AXPY(1, 3)
            }
        }
        float s = 0.f;
#pragma unroll
        for (int i = 0; i < 16; ++i) { acc[i] = fmaf(ALPHA, x[i], acc[i]); s += acc[i]; }
        const float mu = wave_sum(s) * (1.f / 1024.f); float q = 0.f;
#pragma unroll
        for (int i = 0; i < 16; ++i) { const float dd = acc[i] - mu; q = fmaf(dd, dd, q); }
        const float rstd = rsqrtf(wave_sum(q) * (1.f / 1024.f) + LN_EPS);
#pragma unroll
        for (int k4 = 0; k4 < 4; ++k4) {
            const int col = lane * 16 + k4 * 4;
            const f32x4 gg = *(const f32x4*)(p.ln2_g + col), bb = *(const f32x4*)(p.ln2_b + col);
            f32x4 o;
#pragma unroll
            for (int e = 0; e < 4; ++e) o[e] = (acc[k4 * 4 + e] - mu) * rstd * gg[e] + bb[e];
            *(f32x4*)(p.out + (size_t)tok * 1024 + col) = o;
        }
    }
}

#define XB_TMO      128
#define XB_XCNT(j)  (256  + 64 * (j))
#define XB_XSUB(j)  (1280 + 64 * (j))
#define XB_XGEN(j)  (2304 + 64 * (j))
#define XB_TOP      3328
#define XB_TOPGEN   3392
#define XCD_BAR_WORDS 3456
#define XB_SPIN_CAP (1u << 22)
#define LAS __attribute__((address_space(3)))
DI unsigned xb_ld(unsigned* p)              { return __hip_atomic_load(p, __ATOMIC_RELAXED, __HIP_MEMORY_SCOPE_AGENT); }
DI unsigned xb_add(unsigned* p, unsigned v) { return __hip_atomic_fetch_add(p, v, __ATOMIC_RELAXED, __HIP_MEMORY_SCOPE_AGENT); }
DI unsigned xb_xcc_id() { return (unsigned)__builtin_amdgcn_s_getreg((3 << 11) | 20) & 0xFu; }
#define XB_SPIN(cond, bar) do { unsigned _sp = 0; while (cond) { __builtin_amdgcn_s_sleep(1); \
    if ((++_sp & 255u) == 0u) { if (xb_ld(&(bar)[XB_TMO])) break; if (_sp > XB_SPIN_CAP) { atomicAdd(&(bar)[XB_TMO], 1u); break; } } } } while (0)
struct XcdBarrier { unsigned* bar; unsigned x; volatile LAS unsigned* st; };
DI XcdBarrier xcd_barrier_post(unsigned* bar, volatile LAS unsigned* st) {
    XcdBarrier b; b.bar = bar; b.x = xb_xcc_id(); b.st = st;
    if (threadIdx.x == 0) (void)xb_add(&bar[XB_XCNT(b.x)], 1u);
    return b;
}
DI void xcd_barrier_complete(unsigned* bar, unsigned x, unsigned& nloc, unsigned& nx) {
    const unsigned G = gridDim.x * gridDim.y * gridDim.z;
    unsigned sum, cnt, mine, sp = 0u;
    for (;;) {
        sum = 0u; cnt = 0u; mine = 0u;
#pragma unroll
        for (unsigned j = 0; j < 16; ++j) { const unsigned c = xb_ld(&bar[XB_XCNT(j)]); sum += c; cnt += (c > 0u) ? 1u : 0u; mine = (j == x) ? c : mine; }
        if (sum == G) break;
        __builtin_amdgcn_s_sleep(1);
        if ((++sp & 255u) == 0u) { if (xb_ld(&bar[XB_TMO])) break; if (sp > XB_SPIN_CAP) { atomicAdd(&bar[XB_TMO], 1u); break; } }
    }
    nloc = mine > 0u ? mine : 1u; nx = cnt > 0u ? cnt : 1u;
}
DI void xcd_barrier(const XcdBarrier& b) {
    asm volatile("s_waitcnt vmcnt(0)" ::: "memory");
    __syncthreads();
    if (threadIdx.x == 0) {
        unsigned* bar = b.bar;
        __builtin_amdgcn_s_waitcnt(0);
        unsigned nloc = b.st[0], nx = b.st[1];
        if (nloc == 0u) { xcd_barrier_complete(bar, b.x, nloc, nx); b.st[0] = nloc; b.st[1] = nx; }
        const unsigned old = xb_add(&bar[XB_XSUB(b.x)], 1u);
        const unsigned gen = old / nloc;
        if (old + 1u == (gen + 1u) * nloc) {
            __builtin_amdgcn_fence(__ATOMIC_RELEASE, "agent");
            asm volatile("s_waitcnt vmcnt(0)" ::: "memory");
            const unsigned og = xb_add(&bar[XB_TOP], 1u);
            const unsigned tg = og / nx;
            if (og + 1u == (tg + 1u) * nx) xb_add(&bar[XB_TOPGEN], 1u);
            else XB_SPIN(xb_ld(&bar[XB_TOPGEN]) == tg, bar);
            __builtin_amdgcn_fence(__ATOMIC_ACQUIRE, "agent");
            xb_add(&bar[XB_XGEN(b.x)], 1u);
            asm volatile("s_waitcnt vmcnt(0)" ::: "memory");
        } else {
            XB_SPIN(xb_ld(&bar[XB_XGEN(b.x)]) == gen, bar);
            __builtin_amdgcn_fence(__ATOMIC_ACQUIRE, "agent");
            asm volatile("s_waitcnt vmcnt(0)" ::: "memory");
        }
    }
    __syncthreads();
}

constexpr int NPHASE = 7;
__global__ void __launch_bounds__(NTHREADS, 2) mega_fwd(Params p) {
    extern __shared__ __attribute__((aligned(16))) unsigned char lds[];
    cg::grid_group grid = cg::this_grid();
    const int lo = p.ph_lo, hi = p.ph_hi;
    volatile LAS unsigned* xbst = (volatile LAS unsigned*)(LAS unsigned char*)(lds + LDS_BYTES - 16);
#ifndef REP_MASK
#define REP_MASK 0
#endif
#ifndef P2_PROBE_MODE
#define P2_PROBE_MODE 15
#endif
#ifndef PH_MASK
#define PH_MASK 127
#endif
    if (lo == 0x7fffffff) grid.sync();
    if (threadIdx.x == 0) { xbst[0] = 0u; xbst[1] = 0u; }
    __syncthreads();
    XcdBarrier xb = xcd_barrier_post((unsigned*)(p.ws + WS_BAR), xbst);
#define GSYNC() xcd_barrier(xb)
#if REP_MASK & 1
    p0_prep(p, lds); GSYNC();
#endif
    p0_prep(p, lds);
    GSYNC();
#define RUN_PHASE(k, call) { call; if ((REP_MASK >> (k)) & 1) { GSYNC(); call; } }
#if PH_MASK & 2
    RUN_PHASE(1, p1_inproj(p, lds))
#endif
    GSYNC();
#if PH_MASK & 4
#if (REP_MASK >> 2) & 1
    p2a_indexer(p, lds); GSYNC(); p2_attention<P2_PROBE_MODE>(p, lds, 1); GSYNC();
#endif
    p2a_indexer(p, lds);
    GSYNC();
    p2_attention<15>(p, lds, 0);
#endif
    GSYNC();
#if PH_MASK & 8
    RUN_PHASE(3, p3_outproj(p, lds))
#endif
    GSYNC();
#if PH_MASK & 16
    RUN_PHASE(4, p3b_ln1(p))
#endif
    GSYNC();
#if PH_MASK & 32
    RUN_PHASE(5, p4_peer_query(p, lds))
#endif
    GSYNC();
#if PH_MASK & 64
    p5a_udot<0>(p, lds);
#ifdef P5A_REP
    GSYNC(); p5a_udot<P5A_REP>(p, lds);
#endif
    GSYNC();
    p5b_ffn(p);
#endif
}

#ifndef MK_N_LAUNCHES
#define MK_N_LAUNCHES 1
#endif

extern "C" void kernel_launch(void* const* d_in, const int* in_sizes, int n_in, void* d_out, int out_size, void* d_ws, size_t ws_size, hipStream_t stream) {
    static int grid_blocks = 0;
    if (grid_blocks == 0) {
        if (n_in != 14 || out_size != NTOK * D_MODEL || ws_size < WS_END) {
            fprintf(stderr, "kernel_launch: unexpected problem (n_in %d, out %d, ws %zu, need %zu)\n", n_in, out_size, ws_size, (size_t)WS_END); grid_blocks = -1; return;
        }
        int dev = 0, cus = 0, per_cu = 0;
        hipGetDevice(&dev);
        hipDeviceGetAttribute(&cus, hipDeviceAttributeMultiprocessorCount, dev);
        if (hipFuncSetAttribute((const void*)mega_fwd, hipFuncAttributeMaxDynamicSharedMemorySize, LDS_BYTES) != hipSuccess) { fprintf(stderr, "kernel_launch: hipFuncSetAttribute failed\n"); }
        if (hipOccupancyMaxActiveBlocksPerMultiprocessor(&per_cu, (const void*)mega_fwd, NTHREADS, LDS_BYTES) != hipSuccess || per_cu < 1) { fprintf(stderr, "kernel_launch: occupancy query failed\n"); per_cu = 1; }
        if (per_cu > 2) per_cu = 2;
        (void)hipGetLastError();
        grid_blocks = cus * per_cu;
        fprintf(stderr, "kernel_launch: %d CUs x %d blocks\n", cus, per_cu);
    }
    if (grid_blocks < 0) return;
    Params p{};
    p.x = (const float*)d_in[0]; p.w_in = (const float*)d_in[1]; p.idx_k_g = (const float*)d_in[2]; p.idx_k_b = (const float*)d_in[3]; p.sinks = (const float*)d_in[4];
    p.w_o = (const float*)d_in[5]; p.ln1_g = (const float*)d_in[6]; p.ln1_b = (const float*)d_in[7]; p.peer_wq = (const float*)d_in[8]; p.peer_subkeys = (const float*)d_in[9];
    p.peer_u = (const float*)d_in[10]; p.peer_v = (const float*)d_in[11]; p.ln2_g = (const float*)d_in[12]; p.ln2_b = (const float*)d_in[13];
    p.out = (float*)d_out; p.ws = (unsigned char*)d_ws;
    p.ph_lo = 0; p.ph_hi = NPHASE;
    if (hipMemsetAsync((unsigned char*)d_ws + WS_BAR, 0, 16384 + 64, stream) != hipSuccess) { fprintf(stderr, "kernel_launch: memset of the barrier words failed\n"); return; }
    void* args[] = {&p};
    hipError_t e = hipLaunchCooperativeKernel((const void*)mega_fwd, dim3(grid_blocks), dim3(NTHREADS), args, LDS_BYTES, stream);
    if (e != hipSuccess) fprintf(stderr, "cooperative launch failed: %s (grid %d)\n", hipGetErrorString(e), grid_blocks);
}
```

```cpp
#include <hip/hip_runtime.h>
#include <hip/hip_cooperative_groups.h>
#include <cstdio>
#include <cstdint>
namespace cg = cooperative_groups;

typedef unsigned short bf16_t;
typedef short bf16x8 __attribute__((ext_vector_type(8)));
typedef float f32x4 __attribute__((ext_vector_type(4)));
typedef float f32x16 __attribute__((ext_vector_type(16)));
typedef unsigned u32x4 __attribute__((ext_vector_type(4)));
typedef unsigned u32x2 __attribute__((ext_vector_type(2)));
typedef int i32x8 __attribute__((ext_vector_type(8)));
#define DI __device__ __forceinline__

constexpr int D_MODEL = 1024, BATCH = 8, SEQ = 4096, NTOK = BATCH * SEQ;
constexpr int NMIX = 1732, NMIX_PAD = 1792;
constexpr int P1_F8_COLS = 1408;
constexpr int PEER_N = 2048;
constexpr float ALPHA = 1.189207115002721f;
constexpr float LN_EPS = 1e-5f;
constexpr int NTHREADS = 256;
constexpr int LDS_BYTES = 77824;

constexpr size_t MB = 1024 * 1024;
constexpr size_t WS_CTL   = 0;
constexpr size_t WS_AMAX  = 65536 + 16384;
constexpr size_t WS_BAR   = 65536;
constexpr size_t WS_ROPE  = 1 * MB;
constexpr size_t WS_WINT  = 2 * MB;
constexpr size_t WS_WOT   = 6 * MB;
constexpr size_t WS_WQT   = 8 * MB;
constexpr size_t WS_SK    = 12 * MB;
constexpr size_t WS_UT    = 13 * MB;
constexpr size_t WS_VT    = 29 * MB;
constexpr size_t WS_SU    = 45 * MB;
constexpr size_t WS_SV    = 46 * MB;
constexpr size_t WS_SXR   = 47 * MB + 262144;
constexpr size_t WS_SWN   = 47 * MB + 524288;
constexpr size_t WS_X8    = 282 * MB;
constexpr size_t WS_SX    = 47 * MB;
constexpr size_t WS_XB    = 77 * MB;
constexpr size_t WS_QA    = 141 * MB;
constexpr size_t WS_KA    = 173 * MB;
constexpr size_t WS_VA    = 181 * MB;
constexpr size_t WS_QB    = 189 * MB;
constexpr size_t WS_KB    = 221 * MB;
constexpr size_t WS_VB    = 225 * MB;
constexpr size_t WS_QI    = 229 * MB;
constexpr size_t WS_KI    = 245 * MB;
constexpr size_t WS_WI    = 249 * MB;
constexpr size_t WS_ATT   = 250 * MB;
constexpr size_t WS_PE    = 314 * MB;
constexpr size_t WS_PG    = 322 * MB;
constexpr size_t WS_PS    = 338 * MB;
constexpr size_t WS_END   = 354 * MB;

struct Params {
    const float* x; const float* w_in; const float* idx_k_g; const float* idx_k_b; const float* sinks; const float* w_o;
    const float* ln1_g; const float* ln1_b; const float* peer_wq; const float* peer_subkeys; const float* peer_u; const float* peer_v;
    const float* ln2_g; const float* ln2_b;
    float* out; unsigned char* ws;
    int ph_lo, ph_hi;
};

typedef float f32x2 __attribute__((ext_vector_type(2)));
typedef __bf16 bf16x2_t __attribute__((ext_vector_type(2)));
DI unsigned pack_bf16(float lo, float hi) { const f32x2 v = {lo, hi}; return __builtin_bit_cast(unsigned, __builtin_convertvector(v, bf16x2_t)); }
DI unsigned f2bf(float x) { return pack_bf16(x, 0.f) & 0xffffu; }
DI float bf_lo(unsigned w) { return __uint_as_float(w << 16); }
DI float bf_hi(unsigned w) { return __uint_as_float(w & 0xffff0000u); }
DI bf16x8 as_bf16x8(u32x4 v) { return __builtin_bit_cast(bf16x8, v); }
DI u32x4 ldg16(const void* p) { return *(const u32x4*)p; }
DI f32x4 mfma16(bf16x8 a, bf16x8 b, f32x4 c) { return __builtin_amdgcn_mfma_f32_16x16x32_bf16(a, b, c, 0, 0, 0); }
DI f32x16 mfma32(bf16x8 a, bf16x8 b, f32x16 c) { return __builtin_amdgcn_mfma_f32_32x32x16_bf16(a, b, c, 0, 0, 0); }
DI float wave_sum(float v) {
#pragma unroll
    for (int o = 32; o >= 1; o >>= 1) v += __shfl_xor(v, o);
    return v;
}

DI void glds16(const void* src, void* lds_dst) { __builtin_amdgcn_global_load_lds((const unsigned*)src, (__attribute__((address_space(3))) unsigned*)lds_dst, 16, 0, 0); }
DI void gemm_128x128(const bf16_t* __restrict__ X, int ldx, const bf16_t* __restrict__ Wt, int ldw, int K, unsigned char* lds, f32x4 (&acc)[4][4]) {
    int tid = threadIdx.x; asm volatile("" : "+v"(tid));
    const int lane = tid & 63, wave = tid >> 6, wm = wave >> 1, wn = wave & 1, c = lane & 15, g = lane >> 4;
    const int lrow = tid >> 3, lch = tid & 7;
    const bf16_t* xp = X + (size_t)lrow * ldx + ((lch ^ (lrow & 7)) * 8);
    const bf16_t* wp = Wt + (size_t)lrow * ldw + ((lch ^ (lrow & 7)) * 8);
    unsigned char* dst0 = lds + tid * 16;
#pragma unroll
    for (int m = 0; m < 4; ++m)
#pragma unroll
        for (int n = 0; n < 4; ++n) acc[m][n] = (f32x4){0.f, 0.f, 0.f, 0.f};
    const int nk = K / 64;
    __syncthreads();
#pragma unroll
    for (int i = 0; i < 4; ++i) { glds16(xp + (size_t)(32 * i) * ldx, dst0 + i * 4096); glds16(wp + (size_t)(32 * i) * ldw, dst0 + 16384 + i * 4096); }
    asm volatile("s_waitcnt vmcnt(0)" ::: "memory");
    __syncthreads();
    for (int kt = 0; kt < nk; ++kt) {
        const unsigned char* Xs = lds + (kt & 1) * 32768; const unsigned char* Ws = Xs + 16384;
        if (kt + 1 < nk) {
            unsigned char* d = dst0 + ((kt + 1) & 1) * 32768;
#pragma unroll
            for (int i = 0; i < 4; ++i) { glds16(xp + (size_t)(32 * i) * ldx + (kt + 1) * 64, d + i * 4096); glds16(wp + (size_t)(32 * i) * ldw + (kt + 1) * 64, d + 16384 + i * 4096); }
        }
#pragma unroll
        for (int s = 0; s < 2; ++s) {
            bf16x8 xf[4], wf[4];
#pragma unroll
            for (int m = 0; m < 4; ++m) { const int row = wm * 64 + m * 16 + c; xf[m] = as_bf16x8(*(const u32x4*)(Xs + row * 128 + (((4 * s + g) ^ (c & 7)) << 4))); }
#pragma unroll
            for (int n = 0; n < 4; ++n) { const int row = wn * 64 + n * 16 + c; wf[n] = as_bf16x8(*(const u32x4*)(Ws + row * 128 + (((4 * s + g) ^ (c & 7)) << 4))); }
#pragma unroll
            for (int m = 0; m < 4; ++m)
#pragma unroll
                for (int n = 0; n < 4; ++n) acc[m][n] = mfma16(wf[n], xf[m], acc[m][n]);
        }
        asm volatile("s_waitcnt vmcnt(0)" ::: "memory");
        __syncthreads();
    }
}

DI void gemm8_128x128(const unsigned char* __restrict__ X, int ldx, const unsigned char* __restrict__ Wt, int ldw, int K, unsigned char* lds, f32x4 (&acc)[4][4]) {
    int tid = threadIdx.x; asm volatile("" : "+v"(tid));
    const int lane = tid & 63, wave = tid >> 6, wm = wave >> 1, wn = wave & 1, c = lane & 15, g = lane >> 4;
    const int lrow = tid >> 3, lch = tid & 7;
    const unsigned char* xp = X + (size_t)lrow * ldx + ((lch ^ (lrow & 7)) * 16);
    const unsigned char* wp = Wt + (size_t)lrow * ldw + ((lch ^ (lrow & 7)) * 16);
    unsigned char* dst0 = lds + tid * 16;
#pragma unroll
    for (int m = 0; m < 4; ++m)
#pragma unroll
        for (int n = 0; n < 4; ++n) acc[m][n] = (f32x4){0.f, 0.f, 0.f, 0.f};
    const int nk = K / 128;
    __syncthreads();
#pragma unroll
    for (int i = 0; i < 4; ++i) { glds16(xp + (size_t)(32 * i) * ldx, dst0 + i * 4096); glds16(wp + (size_t)(32 * i) * ldw, dst0 + 16384 + i * 4096); }
    asm volatile("s_waitcnt vmcnt(0)" ::: "memory");
    __syncthreads();
    for (int kt = 0; kt < nk; ++kt) {
        const unsigned char* Xs = lds + (kt & 1) * 32768; const unsigned char* Ws = Xs + 16384;
        if (kt + 1 < nk) {
            unsigned char* d = dst0 + ((kt + 1) & 1) * 32768;
#pragma unroll
            for (int i = 0; i < 4; ++i) { glds16(xp + (size_t)(32 * i) * ldx + (kt + 1) * 128, d + i * 4096); glds16(wp + (size_t)(32 * i) * ldw + (kt + 1) * 128, d + 16384 + i * 4096); }
        }
        i32x8 xf[4], wf[4];
#pragma unroll
        for (int m = 0; m < 4; ++m) {
            const int row = wm * 64 + m * 16 + c;
            const u32x4 lo = *(const u32x4*)(Xs + row * 128 + ((g ^ (c & 7)) << 4)), hi = *(const u32x4*)(Xs + row * 128 + (((4 + g) ^ (c & 7)) << 4));
            xf[m][0] = (int)lo.x; xf[m][1] = (int)lo.y; xf[m][2] = (int)lo.z; xf[m][3] = (int)lo.w; xf[m][4] = (int)hi.x; xf[m][5] = (int)hi.y; xf[m][6] = (int)hi.z; xf[m][7] = (int)hi.w;
        }
#pragma unroll
        for (int n = 0; n < 4; ++n) {
            const int row = wn * 64 + n * 16 + c;
            const u32x4 lo = *(const u32x4*)(Ws + row * 128 + ((g ^ (c & 7)) << 4)), hi = *(const u32x4*)(Ws + row * 128 + (((4 + g) ^ (c & 7)) << 4));
            wf[n][0] = (int)lo.x; wf[n][1] = (int)lo.y; wf[n][2] = (int)lo.z; wf[n][3] = (int)lo.w; wf[n][4] = (int)hi.x; wf[n][5] = (int)hi.y; wf[n][6] = (int)hi.z; wf[n][7] = (int)hi.w;
        }
#pragma unroll
        for (int m = 0; m < 4; ++m)
#pragma unroll
            for (int n = 0; n < 4; ++n) acc[m][n] = __builtin_amdgcn_mfma_scale_f32_16x16x128_f8f6f4(wf[n], xf[m], acc[m][n], 0, 0, 0, 0, 0, 0);
        asm volatile("s_waitcnt vmcnt(0)" ::: "memory");
        __syncthreads();
    }
}

DI bool tile_of(int k, int NT, int MT, int& mt, int& nt) {
    const int G = gridDim.x, bid = blockIdx.x;
    if (((G | MT) & 7) == 0) {
        const int idx = (bid >> 3) + k * (G >> 3);
        if (idx >= (MT >> 3) * NT) return false;
        mt = (idx / NT) * 8 + (bid & 7); nt = idx % NT;
    } else {
        const int t = bid + k * G;
        if (t >= MT * NT) return false;
        mt = t / NT; nt = t % NT;
    }
    return true;
}

DI void p0_prep(const Params& p, unsigned char* lds) {
    const int tid = threadIdx.x, nb = gridDim.x, bid = blockIdx.x;
    const size_t gtid = (size_t)bid * NTHREADS + tid, gsz = (size_t)nb * NTHREADS;
    unsigned char* ws = p.ws;
    constexpr int W_ITEMS = (P1_F8_COLS / 64) * 4 + ((NMIX_PAD - P1_F8_COLS) / 64) * 16;
    const int nwb = nb >= 8 ? (nb / 2 < W_ITEMS ? nb / 2 : W_ITEMS) : nb, nxb = nb >= 8 ? nb - nwb : nb;
    const bool xrole = nb < 8 || bid < nxb, wrole = nb < 8 || bid >= nxb;
    const int wbid = nb >= 8 ? bid - nxb : bid;
    {
        float* ct = (float*)(ws + WS_ROPE); float* stb = ct + SEQ * 32;
        for (size_t i = gtid; i < (size_t)SEQ * 32; i += gsz) {
            const int pos = (int)(i >> 5), fi = (int)(i & 31);
            const float inv = powf(10000.0f, -(float)(2 * fi) / 64.0f);
            const float ang = (float)pos * inv;
            ct[i] = cosf(ang); stb[i] = sinf(ang);
        }
    }
    auto conv = [&](const float* src, bf16_t* dst, size_t n) {
        for (size_t i = gtid * 8; i < n; i += gsz * 8) {
            const f32x4 a = *(const f32x4*)(src + i), b = *(const f32x4*)(src + i + 4);
            u32x4 o; o.x = pack_bf16(a.x, a.y); o.y = pack_bf16(a.z, a.w); o.z = pack_bf16(b.x, b.y); o.w = pack_bf16(b.z, b.w);
            *(u32x4*)(dst + i) = o;
        }
    };
    if ((bid & 7) == 0 || nb < 8) {
        const int sb = nb < 8 ? bid : (bid >> 3), nsb = nb < 8 ? nb : ((nb + 7) >> 3);
        float m = 0.f;
        for (size_t i = ((size_t)sb * NTHREADS + tid) * 4; i < (size_t)1024 * 1024; i += (size_t)nsb * NTHREADS * 4) { const f32x4 v = *(const f32x4*)(p.w_o + i); m = fmaxf(m, fmaxf(fmaxf(fabsf(v[0]), fabsf(v[1])), fmaxf(fabsf(v[2]), fabsf(v[3])))); }
#pragma unroll
        for (int o = 32; o >= 1; o >>= 1) m = fmaxf(m, __shfl_xor(m, o));
        float* red = (float*)lds;
        __syncthreads();
        if ((tid & 63) == 0) red[tid >> 6] = m;
        __syncthreads();
        if (tid == 0) { const float mm = fmaxf(fmaxf(red[0], red[1]), fmaxf(red[2], red[3])); if (mm > 0.f) atomicMax((unsigned*)(ws + WS_AMAX), __float_as_uint(mm)); }
        __syncthreads();
    }
    if (xrole) {
        const int lane = tid & 63, gw = bid * 4 + (tid >> 6), nw = nxb * 4;
        bf16_t* XBo = (bf16_t*)(ws + WS_XB); unsigned char* X8o = ws + WS_X8; float* SXRo = (float*)(ws + WS_SXR);
        for (int row0 = gw * 4; row0 < NTOK; row0 += nw * 4) {
            f32x4 v[4][4];
#pragma unroll
            for (int r = 0; r < 4; ++r)
#pragma unroll
                for (int i = 0; i < 4; ++i) v[r][i] = *(const f32x4*)(p.x + (size_t)(row0 + r) * 1024 + lane * 16 + 4 * i);
#pragma unroll
            for (int r = 0; r < 4; ++r) {
                const int row = row0 + r;
                float m = 0.f;
#pragma unroll
                for (int i = 0; i < 4; ++i) m = fmaxf(m, fmaxf(fmaxf(fabsf(v[r][i][0]), fabsf(v[r][i][1])), fmaxf(fabsf(v[r][i][2]), fabsf(v[r][i][3]))));
#pragma unroll
                for (int o = 32; o >= 1; o >>= 1) m = fmaxf(m, __shfl_xor(m, o));
                const float sc = m > 0.f ? 439.f / m : 1.f;
                u32x4 o0, o1, q8;
                o0.x = pack_bf16(v[r][0][0], v[r][0][1]); o0.y = pack_bf16(v[r][0][2], v[r][0][3]); o0.z = pack_bf16(v[r][1][0], v[r][1][1]); o0.w = pack_bf16(v[r][1][2], v[r][1][3]);
                o1.x = pack_bf16(v[r][2][0], v[r][2][1]); o1.y = pack_bf16(v[r][2][2], v[r][2][3]); o1.z = pack_bf16(v[r][3][0], v[r][3][1]); o1.w = pack_bf16(v[r][3][2], v[r][3][3]);
#pragma unroll
                for (int i = 0; i < 4; ++i) {
                    int pk = __builtin_amdgcn_cvt_pk_fp8_f32(v[r][i][0] * sc, v[r][i][1] * sc, 0, false);
                    pk = __builtin_amdgcn_cvt_pk_fp8_f32(v[r][i][2] * sc, v[r][i][3] * sc, pk, true);
                    q8[i] = (unsigned)pk;
                }
                *(u32x4*)(XBo + (size_t)row * 1024 + lane * 16) = o0; *(u32x4*)(XBo + (size_t)row * 1024 + lane * 16 + 8) = o1;
                *(u32x4*)(X8o + (size_t)row * 1024 + lane * 16) = q8;
                if (lane == 0) SXRo[row] = m > 0.f ? m * (1.f / 439.f) : 1.f;
            }
        }
    }
    conv(p.peer_subkeys, (bf16_t*)(ws + WS_SK), (size_t)8 * 2 * 128 * 128);
    float* tl = (float*)lds;
    auto transp = [&](const float* src, bf16_t* dst, int N, int Npad, int nt0) {
        const int tn = Npad / 64 - nt0, tk = 1024 / 64;
        for (int t = wbid - (P1_F8_COLS / 64) * 4; t < tn * tk; t += nwb) {
            if (t < 0) continue;
            const int n0 = (nt0 + t % tn) * 64, k0 = (t / tn) * 64;
            __syncthreads();
            for (int e = tid; e < 4096; e += NTHREADS) { const int kk = e >> 6, nn = e & 63; tl[kk * 65 + nn] = (n0 + nn < N) ? src[(size_t)(k0 + kk) * N + n0 + nn] : 0.f; }
            __syncthreads();
            for (int e = tid; e < 4096; e += NTHREADS) { const int nn = e >> 6, kk = e & 63; dst[(size_t)(n0 + nn) * 1024 + k0 + kk] = (bf16_t)f2bf(tl[kk * 65 + nn]); }
        }
    };
    if (wrole) transp(p.w_in, (bf16_t*)(ws + WS_WINT), NMIX, NMIX_PAD, P1_F8_COLS / 64);
    if (wrole) {
        unsigned char* w8 = ws + WS_WINT; float* swn = (float*)(ws + WS_SWN);
        float* cm = (float*)lds + 64 * 65;
        for (int item = wbid; item < (P1_F8_COLS / 64) * 4; item += nwb) {
            const int n0 = (item >> 2) * 64, kpart = item & 3;
            {
                const int n4 = (tid & 15) * 4, kq = tid >> 4;
                f32x4 m4 = {0.f, 0.f, 0.f, 0.f};
#pragma unroll 8
                for (int k2 = kq; k2 < 1024; k2 += 16) {
                    const f32x4 v = *(const f32x4*)(p.w_in + (size_t)k2 * NMIX + n0 + n4);
                    m4[0] = fmaxf(m4[0], fabsf(v[0])); m4[1] = fmaxf(m4[1], fabsf(v[1])); m4[2] = fmaxf(m4[2], fabsf(v[2])); m4[3] = fmaxf(m4[3], fabsf(v[3]));
                }
                __syncthreads();
                *(f32x4*)(cm + kq * 64 + n4) = m4;
                __syncthreads();
                if (tid < 64) {
                    float a = 0.f;
#pragma unroll
                    for (int r = 0; r < 16; ++r) a = fmaxf(a, cm[r * 64 + tid]);
                    cm[1024 + tid] = a > 0.f ? 439.f / a : 1.f;
                    if (kpart == 0) swn[n0 + tid] = a > 0.f ? a * (1.f / 439.f) : 1.f;
                }
            }
            for (int k0 = kpart * 256; k0 < kpart * 256 + 256; k0 += 64) {
                __syncthreads();
                for (int e = tid; e < 4096; e += NTHREADS) { const int kk = e >> 6, n2 = e & 63; tl[kk * 65 + n2] = p.w_in[(size_t)(k0 + kk) * NMIX + n0 + n2]; }
                __syncthreads();
                for (int e = tid; e < 1024; e += NTHREADS) {
                    const int n2 = e >> 4, kq4 = (e & 15) * 4; const float sc = cm[1024 + n2];
                    int pk = __builtin_amdgcn_cvt_pk_fp8_f32(tl[kq4 * 65 + n2] * sc, tl[(kq4 + 1) * 65 + n2] * sc, 0, false);
                    pk = __builtin_amdgcn_cvt_pk_fp8_f32(tl[(kq4 + 2) * 65 + n2] * sc, tl[(kq4 + 3) * 65 + n2] * sc, pk, true);
                    *(int*)(w8 + (size_t)(n0 + n2) * 1024 + k0 + kq4) = pk;
                }
            }
        }
    }
}

DI void p0_late(const Params& p, unsigned char* lds) {
    const int tid = threadIdx.x, nb = gridDim.x, bid = blockIdx.x;
    unsigned char* ws = p.ws;
    {
        const int lane = tid & 63, gw = bid * 4 + (tid >> 6), nw = nb * 4;
        for (int row0 = gw * 4; row0 < 2 * 16384; row0 += nw * 4) {
            f32x4 v[4][4];
#pragma unroll
            for (int r = 0; r < 4; ++r) {
                const int row = row0 + r; const bool isv = row >= 16384; const int e = isv ? row - 16384 : row;
                const float* src = (isv ? p.peer_v : p.peer_u) + (size_t)e * 1024 + lane * 16;
#pragma unroll
                for (int i = 0; i < 4; ++i) v[r][i] = *(const f32x4*)(src + 4 * i);
            }
#pragma unroll
            for (int r = 0; r < 4; ++r) {
                const int row = row0 + r; const bool isv = row >= 16384; const int e = isv ? row - 16384 : row;
                float mx = 0.f;
#pragma unroll
                for (int i = 0; i < 4; ++i) mx = fmaxf(mx, fmaxf(fmaxf(fabsf(v[r][i][0]), fabsf(v[r][i][1])), fmaxf(fabsf(v[r][i][2]), fabsf(v[r][i][3]))));
#pragma unroll
                for (int o = 32; o >= 1; o >>= 1) mx = fmaxf(mx, __shfl_xor(mx, o));
                const float sc = mx > 0.f ? mx * (1.0f / 5.99f) : 1.0f, inv = mx > 0.f ? 5.99f / mx : 1.0f;
                u32x2 o2;
#pragma unroll
                for (int k = 0; k < 2; ++k) {
                    unsigned w = 0;
                    w = __builtin_amdgcn_cvt_scalef32_pk_fp4_f32(w, v[r][2 * k][0] * inv, v[r][2 * k][1] * inv, 1.0f, 0);
                    w = __builtin_amdgcn_cvt_scalef32_pk_fp4_f32(w, v[r][2 * k][2] * inv, v[r][2 * k][3] * inv, 1.0f, 1);
                    w = __builtin_amdgcn_cvt_scalef32_pk_fp4_f32(w, v[r][2 * k + 1][0] * inv, v[r][2 * k + 1][1] * inv, 1.0f, 2);
                    w = __builtin_amdgcn_cvt_scalef32_pk_fp4_f32(w, v[r][2 * k + 1][2] * inv, v[r][2 * k + 1][3] * inv, 1.0f, 3);
                    o2[k] = w;
                }
                *(u32x2*)(ws + (isv ? WS_VT : WS_UT) + (size_t)e * 512 + lane * 8) = o2;
                if (lane == 0) ((float*)(ws + (isv ? WS_SV : WS_SU)))[e] = sc;
            }
        }
    }
    float* tl = (float*)lds;
    auto transp = [&](const float* src, bf16_t* dst, int N, int Npad) {
        const int tn = Npad / 64, tk = 1024 / 64;
        for (int t = bid; t < tn * tk; t += nb) {
            const int n0 = (t % tn) * 64, k0 = (t / tn) * 64;
            __syncthreads();
            for (int e = tid; e < 4096; e += NTHREADS) { const int kk = e >> 6, nn = e & 63; tl[kk * 65 + nn] = (n0 + nn < N) ? src[(size_t)(k0 + kk) * N + n0 + nn] : 0.f; }
            __syncthreads();
            for (int e = tid; e < 4096; e += NTHREADS) { const int nn = e >> 6, kk = e & 63; dst[(size_t)(n0 + nn) * 1024 + k0 + kk] = (bf16_t)f2bf(tl[kk * 65 + nn]); }
        }
    };
    {
        const float amax = __uint_as_float(*(const unsigned*)(ws + WS_AMAX)), sw = amax > 0.f ? 439.f / amax : 1.f;
        unsigned char* dst8 = ws + WS_WOT;
        for (int t = bid; t < 16 * 16; t += nb) {
            const int n0 = (t % 16) * 64, k0 = (t / 16) * 64;
            __syncthreads();
            for (int e = tid; e < 4096; e += NTHREADS) { const int kk = e >> 6, nn = e & 63; tl[kk * 65 + nn] = p.w_o[(size_t)(k0 + kk) * 1024 + n0 + nn]; }
            __syncthreads();
            for (int e = tid; e < 1024; e += NTHREADS) {
                const int nn = e >> 4, kq = (e & 15) * 4;
                int pk = __builtin_amdgcn_cvt_pk_fp8_f32(tl[kq * 65 + nn] * sw, tl[(kq + 1) * 65 + nn] * sw, 0, false);
                pk = __builtin_amdgcn_cvt_pk_fp8_f32(tl[(kq + 2) * 65 + nn] * sw, tl[(kq + 3) * 65 + nn] * sw, pk, true);
                *(int*)(dst8 + (size_t)(n0 + nn) * 1024 + k0 + kq) = pk;
            }
        }
    }
    transp(p.peer_wq, (bf16_t*)(ws + WS_WQT), PEER_N, PEER_N);
}

DI void p1_inproj(const Params& p, unsigned char* lds) {
    unsigned char* ws = p.ws;
    const bf16_t* XB = (const bf16_t*)(ws + WS_XB); const bf16_t* WT = (const bf16_t*)(ws + WS_WINT);
    const float* cosT = (const float*)(ws + WS_ROPE); const float* sinT = cosT + SEQ * 32;
    const int tid = threadIdx.x, lane = tid & 63, wave = tid >> 6, wm = wave >> 1, wn = wave & 1, c = lane & 15, g = lane >> 4;
    constexpr int NT = NMIX_PAD / 128, MT = NTOK / 128;
    int mt, nt;
    for (int k = 0; tile_of(k, NT, MT, mt, nt); ++k) {
        f32x4 acc[4][4];
        const bool f8 = nt < P1_F8_COLS / 128;
        if (f8) gemm8_128x128(ws + WS_X8 + (size_t)mt * 128 * 1024, 1024, ws + WS_WINT + (size_t)nt * 128 * 1024, 1024, 1024, lds, acc);
        else gemm_128x128(XB + (size_t)mt * 128 * 1024, 1024, WT + (size_t)nt * 128 * 1024, 1024, 1024, lds, acc);
        f32x4 swn4[4];
#pragma unroll
        for (int n = 0; n < 4; ++n) swn4[n] = f8 ? *(const f32x4*)((const float*)(ws + WS_SWN) + nt * 128 + wn * 64 + 16 * n + 4 * g) : (f32x4){1.f, 1.f, 1.f, 1.f};
        const int col64 = nt * 2 + wn;
        bf16_t* dst; int ld, coff; bool rope = true; float scale = 1.f; float vmax = 0.f;
        if (col64 < 8)       { dst = (bf16_t*)(ws + WS_QA); ld = 512; coff = col64 * 64; scale = 0.125f; }
        else if (col64 < 10) { dst = (bf16_t*)(ws + WS_KA); ld = 128; coff = (col64 - 8) * 64; }
        else if (col64 < 12) { dst = (bf16_t*)(ws + WS_VA); ld = 128; coff = (col64 - 10) * 64; rope = false; }
        else if (col64 < 20) { dst = (bf16_t*)(ws + WS_QB); ld = 512; coff = (col64 - 12) * 64; scale = 0.125f; }
        else if (col64 == 20) { dst = (bf16_t*)(ws + WS_KB); ld = 64; coff = 0; }
        else if (col64 == 21) { dst = (bf16_t*)(ws + WS_VB); ld = 64; coff = 0; rope = false; }
        else if (col64 < 26) { dst = (bf16_t*)(ws + WS_QI); ld = 256; coff = (col64 - 22) * 64; }
        else                 { dst = (bf16_t*)(ws + WS_KI); ld = 64; coff = 0; }
        if (col64 == 27) {
            if (g == 0) {
#pragma unroll
                for (int m = 0; m < 4; ++m) { const int tok = mt * 128 + wm * 64 + m * 16 + c; *(f32x4*)((float*)(ws + WS_WI) + (size_t)tok * 4) = acc[m][0] * 0.0625f; }
            }
            continue;
        }
#pragma unroll
        for (int m = 0; m < 4; ++m) {
            const int tok = mt * 128 + wm * 64 + m * 16 + c, pos = tok & (SEQ - 1);
            const float sxr = f8 ? ((const float*)(ws + WS_SXR))[tok] : 1.f;
            f32x4 v[4] = {acc[m][0] * (swn4[0] * sxr), acc[m][1] * (swn4[1] * sxr), acc[m][2] * (swn4[2] * sxr), acc[m][3] * (swn4[3] * sxr)};
            if (col64 == 26) {
                float s = 0.f;
#pragma unroll
                for (int n = 0; n < 4; ++n) s += (v[n][0] + v[n][1]) + (v[n][2] + v[n][3]);
                s += __shfl_xor(s, 16); s += __shfl_xor(s, 32);
                const float mu = s * (1.f / 64.f); float q = 0.f;
#pragma unroll
                for (int n = 0; n < 4; ++n) { const f32x4 d = v[n] - mu; q += (d[0] * d[0] + d[1] * d[1]) + (d[2] * d[2] + d[3] * d[3]); }
                q += __shfl_xor(q, 16); q += __shfl_xor(q, 32);
                const float rstd = rsqrtf(q * (1.f / 64.f) + LN_EPS);
#pragma unroll
                for (int n = 0; n < 4; ++n) {
                    const f32x4 gg = *(const f32x4*)(p.idx_k_g + 16 * n + 4 * g), bb = *(const f32x4*)(p.idx_k_b + 16 * n + 4 * g);
                    v[n] = (v[n] - mu) * rstd * gg + bb;
                }
            }
            if (rope) {
#pragma unroll
                for (int n = 0; n < 2; ++n) {
                    const f32x4 cs = *(const f32x4*)(cosT + pos * 32 + 16 * n + 4 * g), sn = *(const f32x4*)(sinT + pos * 32 + 16 * n + 4 * g);
                    const f32x4 t1 = v[n], t2 = v[n + 2];
                    v[n] = t1 * cs - t2 * sn; v[n + 2] = t2 * cs + t1 * sn;
                }
            }
#pragma unroll
            for (int n = 0; n < 4; ++n) {
                const f32x4 o = v[n] * scale; u32x2 w; w.x = pack_bf16(o[0], o[1]); w.y = pack_bf16(o[2], o[3]);
                *(u32x2*)(dst + (size_t)tok * ld + coff + 16 * n + 4 * g) = w;
                if (!rope) vmax = fmaxf(vmax, fmaxf(fmaxf(fabsf(o[0]), fabsf(o[1])), fmaxf(fabsf(o[2]), fabsf(o[3]))));
            }
        }
        if (!rope) {
#pragma unroll
            for (int o = 32; o >= 1; o >>= 1) vmax = fmaxf(vmax, __shfl_xor(vmax, o));
            if (lane == 0 && vmax > 0.f) atomicMax((unsigned*)(ws + WS_AMAX) + 1, __float_as_uint(vmax));
        }
    }
}

constexpr int NDSA = NTOK / 4, NSWA = BATCH * 32 * 8;
constexpr int P2_STG = 0  , P2_LIST = 32768;

DI unsigned f16_key(float v) {
    _Float16 hv = (_Float16)v; unsigned short hb = __builtin_bit_cast(unsigned short, hv); unsigned b = hb;
    if (b == 0x8000u) b = 0u;
    return (b & 0x8000u) ? ((~b) & 0xffffu) : (b | 0x8000u);
}

DI size_t sc_row_off(int t) { const size_t m = (size_t)(t >> 3); return 8 * (4 * m * (m + 1) + (size_t)(t & 7) * (m + 1)); }
constexpr size_t SC_BATCH = 8404992;
DI unsigned short* sc_batch_base(const Params& p, int b) { return (b < 7) ? (unsigned short*)p.out + (size_t)b * SC_BATCH : (unsigned short*)(p.ws + WS_PG); }

DI void p2a_indexer(const Params& p, unsigned char* lds) {
    unsigned char* ws = p.ws;
    const bf16_t* QI = (const bf16_t*)(ws + WS_QI); const bf16_t* KI = (const bf16_t*)(ws + WS_KI); const float* WI = (const float*)(ws + WS_WI);
    const int G = gridDim.x, bi = blockIdx.x;
    for (int it = 0; it < 2; ++it) {
        const int item = (it == 0) ? bi : 1023 - bi;
        for (int id = (G == 512) ? item : bi + it * G; id < 1024; id += (G == 512) ? 1024 : 2 * G) {
            int tid = threadIdx.x; asm volatile("" : "+v"(tid));
            const int lane = tid & 63, wave = tid >> 6, c = lane & 15, g = lane >> 4, lrow = tid >> 3, lch = tid & 7;
            const int b = id >> 7, t0 = (id & 127) * 32, tokw = b * SEQ + t0 + 8 * wave;
            unsigned short* scb = sc_batch_base(p, b);
            bf16x8 af[2][2]; f32x4 wv[2];
#pragma unroll
            for (int rt = 0; rt < 2; ++rt) {
#pragma unroll
                for (int s2 = 0; s2 < 2; ++s2) af[rt][s2] = as_bf16x8(ldg16(QI + (size_t)(tokw + 4 * rt + (c >> 2)) * 256 + (c & 3) * 64 + 32 * s2 + 8 * g));
                wv[rt] = *(const f32x4*)(WI + (size_t)(tokw + 4 * rt + g) * 4);
            }
            asm volatile("" :: "v"(af[0][0]), "v"(af[0][1]), "v"(af[1][0]), "v"(af[1][1]), "v"(wv[0]), "v"(wv[1]));
            const int nkt = ((t0 + 31) >> 7) + 1;
            const unsigned char* kib = (const unsigned char*)(KI + (size_t)b * SEQ * 64);
            unsigned char* dst0 = lds + tid * 16;
            auto stage = [&](int kt, int buf) {
#pragma unroll
                for (int i = 0; i < 4; ++i) {
                    const int row = lrow + 32 * i;
                    glds16(kib + (size_t)(kt * 128 + row) * 128 + ((lch ^ ((row >> 3) & 7)) << 4), dst0 + buf * 16384 + i * 4096);
                }
            };
            __syncthreads();
            stage(0, 0); if (nkt > 1) stage(1, 1);
            for (int kt = 0; kt < nkt; ++kt) {
                if (kt + 1 < nkt) asm volatile("s_waitcnt vmcnt(4)" ::: "memory");
                else asm volatile("s_waitcnt vmcnt(0)" ::: "memory");
                asm volatile("s_waitcnt lgkmcnt(0)" ::: "memory");
                __builtin_amdgcn_s_barrier();
                if (kt + 2 < nkt) stage(kt + 2, (kt + 2) % 3);
                const unsigned char* Ks = lds + (kt % 3) * 16384;
                unsigned res[2][4];
#pragma unroll
                for (int ct = 0; ct < 8; ++ct) {
                    const int row = 8 * c + ct;
                    const bf16x8 k0 = as_bf16x8(*(const u32x4*)(Ks + row * 128 + ((g ^ (c & 7)) << 4)));
                    const bf16x8 k1 = as_bf16x8(*(const u32x4*)(Ks + row * 128 + (((4 + g) ^ (c & 7)) << 4)));
#pragma unroll
                    for (int rt = 0; rt < 2; ++rt) {
                        f32x4 d = mfma16(af[rt][0], k0, (f32x4){0.f, 0.f, 0.f, 0.f});
                        d = mfma16(af[rt][1], k1, d);
                        const float sv = wv[rt][0] * fmaxf(d[0], 0.f) + wv[rt][1] * fmaxf(d[1], 0.f) + wv[rt][2] * fmaxf(d[2], 0.f) + wv[rt][3] * fmaxf(d[3], 0.f);
                        const int key = kt * 128 + row, tq = t0 + 8 * wave + 4 * rt + g;
                        const unsigned kv = (key <= tq) ? f16_key(sv) : 0u;
                        if (ct & 1) res[rt][ct >> 1] |= kv << 16; else res[rt][ct >> 1] = kv;
                    }
                }
#pragma unroll
                for (int rt = 0; rt < 2; ++rt) {
                    const int tq = t0 + 8 * wave + 4 * rt + g;
                    if (16 * kt + c <= (tq >> 3)) {
                        u32x4 w; w.x = res[rt][0]; w.y = res[rt][1]; w.z = res[rt][2]; w.w = res[rt][3];
                        *(u32x4*)(scb + sc_row_off(tq) + kt * 128 + 8 * c) = w;
                    }
                }
            }
        }
    }
    __syncthreads();
    p0_late(p, lds);
}

template <int MODE> DI void p2_dsa_item(const Params& p, unsigned char* lds, int b, int tb) {
    unsigned char* ws = p.ws;
    const bf16_t* QI = (const bf16_t*)(ws + WS_QI); const bf16_t* KI = (const bf16_t*)(ws + WS_KI); const float* WI = (const float*)(ws + WS_WI);
    const bf16_t* QB = (const bf16_t*)(ws + WS_QB); const bf16_t* KB = (const bf16_t*)(ws + WS_KB); const bf16_t* VB = (const bf16_t*)(ws + WS_VB);
    unsigned char* ATT8 = ws + WS_ATT;
    const float sa8 = 439.f / fmaxf(__uint_as_float(*(const unsigned*)(ws + WS_AMAX + 4)), 1e-30f);
    int tid = threadIdx.x; asm volatile("" : "+v"(tid));
    const int lane = tid & 63, wave = __builtin_amdgcn_readfirstlane(tid >> 6), c = lane & 15, g = lane >> 4;
    const int t0 = tb * 4, tok0 = b * SEQ + t0;
    unsigned char* stg = lds + P2_STG + wave * 8192;
    unsigned* hist = (unsigned*)stg;
    unsigned short* list = (unsigned short*)(lds + P2_LIST) + wave * 256;
    const int tok = tok0 + wave;
    if (!(MODE & 2)) return;
    const int n = t0 + wave + 1;
    const int L = n < 256 ? n : 256;
    const unsigned short* myk = sc_batch_base(p, b) + sc_row_off(t0 + wave);
    if (n <= 256) {
        for (int i = lane; i < n; i += 64) list[i] = (unsigned short)i;
    } else {
        u32x4 kk[8];
#pragma unroll
        for (int i = 0; i < 8; ++i) kk[i] = (512 * i + 8 * lane < n) ? ldg16(myk + 512 * i + 8 * lane) : (u32x4){0u, 0u, 0u, 0u};
#pragma unroll
        for (int i = 0; i < 4; ++i) *(u32x4*)(hist + lane * 16 + i * 4) = (u32x4){0u, 0u, 0u, 0u};
#pragma unroll
        for (int i = 0; i < 8; ++i) {
            if (512 * i < n) {
#pragma unroll
                for (int w = 0; w < 4; ++w) { const unsigned wd = kk[i][w]; atomicAdd(&hist[(wd & 0xffffu) >> 6], 1u); atomicAdd(&hist[wd >> 22], 1u); }
            }
        }
        unsigned h[16];
#pragma unroll
        for (int i = 0; i < 4; ++i) { const u32x4 t = *(const u32x4*)(hist + lane * 16 + i * 4); h[4 * i] = t.x; h[4 * i + 1] = t.y; h[4 * i + 2] = t.z; h[4 * i + 3] = t.w; }
#pragma unroll
        for (int i = 0; i < 4; ++i) *(u32x4*)(hist + lane * 16 + i * 4) = (u32x4){0u, 0u, 0u, 0u};
        unsigned sl = 0;
#pragma unroll
        for (int i = 0; i < 16; ++i) sl += h[i];
        unsigned pre = sl;
#pragma unroll
        for (int o = 1; o < 64; o <<= 1) { const unsigned t = __shfl_up(pre, o); if (lane >= o) pre += t; }
        const unsigned tot = __shfl(pre, 63);
        const unsigned suf = tot - pre;
        int found = -1; unsigned cab = 0, cum = suf;
#pragma unroll
        for (int j = 15; j >= 0; --j) { const bool hit = (found < 0) && (cum + h[j] >= 256u); if (hit) { found = lane * 16 + j; cab = cum; } cum += h[j]; }
        const bool mine = (suf < 256u) && (suf + sl >= 256u);
        const unsigned long long mm = __ballot(mine);
        const int src = __ffsll((long long)mm) - 1;
        const unsigned bstar = (unsigned)__shfl(found, src), cabove = __shfl(cab, src);
        const unsigned r1 = 256u - cabove;
#pragma unroll
        for (int i = 0; i < 8; ++i) {
            if (512 * i < n) {
#pragma unroll
                for (int w = 0; w < 4; ++w) {
                    const unsigned wd = kk[i][w];
                    if (((wd & 0xffffu) >> 6) == bstar) atomicAdd(&hist[wd & 63u], 1u);
                    if ((wd >> 22) == bstar) atomicAdd(&hist[(wd >> 16) & 63u], 1u);
                }
            }
        }
        const unsigned cnt = hist[lane];
        hist[lane] = 0u;
        unsigned pre2 = cnt;
#pragma unroll
        for (int o = 1; o < 64; o <<= 1) { const unsigned t = __shfl_up(pre2, o); if (lane >= o) pre2 += t; }
        const unsigned tot2 = __shfl(pre2, 63);
        const unsigned suf2 = tot2 - pre2;
        const bool mine2 = (suf2 < r1) && (suf2 + cnt >= r1);
        const unsigned long long mm2 = __ballot(mine2);
        const int src2 = __ffsll((long long)mm2) - 1;
        const unsigned T = (bstar << 6) | (unsigned)src2;
        const unsigned req = r1 - __shfl(suf2, src2);
        const unsigned toteq = __shfl(cnt, src2);
        const bool alleq = (req == toteq);
        const unsigned Tt = alleq ? T : T + 1u;
        unsigned cg = 0;
#pragma unroll
        for (int i = 0; i < 8; ++i)
#pragma unroll
            for (int w = 0; w < 4; ++w) { const unsigned wd = kk[i][w]; cg += ((wd & 0xffffu) >= Tt) ? 1u : 0u; cg += ((wd >> 16) >= Tt) ? 1u : 0u; }
        unsigned pre3 = cg;
#pragma unroll
        for (int o = 1; o < 64; o <<= 1) { const unsigned t = __shfl_up(pre3, o); if (lane >= o) pre3 += t; }
        unsigned off = pre3 - cg;
#pragma unroll
        for (int i = 0; i < 8; ++i)
#pragma unroll
            for (int w = 0; w < 4; ++w) {
                const unsigned wd = kk[i][w]; const int idx = 512 * i + 8 * lane + 2 * w;
                if ((wd & 0xffffu) >= Tt) { list[off & 255u] = (unsigned short)idx; ++off; }
                if ((wd >> 16) >= Tt) { list[off & 255u] = (unsigned short)(idx + 1); ++off; }
            }
        if (!alleq) {
            const unsigned cgt = 256u - req; unsigned eq_run = 0;
            for (int base = 0; base < n; base += 64) {
                const int i = base + lane; const unsigned m = (i < n) ? myk[i] : 0u;
                const bool eq = (m == T);
                const unsigned long long eqm = __ballot(eq);
                const unsigned rank = eq_run + __builtin_amdgcn_mbcnt_hi((unsigned)(eqm >> 32), __builtin_amdgcn_mbcnt_lo((unsigned)eqm, 0u));
                if (eq && rank < req) list[cgt + rank] = (unsigned short)i;
                eq_run += (unsigned)__popcll(eqm);
            }
        }
    }
    if (!(MODE & 4)) return;
    bf16x8 qf[2], sel[2];
#pragma unroll
    for (int s = 0; s < 2; ++s) {
        u32x4 t = (u32x4){0u, 0u, 0u, 0u};
        if (c < 8) t = ldg16(QB + (size_t)tok * 512 + c * 64 + 32 * s + 8 * g);
        qf[s] = as_bf16x8(t);
#pragma unroll
        for (int j = 0; j < 8; ++j) sel[s][j] = (8 * g + j == 16 * s + c) ? (short)0x3F80 : (short)0;
    }
    f32x4 st[16];
    const unsigned char* kbb = (const unsigned char*)(KB + (size_t)b * SEQ * 64); const unsigned char* vbb = (const unsigned char*)(VB + (size_t)b * SEQ * 64);
    const int lr = lane >> 3, lc = lane & 7;
    const unsigned st_off = lr * 128 + ((lc ^ lr) << 4);
    auto loadg = [&](const unsigned char* base, int T0, u32x4 (&dst)[8]) {
#pragma unroll
        for (int i = 0; i < 8; ++i) {
            const int idx = T0 * 16 + i * 8 + lr; const unsigned kid = (idx < L) ? (unsigned)list[idx] : 0u;
            dst[i] = ldg16(base + kid * 128u + lc * 16u);
        }
    };
    auto stage = [&](const u32x4 (&src)[8]) {
#pragma unroll
        for (int i = 0; i < 8; ++i) *(u32x4*)(stg + i * 1024 + st_off) = src[i];
    };
    auto frag = [&](int u, int s2) -> bf16x8 { return as_bf16x8(*(const u32x4*)(stg + (16 * u + c) * 128 + (((4 * s2 + g) ^ (c & 7)) << 4))); };
    auto scoreK = [&](int T0) {
#pragma unroll
        for (int T = 0; T < 4; ++T) {
            f32x4 d = mfma16(frag(T, 0), qf[0], (f32x4){0.f, 0.f, 0.f, 0.f});
            st[T0 + T] = mfma16(frag(T, 1), qf[1], d);
        }
    };
    u32x4 rA[8], rB[8], rC[8], rD[8];
    loadg(kbb, 0, rA); loadg(kbb, 4, rB); loadg(kbb, 8, rC); loadg(kbb, 12, rD);
    __builtin_amdgcn_sched_barrier(0);
    stage(rA); scoreK(0);
    stage(rB); scoreK(4);
    __builtin_amdgcn_sched_barrier(0);
    loadg(vbb, 0, rA); loadg(vbb, 4, rB);
    stage(rC); scoreK(8);
    stage(rD); scoreK(12);
    __builtin_amdgcn_sched_barrier(0);
    float mx = -3.0e38f;
    {
        const int lrem = L - 4 * g;
#pragma unroll
        for (int T = 0; T < 16; ++T)
#pragma unroll
            for (int r = 0; r < 4; ++r) { const float sv = (T * 16 + r < lrem) ? st[T][r] : -3.0e38f; st[T][r] = sv; mx = fmaxf(mx, sv); }
    }
    mx = fmaxf(mx, __shfl_xor(mx, 16)); mx = fmaxf(mx, __shfl_xor(mx, 32));
    float lsum = 0.f;
#pragma unroll
    for (int T = 0; T < 16; ++T)
#pragma unroll
        for (int r = 0; r < 4; ++r) { const float e = __expf(st[T][r] - mx); st[T][r] = e; lsum += e; }
    lsum += __shfl_xor(lsum, 16); lsum += __shfl_xor(lsum, 32);
    const float rl = 1.0f / lsum;
    u32x4 pfv[8];
#pragma unroll
    for (int u = 0; u < 8; ++u) {
        const int Ta = 2 * u, Tb = Ta + 1;
        pfv[u].x = pack_bf16(st[Ta][0] * rl, st[Ta][1] * rl); pfv[u].y = pack_bf16(st[Ta][2] * rl, st[Ta][3] * rl);
        pfv[u].z = pack_bf16(st[Tb][0] * rl, st[Tb][1] * rl); pfv[u].w = pack_bf16(st[Tb][2] * rl, st[Tb][3] * rl);
    }
    __builtin_amdgcn_sched_barrier(0);
    f32x4 O[4];
#pragma unroll
    for (int cb = 0; cb < 4; ++cb) O[cb] = (f32x4){0.f, 0.f, 0.f, 0.f};
    auto pv = [&](int T0) {
#pragma unroll
        for (int u = 0; u < 2; ++u) {
            const u32x4 pf = pfv[(T0 >> 1) + u];
#pragma unroll
            for (int cb = 0; cb < 4; ++cb) {
                const f32x4 z = (f32x4){0.f, 0.f, 0.f, 0.f};
                const f32x4 v0 = mfma16(frag(2 * u, cb >> 1), sel[cb & 1], z), v1 = mfma16(frag(2 * u + 1, cb >> 1), sel[cb & 1], z);
                u32x4 vf; vf.x = pack_bf16(v0[0], v0[1]); vf.y = pack_bf16(v0[2], v0[3]); vf.z = pack_bf16(v1[0], v1[1]); vf.w = pack_bf16(v1[2], v1[3]);
                O[cb] = mfma16(as_bf16x8(pf), as_bf16x8(vf), O[cb]);
            }
        }
    };
    loadg(vbb, 8, rC); loadg(vbb, 12, rD);
    __builtin_amdgcn_sched_barrier(0);
    stage(rA); pv(0);
    stage(rB); pv(4);
    __builtin_amdgcn_sched_barrier(0);
    stage(rC); pv(8);
    stage(rD); pv(12);
    if (g < 2) {
#pragma unroll
        for (int cb = 0; cb < 4; ++cb)
#pragma unroll
            for (int r = 0; r < 4; ++r) ATT8[(size_t)tok * 1024 + 512 + (4 * g + r) * 64 + 16 * cb + c] = (unsigned char)__builtin_amdgcn_cvt_pk_fp8_f32(O[cb][r] * sa8, 0.f, 0, false);
    }
}

DI void p2_swa_item(const Params& p, int item2) {
    unsigned char* ws = p.ws;
    const bf16_t* QA = (const bf16_t*)(ws + WS_QA); const bf16_t* KA = (const bf16_t*)(ws + WS_KA); const bf16_t* VA = (const bf16_t*)(ws + WS_VA);
    unsigned char* ATT8 = ws + WS_ATT;
    const float sa8 = 439.f / fmaxf(__uint_as_float(*(const unsigned*)(ws + WS_AMAX + 4)), 1e-30f);
    int tid = threadIdx.x; asm volatile("" : "+v"(tid));
    const int lane = tid & 63, wave = __builtin_amdgcn_readfirstlane(tid >> 6), r = lane & 31, h = lane >> 5;
    const int hq = item2 & 7, blk = (item2 >> 3) & 31, b = item2 >> 8, kvh = hq >> 2;
    const int qi = 32 * wave + r, tokq = b * SEQ + blk * 128 + qi;
    bf16x8 qf[4], sel[2];
#pragma unroll
    for (int s = 0; s < 4; ++s) qf[s] = as_bf16x8(ldg16(QA + (size_t)tokq * 512 + hq * 64 + 16 * s + 8 * h));
#pragma unroll
    for (int x = 0; x < 2; ++x)
#pragma unroll
        for (int j = 0; j < 8; ++j) sel[x][j] = (8 * h + j + 16 * x == r) ? (short)0x3F80 : (short)0;
    const float sink = p.sinks[hq];
    f32x16 ST[5];
#pragma unroll
    for (int ti = 0; ti < 5; ++ti) {
        const int sj = 32 * (wave + ti) + r; int pos = blk * 128 - 128 + sj; pos = pos < 0 ? 0 : pos;
        const bf16_t* kp = KA + (size_t)(b * SEQ + pos) * 128 + kvh * 64 + 8 * h;
        f32x16 d; for (int i = 0; i < 16; ++i) d[i] = 0.f;
#pragma unroll
        for (int s = 0; s < 4; ++s) d = mfma32(as_bf16x8(ldg16(kp + 16 * s)), qf[s], d);
        ST[ti] = d;
    }
    float mx = sink;
    {
        const int lo = r + 1 - 4 * h;
        const int lo0 = (blk > 0) ? lo : (lo > 128 - 32 * wave - 4 * h ? lo : 128 - 32 * wave - 4 * h);
#pragma unroll
        for (int ti = 0; ti < 5; ++ti)
#pragma unroll
            for (int reg = 0; reg < 16; ++reg) {
                const int e = 32 * ti + (reg & 3) + 8 * (reg >> 2);
                const float sv = (e >= lo0 && e < lo + 128) ? ST[ti][reg] : -3.0e38f; ST[ti][reg] = sv; mx = fmaxf(mx, sv);
            }
    }
    mx = fmaxf(mx, __shfl_xor(mx, 32));
    float lsum = 0.f;
#pragma unroll
    for (int ti = 0; ti < 5; ++ti)
#pragma unroll
        for (int reg = 0; reg < 16; ++reg) { const float e = __expf(ST[ti][reg] - mx); ST[ti][reg] = e; lsum += e; }
    lsum += __shfl_xor(lsum, 32);
    lsum += __expf(sink - mx);
    const float rl = 1.0f / lsum;
    f32x16 OT[2];
    for (int i = 0; i < 16; ++i) { OT[0][i] = 0.f; OT[1][i] = 0.f; }
#pragma unroll
    for (int ti = 0; ti < 5; ++ti) {
        const int sj = 32 * (wave + ti) + r; int pos = blk * 128 - 128 + sj; pos = pos < 0 ? 0 : pos;
        const bf16_t* vp = VA + (size_t)(b * SEQ + pos) * 128 + kvh * 64 + 8 * h;
        bf16x8 vf[4];
#pragma unroll
        for (int s = 0; s < 4; ++s) vf[s] = as_bf16x8(ldg16(vp + 16 * s));
        u32x4 pb[2];
#pragma unroll
        for (int s2 = 0; s2 < 2; ++s2) {
            pb[s2].x = pack_bf16(ST[ti][8 * s2 + 0] * rl, ST[ti][8 * s2 + 1] * rl); pb[s2].y = pack_bf16(ST[ti][8 * s2 + 2] * rl, ST[ti][8 * s2 + 3] * rl);
            pb[s2].z = pack_bf16(ST[ti][8 * s2 + 4] * rl, ST[ti][8 * s2 + 5] * rl); pb[s2].w = pack_bf16(ST[ti][8 * s2 + 6] * rl, ST[ti][8 * s2 + 7] * rl);
        }
#pragma unroll
        for (int db = 0; db < 2; ++db) {
            f32x16 vt; for (int i = 0; i < 16; ++i) vt[i] = 0.f;
            vt = mfma32(vf[2 * db], sel[0], vt); vt = mfma32(vf[2 * db + 1], sel[1], vt);
#pragma unroll
            for (int s2 = 0; s2 < 2; ++s2) {
                u32x4 va; va.x = pack_bf16(vt[8 * s2 + 0], vt[8 * s2 + 1]); va.y = pack_bf16(vt[8 * s2 + 2], vt[8 * s2 + 3]);
                va.z = pack_bf16(vt[8 * s2 + 4], vt[8 * s2 + 5]); va.w = pack_bf16(vt[8 * s2 + 6], vt[8 * s2 + 7]);
                OT[db] = mfma32(as_bf16x8(va), as_bf16x8(pb[s2]), OT[db]);
            }
        }
    }
#pragma unroll
    for (int db = 0; db < 2; ++db)
#pragma unroll
        for (int q4 = 0; q4 < 4; ++q4) {
            int pk = __builtin_amdgcn_cvt_pk_fp8_f32(OT[db][4 * q4] * sa8, OT[db][4 * q4 + 1] * sa8, 0, false);
            pk = __builtin_amdgcn_cvt_pk_fp8_f32(OT[db][4 * q4 + 2] * sa8, OT[db][4 * q4 + 3] * sa8, pk, true);
            *(int*)(ATT8 + (size_t)tokq * 1024 + hq * 64 + 32 * db + 8 * q4 + 4 * h) = pk;
        }
}

template <int MODE> DI void p2_attention(const Params& p, unsigned char* lds, int cidx = 0) {
    const int G = gridDim.x, bi = blockIdx.x, rounds = (1024 + G - 1) / G;
    for (int b = 0; b < BATCH; ++b)
        for (int r = 0; r < rounds; ++r) {
            const int idx = (r & 1) ? r * G + (G - 1 - bi) : r * G + bi;
            if (idx < 1024) p2_dsa_item<MODE>(p, lds, b, 1023 - idx);
        }
    if (MODE & 8) for (int item2 = bi; item2 < NSWA; item2 += G) p2_swa_item(p, item2);
}

DI void p3_outproj(const Params& p, unsigned char* lds) {
    unsigned char* ws = p.ws;
    const unsigned char* ATT8 = ws + WS_ATT; const unsigned char* WT8 = ws + WS_WOT;
    const float desc = (fmaxf(__uint_as_float(*(const unsigned*)(ws + WS_AMAX + 4)), 1e-30f) * (1.f / 439.f)) * (fmaxf(__uint_as_float(*(const unsigned*)(ws + WS_AMAX)), 1e-30f) * (1.f / 439.f));
    const int tid = threadIdx.x, lane = tid & 63, wave = tid >> 6, wm = wave >> 1, wn = wave & 1, c = lane & 15, g = lane >> 4;
    constexpr int NT = 8, MT = NTOK / 128;
    int mt, nt;
    for (int k = 0; tile_of(k, NT, MT, mt, nt); ++k) {
        f32x4 acc[4][4];
        gemm8_128x128(ATT8 + (size_t)mt * 128 * 1024, 1024, WT8 + (size_t)nt * 128 * 1024, 1024, 1024, lds, acc);
#pragma unroll
        for (int m = 0; m < 4; ++m) {
            const int tok = mt * 128 + wm * 64 + m * 16 + c;
#pragma unroll
            for (int n = 0; n < 4; ++n) {
                const size_t o = (size_t)tok * 1024 + nt * 128 + wn * 64 + 16 * n + 4 * g;
                const u32x2 xw = *(const u32x2*)((const bf16_t*)(ws + WS_XB) + o);
                const f32x4 xv = {bf_lo(xw.x), bf_hi(xw.x), bf_lo(xw.y), bf_hi(xw.y)};
                const f32x4 hv = xv * ALPHA + acc[m][n] * desc;
                u32x2 w; w.x = pack_bf16(hv[0], hv[1]); w.y = pack_bf16(hv[2], hv[3]);
                *(u32x2*)((bf16_t*)p.out + o) = w;
            }
        }
    }
}

DI void p3b_ln1(const Params& p) {
    bf16_t* H1B = (bf16_t*)(p.ws + WS_XB); const bf16_t* HP = (const bf16_t*)p.out;
    const int lane = threadIdx.x & 63, gw = blockIdx.x * 4 + (threadIdx.x >> 6), nw = gridDim.x * 4;
    for (int row = gw; row < NTOK; row += nw) {
        const u32x4 ra = ldg16(HP + (size_t)row * 1024 + lane * 16), rb = ldg16(HP + (size_t)row * 1024 + lane * 16 + 8);
        float v[16];
        v[0] = bf_lo(ra.x); v[1] = bf_hi(ra.x); v[2] = bf_lo(ra.y); v[3] = bf_hi(ra.y); v[4] = bf_lo(ra.z); v[5] = bf_hi(ra.z); v[6] = bf_lo(ra.w); v[7] = bf_hi(ra.w);
        v[8] = bf_lo(rb.x); v[9] = bf_hi(rb.x); v[10] = bf_lo(rb.y); v[11] = bf_hi(rb.y); v[12] = bf_lo(rb.z); v[13] = bf_hi(rb.z); v[14] = bf_lo(rb.w); v[15] = bf_hi(rb.w);
        float s = 0.f;
#pragma unroll
        for (int i = 0; i < 16; ++i) s += v[i];
        const float mu = wave_sum(s) * (1.f / 1024.f); float q = 0.f;
#pragma unroll
        for (int i = 0; i < 16; ++i) { const float d = v[i] - mu; q = fmaf(d, d, q); }
        const float rstd = rsqrtf(wave_sum(q) * (1.f / 1024.f) + LN_EPS);
        u32x4 oa, ob; float ov[16]; float amax = 0.f;
#pragma unroll
        for (int k4 = 0; k4 < 4; ++k4) {
            const int col = lane * 16 + k4 * 4;
            const f32x4 gg = *(const f32x4*)(p.ln1_g + col), bb = *(const f32x4*)(p.ln1_b + col);
            float o[4];
#pragma unroll
            for (int e = 0; e < 4; ++e) { o[e] = (v[k4 * 4 + e] - mu) * rstd * gg[e] + bb[e]; ov[k4 * 4 + e] = o[e]; amax = fmaxf(amax, fabsf(o[e])); }
            const unsigned w0 = pack_bf16(o[0], o[1]), w1 = pack_bf16(o[2], o[3]);
            if (k4 == 0) { oa.x = w0; oa.y = w1; } else if (k4 == 1) { oa.z = w0; oa.w = w1; } else if (k4 == 2) { ob.x = w0; ob.y = w1; } else { ob.z = w0; ob.w = w1; }
        }
        *(u32x4*)(H1B + (size_t)row * 1024 + lane * 16) = oa; *(u32x4*)(H1B + (size_t)row * 1024 + lane * 16 + 8) = ob;
        {
#pragma unroll
            for (int o2 = 32; o2 >= 1; o2 >>= 1) amax = fmaxf(amax, __shfl_xor(amax, o2));
            const float sx = amax > 0.f ? amax * (1.0f / 440.0f) : 1.0f, inv = amax > 0.f ? 440.0f / amax : 1.0f;
            u32x4 q8;
#pragma unroll
            for (int k4 = 0; k4 < 4; ++k4) {
                int w = 0;
                w = __builtin_amdgcn_cvt_pk_fp8_f32(ov[4 * k4] * inv, ov[4 * k4 + 1] * inv, w, false);
                w = __builtin_amdgcn_cvt_pk_fp8_f32(ov[4 * k4 + 2] * inv, ov[4 * k4 + 3] * inv, w, true);
                q8[k4] = (unsigned)w;
            }
            *(u32x4*)(p.ws + WS_QA + (size_t)row * 1024 + lane * 16) = q8;
            if (lane == 0) ((float*)(p.ws + WS_SX))[row] = sx;
        }
    }
}

DI int f2key(float v) { const int b = __float_as_int(v); return b ^ ((b >> 31) & 0x7fffffff); }
DI float key2f(int k) { return __int_as_float(k ^ ((k >> 31) & 0x7fffffff)); }
DI void ce_desc(int& a, int& b) { const int hi = a > b ? a : b, lo = a > b ? b : a; a = hi; b = lo; }
DI void bitonic_merge16(int (&k)[16]) {
#pragma unroll
    for (int d = 8; d >= 1; d >>= 1)
#pragma unroll
        for (int i = 0; i < 16; ++i) if ((i & d) == 0) ce_desc(k[i], k[i | d]);
}
DI void bitonic_sort16(int (&k)[16]) {
#pragma unroll
    for (int sz = 2; sz <= 16; sz <<= 1) {
#pragma unroll
        for (int i = 0; i < 16; ++i) { const int j = i ^ (sz - 1); if (j > i) ce_desc(k[i], k[j]); }
#pragma unroll
        for (int d = sz >> 2; d >= 1; d >>= 1)
#pragma unroll
            for (int i = 0; i < 16; ++i) if ((i & d) == 0) ce_desc(k[i], k[i | d]);
    }
}
DI void top16_merge(int (&t)[16], const int (&sdesc)[16]) {
#pragma unroll
    for (int i = 0; i < 16; ++i) t[i] = t[i] > sdesc[15 - i] ? t[i] : sdesc[15 - i];
    bitonic_merge16(t);
}
constexpr int P4_QS = 32768, P4_SS_STRIDE = 132, P4_ST0 = 67584  , P4_M = 0  , P4_ST1 = 8704  ;

DI void p4_peer_query(const Params& p, unsigned char* lds) {
    unsigned char* ws = p.ws;
    const bf16_t* H1B = (const bf16_t*)(ws + WS_XB); const bf16_t* WQT = (const bf16_t*)(ws + WS_WQT); const bf16_t* SK = (const bf16_t*)(ws + WS_SK);
    unsigned short* PE = (unsigned short*)(ws + WS_PE); float* PG = (float*)(ws + WS_PG); float* PS = (float*)(ws + WS_PS);
    const float* SU = (const float*)(ws + WS_SU); const float* SV = (const float*)(ws + WS_SV);
    float* Ss = (float*)lds;
    float* st0 = (float*)(lds + P4_ST0); float* mbuf = (float*)(lds + P4_M); float* st1 = (float*)(lds + P4_ST1);
    constexpr int MT = NTOK / 128;
    int mt, head;
    for (int k = 0; tile_of(k, 8, MT, mt, head); ++k) {
        int tid = threadIdx.x; asm volatile("" : "+v"(tid));
        const int lane = tid & 63, wave = tid >> 6, wm = wave >> 1, wn = wave & 1, c = lane & 15, g = lane >> 4;
        const int lrow = tid >> 3, lch = tid & 7;
        const int srow = tid & 127, shalf = tid >> 7;
#pragma unroll 1
        for (int ph = 0; ph < 2; ++ph) {
            f32x4 acc[4][4];
            gemm_128x128(H1B + (size_t)mt * 128 * 1024, 1024, WQT + (size_t)(head * 256 + ph * 128) * 1024, 1024, 1024, lds, acc);
            __syncthreads();
#pragma unroll
            for (int m = 0; m < 4; ++m)
#pragma unroll
                for (int n = 0; n < 4; ++n) {
                    const int row = wm * 64 + m * 16 + c;
                    u32x2 w; w.x = pack_bf16(acc[m][n][0], acc[m][n][1]); w.y = pack_bf16(acc[m][n][2], acc[m][n][3]);
                    *(u32x2*)(lds + P4_QS + wn * 16384 + row * 128 + (((2 * n + (g >> 1)) ^ (row & 7)) << 4) + (g & 1) * 8) = w;
                }
            {
                const bf16_t* sp = SK + (size_t)((head * 2 + ph) * 128 + lrow) * 128 + lch * 8;
#pragma unroll
                for (int k2 = 0; k2 < 2; ++k2)
#pragma unroll
                    for (int i = 0; i < 4; ++i) *(u32x4*)(lds + k2 * 16384 + (lrow + 32 * i) * 128 + ((lch ^ (lrow & 7)) << 4)) = ldg16(sp + (size_t)(32 * i) * 128 + k2 * 64);
            }
            __syncthreads();
            f32x4 a2[4][4];
#pragma unroll
            for (int m = 0; m < 4; ++m)
#pragma unroll
                for (int n = 0; n < 4; ++n) a2[m][n] = (f32x4){0.f, 0.f, 0.f, 0.f};
#pragma unroll
            for (int k2 = 0; k2 < 2; ++k2)
#pragma unroll
                for (int s = 0; s < 2; ++s) {
                    bf16x8 xf[4], wf[4];
#pragma unroll
                    for (int m = 0; m < 4; ++m) { const int row = wm * 64 + m * 16 + c; xf[m] = as_bf16x8(*(const u32x4*)(lds + P4_QS + k2 * 16384 + row * 128 + (((4 * s + g) ^ (c & 7)) << 4))); }
#pragma unroll
                    for (int n = 0; n < 4; ++n) { const int row = wn * 64 + n * 16 + c; wf[n] = as_bf16x8(*(const u32x4*)(lds + k2 * 16384 + row * 128 + (((4 * s + g) ^ (c & 7)) << 4))); }
#pragma unroll
                    for (int m = 0; m < 4; ++m)
#pragma unroll
                        for (int n = 0; n < 4; ++n) a2[m][n] = mfma16(wf[n], xf[m], a2[m][n]);
                }
            __syncthreads();
#pragma unroll
            for (int m = 0; m < 4; ++m)
#pragma unroll
                for (int n = 0; n < 4; ++n) {
                    const int key0 = wn * 64 + 16 * n + 4 * g;
                    u32x4 w;
#pragma unroll
                    for (int r = 0; r < 4; ++r) w[r] = (unsigned)f2key(__uint_as_float((__float_as_uint(a2[m][n][r]) & 0xFFFFFF80u) | (unsigned)(key0 + r)));
                    *(u32x4*)(Ss + (wm * 64 + m * 16 + c) * P4_SS_STRIDE + key0) = w;
                }
            __syncthreads();
            int tv[16];
            {
                const int* rowp = (const int*)Ss + srow * P4_SS_STRIDE + shalf * 64;
#pragma unroll
                for (int bt = 0; bt < 4; ++bt) {
                    int bk[16];
#pragma unroll
                    for (int j = 0; j < 4; ++j) { const u32x4 v = *(const u32x4*)(rowp + 16 * bt + 4 * j); bk[4 * j] = (int)v.x; bk[4 * j + 1] = (int)v.y; bk[4 * j + 2] = (int)v.z; bk[4 * j + 3] = (int)v.w; }
                    bitonic_sort16(bk);
                    if (bt == 0) {
#pragma unroll
                        for (int j = 0; j < 16; ++j) tv[j] = bk[j];
                    } else top16_merge(tv, bk);
                }
            }
            __syncthreads();
            int* mbi = (int*)mbuf;
            if (shalf == 1) {
#pragma unroll
                for (int j = 0; j < 16; ++j) mbi[srow * 17 + j] = tv[j];
            }
            __syncthreads();
            if (shalf == 0) {
                int* dst = (int*)((ph == 0) ? st0 : st1);
                int ob[16];
#pragma unroll
                for (int j = 0; j < 16; ++j) ob[j] = mbi[srow * 17 + j];
                top16_merge(tv, ob);
#pragma unroll
                for (int j = 0; j < 16; ++j) dst[srow * 17 + j] = tv[j];
            }
        }
        __syncthreads();
        int cv[16];
        {
            const int* st0i = (const int*)st0; const int* st1i = (const int*)st1;
            float v2[16];
#pragma unroll
            for (int b = 0; b < 16; ++b) v2[b] = key2f(st1i[srow * 17 + b]);
#pragma unroll
            for (int a8 = 0; a8 < 8; ++a8) {
                const int a = shalf * 8 + a8; const float va = key2f(st0i[srow * 17 + a]);
                int bk[16];
#pragma unroll
                for (int b = 0; b < 16; ++b) bk[b] = (f2key(va + v2[b]) & (int)0xFFFFFF00) | (a * 16 + 15 - b);
                if (a8 == 0) {
#pragma unroll
                    for (int j = 0; j < 16; ++j) cv[j] = bk[j];
                } else top16_merge(cv, bk);
            }
        }
        __syncthreads();
        int* mbi = (int*)mbuf;
        if (shalf == 1) {
#pragma unroll
            for (int j = 0; j < 16; ++j) mbi[srow * 17 + j] = cv[j];
        }
        __syncthreads();
        if (shalf == 0) {
            const int* st0i = (const int*)st0; const int* st1i = (const int*)st1;
            int fk[16]; float fv[16];
#pragma unroll
            for (int j = 0; j < 16; ++j) { const int o = mbi[srow * 17 + 15 - j]; fk[j] = cv[j] > o ? cv[j] : o; fv[j] = key2f(fk[j]); }
            float cmax = fv[0];
#pragma unroll
            for (int j = 1; j < 16; ++j) cmax = fmaxf(cmax, fv[j]);
            float den = 0.f; float ev[16];
#pragma unroll
            for (int j = 0; j < 16; ++j) { ev[j] = __expf(fv[j] - cmax); den += ev[j]; }
            const float rden = 1.0f / den;
            const size_t ob = (size_t)(mt * 128 + srow) * 128 + head * 16;
#pragma unroll
            for (int j = 0; j < 16; ++j) {
                const unsigned cde = (unsigned)fk[j] & 0xFFu;
                const unsigned a = cde >> 4, b = 15u - (cde & 15u);
                const unsigned i1 = __float_as_uint(key2f(st0i[srow * 17 + a])) & 0x7Fu, i2 = __float_as_uint(key2f(st1i[srow * 17 + b])) & 0x7Fu;
                const int e = (int)(i1 * 128u + i2);
                PE[ob + j] = (unsigned short)e; PG[ob + j] = ev[j] * rden * SV[e]; PS[ob + j] = SU[e];
            }
        }
        __syncthreads();
    }
}

DI float gelu_exact(float z) { return 0.5f * z * (1.0f + erff(z * 0.70710678118654752f)); }
DI float rdlane(float v, int l) { return __int_as_float(__builtin_amdgcn_readlane(__float_as_int(v), l)); }

constexpr int P5A_LIST_BYTES = (2048 + 128) * 4, P5A_WAVE_LDS = P5A_LIST_BYTES + 8192;
template <int MODE>
DI void p5a_udot(const Params& p, unsigned char* lds) {
    unsigned char* ws = p.ws;
    const unsigned char* H1Q = ws + WS_QA; const unsigned char* UT = ws + WS_UT;
    const unsigned short* PE = (const unsigned short*)(ws + WS_PE); float* ZB = (float*)(ws + (MODE ? WS_QI : WS_QB));
    const int lane = threadIdx.x & 63, wave = threadIdx.x >> 6, c = lane & 15, kb = lane >> 4;
    const int G = gridDim.x, bid = blockIdx.x;
    const bool affine = (G & 7) == 0;
    const int npass = affine ? 1 : 4;
    unsigned* list = (unsigned*)(lds + wave * P5A_WAVE_LDS);
    unsigned char* slot = lds + wave * P5A_WAVE_LDS + P5A_LIST_BYTES;
    const int l31 = lane & 31, lh = lane >> 5;
    unsigned cq[8];
#pragma unroll
    for (int q = 0; q < 8; ++q) cq[q] = (unsigned)((l31 ^ (q + 8 * lh)) * 16);
    for (int pass = 0; pass < npass; ++pass) {
        const int part = affine ? (bid & 3) : pass, rank = affine ? (bid >> 2) : bid, nper = affine ? (G >> 2) : G;
        const unsigned char* UTp = UT + (size_t)part * (4096 * 512);
        for (int gid = rank * 4 + wave; gid < NTOK / 16; gid += nper * 4) {
            const int t0 = gid * 16;
            u32x4 pv[4];
#pragma unroll
            for (int i = 0; i < 4; ++i) pv[i] = ldg16(PE + (size_t)(t0 + (lane >> 2)) * 128 + (lane & 3) * 32 + 8 * i);
            i32x8 ax[8];
#pragma unroll
            for (int s2 = 0; s2 < 8; ++s2) {
                const unsigned char* xp = H1Q + (size_t)(t0 + c) * 1024 + 128 * s2 + 16 * kb;
                const u32x4 lo = ldg16(xp), hi = ldg16(xp + 64);
                ax[s2][0] = (int)lo.x; ax[s2][1] = (int)lo.y; ax[s2][2] = (int)lo.z; ax[s2][3] = (int)lo.w; ax[s2][4] = (int)hi.x; ax[s2][5] = (int)hi.y; ax[s2][6] = (int)hi.z; ax[s2][7] = (int)hi.w;
            }
            unsigned base = 0;
            const unsigned zl = (unsigned)((lane >> 2) * 128 + (lane & 3) * 32) << 21;
#pragma unroll
            for (int i = 0; i < 4; ++i)
#pragma unroll
                for (int w = 0; w < 4; ++w)
#pragma unroll
                    for (int hf = 0; hf < 2; ++hf) {
                        const unsigned e = hf ? (pv[i][w] >> 16) : (pv[i][w] & 0xffffu);
                        const bool cnd = (int)(e >> 12) == part;
                        const unsigned long long mk = __ballot(cnd);
                        if (mk) {
                            const unsigned pos = base + __builtin_amdgcn_mbcnt_hi((unsigned)(mk >> 32), __builtin_amdgcn_mbcnt_lo((unsigned)mk, 0u));
                            if (cnd) list[pos] = ((e & 4095u) << 9) | (zl + ((unsigned)(8 * i + 2 * w + hf) << 21));
                            base += (unsigned)__popcll(mk);
                        }
                    }
            const int count = (int)base, nrt = (count + 15) >> 4;
            if (MODE == 2) { if (count == 12345) ZB[lane] = (float)ax[7][7] + (float)ax[0][0]; }
            else if (count > 0) {
                {
                    const unsigned last = list[count - 1];
                    list[count + lane] = last; list[count + 64 + lane] = last;
                }
                float* ZBg = ZB + (size_t)t0 * 128;
                auto loadA = [&](int rt, u32x4 (&dst)[8]) {
                    const u32x4 ea = *(const u32x4*)(list + 16 * rt + 8 * lh), eb = *(const u32x4*)(list + 16 * rt + 8 * lh + 4);
#pragma unroll
                    for (int q = 0; q < 8; ++q) {
                        const unsigned ent = q < 4 ? ea[q & 3] : eb[q & 3];
                        dst[q] = ldg16(UTp + ((ent & 0x1ffe00u) | cq[q]));
                    }
                };
                auto compute = [&](int rt, const u32x4 (&st)[8]) {
#pragma unroll
                    for (int q = 0; q < 8; ++q) *(u32x4*)(slot + q * 512 + lh * 4096 + l31 * 16) = st[q];
                    u32x4 bf[8];
#pragma unroll
                    for (int s2 = 0; s2 < 8; ++s2) bf[s2] = *(const u32x4*)(slot + c * 512 + (((4 * s2 + kb) ^ c) * 16));
                    const unsigned ent = list[16 * rt + c];
                    f32x4 D = {0.f, 0.f, 0.f, 0.f};
#pragma unroll
                    for (int s2 = 0; s2 < 8; ++s2) {
                        i32x8 b8; b8[0] = (int)bf[s2].x; b8[1] = (int)bf[s2].y; b8[2] = (int)bf[s2].z; b8[3] = (int)bf[s2].w; b8[4] = 0; b8[5] = 0; b8[6] = 0; b8[7] = 0;
                        D = __builtin_amdgcn_mfma_scale_f32_16x16x128_f8f6f4(ax[s2], b8, D, 0  , 4  , 0, 0, 0, 0);
                    }
                    const unsigned zoff = ent >> 21, tk = zoff >> 7;
                    const float val = (tk & 2u) ? ((tk & 1u) ? D[3] : D[2]) : ((tk & 1u) ? D[1] : D[0]);
                    if ((int)(tk >> 2) == kb && 16 * rt + c < count && (MODE != 3 || val == 1234.5f)) ZBg[zoff] = val;
                };
                u32x4 a0[8], a1[8], a2[8];
                loadA(0, a0); loadA(1, a1); loadA(2, a2);
                for (int rt = 0; rt < nrt; rt += 3) {
                    compute(rt, a0); loadA(rt + 3, a0);
                    if (rt + 1 < nrt) compute(rt + 1, a1);
                    loadA(rt + 4, a1);
                    if (rt + 2 < nrt) compute(rt + 2, a2);
                    loadA(rt + 5, a2);
                }
            }
        }
    }
}

DI void p5b_ffn(const Params& p) {
    unsigned char* ws = p.ws;
    const bf16_t* H1B = (const bf16_t*)(ws + WS_XB); const unsigned char* VT = ws + WS_VT;
    const unsigned short* PE = (const unsigned short*)(ws + WS_PE); const float* PG = (const float*)(ws + WS_PG); const float* PS = (const float*)(ws + WS_PS);
    const int lane = threadIdx.x & 63, gw = blockIdx.x * 4 + (threadIdx.x >> 6), nw = gridDim.x * 4;
    for (int tok = gw; tok < NTOK; tok += nw) {
        float x[16], acc[16];
        {
            const u32x4 xa = ldg16(H1B + (size_t)tok * 1024 + lane * 16), xb = ldg16(H1B + (size_t)tok * 1024 + lane * 16 + 8);
            x[0] = bf_lo(xa.x); x[1] = bf_hi(xa.x); x[2] = bf_lo(xa.y); x[3] = bf_hi(xa.y); x[4] = bf_lo(xa.z); x[5] = bf_hi(xa.z); x[6] = bf_lo(xa.w); x[7] = bf_hi(xa.w);
            x[8] = bf_lo(xb.x); x[9] = bf_hi(xb.x); x[10] = bf_lo(xb.y); x[11] = bf_hi(xb.y); x[12] = bf_lo(xb.z); x[13] = bf_hi(xb.z); x[14] = bf_lo(xb.w); x[15] = bf_hi(xb.w);
        }
#pragma unroll
        for (int i = 0; i < 16; ++i) acc[i] = 0.f;
        const int pe_lo = (int)PE[(size_t)tok * 128 + lane], pe_hi = (int)PE[(size_t)tok * 128 + 64 + lane];
        const float* ZB = (const float*)(ws + WS_QB);
        const float sxt = ((const float*)(ws + WS_SX))[tok];
        const float cf_lo = gelu_exact(ZB[(size_t)tok * 128 + lane] * PS[(size_t)tok * 128 + lane] * sxt) * PG[(size_t)tok * 128 + lane];
        const float cf_hi = gelu_exact(ZB[(size_t)tok * 128 + 64 + lane] * PS[(size_t)tok * 128 + 64 + lane] * sxt) * PG[(size_t)tok * 128 + 64 + lane];
#pragma unroll 1
        for (int hb = 0; hb < 4; ++hb) {
            const int pes = hb < 2 ? pe_lo : pe_hi; const float cfs = hb < 2 ? cf_lo : cf_hi;
            const int lb = (hb & 1) * 32;
#pragma unroll
            for (int j = 0; j < 32; ++j) {
                const int e = __builtin_amdgcn_readlane(pes, lb + j);
                const float cj = rdlane(cfs, lb + j);
                const u32x2 vw = *(const u32x2*)(VT + (size_t)e * 512 + lane * 8);
#define P5_AXPY(k, bs) { const f32x2 f = __builtin_amdgcn_cvt_scalef32_pk_f32_fp4(vw[k], 1.0f, bs); acc[8 * (k) + 2 * (bs)] = fmaf(cj, f.x, acc[8 * (k) + 2 * (bs)]); acc[8 * (k) + 2 * (bs) + 1] = fmaf(cj, f.y, acc[8 * (k) + 2 * (bs) + 1]); }
                P5_AXPY(0, 0) P5_AXPY(0, 1) P5_AXPY(0, 2) P5_AXPY(0, 3) P5_AXPY(1, 0) P5_AXPY(1, 1) P5_AXPY(1, 2) P5_AXPY(1, 3)
            }
        }
        float s = 0.f;
#pragma unroll
        for (int i = 0; i < 16; ++i) { acc[i] = fmaf(ALPHA, x[i], acc[i]); s += acc[i]; }
        const float mu = wave_sum(s) * (1.f / 1024.f); float q = 0.f;
#pragma unroll
        for (int i = 0; i < 16; ++i) { const float dd = acc[i] - mu; q = fmaf(dd, dd, q); }
        const float rstd = rsqrtf(wave_sum(q) * (1.f / 1024.f) + LN_EPS);
#pragma unroll
        for (int k4 = 0; k4 < 4; ++k4) {
            const int col = lane * 16 + k4 * 4;
            const f32x4 gg = *(const f32x4*)(p.ln2_g + col), bb = *(const f32x4*)(p.ln2_b + col);
            f32x4 o;
#pragma unroll
            for (int e = 0; e < 4; ++e) o[e] = (acc[k4 * 4 + e] - mu) * rstd * gg[e] + bb[e];
            *(f32x4*)(p.out + (size_t)tok * 1024 + col) = o;
        }
    }
}

#define XB_TMO      128
#define XB_XCNT(j)  (256  + 64 * (j))
#define XB_XSUB(j)  (1280 + 64 * (j))
#define XB_XGEN(j)  (2304 + 64 * (j))
#define XB_TOP      3328
#define XB_TOPGEN   3392
#define XCD_BAR_WORDS 3456
#define XB_SPIN_CAP (1u << 22)
#define LAS __attribute__((address_space(3)))
DI unsigned xb_ld(unsigned* p)              { return __hip_atomic_load(p, __ATOMIC_RELAXED, __HIP_MEMORY_SCOPE_AGENT); }
DI unsigned xb_add(unsigned* p, unsigned v) { return __hip_atomic_fetch_add(p, v, __ATOMIC_RELAXED, __HIP_MEMORY_SCOPE_AGENT); }
DI unsigned xb_xcc_id() { return (unsigned)__builtin_amdgcn_s_getreg((3 << 11) | 20) & 0xFu; }
#define XB_SPIN(cond, bar) do { unsigned _sp = 0; while (cond) { __builtin_amdgcn_s_sleep(1); \
    if ((++_sp & 255u) == 0u) { if (xb_ld(&(bar)[XB_TMO])) break; if (_sp > XB_SPIN_CAP) { atomicAdd(&(bar)[XB_TMO], 1u); break; } } } } while (0)
struct XcdBarrier { unsigned* bar; unsigned x; volatile LAS unsigned* st; };
DI XcdBarrier xcd_barrier_post(unsigned* bar, volatile LAS unsigned* st) {
    XcdBarrier b; b.bar = bar; b.x = xb_xcc_id(); b.st = st;
    if (threadIdx.x == 0) (void)xb_add(&bar[XB_XCNT(b.x)], 1u);
    return b;
}
DI void xcd_barrier_complete(unsigned* bar, unsigned x, unsigned& nloc, unsigned& nx) {
    const unsigned G = gridDim.x * gridDim.y * gridDim.z;
    unsigned sum, cnt, mine, sp = 0u;
    for (;;) {
        sum = 0u; cnt = 0u; mine = 0u;
#pragma unroll
        for (unsigned j = 0; j < 16; ++j) { const unsigned c = xb_ld(&bar[XB_XCNT(j)]); sum += c; cnt += (c > 0u) ? 1u : 0u; mine = (j == x) ? c : mine; }
        if (sum == G) break;
        __builtin_amdgcn_s_sleep(1);
        if ((++sp & 255u) == 0u) { if (xb_ld(&bar[XB_TMO])) break; if (sp > XB_SPIN_CAP) { atomicAdd(&bar[XB_TMO], 1u); break; } }
    }
    nloc = mine > 0u ? mine : 1u; nx = cnt > 0u ? cnt : 1u;
}
DI void xcd_barrier(const XcdBarrier& b) {
    asm volatile("s_waitcnt vmcnt(0)" ::: "memory");
    __syncthreads();
    if (threadIdx.x == 0) {
        unsigned* bar = b.bar;
        __builtin_amdgcn_s_waitcnt(0);
        unsigned nloc = b.st[0], nx = b.st[1];
        if (nloc == 0u) { xcd_barrier_complete(bar, b.x, nloc, nx); b.st[0] = nloc; b.st[1] = nx; }
        const unsigned old = xb_add(&bar[XB_XSUB(b.x)], 1u);
        const unsigned gen = old / nloc;
        if (old + 1u == (gen + 1u) * nloc) {
            __builtin_amdgcn_fence(__ATOMIC_RELEASE, "agent");
            asm volatile("s_waitcnt vmcnt(0)" ::: "memory");
            const unsigned og = xb_add(&bar[XB_TOP], 1u);
            const unsigned tg = og / nx;
            if (og + 1u == (tg + 1u) * nx) xb_add(&bar[XB_TOPGEN], 1u);
            else XB_SPIN(xb_ld(&bar[XB_TOPGEN]) == tg, bar);
            __builtin_amdgcn_fence(__ATOMIC_ACQUIRE, "agent");
            xb_add(&bar[XB_XGEN(b.x)], 1u);
            asm volatile("s_waitcnt vmcnt(0)" ::: "memory");
        } else {
            XB_SPIN(xb_ld(&bar[XB_XGEN(b.x)]) == gen, bar);
            __builtin_amdgcn_fence(__ATOMIC_ACQUIRE, "agent");
            asm volatile("s_waitcnt vmcnt(0)" ::: "memory");
        }
    }
    __syncthreads();
}

constexpr int NPHASE = 7;
__global__ void __launch_bounds__(NTHREADS, 2) mega_fwd(Params p) {
    extern __shared__ __attribute__((aligned(16))) unsigned char lds[];
    cg::grid_group grid = cg::this_grid();
    const int lo = p.ph_lo, hi = p.ph_hi;
    volatile LAS unsigned* xbst = (volatile LAS unsigned*)(LAS unsigned char*)(lds + LDS_BYTES - 16);
#ifndef REP_MASK
#define REP_MASK 0
#endif
#ifndef P2_PROBE_MODE
#define P2_PROBE_MODE 15
#endif
#ifndef PH_MASK
#define PH_MASK 127
#endif
    if (lo == 0x7fffffff) grid.sync();
    if (threadIdx.x == 0) { xbst[0] = 0u; xbst[1] = 0u; }
    __syncthreads();
    XcdBarrier xb = xcd_barrier_post((unsigned*)(p.ws + WS_BAR), xbst);
#define GSYNC() xcd_barrier(xb)
#if REP_MASK & 1
    p0_prep(p, lds); GSYNC();
#endif
    p0_prep(p, lds);
    GSYNC();
#define RUN_PHASE(k, call) { call; if ((REP_MASK >> (k)) & 1) { GSYNC(); call; } }
#if PH_MASK & 2
    RUN_PHASE(1, p1_inproj(p, lds))
#endif
    GSYNC();
#if PH_MASK & 4
#if (REP_MASK >> 2) & 1
    p2a_indexer(p, lds); GSYNC(); p2_attention<P2_PROBE_MODE>(p, lds, 1); GSYNC();
#endif
    p2a_indexer(p, lds);
    GSYNC();
    p2_attention<15>(p, lds, 0);
#endif
    GSYNC();
#if PH_MASK & 8
    RUN_PHASE(3, p3_outproj(p, lds))
#endif
    GSYNC();
#if PH_MASK & 16
    RUN_PHASE(4, p3b_ln1(p))
#endif
    GSYNC();
#if PH_MASK & 32
    RUN_PHASE(5, p4_peer_query(p, lds))
#endif
    GSYNC();
#if PH_MASK & 64
    p5a_udot<0>(p, lds);
#ifdef P5A_REP
    GSYNC(); p5a_udot<P5A_REP>(p, lds);
#endif
    GSYNC();
    p5b_ffn(p);
#endif
}

#ifndef MK_N_LAUNCHES
#define MK_N_LAUNCHES 1
#endif

extern "C" void kernel_launch(void* const* d_in, const int* in_sizes, int n_in, void* d_out, int out_size, void* d_ws, size_t ws_size, hipStream_t stream) {
    static int grid_blocks = 0;
    if (grid_blocks == 0) {
        if (n_in != 14 || out_size != NTOK * D_MODEL || ws_size < WS_END) {
            fprintf(stderr, "kernel_launch: unexpected problem (n_in %d, out %d, ws %zu, need %zu)\n", n_in, out_size, ws_size, (size_t)WS_END); grid_blocks = -1; return;
        }
        int dev = 0, cus = 0, per_cu = 0;
        hipGetDevice(&dev);
        hipDeviceGetAttribute(&cus, hipDeviceAttributeMultiprocessorCount, dev);
        if (hipFuncSetAttribute((const void*)mega_fwd, hipFuncAttributeMaxDynamicSharedMemorySize, LDS_BYTES) != hipSuccess) { fprintf(stderr, "kernel_launch: hipFuncSetAttribute failed\n"); }
        if (hipOccupancyMaxActiveBlocksPerMultiprocessor(&per_cu, (const void*)mega_fwd, NTHREADS, LDS_BYTES) != hipSuccess || per_cu < 1) { fprintf(stderr, "kernel_launch: occupancy query failed\n"); per_cu = 1; }
        if (per_cu > 2) per_cu = 2;
        (void)hipGetLastError();
        grid_blocks = cus * per_cu;
        fprintf(stderr, "kernel_launch: %d CUs x %d blocks\n", cus, per_cu);
    }
    if (grid_blocks < 0) return;
    Params p{};
    p.x = (const float*)d_in[0]; p.w_in = (const float*)d_in[1]; p.idx_k_g = (const float*)d_in[2]; p.idx_k_b = (const float*)d_in[3]; p.sinks = (const float*)d_in[4];
    p.w_o = (const float*)d_in[5]; p.ln1_g = (const float*)d_in[6]; p.ln1_b = (const float*)d_in[7]; p.peer_wq = (const float*)d_in[8]; p.peer_subkeys = (const float*)d_in[9];
    p.peer_u = (const float*)d_in[10]; p.peer_v = (const float*)d_in[11]; p.ln2_g = (const float*)d_in[12]; p.ln2_b = (const float*)d_in[13];
    p.out = (float*)d_out; p.ws = (unsigned char*)d_ws;
    p.ph_lo = 0; p.ph_hi = NPHASE;
    if (hipMemsetAsync((unsigned char*)d_ws + WS_BAR, 0, 16384 + 64, stream) != hipSuccess) { fprintf(stderr, "kernel_launch: memset of the barrier words failed\n"); return; }
    void* args[] = {&p};
    hipError_t e = hipLaunchCooperativeKernel((const void*)mega_fwd, dim3(grid_blocks), dim3(NTHREADS), args, LDS_BYTES, stream);
    if (e != hipSuccess) fprintf(stderr, "cooperative launch failed: %s (grid %d)\n", hipGetErrorString(e), grid_blocks);
}
```

```cpp
#include <hip/hip_runtime.h>
#include <hip/hip_cooperative_groups.h>
#include <cstdio>
#include <cstdint>
namespace cg = cooperative_groups;

typedef unsigned short bf16_t;
typedef short bf16x8 __attribute__((ext_vector_type(8)));
typedef float f32x4 __attribute__((ext_vector_type(4)));
typedef float f32x16 __attribute__((ext_vector_type(16)));
typedef unsigned u32x4 __attribute__((ext_vector_type(4)));
typedef unsigned u32x2 __attribute__((ext_vector_type(2)));
typedef int i32x8 __attribute__((ext_vector_type(8)));
#define DI __device__ __forceinline__

constexpr int D_MODEL = 1024, BATCH = 8, SEQ = 4096, NTOK = BATCH * SEQ;
constexpr int NMIX = 1732, NMIX_PAD = 1792;
constexpr int P1_F8_COLS = 1408;
constexpr int PEER_N = 2048;
constexpr float ALPHA = 1.189207115002721f;
constexpr float LN_EPS = 1e-5f;
constexpr int NTHREADS = 256;
constexpr int LDS_BYTES = 77824;

constexpr size_t MB = 1024 * 1024;
constexpr size_t WS_CTL   = 0;
constexpr size_t WS_AMAX  = 65536 + 16384;
constexpr size_t WS_BAR   = 65536;
constexpr size_t WS_ROPE  = 1 * MB;
constexpr size_t WS_WINT  = 2 * MB;
constexpr size_t WS_WOT   = 6 * MB;
constexpr size_t WS_WQT   = 8 * MB;
constexpr size_t WS_SK    = 12 * MB;
constexpr size_t WS_UT    = 13 * MB;
constexpr size_t WS_VT    = 29 * MB;
constexpr size_t WS_SU    = 45 * MB;
constexpr size_t WS_SV    = 46 * MB;
constexpr size_t WS_SXR   = 47 * MB + 262144;
constexpr size_t WS_SWN   = 47 * MB + 524288;
constexpr size_t WS_X8    = 282 * MB;
constexpr size_t WS_SX    = 47 * MB;
constexpr size_t WS_XB    = 77 * MB;
constexpr size_t WS_QA    = 141 * MB;
constexpr size_t WS_KA    = 173 * MB;
constexpr size_t WS_VA    = 181 * MB;
constexpr size_t WS_QB    = 189 * MB;
constexpr size_t WS_KB    = 221 * MB;
constexpr size_t WS_VB    = 225 * MB;
constexpr size_t WS_QI    = 229 * MB;
constexpr size_t WS_KI    = 245 * MB;
constexpr size_t WS_WI    = 249 * MB;
constexpr size_t WS_ATT   = 250 * MB;
constexpr size_t WS_PE    = 314 * MB;
constexpr size_t WS_PG    = 322 * MB;
constexpr size_t WS_PS    = 338 * MB;
constexpr size_t WS_END   = 354 * MB;

struct Params {
    const float* x; const float* w_in; const float* idx_k_g; const float* idx_k_b; const float* sinks; const float* w_o;
    const float* ln1_g; const float* ln1_b; const float* peer_wq; const float* peer_subkeys; const float* peer_u; const float* peer_v;
    const float* ln2_g; const float* ln2_b;
    float* out; unsigned char* ws;
    int ph_lo, ph_hi;
};

typedef float f32x2 __attribute__((ext_vector_type(2)));
typedef __bf16 bf16x2_t __attribute__((ext_vector_type(2)));
DI unsigned pack_bf16(float lo, float hi) { const f32x2 v = {lo, hi}; return __builtin_bit_cast(unsigned, __builtin_convertvector(v, bf16x2_t)); }
DI unsigned f2bf(float x) { return pack_bf16(x, 0.f) & 0xffffu; }
DI float bf_lo(unsigned w) { return __uint_as_float(w << 16); }
DI float bf_hi(unsigned w) { return __uint_as_float(w & 0xffff0000u); }
DI bf16x8 as_bf16x8(u32x4 v) { return __builtin_bit_cast(bf16x8, v); }
DI u32x4 ldg16(const void* p) { return *(const u32x4*)p; }
DI f32x4 mfma16(bf16x8 a, bf16x8 b, f32x4 c) { return __builtin_amdgcn_mfma_f32_16x16x32_bf16(a, b, c, 0, 0, 0); }
DI f32x16 mfma32(bf16x8 a, bf16x8 b, f32x16 c) { return __builtin_amdgcn_mfma_f32_32x32x16_bf16(a, b, c, 0, 0, 0); }
DI float wave_sum(float v) {
#pragma unroll
    for (int o = 32; o >= 1; o >>= 1) v += __shfl_xor(v, o);
    return v;
}

DI void glds16(const void* src, void* lds_dst) { __builtin_amdgcn_global_load_lds((const unsigned*)src, (__attribute__((address_space(3))) unsigned*)lds_dst, 16, 0, 0); }
DI void gemm_128x128(const bf16_t* __restrict__ X, int ldx, const bf16_t* __restrict__ Wt, int ldw, int K, unsigned char* lds, f32x4 (&acc)[4][4]) {
    int tid = threadIdx.x; asm volatile("" : "+v"(tid));
    const int lane = tid & 63, wave = tid >> 6, wm = wave >> 1, wn = wave & 1, c = lane & 15, g = lane >> 4;
    const int lrow = tid >> 3, lch = tid & 7;
    const bf16_t* xp = X + (size_t)lrow * ldx + ((lch ^ (lrow & 7)) * 8);
    const bf16_t* wp = Wt + (size_t)lrow * ldw + ((lch ^ (lrow & 7)) * 8);
    unsigned char* dst0 = lds + tid * 16;
#pragma unroll
    for (int m = 0; m < 4; ++m)
#pragma unroll
        for (int n = 0; n < 4; ++n) acc[m][n] = (f32x4){0.f, 0.f, 0.f, 0.f};
    const int nk = K / 64;
    __syncthreads();
#pragma unroll
    for (int i = 0; i < 4; ++i) { glds16(xp + (size_t)(32 * i) * ldx, dst0 + i * 4096); glds16(wp + (size_t)(32 * i) * ldw, dst0 + 16384 + i * 4096); }
    asm volatile("s_waitcnt vmcnt(0)" ::: "memory");
    __syncthreads();
    for (int kt = 0; kt < nk; ++kt) {
        const unsigned char* Xs = lds + (kt & 1) * 32768; const unsigned char* Ws = Xs + 16384;
        if (kt + 1 < nk) {
            unsigned char* d = dst0 + ((kt + 1) & 1) * 32768;
#pragma unroll
            for (int i = 0; i < 4; ++i) { glds16(xp + (size_t)(32 * i) * ldx + (kt + 1) * 64, d + i * 4096); glds16(wp + (size_t)(32 * i) * ldw + (kt + 1) * 64, d + 16384 + i * 4096); }
        }
#pragma unroll
        for (int s = 0; s < 2; ++s) {
            bf16x8 xf[4], wf[4];
#pragma unroll
            for (int m = 0; m < 4; ++m) { const int row = wm * 64 + m * 16 + c; xf[m] = as_bf16x8(*(const u32x4*)(Xs + row * 128 + (((4 * s + g) ^ (c & 7)) << 4))); }
#pragma unroll
            for (int n = 0; n < 4; ++n) { const int row = wn * 64 + n * 16 + c; wf[n] = as_bf16x8(*(const u32x4*)(Ws + row * 128 + (((4 * s + g) ^ (c & 7)) << 4))); }
#pragma unroll
            for (int m = 0; m < 4; ++m)
#pragma unroll
                for (int n = 0; n < 4; ++n) acc[m][n] = mfma16(wf[n], xf[m], acc[m][n]);
        }
        asm volatile("s_waitcnt vmcnt(0)" ::: "memory");
        __syncthreads();
    }
}

DI void gemm8_128x128(const unsigned char* __restrict__ X, int ldx, const unsigned char* __restrict__ Wt, int ldw, int K, unsigned char* lds, f32x4 (&acc)[4][4]) {
    int tid = threadIdx.x; asm volatile("" : "+v"(tid));
    const int lane = tid & 63, wave = tid >> 6, wm = wave >> 1, wn = wave & 1, c = lane & 15, g = lane >> 4;
    const int lrow = tid >> 3, lch = tid & 7;
    const unsigned char* xp = X + (size_t)lrow * ldx + ((lch ^ (lrow & 7)) * 16);
    const unsigned char* wp = Wt + (size_t)lrow * ldw + ((lch ^ (lrow & 7)) * 16);
    unsigned char* dst0 = lds + tid * 16;
#pragma unroll
    for (int m = 0; m < 4; ++m)
#pragma unroll
        for (int n = 0; n < 4; ++n) acc[m][n] = (f32x4){0.f, 0.f, 0.f, 0.f};
    const int nk = K / 128;
    __syncthreads();
#pragma unroll
    for (int i = 0; i < 4; ++i) { glds16(xp + (size_t)(32 * i) * ldx, dst0 + i * 4096); glds16(wp + (size_t)(32 * i) * ldw, dst0 + 16384 + i * 4096); }
    asm volatile("s_waitcnt vmcnt(0)" ::: "memory");
    __syncthreads();
    for (int kt = 0; kt < nk; ++kt) {
        const unsigned char* Xs = lds + (kt & 1) * 32768; const unsigned char* Ws = Xs + 16384;
        if (kt + 1 < nk) {
            unsigned char* d = dst0 + ((kt + 1) & 1) * 32768;
#pragma unroll
            for (int i = 0; i < 4; ++i) { glds16(xp + (size_t)(32 * i) * ldx + (kt + 1) * 128, d + i * 4096); glds16(wp + (size_t)(32 * i) * ldw + (kt + 1) * 128, d + 16384 + i * 4096); }
        }
        i32x8 xf[4], wf[4];
#pragma unroll
        for (int m = 0; m < 4; ++m) {
            const int row = wm * 64 + m * 16 + c;
            const u32x4 lo = *(const u32x4*)(Xs + row * 128 + ((g ^ (c & 7)) << 4)), hi = *(const u32x4*)(Xs + row * 128 + (((4 + g) ^ (c & 7)) << 4));
            xf[m][0] = (int)lo.x; xf[m][1] = (int)lo.y; xf[m][2] = (int)lo.z; xf[m][3] = (int)lo.w; xf[m][4] = (int)hi.x; xf[m][5] = (int)hi.y; xf[m][6] = (int)hi.z; xf[m][7] = (int)hi.w;
        }
#pragma unroll
        for (int n = 0; n < 4; ++n) {
            const int row = wn * 64 + n * 16 + c;
            const u32x4 lo = *(const u32x4*)(Ws + row * 128 + ((g ^ (c & 7)) << 4)), hi = *(const u32x4*)(Ws + row * 128 + (((4 + g) ^ (c & 7)) << 4));
            wf[n][0] = (int)lo.x; wf[n][1] = (int)lo.y; wf[n][2] = (int)lo.z; wf[n][3] = (int)lo.w; wf[n][4] = (int)hi.x; wf[n][5] = (int)hi.y; wf[n][6] = (int)hi.z; wf[n][7] = (int)hi.w;
        }
#pragma unroll
        for (int m = 0; m < 4; ++m)
#pragma unroll
            for (int n = 0; n < 4; ++n) acc[m][n] = __builtin_amdgcn_mfma_scale_f32_16x16x128_f8f6f4(wf[n], xf[m], acc[m][n], 0, 0, 0, 0, 0, 0);
        asm volatile("s_waitcnt vmcnt(0)" ::: "memory");
        __syncthreads();
    }
}

DI bool tile_of(int k, int NT, int MT, int& mt, int& nt) {
    const int G = gridDim.x, bid = blockIdx.x;
    if (((G | MT) & 7) == 0) {
        const int idx = (bid >> 3) + k * (G >> 3);
        if (idx >= (MT >> 3) * NT) return false;
        mt = (idx / NT) * 8 + (bid & 7); nt = idx % NT;
    } else {
        const int t = bid + k * G;
        if (t >= MT * NT) return false;
        mt = t / NT; nt = t % NT;
    }
    return true;
}

DI void p0_prep(const Params& p, unsigned char* lds) {
    const int tid = threadIdx.x, nb = gridDim.x, bid = blockIdx.x;
    const size_t gtid = (size_t)bid * NTHREADS + tid, gsz = (size_t)nb * NTHREADS;
    unsigned char* ws = p.ws;
    constexpr int W_ITEMS = (P1_F8_COLS / 64) * 4 + ((NMIX_PAD - P1_F8_COLS) / 64) * 16;
    const int nwb = nb >= 8 ? (nb / 2 < W_ITEMS ? nb / 2 : W_ITEMS) : nb, nxb = nb >= 8 ? nb - nwb : nb;
    const bool xrole = nb < 8 || bid < nxb, wrole = nb < 8 || bid >= nxb;
    const int wbid = nb >= 8 ? bid - nxb : bid;
    {
        float* ct = (float*)(ws + WS_ROPE); float* stb = ct + SEQ * 32;
        for (size_t i = gtid; i < (size_t)SEQ * 32; i += gsz) {
            const int pos = (int)(i >> 5), fi = (int)(i & 31);
            const float inv = powf(10000.0f, -(float)(2 * fi) / 64.0f);
            const float ang = (float)pos * inv;
            ct[i] = cosf(ang); stb[i] = sinf(ang);
        }
    }
    auto conv = [&](const float* src, bf16_t* dst, size_t n) {
        for (size_t i = gtid * 8; i < n; i += gsz * 8) {
            const f32x4 a = *(const f32x4*)(src + i), b = *(const f32x4*)(src + i + 4);
            u32x4 o; o.x = pack_bf16(a.x, a.y); o.y = pack_bf16(a.z, a.w); o.z = pack_bf16(b.x, b.y); o.w = pack_bf16(b.z, b.w);
            *(u32x4*)(dst + i) = o;
        }
    };
    if ((bid & 7) == 0 || nb < 8) {
        const int sb = nb < 8 ? bid : (bid >> 3), nsb = nb < 8 ? nb : ((nb + 7) >> 3);
        float m = 0.f;
        for (size_t i = ((size_t)sb * NTHREADS + tid) * 4; i < (size_t)1024 * 1024; i += (size_t)nsb * NTHREADS * 4) { const f32x4 v = *(const f32x4*)(p.w_o + i); m = fmaxf(m, fmaxf(fmaxf(fabsf(v[0]), fabsf(v[1])), fmaxf(fabsf(v[2]), fabsf(v[3])))); }
#pragma unroll
        for (int o = 32; o >= 1; o >>= 1) m = fmaxf(m, __shfl_xor(m, o));
        float* red = (float*)lds;
        __syncthreads();
        if ((tid & 63) == 0) red[tid >> 6] = m;
        __syncthreads();
        if (tid == 0) { const float mm = fmaxf(fmaxf(red[0], red[1]), fmaxf(red[2], red[3])); if (mm > 0.f) atomicMax((unsigned*)(ws + WS_AMAX), __float_as_uint(mm)); }
        __syncthreads();
    }
    if (xrole) {
        const int lane = tid & 63, gw = bid * 4 + (tid >> 6), nw = nxb * 4;
        bf16_t* XBo = (bf16_t*)(ws + WS_XB); unsigned char* X8o = ws + WS_X8; float* SXRo = (float*)(ws + WS_SXR);
        for (int row0 = gw * 4; row0 < NTOK; row0 += nw * 4) {
            f32x4 v[4][4];
#pragma unroll
            for (int r = 0; r < 4; ++r)
#pragma unroll
                for (int i = 0; i < 4; ++i) v[r][i] = *(const f32x4*)(p.x + (size_t)(row0 + r) * 1024 + lane * 16 + 4 * i);
#pragma unroll
            for (int r = 0; r < 4; ++r) {
                const int row = row0 + r;
                float m = 0.f;
#pragma unroll
                for (int i = 0; i < 4; ++i) m = fmaxf(m, fmaxf(fmaxf(fabsf(v[r][i][0]), fabsf(v[r][i][1])), fmaxf(fabsf(v[r][i][2]), fabsf(v[r][i][3]))));
#pragma unroll
                for (int o = 32; o >= 1; o >>= 1) m = fmaxf(m, __shfl_xor(m, o));
                const float sc = m > 0.f ? 439.f / m : 1.f;
                u32x4 o0, o1, q8;
                o0.x = pack_bf16(v[r][0][0], v[r][0][1]); o0.y = pack_bf16(v[r][0][2], v[r][0][3]); o0.z = pack_bf16(v[r][1][0], v[r][1][1]); o0.w = pack_bf16(v[r][1][2], v[r][1][3]);
                o1.x = pack_bf16(v[r][2][0], v[r][2][1]); o1.y = pack_bf16(v[r][2][2], v[r][2][3]); o1.z = pack_bf16(v[r][3][0], v[r][3][1]); o1.w = pack_bf16(v[r][3][2], v[r][3][3]);
#pragma unroll
                for (int i = 0; i < 4; ++i) {
                    int pk = __builtin_amdgcn_cvt_pk_fp8_f32(v[r][i][0] * sc, v[r][i][1] * sc, 0, false);
                    pk = __builtin_amdgcn_cvt_pk_fp8_f32(v[r][i][2] * sc, v[r][i][3] * sc, pk, true);
                    q8[i] = (unsigned)pk;
                }
                *(u32x4*)(XBo + (size_t)row * 1024 + lane * 16) = o0; *(u32x4*)(XBo + (size_t)row * 1024 + lane * 16 + 8) = o1;
                *(u32x4*)(X8o + (size_t)row * 1024 + lane * 16) = q8;
                if (lane == 0) SXRo[row] = m > 0.f ? m * (1.f / 439.f) : 1.f;
            }
        }
    }
    conv(p.peer_subkeys, (bf16_t*)(ws + WS_SK), (size_t)8 * 2 * 128 * 128);
    float* tl = (float*)lds;
    auto transp = [&](const float* src, bf16_t* dst, int N, int Npad, int nt0) {
        const int tn = Npad / 64 - nt0, tk = 1024 / 64;
        for (int t = wbid - (P1_F8_COLS / 64) * 4; t < tn * tk; t += nwb) {
            if (t < 0) continue;
            const int n0 = (nt0 + t % tn) * 64, k0 = (t / tn) * 64;
            __syncthreads();
            for (int e = tid; e < 4096; e += NTHREADS) { const int kk = e >> 6, nn = e & 63; tl[kk * 65 + nn] = (n0 + nn < N) ? src[(size_t)(k0 + kk) * N + n0 + nn] : 0.f; }
            __syncthreads();
            for (int e = tid; e < 4096; e += NTHREADS) { const int nn = e >> 6, kk = e & 63; dst[(size_t)(n0 + nn) * 1024 + k0 + kk] = (bf16_t)f2bf(tl[kk * 65 + nn]); }
        }
    };
    if (wrole) transp(p.w_in, (bf16_t*)(ws + WS_WINT), NMIX, NMIX_PAD, P1_F8_COLS / 64);
    if (wrole) {
        unsigned char* w8 = ws + WS_WINT; float* swn = (float*)(ws + WS_SWN);
        float* cm = (float*)lds + 64 * 65;
        for (int item = wbid; item < (P1_F8_COLS / 64) * 4; item += nwb) {
            const int n0 = (item >> 2) * 64, kpart = item & 3;
            {
                const int n4 = (tid & 15) * 4, kq = tid >> 4;
                f32x4 m4 = {0.f, 0.f, 0.f, 0.f};
#pragma unroll 8
                for (int k2 = kq; k2 < 1024; k2 += 16) {
                    const f32x4 v = *(const f32x4*)(p.w_in + (size_t)k2 * NMIX + n0 + n4);
                    m4[0] = fmaxf(m4[0], fabsf(v[0])); m4[1] = fmaxf(m4[1], fabsf(v[1])); m4[2] = fmaxf(m4[2], fabsf(v[2])); m4[3] = fmaxf(m4[3], fabsf(v[3]));
                }
                __syncthreads();
                *(f32x4*)(cm + kq * 64 + n4) = m4;
                __syncthreads();
                if (tid < 64) {
                    float a = 0.f;
#pragma unroll
                    for (int r = 0; r < 16; ++r) a = fmaxf(a, cm[r * 64 + tid]);
                    cm[1024 + tid] = a > 0.f ? 439.f / a : 1.f;
                    if (kpart == 0) swn[n0 + tid] = a > 0.f ? a * (1.f / 439.f) : 1.f;
                }
            }
            for (int k0 = kpart * 256; k0 < kpart * 256 + 256; k0 += 64) {
                __syncthreads();
                for (int e = tid; e < 4096; e += NTHREADS) { const int kk = e >> 6, n2 = e & 63; tl[kk * 65 + n2] = p.w_in[(size_t)(k0 + kk) * NMIX + n0 + n2]; }
                __syncthreads();
                for (int e = tid; e < 1024; e += NTHREADS) {
                    const int n2 = e >> 4, kq4 = (e & 15) * 4; const float sc = cm[1024 + n2];
                    int pk = __builtin_amdgcn_cvt_pk_fp8_f32(tl[kq4 * 65 + n2] * sc, tl[(kq4 + 1) * 65 + n2] * sc, 0, false);
                    pk = __builtin_amdgcn_cvt_pk_fp8_f32(tl[(kq4 + 2) * 65 + n2] * sc, tl[(kq4 + 3) * 65 + n2] * sc, pk, true);
                    *(int*)(w8 + (size_t)(n0 + n2) * 1024 + k0 + kq4) = pk;
                }
            }
        }
    }
}

DI void p0_late(const Params& p, unsigned char* lds) {
    const int tid = threadIdx.x, nb = gridDim.x, bid = blockIdx.x;
    unsigned char* ws = p.ws;
    {
        const int lane = tid & 63, gw = bid * 4 + (tid >> 6), nw = nb * 4;
        for (int row0 = gw * 4; row0 < 2 * 16384; row0 += nw * 4) {
            f32x4 v[4][4];
#pragma unroll
            for (int r = 0; r < 4; ++r) {
                const int row = row0 + r; const bool isv = row >= 16384; const int e = isv ? row - 16384 : row;
                const float* src = (isv ? p.peer_v : p.peer_u) + (size_t)e * 1024 + lane * 16;
#pragma unroll
                for (int i = 0; i < 4; ++i) v[r][i] = *(const f32x4*)(src + 4 * i);
            }
#pragma unroll
            for (int r = 0; r < 4; ++r) {
                const int row = row0 + r; const bool isv = row >= 16384; const int e = isv ? row - 16384 : row;
                float mx = 0.f;
#pragma unroll
                for (int i = 0; i < 4; ++i) mx = fmaxf(mx, fmaxf(fmaxf(fabsf(v[r][i][0]), fabsf(v[r][i][1])), fmaxf(fabsf(v[r][i][2]), fabsf(v[r][i][3]))));
#pragma unroll
                for (int o = 32; o >= 1; o >>= 1) mx = fmaxf(mx, __shfl_xor(mx, o));
                const float sc = mx > 0.f ? mx * (1.0f / 5.99f) : 1.0f, inv = mx > 0.f ? 5.99f / mx : 1.0f;
                u32x2 o2;
#pragma unroll
                for (int k = 0; k < 2; ++k) {
                    unsigned w = 0;
                    w = __builtin_amdgcn_cvt_scalef32_pk_fp4_f32(w, v[r][2 * k][0] * inv, v[r][2 * k][1] * inv, 1.0f, 0);
                    w = __builtin_amdgcn_cvt_scalef32_pk_fp4_f32(w, v[r][2 * k][2] * inv, v[r][2 * k][3] * inv, 1.0f, 1);
                    w = __builtin_amdgcn_cvt_scalef32_pk_fp4_f32(w, v[r][2 * k + 1][0] * inv, v[r][2 * k + 1][1] * inv, 1.0f, 2);
                    w = __builtin_amdgcn_cvt_scalef32_pk_fp4_f32(w, v[r][2 * k + 1][2] * inv, v[r][2 * k + 1][3] * inv, 1.0f, 3);
                    o2[k] = w;
                }
                *(u32x2*)(ws + (isv ? WS_VT : WS_UT) + (size_t)e * 512 + lane * 8) = o2;
                if (lane == 0) ((float*)(ws + (isv ? WS_SV : WS_SU)))[e] = sc;
            }
        }
    }
    float* tl = (float*)lds;
    auto transp = [&](const float* src, bf16_t* dst, int N, int Npad) {
        const int tn = Npad / 64, tk = 1024 / 64;
        for (int t = bid; t < tn * tk; t += nb) {
            const int n0 = (t % tn) * 64, k0 = (t / tn) * 64;
            __syncthreads();
            for (int e = tid; e < 4096; e += NTHREADS) { const int kk = e >> 6, nn = e & 63; tl[kk * 65 + nn] = (n0 + nn < N) ? src[(size_t)(k0 + kk) * N + n0 + nn] : 0.f; }
            __syncthreads();
            for (int e = tid; e < 4096; e += NTHREADS) { const int nn = e >> 6, kk = e & 63; dst[(size_t)(n0 + nn) * 1024 + k0 + kk] = (bf16_t)f2bf(tl[kk * 65 + nn]); }
        }
    };
    {
        const float amax = __uint_as_float(*(const unsigned*)(ws + WS_AMAX)), sw = amax > 0.f ? 439.f / amax : 1.f;
        unsigned char* dst8 = ws + WS_WOT;
        for (int t = bid; t < 16 * 16; t += nb) {
            const int n0 = (t % 16) * 64, k0 = (t / 16) * 64;
            __syncthreads();
            for (int e = tid; e < 4096; e += NTHREADS) { const int kk = e >> 6, nn = e & 63; tl[kk * 65 + nn] = p.w_o[(size_t)(k0 + kk) * 1024 + n0 + nn]; }
            __syncthreads();
            for (int e = tid; e < 1024; e += NTHREADS) {
                const int nn = e >> 4, kq = (e & 15) * 4;
                int pk = __builtin_amdgcn_cvt_pk_fp8_f32(tl[kq * 65 + nn] * sw, tl[(kq + 1) * 65 + nn] * sw, 0, false);
                pk = __builtin_amdgcn_cvt_pk_fp8_f32(tl[(kq + 2) * 65 + nn] * sw, tl[(kq + 3) * 65 + nn] * sw, pk, true);
                *(int*)(dst8 + (size_t)(n0 + nn) * 1024 + k0 + kq) = pk;
            }
        }
    }
    transp(p.peer_wq, (bf16_t*)(ws + WS_WQT), PEER_N, PEER_N);
}

DI void p1_inproj(const Params& p, unsigned char* lds) {
    unsigned char* ws = p.ws;
    const bf16_t* XB = (const bf16_t*)(ws + WS_XB); const bf16_t* WT = (const bf16_t*)(ws + WS_WINT);
    const float* cosT = (const float*)(ws + WS_ROPE); const float* sinT = cosT + SEQ * 32;
    const int tid = threadIdx.x, lane = tid & 63, wave = tid >> 6, wm = wave >> 1, wn = wave & 1, c = lane & 15, g = lane >> 4;
    constexpr int NT = NMIX_PAD / 128, MT = NTOK / 128;
    int mt, nt;
    for (int k = 0; tile_of(k, NT, MT, mt, nt); ++k) {
        f32x4 acc[4][4];
        const bool f8 = nt < P1_F8_COLS / 128;
        if (f8) gemm8_128x128(ws + WS_X8 + (size_t)mt * 128 * 1024, 1024, ws + WS_WINT + (size_t)nt * 128 * 1024, 1024, 1024, lds, acc);
        else gemm_128x128(XB + (size_t)mt * 128 * 1024, 1024, WT + (size_t)nt * 128 * 1024, 1024, 1024, lds, acc);
        f32x4 swn4[4];
#pragma unroll
        for (int n = 0; n < 4; ++n) swn4[n] = f8 ? *(const f32x4*)((const float*)(ws + WS_SWN) + nt * 128 + wn * 64 + 16 * n + 4 * g) : (f32x4){1.f, 1.f, 1.f, 1.f};
        const int col64 = nt * 2 + wn;
        bf16_t* dst; int ld, coff; bool rope = true; float scale = 1.f; float vmax = 0.f;
        if (col64 < 8)       { dst = (bf16_t*)(ws + WS_QA); ld = 512; coff = col64 * 64; scale = 0.125f; }
        else if (col64 < 10) { dst = (bf16_t*)(ws + WS_KA); ld = 128; coff = (col64 - 8) * 64; }
        else if (col64 < 12) { dst = (bf16_t*)(ws + WS_VA); ld = 128; coff = (col64 - 10) * 64; rope = false; }
        else if (col64 < 20) { dst = (bf16_t*)(ws + WS_QB); ld = 512; coff = (col64 - 12) * 64; scale = 0.125f; }
        else if (col64 == 20) { dst = (bf16_t*)(ws + WS_KB); ld = 64; coff = 0; }
        else if (col64 == 21) { dst = (bf16_t*)(ws + WS_VB); ld = 64; coff = 0; rope = false; }
        else if (col64 < 26) { dst = (bf16_t*)(ws + WS_QI); ld = 256; coff = (col64 - 22) * 64; }
        else                 { dst = (bf16_t*)(ws + WS_KI); ld = 64; coff = 0; }
        if (col64 == 27) {
            if (g == 0) {
#pragma unroll
                for (int m = 0; m < 4; ++m) { const int tok = mt * 128 + wm * 64 + m * 16 + c; *(f32x4*)((float*)(ws + WS_WI) + (size_t)tok * 4) = acc[m][0] * 0.0625f; }
            }
            continue;
        }
#pragma unroll
        for (int m = 0; m < 4; ++m) {
            const int tok = mt * 128 + wm * 64 + m * 16 + c, pos = tok & (SEQ - 1);
            const float sxr = f8 ? ((const float*)(ws + WS_SXR))[tok] : 1.f;
            f32x4 v[4] = {acc[m][0] * (swn4[0] * sxr), acc[m][1] * (swn4[1] * sxr), acc[m][2] * (swn4[2] * sxr), acc[m][3] * (swn4[3] * sxr)};
            if (col64 == 26) {
                float s = 0.f;
#pragma unroll
                for (int n = 0; n < 4; ++n) s += (v[n][0] + v[n][1]) + (v[n][2] + v[n][3]);
                s += __shfl_xor(s, 16); s += __shfl_xor(s, 32);
                const float mu = s * (1.f / 64.f); float q = 0.f;
#pragma unroll
                for (int n = 0; n < 4; ++n) { const f32x4 d = v[n] - mu; q += (d[0] * d[0] + d[1] * d[1]) + (d[2] * d[2] + d[3] * d[3]); }
                q += __shfl_xor(q, 16); q += __shfl_xor(q, 32);
                const float rstd = rsqrtf(q * (1.f / 64.f) + LN_EPS);
#pragma unroll
                for (int n = 0; n < 4; ++n) {
                    const f32x4 gg = *(const f32x4*)(p.idx_k_g + 16 * n + 4 * g), bb = *(const f32x4*)(p.idx_k_b + 16 * n + 4 * g);
                    v[n] = (v[n] - mu) * rstd * gg + bb;
                }
            }
            if (rope) {
#pragma unroll
                for (int n = 0; n < 2; ++n) {
                    const f32x4 cs = *(const f32x4*)(cosT + pos * 32 + 16 * n + 4 * g), sn = *(const f32x4*)(sinT + pos * 32 + 16 * n + 4 * g);
                    const f32x4 t1 = v[n], t2 = v[n + 2];
                    v[n] = t1 * cs - t2 * sn; v[n + 2] = t2 * cs + t1 * sn;
                }
            }
#pragma unroll
            for (int n = 0; n < 4; ++n) {
                const f32x4 o = v[n] * scale; u32x2 w; w.x = pack_bf16(o[0], o[1]); w.y = pack_bf16(o[2], o[3]);
                *(u32x2*)(dst + (size_t)tok * ld + coff + 16 * n + 4 * g) = w;
                if (!rope) vmax = fmaxf(vmax, fmaxf(fmaxf(fabsf(o[0]), fabsf(o[1])), fmaxf(fabsf(o[2]), fabsf(o[3]))));
            }
        }
        if (!rope) {
#pragma unroll
            for (int o = 32; o >= 1; o >>= 1) vmax = fmaxf(vmax, __shfl_xor(vmax, o));
            if (lane == 0 && vmax > 0.f) atomicMax((unsigned*)(ws + WS_AMAX) + 1, __float_as_uint(vmax));
        }
    }
}

constexpr int NDSA = NTOK / 4, NSWA = BATCH * 32 * 8;
constexpr int P2_STG = 0  , P2_LIST = 32768;

DI unsigned f16_key(float v) {
    _Float16 hv = (_Float16)v; unsigned short hb = __builtin_bit_cast(unsigned short, hv); unsigned b = hb;
    if (b == 0x8000u) b = 0u;
    return (b & 0x8000u) ? ((~b) & 0xffffu) : (b | 0x8000u);
}

DI size_t sc_row_off(int t) { const size_t m = (size_t)(t >> 3); return 8 * (4 * m * (m + 1) + (size_t)(t & 7) * (m + 1)); }
constexpr size_t SC_BATCH = 8404992;
DI unsigned short* sc_batch_base(const Params& p, int b) { return (b < 7) ? (unsigned short*)p.out + (size_t)b * SC_BATCH : (unsigned short*)(p.ws + WS_PG); }

DI void p2a_indexer(const Params& p, unsigned char* lds) {
    unsigned char* ws = p.ws;
    const bf16_t* QI = (const bf16_t*)(ws + WS_QI); const bf16_t* KI = (const bf16_t*)(ws + WS_KI); const float* WI = (const float*)(ws + WS_WI);
    const int G = gridDim.x, bi = blockIdx.x;
    for (int it = 0; it < 2; ++it) {
        const int item = (it == 0) ? bi : 1023 - bi;
        for (int id = (G == 512) ? item : bi + it * G; id < 1024; id += (G == 512) ? 1024 : 2 * G) {
            int tid = threadIdx.x; asm volatile("" : "+v"(tid));
            const int lane = tid & 63, wave = tid >> 6, c = lane & 15, g = lane >> 4, lrow = tid >> 3, lch = tid & 7;
            const int b = id >> 7, t0 = (id & 127) * 32, tokw = b * SEQ + t0 + 8 * wave;
            unsigned short* scb = sc_batch_base(p, b);
            bf16x8 af[2][2]; f32x4 wv[2];
#pragma unroll
            for (int rt = 0; rt < 2; ++rt) {
#pragma unroll
                for (int s2 = 0; s2 < 2; ++s2) af[rt][s2] = as_bf16x8(ldg16(QI + (size_t)(tokw + 4 * rt + (c >> 2)) * 256 + (c & 3) * 64 + 32 * s2 + 8 * g));
                wv[rt] = *(const f32x4*)(WI + (size_t)(tokw + 4 * rt + g) * 4);
            }
            asm volatile("" :: "v"(af[0][0]), "v"(af[0][1]), "v"(af[1][0]), "v"(af[1][1]), "v"(wv[0]), "v"(wv[1]));
            const int nkt = ((t0 + 31) >> 7) + 1;
            const unsigned char* kib = (const unsigned char*)(KI + (size_t)b * SEQ * 64);
            unsigned char* dst0 = lds + tid * 16;
            auto stage = [&](int kt, int buf) {
#pragma unroll
                for (int i = 0; i < 4; ++i) {
                    const int row = lrow + 32 * i;
                    glds16(kib + (size_t)(kt * 128 + row) * 128 + ((lch ^ ((row >> 3) & 7)) << 4), dst0 + buf * 16384 + i * 4096);
                }
            };
            __syncthreads();
            stage(0, 0); if (nkt > 1) stage(1, 1);
            for (int kt = 0; kt < nkt; ++kt) {
                if (kt + 1 < nkt) asm volatile("s_waitcnt vmcnt(4)" ::: "memory");
                else asm volatile("s_waitcnt vmcnt(0)" ::: "memory");
                asm volatile("s_waitcnt lgkmcnt(0)" ::: "memory");
                __builtin_amdgcn_s_barrier();
                if (kt + 2 < nkt) stage(kt + 2, (kt + 2) % 3);
                const unsigned char* Ks = lds + (kt % 3) * 16384;
                unsigned res[2][4];
#pragma unroll
                for (int ct = 0; ct < 8; ++ct) {
                    const int row = 8 * c + ct;
                    const bf16x8 k0 = as_bf16x8(*(const u32x4*)(Ks + row * 128 + ((g ^ (c & 7)) << 4)));
                    const bf16x8 k1 = as_bf16x8(*(const u32x4*)(Ks + row * 128 + (((4 + g) ^ (c & 7)) << 4)));
#pragma unroll
                    for (int rt = 0; rt < 2; ++rt) {
                        f32x4 d = mfma16(af[rt][0], k0, (f32x4){0.f, 0.f, 0.f, 0.f});
                        d = mfma16(af[rt][1], k1, d);
                        const float sv = wv[rt][0] * fmaxf(d[0], 0.f) + wv[rt][1] * fmaxf(d[1], 0.f) + wv[rt][2] * fmaxf(d[2], 0.f) + wv[rt][3] * fmaxf(d[3], 0.f);
                        const int key = kt * 128 + row, tq = t0 + 8 * wave + 4 * rt + g;
                        const unsigned kv = (key <= tq) ? f16_key(sv) : 0u;
                        if (ct & 1) res[rt][ct >> 1] |= kv << 16; else res[rt][ct >> 1] = kv;
                    }
                }
#pragma unroll
                for (int rt = 0; rt < 2; ++rt) {
                    const int tq = t0 + 8 * wave + 4 * rt + g;
                    if (16 * kt + c <= (tq >> 3)) {
                        u32x4 w; w.x = res[rt][0]; w.y = res[rt][1]; w.z = res[rt][2]; w.w = res[rt][3];
                        *(u32x4*)(scb + sc_row_off(tq) + kt * 128 + 8 * c) = w;
                    }
                }
            }
        }
    }
    __syncthreads();
    p0_late(p, lds);
}

template <int MODE> DI void p2_dsa_item(const Params& p, unsigned char* lds, int b, int tb) {
    unsigned char* ws = p.ws;
    const bf16_t* QI = (const bf16_t*)(ws + WS_QI); const bf16_t* KI = (const bf16_t*)(ws + WS_KI); const float* WI = (const float*)(ws + WS_WI);
    const bf16_t* QB = (const bf16_t*)(ws + WS_QB); const bf16_t* KB = (const bf16_t*)(ws + WS_KB); const bf16_t* VB = (const bf16_t*)(ws + WS_VB);
    unsigned char* ATT8 = ws + WS_ATT;
    const float sa8 = 439.f / fmaxf(__uint_as_float(*(const unsigned*)(ws + WS_AMAX + 4)), 1e-30f);
    int tid = threadIdx.x; asm volatile("" : "+v"(tid));
    const int lane = tid & 63, wave = __builtin_amdgcn_readfirstlane(tid >> 6), c = lane & 15, g = lane >> 4;
    const int t0 = tb * 4, tok0 = b * SEQ + t0;
    unsigned char* stg = lds + P2_STG + wave * 8192;
    unsigned* hist = (unsigned*)stg;
    unsigned short* list = (unsigned short*)(lds + P2_LIST) + wave * 256;
    const int tok = tok0 + wave;
    if (!(MODE & 2)) return;
    const int n = t0 + wave + 1;
    const int L = n < 256 ? n : 256;
    const unsigned short* myk = sc_batch_base(p, b) + sc_row_off(t0 + wave);
    if (n <= 256) {
        for (int i = lane; i < n; i += 64) list[i] = (unsigned short)i;
    } else {
        u32x4 kk[8];
#pragma unroll
        for (int i = 0; i < 8; ++i) kk[i] = (512 * i + 8 * lane < n) ? ldg16(myk + 512 * i + 8 * lane) : (u32x4){0u, 0u, 0u, 0u};
#pragma unroll
        for (int i = 0; i < 4; ++i) *(u32x4*)(hist + lane * 16 + i * 4) = (u32x4){0u, 0u, 0u, 0u};
#pragma unroll
        for (int i = 0; i < 8; ++i) {
            if (512 * i < n) {
#pragma unroll
                for (int w = 0; w < 4; ++w) { const unsigned wd = kk[i][w]; atomicAdd(&hist[(wd & 0xffffu) >> 6], 1u); atomicAdd(&hist[wd >> 22], 1u); }
            }
        }
        unsigned h[16];
#pragma unroll
        for (int i = 0; i < 4; ++i) { const u32x4 t = *(const u32x4*)(hist + lane * 16 + i * 4); h[4 * i] = t.x; h[4 * i + 1] = t.y; h[4 * i + 2] = t.z; h[4 * i + 3] = t.w; }
#pragma unroll
        for (int i = 0; i < 4; ++i) *(u32x4*)(hist + lane * 16 + i * 4) = (u32x4){0u, 0u, 0u, 0u};
        unsigned sl = 0;
#pragma unroll
        for (int i = 0; i < 16; ++i) sl += h[i];
        unsigned pre = sl;
#pragma unroll
        for (int o = 1; o < 64; o <<= 1) { const unsigned t = __shfl_up(pre, o); if (lane >= o) pre += t; }
        const unsigned tot = __shfl(pre, 63);
        const unsigned suf = tot - pre;
        int found = -1; unsigned cab = 0, cum = suf;
#pragma unroll
        for (int j = 15; j >= 0; --j) { const bool hit = (found < 0) && (cum + h[j] >= 256u); if (hit) { found = lane * 16 + j; cab = cum; } cum += h[j]; }
        const bool mine = (suf < 256u) && (suf + sl >= 256u);
        const unsigned long long mm = __ballot(mine);
        const int src = __ffsll((long long)mm) - 1;
        const unsigned bstar = (unsigned)__shfl(found, src), cabove = __shfl(cab, src);
        const unsigned r1 = 256u - cabove;
#pragma unroll
        for (int i = 0; i < 8; ++i) {
            if (512 * i < n) {
#pragma unroll
                for (int w = 0; w < 4; ++w) {
                    const unsigned wd = kk[i][w];
                    if (((wd & 0xffffu) >> 6) == bstar) atomicAdd(&hist[wd & 63u], 1u);
                    if ((wd >> 22) == bstar) atomicAdd(&hist[(wd >> 16) & 63u], 1u);
                }
            }
        }
        const unsigned cnt = hist[lane];
        hist[lane] = 0u;
        unsigned pre2 = cnt;
#pragma unroll
        for (int o = 1; o < 64; o <<= 1) { const unsigned t = __shfl_up(pre2, o); if (lane >= o) pre2 += t; }
        const unsigned tot2 = __shfl(pre2, 63);
        const unsigned suf2 = tot2 - pre2;
        const bool mine2 = (suf2 < r1) && (suf2 + cnt >= r1);
        const unsigned long long mm2 = __ballot(mine2);
        const int src2 = __ffsll((long long)mm2) - 1;
        const unsigned T = (bstar << 6) | (unsigned)src2;
        const unsigned req = r1 - __shfl(suf2, src2);
        const unsigned toteq = __shfl(cnt, src2);
        const bool alleq = (req == toteq);
        const unsigned Tt = alleq ? T : T + 1u;
        unsigned cg = 0;
#pragma unroll
        for (int i = 0; i < 8; ++i)
#pragma unroll
            for (int w = 0; w < 4; ++w) { const unsigned wd = kk[i][w]; cg += ((wd & 0xffffu) >= Tt) ? 1u : 0u; cg += ((wd >> 16) >= Tt) ? 1u : 0u; }
        unsigned pre3 = cg;
#pragma unroll
        for (int o = 1; o < 64; o <<= 1) { const unsigned t = __shfl_up(pre3, o); if (lane >= o) pre3 += t; }
        unsigned off = pre3 - cg;
#pragma unroll
        for (int i = 0; i < 8; ++i)
#pragma unroll
            for (int w = 0; w < 4; ++w) {
                const unsigned wd = kk[i][w]; const int idx = 512 * i + 8 * lane + 2 * w;
                if ((wd & 0xffffu) >= Tt) { list[off & 255u] = (unsigned short)idx; ++off; }
                if ((wd >> 16) >= Tt) { list[off & 255u] = (unsigned short)(idx + 1); ++off; }
            }
        if (!alleq) {
            const unsigned cgt = 256u - req; unsigned eq_run = 0;
            for (int base = 0; base < n; base += 64) {
                const int i = base + lane; const unsigned m = (i < n) ? myk[i] : 0u;
                const bool eq = (m == T);
                const unsigned long long eqm = __ballot(eq);
                const unsigned rank = eq_run + __builtin_amdgcn_mbcnt_hi((unsigned)(eqm >> 32), __builtin_amdgcn_mbcnt_lo((unsigned)eqm, 0u));
                if (eq && rank < req) list[cgt + rank] = (unsigned short)i;
                eq_run += (unsigned)__popcll(eqm);
            }
        }
    }
    if (!(MODE & 4)) return;
    bf16x8 qf[2], sel[2];
#pragma unroll
    for (int s = 0; s < 2; ++s) {
        u32x4 t = (u32x4){0u, 0u, 0u, 0u};
        if (c < 8) t = ldg16(QB + (size_t)tok * 512 + c * 64 + 32 * s + 8 * g);
        qf[s] = as_bf16x8(t);
#pragma unroll
        for (int j = 0; j < 8; ++j) sel[s][j] = (8 * g + j == 16 * s + c) ? (short)0x3F80 : (short)0;
    }
    f32x4 st[16];
    const unsigned char* kbb = (const unsigned char*)(KB + (size_t)b * SEQ * 64); const unsigned char* vbb = (const unsigned char*)(VB + (size_t)b * SEQ * 64);
    const int lr = lane >> 3, lc = lane & 7;
    const unsigned st_off = lr * 128 + ((lc ^ lr) << 4);
    auto loadg = [&](const unsigned char* base, int T0, u32x4 (&dst)[8]) {
#pragma unroll
        for (int i = 0; i < 8; ++i) {
            const int idx = T0 * 16 + i * 8 + lr; const unsigned kid = (idx < L) ? (unsigned)list[idx] : 0u;
            dst[i] = ldg16(base + kid * 128u + lc * 16u);
        }
    };
    auto stage = [&](const u32x4 (&src)[8]) {
#pragma unroll
        for (int i = 0; i < 8; ++i) *(u32x4*)(stg + i * 1024 + st_off) = src[i];
    };
    auto frag = [&](int u, int s2) -> bf16x8 { return as_bf16x8(*(const u32x4*)(stg + (16 * u + c) * 128 + (((4 * s2 + g) ^ (c & 7)) << 4))); };
    auto scoreK = [&](int T0) {
#pragma unroll
        for (int T = 0; T < 4; ++T) {
            f32x4 d = mfma16(frag(T, 0), qf[0], (f32x4){0.f, 0.f, 0.f, 0.f});
            st[T0 + T] = mfma16(frag(T, 1), qf[1], d);
        }
    };
    u32x4 rA[8], rB[8], rC[8], rD[8];
    loadg(kbb, 0, rA); loadg(kbb, 4, rB); loadg(kbb, 8, rC); loadg(kbb, 12, rD);
    __builtin_amdgcn_sched_barrier(0);
    stage(rA); scoreK(0);
    stage(rB); scoreK(4);
    __builtin_amdgcn_sched_barrier(0);
    loadg(vbb, 0, rA); loadg(vbb, 4, rB);
    stage(rC); scoreK(8);
    stage(rD); scoreK(12);
    __builtin_amdgcn_sched_barrier(0);
    float mx = -3.0e38f;
    {
        const int lrem = L - 4 * g;
#pragma unroll
        for (int T = 0; T < 16; ++T)
#pragma unroll
            for (int r = 0; r < 4; ++r) { const float sv = (T * 16 + r < lrem) ? st[T][r] : -3.0e38f; st[T][r] = sv; mx = fmaxf(mx, sv); }
    }
    mx = fmaxf(mx, __shfl_xor(mx, 16)); mx = fmaxf(mx, __shfl_xor(mx, 32));
    float lsum = 0.f;
#pragma unroll
    for (int T = 0; T < 16; ++T)
#pragma unroll
        for (int r = 0; r < 4; ++r) { const float e = __expf(st[T][r] - mx); st[T][r] = e; lsum += e; }
    lsum += __shfl_xor(lsum, 16); lsum += __shfl_xor(lsum, 32);
    const float rl = 1.0f / lsum;
    u32x4 pfv[8];
#pragma unroll
    for (int u = 0; u < 8; ++u) {
        const int Ta = 2 * u, Tb = Ta + 1;
        pfv[u].x = pack_bf16(st[Ta][0] * rl, st[Ta][1] * rl); pfv[u].y = pack_bf16(st[Ta][2] * rl, st[Ta][3] * rl);
        pfv[u].z = pack_bf16(st[Tb][0] * rl, st[Tb][1] * rl); pfv[u].w = pack_bf16(st[Tb][2] * rl, st[Tb][3] * rl);
    }
    __builtin_amdgcn_sched_barrier(0);
    f32x4 O[4];
#pragma unroll
    for (int cb = 0; cb < 4; ++cb) O[cb] = (f32x4){0.f, 0.f, 0.f, 0.f};
    auto pv = [&](int T0) {
#pragma unroll
        for (int u = 0; u < 2; ++u) {
            const u32x4 pf = pfv[(T0 >> 1) + u];
#pragma unroll
            for (int cb = 0; cb < 4; ++cb) {
                const f32x4 z = (f32x4){0.f, 0.f, 0.f, 0.f};
                const f32x4 v0 = mfma16(frag(2 * u, cb >> 1), sel[cb & 1], z), v1 = mfma16(frag(2 * u + 1, cb >> 1), sel[cb & 1], z);
                u32x4 vf; vf.x = pack_bf16(v0[0], v0[1]); vf.y = pack_bf16(v0[2], v0[3]); vf.z = pack_bf16(v1[0], v1[1]); vf.w = pack_bf16(v1[2], v1[3]);
                O[cb] = mfma16(as_bf16x8(pf), as_bf16x8(vf), O[cb]);
            }
        }
    };
    loadg(vbb, 8, rC); loadg(vbb, 12, rD);
    __builtin_amdgcn_sched_barrier(0);
    stage(rA); pv(0);
    stage(rB); pv(4);
    __builtin_amdgcn_sched_barrier(0);
    stage(rC); pv(8);
    stage(rD); pv(12);
    if (g < 2) {
#pragma unroll
        for (int cb = 0; cb < 4; ++cb)
#pragma unroll
            for (int r = 0; r < 4; ++r) ATT8[(size_t)tok * 1024 + 512 + (4 * g + r) * 64 + 16 * cb + c] = (unsigned char)__builtin_amdgcn_cvt_pk_fp8_f32(O[cb][r] * sa8, 0.f, 0, false);
    }
}

DI void p2_swa_item(const Params& p, int item2) {
    unsigned char* ws = p.ws;
    const bf16_t* QA = (const bf16_t*)(ws + WS_QA); const bf16_t* KA = (const bf16_t*)(ws + WS_KA); const bf16_t* VA = (const bf16_t*)(ws + WS_VA);
    unsigned char* ATT8 = ws + WS_ATT;
    const float sa8 = 439.f / fmaxf(__uint_as_float(*(const unsigned*)(ws + WS_AMAX + 4)), 1e-30f);
    int tid = threadIdx.x; asm volatile("" : "+v"(tid));
    const int lane = tid & 63, wave = __builtin_amdgcn_readfirstlane(tid >> 6), r = lane & 31, h = lane >> 5;
    const int hq = item2 & 7, blk = (item2 >> 3) & 31, b = item2 >> 8, kvh = hq >> 2;
    const int qi = 32 * wave + r, tokq = b * SEQ + blk * 128 + qi;
    bf16x8 qf[4], sel[2];
#pragma unroll
    for (int s = 0; s < 4; ++s) qf[s] = as_bf16x8(ldg16(QA + (size_t)tokq * 512 + hq * 64 + 16 * s + 8 * h));
#pragma unroll
    for (int x = 0; x < 2; ++x)
#pragma unroll
        for (int j = 0; j < 8; ++j) sel[x][j] = (8 * h + j + 16 * x == r) ? (short)0x3F80 : (short)0;
    const float sink = p.sinks[hq];
    f32x16 ST[5];
#pragma unroll
    for (int ti = 0; ti < 5; ++ti) {
        const int sj = 32 * (wave + ti) + r; int pos = blk * 128 - 128 + sj; pos = pos < 0 ? 0 : pos;
        const bf16_t* kp = KA + (size_t)(b * SEQ + pos) * 128 + kvh * 64 + 8 * h;
        f32x16 d; for (int i = 0; i < 16; ++i) d[i] = 0.f;
#pragma unroll
        for (int s = 0; s < 4; ++s) d = mfma32(as_bf16x8(ldg16(kp + 16 * s)), qf[s], d);
        ST[ti] = d;
    }
    float mx = sink;
    {
        const int lo = r + 1 - 4 * h;
        const int lo0 = (blk > 0) ? lo : (lo > 128 - 32 * wave - 4 * h ? lo : 128 - 32 * wave - 4 * h);
#pragma unroll
        for (int ti = 0; ti < 5; ++ti)
#pragma unroll
            for (int reg = 0; reg < 16; ++reg) {
                const int e = 32 * ti + (reg & 3) + 8 * (reg >> 2);
                const float sv = (e >= lo0 && e < lo + 128) ? ST[ti][reg] : -3.0e38f; ST[ti][reg] = sv; mx = fmaxf(mx, sv);
            }
    }
    mx = fmaxf(mx, __shfl_xor(mx, 32));
    float lsum = 0.f;
#pragma unroll
    for (int ti = 0; ti < 5; ++ti)
#pragma unroll
        for (int reg = 0; reg < 16; ++reg) { const float e = __expf(ST[ti][reg] - mx); ST[ti][reg] = e; lsum += e; }
    lsum += __shfl_xor(lsum, 32);
    lsum += __expf(sink - mx);
    const float rl = 1.0f / lsum;
    f32x16 OT[2];
    for (int i = 0; i < 16; ++i) { OT[0][i] = 0.f; OT[1][i] = 0.f; }
#pragma unroll
    for (int ti = 0; ti < 5; ++ti) {
        const int sj = 32 * (wave + ti) + r; int pos = blk * 128 - 128 + sj; pos = pos < 0 ? 0 : pos;
        const bf16_t* vp = VA + (size_t)(b * SEQ + pos) * 128 + kvh * 64 + 8 * h;
        bf16x8 vf[4];
#pragma unroll
        for (int s = 0; s < 4; ++s) vf[s] = as_bf16x8(ldg16(vp + 16 * s));
        u32x4 pb[2];
#pragma unroll
        for (int s2 = 0; s2 < 2; ++s2) {
            pb[s2].x = pack_bf16(ST[ti][8 * s2 + 0] * rl, ST[ti][8 * s2 + 1] * rl); pb[s2].y = pack_bf16(ST[ti][8 * s2 + 2] * rl, ST[ti][8 * s2 + 3] * rl);
            pb[s2].z = pack_bf16(ST[ti][8 * s2 + 4] * rl, ST[ti][8 * s2 + 5] * rl); pb[s2].w = pack_bf16(ST[ti][8 * s2 + 6] * rl, ST[ti][8 * s2 + 7] * rl);
        }
#pragma unroll
        for (int db = 0; db < 2; ++db) {
            f32x16 vt; for (int i = 0; i < 16; ++i) vt[i] = 0.f;
            vt = mfma32(vf[2 * db], sel[0], vt); vt = mfma32(vf[2 * db + 1], sel[1], vt);
#pragma unroll
            for (int s2 = 0; s2 < 2; ++s2) {
                u32x4 va; va.x = pack_bf16(vt[8 * s2 + 0], vt[8 * s2 + 1]); va.y = pack_bf16(vt[8 * s2 + 2], vt[8 * s2 + 3]);
                va.z = pack_bf16(vt[8 * s2 + 4], vt[8 * s2 + 5]); va.w = pack_bf16(vt[8 * s2 + 6], vt[8 * s2 + 7]);
                OT[db] = mfma32(as_bf16x8(va), as_bf16x8(pb[s2]), OT[db]);
            }
        }
    }
#pragma unroll
    for (int db = 0; db < 2; ++db)
#pragma unroll
        for (int q4 = 0; q4 < 4; ++q4) {
            int pk = __builtin_amdgcn_cvt_pk_fp8_f32(OT[db][4 * q4] * sa8, OT[db][4 * q4 + 1] * sa8, 0, false);
            pk = __builtin_amdgcn_cvt_pk_fp8_f32(OT[db][4 * q4 + 2] * sa8, OT[db][4 * q4 + 3] * sa8, pk, true);
            *(int*)(ATT8 + (size_t)tokq * 1024 + hq * 64 + 32 * db + 8 * q4 + 4 * h) = pk;
        }
}

template <int MODE> DI void p2_attention(const Params& p, unsigned char* lds, int cidx = 0) {
    const int G = gridDim.x, bi = blockIdx.x, rounds = (1024 + G - 1) / G;
    for (int b = 0; b < BATCH; ++b)
        for (int r = 0; r < rounds; ++r) {
            const int idx = (r & 1) ? r * G + (G - 1 - bi) : r * G + bi;
            if (idx < 1024) p2_dsa_item<MODE>(p, lds, b, 1023 - idx);
        }
    if (MODE & 8) for (int item2 = bi; item2 < NSWA; item2 += G) p2_swa_item(p, item2);
}

DI void p3_outproj(const Params& p, unsigned char* lds) {
    unsigned char* ws = p.ws;
    const unsigned char* ATT8 = ws + WS_ATT; const unsigned char* WT8 = ws + WS_WOT;
    const float desc = (fmaxf(__uint_as_float(*(const unsigned*)(ws + WS_AMAX + 4)), 1e-30f) * (1.f / 439.f)) * (fmaxf(__uint_as_float(*(const unsigned*)(ws + WS_AMAX)), 1e-30f) * (1.f / 439.f));
    const int tid = threadIdx.x, lane = tid & 63, wave = tid >> 6, wm = wave >> 1, wn = wave & 1, c = lane & 15, g = lane >> 4;
    constexpr int NT = 8, MT = NTOK / 128;
    int mt, nt;
    for (int k = 0; tile_of(k, NT, MT, mt, nt); ++k) {
        f32x4 acc[4][4];
        gemm8_128x128(ATT8 + (size_t)mt * 128 * 1024, 1024, WT8 + (size_t)nt * 128 * 1024, 1024, 1024, lds, acc);
#pragma unroll
        for (int m = 0; m < 4; ++m) {
            const int tok = mt * 128 + wm * 64 + m * 16 + c;
#pragma unroll
            for (int n = 0; n < 4; ++n) {
                const size_t o = (size_t)tok * 1024 + nt * 128 + wn * 64 + 16 * n + 4 * g;
                const u32x2 xw = *(const u32x2*)((const bf16_t*)(ws + WS_XB) + o);
                const f32x4 xv = {bf_lo(xw.x), bf_hi(xw.x), bf_lo(xw.y), bf_hi(xw.y)};
                const f32x4 hv = xv * ALPHA + acc[m][n] * desc;
                u32x2 w; w.x = pack_bf16(hv[0], hv[1]); w.y = pack_bf16(hv[2], hv[3]);
                *(u32x2*)((bf16_t*)p.out + o) = w;
            }
        }
    }
}

DI void p3b_ln1(const Params& p) {
    bf16_t* H1B = (bf16_t*)(p.ws + WS_XB); const bf16_t* HP = (const bf16_t*)p.out;
    const int lane = threadIdx.x & 63, gw = blockIdx.x * 4 + (threadIdx.x >> 6), nw = gridDim.x * 4;
    for (int row = gw; row < NTOK; row += nw) {
        const u32x4 ra = ldg16(HP + (size_t)row * 1024 + lane * 16), rb = ldg16(HP + (size_t)row * 1024 + lane * 16 + 8);
        float v[16];
        v[0] = bf_lo(ra.x); v[1] = bf_hi(ra.x); v[2] = bf_lo(ra.y); v[3] = bf_hi(ra.y); v[4] = bf_lo(ra.z); v[5] = bf_hi(ra.z); v[6] = bf_lo(ra.w); v[7] = bf_hi(ra.w);
        v[8] = bf_lo(rb.x); v[9] = bf_hi(rb.x); v[10] = bf_lo(rb.y); v[11] = bf_hi(rb.y); v[12] = bf_lo(rb.z); v[13] = bf_hi(rb.z); v[14] = bf_lo(rb.w); v[15] = bf_hi(rb.w);
        float s = 0.f;
#pragma unroll
        for (int i = 0; i < 16; ++i) s += v[i];
        const float mu = wave_sum(s) * (1.f / 1024.f); float q = 0.f;
#pragma unroll
        for (int i = 0; i < 16; ++i) { const float d = v[i] - mu; q = fmaf(d, d, q); }
        const float rstd = rsqrtf(wave_sum(q) * (1.f / 1024.f) + LN_EPS);
        u32x4 oa, ob; float ov[16]; float amax = 0.f;
#pragma unroll
        for (int k4 = 0; k4 < 4; ++k4) {
            const int col = lane * 16 + k4 * 4;
            const f32x4 gg = *(const f32x4*)(p.ln1_g + col), bb = *(const f32x4*)(p.ln1_b + col);
            float o[4];
#pragma unroll
            for (int e = 0; e < 4; ++e) { o[e] = (v[k4 * 4 + e] - mu) * rstd * gg[e] + bb[e]; ov[k4 * 4 + e] = o[e]; amax = fmaxf(amax, fabsf(o[e])); }
            const unsigned w0 = pack_bf16(o[0], o[1]), w1 = pack_bf16(o[2], o[3]);
            if (k4 == 0) { oa.x = w0; oa.y = w1; } else if (k4 == 1) { oa.z = w0; oa.w = w1; } else if (k4 == 2) { ob.x = w0; ob.y = w1; } else { ob.z = w0; ob.w = w1; }
        }
        *(u32x4*)(H1B + (size_t)row * 1024 + lane * 16) = oa; *(u32x4*)(H1B + (size_t)row * 1024 + lane * 16 + 8) = ob;
        {
#pragma unroll
            for (int o2 = 32; o2 >= 1; o2 >>= 1) amax = fmaxf(amax, __shfl_xor(amax, o2));
            const float sx = amax > 0.f ? amax * (1.0f / 440.0f) : 1.0f, inv = amax > 0.f ? 440.0f / amax : 1.0f;
            u32x4 q8;
#pragma unroll
            for (int k4 = 0; k4 < 4; ++k4) {
                int w = 0;
                w = __builtin_amdgcn_cvt_pk_fp8_f32(ov[4 * k4] * inv, ov[4 * k4 + 1] * inv, w, false);
                w = __builtin_amdgcn_cvt_pk_fp8_f32(ov[4 * k4 + 2] * inv, ov[4 * k4 + 3] * inv, w, true);
                q8[k4] = (unsigned)w;
            }
            *(u32x4*)(p.ws + WS_QA + (size_t)row * 1024 + lane * 16) = q8;
            if (lane == 0) ((float*)(p.ws + WS_SX))[row] = sx;
        }
    }
}

DI int f2key(float v) { const int b = __float_as_int(v); return b ^ ((b >> 31) & 0x7fffffff); }
DI float key2f(int k) { return __int_as_float(k ^ ((k >> 31) & 0x7fffffff)); }
DI void ce_desc(int& a, int& b) { const int hi = a > b ? a : b, lo = a > b ? b : a; a = hi; b = lo; }
DI void bitonic_merge16(int (&k)[16]) {
#pragma unroll
    for (int d = 8; d >= 1; d >>= 1)
#pragma unroll
        for (int i = 0; i < 16; ++i) if ((i & d) == 0) ce_desc(k[i], k[i | d]);
}
DI void bitonic_sort16(int (&k)[16]) {
#pragma unroll
    for (int sz = 2; sz <= 16; sz <<= 1) {
#pragma unroll
        for (int i = 0; i < 16; ++i) { const int j = i ^ (sz - 1); if (j > i) ce_desc(k[i], k[j]); }
#pragma unroll
        for (int d = sz >> 2; d >= 1; d >>= 1)
#pragma unroll
            for (int i = 0; i < 16; ++i) if ((i & d) == 0) ce_desc(k[i], k[i | d]);
    }
}
DI void top16_merge(int (&t)[16], const int (&sdesc)[16]) {
#pragma unroll
    for (int i = 0; i < 16; ++i) t[i] = t[i] > sdesc[15 - i] ? t[i] : sdesc[15 - i];
    bitonic_merge16(t);
}
constexpr int P4_QS = 32768, P4_SS_STRIDE = 132, P4_ST0 = 67584  , P4_M = 0  , P4_ST1 = 8704  ;

DI void p4_peer_query(const Params& p, unsigned char* lds) {
    unsigned char* ws = p.ws;
    const bf16_t* H1B = (const bf16_t*)(ws + WS_XB); const bf16_t* WQT = (const bf16_t*)(ws + WS_WQT); const bf16_t* SK = (const bf16_t*)(ws + WS_SK);
    unsigned short* PE = (unsigned short*)(ws + WS_PE); float* PG = (float*)(ws + WS_PG); float* PS = (float*)(ws + WS_PS);
    const float* SU = (const float*)(ws + WS_SU); const float* SV = (const float*)(ws + WS_SV);
    float* Ss = (float*)lds;
    float* st0 = (float*)(lds + P4_ST0); float* mbuf = (float*)(lds + P4_M); float* st1 = (float*)(lds + P4_ST1);
    constexpr int MT = NTOK / 128;
    int mt, head;
    for (int k = 0; tile_of(k, 8, MT, mt, head); ++k) {
        int tid = threadIdx.x; asm volatile("" : "+v"(tid));
        const int lane = tid & 63, wave = tid >> 6, wm = wave >> 1, wn = wave & 1, c = lane & 15, g = lane >> 4;
        const int lrow = tid >> 3, lch = tid & 7;
        const int srow = tid & 127, shalf = tid >> 7;
#pragma unroll 1
        for (int ph = 0; ph < 2; ++ph) {
            f32x4 acc[4][4];
            gemm_128x128(H1B + (size_t)mt * 128 * 1024, 1024, WQT + (size_t)(head * 256 + ph * 128) * 1024, 1024, 1024, lds, acc);
            __syncthreads();
#pragma unroll
            for (int m = 0; m < 4; ++m)
#pragma unroll
                for (int n = 0; n < 4; ++n) {
                    const int row = wm * 64 + m * 16 + c;
                    u32x2 w; w.x = pack_bf16(acc[m][n][0], acc[m][n][1]); w.y = pack_bf16(acc[m][n][2], acc[m][n][3]);
                    *(u32x2*)(lds + P4_QS + wn * 16384 + row * 128 + (((2 * n + (g >> 1)) ^ (row & 7)) << 4) + (g & 1) * 8) = w;
                }
            {
                const bf16_t* sp = SK + (size_t)((head * 2 + ph) * 128 + lrow) * 128 + lch * 8;
#pragma unroll
                for (int k2 = 0; k2 < 2; ++k2)
#pragma unroll
                    for (int i = 0; i < 4; ++i) *(u32x4*)(lds + k2 * 16384 + (lrow + 32 * i) * 128 + ((lch ^ (lrow & 7)) << 4)) = ldg16(sp + (size_t)(32 * i) * 128 + k2 * 64);
            }
            __syncthreads();
            f32x4 a2[4][4];
#pragma unroll
            for (int m = 0; m < 4; ++m)
#pragma unroll
                for (int n = 0; n < 4; ++n) a2[m][n] = (f32x4){0.f, 0.f, 0.f, 0.f};
#pragma unroll
            for (int k2 = 0; k2 < 2; ++k2)
#pragma unroll
                for (int s = 0; s < 2; ++s) {
                    bf16x8 xf[4], wf[4];
#pragma unroll
                    for (int m = 0; m < 4; ++m) { const int row = wm * 64 + m * 16 + c; xf[m] = as_bf16x8(*(const u32x4*)(lds + P4_QS + k2 * 16384 + row * 128 + (((4 * s + g) ^ (c & 7)) << 4))); }
#pragma unroll
                    for (int n = 0; n < 4; ++n) { const int row = wn * 64 + n * 16 + c; wf[n] = as_bf16x8(*(const u32x4*)(lds + k2 * 16384 + row * 128 + (((4 * s + g) ^ (c & 7)) << 4))); }
#pragma unroll
                    for (int m = 0; m < 4; ++m)
#pragma unroll
                        for (int n = 0; n < 4; ++n) a2[m][n] = mfma16(wf[n], xf[m], a2[m][n]);
                }
            __syncthreads();
#pragma unroll
            for (int m = 0; m < 4; ++m)
#pragma unroll
                for (int n = 0; n < 4; ++n) {
                    const int key0 = wn * 64 + 16 * n + 4 * g;
                    u32x4 w;
#pragma unroll
                    for (int r = 0; r < 4; ++r) w[r] = (unsigned)f2key(__uint_as_float((__float_as_uint(a2[m][n][r]) & 0xFFFFFF80u) | (unsigned)(key0 + r)));
                    *(u32x4*)(Ss + (wm * 64 + m * 16 + c) * P4_SS_STRIDE + key0) = w;
                }
            __syncthreads();
            int tv[16];
            {
                const int* rowp = (const int*)Ss + srow * P4_SS_STRIDE + shalf * 64;
#pragma unroll
                for (int bt = 0; bt < 4; ++bt) {
                    int bk[16];
#pragma unroll
                    for (int j = 0; j < 4; ++j) { const u32x4 v = *(const u32x4*)(rowp + 16 * bt + 4 * j); bk[4 * j] = (int)v.x; bk[4 * j + 1] = (int)v.y; bk[4 * j + 2] = (int)v.z; bk[4 * j + 3] = (int)v.w; }
                    bitonic_sort16(bk);
                    if (bt == 0) {
#pragma unroll
                        for (int j = 0; j < 16; ++j) tv[j] = bk[j];
                    } else top16_merge(tv, bk);
                }
            }
            __syncthreads();
            int* mbi = (int*)mbuf;
            if (shalf == 1) {
#pragma unroll
                for (int j = 0; j < 16; ++j) mbi[srow * 17 + j] = tv[j];
            }
            __syncthreads();
            if (shalf == 0) {
                int* dst = (int*)((ph == 0) ? st0 : st1);
                int ob[16];
#pragma unroll
                for (int j = 0; j < 16; ++j) ob[j] = mbi[srow * 17 + j];
                top16_merge(tv, ob);
#pragma unroll
                for (int j = 0; j < 16; ++j) dst[srow * 17 + j] = tv[j];
            }
        }
        __syncthreads();
        int cv[16];
        {
            const int* st0i = (const int*)st0; const int* st1i = (const int*)st1;
            float v2[16];
#pragma unroll
            for (int b = 0; b < 16; ++b) v2[b] = key2f(st1i[srow * 17 + b]);
#pragma unroll
            for (int a8 = 0; a8 < 8; ++a8) {
                const int a = shalf * 8 + a8; const float va = key2f(st0i[srow * 17 + a]);
                int bk[16];
#pragma unroll
                for (int b = 0; b < 16; ++b) bk[b] = (f2key(va + v2[b]) & (int)0xFFFFFF00) | (a * 16 + 15 - b);
                if (a8 == 0) {
#pragma unroll
                    for (int j = 0; j < 16; ++j) cv[j] = bk[j];
                } else top16_merge(cv, bk);
            }
        }
        __syncthreads();
        int* mbi = (int*)mbuf;
        if (shalf == 1) {
#pragma unroll
            for (int j = 0; j < 16; ++j) mbi[srow * 17 + j] = cv[j];
        }
        __syncthreads();
        if (shalf == 0) {
            const int* st0i = (const int*)st0; const int* st1i = (const int*)st1;
            int fk[16]; float fv[16];
#pragma unroll
            for (int j = 0; j < 16; ++j) { const int o = mbi[srow * 17 + 15 - j]; fk[j] = cv[j] > o ? cv[j] : o; fv[j] = key2f(fk[j]); }
            float cmax = fv[0];
#pragma unroll
            for (int j = 1; j < 16; ++j) cmax = fmaxf(cmax, fv[j]);
            float den = 0.f; float ev[16];
#pragma unroll
            for (int j = 0; j < 16; ++j) { ev[j] = __expf(fv[j] - cmax); den += ev[j]; }
            const float rden = 1.0f / den;
            const size_t ob = (size_t)(mt * 128 + srow) * 128 + head * 16;
#pragma unroll
            for (int j = 0; j < 16; ++j) {
                const unsigned cde = (unsigned)fk[j] & 0xFFu;
                const unsigned a = cde >> 4, b = 15u - (cde & 15u);
                const unsigned i1 = __float_as_uint(key2f(st0i[srow * 17 + a])) & 0x7Fu, i2 = __float_as_uint(key2f(st1i[srow * 17 + b])) & 0x7Fu;
                const int e = (int)(i1 * 128u + i2);
                PE[ob + j] = (unsigned short)e; PG[ob + j] = ev[j] * rden * SV[e]; PS[ob + j] = SU[e];
            }
        }
        __syncthreads();
    }
}

DI float gelu_exact(float z) { return 0.5f * z * (1.0f + erff(z * 0.70710678118654752f)); }
DI float rdlane(float v, int l) { return __int_as_float(__builtin_amdgcn_readlane(__float_as_int(v), l)); }

constexpr int P5A_LIST_BYTES = (2048 + 128) * 4, P5A_WAVE_LDS = P5A_LIST_BYTES + 8192;
template <int MODE>
DI void p5a_udot(const Params& p, unsigned char* lds) {
    unsigned char* ws = p.ws;
    const unsigned char* H1Q = ws + WS_QA; const unsigned char* UT = ws + WS_UT;
    const unsigned short* PE = (const unsigned short*)(ws + WS_PE); float* ZB = (float*)(ws + (MODE ? WS_QI : WS_QB));
    const int lane = threadIdx.x & 63, wave = threadIdx.x >> 6, c = lane & 15, kb = lane >> 4;
    const int G = gridDim.x, bid = blockIdx.x;
    const bool affine = (G & 7) == 0;
    const int npass = affine ? 1 : 4;
    unsigned* list = (unsigned*)(lds + wave * P5A_WAVE_LDS);
    unsigned char* slot = lds + wave * P5A_WAVE_LDS + P5A_LIST_BYTES;
    const int l31 = lane & 31, lh = lane >> 5;
    unsigned cq[8];
#pragma unroll
    for (int q = 0; q < 8; ++q) cq[q] = (unsigned)((l31 ^ (q + 8 * lh)) * 16);
    for (int pass = 0; pass < npass; ++pass) {
        const int part = affine ? (bid & 3) : pass, rank = affine ? (bid >> 2) : bid, nper = affine ? (G >> 2) : G;
        const unsigned char* UTp = UT + (size_t)part * (4096 * 512);
        for (int gid = rank * 4 + wave; gid < NTOK / 16; gid += nper * 4) {
            const int t0 = gid * 16;
            u32x4 pv[4];
#pragma unroll
            for (int i = 0; i < 4; ++i) pv[i] = ldg16(PE + (size_t)(t0 + (lane >> 2)) * 128 + (lane & 3) * 32 + 8 * i);
            i32x8 ax[8];
#pragma unroll
            for (int s2 = 0; s2 < 8; ++s2) {
                const unsigned char* xp = H1Q + (size_t)(t0 + c) * 1024 + 128 * s2 + 16 * kb;
                const u32x4 lo = ldg16(xp), hi = ldg16(xp + 64);
                ax[s2][0] = (int)lo.x; ax[s2][1] = (int)lo.y; ax[s2][2] = (int)lo.z; ax[s2][3] = (int)lo.w; ax[s2][4] = (int)hi.x; ax[s2][5] = (int)hi.y; ax[s2][6] = (int)hi.z; ax[s2][7] = (int)hi.w;
            }
            unsigned base = 0;
            const unsigned zl = (unsigned)((lane >> 2) * 128 + (lane & 3) * 32) << 21;
#pragma unroll
            for (int i = 0; i < 4; ++i)
#pragma unroll
                for (int w = 0; w < 4; ++w)
#pragma unroll
                    for (int hf = 0; hf < 2; ++hf) {
                        const unsigned e = hf ? (pv[i][w] >> 16) : (pv[i][w] & 0xffffu);
                        const bool cnd = (int)(e >> 12) == part;
                        const unsigned long long mk = __ballot(cnd);
                        if (mk) {
                            const unsigned pos = base + __builtin_amdgcn_mbcnt_hi((unsigned)(mk >> 32), __builtin_amdgcn_mbcnt_lo((unsigned)mk, 0u));
                            if (cnd) list[pos] = ((e & 4095u) << 9) | (zl + ((unsigned)(8 * i + 2 * w + hf) << 21));
                            base += (unsigned)__popcll(mk);
                        }
                    }
            const int count = (int)base, nrt = (count + 15) >> 4;
            if (MODE == 2) { if (count == 12345) ZB[lane] = (float)ax[7][7] + (float)ax[0][0]; }
            else if (count > 0) {
                {
                    const unsigned last = list[count - 1];
                    list[count + lane] = last; list[count + 64 + lane] = last;
                }
                float* ZBg = ZB + (size_t)t0 * 128;
                auto loadA = [&](int rt, u32x4 (&dst)[8]) {
                    const u32x4 ea = *(const u32x4*)(list + 16 * rt + 8 * lh), eb = *(const u32x4*)(list + 16 * rt + 8 * lh + 4);
#pragma unroll
                    for (int q = 0; q < 8; ++q) {
                        const unsigned ent = q < 4 ? ea[q & 3] : eb[q & 3];
                        dst[q] = ldg16(UTp + ((ent & 0x1ffe00u) | cq[q]));
                    }
                };
                auto compute = [&](int rt, const u32x4 (&st)[8]) {
#pragma unroll
                    for (int q = 0; q < 8; ++q) *(u32x4*)(slot + q * 512 + lh * 4096 + l31 * 16) = st[q];
                    u32x4 bf[8];
#pragma unroll
                    for (int s2 = 0; s2 < 8; ++s2) bf[s2] = *(const u32x4*)(slot + c * 512 + (((4 * s2 + kb) ^ c) * 16));
                    const unsigned ent = list[16 * rt + c];
                    f32x4 D = {0.f, 0.f, 0.f, 0.f};
#pragma unroll
                    for (int s2 = 0; s2 < 8; ++s2) {
                        i32x8 b8; b8[0] = (int)bf[s2].x; b8[1] = (int)bf[s2].y; b8[2] = (int)bf[s2].z; b8[3] = (int)bf[s2].w; b8[4] = 0; b8[5] = 0; b8[6] = 0; b8[7] = 0;
                        D = __builtin_amdgcn_mfma_scale_f32_16x16x128_f8f6f4(ax[s2], b8, D, 0  , 4  , 0, 0, 0, 0);
                    }
                    const unsigned zoff = ent >> 21, tk = zoff >> 7;
                    const float val = (tk & 2u) ? ((tk & 1u) ? D[3] : D[2]) : ((tk & 1u) ? D[1] : D[0]);
                    if ((int)(tk >> 2) == kb && 16 * rt + c < count && (MODE != 3 || val == 1234.5f)) ZBg[zoff] = val;
                };
                u32x4 a0[8], a1[8], a2[8];
                loadA(0, a0); loadA(1, a1); loadA(2, a2);
                for (int rt = 0; rt < nrt; rt += 3) {
                    compute(rt, a0); loadA(rt + 3, a0);
                    if (rt + 1 < nrt) compute(rt + 1, a1);
                    loadA(rt + 4, a1);
                    if (rt + 2 < nrt) compute(rt + 2, a2);
                    loadA(rt + 5, a2);
                }
            }
        }
    }
}

DI void p5b_ffn(const Params& p) {
    unsigned char* ws = p.ws;
    const bf16_t* H1B = (const bf16_t*)(ws + WS_XB); const unsigned char* VT = ws + WS_VT;
    const unsigned short* PE = (const unsigned short*)(ws + WS_PE); const float* PG = (const float*)(ws + WS_PG); const float* PS = (const float*)(ws + WS_PS);
    const int lane = threadIdx.x & 63, gw = blockIdx.x * 4 + (threadIdx.x >> 6), nw = gridDim.x * 4;
    for (int tok = gw; tok < NTOK; tok += nw) {
        float acc[16];
#pragma unroll
        for (int i = 0; i < 16; ++i) acc[i] = 0.f;
        const int pe_lo = (int)PE[(size_t)tok * 128 + lane], pe_hi = (int)PE[(size_t)tok * 128 + 64 + lane];
        const float* ZB = (const float*)(ws + WS_QB);
        const float sxt = ((const float*)(ws + WS_SX))[tok];
        const float cf_lo = gelu_exact(ZB[(size_t)tok * 128 + lane] * PS[(size_t)tok * 128 + lane] * sxt) * PG[(size_t)tok * 128 + lane];
        const float cf_hi = gelu_exact(ZB[(size_t)tok * 128 + 64 + lane] * PS[(size_t)tok * 128 + 64 + lane] * sxt) * PG[(size_t)tok * 128 + 64 + lane];
#define P5_AXPY(vw, k, bs) { const f32x2 f = __builtin_amdgcn_cvt_scalef32_pk_f32_fp4(vw[k], 1.0f, bs); acc[8 * (k) + 2 * (bs)] = fmaf(cj, f.x, acc[8 * (k) + 2 * (bs)]); acc[8 * (k) + 2 * (bs) + 1] = fmaf(cj, f.y, acc[8 * (k) + 2 * (bs) + 1]); }
        u32x2 bufA[16], bufB[16];
        auto issue = [&](int gq, u32x2 (&buf)[16]) {
            const int pes = gq < 4 ? pe_lo : pe_hi; const int lb = (gq & 3) * 16;
#pragma unroll
            for (int j = 0; j < 16; ++j) { const int e = __builtin_amdgcn_readlane(pes, lb + j); buf[j] = *(const u32x2*)(VT + (size_t)e * 512 + lane * 8); }
        };
        auto consume = [&](int gq, const u32x2 (&buf)[16]) {
            const float cfs = gq < 4 ? cf_lo : cf_hi; const int lb = (gq & 3) * 16;
#pragma unroll
            for (int j = 0; j < 16; ++j) {
                const float cj = rdlane(cfs, lb + j);
                const u32x2 vw = buf[j];
                P5_AXPY(vw, 0, 0) P5_AXPY(vw, 0, 1) P5_AXPY(vw, 0, 2) P5_AXPY(vw, 0, 3) P5_AXPY(vw, 1, 0) P5_AXPY(vw, 1, 1) P5_AXPY(vw, 1, 2) P5_AXPY(vw, 1, 3)
            }
        };
#define P5_SB() do {} while (0)
        issue(0, bufA); P5_SB(); issue(1, bufB); P5_SB();
        consume(0, bufA); P5_SB(); issue(2, bufA); P5_SB();
        consume(1, bufB); P5_SB(); issue(3, bufB); P5_SB();
        consume(2, bufA); P5_SB(); issue(4, bufA); P5_SB();
        consume(3, bufB); P5_SB(); issue(5, bufB); P5_SB();
        consume(4, bufA); P5_SB(); issue(6, bufA); P5_SB();
        consume(5, bufB); P5_SB(); issue(7, bufB); P5_SB();
        const u32x4 xa = ldg16(H1B + (size_t)tok * 1024 + lane * 16), xb = ldg16(H1B + (size_t)tok * 1024 + lane * 16 + 8);
        consume(6, bufA); P5_SB();
        consume(7, bufB);
        float x[16];
        x[0] = bf_lo(xa.x); x[1] = bf_hi(xa.x); x[2] = bf_lo(xa.y); x[3] = bf_hi(xa.y); x[4] = bf_lo(xa.z); x[5] = bf_hi(xa.z); x[6] = bf_lo(xa.w); x[7] = bf_hi(xa.w);
        x[8] = bf_lo(xb.x); x[9] = bf_hi(xb.x); x[10] = bf_lo(xb.y); x[11] = bf_hi(xb.y); x[12] = bf_lo(xb.z); x[13] = bf_hi(xb.z); x[14] = bf_lo(xb.w); x[15] = bf_hi(xb.w);
        float s = 0.f;
#pragma unroll
        for (int i = 0; i < 16; ++i) { acc[i] = fmaf(ALPHA, x[i], acc[i]); s += acc[i]; }
        const float mu = wave_sum(s) * (1.f / 1024.f); float q = 0.f;
#pragma unroll
        for (int i = 0; i < 16; ++i) { const float dd = acc[i] - mu; q = fmaf(dd, dd, q); }
        const float rstd = rsqrtf(wave_sum(q) * (1.f / 1024.f) + LN_EPS);
#pragma unroll
        for (int k4 = 0; k4 < 4; ++k4) {
            const int col = lane * 16 + k4 * 4;
            const f32x4 gg = *(const f32x4*)(p.ln2_g + col), bb = *(const f32x4*)(p.ln2_b + col);
            f32x4 o;
#pragma unroll
            for (int e = 0; e < 4; ++e) o[e] = (acc[k4 * 4 + e] - mu) * rstd * gg[e] + bb[e];
            *(f32x4*)(p.out + (size_t)tok * 1024 + col) = o;
        }
    }
}

#define XB_TMO      128
#define XB_XCNT(j)  (256  + 64 * (j))
#define XB_XSUB(j)  (1280 + 64 * (j))
#define XB_XGEN(j)  (2304 + 64 * (j))
#define XB_TOP      3328
#define XB_TOPGEN   3392
#define XCD_BAR_WORDS 3456
#define XB_SPIN_CAP (1u << 22)
#define LAS __attribute__((address_space(3)))
DI unsigned xb_ld(unsigned* p)              { return __hip_atomic_load(p, __ATOMIC_RELAXED, __HIP_MEMORY_SCOPE_AGENT); }
DI unsigned xb_add(unsigned* p, unsigned v) { return __hip_atomic_fetch_add(p, v, __ATOMIC_RELAXED, __HIP_MEMORY_SCOPE_AGENT); }
DI unsigned xb_xcc_id() { return (unsigned)__builtin_amdgcn_s_getreg((3 << 11) | 20) & 0xFu; }
#define XB_SPIN(cond, bar) do { unsigned _sp = 0; while (cond) { __builtin_amdgcn_s_sleep(1); \
    if ((++_sp & 255u) == 0u) { if (xb_ld(&(bar)[XB_TMO])) break; if (_sp > XB_SPIN_CAP) { atomicAdd(&(bar)[XB_TMO], 1u); break; } } } } while (0)
struct XcdBarrier { unsigned* bar; unsigned x; volatile LAS unsigned* st; };
DI XcdBarrier xcd_barrier_post(unsigned* bar, volatile LAS unsigned* st) {
    XcdBarrier b; b.bar = bar; b.x = xb_xcc_id(); b.st = st;
    if (threadIdx.x == 0) (void)xb_add(&bar[XB_XCNT(b.x)], 1u);
    return b;
}
DI void xcd_barrier_complete(unsigned* bar, unsigned x, unsigned& nloc, unsigned& nx) {
    const unsigned G = gridDim.x * gridDim.y * gridDim.z;
    unsigned sum, cnt, mine, sp = 0u;
    for (;;) {
        sum = 0u; cnt = 0u; mine = 0u;
#pragma unroll
        for (unsigned j = 0; j < 16; ++j) { const unsigned c = xb_ld(&bar[XB_XCNT(j)]); sum += c; cnt += (c > 0u) ? 1u : 0u; mine = (j == x) ? c : mine; }
        if (sum == G) break;
        __builtin_amdgcn_s_sleep(1);
        if ((++sp & 255u) == 0u) { if (xb_ld(&bar[XB_TMO])) break; if (sp > XB_SPIN_CAP) { atomicAdd(&bar[XB_TMO], 1u); break; } }
    }
    nloc = mine > 0u ? mine : 1u; nx = cnt > 0u ? cnt : 1u;
}
DI void xcd_barrier(const XcdBarrier& b) {
    asm volatile("s_waitcnt vmcnt(0)" ::: "memory");
    __syncthreads();
    if (threadIdx.x == 0) {
        unsigned* bar = b.bar;
        __builtin_amdgcn_s_waitcnt(0);
        unsigned nloc = b.st[0], nx = b.st[1];
        if (nloc == 0u) { xcd_barrier_complete(bar, b.x, nloc, nx); b.st[0] = nloc; b.st[1] = nx; }
        const unsigned old = xb_add(&bar[XB_XSUB(b.x)], 1u);
        const unsigned gen = old / nloc;
        if (old + 1u == (gen + 1u) * nloc) {
            __builtin_amdgcn_fence(__ATOMIC_RELEASE, "agent");
            asm volatile("s_waitcnt vmcnt(0)" ::: "memory");
            const unsigned og = xb_add(&bar[XB_TOP], 1u);
            const unsigned tg = og / nx;
            if (og + 1u == (tg + 1u) * nx) xb_add(&bar[XB_TOPGEN], 1u);
            else XB_SPIN(xb_ld(&bar[XB_TOPGEN]) == tg, bar);
            __builtin_amdgcn_fence(__ATOMIC_ACQUIRE, "agent");
            xb_add(&bar[XB_XGEN(b.x)], 1u);
            asm volatile("s_waitcnt vmcnt(0)" ::: "memory");
        } else {
            XB_SPIN(xb_ld(&bar[XB_XGEN(b.x)]) == gen, bar);
            __builtin_amdgcn_fence(__ATOMIC_ACQUIRE, "agent");
            asm volatile("s_waitcnt vmcnt(0)" ::: "memory");
        }
    }
    __syncthreads();
}

constexpr int NPHASE = 7;
__global__ void __launch_bounds__(NTHREADS, 2) mega_fwd(Params p) {
    extern __shared__ __attribute__((aligned(16))) unsigned char lds[];
    cg::grid_group grid = cg::this_grid();
    const int lo = p.ph_lo, hi = p.ph_hi;
    volatile LAS unsigned* xbst = (volatile LAS unsigned*)(LAS unsigned char*)(lds + LDS_BYTES - 16);
#ifndef REP_MASK
#define REP_MASK 0
#endif
#ifndef P2_PROBE_MODE
#define P2_PROBE_MODE 15
#endif
#ifndef PH_MASK
#define PH_MASK 127
#endif
    if (lo == 0x7fffffff) grid.sync();
    if (threadIdx.x == 0) { xbst[0] = 0u; xbst[1] = 0u; }
    __syncthreads();
    XcdBarrier xb = xcd_barrier_post((unsigned*)(p.ws + WS_BAR), xbst);
#define GSYNC() xcd_barrier(xb)
#if REP_MASK & 1
    p0_prep(p, lds); GSYNC();
#endif
    p0_prep(p, lds);
    GSYNC();
#define RUN_PHASE(k, call) { call; if ((REP_MASK >> (k)) & 1) { GSYNC(); call; } }
#if PH_MASK & 2
    RUN_PHASE(1, p1_inproj(p, lds))
#endif
    GSYNC();
#if PH_MASK & 4
#if (REP_MASK >> 2) & 1
    p2a_indexer(p, lds); GSYNC(); p2_attention<P2_PROBE_MODE>(p, lds, 1); GSYNC();
#endif
    p2a_indexer(p, lds);
    GSYNC();
    p2_attention<15>(p, lds, 0);
#endif
    GSYNC();
#if PH_MASK & 8
    RUN_PHASE(3, p3_outproj(p, lds))
#endif
    GSYNC();
#if PH_MASK & 16
    RUN_PHASE(4, p3b_ln1(p))
#endif
    GSYNC();
#if PH_MASK & 32
    RUN_PHASE(5, p4_peer_query(p, lds))
#endif
    GSYNC();
#if PH_MASK & 64
    p5a_udot<0>(p, lds);
#ifdef P5A_REP
    GSYNC(); p5a_udot<P5A_REP>(p, lds);
#endif
    GSYNC();
    p5b_ffn(p);
#endif
}

#ifndef MK_N_LAUNCHES
#define MK_N_LAUNCHES 1
#endif

extern "C" void kernel_launch(void* const* d_in, const int* in_sizes, int n_in, void* d_out, int out_size, void* d_ws, size_t ws_size, hipStream_t stream) {
    static int grid_blocks = 0;
    if (grid_blocks == 0) {
        if (n_in != 14 || out_size != NTOK * D_MODEL || ws_size < WS_END) {
            fprintf(stderr, "kernel_launch: unexpected problem (n_in %d, out %d, ws %zu, need %zu)\n", n_in, out_size, ws_size, (size_t)WS_END); grid_blocks = -1; return;
        }
        int dev = 0, cus = 0, per_cu = 0;
        hipGetDevice(&dev);
        hipDeviceGetAttribute(&cus, hipDeviceAttributeMultiprocessorCount, dev);
        if (hipFuncSetAttribute((const void*)mega_fwd, hipFuncAttributeMaxDynamicSharedMemorySize, LDS_BYTES) != hipSuccess) { fprintf(stderr, "kernel_launch: hipFuncSetAttribute failed\n"); }
        if (hipOccupancyMaxActiveBlocksPerMultiprocessor(&per_cu, (const void*)mega_fwd, NTHREADS, LDS_BYTES) != hipSuccess || per_cu < 1) { fprintf(stderr, "kernel_launch: occupancy query failed\n"); per_cu = 1; }
        if (per_cu > 2) per_cu = 2;
        (void)hipGetLastError();
        grid_blocks = cus * per_cu;
        fprintf(stderr, "kernel_launch: %d CUs x %d blocks\n", cus, per_cu);
    }
    if (grid_blocks < 0) return;
    Params p{};
    p.x = (const float*)d_in[0]; p.w_in = (const float*)d_in[1]; p.idx_k_g = (const float*)d_in[2]; p.idx_k_b = (const float*)d_in[3]; p.sinks = (const float*)d_in[4];
    p.w_o = (const float*)d_in[5]; p.ln1_g = (const float*)d_in[6]; p.ln1_b = (const float*)d_in[7]; p.peer_wq = (const float*)d_in[8]; p.peer_subkeys = (const float*)d_in[9];
    p.peer_u = (const float*)d_in[10]; p.peer_v = (const float*)d_in[11]; p.ln2_g = (const float*)d_in[12]; p.ln2_b = (const float*)d_in[13];
    p.out = (float*)d_out; p.ws = (unsigned char*)d_ws;
    p.ph_lo = 0; p.ph_hi = NPHASE;
    if (hipMemsetAsync((unsigned char*)d_ws + WS_BAR, 0, 16384 + 64, stream) != hipSuccess) { fprintf(stderr, "kernel_launch: memset of the barrier words failed\n"); return; }
    void* args[] = {&p};
    hipError_t e = hipLaunchCooperativeKernel((const void*)mega_fwd, dim3(grid_blocks), dim3(NTHREADS), args, LDS_BYTES, stream);
    if (e != hipSuccess) fprintf(stderr, "cooperative launch failed: %s (grid %d)\n", hipGetErrorString(e), grid_blocks);
}
```

```cpp
#include <hip/hip_runtime.h>
#include <hip/hip_cooperative_groups.h>
#include <cstdio>
#include <cstdint>
namespace cg = cooperative_groups;

typedef unsigned short bf16_t;
typedef short bf16x8 __attribute__((ext_vector_type(8)));
typedef float f32x4 __attribute__((ext_vector_type(4)));
typedef float f32x16 __attribute__((ext_vector_type(16)));
typedef unsigned u32x4 __attribute__((ext_vector_type(4)));
typedef unsigned u32x2 __attribute__((ext_vector_type(2)));
typedef int i32x8 __attribute__((ext_vector_type(8)));
#define DI __device__ __forceinline__

constexpr int D_MODEL = 1024, BATCH = 8, SEQ = 4096, NTOK = BATCH * SEQ;
constexpr int NMIX = 1732, NMIX_PAD = 1792;
constexpr int P1_F8_COLS = 1408;
constexpr int PEER_N = 2048;
constexpr float ALPHA = 1.189207115002721f;
constexpr float LN_EPS = 1e-5f;
constexpr int NTHREADS = 256;
constexpr int LDS_BYTES = 77824;

constexpr size_t MB = 1024 * 1024;
constexpr size_t WS_CTL   = 0;
constexpr size_t WS_AMAX  = 65536 + 16384;
constexpr size_t WS_BAR   = 65536;
constexpr size_t WS_ROPE  = 1 * MB;
constexpr size_t WS_WINT  = 2 * MB;
constexpr size_t WS_WOT   = 6 * MB;
constexpr size_t WS_WQT   = 8 * MB;
constexpr size_t WS_SK    = 12 * MB;
constexpr size_t WS_UT    = 13 * MB;
constexpr size_t WS_VT    = 29 * MB;
constexpr size_t WS_SU    = 45 * MB;
constexpr size_t WS_SV    = 46 * MB;
constexpr size_t WS_SXR   = 47 * MB + 262144;
constexpr size_t WS_SWN   = 47 * MB + 524288;
constexpr size_t WS_X8    = 282 * MB;
constexpr size_t WS_SX    = 47 * MB;
constexpr size_t WS_XB    = 77 * MB;
constexpr size_t WS_QA    = 141 * MB;
constexpr size_t WS_KA    = 173 * MB;
constexpr size_t WS_VA    = 181 * MB;
constexpr size_t WS_QB    = 189 * MB;
constexpr size_t WS_KB    = 221 * MB;
constexpr size_t WS_VB    = 225 * MB;
constexpr size_t WS_QI    = 229 * MB;
constexpr size_t WS_KI    = 245 * MB;
constexpr size_t WS_WI    = 249 * MB;
constexpr size_t WS_ATT   = 250 * MB;
constexpr size_t WS_PE    = 314 * MB;
constexpr size_t WS_PG    = 322 * MB;
constexpr size_t WS_PS    = 338 * MB;
constexpr size_t WS_END   = 354 * MB;

struct Params {
    const float* x; const float* w_in; const float* idx_k_g; const float* idx_k_b; const float* sinks; const float* w_o;
    const float* ln1_g; const float* ln1_b; const float* peer_wq; const float* peer_subkeys; const float* peer_u; const float* peer_v;
    const float* ln2_g; const float* ln2_b;
    float* out; unsigned char* ws;
    int ph_lo, ph_hi;
};

typedef float f32x2 __attribute__((ext_vector_type(2)));
typedef __bf16 bf16x2_t __attribute__((ext_vector_type(2)));
DI unsigned pack_bf16(float lo, float hi) { const f32x2 v = {lo, hi}; return __builtin_bit_cast(unsigned, __builtin_convertvector(v, bf16x2_t)); }
DI unsigned f2bf(float x) { return pack_bf16(x, 0.f) & 0xffffu; }
DI float bf_lo(unsigned w) { return __uint_as_float(w << 16); }
DI float bf_hi(unsigned w) { return __uint_as_float(w & 0xffff0000u); }
DI bf16x8 as_bf16x8(u32x4 v) { return __builtin_bit_cast(bf16x8, v); }
DI u32x4 ldg16(const void* p) { return *(const u32x4*)p; }
DI f32x4 mfma16(bf16x8 a, bf16x8 b, f32x4 c) { return __builtin_amdgcn_mfma_f32_16x16x32_bf16(a, b, c, 0, 0, 0); }
DI f32x16 mfma32(bf16x8 a, bf16x8 b, f32x16 c) { return __builtin_amdgcn_mfma_f32_32x32x16_bf16(a, b, c, 0, 0, 0); }
DI float wave_sum(float v) {
#pragma unroll
    for (int o = 32; o >= 1; o >>= 1) v += __shfl_xor(v, o);
    return v;
}

DI void glds16(const void* src, void* lds_dst) { __builtin_amdgcn_global_load_lds((const unsigned*)src, (__attribute__((address_space(3))) unsigned*)lds_dst, 16, 0, 0); }
DI void gemm_128x128(const bf16_t* __restrict__ X, int ldx, const bf16_t* __restrict__ Wt, int ldw, int K, unsigned char* lds, f32x4 (&acc)[4][4]) {
    int tid = threadIdx.x; asm volatile("" : "+v"(tid));
    const int lane = tid & 63, wave = tid >> 6, wm = wave >> 1, wn = wave & 1, c = lane & 15, g = lane >> 4;
    const int lrow = tid >> 3, lch = tid & 7;
    const bf16_t* xp = X + (size_t)lrow * ldx + ((lch ^ (lrow & 7)) * 8);
    const bf16_t* wp = Wt + (size_t)lrow * ldw + ((lch ^ (lrow & 7)) * 8);
    unsigned char* dst0 = lds + tid * 16;
#pragma unroll
    for (int m = 0; m < 4; ++m)
#pragma unroll
        for (int n = 0; n < 4; ++n) acc[m][n] = (f32x4){0.f, 0.f, 0.f, 0.f};
    const int nk = K / 64;
    __syncthreads();
#pragma unroll
    for (int i = 0; i < 4; ++i) { glds16(xp + (size_t)(32 * i) * ldx, dst0 + i * 4096); glds16(wp + (size_t)(32 * i) * ldw, dst0 + 16384 + i * 4096); }
    asm volatile("s_waitcnt vmcnt(0)" ::: "memory");
    __syncthreads();
    for (int kt = 0; kt < nk; ++kt) {
        const unsigned char* Xs = lds + (kt & 1) * 32768; const unsigned char* Ws = Xs + 16384;
        if (kt + 1 < nk) {
            unsigned char* d = dst0 + ((kt + 1) & 1) * 32768;
#pragma unroll
            for (int i = 0; i < 4; ++i) { glds16(xp + (size_t)(32 * i) * ldx + (kt + 1) * 64, d + i * 4096); glds16(wp + (size_t)(32 * i) * ldw + (kt + 1) * 64, d + 16384 + i * 4096); }
        }
#pragma unroll
        for (int s = 0; s < 2; ++s) {
            bf16x8 xf[4], wf[4];
#pragma unroll
            for (int m = 0; m < 4; ++m) { const int row = wm * 64 + m * 16 + c; xf[m] = as_bf16x8(*(const u32x4*)(Xs + row * 128 + (((4 * s + g) ^ (c & 7)) << 4))); }
#pragma unroll
            for (int n = 0; n < 4; ++n) { const int row = wn * 64 + n * 16 + c; wf[n] = as_bf16x8(*(const u32x4*)(Ws + row * 128 + (((4 * s + g) ^ (c & 7)) << 4))); }
#pragma unroll
            for (int m = 0; m < 4; ++m)
#pragma unroll
                for (int n = 0; n < 4; ++n) acc[m][n] = mfma16(wf[n], xf[m], acc[m][n]);
        }
        asm volatile("s_waitcnt vmcnt(0)" ::: "memory");
        __syncthreads();
    }
}

DI void gemm8_128x128(const unsigned char* __restrict__ X, int ldx, const unsigned char* __restrict__ Wt, int ldw, int K, unsigned char* lds, f32x4 (&acc)[4][4]) {
    int tid = threadIdx.x; asm volatile("" : "+v"(tid));
    const int lane = tid & 63, wave = tid >> 6, wm = wave >> 1, wn = wave & 1, c = lane & 15, g = lane >> 4;
    const int lrow = tid >> 3, lch = tid & 7;
    const unsigned char* xp = X + (size_t)lrow * ldx + ((lch ^ (lrow & 7)) * 16);
    const unsigned char* wp = Wt + (size_t)lrow * ldw + ((lch ^ (lrow & 7)) * 16);
    unsigned char* dst0 = lds + tid * 16;
#pragma unroll
    for (int m = 0; m < 4; ++m)
#pragma unroll
        for (int n = 0; n < 4; ++n) acc[m][n] = (f32x4){0.f, 0.f, 0.f, 0.f};
    const int nk = K / 128;
    __syncthreads();
#pragma unroll
    for (int i = 0; i < 4; ++i) { glds16(xp + (size_t)(32 * i) * ldx, dst0 + i * 4096); glds16(wp + (size_t)(32 * i) * ldw, dst0 + 16384 + i * 4096); }
    asm volatile("s_waitcnt vmcnt(0)" ::: "memory");
    __syncthreads();
    for (int kt = 0; kt < nk; ++kt) {
        const unsigned char* Xs = lds + (kt & 1) * 32768; const unsigned char* Ws = Xs + 16384;
        if (kt + 1 < nk) {
            unsigned char* d = dst0 + ((kt + 1) & 1) * 32768;
#pragma unroll
            for (int i = 0; i < 4; ++i) { glds16(xp + (size_t)(32 * i) * ldx + (kt + 1) * 128, d + i * 4096); glds16(wp + (size_t)(32 * i) * ldw + (kt + 1) * 128, d + 16384 + i * 4096); }
        }
        i32x8 xf[4], wf[4];
#pragma unroll
        for (int m = 0; m < 4; ++m) {
            const int row = wm * 64 + m * 16 + c;
            const u32x4 lo = *(const u32x4*)(Xs + row * 128 + ((g ^ (c & 7)) << 4)), hi = *(const u32x4*)(Xs + row * 128 + (((4 + g) ^ (c & 7)) << 4));
            xf[m][0] = (int)lo.x; xf[m][1] = (int)lo.y; xf[m][2] = (int)lo.z; xf[m][3] = (int)lo.w; xf[m][4] = (int)hi.x; xf[m][5] = (int)hi.y; xf[m][6] = (int)hi.z; xf[m][7] = (int)hi.w;
        }
#pragma unroll
        for (int n = 0; n < 4; ++n) {
            const int row = wn * 64 + n * 16 + c;
            const u32x4 lo = *(const u32x4*)(Ws + row * 128 + ((g ^ (c & 7)) << 4)), hi = *(const u32x4*)(Ws + row * 128 + (((4 + g) ^ (c & 7)) << 4));
            wf[n][0] = (int)lo.x; wf[n][1] = (int)lo.y; wf[n][2] = (int)lo.z; wf[n][3] = (int)lo.w; wf[n][4] = (int)hi.x; wf[n][5] = (int)hi.y; wf[n][6] = (int)hi.z; wf[n][7] = (int)hi.w;
        }
#pragma unroll
        for (int m = 0; m < 4; ++m)
#pragma unroll
            for (int n = 0; n < 4; ++n) acc[m][n] = __builtin_amdgcn_mfma_scale_f32_16x16x128_f8f6f4(wf[n], xf[m], acc[m][n], 0, 0, 0, 0, 0, 0);
        asm volatile("s_waitcnt vmcnt(0)" ::: "memory");
        __syncthreads();
    }
}

DI bool tile_of(int k, int NT, int MT, int& mt, int& nt) {
    const int G = gridDim.x, bid = blockIdx.x;
    if (((G | MT) & 7) == 0) {
        const int idx = (bid >> 3) + k * (G >> 3);
        if (idx >= (MT >> 3) * NT) return false;
        mt = (idx / NT) * 8 + (bid & 7); nt = idx % NT;
    } else {
        const int t = bid + k * G;
        if (t >= MT * NT) return false;
        mt = t / NT; nt = t % NT;
    }
    return true;
}

DI void p0_prep(const Params& p, unsigned char* lds) {
    const int tid = threadIdx.x, nb = gridDim.x, bid = blockIdx.x;
    const size_t gtid = (size_t)bid * NTHREADS + tid, gsz = (size_t)nb * NTHREADS;
    unsigned char* ws = p.ws;
    constexpr int W_ITEMS = (P1_F8_COLS / 64) * 4 + ((NMIX_PAD - P1_F8_COLS) / 64) * 16;
    const int nwb = nb >= 8 ? (nb / 2 < W_ITEMS ? nb / 2 : W_ITEMS) : nb, nxb = nb >= 8 ? nb - nwb : nb;
    const bool xrole = nb < 8 || bid < nxb, wrole = nb < 8 || bid >= nxb;
    const int wbid = nb >= 8 ? bid - nxb : bid;
    {
        float* ct = (float*)(ws + WS_ROPE); float* stb = ct + SEQ * 32;
        for (size_t i = gtid; i < (size_t)SEQ * 32; i += gsz) {
            const int pos = (int)(i >> 5), fi = (int)(i & 31);
            const float inv = powf(10000.0f, -(float)(2 * fi) / 64.0f);
            const float ang = (float)pos * inv;
            ct[i] = cosf(ang); stb[i] = sinf(ang);
        }
    }
    auto conv = [&](const float* src, bf16_t* dst, size_t n) {
        for (size_t i = gtid * 8; i < n; i += gsz * 8) {
            const f32x4 a = *(const f32x4*)(src + i), b = *(const f32x4*)(src + i + 4);
            u32x4 o; o.x = pack_bf16(a.x, a.y); o.y = pack_bf16(a.z, a.w); o.z = pack_bf16(b.x, b.y); o.w = pack_bf16(b.z, b.w);
            *(u32x4*)(dst + i) = o;
        }
    };
    if ((bid & 7) == 0 || nb < 8) {
        const int sb = nb < 8 ? bid : (bid >> 3), nsb = nb < 8 ? nb : ((nb + 7) >> 3);
        float m = 0.f;
        for (size_t i = ((size_t)sb * NTHREADS + tid) * 4; i < (size_t)1024 * 1024; i += (size_t)nsb * NTHREADS * 4) { const f32x4 v = *(const f32x4*)(p.w_o + i); m = fmaxf(m, fmaxf(fmaxf(fabsf(v[0]), fabsf(v[1])), fmaxf(fabsf(v[2]), fabsf(v[3])))); }
#pragma unroll
        for (int o = 32; o >= 1; o >>= 1) m = fmaxf(m, __shfl_xor(m, o));
        float* red = (float*)lds;
        __syncthreads();
        if ((tid & 63) == 0) red[tid >> 6] = m;
        __syncthreads();
        if (tid == 0) { const float mm = fmaxf(fmaxf(red[0], red[1]), fmaxf(red[2], red[3])); if (mm > 0.f) atomicMax((unsigned*)(ws + WS_AMAX), __float_as_uint(mm)); }
        __syncthreads();
    }
    if (xrole) {
        const int lane = tid & 63, gw = bid * 4 + (tid >> 6), nw = nxb * 4;
        bf16_t* XBo = (bf16_t*)(ws + WS_XB); unsigned char* X8o = ws + WS_X8; float* SXRo = (float*)(ws + WS_SXR);
        for (int row0 = gw * 4; row0 < NTOK; row0 += nw * 4) {
            f32x4 v[4][4];
#pragma unroll
            for (int r = 0; r < 4; ++r)
#pragma unroll
                for (int i = 0; i < 4; ++i) v[r][i] = *(const f32x4*)(p.x + (size_t)(row0 + r) * 1024 + lane * 16 + 4 * i);
#pragma unroll
            for (int r = 0; r < 4; ++r) {
                const int row = row0 + r;
                float m = 0.f;
#pragma unroll
                for (int i = 0; i < 4; ++i) m = fmaxf(m, fmaxf(fmaxf(fabsf(v[r][i][0]), fabsf(v[r][i][1])), fmaxf(fabsf(v[r][i][2]), fabsf(v[r][i][3]))));
#pragma unroll
                for (int o = 32; o >= 1; o >>= 1) m = fmaxf(m, __shfl_xor(m, o));
                const float sc = m > 0.f ? 439.f / m : 1.f;
                u32x4 o0, o1, q8;
                o0.x = pack_bf16(v[r][0][0], v[r][0][1]); o0.y = pack_bf16(v[r][0][2], v[r][0][3]); o0.z = pack_bf16(v[r][1][0], v[r][1][1]); o0.w = pack_bf16(v[r][1][2], v[r][1][3]);
                o1.x = pack_bf16(v[r][2][0], v[r][2][1]); o1.y = pack_bf16(v[r][2][2], v[r][2][3]); o1.z = pack_bf16(v[r][3][0], v[r][3][1]); o1.w = pack_bf16(v[r][3][2], v[r][3][3]);
#pragma unroll
                for (int i = 0; i < 4; ++i) {
                    int pk = __builtin_amdgcn_cvt_pk_fp8_f32(v[r][i][0] * sc, v[r][i][1] * sc, 0, false);
                    pk = __builtin_amdgcn_cvt_pk_fp8_f32(v[r][i][2] * sc, v[r][i][3] * sc, pk, true);
                    q8[i] = (unsigned)pk;
                }
                *(u32x4*)(XBo + (size_t)row * 1024 + lane * 16) = o0; *(u32x4*)(XBo + (size_t)row * 1024 + lane * 16 + 8) = o1;
                *(u32x4*)(X8o + (size_t)row * 1024 + lane * 16) = q8;
                if (lane == 0) SXRo[row] = m > 0.f ? m * (1.f / 439.f) : 1.f;
            }
        }
    }
    conv(p.peer_subkeys, (bf16_t*)(ws + WS_SK), (size_t)8 * 2 * 128 * 128);
    float* tl = (float*)lds;
    auto transp = [&](const float* src, bf16_t* dst, int N, int Npad, int nt0) {
        const int tn = Npad / 64 - nt0, tk = 1024 / 64;
        for (int t = wbid - (P1_F8_COLS / 64) * 4; t < tn * tk; t += nwb) {
            if (t < 0) continue;
            const int n0 = (nt0 + t % tn) * 64, k0 = (t / tn) * 64;
            __syncthreads();
            for (int e = tid; e < 4096; e += NTHREADS) { const int kk = e >> 6, nn = e & 63; tl[kk * 65 + nn] = (n0 + nn < N) ? src[(size_t)(k0 + kk) * N + n0 + nn] : 0.f; }
            __syncthreads();
            for (int e = tid; e < 4096; e += NTHREADS) { const int nn = e >> 6, kk = e & 63; dst[(size_t)(n0 + nn) * 1024 + k0 + kk] = (bf16_t)f2bf(tl[kk * 65 + nn]); }
        }
    };
    if (wrole) transp(p.w_in, (bf16_t*)(ws + WS_WINT), NMIX, NMIX_PAD, P1_F8_COLS / 64);
    if (wrole) {
        unsigned char* w8 = ws + WS_WINT; float* swn = (float*)(ws + WS_SWN);
        float* cm = (float*)lds + 64 * 65;
        for (int item = wbid; item < (P1_F8_COLS / 64) * 4; item += nwb) {
            const int n0 = (item >> 2) * 64, kpart = item & 3;
            {
                const int n4 = (tid & 15) * 4, kq = tid >> 4;
                f32x4 m4 = {0.f, 0.f, 0.f, 0.f};
#pragma unroll 8
                for (int k2 = kq; k2 < 1024; k2 += 16) {
                    const f32x4 v = *(const f32x4*)(p.w_in + (size_t)k2 * NMIX + n0 + n4);
                    m4[0] = fmaxf(m4[0], fabsf(v[0])); m4[1] = fmaxf(m4[1], fabsf(v[1])); m4[2] = fmaxf(m4[2], fabsf(v[2])); m4[3] = fmaxf(m4[3], fabsf(v[3]));
                }
                __syncthreads();
                *(f32x4*)(cm + kq * 64 + n4) = m4;
                __syncthreads();
                if (tid < 64) {
                    float a = 0.f;
#pragma unroll
                    for (int r = 0; r < 16; ++r) a = fmaxf(a, cm[r * 64 + tid]);
                    cm[1024 + tid] = a > 0.f ? 439.f / a : 1.f;
                    if (kpart == 0) swn[n0 + tid] = a > 0.f ? a * (1.f / 439.f) : 1.f;
                }
            }
            for (int k0 = kpart * 256; k0 < kpart * 256 + 256; k0 += 64) {
                __syncthreads();
                for (int e = tid; e < 4096; e += NTHREADS) { const int kk = e >> 6, n2 = e & 63; tl[kk * 65 + n2] = p.w_in[(size_t)(k0 + kk) * NMIX + n0 + n2]; }
                __syncthreads();
                for (int e = tid; e < 1024; e += NTHREADS) {
                    const int n2 = e >> 4, kq4 = (e & 15) * 4; const float sc = cm[1024 + n2];
                    int pk = __builtin_amdgcn_cvt_pk_fp8_f32(tl[kq4 * 65 + n2] * sc, tl[(kq4 + 1) * 65 + n2] * sc, 0, false);
                    pk = __builtin_amdgcn_cvt_pk_fp8_f32(tl[(kq4 + 2) * 65 + n2] * sc, tl[(kq4 + 3) * 65 + n2] * sc, pk, true);
                    *(int*)(w8 + (size_t)(n0 + n2) * 1024 + k0 + kq4) = pk;
                }
            }
        }
    }
}

DI void p0_late(const Params& p, unsigned char* lds) {
    const int tid = threadIdx.x, nb = gridDim.x, bid = blockIdx.x;
    unsigned char* ws = p.ws;
    {
        const int lane = tid & 63, gw = bid * 4 + (tid >> 6), nw = nb * 4;
        for (int row0 = gw * 4; row0 < 2 * 16384; row0 += nw * 4) {
            f32x4 v[4][4];
#pragma unroll
            for (int r = 0; r < 4; ++r) {
                const int row = row0 + r; const bool isv = row >= 16384; const int e = isv ? row - 16384 : row;
                const float* src = (isv ? p.peer_v : p.peer_u) + (size_t)e * 1024 + lane * 16;
#pragma unroll
                for (int i = 0; i < 4; ++i) v[r][i] = *(const f32x4*)(src + 4 * i);
            }
#pragma unroll
            for (int r = 0; r < 4; ++r) {
                const int row = row0 + r; const bool isv = row >= 16384; const int e = isv ? row - 16384 : row;
                float mx = 0.f;
#pragma unroll
                for (int i = 0; i < 4; ++i) mx = fmaxf(mx, fmaxf(fmaxf(fabsf(v[r][i][0]), fabsf(v[r][i][1])), fmaxf(fabsf(v[r][i][2]), fabsf(v[r][i][3]))));
#pragma unroll
                for (int o = 32; o >= 1; o >>= 1) mx = fmaxf(mx, __shfl_xor(mx, o));
                const float sc = mx > 0.f ? mx * (1.0f / 5.99f) : 1.0f, inv = mx > 0.f ? 5.99f / mx : 1.0f;
                u32x2 o2;
#pragma unroll
                for (int k = 0; k < 2; ++k) {
                    unsigned w = 0;
                    w = __builtin_amdgcn_cvt_scalef32_pk_fp4_f32(w, v[r][2 * k][0] * inv, v[r][2 * k][1] * inv, 1.0f, 0);
                    w = __builtin_amdgcn_cvt_scalef32_pk_fp4_f32(w, v[r][2 * k][2] * inv, v[r][2 * k][3] * inv, 1.0f, 1);
                    w = __builtin_amdgcn_cvt_scalef32_pk_fp4_f32(w, v[r][2 * k + 1][0] * inv, v[r][2 * k + 1][1] * inv, 1.0f, 2);
                    w = __builtin_amdgcn_cvt_scalef32_pk_fp4_f32(w, v[r][2 * k + 1][2] * inv, v[r][2 * k + 1][3] * inv, 1.0f, 3);
                    o2[k] = w;
                }
                *(u32x2*)(ws + (isv ? WS_VT : WS_UT) + (size_t)e * 512 + lane * 8) = o2;
                if (lane == 0) ((float*)(ws + (isv ? WS_SV : WS_SU)))[e] = sc;
            }
        }
    }
    float* tl = (float*)lds;
    auto transp = [&](const float* src, bf16_t* dst, int N, int Npad) {
        const int tn = Npad / 64, tk = 1024 / 64;
        for (int t = bid; t < tn * tk; t += nb) {
            const int n0 = (t % tn) * 64, k0 = (t / tn) * 64;
            __syncthreads();
            for (int e = tid; e < 4096; e += NTHREADS) { const int kk = e >> 6, nn = e & 63; tl[kk * 65 + nn] = (n0 + nn < N) ? src[(size_t)(k0 + kk) * N + n0 + nn] : 0.f; }
            __syncthreads();
            for (int e = tid; e < 4096; e += NTHREADS) { const int nn = e >> 6, kk = e & 63; dst[(size_t)(n0 + nn) * 1024 + k0 + kk] = (bf16_t)f2bf(tl[kk * 65 + nn]); }
        }
    };
    {
        const float amax = __uint_as_float(*(const unsigned*)(ws + WS_AMAX)), sw = amax > 0.f ? 439.f / amax : 1.f;
        unsigned char* dst8 = ws + WS_WOT;
        for (int t = bid; t < 16 * 16; t += nb) {
            const int n0 = (t % 16) * 64, k0 = (t / 16) * 64;
            __syncthreads();
            for (int e = tid; e < 4096; e += NTHREADS) { const int kk = e >> 6, nn = e & 63; tl[kk * 65 + nn] = p.w_o[(size_t)(k0 + kk) * 1024 + n0 + nn]; }
            __syncthreads();
            for (int e = tid; e < 1024; e += NTHREADS) {
                const int nn = e >> 4, kq = (e & 15) * 4;
                int pk = __builtin_amdgcn_cvt_pk_fp8_f32(tl[kq * 65 + nn] * sw, tl[(kq + 1) * 65 + nn] * sw, 0, false);
                pk = __builtin_amdgcn_cvt_pk_fp8_f32(tl[(kq + 2) * 65 + nn] * sw, tl[(kq + 3) * 65 + nn] * sw, pk, true);
                *(int*)(dst8 + (size_t)(n0 + nn) * 1024 + k0 + kq) = pk;
            }
        }
    }
    transp(p.peer_wq, (bf16_t*)(ws + WS_WQT), PEER_N, PEER_N);
}

DI void p1_inproj(const Params& p, unsigned char* lds) {
    unsigned char* ws = p.ws;
    const bf16_t* XB = (const bf16_t*)(ws + WS_XB); const bf16_t* WT = (const bf16_t*)(ws + WS_WINT);
    const float* cosT = (const float*)(ws + WS_ROPE); const float* sinT = cosT + SEQ * 32;
    const int tid = threadIdx.x, lane = tid & 63, wave = tid >> 6, wm = wave >> 1, wn = wave & 1, c = lane & 15, g = lane >> 4;
    constexpr int NT = NMIX_PAD / 128, MT = NTOK / 128;
    int mt, nt;
    for (int k = 0; tile_of(k, NT, MT, mt, nt); ++k) {
        f32x4 acc[4][4];
        const bool f8 = nt < P1_F8_COLS / 128;
        if (f8) gemm8_128x128(ws + WS_X8 + (size_t)mt * 128 * 1024, 1024, ws + WS_WINT + (size_t)nt * 128 * 1024, 1024, 1024, lds, acc);
        else gemm_128x128(XB + (size_t)mt * 128 * 1024, 1024, WT + (size_t)nt * 128 * 1024, 1024, 1024, lds, acc);
        f32x4 swn4[4];
#pragma unroll
        for (int n = 0; n < 4; ++n) swn4[n] = f8 ? *(const f32x4*)((const float*)(ws + WS_SWN) + nt * 128 + wn * 64 + 16 * n + 4 * g) : (f32x4){1.f, 1.f, 1.f, 1.f};
        const int col64 = nt * 2 + wn;
        bf16_t* dst; int ld, coff; bool rope = true; float scale = 1.f; float vmax = 0.f;
        if (col64 < 8)       { dst = (bf16_t*)(ws + WS_QA); ld = 512; coff = col64 * 64; scale = 0.125f; }
        else if (col64 < 10) { dst = (bf16_t*)(ws + WS_KA); ld = 128; coff = (col64 - 8) * 64; }
        else if (col64 < 12) { dst = (bf16_t*)(ws + WS_VA); ld = 128; coff = (col64 - 10) * 64; rope = false; }
        else if (col64 < 20) { dst = (bf16_t*)(ws + WS_QB); ld = 512; coff = (col64 - 12) * 64; scale = 0.125f; }
        else if (col64 == 20) { dst = (bf16_t*)(ws + WS_KB); ld = 64; coff = 0; }
        else if (col64 == 21) { dst = (bf16_t*)(ws + WS_VB); ld = 64; coff = 0; rope = false; }
        else if (col64 < 26) { dst = (bf16_t*)(ws + WS_QI); ld = 256; coff = (col64 - 22) * 64; }
        else                 { dst = (bf16_t*)(ws + WS_KI); ld = 64; coff = 0; }
        if (col64 == 27) {
            if (g == 0) {
#pragma unroll
                for (int m = 0; m < 4; ++m) { const int tok = mt * 128 + wm * 64 + m * 16 + c; *(f32x4*)((float*)(ws + WS_WI) + (size_t)tok * 4) = acc[m][0] * 0.0625f; }
            }
            continue;
        }
#pragma unroll
        for (int m = 0; m < 4; ++m) {
            const int tok = mt * 128 + wm * 64 + m * 16 + c, pos = tok & (SEQ - 1);
            const float sxr = f8 ? ((const float*)(ws + WS_SXR))[tok] : 1.f;
            f32x4 v[4] = {acc[m][0] * (swn4[0] * sxr), acc[m][1] * (swn4[1] * sxr), acc[m][2] * (swn4[2] * sxr), acc[m][3] * (swn4[3] * sxr)};
            if (col64 == 26) {
                float s = 0.f;
#pragma unroll
                for (int n = 0; n < 4; ++n) s += (v[n][0] + v[n][1]) + (v[n][2] + v[n][3]);
                s += __shfl_xor(s, 16); s += __shfl_xor(s, 32);
                const float mu = s * (1.f / 64.f); float q = 0.f;
#pragma unroll
                for (int n = 0; n < 4; ++n) { const f32x4 d = v[n] - mu; q += (d[0] * d[0] + d[1] * d[1]) + (d[2] * d[2] + d[3] * d[3]); }
                q += __shfl_xor(q, 16); q += __shfl_xor(q, 32);
                const float rstd = rsqrtf(q * (1.f / 64.f) + LN_EPS);
#pragma unroll
                for (int n = 0; n < 4; ++n) {
                    const f32x4 gg = *(const f32x4*)(p.idx_k_g + 16 * n + 4 * g), bb = *(const f32x4*)(p.idx_k_b + 16 * n + 4 * g);
                    v[n] = (v[n] - mu) * rstd * gg + bb;
                }
            }
            if (rope) {
#pragma unroll
                for (int n = 0; n < 2; ++n) {
                    const f32x4 cs = *(const f32x4*)(cosT + pos * 32 + 16 * n + 4 * g), sn = *(const f32x4*)(sinT + pos * 32 + 16 * n + 4 * g);
                    const f32x4 t1 = v[n], t2 = v[n + 2];
                    v[n] = t1 * cs - t2 * sn; v[n + 2] = t2 * cs + t1 * sn;
                }
            }
#pragma unroll
            for (int n = 0; n < 4; ++n) {
                const f32x4 o = v[n] * scale; u32x2 w; w.x = pack_bf16(o[0], o[1]); w.y = pack_bf16(o[2], o[3]);
                *(u32x2*)(dst + (size_t)tok * ld + coff + 16 * n + 4 * g) = w;
                if (!rope) vmax = fmaxf(vmax, fmaxf(fmaxf(fabsf(o[0]), fabsf(o[1])), fmaxf(fabsf(o[2]), fabsf(o[3]))));
            }
        }
        if (!rope) {
#pragma unroll
            for (int o = 32; o >= 1; o >>= 1) vmax = fmaxf(vmax, __shfl_xor(vmax, o));
            if (lane == 0 && vmax > 0.f) atomicMax((unsigned*)(ws + WS_AMAX) + 1, __float_as_uint(vmax));
        }
    }
}

constexpr int NDSA = NTOK / 4, NSWA = BATCH * 32 * 8;
constexpr int P2_STG = 0  , P2_LIST = 32768;

DI unsigned f16_key(float v) {
    _Float16 hv = (_Float16)v; unsigned short hb = __builtin_bit_cast(unsigned short, hv); unsigned b = hb;
    if (b == 0x8000u) b = 0u;
    return (b & 0x8000u) ? ((~b) & 0xffffu) : (b | 0x8000u);
}

DI size_t sc_row_off(int t) { const size_t m = (size_t)(t >> 3); return 8 * (4 * m * (m + 1) + (size_t)(t & 7) * (m + 1)); }
constexpr size_t SC_BATCH = 8404992;
DI unsigned short* sc_batch_base(const Params& p, int b) { return (b < 7) ? (unsigned short*)p.out + (size_t)b * SC_BATCH : (unsigned short*)(p.ws + WS_PG); }

DI void p2a_indexer(const Params& p, unsigned char* lds) {
    unsigned char* ws = p.ws;
    const bf16_t* QI = (const bf16_t*)(ws + WS_QI); const bf16_t* KI = (const bf16_t*)(ws + WS_KI); const float* WI = (const float*)(ws + WS_WI);
    const int G = gridDim.x, bi = blockIdx.x;
    for (int it = 0; it < 2; ++it) {
        const int item = (it == 0) ? bi : 1023 - bi;
        for (int id = (G == 512) ? item : bi + it * G; id < 1024; id += (G == 512) ? 1024 : 2 * G) {
            int tid = threadIdx.x; asm volatile("" : "+v"(tid));
            const int lane = tid & 63, wave = tid >> 6, c = lane & 15, g = lane >> 4, lrow = tid >> 3, lch = tid & 7;
            const int b = id >> 7, t0 = (id & 127) * 32, tokw = b * SEQ + t0 + 8 * wave;
            unsigned short* scb = sc_batch_base(p, b);
            bf16x8 af[2][2]; f32x4 wv[2];
#pragma unroll
            for (int rt = 0; rt < 2; ++rt) {
#pragma unroll
                for (int s2 = 0; s2 < 2; ++s2) af[rt][s2] = as_bf16x8(ldg16(QI + (size_t)(tokw + 4 * rt + (c >> 2)) * 256 + (c & 3) * 64 + 32 * s2 + 8 * g));
                wv[rt] = *(const f32x4*)(WI + (size_t)(tokw + 4 * rt + g) * 4);
            }
            asm volatile("" :: "v"(af[0][0]), "v"(af[0][1]), "v"(af[1][0]), "v"(af[1][1]), "v"(wv[0]), "v"(wv[1]));
            const int nkt = ((t0 + 31) >> 7) + 1;
            const unsigned char* kib = (const unsigned char*)(KI + (size_t)b * SEQ * 64);
            unsigned char* dst0 = lds + tid * 16;
            auto stage = [&](int kt, int buf) {
#pragma unroll
                for (int i = 0; i < 4; ++i) {
                    const int row = lrow + 32 * i;
                    glds16(kib + (size_t)(kt * 128 + row) * 128 + ((lch ^ ((row >> 3) & 7)) << 4), dst0 + buf * 16384 + i * 4096);
                }
            };
            __syncthreads();
            stage(0, 0); if (nkt > 1) stage(1, 1);
            for (int kt = 0; kt < nkt; ++kt) {
                if (kt + 1 < nkt) asm volatile("s_waitcnt vmcnt(4)" ::: "memory");
                else asm volatile("s_waitcnt vmcnt(0)" ::: "memory");
                asm volatile("s_waitcnt lgkmcnt(0)" ::: "memory");
                __builtin_amdgcn_s_barrier();
                if (kt + 2 < nkt) stage(kt + 2, (kt + 2) % 3);
                const unsigned char* Ks = lds + (kt % 3) * 16384;
                unsigned res[2][4];
#pragma unroll
                for (int ct = 0; ct < 8; ++ct) {
                    const int row = 8 * c + ct;
                    const bf16x8 k0 = as_bf16x8(*(const u32x4*)(Ks + row * 128 + ((g ^ (c & 7)) << 4)));
                    const bf16x8 k1 = as_bf16x8(*(const u32x4*)(Ks + row * 128 + (((4 + g) ^ (c & 7)) << 4)));
#pragma unroll
                    for (int rt = 0; rt < 2; ++rt) {
                        f32x4 d = mfma16(af[rt][0], k0, (f32x4){0.f, 0.f, 0.f, 0.f});
                        d = mfma16(af[rt][1], k1, d);
                        const float sv = wv[rt][0] * fmaxf(d[0], 0.f) + wv[rt][1] * fmaxf(d[1], 0.f) + wv[rt][2] * fmaxf(d[2], 0.f) + wv[rt][3] * fmaxf(d[3], 0.f);
                        const int key = kt * 128 + row, tq = t0 + 8 * wave + 4 * rt + g;
                        const unsigned kv = (key <= tq) ? f16_key(sv) : 0u;
                        if (ct & 1) res[rt][ct >> 1] |= kv << 16; else res[rt][ct >> 1] = kv;
                    }
                }
#pragma unroll
                for (int rt = 0; rt < 2; ++rt) {
                    const int tq = t0 + 8 * wave + 4 * rt + g;
                    if (16 * kt + c <= (tq >> 3)) {
                        u32x4 w; w.x = res[rt][0]; w.y = res[rt][1]; w.z = res[rt][2]; w.w = res[rt][3];
                        *(u32x4*)(scb + sc_row_off(tq) + kt * 128 + 8 * c) = w;
                    }
                }
            }
        }
    }
    __syncthreads();
    p0_late(p, lds);
}

template <int MODE> DI void p2_dsa_item(const Params& p, unsigned char* lds, int b, int tb) {
    unsigned char* ws = p.ws;
    const bf16_t* QI = (const bf16_t*)(ws + WS_QI); const bf16_t* KI = (const bf16_t*)(ws + WS_KI); const float* WI = (const float*)(ws + WS_WI);
    const bf16_t* QB = (const bf16_t*)(ws + WS_QB); const bf16_t* KB = (const bf16_t*)(ws + WS_KB); const bf16_t* VB = (const bf16_t*)(ws + WS_VB);
    unsigned char* ATT8 = ws + WS_ATT;
    const float sa8 = 439.f / fmaxf(__uint_as_float(*(const unsigned*)(ws + WS_AMAX + 4)), 1e-30f);
    int tid = threadIdx.x; asm volatile("" : "+v"(tid));
    const int lane = tid & 63, wave = __builtin_amdgcn_readfirstlane(tid >> 6), c = lane & 15, g = lane >> 4;
    const int t0 = tb * 4, tok0 = b * SEQ + t0;
    unsigned char* stg = lds + P2_STG + wave * 8192;
    unsigned* hist = (unsigned*)stg;
    unsigned short* list = (unsigned short*)(lds + P2_LIST) + wave * 256;
    const int tok = tok0 + wave;
    if (!(MODE & 2)) return;
    const int n = t0 + wave + 1;
    const int L = n < 256 ? n : 256;
    const unsigned short* myk = sc_batch_base(p, b) + sc_row_off(t0 + wave);
    if (n <= 256) {
        for (int i = lane; i < n; i += 64) list[i] = (unsigned short)i;
    } else {
        u32x4 kk[8];
#pragma unroll
        for (int i = 0; i < 8; ++i) kk[i] = (512 * i + 8 * lane < n) ? ldg16(myk + 512 * i + 8 * lane) : (u32x4){0u, 0u, 0u, 0u};
#pragma unroll
        for (int i = 0; i < 4; ++i) *(u32x4*)(hist + lane * 16 + i * 4) = (u32x4){0u, 0u, 0u, 0u};
#pragma unroll
        for (int i = 0; i < 8; ++i) {
            if (512 * i < n) {
#pragma unroll
                for (int w = 0; w < 4; ++w) { const unsigned wd = kk[i][w]; atomicAdd(&hist[(wd & 0xffffu) >> 6], 1u); atomicAdd(&hist[wd >> 22], 1u); }
            }
        }
        unsigned h[16];
#pragma unroll
        for (int i = 0; i < 4; ++i) { const u32x4 t = *(const u32x4*)(hist + lane * 16 + i * 4); h[4 * i] = t.x; h[4 * i + 1] = t.y; h[4 * i + 2] = t.z; h[4 * i + 3] = t.w; }
#pragma unroll
        for (int i = 0; i < 4; ++i) *(u32x4*)(hist + lane * 16 + i * 4) = (u32x4){0u, 0u, 0u, 0u};
        unsigned sl = 0;
#pragma unroll
        for (int i = 0; i < 16; ++i) sl += h[i];
        unsigned pre = sl;
#pragma unroll
        for (int o = 1; o < 64; o <<= 1) { const unsigned t = __shfl_up(pre, o); if (lane >= o) pre += t; }
        const unsigned tot = __shfl(pre, 63);
        const unsigned suf = tot - pre;
        int found = -1; unsigned cab = 0, cum = suf;
#pragma unroll
        for (int j = 15; j >= 0; --j) { const bool hit = (found < 0) && (cum + h[j] >= 256u); if (hit) { found = lane * 16 + j; cab = cum; } cum += h[j]; }
        const bool mine = (suf < 256u) && (suf + sl >= 256u);
        const unsigned long long mm = __ballot(mine);
        const int src = __ffsll((long long)mm) - 1;
        const unsigned bstar = (unsigned)__shfl(found, src), cabove = __shfl(cab, src);
        const unsigned r1 = 256u - cabove;
#pragma unroll
        for (int i = 0; i < 8; ++i) {
            if (512 * i < n) {
#pragma unroll
                for (int w = 0; w < 4; ++w) {
                    const unsigned wd = kk[i][w];
                    if (((wd & 0xffffu) >> 6) == bstar) atomicAdd(&hist[wd & 63u], 1u);
                    if ((wd >> 22) == bstar) atomicAdd(&hist[(wd >> 16) & 63u], 1u);
                }
            }
        }
        const unsigned cnt = hist[lane];
        hist[lane] = 0u;
        unsigned pre2 = cnt;
#pragma unroll
        for (int o = 1; o < 64; o <<= 1) { const unsigned t = __shfl_up(pre2, o); if (lane >= o) pre2 += t; }
        const unsigned tot2 = __shfl(pre2, 63);
        const unsigned suf2 = tot2 - pre2;
        const bool mine2 = (suf2 < r1) && (suf2 + cnt >= r1);
        const unsigned long long mm2 = __ballot(mine2);
        const int src2 = __ffsll((long long)mm2) - 1;
        const unsigned T = (bstar << 6) | (unsigned)src2;
        const unsigned req = r1 - __shfl(suf2, src2);
        const unsigned toteq = __shfl(cnt, src2);
        const bool alleq = (req == toteq);
        const unsigned Tt = alleq ? T : T + 1u;
        unsigned cg = 0;
#pragma unroll
        for (int i = 0; i < 8; ++i)
#pragma unroll
            for (int w = 0; w < 4; ++w) { const unsigned wd = kk[i][w]; cg += ((wd & 0xffffu) >= Tt) ? 1u : 0u; cg += ((wd >> 16) >= Tt) ? 1u : 0u; }
        unsigned pre3 = cg;
#pragma unroll
        for (int o = 1; o < 64; o <<= 1) { const unsigned t = __shfl_up(pre3, o); if (lane >= o) pre3 += t; }
        unsigned off = pre3 - cg;
#pragma unroll
        for (int i = 0; i < 8; ++i)
#pragma unroll
            for (int w = 0; w < 4; ++w) {
                const unsigned wd = kk[i][w]; const int idx = 512 * i + 8 * lane + 2 * w;
                if ((wd & 0xffffu) >= Tt) { list[off & 255u] = (unsigned short)idx; ++off; }
                if ((wd >> 16) >= Tt) { list[off & 255u] = (unsigned short)(idx + 1); ++off; }
            }
        if (!alleq) {
            const unsigned cgt = 256u - req; unsigned eq_run = 0;
            for (int base = 0; base < n; base += 64) {
                const int i = base + lane; const unsigned m = (i < n) ? myk[i] : 0u;
                const bool eq = (m == T);
                const unsigned long long eqm = __ballot(eq);
                const unsigned rank = eq_run + __builtin_amdgcn_mbcnt_hi((unsigned)(eqm >> 32), __builtin_amdgcn_mbcnt_lo((unsigned)eqm, 0u));
                if (eq && rank < req) list[cgt + rank] = (unsigned short)i;
                eq_run += (unsigned)__popcll(eqm);
            }
        }
    }
    if (!(MODE & 4)) return;
    bf16x8 qf[2], sel[2];
#pragma unroll
    for (int s = 0; s < 2; ++s) {
        u32x4 t = (u32x4){0u, 0u, 0u, 0u};
        if (c < 8) t = ldg16(QB + (size_t)tok * 512 + c * 64 + 32 * s + 8 * g);
        qf[s] = as_bf16x8(t);
#pragma unroll
        for (int j = 0; j < 8; ++j) sel[s][j] = (8 * g + j == 16 * s + c) ? (short)0x3F80 : (short)0;
    }
    f32x4 st[16];
    const unsigned char* kbb = (const unsigned char*)(KB + (size_t)b * SEQ * 64); const unsigned char* vbb = (const unsigned char*)(VB + (size_t)b * SEQ * 64);
    const int lr = lane >> 3, lc = lane & 7;
    const unsigned st_off = lr * 128 + ((lc ^ lr) << 4);
    auto loadg = [&](const unsigned char* base, int T0, u32x4 (&dst)[8]) {
#pragma unroll
        for (int i = 0; i < 8; ++i) {
            const int idx = T0 * 16 + i * 8 + lr; const unsigned kid = (idx < L) ? (unsigned)list[idx] : 0u;
            dst[i] = ldg16(base + kid * 128u + lc * 16u);
        }
    };
    auto stage = [&](const u32x4 (&src)[8]) {
#pragma unroll
        for (int i = 0; i < 8; ++i) *(u32x4*)(stg + i * 1024 + st_off) = src[i];
    };
    auto frag = [&](int u, int s2) -> bf16x8 { return as_bf16x8(*(const u32x4*)(stg + (16 * u + c) * 128 + (((4 * s2 + g) ^ (c & 7)) << 4))); };
    auto scoreK = [&](int T0) {
#pragma unroll
        for (int T = 0; T < 4; ++T) {
            f32x4 d = mfma16(frag(T, 0), qf[0], (f32x4){0.f, 0.f, 0.f, 0.f});
            st[T0 + T] = mfma16(frag(T, 1), qf[1], d);
        }
    };
    u32x4 rA[8], rB[8], rC[8], rD[8];
    loadg(kbb, 0, rA); loadg(kbb, 4, rB); loadg(kbb, 8, rC); loadg(kbb, 12, rD);
    __builtin_amdgcn_sched_barrier(0);
    stage(rA); scoreK(0);
    stage(rB); scoreK(4);
    __builtin_amdgcn_sched_barrier(0);
    loadg(vbb, 0, rA); loadg(vbb, 4, rB);
    stage(rC); scoreK(8);
    stage(rD); scoreK(12);
    __builtin_amdgcn_sched_barrier(0);
    float mx = -3.0e38f;
    {
        const int lrem = L - 4 * g;
#pragma unroll
        for (int T = 0; T < 16; ++T)
#pragma unroll
            for (int r = 0; r < 4; ++r) { const float sv = (T * 16 + r < lrem) ? st[T][r] : -3.0e38f; st[T][r] = sv; mx = fmaxf(mx, sv); }
    }
    mx = fmaxf(mx, __shfl_xor(mx, 16)); mx = fmaxf(mx, __shfl_xor(mx, 32));
    float lsum = 0.f;
#pragma unroll
    for (int T = 0; T < 16; ++T)
#pragma unroll
        for (int r = 0; r < 4; ++r) { const float e = __expf(st[T][r] - mx); st[T][r] = e; lsum += e; }
    lsum += __shfl_xor(lsum, 16); lsum += __shfl_xor(lsum, 32);
    const float rl = 1.0f / lsum;
    u32x4 pfv[8];
#pragma unroll
    for (int u = 0; u < 8; ++u) {
        const int Ta = 2 * u, Tb = Ta + 1;
        pfv[u].x = pack_bf16(st[Ta][0] * rl, st[Ta][1] * rl); pfv[u].y = pack_bf16(st[Ta][2] * rl, st[Ta][3] * rl);
        pfv[u].z = pack_bf16(st[Tb][0] * rl, st[Tb][1] * rl); pfv[u].w = pack_bf16(st[Tb][2] * rl, st[Tb][3] * rl);
    }
    __builtin_amdgcn_sched_barrier(0);
    f32x4 O[4];
#pragma unroll
    for (int cb = 0; cb < 4; ++cb) O[cb] = (f32x4){0.f, 0.f, 0.f, 0.f};
    auto pv = [&](int T0) {
#pragma unroll
        for (int u = 0; u < 2; ++u) {
            const u32x4 pf = pfv[(T0 >> 1) + u];
#pragma unroll
            for (int cb = 0; cb < 4; ++cb) {
                const f32x4 z = (f32x4){0.f, 0.f, 0.f, 0.f};
                const f32x4 v0 = mfma16(frag(2 * u, cb >> 1), sel[cb & 1], z), v1 = mfma16(frag(2 * u + 1, cb >> 1), sel[cb & 1], z);
                u32x4 vf; vf.x = pack_bf16(v0[0], v0[1]); vf.y = pack_bf16(v0[2], v0[3]); vf.z = pack_bf16(v1[0], v1[1]); vf.w = pack_bf16(v1[2], v1[3]);
                O[cb] = mfma16(as_bf16x8(pf), as_bf16x8(vf), O[cb]);
            }
        }
    };
    loadg(vbb, 8, rC); loadg(vbb, 12, rD);
    __builtin_amdgcn_sched_barrier(0);
    stage(rA); pv(0);
    stage(rB); pv(4);
    __builtin_amdgcn_sched_barrier(0);
    stage(rC); pv(8);
    stage(rD); pv(12);
    if (g < 2) {
#pragma unroll
        for (int cb = 0; cb < 4; ++cb)
#pragma unroll
            for (int r = 0; r < 4; ++r) ATT8[(size_t)tok * 1024 + 512 + (4 * g + r) * 64 + 16 * cb + c] = (unsigned char)__builtin_amdgcn_cvt_pk_fp8_f32(O[cb][r] * sa8, 0.f, 0, false);
    }
}

DI void p2_swa_item(const Params& p, int item2) {
    unsigned char* ws = p.ws;
    const bf16_t* QA = (const bf16_t*)(ws + WS_QA); const bf16_t* KA = (const bf16_t*)(ws + WS_KA); const bf16_t* VA = (const bf16_t*)(ws + WS_VA);
    unsigned char* ATT8 = ws + WS_ATT;
    const float sa8 = 439.f / fmaxf(__uint_as_float(*(const unsigned*)(ws + WS_AMAX + 4)), 1e-30f);
    int tid = threadIdx.x; asm volatile("" : "+v"(tid));
    const int lane = tid & 63, wave = __builtin_amdgcn_readfirstlane(tid >> 6), r = lane & 31, h = lane >> 5;
    const int hq = item2 & 7, blk = (item2 >> 3) & 31, b = item2 >> 8, kvh = hq >> 2;
    const int qi = 32 * wave + r, tokq = b * SEQ + blk * 128 + qi;
    bf16x8 qf[4], sel[2];
#pragma unroll
    for (int s = 0; s < 4; ++s) qf[s] = as_bf16x8(ldg16(QA + (size_t)tokq * 512 + hq * 64 + 16 * s + 8 * h));
#pragma unroll
    for (int x = 0; x < 2; ++x)
#pragma unroll
        for (int j = 0; j < 8; ++j) sel[x][j] = (8 * h + j + 16 * x == r) ? (short)0x3F80 : (short)0;
    const float sink = p.sinks[hq];
    f32x16 ST[5];
#pragma unroll
    for (int ti = 0; ti < 5; ++ti) {
        const int sj = 32 * (wave + ti) + r; int pos = blk * 128 - 128 + sj; pos = pos < 0 ? 0 : pos;
        const bf16_t* kp = KA + (size_t)(b * SEQ + pos) * 128 + kvh * 64 + 8 * h;
        f32x16 d; for (int i = 0; i < 16; ++i) d[i] = 0.f;
#pragma unroll
        for (int s = 0; s < 4; ++s) d = mfma32(as_bf16x8(ldg16(kp + 16 * s)), qf[s], d);
        ST[ti] = d;
    }
    float mx = sink;
    {
        const int lo = r + 1 - 4 * h;
        const int lo0 = (blk > 0) ? lo : (lo > 128 - 32 * wave - 4 * h ? lo : 128 - 32 * wave - 4 * h);
#pragma unroll
        for (int ti = 0; ti < 5; ++ti)
#pragma unroll
            for (int reg = 0; reg < 16; ++reg) {
                const int e = 32 * ti + (reg & 3) + 8 * (reg >> 2);
                const float sv = (e >= lo0 && e < lo + 128) ? ST[ti][reg] : -3.0e38f; ST[ti][reg] = sv; mx = fmaxf(mx, sv);
            }
    }
    mx = fmaxf(mx, __shfl_xor(mx, 32));
    float lsum = 0.f;
#pragma unroll
    for (int ti = 0; ti < 5; ++ti)
#pragma unroll
        for (int reg = 0; reg < 16; ++reg) { const float e = __expf(ST[ti][reg] - mx); ST[ti][reg] = e; lsum += e; }
    lsum += __shfl_xor(lsum, 32);
    lsum += __expf(sink - mx);
    const float rl = 1.0f / lsum;
    f32x16 OT[2];
    for (int i = 0; i < 16; ++i) { OT[0][i] = 0.f; OT[1][i] = 0.f; }
#pragma unroll
    for (int ti = 0; ti < 5; ++ti) {
        const int sj = 32 * (wave + ti) + r; int pos = blk * 128 - 128 + sj; pos = pos < 0 ? 0 : pos;
        const bf16_t* vp = VA + (size_t)(b * SEQ + pos) * 128 + kvh * 64 + 8 * h;
        bf16x8 vf[4];
#pragma unroll
        for (int s = 0; s < 4; ++s) vf[s] = as_bf16x8(ldg16(vp + 16 * s));
        u32x4 pb[2];
#pragma unroll
        for (int s2 = 0; s2 < 2; ++s2) {
            pb[s2].x = pack_bf16(ST[ti][8 * s2 + 0] * rl, ST[ti][8 * s2 + 1] * rl); pb[s2].y = pack_bf16(ST[ti][8 * s2 + 2] * rl, ST[ti][8 * s2 + 3] * rl);
            pb[s2].z = pack_bf16(ST[ti][8 * s2 + 4] * rl, ST[ti][8 * s2 + 5] * rl); pb[s2].w = pack_bf16(ST[ti][8 * s2 + 6] * rl, ST[ti][8 * s2 + 7] * rl);
        }
#pragma unroll
        for (int db = 0; db < 2; ++db) {
            f32x16 vt; for (int i = 0; i < 16; ++i) vt[i] = 0.f;
            vt = mfma32(vf[2 * db], sel[0], vt); vt = mfma32(vf[2 * db + 1], sel[1], vt);
#pragma unroll
            for (int s2 = 0; s2 < 2; ++s2) {
                u32x4 va; va.x = pack_bf16(vt[8 * s2 + 0], vt[8 * s2 + 1]); va.y = pack_bf16(vt[8 * s2 + 2], vt[8 * s2 + 3]);
                va.z = pack_bf16(vt[8 * s2 + 4], vt[8 * s2 + 5]); va.w = pack_bf16(vt[8 * s2 + 6], vt[8 * s2 + 7]);
                OT[db] = mfma32(as_bf16x8(va), as_bf16x8(pb[s2]), OT[db]);
            }
        }
    }
#pragma unroll
    for (int db = 0; db < 2; ++db)
#pragma unroll
        for (int q4 = 0; q4 < 4; ++q4) {
            int pk = __builtin_amdgcn_cvt_pk_fp8_f32(OT[db][4 * q4] * sa8, OT[db][4 * q4 + 1] * sa8, 0, false);
            pk = __builtin_amdgcn_cvt_pk_fp8_f32(OT[db][4 * q4 + 2] * sa8, OT[db][4 * q4 + 3] * sa8, pk, true);
            *(int*)(ATT8 + (size_t)tokq * 1024 + hq * 64 + 32 * db + 8 * q4 + 4 * h) = pk;
        }
}

template <int MODE> DI void p2_attention(const Params& p, unsigned char* lds, int cidx = 0) {
    const int G = gridDim.x, bi = blockIdx.x, rounds = (1024 + G - 1) / G;
    for (int b = 0; b < BATCH; ++b)
        for (int r = 0; r < rounds; ++r) {
            const int idx = (r & 1) ? r * G + (G - 1 - bi) : r * G + bi;
            if (idx < 1024) p2_dsa_item<MODE>(p, lds, b, 1023 - idx);
        }
    if (MODE & 8) for (int item2 = bi; item2 < NSWA; item2 += G) p2_swa_item(p, item2);
}

DI void p3_outproj(const Params& p, unsigned char* lds) {
    unsigned char* ws = p.ws;
    const unsigned char* ATT8 = ws + WS_ATT; const unsigned char* WT8 = ws + WS_WOT;
    const float desc = (fmaxf(__uint_as_float(*(const unsigned*)(ws + WS_AMAX + 4)), 1e-30f) * (1.f / 439.f)) * (fmaxf(__uint_as_float(*(const unsigned*)(ws + WS_AMAX)), 1e-30f) * (1.f / 439.f));
    const int tid = threadIdx.x, lane = tid & 63, wave = tid >> 6, wm = wave >> 1, wn = wave & 1, c = lane & 15, g = lane >> 4;
    constexpr int NT = 8, MT = NTOK / 128;
    int mt, nt;
    for (int k = 0; tile_of(k, NT, MT, mt, nt); ++k) {
        f32x4 acc[4][4];
        gemm8_128x128(ATT8 + (size_t)mt * 128 * 1024, 1024, WT8 + (size_t)nt * 128 * 1024, 1024, 1024, lds, acc);
#pragma unroll
        for (int m = 0; m < 4; ++m) {
            const int tok = mt * 128 + wm * 64 + m * 16 + c;
#pragma unroll
            for (int n = 0; n < 4; ++n) {
                const size_t o = (size_t)tok * 1024 + nt * 128 + wn * 64 + 16 * n + 4 * g;
                const u32x2 xw = *(const u32x2*)((const bf16_t*)(ws + WS_XB) + o);
                const f32x4 xv = {bf_lo(xw.x), bf_hi(xw.x), bf_lo(xw.y), bf_hi(xw.y)};
                const f32x4 hv = xv * ALPHA + acc[m][n] * desc;
                u32x2 w; w.x = pack_bf16(hv[0], hv[1]); w.y = pack_bf16(hv[2], hv[3]);
                *(u32x2*)((bf16_t*)p.out + o) = w;
            }
        }
    }
}

DI void p3b_ln1(const Params& p) {
    bf16_t* H1B = (bf16_t*)(p.ws + WS_XB); const bf16_t* HP = (const bf16_t*)p.out;
    const int lane = threadIdx.x & 63, gw = blockIdx.x * 4 + (threadIdx.x >> 6), nw = gridDim.x * 4;
    for (int row = gw; row < NTOK; row += nw) {
        const u32x4 ra = ldg16(HP + (size_t)row * 1024 + lane * 16), rb = ldg16(HP + (size_t)row * 1024 + lane * 16 + 8);
        float v[16];
        v[0] = bf_lo(ra.x); v[1] = bf_hi(ra.x); v[2] = bf_lo(ra.y); v[3] = bf_hi(ra.y); v[4] = bf_lo(ra.z); v[5] = bf_hi(ra.z); v[6] = bf_lo(ra.w); v[7] = bf_hi(ra.w);
        v[8] = bf_lo(rb.x); v[9] = bf_hi(rb.x); v[10] = bf_lo(rb.y); v[11] = bf_hi(rb.y); v[12] = bf_lo(rb.z); v[13] = bf_hi(rb.z); v[14] = bf_lo(rb.w); v[15] = bf_hi(rb.w);
        float s = 0.f;
#pragma unroll
        for (int i = 0; i < 16; ++i) s += v[i];
        const float mu = wave_sum(s) * (1.f / 1024.f); float q = 0.f;
#pragma unroll
        for (int i = 0; i < 16; ++i) { const float d = v[i] - mu; q = fmaf(d, d, q); }
        const float rstd = rsqrtf(wave_sum(q) * (1.f / 1024.f) + LN_EPS);
        u32x4 oa, ob; float ov[16]; float amax = 0.f;
#pragma unroll
        for (int k4 = 0; k4 < 4; ++k4) {
            const int col = lane * 16 + k4 * 4;
            const f32x4 gg = *(const f32x4*)(p.ln1_g + col), bb = *(const f32x4*)(p.ln1_b + col);
            float o[4];
#pragma unroll
            for (int e = 0; e < 4; ++e) { o[e] = (v[k4 * 4 + e] - mu) * rstd * gg[e] + bb[e]; ov[k4 * 4 + e] = o[e]; amax = fmaxf(amax, fabsf(o[e])); }
            const unsigned w0 = pack_bf16(o[0], o[1]), w1 = pack_bf16(o[2], o[3]);
            if (k4 == 0) { oa.x = w0; oa.y = w1; } else if (k4 == 1) { oa.z = w0; oa.w = w1; } else if (k4 == 2) { ob.x = w0; ob.y = w1; } else { ob.z = w0; ob.w = w1; }
        }
        *(u32x4*)(H1B + (size_t)row * 1024 + lane * 16) = oa; *(u32x4*)(H1B + (size_t)row * 1024 + lane * 16 + 8) = ob;
        {
#pragma unroll
            for (int o2 = 32; o2 >= 1; o2 >>= 1) amax = fmaxf(amax, __shfl_xor(amax, o2));
            const float sx = amax > 0.f ? amax * (1.0f / 440.0f) : 1.0f, inv = amax > 0.f ? 440.0f / amax : 1.0f;
            u32x4 q8;
#pragma unroll
            for (int k4 = 0; k4 < 4; ++k4) {
                int w = 0;
                w = __builtin_amdgcn_cvt_pk_fp8_f32(ov[4 * k4] * inv, ov[4 * k4 + 1] * inv, w, false);
                w = __builtin_amdgcn_cvt_pk_fp8_f32(ov[4 * k4 + 2] * inv, ov[4 * k4 + 3] * inv, w, true);
                q8[k4] = (unsigned)w;
            }
            *(u32x4*)(p.ws + WS_QA + (size_t)row * 1024 + lane * 16) = q8;
            if (lane == 0) ((float*)(p.ws + WS_SX))[row] = sx;
        }
    }
}

DI int f2key(float v) { const int b = __float_as_int(v); return b ^ ((b >> 31) & 0x7fffffff); }
DI float key2f(int k) { return __int_as_float(k ^ ((k >> 31) & 0x7fffffff)); }
DI void ce_desc(int& a, int& b) { const int hi = a > b ? a : b, lo = a > b ? b : a; a = hi; b = lo; }
DI void bitonic_merge16(int (&k)[16]) {
#pragma unroll
    for (int d = 8; d >= 1; d >>= 1)
#pragma unroll
        for (int i = 0; i < 16; ++i) if ((i & d) == 0) ce_desc(k[i], k[i | d]);
}
DI void bitonic_sort16(int (&k)[16]) {
#pragma unroll
    for (int sz = 2; sz <= 16; sz <<= 1) {
#pragma unroll
        for (int i = 0; i < 16; ++i) { const int j = i ^ (sz - 1); if (j > i) ce_desc(k[i], k[j]); }
#pragma unroll
        for (int d = sz >> 2; d >= 1; d >>= 1)
#pragma unroll
            for (int i = 0; i < 16; ++i) if ((i & d) == 0) ce_desc(k[i], k[i | d]);
    }
}
DI void top16_merge(int (&t)[16], const int (&sdesc)[16]) {
#pragma unroll
    for (int i = 0; i < 16; ++i) t[i] = t[i] > sdesc[15 - i] ? t[i] : sdesc[15 - i];
    bitonic_merge16(t);
}
constexpr int P4_QS = 32768, P4_SS_STRIDE = 132, P4_ST0 = 67584  , P4_M = 0  , P4_ST1 = 8704  ;

DI void p4_peer_query(const Params& p, unsigned char* lds) {
    unsigned char* ws = p.ws;
    const bf16_t* H1B = (const bf16_t*)(ws + WS_XB); const bf16_t* WQT = (const bf16_t*)(ws + WS_WQT); const bf16_t* SK = (const bf16_t*)(ws + WS_SK);
    unsigned short* PE = (unsigned short*)(ws + WS_PE); float* PG = (float*)(ws + WS_PG); float* PS = (float*)(ws + WS_PS);
    const float* SU = (const float*)(ws + WS_SU); const float* SV = (const float*)(ws + WS_SV);
    float* Ss = (float*)lds;
    float* st0 = (float*)(lds + P4_ST0); float* mbuf = (float*)(lds + P4_M); float* st1 = (float*)(lds + P4_ST1);
    constexpr int MT = NTOK / 128;
    int mt, head;
    for (int k = 0; tile_of(k, 8, MT, mt, head); ++k) {
        int tid = threadIdx.x; asm volatile("" : "+v"(tid));
        const int lane = tid & 63, wave = tid >> 6, wm = wave >> 1, wn = wave & 1, c = lane & 15, g = lane >> 4;
        const int lrow = tid >> 3, lch = tid & 7;
        const int srow = tid & 127, shalf = tid >> 7;
#pragma unroll 1
        for (int ph = 0; ph < 2; ++ph) {
            f32x4 acc[4][4];
            gemm_128x128(H1B + (size_t)mt * 128 * 1024, 1024, WQT + (size_t)(head * 256 + ph * 128) * 1024, 1024, 1024, lds, acc);
            __syncthreads();
#pragma unroll
            for (int m = 0; m < 4; ++m)
#pragma unroll
                for (int n = 0; n < 4; ++n) {
                    const int row = wm * 64 + m * 16 + c;
                    u32x2 w; w.x = pack_bf16(acc[m][n][0], acc[m][n][1]); w.y = pack_bf16(acc[m][n][2], acc[m][n][3]);
                    *(u32x2*)(lds + P4_QS + wn * 16384 + row * 128 + (((2 * n + (g >> 1)) ^ (row & 7)) << 4) + (g & 1) * 8) = w;
                }
            {
                const bf16_t* sp = SK + (size_t)((head * 2 + ph) * 128 + lrow) * 128 + lch * 8;
#pragma unroll
                for (int k2 = 0; k2 < 2; ++k2)
#pragma unroll
                    for (int i = 0; i < 4; ++i) *(u32x4*)(lds + k2 * 16384 + (lrow + 32 * i) * 128 + ((lch ^ (lrow & 7)) << 4)) = ldg16(sp + (size_t)(32 * i) * 128 + k2 * 64);
            }
            __syncthreads();
            f32x4 a2[4][4];
#pragma unroll
            for (int m = 0; m < 4; ++m)
#pragma unroll
                for (int n = 0; n < 4; ++n) a2[m][n] = (f32x4){0.f, 0.f, 0.f, 0.f};
#pragma unroll
            for (int k2 = 0; k2 < 2; ++k2)
#pragma unroll
                for (int s = 0; s < 2; ++s) {
                    bf16x8 xf[4], wf[4];
#pragma unroll
                    for (int m = 0; m < 4; ++m) { const int row = wm * 64 + m * 16 + c; xf[m] = as_bf16x8(*(const u32x4*)(lds + P4_QS + k2 * 16384 + row * 128 + (((4 * s + g) ^ (c & 7)) << 4))); }
#pragma unroll
                    for (int n = 0; n < 4; ++n) { const int row = wn * 64 + n * 16 + c; wf[n] = as_bf16x8(*(const u32x4*)(lds + k2 * 16384 + row * 128 + (((4 * s + g) ^ (c & 7)) << 4))); }
#pragma unroll
                    for (int m = 0; m < 4; ++m)
#pragma unroll
                        for (int n = 0; n < 4; ++n) a2[m][n] = mfma16(wf[n], xf[m], a2[m][n]);
                }
            __syncthreads();
#pragma unroll
            for (int m = 0; m < 4; ++m)
#pragma unroll
                for (int n = 0; n < 4; ++n) {
                    const int key0 = wn * 64 + 16 * n + 4 * g;
                    u32x4 w;
#pragma unroll
                    for (int r = 0; r < 4; ++r) w[r] = (unsigned)f2key(__uint_as_float((__float_as_uint(a2[m][n][r]) & 0xFFFFFF80u) | (unsigned)(key0 + r)));
                    *(u32x4*)(Ss + (wm * 64 + m * 16 + c) * P4_SS_STRIDE + key0) = w;
                }
            __syncthreads();
            int tv[16];
            {
                const int* rowp = (const int*)Ss + srow * P4_SS_STRIDE + shalf * 64;
#pragma unroll
                for (int bt = 0; bt < 4; ++bt) {
                    int bk[16];
#pragma unroll
                    for (int j = 0; j < 4; ++j) { const u32x4 v = *(const u32x4*)(rowp + 16 * bt + 4 * j); bk[4 * j] = (int)v.x; bk[4 * j + 1] = (int)v.y; bk[4 * j + 2] = (int)v.z; bk[4 * j + 3] = (int)v.w; }
                    bitonic_sort16(bk);
                    if (bt == 0) {
#pragma unroll
                        for (int j = 0; j < 16; ++j) tv[j] = bk[j];
                    } else top16_merge(tv, bk);
                }
            }
            __syncthreads();
            int* mbi = (int*)mbuf;
            if (shalf == 1) {
#pragma unroll
                for (int j = 0; j < 16; ++j) mbi[srow * 17 + j] = tv[j];
            }
            __syncthreads();
            if (shalf == 0) {
                int* dst = (int*)((ph == 0) ? st0 : st1);
                int ob[16];
#pragma unroll
                for (int j = 0; j < 16; ++j) ob[j] = mbi[srow * 17 + j];
                top16_merge(tv, ob);
#pragma unroll
                for (int j = 0; j < 16; ++j) dst[srow * 17 + j] = tv[j];
            }
        }
        __syncthreads();
        int cv[16];
        {
            const int* st0i = (const int*)st0; const int* st1i = (const int*)st1;
            float v2[16];
#pragma unroll
            for (int b = 0; b < 16; ++b) v2[b] = key2f(st1i[srow * 17 + b]);
#pragma unroll
            for (int a8 = 0; a8 < 8; ++a8) {
                const int a = shalf * 8 + a8; const float va = key2f(st0i[srow * 17 + a]);
                int bk[16];
#pragma unroll
                for (int b = 0; b < 16; ++b) bk[b] = (f2key(va + v2[b]) & (int)0xFFFFFF00) | (a * 16 + 15 - b);
                if (a8 == 0) {
#pragma unroll
                    for (int j = 0; j < 16; ++j) cv[j] = bk[j];
                } else top16_merge(cv, bk);
            }
        }
        __syncthreads();
        int* mbi = (int*)mbuf;
        if (shalf == 1) {
#pragma unroll
            for (int j = 0; j < 16; ++j) mbi[srow * 17 + j] = cv[j];
        }
        __syncthreads();
        if (shalf == 0) {
            const int* st0i = (const int*)st0; const int* st1i = (const int*)st1;
            int fk[16]; float fv[16];
#pragma unroll
            for (int j = 0; j < 16; ++j) { const int o = mbi[srow * 17 + 15 - j]; fk[j] = cv[j] > o ? cv[j] : o; fv[j] = key2f(fk[j]); }
            float cmax = fv[0];
#pragma unroll
            for (int j = 1; j < 16; ++j) cmax = fmaxf(cmax, fv[j]);
            float den = 0.f; float ev[16];
#pragma unroll
            for (int j = 0; j < 16; ++j) { ev[j] = __expf(fv[j] - cmax); den += ev[j]; }
            const float rden = 1.0f / den;
            const size_t ob = (size_t)(mt * 128 + srow) * 128 + head * 16;
#pragma unroll
            for (int j = 0; j < 16; ++j) {
                const unsigned cde = (unsigned)fk[j] & 0xFFu;
                const unsigned a = cde >> 4, b = 15u - (cde & 15u);
                const unsigned i1 = __float_as_uint(key2f(st0i[srow * 17 + a])) & 0x7Fu, i2 = __float_as_uint(key2f(st1i[srow * 17 + b])) & 0x7Fu;
                const int e = (int)(i1 * 128u + i2);
                PE[ob + j] = (unsigned short)e; PG[ob + j] = ev[j] * rden * SV[e]; PS[ob + j] = SU[e];
            }
        }
        __syncthreads();
    }
}

DI float gelu_exact(float z) { return 0.5f * z * (1.0f + erff(z * 0.70710678118654752f)); }
DI float rdlane(float v, int l) { return __int_as_float(__builtin_amdgcn_readlane(__float_as_int(v), l)); }

constexpr int P5A_LIST_BYTES = (2048 + 128) * 4, P5A_WAVE_LDS = P5A_LIST_BYTES + 8192;
template <int MODE>
DI void p5a_udot(const Params& p, unsigned char* lds) {
    unsigned char* ws = p.ws;
    const unsigned char* H1Q = ws + WS_QA; const unsigned char* UT = ws + WS_UT;
    const unsigned short* PE = (const unsigned short*)(ws + WS_PE); float* ZB = (float*)(ws + (MODE ? WS_QI : WS_QB));
    const int lane = threadIdx.x & 63, wave = threadIdx.x >> 6, c = lane & 15, kb = lane >> 4;
    const int G = gridDim.x, bid = blockIdx.x;
    const bool affine = (G & 7) == 0;
    const int npass = affine ? 1 : 4;
    unsigned* list = (unsigned*)(lds + wave * P5A_WAVE_LDS);
    unsigned char* slot = lds + wave * P5A_WAVE_LDS + P5A_LIST_BYTES;
    const int l31 = lane & 31, lh = lane >> 5;
    unsigned cq[8];
#pragma unroll
    for (int q = 0; q < 8; ++q) cq[q] = (unsigned)((l31 ^ (q + 8 * lh)) * 16);
    for (int pass = 0; pass < npass; ++pass) {
        const int part = affine ? (bid & 3) : pass, rank = affine ? (bid >> 2) : bid, nper = affine ? (G >> 2) : G;
        const unsigned char* UTp = UT + (size_t)part * (4096 * 512);
        for (int gid = rank * 4 + wave; gid < NTOK / 16; gid += nper * 4) {
            const int t0 = gid * 16;
            u32x4 pv[4];
#pragma unroll
            for (int i = 0; i < 4; ++i) pv[i] = ldg16(PE + (size_t)(t0 + (lane >> 2)) * 128 + (lane & 3) * 32 + 8 * i);
            i32x8 ax[8];
#pragma unroll
            for (int s2 = 0; s2 < 8; ++s2) {
                const unsigned char* xp = H1Q + (size_t)(t0 + c) * 1024 + 128 * s2 + 16 * kb;
                const u32x4 lo = ldg16(xp), hi = ldg16(xp + 64);
                ax[s2][0] = (int)lo.x; ax[s2][1] = (int)lo.y; ax[s2][2] = (int)lo.z; ax[s2][3] = (int)lo.w; ax[s2][4] = (int)hi.x; ax[s2][5] = (int)hi.y; ax[s2][6] = (int)hi.z; ax[s2][7] = (int)hi.w;
            }
            unsigned base = 0;
            const unsigned zl = (unsigned)((lane >> 2) * 128 + (lane & 3) * 32) << 21;
#pragma unroll
            for (int i = 0; i < 4; ++i)
#pragma unroll
                for (int w = 0; w < 4; ++w)
#pragma unroll
                    for (int hf = 0; hf < 2; ++hf) {
                        const unsigned e = hf ? (pv[i][w] >> 16) : (pv[i][w] & 0xffffu);
                        const bool cnd = (int)(e >> 12) == part;
                        const unsigned long long mk = __ballot(cnd);
                        if (mk) {
                            const unsigned pos = base + __builtin_amdgcn_mbcnt_hi((unsigned)(mk >> 32), __builtin_amdgcn_mbcnt_lo((unsigned)mk, 0u));
                            if (cnd) list[pos] = ((e & 4095u) << 9) | (zl + ((unsigned)(8 * i + 2 * w + hf) << 21));
                            base += (unsigned)__popcll(mk);
                        }
                    }
            const int count = (int)base, nrt = (count + 15) >> 4;
            if (MODE == 2) { if (count == 12345) ZB[lane] = (float)ax[7][7] + (float)ax[0][0]; }
            else if (count > 0) {
                {
                    const unsigned last = list[count - 1];
                    list[count + lane] = last; list[count + 64 + lane] = last;
                }
                float* ZBg = ZB + (size_t)t0 * 128;
                auto loadA = [&](int rt, u32x4 (&dst)[8]) {
                    const u32x4 ea = *(const u32x4*)(list + 16 * rt + 8 * lh), eb = *(const u32x4*)(list + 16 * rt + 8 * lh + 4);
#pragma unroll
                    for (int q = 0; q < 8; ++q) {
                        const unsigned ent = q < 4 ? ea[q & 3] : eb[q & 3];
                        dst[q] = ldg16(UTp + ((ent & 0x1ffe00u) | cq[q]));
                    }
                };
                auto compute = [&](int rt, const u32x4 (&st)[8]) {
#pragma unroll
                    for (int q = 0; q < 8; ++q) *(u32x4*)(slot + q * 512 + lh * 4096 + l31 * 16) = st[q];
                    u32x4 bf[8];
#pragma unroll
                    for (int s2 = 0; s2 < 8; ++s2) bf[s2] = *(const u32x4*)(slot + c * 512 + (((4 * s2 + kb) ^ c) * 16));
                    const unsigned ent = list[16 * rt + c];
                    f32x4 D = {0.f, 0.f, 0.f, 0.f};
#pragma unroll
                    for (int s2 = 0; s2 < 8; ++s2) {
                        i32x8 b8; b8[0] = (int)bf[s2].x; b8[1] = (int)bf[s2].y; b8[2] = (int)bf[s2].z; b8[3] = (int)bf[s2].w; b8[4] = 0; b8[5] = 0; b8[6] = 0; b8[7] = 0;
                        D = __builtin_amdgcn_mfma_scale_f32_16x16x128_f8f6f4(ax[s2], b8, D, 0  , 4  , 0, 0, 0, 0);
                    }
                    const unsigned zoff = ent >> 21, tk = zoff >> 7;
                    const float val = (tk & 2u) ? ((tk & 1u) ? D[3] : D[2]) : ((tk & 1u) ? D[1] : D[0]);
                    if ((int)(tk >> 2) == kb && 16 * rt + c < count && (MODE != 3 || val == 1234.5f)) ZBg[zoff] = val;
                };
                u32x4 a0[8], a1[8], a2[8];
                loadA(0, a0); loadA(1, a1); loadA(2, a2);
                for (int rt = 0; rt < nrt; rt += 3) {
                    compute(rt, a0); loadA(rt + 3, a0);
                    if (rt + 1 < nrt) compute(rt + 1, a1);
                    loadA(rt + 4, a1);
                    if (rt + 2 < nrt) compute(rt + 2, a2);
                    loadA(rt + 5, a2);
                }
            }
        }
    }
}

DI void p5b_ffn(const Params& p) {
    unsigned char* ws = p.ws;
    const bf16_t* H1B = (const bf16_t*)(ws + WS_XB); const unsigned char* VT = ws + WS_VT;
    const unsigned short* PE = (const unsigned short*)(ws + WS_PE); const float* PG = (const float*)(ws + WS_PG); const float* PS = (const float*)(ws + WS_PS);
    const int lane = threadIdx.x & 63, gw = blockIdx.x * 4 + (threadIdx.x >> 6), nw = gridDim.x * 4;
    const float* ZB = (const float*)(ws + WS_QB); const float* SXp = (const float*)(ws + WS_SX);
    int n_pe_lo = 0, n_pe_hi = 0; float n_z_lo = 0.f, n_z_hi = 0.f, n_ps_lo = 0.f, n_ps_hi = 0.f, n_pg_lo = 0.f, n_pg_hi = 0.f, n_sx = 0.f;
    auto header = [&](int t) {
        const size_t o = (size_t)t * 128 + lane;
        n_pe_lo = (int)PE[o]; n_pe_hi = (int)PE[o + 64]; n_z_lo = ZB[o]; n_z_hi = ZB[o + 64]; n_ps_lo = PS[o]; n_ps_hi = PS[o + 64]; n_pg_lo = PG[o]; n_pg_hi = PG[o + 64]; n_sx = SXp[t];
    };
    if (gw < NTOK) header(gw);
    for (int tok = gw; tok < NTOK; tok += nw) {
        float acc[16];
#pragma unroll
        for (int i = 0; i < 16; ++i) acc[i] = 0.f;
        const int pe_lo = n_pe_lo, pe_hi = n_pe_hi;
        const float cf_lo = gelu_exact(n_z_lo * n_ps_lo * n_sx) * n_pg_lo;
        const float cf_hi = gelu_exact(n_z_hi * n_ps_hi * n_sx) * n_pg_hi;
#define P5_AXPY(vw, k, bs) { const f32x2 f = __builtin_amdgcn_cvt_scalef32_pk_f32_fp4(vw[k], 1.0f, bs); acc[8 * (k) + 2 * (bs)] = fmaf(cj, f.x, acc[8 * (k) + 2 * (bs)]); acc[8 * (k) + 2 * (bs) + 1] = fmaf(cj, f.y, acc[8 * (k) + 2 * (bs) + 1]); }
        u32x2 bufA[16], bufB[16];
        auto issue = [&](int gq, u32x2 (&buf)[16]) {
            const int pes = gq < 4 ? pe_lo : pe_hi; const int lb = (gq & 3) * 16;
#pragma unroll
            for (int j = 0; j < 16; ++j) { const int e = __builtin_amdgcn_readlane(pes, lb + j); buf[j] = *(const u32x2*)(VT + (size_t)e * 512 + lane * 8); }
        };
        auto consume = [&](int gq, const u32x2 (&buf)[16]) {
            const float cfs = gq < 4 ? cf_lo : cf_hi; const int lb = (gq & 3) * 16;
#pragma unroll
            for (int j = 0; j < 16; ++j) {
                const float cj = rdlane(cfs, lb + j);
                const u32x2 vw = buf[j];
                P5_AXPY(vw, 0, 0) P5_AXPY(vw, 0, 1) P5_AXPY(vw, 0, 2) P5_AXPY(vw, 0, 3) P5_AXPY(vw, 1, 0) P5_AXPY(vw, 1, 1) P5_AXPY(vw, 1, 2) P5_AXPY(vw, 1, 3)
            }
        };
#define P5_SB() do {} while (0)
        issue(0, bufA); P5_SB(); issue(1, bufB); P5_SB();
        consume(0, bufA); P5_SB(); issue(2, bufA); P5_SB();
        consume(1, bufB); P5_SB(); issue(3, bufB); P5_SB();
        consume(2, bufA); P5_SB(); issue(4, bufA); P5_SB();
        consume(3, bufB); P5_SB(); issue(5, bufB); P5_SB();
        consume(4, bufA); P5_SB(); issue(6, bufA); P5_SB();
        consume(5, bufB); P5_SB(); issue(7, bufB); P5_SB();
        const u32x4 xa = ldg16(H1B + (size_t)tok * 1024 + lane * 16), xb = ldg16(H1B + (size_t)tok * 1024 + lane * 16 + 8);
        { const int tn = tok + nw < NTOK ? tok + nw : tok; header(tn); }
        consume(6, bufA); P5_SB();
        consume(7, bufB);
        float x[16];
        x[0] = bf_lo(xa.x); x[1] = bf_hi(xa.x); x[2] = bf_lo(xa.y); x[3] = bf_hi(xa.y); x[4] = bf_lo(xa.z); x[5] = bf_hi(xa.z); x[6] = bf_lo(xa.w); x[7] = bf_hi(xa.w);
        x[8] = bf_lo(xb.x); x[9] = bf_hi(xb.x); x[10] = bf_lo(xb.y); x[11] = bf_hi(xb.y); x[12] = bf_lo(xb.z); x[13] = bf_hi(xb.z); x[14] = bf_lo(xb.w); x[15] = bf_hi(xb.w);
        float s = 0.f;
#pragma unroll
        for (int i = 0; i < 16; ++i) { acc[i] = fmaf(ALPHA, x[i], acc[i]); s += acc[i]; }
        const float mu = wave_sum(s) * (1.f / 1024.f); float q = 0.f;
#pragma unroll
        for (int i = 0; i < 16; ++i) { const float dd = acc[i] - mu; q = fmaf(dd, dd, q); }
        const float rstd = rsqrtf(wave_sum(q) * (1.f / 1024.f) + LN_EPS);
#pragma unroll
        for (int k4 = 0; k4 < 4; ++k4) {
            const int col = lane * 16 + k4 * 4;
            const f32x4 gg = *(const f32x4*)(p.ln2_g + col), bb = *(const f32x4*)(p.ln2_b + col);
            f32x4 o;
#pragma unroll
            for (int e = 0; e < 4; ++e) o[e] = (acc[k4 * 4 + e] - mu) * rstd * gg[e] + bb[e];
            *(f32x4*)(p.out + (size_t)tok * 1024 + col) = o;
        }
    }
}

#define XB_TMO      128
#define XB_XCNT(j)  (256  + 64 * (j))
#define XB_XSUB(j)  (1280 + 64 * (j))
#define XB_XGEN(j)  (2304 + 64 * (j))
#define XB_TOP      3328
#define XB_TOPGEN   3392
#define XCD_BAR_WORDS 3456
#define XB_SPIN_CAP (1u << 22)
#define LAS __attribute__((address_space(3)))
DI unsigned xb_ld(unsigned* p)              { return __hip_atomic_load(p, __ATOMIC_RELAXED, __HIP_MEMORY_SCOPE_AGENT); }
DI unsigned xb_add(unsigned* p, unsigned v) { return __hip_atomic_fetch_add(p, v, __ATOMIC_RELAXED, __HIP_MEMORY_SCOPE_AGENT); }
DI unsigned xb_xcc_id() { return (unsigned)__builtin_amdgcn_s_getreg((3 << 11) | 20) & 0xFu; }
#define XB_SPIN(cond, bar) do { unsigned _sp = 0; while (cond) { __builtin_amdgcn_s_sleep(1); \
    if ((++_sp & 255u) == 0u) { if (xb_ld(&(bar)[XB_TMO])) break; if (_sp > XB_SPIN_CAP) { atomicAdd(&(bar)[XB_TMO], 1u); break; } } } } while (0)
struct XcdBarrier { unsigned* bar; unsigned x; volatile LAS unsigned* st; };
DI XcdBarrier xcd_barrier_post(unsigned* bar, volatile LAS unsigned* st) {
    XcdBarrier b; b.bar = bar; b.x = xb_xcc_id(); b.st = st;
    if (threadIdx.x == 0) (void)xb_add(&bar[XB_XCNT(b.x)], 1u);
    return b;
}
DI void xcd_barrier_complete(unsigned* bar, unsigned x, unsigned& nloc, unsigned& nx) {
    const unsigned G = gridDim.x * gridDim.y * gridDim.z;
    unsigned sum, cnt, mine, sp = 0u;
    for (;;) {
        sum = 0u; cnt = 0u; mine = 0u;
#pragma unroll
        for (unsigned j = 0; j < 16; ++j) { const unsigned c = xb_ld(&bar[XB_XCNT(j)]); sum += c; cnt += (c > 0u) ? 1u : 0u; mine = (j == x) ? c : mine; }
        if (sum == G) break;
        __builtin_amdgcn_s_sleep(1);
        if ((++sp & 255u) == 0u) { if (xb_ld(&bar[XB_TMO])) break; if (sp > XB_SPIN_CAP) { atomicAdd(&bar[XB_TMO], 1u); break; } }
    }
    nloc = mine > 0u ? mine : 1u; nx = cnt > 0u ? cnt : 1u;
}
DI void xcd_barrier(const XcdBarrier& b) {
    asm volatile("s_waitcnt vmcnt(0)" ::: "memory");
    __syncthreads();
    if (threadIdx.x == 0) {
        unsigned* bar = b.bar;
        __builtin_amdgcn_s_waitcnt(0);
        unsigned nloc = b.st[0], nx = b.st[1];
        if (nloc == 0u) { xcd_barrier_complete(bar, b.x, nloc, nx); b.st[0] = nloc; b.st[1] = nx; }
        const unsigned old = xb_add(&bar[XB_XSUB(b.x)], 1u);
        const unsigned gen = old / nloc;
        if (old + 1u == (gen + 1u) * nloc) {
            __builtin_amdgcn_fence(__ATOMIC_RELEASE, "agent");
            asm volatile("s_waitcnt vmcnt(0)" ::: "memory");
            const unsigned og = xb_add(&bar[XB_TOP], 1u);
            const unsigned tg = og / nx;
            if (og + 1u == (tg + 1u) * nx) xb_add(&bar[XB_TOPGEN], 1u);
            else XB_SPIN(xb_ld(&bar[XB_TOPGEN]) == tg, bar);
            __builtin_amdgcn_fence(__ATOMIC_ACQUIRE, "agent");
            xb_add(&bar[XB_XGEN(b.x)], 1u);
            asm volatile("s_waitcnt vmcnt(0)" ::: "memory");
        } else {
            XB_SPIN(xb_ld(&bar[XB_XGEN(b.x)]) == gen, bar);
            __builtin_amdgcn_fence(__ATOMIC_ACQUIRE, "agent");
            asm volatile("s_waitcnt vmcnt(0)" ::: "memory");
        }
    }
    __syncthreads();
}

constexpr int NPHASE = 7;
__global__ void __launch_bounds__(NTHREADS, 2) mega_fwd(Params p) {
    extern __shared__ __attribute__((aligned(16))) unsigned char lds[];
    cg::grid_group grid = cg::this_grid();
    const int lo = p.ph_lo, hi = p.ph_hi;
    volatile LAS unsigned* xbst = (volatile LAS unsigned*)(LAS unsigned char*)(lds + LDS_BYTES - 16);
#ifndef REP_MASK
#define REP_MASK 0
#endif
#ifndef P2_PROBE_MODE
#define P2_PROBE_MODE 15
#endif
#ifndef PH_MASK
#define PH_MASK 127
#endif
    if (lo == 0x7fffffff) grid.sync();
    if (threadIdx.x == 0) { xbst[0] = 0u; xbst[1] = 0u; }
    __syncthreads();
    XcdBarrier xb = xcd_barrier_post((unsigned*)(p.ws + WS_BAR), xbst);
#define GSYNC() xcd_barrier(xb)
#if REP_MASK & 1
    p0_prep(p, lds); GSYNC();
#endif
    p0_prep(p, lds);
    GSYNC();
#define RUN_PHASE(k, call) { call; if ((REP_MASK >> (k)) & 1) { GSYNC(); call; } }
#if PH_MASK & 2
    RUN_PHASE(1, p1_inproj(p, lds))
#endif
    GSYNC();
#if PH_MASK & 4
#if (REP_MASK >> 2) & 1
    p2a_indexer(p, lds); GSYNC(); p2_attention<P2_PROBE_MODE>(p, lds, 1); GSYNC();
#endif
    p2a_indexer(p, lds);
    GSYNC();
    p2_attention<15>(p, lds, 0);
#endif
    GSYNC();
#if PH_MASK & 8
    RUN_PHASE(3, p3_outproj(p, lds))
#endif
    GSYNC();
#if PH_MASK & 16
    RUN_PHASE(4, p3b_ln1(p))
#endif
    GSYNC();
#if PH_MASK & 32
    RUN_PHASE(5, p4_peer_query(p, lds))
#endif
    GSYNC();
#if PH_MASK & 64
    p5a_udot<0>(p, lds);
#ifdef P5A_REP
    GSYNC(); p5a_udot<P5A_REP>(p, lds);
#endif
    GSYNC();
    p5b_ffn(p);
#endif
}

#ifndef MK_N_LAUNCHES
#define MK_N_LAUNCHES 1
#endif

extern "C" void kernel_launch(void* const* d_in, const int* in_sizes, int n_in, void* d_out, int out_size, void* d_ws, size_t ws_size, hipStream_t stream) {
    static int grid_blocks = 0;
    if (grid_blocks == 0) {
        if (n_in != 14 || out_size != NTOK * D_MODEL || ws_size < WS_END) {
            fprintf(stderr, "kernel_launch: unexpected problem (n_in %d, out %d, ws %zu, need %zu)\n", n_in, out_size, ws_size, (size_t)WS_END); grid_blocks = -1; return;
        }
        int dev = 0, cus = 0, per_cu = 0;
        hipGetDevice(&dev);
        hipDeviceGetAttribute(&cus, hipDeviceAttributeMultiprocessorCount, dev);
        if (hipFuncSetAttribute((const void*)mega_fwd, hipFuncAttributeMaxDynamicSharedMemorySize, LDS_BYTES) != hipSuccess) { fprintf(stderr, "kernel_launch: hipFuncSetAttribute failed\n"); }
        if (hipOccupancyMaxActiveBlocksPerMultiprocessor(&per_cu, (const void*)mega_fwd, NTHREADS, LDS_BYTES) != hipSuccess || per_cu < 1) { fprintf(stderr, "kernel_launch: occupancy query failed\n"); per_cu = 1; }
        if (per_cu > 2) per_cu = 2;
        (void)hipGetLastError();
        grid_blocks = cus * per_cu;
        fprintf(stderr, "kernel_launch: %d CUs x %d blocks\n", cus, per_cu);
    }
    if (grid_blocks < 0) return;
    Params p{};
    p.x = (const float*)d_in[0]; p.w_in = (const float*)d_in[1]; p.idx_k_g = (const float*)d_in[2]; p.idx_k_b = (const float*)d_in[3]; p.sinks = (const float*)d_in[4];
    p.w_o = (const float*)d_in[5]; p.ln1_g = (const float*)d_in[6]; p.ln1_b = (const float*)d_in[7]; p.peer_wq = (const float*)d_in[8]; p.peer_subkeys = (const float*)d_in[9];
    p.peer_u = (const float*)d_in[10]; p.peer_v = (const float*)d_in[11]; p.ln2_g = (const float*)d_in[12]; p.ln2_b = (const float*)d_in[13];
    p.out = (float*)d_out; p.ws = (unsigned char*)d_ws;
    p.ph_lo = 0; p.ph_hi = NPHASE;
    if (hipMemsetAsync((unsigned char*)d_ws + WS_BAR, 0, 16384 + 64, stream) != hipSuccess) { fprintf(stderr, "kernel_launch: memset of the barrier words failed\n"); return; }
    void* args[] = {&p};
    hipError_t e = hipLaunchCooperativeKernel((const void*)mega_fwd, dim3(grid_blocks), dim3(NTHREADS), args, LDS_BYTES, stream);
    if (e != hipSuccess) fprintf(stderr, "cooperative launch failed: %s (grid %d)\n", hipGetErrorString(e), grid_blocks);
}
```

```cpp
#include <hip/hip_runtime.h>
#include <hip/hip_cooperative_groups.h>
#include <cstdio>
#include <cstdint>
namespace cg = cooperative_groups;

typedef unsigned short bf16_t;
typedef short bf16x8 __attribute__((ext_vector_type(8)));
typedef float f32x4 __attribute__((ext_vector_type(4)));
typedef float f32x16 __attribute__((ext_vector_type(16)));
typedef unsigned u32x4 __attribute__((ext_vector_type(4)));
typedef unsigned u32x2 __attribute__((ext_vector_type(2)));
typedef int i32x8 __attribute__((ext_vector_type(8)));
#define DI __device__ __forceinline__

constexpr int D_MODEL = 1024, BATCH = 8, SEQ = 4096, NTOK = BATCH * SEQ;
constexpr int NMIX = 1732, NMIX_PAD = 1792;
constexpr int P1_F8_COLS = 1408;
constexpr int PEER_N = 2048;
constexpr float ALPHA = 1.189207115002721f;
constexpr float LN_EPS = 1e-5f;
constexpr int NTHREADS = 256;
constexpr int LDS_BYTES = 77824;

constexpr size_t MB = 1024 * 1024;
constexpr size_t WS_CTL   = 0;
constexpr size_t WS_AMAX  = 65536 + 16384;
constexpr size_t WS_BAR   = 65536;
constexpr size_t WS_ROPE  = 1 * MB;
constexpr size_t WS_WINT  = 2 * MB;
constexpr size_t WS_WOT   = 6 * MB;
constexpr size_t WS_WQT   = 8 * MB;
constexpr size_t WS_SK    = 12 * MB;
constexpr size_t WS_UT    = 13 * MB;
constexpr size_t WS_VT    = 29 * MB;
constexpr size_t WS_SU    = 45 * MB;
constexpr size_t WS_SV    = 46 * MB;
constexpr size_t WS_SXR   = 47 * MB + 262144;
constexpr size_t WS_SWN   = 47 * MB + 524288;
constexpr size_t WS_X8    = 282 * MB;
constexpr size_t WS_SX    = 47 * MB;
constexpr size_t WS_XB    = 77 * MB;
constexpr size_t WS_QA    = 141 * MB;
constexpr size_t WS_KA    = 173 * MB;
constexpr size_t WS_VA    = 181 * MB;
constexpr size_t WS_QB    = 189 * MB;
constexpr size_t WS_KB    = 221 * MB;
constexpr size_t WS_VB    = 225 * MB;
constexpr size_t WS_QI    = 229 * MB;
constexpr size_t WS_KI    = 245 * MB;
constexpr size_t WS_WI    = 249 * MB;
constexpr size_t WS_ATT   = 250 * MB;
constexpr size_t WS_PE    = 314 * MB;
constexpr size_t WS_PG    = 322 * MB;
constexpr size_t WS_PS    = 338 * MB;
constexpr size_t WS_END   = 354 * MB;

struct Params {
    const float* x; const float* w_in; const float* idx_k_g; const float* idx_k_b; const float* sinks; const float* w_o;
    const float* ln1_g; const float* ln1_b; const float* peer_wq; const float* peer_subkeys; const float* peer_u; const float* peer_v;
    const float* ln2_g; const float* ln2_b;
    float* out; unsigned char* ws;
    int ph_lo, ph_hi;
};

typedef float f32x2 __attribute__((ext_vector_type(2)));
typedef __bf16 bf16x2_t __attribute__((ext_vector_type(2)));
DI unsigned pack_bf16(float lo, float hi) { const f32x2 v = {lo, hi}; return __builtin_bit_cast(unsigned, __builtin_convertvector(v, bf16x2_t)); }
DI unsigned f2bf(float x) { return pack_bf16(x, 0.f) & 0xffffu; }
DI float bf_lo(unsigned w) { return __uint_as_float(w << 16); }
DI float bf_hi(unsigned w) { return __uint_as_float(w & 0xffff0000u); }
DI bf16x8 as_bf16x8(u32x4 v) { return __builtin_bit_cast(bf16x8, v); }
DI u32x4 ldg16(const void* p) { return *(const u32x4*)p; }
DI f32x4 mfma16(bf16x8 a, bf16x8 b, f32x4 c) { return __builtin_amdgcn_mfma_f32_16x16x32_bf16(a, b, c, 0, 0, 0); }
DI f32x16 mfma32(bf16x8 a, bf16x8 b, f32x16 c) { return __builtin_amdgcn_mfma_f32_32x32x16_bf16(a, b, c, 0, 0, 0); }
DI float wave_sum(float v) {
#pragma unroll
    for (int o = 32; o >= 1; o >>= 1) v += __shfl_xor(v, o);
    return v;
}

DI void glds16(const void* src, void* lds_dst) { __builtin_amdgcn_global_load_lds((const unsigned*)src, (__attribute__((address_space(3))) unsigned*)lds_dst, 16, 0, 0); }
DI void gemm_128x128(const bf16_t* __restrict__ X, int ldx, const bf16_t* __restrict__ Wt, int ldw, int K, unsigned char* lds, f32x4 (&acc)[4][4]) {
    int tid = threadIdx.x; asm volatile("" : "+v"(tid));
    const int lane = tid & 63, wave = tid >> 6, wm = wave >> 1, wn = wave & 1, c = lane & 15, g = lane >> 4;
    const int lrow = tid >> 3, lch = tid & 7;
    const bf16_t* xp = X + (size_t)lrow * ldx + ((lch ^ (lrow & 7)) * 8);
    const bf16_t* wp = Wt + (size_t)lrow * ldw + ((lch ^ (lrow & 7)) * 8);
    unsigned char* dst0 = lds + tid * 16;
#pragma unroll
    for (int m = 0; m < 4; ++m)
#pragma unroll
        for (int n = 0; n < 4; ++n) acc[m][n] = (f32x4){0.f, 0.f, 0.f, 0.f};
    const int nk = K / 64;
    __syncthreads();
#pragma unroll
    for (int i = 0; i < 4; ++i) { glds16(xp + (size_t)(32 * i) * ldx, dst0 + i * 4096); glds16(wp + (size_t)(32 * i) * ldw, dst0 + 16384 + i * 4096); }
    asm volatile("s_waitcnt vmcnt(0)" ::: "memory");
    __syncthreads();
    for (int kt = 0; kt < nk; ++kt) {
        const unsigned char* Xs = lds + (kt & 1) * 32768; const unsigned char* Ws = Xs + 16384;
        if (kt + 1 < nk) {
            unsigned char* d = dst0 + ((kt + 1) & 1) * 32768;
#pragma unroll
            for (int i = 0; i < 4; ++i) { glds16(xp + (size_t)(32 * i) * ldx + (kt + 1) * 64, d + i * 4096); glds16(wp + (size_t)(32 * i) * ldw + (kt + 1) * 64, d + 16384 + i * 4096); }
        }
#pragma unroll
        for (int s = 0; s < 2; ++s) {
            bf16x8 xf[4], wf[4];
#pragma unroll
            for (int m = 0; m < 4; ++m) { const int row = wm * 64 + m * 16 + c; xf[m] = as_bf16x8(*(const u32x4*)(Xs + row * 128 + (((4 * s + g) ^ (c & 7)) << 4))); }
#pragma unroll
            for (int n = 0; n < 4; ++n) { const int row = wn * 64 + n * 16 + c; wf[n] = as_bf16x8(*(const u32x4*)(Ws + row * 128 + (((4 * s + g) ^ (c & 7)) << 4))); }
#pragma unroll
            for (int m = 0; m < 4; ++m)
#pragma unroll
                for (int n = 0; n < 4; ++n) acc[m][n] = mfma16(wf[n], xf[m], acc[m][n]);
        }
        asm volatile("s_waitcnt vmcnt(0)" ::: "memory");
        __syncthreads();
    }
}

DI void gemm8_128x128(const unsigned char* __restrict__ X, int ldx, const unsigned char* __restrict__ Wt, int ldw, int K, unsigned char* lds, f32x4 (&acc)[4][4]) {
    int tid = threadIdx.x; asm volatile("" : "+v"(tid));
    const int lane = tid & 63, wave = tid >> 6, wm = wave >> 1, wn = wave & 1, c = lane & 15, g = lane >> 4;
    const int lrow = tid >> 3, lch = tid & 7;
    const unsigned char* xp = X + (size_t)lrow * ldx + ((lch ^ (lrow & 7)) * 16);
    const unsigned char* wp = Wt + (size_t)lrow * ldw + ((lch ^ (lrow & 7)) * 16);
    unsigned char* dst0 = lds + tid * 16;
#pragma unroll
    for (int m = 0; m < 4; ++m)
#pragma unroll
        for (int n = 0; n < 4; ++n) acc[m][n] = (f32x4){0.f, 0.f, 0.f, 0.f};
    const int nk = K / 128;
    __syncthreads();
#pragma unroll
    for (int i = 0; i < 4; ++i) { glds16(xp + (size_t)(32 * i) * ldx, dst0 + i * 4096); glds16(wp + (size_t)(32 * i) * ldw, dst0 + 16384 + i * 4096); }
    asm volatile("s_waitcnt vmcnt(0)" ::: "memory");
    __syncthreads();
    for (int kt = 0; kt < nk; ++kt) {
        const unsigned char* Xs = lds + (kt & 1) * 32768; const unsigned char* Ws = Xs + 16384;
        if (kt + 1 < nk) {
            unsigned char* d = dst0 + ((kt + 1) & 1) * 32768;
#pragma unroll
            for (int i = 0; i < 4; ++i) { glds16(xp + (size_t)(32 * i) * ldx + (kt + 1) * 128, d + i * 4096); glds16(wp + (size_t)(32 * i) * ldw + (kt + 1) * 128, d + 16384 + i * 4096); }
        }
        i32x8 xf[4], wf[4];
#pragma unroll
        for (int m = 0; m < 4; ++m) {
            const int row = wm * 64 + m * 16 + c;
            const u32x4 lo = *(const u32x4*)(Xs + row * 128 + ((g ^ (c & 7)) << 4)), hi = *(const u32x4*)(Xs + row * 128 + (((4 + g) ^ (c & 7)) << 4));
            xf[m][0] = (int)lo.x; xf[m][1] = (int)lo.y; xf[m][2] = (int)lo.z; xf[m][3] = (int)lo.w; xf[m][4] = (int)hi.x; xf[m][5] = (int)hi.y; xf[m][6] = (int)hi.z; xf[m][7] = (int)hi.w;
        }
#pragma unroll
        for (int n = 0; n < 4; ++n) {
            const int row = wn * 64 + n * 16 + c;
            const u32x4 lo = *(const u32x4*)(Ws + row * 128 + ((g ^ (c & 7)) << 4)), hi = *(const u32x4*)(Ws + row * 128 + (((4 + g) ^ (c & 7)) << 4));
            wf[n][0] = (int)lo.x; wf[n][1] = (int)lo.y; wf[n][2] = (int)lo.z; wf[n][3] = (int)lo.w; wf[n][4] = (int)hi.x; wf[n][5] = (int)hi.y; wf[n][6] = (int)hi.z; wf[n][7] = (int)hi.w;
        }
#pragma unroll
        for (int m = 0; m < 4; ++m)
#pragma unroll
            for (int n = 0; n < 4; ++n) acc[m][n] = __builtin_amdgcn_mfma_scale_f32_16x16x128_f8f6f4(wf[n], xf[m], acc[m][n], 0, 0, 0, 0, 0, 0);
        asm volatile("s_waitcnt vmcnt(0)" ::: "memory");
        __syncthreads();
    }
}

DI bool tile_of(int k, int NT, int MT, int& mt, int& nt) {
    const int G = gridDim.x, bid = blockIdx.x;
    if (((G | MT) & 7) == 0) {
        const int idx = (bid >> 3) + k * (G >> 3);
        if (idx >= (MT >> 3) * NT) return false;
        mt = (idx / NT) * 8 + (bid & 7); nt = idx % NT;
    } else {
        const int t = bid + k * G;
        if (t >= MT * NT) return false;
        mt = t / NT; nt = t % NT;
    }
    return true;
}

DI void p0_prep(const Params& p, unsigned char* lds) {
    const int tid = threadIdx.x, nb = gridDim.x, bid = blockIdx.x;
    const size_t gtid = (size_t)bid * NTHREADS + tid, gsz = (size_t)nb * NTHREADS;
    unsigned char* ws = p.ws;
    constexpr int W_ITEMS = (P1_F8_COLS / 64) * 4 + ((NMIX_PAD - P1_F8_COLS) / 64) * 16;
    const int nwb = nb >= 8 ? (nb / 2 < W_ITEMS ? nb / 2 : W_ITEMS) : nb, nxb = nb >= 8 ? nb - nwb : nb;
    const bool xrole = nb < 8 || bid < nxb, wrole = nb < 8 || bid >= nxb;
    const int wbid = nb >= 8 ? bid - nxb : bid;
    {
        float* ct = (float*)(ws + WS_ROPE); float* stb = ct + SEQ * 32;
        for (size_t i = gtid; i < (size_t)SEQ * 32; i += gsz) {
            const int pos = (int)(i >> 5), fi = (int)(i & 31);
            const float inv = powf(10000.0f, -(float)(2 * fi) / 64.0f);
            const float ang = (float)pos * inv;
            ct[i] = cosf(ang); stb[i] = sinf(ang);
        }
    }
    auto conv = [&](const float* src, bf16_t* dst, size_t n) {
        for (size_t i = gtid * 8; i < n; i += gsz * 8) {
            const f32x4 a = *(const f32x4*)(src + i), b = *(const f32x4*)(src + i + 4);
            u32x4 o; o.x = pack_bf16(a.x, a.y); o.y = pack_bf16(a.z, a.w); o.z = pack_bf16(b.x, b.y); o.w = pack_bf16(b.z, b.w);
            *(u32x4*)(dst + i) = o;
        }
    };
    if ((bid & 7) == 0 || nb < 8) {
        const int sb = nb < 8 ? bid : (bid >> 3), nsb = nb < 8 ? nb : ((nb + 7) >> 3);
        float m = 0.f;
        for (size_t i = ((size_t)sb * NTHREADS + tid) * 4; i < (size_t)1024 * 1024; i += (size_t)nsb * NTHREADS * 4) { const f32x4 v = *(const f32x4*)(p.w_o + i); m = fmaxf(m, fmaxf(fmaxf(fabsf(v[0]), fabsf(v[1])), fmaxf(fabsf(v[2]), fabsf(v[3])))); }
#pragma unroll
        for (int o = 32; o >= 1; o >>= 1) m = fmaxf(m, __shfl_xor(m, o));
        float* red = (float*)lds;
        __syncthreads();
        if ((tid & 63) == 0) red[tid >> 6] = m;
        __syncthreads();
        if (tid == 0) { const float mm = fmaxf(fmaxf(red[0], red[1]), fmaxf(red[2], red[3])); if (mm > 0.f) atomicMax((unsigned*)(ws + WS_AMAX), __float_as_uint(mm)); }
        __syncthreads();
    }
    if (xrole) {
        const int lane = tid & 63, gw = bid * 4 + (tid >> 6), nw = nxb * 4;
        bf16_t* XBo = (bf16_t*)(ws + WS_XB); unsigned char* X8o = ws + WS_X8; float* SXRo = (float*)(ws + WS_SXR);
        for (int row0 = gw * 4; row0 < NTOK; row0 += nw * 4) {
            f32x4 v[4][4];
#pragma unroll
            for (int r = 0; r < 4; ++r)
#pragma unroll
                for (int i = 0; i < 4; ++i) v[r][i] = *(const f32x4*)(p.x + (size_t)(row0 + r) * 1024 + lane * 16 + 4 * i);
#pragma unroll
            for (int r = 0; r < 4; ++r) {
                const int row = row0 + r;
                float m = 0.f;
#pragma unroll
                for (int i = 0; i < 4; ++i) m = fmaxf(m, fmaxf(fmaxf(fabsf(v[r][i][0]), fabsf(v[r][i][1])), fmaxf(fabsf(v[r][i][2]), fabsf(v[r][i][3]))));
#pragma unroll
                for (int o = 32; o >= 1; o >>= 1) m = fmaxf(m, __shfl_xor(m, o));
                const float sc = m > 0.f ? 439.f / m : 1.f;
                u32x4 o0, o1, q8;
                o0.x = pack_bf16(v[r][0][0], v[r][0][1]); o0.y = pack_bf16(v[r][0][2], v[r][0][3]); o0.z = pack_bf16(v[r][1][0], v[r][1][1]); o0.w = pack_bf16(v[r][1][2], v[r][1][3]);
                o1.x = pack_bf16(v[r][2][0], v[r][2][1]); o1.y = pack_bf16(v[r][2][2], v[r][2][3]); o1.z = pack_bf16(v[r][3][0], v[r][3][1]); o1.w = pack_bf16(v[r][3][2], v[r][3][3]);
#pragma unroll
                for (int i = 0; i < 4; ++i) {
                    int pk = __builtin_amdgcn_cvt_pk_fp8_f32(v[r][i][0] * sc, v[r][i][1] * sc, 0, false);
                    pk = __builtin_amdgcn_cvt_pk_fp8_f32(v[r][i][2] * sc, v[r][i][3] * sc, pk, true);
                    q8[i] = (unsigned)pk;
                }
                *(u32x4*)(XBo + (size_t)row * 1024 + lane * 16) = o0; *(u32x4*)(XBo + (size_t)row * 1024 + lane * 16 + 8) = o1;
                *(u32x4*)(X8o + (size_t)row * 1024 + lane * 16) = q8;
                if (lane == 0) SXRo[row] = m > 0.f ? m * (1.f / 439.f) : 1.f;
            }
        }
    }
    conv(p.peer_subkeys, (bf16_t*)(ws + WS_SK), (size_t)8 * 2 * 128 * 128);
    float* tl = (float*)lds;
    auto transp = [&](const float* src, bf16_t* dst, int N, int Npad, int nt0) {
        const int tn = Npad / 64 - nt0, tk = 1024 / 64;
        for (int t = wbid - (P1_F8_COLS / 64) * 4; t < tn * tk; t += nwb) {
            if (t < 0) continue;
            const int n0 = (nt0 + t % tn) * 64, k0 = (t / tn) * 64;
            __syncthreads();
            for (int e = tid; e < 4096; e += NTHREADS) { const int kk = e >> 6, nn = e & 63; tl[kk * 65 + nn] = (n0 + nn < N) ? src[(size_t)(k0 + kk) * N + n0 + nn] : 0.f; }
            __syncthreads();
            for (int e = tid; e < 4096; e += NTHREADS) { const int nn = e >> 6, kk = e & 63; dst[(size_t)(n0 + nn) * 1024 + k0 + kk] = (bf16_t)f2bf(tl[kk * 65 + nn]); }
        }
    };
    if (wrole) transp(p.w_in, (bf16_t*)(ws + WS_WINT), NMIX, NMIX_PAD, P1_F8_COLS / 64);
    if (wrole) {
        unsigned char* w8 = ws + WS_WINT; float* swn = (float*)(ws + WS_SWN);
        float* cm = (float*)lds + 64 * 65;
        for (int item = wbid; item < (P1_F8_COLS / 64) * 4; item += nwb) {
            const int n0 = (item >> 2) * 64, kpart = item & 3;
            {
                const int n4 = (tid & 15) * 4, kq = tid >> 4;
                f32x4 m4 = {0.f, 0.f, 0.f, 0.f};
#pragma unroll 8
                for (int k2 = kq; k2 < 1024; k2 += 16) {
                    const f32x4 v = *(const f32x4*)(p.w_in + (size_t)k2 * NMIX + n0 + n4);
                    m4[0] = fmaxf(m4[0], fabsf(v[0])); m4[1] = fmaxf(m4[1], fabsf(v[1])); m4[2] = fmaxf(m4[2], fabsf(v[2])); m4[3] = fmaxf(m4[3], fabsf(v[3]));
                }
                __syncthreads();
                *(f32x4*)(cm + kq * 64 + n4) = m4;
                __syncthreads();
                if (tid < 64) {
                    float a = 0.f;
#pragma unroll
                    for (int r = 0; r < 16; ++r) a = fmaxf(a, cm[r * 64 + tid]);
                    cm[1024 + tid] = a > 0.f ? 439.f / a : 1.f;
                    if (kpart == 0) swn[n0 + tid] = a > 0.f ? a * (1.f / 439.f) : 1.f;
                }
            }
            for (int k0 = kpart * 256; k0 < kpart * 256 + 256; k0 += 64) {
                __syncthreads();
                for (int e = tid; e < 4096; e += NTHREADS) { const int kk = e >> 6, n2 = e & 63; tl[kk * 65 + n2] = p.w_in[(size_t)(k0 + kk) * NMIX + n0 + n2]; }
                __syncthreads();
                for (int e = tid; e < 1024; e += NTHREADS) {
                    const int n2 = e >> 4, kq4 = (e & 15) * 4; const float sc = cm[1024 + n2];
                    int pk = __builtin_amdgcn_cvt_pk_fp8_f32(tl[kq4 * 65 + n2] * sc, tl[(kq4 + 1) * 65 + n2] * sc, 0, false);
                    pk = __builtin_amdgcn_cvt_pk_fp8_f32(tl[(kq4 + 2) * 65 + n2] * sc, tl[(kq4 + 3) * 65 + n2] * sc, pk, true);
                    *(int*)(w8 + (size_t)(n0 + n2) * 1024 + k0 + kq4) = pk;
                }
            }
        }
    }
}

DI void p0_late(const Params& p, unsigned char* lds) {
    const int tid = threadIdx.x, nb = gridDim.x, bid = blockIdx.x;
    unsigned char* ws = p.ws;
    {
        const int lane = tid & 63, gw = bid * 4 + (tid >> 6), nw = nb * 4;
        for (int row0 = gw * 4; row0 < 2 * 16384; row0 += nw * 4) {
            f32x4 v[4][4];
#pragma unroll
            for (int r = 0; r < 4; ++r) {
                const int row = row0 + r; const bool isv = row >= 16384; const int e = isv ? row - 16384 : row;
                const float* src = (isv ? p.peer_v : p.peer_u) + (size_t)e * 1024 + lane * 16;
#pragma unroll
                for (int i = 0; i < 4; ++i) v[r][i] = *(const f32x4*)(src + 4 * i);
            }
#pragma unroll
            for (int r = 0; r < 4; ++r) {
                const int row = row0 + r; const bool isv = row >= 16384; const int e = isv ? row - 16384 : row;
                float mx = 0.f;
#pragma unroll
                for (int i = 0; i < 4; ++i) mx = fmaxf(mx, fmaxf(fmaxf(fabsf(v[r][i][0]), fabsf(v[r][i][1])), fmaxf(fabsf(v[r][i][2]), fabsf(v[r][i][3]))));
#pragma unroll
                for (int o = 32; o >= 1; o >>= 1) mx = fmaxf(mx, __shfl_xor(mx, o));
                const float sc = mx > 0.f ? mx * (1.0f / 5.99f) : 1.0f, inv = mx > 0.f ? 5.99f / mx : 1.0f;
                u32x2 o2;
#pragma unroll
                for (int k = 0; k < 2; ++k) {
                    unsigned w = 0;
                    w = __builtin_amdgcn_cvt_scalef32_pk_fp4_f32(w, v[r][2 * k][0] * inv, v[r][2 * k][1] * inv, 1.0f, 0);
                    w = __builtin_amdgcn_cvt_scalef32_pk_fp4_f32(w, v[r][2 * k][2] * inv, v[r][2 * k][3] * inv, 1.0f, 1);
                    w = __builtin_amdgcn_cvt_scalef32_pk_fp4_f32(w, v[r][2 * k + 1][0] * inv, v[r][2 * k + 1][1] * inv, 1.0f, 2);
                    w = __builtin_amdgcn_cvt_scalef32_pk_fp4_f32(w, v[r][2 * k + 1][2] * inv, v[r][2 * k + 1][3] * inv, 1.0f, 3);
                    o2[k] = w;
                }
                *(u32x2*)(ws + (isv ? WS_VT : WS_UT) + (size_t)e * 512 + lane * 8) = o2;
                if (lane == 0) ((float*)(ws + (isv ? WS_SV : WS_SU)))[e] = sc;
            }
        }
    }
    float* tl = (float*)lds;
    auto transp = [&](const float* src, bf16_t* dst, int N, int Npad) {
        const int tn = Npad / 64, tk = 1024 / 64;
        for (int t = bid; t < tn * tk; t += nb) {
            const int n0 = (t % tn) * 64, k0 = (t / tn) * 64;
            __syncthreads();
            for (int e = tid; e < 4096; e += NTHREADS) { const int kk = e >> 6, nn = e & 63; tl[kk * 65 + nn] = (n0 + nn < N) ? src[(size_t)(k0 + kk) * N + n0 + nn] : 0.f; }
            __syncthreads();
            for (int e = tid; e < 4096; e += NTHREADS) { const int nn = e >> 6, kk = e & 63; dst[(size_t)(n0 + nn) * 1024 + k0 + kk] = (bf16_t)f2bf(tl[kk * 65 + nn]); }
        }
    };
    {
        const float amax = __uint_as_float(*(const unsigned*)(ws + WS_AMAX)), sw = amax > 0.f ? 439.f / amax : 1.f;
        unsigned char* dst8 = ws + WS_WOT;
        for (int t = bid; t < 16 * 16; t += nb) {
            const int n0 = (t % 16) * 64, k0 = (t / 16) * 64;
            __syncthreads();
            for (int e = tid; e < 4096; e += NTHREADS) { const int kk = e >> 6, nn = e & 63; tl[kk * 65 + nn] = p.w_o[(size_t)(k0 + kk) * 1024 + n0 + nn]; }
            __syncthreads();
            for (int e = tid; e < 1024; e += NTHREADS) {
                const int nn = e >> 4, kq = (e & 15) * 4;
                int pk = __builtin_amdgcn_cvt_pk_fp8_f32(tl[kq * 65 + nn] * sw, tl[(kq + 1) * 65 + nn] * sw, 0, false);
                pk = __builtin_amdgcn_cvt_pk_fp8_f32(tl[(kq + 2) * 65 + nn] * sw, tl[(kq + 3) * 65 + nn] * sw, pk, true);
                *(int*)(dst8 + (size_t)(n0 + nn) * 1024 + k0 + kq) = pk;
            }
        }
    }
    transp(p.peer_wq, (bf16_t*)(ws + WS_WQT), PEER_N, PEER_N);
}

DI void p1_inproj(const Params& p, unsigned char* lds) {
    unsigned char* ws = p.ws;
    const bf16_t* XB = (const bf16_t*)(ws + WS_XB); const bf16_t* WT = (const bf16_t*)(ws + WS_WINT);
    const float* cosT = (const float*)(ws + WS_ROPE); const float* sinT = cosT + SEQ * 32;
    const int tid = threadIdx.x, lane = tid & 63, wave = tid >> 6, wm = wave >> 1, wn = wave & 1, c = lane & 15, g = lane >> 4;
    constexpr int NT = NMIX_PAD / 128, MT = NTOK / 128;
    int mt, nt;
    for (int k = 0; tile_of(k, NT, MT, mt, nt); ++k) {
        f32x4 acc[4][4];
        const bool f8 = nt < P1_F8_COLS / 128;
        if (f8) gemm8_128x128(ws + WS_X8 + (size_t)mt * 128 * 1024, 1024, ws + WS_WINT + (size_t)nt * 128 * 1024, 1024, 1024, lds, acc);
        else gemm_128x128(XB + (size_t)mt * 128 * 1024, 1024, WT + (size_t)nt * 128 * 1024, 1024, 1024, lds, acc);
        f32x4 swn4[4];
#pragma unroll
        for (int n = 0; n < 4; ++n) swn4[n] = f8 ? *(const f32x4*)((const float*)(ws + WS_SWN) + nt * 128 + wn * 64 + 16 * n + 4 * g) : (f32x4){1.f, 1.f, 1.f, 1.f};
        const int col64 = nt * 2 + wn;
        bf16_t* dst; int ld, coff; bool rope = true; float scale = 1.f; float vmax = 0.f;
        if (col64 < 8)       { dst = (bf16_t*)(ws + WS_QA); ld = 512; coff = col64 * 64; scale = 0.125f; }
        else if (col64 < 10) { dst = (bf16_t*)(ws + WS_KA); ld = 128; coff = (col64 - 8) * 64; }
        else if (col64 < 12) { dst = (bf16_t*)(ws + WS_VA); ld = 128; coff = (col64 - 10) * 64; rope = false; }
        else if (col64 < 20) { dst = (bf16_t*)(ws + WS_QB); ld = 512; coff = (col64 - 12) * 64; scale = 0.125f; }
        else if (col64 == 20) { dst = (bf16_t*)(ws + WS_KB); ld = 64; coff = 0; }
        else if (col64 == 21) { dst = (bf16_t*)(ws + WS_VB); ld = 64; coff = 0; rope = false; }
        else if (col64 < 26) { dst = (bf16_t*)(ws + WS_QI); ld = 256; coff = (col64 - 22) * 64; }
        else                 { dst = (bf16_t*)(ws + WS_KI); ld = 64; coff = 0; }
        if (col64 == 27) {
            if (g == 0) {
#pragma unroll
                for (int m = 0; m < 4; ++m) { const int tok = mt * 128 + wm * 64 + m * 16 + c; *(f32x4*)((float*)(ws + WS_WI) + (size_t)tok * 4) = acc[m][0] * 0.0625f; }
            }
            continue;
        }
#pragma unroll
        for (int m = 0; m < 4; ++m) {
            const int tok = mt * 128 + wm * 64 + m * 16 + c, pos = tok & (SEQ - 1);
            const float sxr = f8 ? ((const float*)(ws + WS_SXR))[tok] : 1.f;
            f32x4 v[4] = {acc[m][0] * (swn4[0] * sxr), acc[m][1] * (swn4[1] * sxr), acc[m][2] * (swn4[2] * sxr), acc[m][3] * (swn4[3] * sxr)};
            if (col64 == 26) {
                float s = 0.f;
#pragma unroll
                for (int n = 0; n < 4; ++n) s += (v[n][0] + v[n][1]) + (v[n][2] + v[n][3]);
                s += __shfl_xor(s, 16); s += __shfl_xor(s, 32);
                const float mu = s * (1.f / 64.f); float q = 0.f;
#pragma unroll
                for (int n = 0; n < 4; ++n) { const f32x4 d = v[n] - mu; q += (d[0] * d[0] + d[1] * d[1]) + (d[2] * d[2] + d[3] * d[3]); }
                q += __shfl_xor(q, 16); q += __shfl_xor(q, 32);
                const float rstd = rsqrtf(q * (1.f / 64.f) + LN_EPS);
#pragma unroll
                for (int n = 0; n < 4; ++n) {
                    const f32x4 gg = *(const f32x4*)(p.idx_k_g + 16 * n + 4 * g), bb = *(const f32x4*)(p.idx_k_b + 16 * n + 4 * g);
                    v[n] = (v[n] - mu) * rstd * gg + bb;
                }
            }
            if (rope) {
#pragma unroll
                for (int n = 0; n < 2; ++n) {
                    const f32x4 cs = *(const f32x4*)(cosT + pos * 32 + 16 * n + 4 * g), sn = *(const f32x4*)(sinT + pos * 32 + 16 * n + 4 * g);
                    const f32x4 t1 = v[n], t2 = v[n + 2];
                    v[n] = t1 * cs - t2 * sn; v[n + 2] = t2 * cs + t1 * sn;
                }
            }
#pragma unroll
            for (int n = 0; n < 4; ++n) {
                const f32x4 o = v[n] * scale; u32x2 w; w.x = pack_bf16(o[0], o[1]); w.y = pack_bf16(o[2], o[3]);
                *(u32x2*)(dst + (size_t)tok * ld + coff + 16 * n + 4 * g) = w;
                if (!rope) vmax = fmaxf(vmax, fmaxf(fmaxf(fabsf(o[0]), fabsf(o[1])), fmaxf(fabsf(o[2]), fabsf(o[3]))));
            }
        }
        if (!rope) {
#pragma unroll
            for (int o = 32; o >= 1; o >>= 1) vmax = fmaxf(vmax, __shfl_xor(vmax, o));
            if (lane == 0 && vmax > 0.f) atomicMax((unsigned*)(ws + WS_AMAX) + 1, __float_as_uint(vmax));
        }
    }
}

constexpr int NDSA = NTOK / 4, NSWA = BATCH * 32 * 8;
constexpr int P2_STG = 0  , P2_LIST = 32768;

DI unsigned f16_key(float v) {
    _Float16 hv = (_Float16)v; unsigned short hb = __builtin_bit_cast(unsigned short, hv); unsigned b = hb;
    if (b == 0x8000u) b = 0u;
    return (b & 0x8000u) ? ((~b) & 0xffffu) : (b | 0x8000u);
}

DI size_t sc_row_off(int t) { const size_t m = (size_t)(t >> 3); return 8 * (4 * m * (m + 1) + (size_t)(t & 7) * (m + 1)); }
constexpr size_t SC_BATCH = 8404992;
DI unsigned short* sc_batch_base(const Params& p, int b) { return (b < 7) ? (unsigned short*)p.out + (size_t)b * SC_BATCH : (unsigned short*)(p.ws + WS_PG); }

DI void p2a_indexer(const Params& p, unsigned char* lds) {
    unsigned char* ws = p.ws;
    const bf16_t* QI = (const bf16_t*)(ws + WS_QI); const bf16_t* KI = (const bf16_t*)(ws + WS_KI); const float* WI = (const float*)(ws + WS_WI);
    const int G = gridDim.x, bi = blockIdx.x;
    for (int it = 0; it < 2; ++it) {
        const int item = (it == 0) ? bi : 1023 - bi;
        for (int id = (G == 512) ? item : bi + it * G; id < 1024; id += (G == 512) ? 1024 : 2 * G) {
            int tid = threadIdx.x; asm volatile("" : "+v"(tid));
            const int lane = tid & 63, wave = tid >> 6, c = lane & 15, g = lane >> 4, lrow = tid >> 3, lch = tid & 7;
            const int b = id >> 7, t0 = (id & 127) * 32, tokw = b * SEQ + t0 + 8 * wave;
            unsigned short* scb = sc_batch_base(p, b);
            bf16x8 af[2][2]; f32x4 wv[2];
#pragma unroll
            for (int rt = 0; rt < 2; ++rt) {
#pragma unroll
                for (int s2 = 0; s2 < 2; ++s2) af[rt][s2] = as_bf16x8(ldg16(QI + (size_t)(tokw + 4 * rt + (c >> 2)) * 256 + (c & 3) * 64 + 32 * s2 + 8 * g));
                wv[rt] = *(const f32x4*)(WI + (size_t)(tokw + 4 * rt + g) * 4);
            }
            asm volatile("" :: "v"(af[0][0]), "v"(af[0][1]), "v"(af[1][0]), "v"(af[1][1]), "v"(wv[0]), "v"(wv[1]));
            const int nkt = ((t0 + 31) >> 7) + 1;
            const unsigned char* kib = (const unsigned char*)(KI + (size_t)b * SEQ * 64);
            unsigned char* dst0 = lds + tid * 16;
            auto stage = [&](int kt, int buf) {
#pragma unroll
                for (int i = 0; i < 4; ++i) {
                    const int row = lrow + 32 * i;
                    glds16(kib + (size_t)(kt * 128 + row) * 128 + ((lch ^ ((row >> 3) & 7)) << 4), dst0 + buf * 16384 + i * 4096);
                }
            };
            __syncthreads();
            stage(0, 0); if (nkt > 1) stage(1, 1);
            for (int kt = 0; kt < nkt; ++kt) {
                if (kt + 1 < nkt) asm volatile("s_waitcnt vmcnt(4)" ::: "memory");
                else asm volatile("s_waitcnt vmcnt(0)" ::: "memory");
                asm volatile("s_waitcnt lgkmcnt(0)" ::: "memory");
                __builtin_amdgcn_s_barrier();
                if (kt + 2 < nkt) stage(kt + 2, (kt + 2) % 3);
                const unsigned char* Ks = lds + (kt % 3) * 16384;
                unsigned res[2][4];
#pragma unroll
                for (int ct = 0; ct < 8; ++ct) {
                    const int row = 8 * c + ct;
                    const bf16x8 k0 = as_bf16x8(*(const u32x4*)(Ks + row * 128 + ((g ^ (c & 7)) << 4)));
                    const bf16x8 k1 = as_bf16x8(*(const u32x4*)(Ks + row * 128 + (((4 + g) ^ (c & 7)) << 4)));
#pragma unroll
                    for (int rt = 0; rt < 2; ++rt) {
                        f32x4 d = mfma16(af[rt][0], k0, (f32x4){0.f, 0.f, 0.f, 0.f});
                        d = mfma16(af[rt][1], k1, d);
                        const float sv = wv[rt][0] * fmaxf(d[0], 0.f) + wv[rt][1] * fmaxf(d[1], 0.f) + wv[rt][2] * fmaxf(d[2], 0.f) + wv[rt][3] * fmaxf(d[3], 0.f);
                        const int key = kt * 128 + row, tq = t0 + 8 * wave + 4 * rt + g;
                        const unsigned kv = (key <= tq) ? f16_key(sv) : 0u;
                        if (ct & 1) res[rt][ct >> 1] |= kv << 16; else res[rt][ct >> 1] = kv;
                    }
                }
#pragma unroll
                for (int rt = 0; rt < 2; ++rt) {
                    const int tq = t0 + 8 * wave + 4 * rt + g;
                    if (16 * kt + c <= (tq >> 3)) {
                        u32x4 w; w.x = res[rt][0]; w.y = res[rt][1]; w.z = res[rt][2]; w.w = res[rt][3];
                        *(u32x4*)(scb + sc_row_off(tq) + kt * 128 + 8 * c) = w;
                    }
                }
            }
        }
    }
    __syncthreads();
    p0_late(p, lds);
}

template <int MODE> DI void p2_dsa_item(const Params& p, unsigned char* lds, int b, int tb) {
    unsigned char* ws = p.ws;
    const bf16_t* QI = (const bf16_t*)(ws + WS_QI); const bf16_t* KI = (const bf16_t*)(ws + WS_KI); const float* WI = (const float*)(ws + WS_WI);
    const bf16_t* QB = (const bf16_t*)(ws + WS_QB); const bf16_t* KB = (const bf16_t*)(ws + WS_KB); const bf16_t* VB = (const bf16_t*)(ws + WS_VB);
    unsigned char* ATT8 = ws + WS_ATT;
    const float sa8 = 439.f / fmaxf(__uint_as_float(*(const unsigned*)(ws + WS_AMAX + 4)), 1e-30f);
    int tid = threadIdx.x; asm volatile("" : "+v"(tid));
    const int lane = tid & 63, wave = __builtin_amdgcn_readfirstlane(tid >> 6), c = lane & 15, g = lane >> 4;
    const int t0 = tb * 4, tok0 = b * SEQ + t0;
    unsigned char* stg = lds + P2_STG + wave * 8192;
    unsigned* hist = (unsigned*)stg;
    unsigned short* list = (unsigned short*)(lds + P2_LIST) + wave * 256;
    const int tok = tok0 + wave;
    if (!(MODE & 2)) return;
    const int n = t0 + wave + 1;
    const int L = n < 256 ? n : 256;
    const unsigned short* myk = sc_batch_base(p, b) + sc_row_off(t0 + wave);
    if (n <= 256) {
        for (int i = lane; i < n; i += 64) list[i] = (unsigned short)i;
    } else {
        u32x4 kk[8];
#pragma unroll
        for (int i = 0; i < 8; ++i) kk[i] = (512 * i + 8 * lane < n) ? ldg16(myk + 512 * i + 8 * lane) : (u32x4){0u, 0u, 0u, 0u};
#pragma unroll
        for (int i = 0; i < 4; ++i) *(u32x4*)(hist + lane * 16 + i * 4) = (u32x4){0u, 0u, 0u, 0u};
#pragma unroll
        for (int i = 0; i < 8; ++i) {
            if (512 * i < n) {
#pragma unroll
                for (int w = 0; w < 4; ++w) { const unsigned wd = kk[i][w]; atomicAdd(&hist[(wd & 0xffffu) >> 6], 1u); atomicAdd(&hist[wd >> 22], 1u); }
            }
        }
        unsigned h[16];
#pragma unroll
        for (int i = 0; i < 4; ++i) { const u32x4 t = *(const u32x4*)(hist + lane * 16 + i * 4); h[4 * i] = t.x; h[4 * i + 1] = t.y; h[4 * i + 2] = t.z; h[4 * i + 3] = t.w; }
#pragma unroll
        for (int i = 0; i < 4; ++i) *(u32x4*)(hist + lane * 16 + i * 4) = (u32x4){0u, 0u, 0u, 0u};
        unsigned sl = 0;
#pragma unroll
        for (int i = 0; i < 16; ++i) sl += h[i];
        unsigned pre = sl;
#pragma unroll
        for (int o = 1; o < 64; o <<= 1) { const unsigned t = __shfl_up(pre, o); if (lane >= o) pre += t; }
        const unsigned tot = __shfl(pre, 63);
        const unsigned suf = tot - pre;
        int found = -1; unsigned cab = 0, cum = suf;
#pragma unroll
        for (int j = 15; j >= 0; --j) { const bool hit = (found < 0) && (cum + h[j] >= 256u); if (hit) { found = lane * 16 + j; cab = cum; } cum += h[j]; }
        const bool mine = (suf < 256u) && (suf + sl >= 256u);
        const unsigned long long mm = __ballot(mine);
        const int src = __ffsll((long long)mm) - 1;
        const unsigned bstar = (unsigned)__shfl(found, src), cabove = __shfl(cab, src);
        const unsigned r1 = 256u - cabove;
#pragma unroll
        for (int i = 0; i < 8; ++i) {
            if (512 * i < n) {
#pragma unroll
                for (int w = 0; w < 4; ++w) {
                    const unsigned wd = kk[i][w];
                    if (((wd & 0xffffu) >> 6) == bstar) atomicAdd(&hist[wd & 63u], 1u);
                    if ((wd >> 22) == bstar) atomicAdd(&hist[(wd >> 16) & 63u], 1u);
                }
            }
        }
        const unsigned cnt = hist[lane];
        hist[lane] = 0u;
        unsigned pre2 = cnt;
#pragma unroll
        for (int o = 1; o < 64; o <<= 1) { const unsigned t = __shfl_up(pre2, o); if (lane >= o) pre2 += t; }
        const unsigned tot2 = __shfl(pre2, 63);
        const unsigned suf2 = tot2 - pre2;
        const bool mine2 = (suf2 < r1) && (suf2 + cnt >= r1);
        const unsigned long long mm2 = __ballot(mine2);
        const int src2 = __ffsll((long long)mm2) - 1;
        const unsigned T = (bstar << 6) | (unsigned)src2;
        const unsigned req = r1 - __shfl(suf2, src2);
        const unsigned toteq = __shfl(cnt, src2);
        const bool alleq = (req == toteq);
        const unsigned Tt = alleq ? T : T + 1u;
        unsigned cg = 0;
#pragma unroll
        for (int i = 0; i < 8; ++i)
#pragma unroll
            for (int w = 0; w < 4; ++w) { const unsigned wd = kk[i][w]; cg += ((wd & 0xffffu) >= Tt) ? 1u : 0u; cg += ((wd >> 16) >= Tt) ? 1u : 0u; }
        unsigned pre3 = cg;
#pragma unroll
        for (int o = 1; o < 64; o <<= 1) { const unsigned t = __shfl_up(pre3, o); if (lane >= o) pre3 += t; }
        unsigned off = pre3 - cg;
#pragma unroll
        for (int i = 0; i < 8; ++i)
#pragma unroll
            for (int w = 0; w < 4; ++w) {
                const unsigned wd = kk[i][w]; const int idx = 512 * i + 8 * lane + 2 * w;
                if ((wd & 0xffffu) >= Tt) { list[off & 255u] = (unsigned short)idx; ++off; }
                if ((wd >> 16) >= Tt) { list[off & 255u] = (unsigned short)(idx + 1); ++off; }
            }
        if (!alleq) {
            const unsigned cgt = 256u - req; unsigned eq_run = 0;
            for (int base = 0; base < n; base += 64) {
                const int i = base + lane; const unsigned m = (i < n) ? myk[i] : 0u;
                const bool eq = (m == T);
                const unsigned long long eqm = __ballot(eq);
                const unsigned rank = eq_run + __builtin_amdgcn_mbcnt_hi((unsigned)(eqm >> 32), __builtin_amdgcn_mbcnt_lo((unsigned)eqm, 0u));
                if (eq && rank < req) list[cgt + rank] = (unsigned short)i;
                eq_run += (unsigned)__popcll(eqm);
            }
        }
    }
    if (!(MODE & 4)) return;
    bf16x8 qf[2], sel[2];
#pragma unroll
    for (int s = 0; s < 2; ++s) {
        u32x4 t = (u32x4){0u, 0u, 0u, 0u};
        if (c < 8) t = ldg16(QB + (size_t)tok * 512 + c * 64 + 32 * s + 8 * g);
        qf[s] = as_bf16x8(t);
#pragma unroll
        for (int j = 0; j < 8; ++j) sel[s][j] = (8 * g + j == 16 * s + c) ? (short)0x3F80 : (short)0;
    }
    f32x4 st[16];
    const unsigned char* kbb = (const unsigned char*)(KB + (size_t)b * SEQ * 64); const unsigned char* vbb = (const unsigned char*)(VB + (size_t)b * SEQ * 64);
    const int lr = lane >> 3, lc = lane & 7;
    const unsigned st_off = lr * 128 + ((lc ^ lr) << 4);
    auto loadg = [&](const unsigned char* base, int T0, u32x4 (&dst)[8]) {
#pragma unroll
        for (int i = 0; i < 8; ++i) {
            const int idx = T0 * 16 + i * 8 + lr; const unsigned kid = (idx < L) ? (unsigned)list[idx] : 0u;
            dst[i] = ldg16(base + kid * 128u + lc * 16u);
        }
    };
    auto stage = [&](const u32x4 (&src)[8]) {
#pragma unroll
        for (int i = 0; i < 8; ++i) *(u32x4*)(stg + i * 1024 + st_off) = src[i];
    };
    auto frag = [&](int u, int s2) -> bf16x8 { return as_bf16x8(*(const u32x4*)(stg + (16 * u + c) * 128 + (((4 * s2 + g) ^ (c & 7)) << 4))); };
    auto scoreK = [&](int T0) {
#pragma unroll
        for (int T = 0; T < 4; ++T) {
            f32x4 d = mfma16(frag(T, 0), qf[0], (f32x4){0.f, 0.f, 0.f, 0.f});
            st[T0 + T] = mfma16(frag(T, 1), qf[1], d);
        }
    };
    u32x4 rA[8], rB[8], rC[8], rD[8];
    loadg(kbb, 0, rA); loadg(kbb, 4, rB); loadg(kbb, 8, rC); loadg(kbb, 12, rD);
    __builtin_amdgcn_sched_barrier(0);
    stage(rA); scoreK(0);
    stage(rB); scoreK(4);
    __builtin_amdgcn_sched_barrier(0);
    loadg(vbb, 0, rA); loadg(vbb, 4, rB);
    stage(rC); scoreK(8);
    stage(rD); scoreK(12);
    __builtin_amdgcn_sched_barrier(0);
    float mx = -3.0e38f;
    {
        const int lrem = L - 4 * g;
#pragma unroll
        for (int T = 0; T < 16; ++T)
#pragma unroll
            for (int r = 0; r < 4; ++r) { const float sv = (T * 16 + r < lrem) ? st[T][r] : -3.0e38f; st[T][r] = sv; mx = fmaxf(mx, sv); }
    }
    mx = fmaxf(mx, __shfl_xor(mx, 16)); mx = fmaxf(mx, __shfl_xor(mx, 32));
    float lsum = 0.f;
#pragma unroll
    for (int T = 0; T < 16; ++T)
#pragma unroll
        for (int r = 0; r < 4; ++r) { const float e = __expf(st[T][r] - mx); st[T][r] = e; lsum += e; }
    lsum += __shfl_xor(lsum, 16); lsum += __shfl_xor(lsum, 32);
    const float rl = 1.0f / lsum;
    u32x4 pfv[8];
#pragma unroll
    for (int u = 0; u < 8; ++u) {
        const int Ta = 2 * u, Tb = Ta + 1;
        pfv[u].x = pack_bf16(st[Ta][0] * rl, st[Ta][1] * rl); pfv[u].y = pack_bf16(st[Ta][2] * rl, st[Ta][3] * rl);
        pfv[u].z = pack_bf16(st[Tb][0] * rl, st[Tb][1] * rl); pfv[u].w = pack_bf16(st[Tb][2] * rl, st[Tb][3] * rl);
    }
    __builtin_amdgcn_sched_barrier(0);
    f32x4 O[4];
#pragma unroll
    for (int cb = 0; cb < 4; ++cb) O[cb] = (f32x4){0.f, 0.f, 0.f, 0.f};
    auto pv = [&](int T0) {
#pragma unroll
        for (int u = 0; u < 2; ++u) {
            const u32x4 pf = pfv[(T0 >> 1) + u];
#pragma unroll
            for (int cb = 0; cb < 4; ++cb) {
                const f32x4 z = (f32x4){0.f, 0.f, 0.f, 0.f};
                const f32x4 v0 = mfma16(frag(2 * u, cb >> 1), sel[cb & 1], z), v1 = mfma16(frag(2 * u + 1, cb >> 1), sel[cb & 1], z);
                u32x4 vf; vf.x = pack_bf16(v0[0], v0[1]); vf.y = pack_bf16(v0[2], v0[3]); vf.z = pack_bf16(v1[0], v1[1]); vf.w = pack_bf16(v1[2], v1[3]);
                O[cb] = mfma16(as_bf16x8(pf), as_bf16x8(vf), O[cb]);
            }
        }
    };
    loadg(vbb, 8, rC); loadg(vbb, 12, rD);
    __builtin_amdgcn_sched_barrier(0);
    stage(rA); pv(0);
    stage(rB); pv(4);
    __builtin_amdgcn_sched_barrier(0);
    stage(rC); pv(8);
    stage(rD); pv(12);
    if (g < 2) {
#pragma unroll
        for (int cb = 0; cb < 4; ++cb)
#pragma unroll
            for (int r = 0; r < 4; ++r) ATT8[(size_t)tok * 1024 + 512 + (4 * g + r) * 64 + 16 * cb + c] = (unsigned char)__builtin_amdgcn_cvt_pk_fp8_f32(O[cb][r] * sa8, 0.f, 0, false);
    }
}

DI void p2_swa_item(const Params& p, int item2) {
    unsigned char* ws = p.ws;
    const bf16_t* QA = (const bf16_t*)(ws + WS_QA); const bf16_t* KA = (const bf16_t*)(ws + WS_KA); const bf16_t* VA = (const bf16_t*)(ws + WS_VA);
    unsigned char* ATT8 = ws + WS_ATT;
    const float sa8 = 439.f / fmaxf(__uint_as_float(*(const unsigned*)(ws + WS_AMAX + 4)), 1e-30f);
    int tid = threadIdx.x; asm volatile("" : "+v"(tid));
    const int lane = tid & 63, wave = __builtin_amdgcn_readfirstlane(tid >> 6), r = lane & 31, h = lane >> 5;
    const int hq = item2 & 7, blk = (item2 >> 3) & 31, b = item2 >> 8, kvh = hq >> 2;
    const int qi = 32 * wave + r, tokq = b * SEQ + blk * 128 + qi;
    bf16x8 qf[4], sel[2];
#pragma unroll
    for (int s = 0; s < 4; ++s) qf[s] = as_bf16x8(ldg16(QA + (size_t)tokq * 512 + hq * 64 + 16 * s + 8 * h));
#pragma unroll
    for (int x = 0; x < 2; ++x)
#pragma unroll
        for (int j = 0; j < 8; ++j) sel[x][j] = (8 * h + j + 16 * x == r) ? (short)0x3F80 : (short)0;
    const float sink = p.sinks[hq];
    f32x16 ST[5];
#pragma unroll
    for (int ti = 0; ti < 5; ++ti) {
        const int sj = 32 * (wave + ti) + r; int pos = blk * 128 - 128 + sj; pos = pos < 0 ? 0 : pos;
        const bf16_t* kp = KA + (size_t)(b * SEQ + pos) * 128 + kvh * 64 + 8 * h;
        f32x16 d; for (int i = 0; i < 16; ++i) d[i] = 0.f;
#pragma unroll
        for (int s = 0; s < 4; ++s) d = mfma32(as_bf16x8(ldg16(kp + 16 * s)), qf[s], d);
        ST[ti] = d;
    }
    float mx = sink;
    {
        const int lo = r + 1 - 4 * h;
        const int lo0 = (blk > 0) ? lo : (lo > 128 - 32 * wave - 4 * h ? lo : 128 - 32 * wave - 4 * h);
#pragma unroll
        for (int ti = 0; ti < 5; ++ti)
#pragma unroll
            for (int reg = 0; reg < 16; ++reg) {
                const int e = 32 * ti + (reg & 3) + 8 * (reg >> 2);
                const float sv = (e >= lo0 && e < lo + 128) ? ST[ti][reg] : -3.0e38f; ST[ti][reg] = sv; mx = fmaxf(mx, sv);
            }
    }
    mx = fmaxf(mx, __shfl_xor(mx, 32));
    float lsum = 0.f;
#pragma unroll
    for (int ti = 0; ti < 5; ++ti)
#pragma unroll
        for (int reg = 0; reg < 16; ++reg) { const float e = __expf(ST[ti][reg] - mx); ST[ti][reg] = e; lsum += e; }
    lsum += __shfl_xor(lsum, 32);
    lsum += __expf(sink - mx);
    const float rl = 1.0f / lsum;
    f32x16 OT[2];
    for (int i = 0; i < 16; ++i) { OT[0][i] = 0.f; OT[1][i] = 0.f; }
#pragma unroll
    for (int ti = 0; ti < 5; ++ti) {
        const int sj = 32 * (wave + ti) + r; int pos = blk * 128 - 128 + sj; pos = pos < 0 ? 0 : pos;
        const bf16_t* vp = VA + (size_t)(b * SEQ + pos) * 128 + kvh * 64 + 8 * h;
        bf16x8 vf[4];
#pragma unroll
        for (int s = 0; s < 4; ++s) vf[s] = as_bf16x8(ldg16(vp + 16 * s));
        u32x4 pb[2];
#pragma unroll
        for (int s2 = 0; s2 < 2; ++s2) {
            pb[s2].x = pack_bf16(ST[ti][8 * s2 + 0] * rl, ST[ti][8 * s2 + 1] * rl); pb[s2].y = pack_bf16(ST[ti][8 * s2 + 2] * rl, ST[ti][8 * s2 + 3] * rl);
            pb[s2].z = pack_bf16(ST[ti][8 * s2 + 4] * rl, ST[ti][8 * s2 + 5] * rl); pb[s2].w = pack_bf16(ST[ti][8 * s2 + 6] * rl, ST[ti][8 * s2 + 7] * rl);
        }
#pragma unroll
        for (int db = 0; db < 2; ++db) {
            f32x16 vt; for (int i = 0; i < 16; ++i) vt[i] = 0.f;
            vt = mfma32(vf[2 * db], sel[0], vt); vt = mfma32(vf[2 * db + 1], sel[1], vt);
#pragma unroll
            for (int s2 = 0; s2 < 2; ++s2) {
                u32x4 va; va.x = pack_bf16(vt[8 * s2 + 0], vt[8 * s2 + 1]); va.y = pack_bf16(vt[8 * s2 + 2], vt[8 * s2 + 3]);
                va.z = pack_bf16(vt[8 * s2 + 4], vt[8 * s2 + 5]); va.w = pack_bf16(vt[8 * s2 + 6], vt[8 * s2 + 7]);
                OT[db] = mfma32(as_bf16x8(va), as_bf16x8(pb[s2]), OT[db]);
            }
        }
    }
#pragma unroll
    for (int db = 0; db < 2; ++db)
#pragma unroll
        for (int q4 = 0; q4 < 4; ++q4) {
            int pk = __builtin_amdgcn_cvt_pk_fp8_f32(OT[db][4 * q4] * sa8, OT[db][4 * q4 + 1] * sa8, 0, false);
            pk = __builtin_amdgcn_cvt_pk_fp8_f32(OT[db][4 * q4 + 2] * sa8, OT[db][4 * q4 + 3] * sa8, pk, true);
            *(int*)(ATT8 + (size_t)tokq * 1024 + hq * 64 + 32 * db + 8 * q4 + 4 * h) = pk;
        }
}

template <int MODE> DI void p2_attention(const Params& p, unsigned char* lds, int cidx = 0) {
    const int G = gridDim.x, bi = blockIdx.x, rounds = (1024 + G - 1) / G;
    for (int b = 0; b < BATCH; ++b)
        for (int r = 0; r < rounds; ++r) {
            const int idx = (r & 1) ? r * G + (G - 1 - bi) : r * G + bi;
            if (idx < 1024) p2_dsa_item<MODE>(p, lds, b, 1023 - idx);
        }
    if (MODE & 8) for (int item2 = bi; item2 < NSWA; item2 += G) p2_swa_item(p, item2);
}

DI void p3_outproj(const Params& p, unsigned char* lds) {
    unsigned char* ws = p.ws;
    const unsigned char* ATT8 = ws + WS_ATT; const unsigned char* WT8 = ws + WS_WOT;
    const float desc = (fmaxf(__uint_as_float(*(const unsigned*)(ws + WS_AMAX + 4)), 1e-30f) * (1.f / 439.f)) * (fmaxf(__uint_as_float(*(const unsigned*)(ws + WS_AMAX)), 1e-30f) * (1.f / 439.f));
    const int tid = threadIdx.x, lane = tid & 63, wave = tid >> 6, wm = wave >> 1, wn = wave & 1, c = lane & 15, g = lane >> 4;
    constexpr int NT = 8, MT = NTOK / 128;
    int mt, nt;
    for (int k = 0; tile_of(k, NT, MT, mt, nt); ++k) {
        f32x4 acc[4][4];
        gemm8_128x128(ATT8 + (size_t)mt * 128 * 1024, 1024, WT8 + (size_t)nt * 128 * 1024, 1024, 1024, lds, acc);
#pragma unroll
        for (int m = 0; m < 4; ++m) {
            const int tok = mt * 128 + wm * 64 + m * 16 + c;
#pragma unroll
            for (int n = 0; n < 4; ++n) {
                const size_t o = (size_t)tok * 1024 + nt * 128 + wn * 64 + 16 * n + 4 * g;
                const u32x2 xw = *(const u32x2*)((const bf16_t*)(ws + WS_XB) + o);
                const f32x4 xv = {bf_lo(xw.x), bf_hi(xw.x), bf_lo(xw.y), bf_hi(xw.y)};
                const f32x4 hv = xv * ALPHA + acc[m][n] * desc;
                u32x2 w; w.x = pack_bf16(hv[0], hv[1]); w.y = pack_bf16(hv[2], hv[3]);
                *(u32x2*)((bf16_t*)p.out + o) = w;
            }
        }
    }
}

DI void p3b_ln1(const Params& p) {
    bf16_t* H1B = (bf16_t*)(p.ws + WS_XB); const bf16_t* HP = (const bf16_t*)p.out;
    const int lane = threadIdx.x & 63, gw = blockIdx.x * 4 + (threadIdx.x >> 6), nw = gridDim.x * 4;
    for (int row = gw; row < NTOK; row += nw) {
        const u32x4 ra = ldg16(HP + (size_t)row * 1024 + lane * 16), rb = ldg16(HP + (size_t)row * 1024 + lane * 16 + 8);
        float v[16];
        v[0] = bf_lo(ra.x); v[1] = bf_hi(ra.x); v[2] = bf_lo(ra.y); v[3] = bf_hi(ra.y); v[4] = bf_lo(ra.z); v[5] = bf_hi(ra.z); v[6] = bf_lo(ra.w); v[7] = bf_hi(ra.w);
        v[8] = bf_lo(rb.x); v[9] = bf_hi(rb.x); v[10] = bf_lo(rb.y); v[11] = bf_hi(rb.y); v[12] = bf_lo(rb.z); v[13] = bf_hi(rb.z); v[14] = bf_lo(rb.w); v[15] = bf_hi(rb.w);
        float s = 0.f;
#pragma unroll
        for (int i = 0; i < 16; ++i) s += v[i];
        const float mu = wave_sum(s) * (1.f / 1024.f); float q = 0.f;
#pragma unroll
        for (int i = 0; i < 16; ++i) { const float d = v[i] - mu; q = fmaf(d, d, q); }
        const float rstd = rsqrtf(wave_sum(q) * (1.f / 1024.f) + LN_EPS);
        u32x4 oa, ob; float ov[16]; float amax = 0.f;
#pragma unroll
        for (int k4 = 0; k4 < 4; ++k4) {
            const int col = lane * 16 + k4 * 4;
            const f32x4 gg = *(const f32x4*)(p.ln1_g + col), bb = *(const f32x4*)(p.ln1_b + col);
            float o[4];
#pragma unroll
            for (int e = 0; e < 4; ++e) { o[e] = (v[k4 * 4 + e] - mu) * rstd * gg[e] + bb[e]; ov[k4 * 4 + e] = o[e]; amax = fmaxf(amax, fabsf(o[e])); }
            const unsigned w0 = pack_bf16(o[0], o[1]), w1 = pack_bf16(o[2], o[3]);
            if (k4 == 0) { oa.x = w0; oa.y = w1; } else if (k4 == 1) { oa.z = w0; oa.w = w1; } else if (k4 == 2) { ob.x = w0; ob.y = w1; } else { ob.z = w0; ob.w = w1; }
        }
        *(u32x4*)(H1B + (size_t)row * 1024 + lane * 16) = oa; *(u32x4*)(H1B + (size_t)row * 1024 + lane * 16 + 8) = ob;
        {
#pragma unroll
            for (int o2 = 32; o2 >= 1; o2 >>= 1) amax = fmaxf(amax, __shfl_xor(amax, o2));
            const float sx = amax > 0.f ? amax * (1.0f / 440.0f) : 1.0f, inv = amax > 0.f ? 440.0f / amax : 1.0f;
            u32x4 q8;
#pragma unroll
            for (int k4 = 0; k4 < 4; ++k4) {
                int w = 0;
                w = __builtin_amdgcn_cvt_pk_fp8_f32(ov[4 * k4] * inv, ov[4 * k4 + 1] * inv, w, false);
                w = __builtin_amdgcn_cvt_pk_fp8_f32(ov[4 * k4 + 2] * inv, ov[4 * k4 + 3] * inv, w, true);
                q8[k4] = (unsigned)w;
            }
            *(u32x4*)(p.ws + WS_QA + (size_t)row * 1024 + lane * 16) = q8;
            if (lane == 0) ((float*)(p.ws + WS_SX))[row] = sx;
        }
    }
}

DI int f2key(float v) { const int b = __float_as_int(v); return b ^ ((b >> 31) & 0x7fffffff); }
DI float key2f(int k) { return __int_as_float(k ^ ((k >> 31) & 0x7fffffff)); }
DI void ce_desc(int& a, int& b) { const int hi = a > b ? a : b, lo = a > b ? b : a; a = hi; b = lo; }
DI void bitonic_merge16(int (&k)[16]) {
#pragma unroll
    for (int d = 8; d >= 1; d >>= 1)
#pragma unroll
        for (int i = 0; i < 16; ++i) if ((i & d) == 0) ce_desc(k[i], k[i | d]);
}
DI void bitonic_sort16(int (&k)[16]) {
#pragma unroll
    for (int sz = 2; sz <= 16; sz <<= 1) {
#pragma unroll
        for (int i = 0; i < 16; ++i) { const int j = i ^ (sz - 1); if (j > i) ce_desc(k[i], k[j]); }
#pragma unroll
        for (int d = sz >> 2; d >= 1; d >>= 1)
#pragma unroll
            for (int i = 0; i < 16; ++i) if ((i & d) == 0) ce_desc(k[i], k[i | d]);
    }
}
DI void top16_merge(int (&t)[16], const int (&sdesc)[16]) {
#pragma unroll
    for (int i = 0; i < 16; ++i) t[i] = t[i] > sdesc[15 - i] ? t[i] : sdesc[15 - i];
    bitonic_merge16(t);
}
constexpr int P4_QS = 32768, P4_SS_STRIDE = 132, P4_ST0 = 67584  , P4_M = 0  , P4_ST1 = 8704  ;

DI void p4_peer_query(const Params& p, unsigned char* lds) {
    unsigned char* ws = p.ws;
    const bf16_t* H1B = (const bf16_t*)(ws + WS_XB); const bf16_t* WQT = (const bf16_t*)(ws + WS_WQT); const bf16_t* SK = (const bf16_t*)(ws + WS_SK);
    unsigned short* PE = (unsigned short*)(ws + WS_PE); float* PG = (float*)(ws + WS_PG); float* PS = (float*)(ws + WS_PS);
    const float* SU = (const float*)(ws + WS_SU); const float* SV = (const float*)(ws + WS_SV);
    float* Ss = (float*)lds;
    float* st0 = (float*)(lds + P4_ST0); float* mbuf = (float*)(lds + P4_M); float* st1 = (float*)(lds + P4_ST1);
    constexpr int MT = NTOK / 128;
    int mt, head;
    for (int k = 0; tile_of(k, 8, MT, mt, head); ++k) {
        int tid = threadIdx.x; asm volatile("" : "+v"(tid));
        const int lane = tid & 63, wave = tid >> 6, wm = wave >> 1, wn = wave & 1, c = lane & 15, g = lane >> 4;
        const int lrow = tid >> 3, lch = tid & 7;
        const int srow = tid & 127, shalf = tid >> 7;
#pragma unroll 1
        for (int ph = 0; ph < 2; ++ph) {
            f32x4 acc[4][4];
            gemm_128x128(H1B + (size_t)mt * 128 * 1024, 1024, WQT + (size_t)(head * 256 + ph * 128) * 1024, 1024, 1024, lds, acc);
            __syncthreads();
#pragma unroll
            for (int m = 0; m < 4; ++m)
#pragma unroll
                for (int n = 0; n < 4; ++n) {
                    const int row = wm * 64 + m * 16 + c;
                    u32x2 w; w.x = pack_bf16(acc[m][n][0], acc[m][n][1]); w.y = pack_bf16(acc[m][n][2], acc[m][n][3]);
                    *(u32x2*)(lds + P4_QS + wn * 16384 + row * 128 + (((2 * n + (g >> 1)) ^ (row & 7)) << 4) + (g & 1) * 8) = w;
                }
            {
                const bf16_t* sp = SK + (size_t)((head * 2 + ph) * 128 + lrow) * 128 + lch * 8;
#pragma unroll
                for (int k2 = 0; k2 < 2; ++k2)
#pragma unroll
                    for (int i = 0; i < 4; ++i) *(u32x4*)(lds + k2 * 16384 + (lrow + 32 * i) * 128 + ((lch ^ (lrow & 7)) << 4)) = ldg16(sp + (size_t)(32 * i) * 128 + k2 * 64);
            }
            __syncthreads();
            f32x4 a2[4][4];
#pragma unroll
            for (int m = 0; m < 4; ++m)
#pragma unroll
                for (int n = 0; n < 4; ++n) a2[m][n] = (f32x4){0.f, 0.f, 0.f, 0.f};
#pragma unroll
            for (int k2 = 0; k2 < 2; ++k2)
#pragma unroll
                for (int s = 0; s < 2; ++s) {
                    bf16x8 xf[4], wf[4];
#pragma unroll
                    for (int m = 0; m < 4; ++m) { const int row = wm * 64 + m * 16 + c; xf[m] = as_bf16x8(*(const u32x4*)(lds + P4_QS + k2 * 16384 + row * 128 + (((4 * s + g) ^ (c & 7)) << 4))); }
#pragma unroll
                    for (int n = 0; n < 4; ++n) { const int row = wn * 64 + n * 16 + c; wf[n] = as_bf16x8(*(const u32x4*)(lds + k2 * 16384 + row * 128 + (((4 * s + g) ^ (c & 7)) << 4))); }
#pragma unroll
                    for (int m = 0; m < 4; ++m)
#pragma unroll
                        for (int n = 0; n < 4; ++n) a2[m][n] = mfma16(wf[n], xf[m], a2[m][n]);
                }
            __syncthreads();
#pragma unroll
            for (int m = 0; m < 4; ++m)
#pragma unroll
                for (int n = 0; n < 4; ++n) {
                    const int key0 = wn * 64 + 16 * n + 4 * g;
                    u32x4 w;
#pragma unroll
                    for (int r = 0; r < 4; ++r) w[r] = (unsigned)f2key(__uint_as_float((__float_as_uint(a2[m][n][r]) & 0xFFFFFF80u) | (unsigned)(key0 + r)));
                    *(u32x4*)(Ss + (wm * 64 + m * 16 + c) * P4_SS_STRIDE + key0) = w;
                }
            __syncthreads();
            int tv[16];
            {
                const int* rowp = (const int*)Ss + srow * P4_SS_STRIDE + shalf * 64;
#pragma unroll
                for (int bt = 0; bt < 4; ++bt) {
                    int bk[16];
#pragma unroll
                    for (int j = 0; j < 4; ++j) { const u32x4 v = *(const u32x4*)(rowp + 16 * bt + 4 * j); bk[4 * j] = (int)v.x; bk[4 * j + 1] = (int)v.y; bk[4 * j + 2] = (int)v.z; bk[4 * j + 3] = (int)v.w; }
                    bitonic_sort16(bk);
                    if (bt == 0) {
#pragma unroll
                        for (int j = 0; j < 16; ++j) tv[j] = bk[j];
                    } else top16_merge(tv, bk);
                }
            }
            __syncthreads();
            int* mbi = (int*)mbuf;
            if (shalf == 1) {
#pragma unroll
                for (int j = 0; j < 16; ++j) mbi[srow * 17 + j] = tv[j];
            }
            __syncthreads();
            if (shalf == 0) {
                int* dst = (int*)((ph == 0) ? st0 : st1);
                int ob[16];
#pragma unroll
                for (int j = 0; j < 16; ++j) ob[j] = mbi[srow * 17 + j];
                top16_merge(tv, ob);
#pragma unroll
                for (int j = 0; j < 16; ++j) dst[srow * 17 + j] = tv[j];
            }
        }
        __syncthreads();
        int cv[16];
        {
            const int* st0i = (const int*)st0; const int* st1i = (const int*)st1;
            float v2[16];
#pragma unroll
            for (int b = 0; b < 16; ++b) v2[b] = key2f(st1i[srow * 17 + b]);
#pragma unroll
            for (int a8 = 0; a8 < 8; ++a8) {
                const int a = shalf * 8 + a8; const float va = key2f(st0i[srow * 17 + a]);
                int bk[16];
#pragma unroll
                for (int b = 0; b < 16; ++b) bk[b] = (f2key(va + v2[b]) & (int)0xFFFFFF00) | (a * 16 + 15 - b);
                if (a8 == 0) {
#pragma unroll
                    for (int j = 0; j < 16; ++j) cv[j] = bk[j];
                } else top16_merge(cv, bk);
            }
        }
        __syncthreads();
        int* mbi = (int*)mbuf;
        if (shalf == 1) {
#pragma unroll
            for (int j = 0; j < 16; ++j) mbi[srow * 17 + j] = cv[j];
        }
        __syncthreads();
        if (shalf == 0) {
            const int* st0i = (const int*)st0; const int* st1i = (const int*)st1;
            int fk[16]; float fv[16];
#pragma unroll
            for (int j = 0; j < 16; ++j) { const int o = mbi[srow * 17 + 15 - j]; fk[j] = cv[j] > o ? cv[j] : o; fv[j] = key2f(fk[j]); }
            float cmax = fv[0];
#pragma unroll
            for (int j = 1; j < 16; ++j) cmax = fmaxf(cmax, fv[j]);
            float den = 0.f; float ev[16];
#pragma unroll
            for (int j = 0; j < 16; ++j) { ev[j] = __expf(fv[j] - cmax); den += ev[j]; }
            const float rden = 1.0f / den;
            const size_t ob = (size_t)(mt * 128 + srow) * 128 + head * 16;
            int ee[16]; float svv[16], suv[16];
#pragma unroll
            for (int j = 0; j < 16; ++j) {
                const unsigned cde = (unsigned)fk[j] & 0xFFu;
                const unsigned a = cde >> 4, b = 15u - (cde & 15u);
                const unsigned i1 = __float_as_uint(key2f(st0i[srow * 17 + a])) & 0x7Fu, i2 = __float_as_uint(key2f(st1i[srow * 17 + b])) & 0x7Fu;
                ee[j] = (int)(i1 * 128u + i2);
                svv[j] = SV[ee[j]]; suv[j] = SU[ee[j]];
            }
            {
                u32x4 pe0, pe1;
                pe0.x = (unsigned)ee[0] | ((unsigned)ee[1] << 16); pe0.y = (unsigned)ee[2] | ((unsigned)ee[3] << 16); pe0.z = (unsigned)ee[4] | ((unsigned)ee[5] << 16); pe0.w = (unsigned)ee[6] | ((unsigned)ee[7] << 16);
                pe1.x = (unsigned)ee[8] | ((unsigned)ee[9] << 16); pe1.y = (unsigned)ee[10] | ((unsigned)ee[11] << 16); pe1.z = (unsigned)ee[12] | ((unsigned)ee[13] << 16); pe1.w = (unsigned)ee[14] | ((unsigned)ee[15] << 16);
                *(u32x4*)(PE + ob) = pe0; *(u32x4*)(PE + ob + 8) = pe1;
#pragma unroll
                for (int j4 = 0; j4 < 4; ++j4) {
                    f32x4 g4, s4;
#pragma unroll
                    for (int r = 0; r < 4; ++r) { g4[r] = ev[4 * j4 + r] * rden * svv[4 * j4 + r]; s4[r] = suv[4 * j4 + r]; }
                    *(f32x4*)(PG + ob + 4 * j4) = g4; *(f32x4*)(PS + ob + 4 * j4) = s4;
                }
            }
        }
        __syncthreads();
    }
}

DI float gelu_exact(float z) { return 0.5f * z * (1.0f + erff(z * 0.70710678118654752f)); }
DI float rdlane(float v, int l) { return __int_as_float(__builtin_amdgcn_readlane(__float_as_int(v), l)); }

constexpr int P5A_LIST_BYTES = (2048 + 128) * 4, P5A_WAVE_LDS = P5A_LIST_BYTES + 8192;
template <int MODE>
DI void p5a_udot(const Params& p, unsigned char* lds) {
    unsigned char* ws = p.ws;
    const unsigned char* H1Q = ws + WS_QA; const unsigned char* UT = ws + WS_UT;
    const unsigned short* PE = (const unsigned short*)(ws + WS_PE); float* ZB = (float*)(ws + (MODE ? WS_QI : WS_QB));
    const int lane = threadIdx.x & 63, wave = threadIdx.x >> 6, c = lane & 15, kb = lane >> 4;
    const int G = gridDim.x, bid = blockIdx.x;
    const bool affine = (G & 7) == 0;
    const int npass = affine ? 1 : 4;
    unsigned* list = (unsigned*)(lds + wave * P5A_WAVE_LDS);
    unsigned char* slot = lds + wave * P5A_WAVE_LDS + P5A_LIST_BYTES;
    const int l31 = lane & 31, lh = lane >> 5;
    unsigned cq[8];
#pragma unroll
    for (int q = 0; q < 8; ++q) cq[q] = (unsigned)((l31 ^ (q + 8 * lh)) * 16);
    for (int pass = 0; pass < npass; ++pass) {
        const int part = affine ? (bid & 3) : pass, rank = affine ? (bid >> 2) : bid, nper = affine ? (G >> 2) : G;
        const unsigned char* UTp = UT + (size_t)part * (4096 * 512);
        for (int gid = rank * 4 + wave; gid < NTOK / 16; gid += nper * 4) {
            const int t0 = gid * 16;
            u32x4 pv[4];
#pragma unroll
            for (int i = 0; i < 4; ++i) pv[i] = ldg16(PE + (size_t)(t0 + (lane >> 2)) * 128 + (lane & 3) * 32 + 8 * i);
            i32x8 ax[8];
#pragma unroll
            for (int s2 = 0; s2 < 8; ++s2) {
                const unsigned char* xp = H1Q + (size_t)(t0 + c) * 1024 + 128 * s2 + 16 * kb;
                const u32x4 lo = ldg16(xp), hi = ldg16(xp + 64);
                ax[s2][0] = (int)lo.x; ax[s2][1] = (int)lo.y; ax[s2][2] = (int)lo.z; ax[s2][3] = (int)lo.w; ax[s2][4] = (int)hi.x; ax[s2][5] = (int)hi.y; ax[s2][6] = (int)hi.z; ax[s2][7] = (int)hi.w;
            }
            unsigned base = 0;
            const unsigned zl = (unsigned)((lane >> 2) * 128 + (lane & 3) * 32) << 21;
#pragma unroll
            for (int i = 0; i < 4; ++i)
#pragma unroll
                for (int w = 0; w < 4; ++w)
#pragma unroll
                    for (int hf = 0; hf < 2; ++hf) {
                        const unsigned e = hf ? (pv[i][w] >> 16) : (pv[i][w] & 0xffffu);
                        const bool cnd = (int)(e >> 12) == part;
                        const unsigned long long mk = __ballot(cnd);
                        if (mk) {
                            const unsigned pos = base + __builtin_amdgcn_mbcnt_hi((unsigned)(mk >> 32), __builtin_amdgcn_mbcnt_lo((unsigned)mk, 0u));
                            if (cnd) list[pos] = ((e & 4095u) << 9) | (zl + ((unsigned)(8 * i + 2 * w + hf) << 21));
                            base += (unsigned)__popcll(mk);
                        }
                    }
            const int count = (int)base, nrt = (count + 15) >> 4;
            if (MODE == 2) { if (count == 12345) ZB[lane] = (float)ax[7][7] + (float)ax[0][0]; }
            else if (count > 0) {
                {
                    const unsigned last = list[count - 1];
                    list[count + lane] = last; list[count + 64 + lane] = last;
                }
                float* ZBg = ZB + (size_t)t0 * 128;
                auto loadA = [&](int rt, u32x4 (&dst)[8]) {
                    const u32x4 ea = *(const u32x4*)(list + 16 * rt + 8 * lh), eb = *(const u32x4*)(list + 16 * rt + 8 * lh + 4);
#pragma unroll
                    for (int q = 0; q < 8; ++q) {
                        const unsigned ent = q < 4 ? ea[q & 3] : eb[q & 3];
                        dst[q] = ldg16(UTp + ((ent & 0x1ffe00u) | cq[q]));
                    }
                };
                auto compute = [&](int rt, const u32x4 (&st)[8]) {
#pragma unroll
                    for (int q = 0; q < 8; ++q) *(u32x4*)(slot + q * 512 + lh * 4096 + l31 * 16) = st[q];
                    u32x4 bf[8];
#pragma unroll
                    for (int s2 = 0; s2 < 8; ++s2) bf[s2] = *(const u32x4*)(slot + c * 512 + (((4 * s2 + kb) ^ c) * 16));
                    const unsigned ent = list[16 * rt + c];
                    f32x4 D = {0.f, 0.f, 0.f, 0.f};
#pragma unroll
                    for (int s2 = 0; s2 < 8; ++s2) {
                        i32x8 b8; b8[0] = (int)bf[s2].x; b8[1] = (int)bf[s2].y; b8[2] = (int)bf[s2].z; b8[3] = (int)bf[s2].w; b8[4] = 0; b8[5] = 0; b8[6] = 0; b8[7] = 0;
                        D = __builtin_amdgcn_mfma_scale_f32_16x16x128_f8f6f4(ax[s2], b8, D, 0  , 4  , 0, 0, 0, 0);
                    }
                    const unsigned zoff = ent >> 21, tk = zoff >> 7;
                    const float val = (tk & 2u) ? ((tk & 1u) ? D[3] : D[2]) : ((tk & 1u) ? D[1] : D[0]);
                    if ((int)(tk >> 2) == kb && 16 * rt + c < count && (MODE != 3 || val == 1234.5f)) ZBg[zoff] = val;
                };
                u32x4 a0[8], a1[8], a2[8];
                loadA(0, a0); loadA(1, a1); loadA(2, a2);
                for (int rt = 0; rt < nrt; rt += 3) {
                    compute(rt, a0); loadA(rt + 3, a0);
                    if (rt + 1 < nrt) compute(rt + 1, a1);
                    loadA(rt + 4, a1);
                    if (rt + 2 < nrt) compute(rt + 2, a2);
                    loadA(rt + 5, a2);
                }
            }
        }
    }
}

DI void p5b_ffn(const Params& p) {
    unsigned char* ws = p.ws;
    const bf16_t* H1B = (const bf16_t*)(ws + WS_XB); const unsigned char* VT = ws + WS_VT;
    const unsigned short* PE = (const unsigned short*)(ws + WS_PE); const float* PG = (const float*)(ws + WS_PG); const float* PS = (const float*)(ws + WS_PS);
    const int lane = threadIdx.x & 63, gw = blockIdx.x * 4 + (threadIdx.x >> 6), nw = gridDim.x * 4;
    const float* ZB = (const float*)(ws + WS_QB); const float* SXp = (const float*)(ws + WS_SX);
    int n_pe_lo = 0, n_pe_hi = 0; float n_z_lo = 0.f, n_z_hi = 0.f, n_ps_lo = 0.f, n_ps_hi = 0.f, n_pg_lo = 0.f, n_pg_hi = 0.f, n_sx = 0.f;
    auto header = [&](int t) {
        const size_t o = (size_t)t * 128 + lane;
        n_pe_lo = (int)PE[o]; n_pe_hi = (int)PE[o + 64]; n_z_lo = ZB[o]; n_z_hi = ZB[o + 64]; n_ps_lo = PS[o]; n_ps_hi = PS[o + 64]; n_pg_lo = PG[o]; n_pg_hi = PG[o + 64]; n_sx = SXp[t];
    };
    if (gw < NTOK) header(gw);
    for (int tok = gw; tok < NTOK; tok += nw) {
        float acc[16];
#pragma unroll
        for (int i = 0; i < 16; ++i) acc[i] = 0.f;
        const int pe_lo = n_pe_lo, pe_hi = n_pe_hi;
        const float cf_lo = gelu_exact(n_z_lo * n_ps_lo * n_sx) * n_pg_lo;
        const float cf_hi = gelu_exact(n_z_hi * n_ps_hi * n_sx) * n_pg_hi;
#define P5_AXPY(vw, k, bs) { const f32x2 f = __builtin_amdgcn_cvt_scalef32_pk_f32_fp4(vw[k], 1.0f, bs); acc[8 * (k) + 2 * (bs)] = fmaf(cj, f.x, acc[8 * (k) + 2 * (bs)]); acc[8 * (k) + 2 * (bs) + 1] = fmaf(cj, f.y, acc[8 * (k) + 2 * (bs) + 1]); }
        u32x2 bufA[16], bufB[16];
        auto issue = [&](int gq, u32x2 (&buf)[16]) {
            const int pes = gq < 4 ? pe_lo : pe_hi; const int lb = (gq & 3) * 16;
#pragma unroll
            for (int j = 0; j < 16; ++j) { const int e = __builtin_amdgcn_readlane(pes, lb + j); buf[j] = *(const u32x2*)(VT + (size_t)e * 512 + lane * 8); }
        };
        auto consume = [&](int gq, const u32x2 (&buf)[16]) {
            const float cfs = gq < 4 ? cf_lo : cf_hi; const int lb = (gq & 3) * 16;
#pragma unroll
            for (int j = 0; j < 16; ++j) {
                const float cj = rdlane(cfs, lb + j);
                const u32x2 vw = buf[j];
                P5_AXPY(vw, 0, 0) P5_AXPY(vw, 0, 1) P5_AXPY(vw, 0, 2) P5_AXPY(vw, 0, 3) P5_AXPY(vw, 1, 0) P5_AXPY(vw, 1, 1) P5_AXPY(vw, 1, 2) P5_AXPY(vw, 1, 3)
            }
        };
#define P5_SB() do {} while (0)
        issue(0, bufA); P5_SB(); issue(1, bufB); P5_SB();
        consume(0, bufA); P5_SB(); issue(2, bufA); P5_SB();
        consume(1, bufB); P5_SB(); issue(3, bufB); P5_SB();
        consume(2, bufA); P5_SB(); issue(4, bufA); P5_SB();
        consume(3, bufB); P5_SB(); issue(5, bufB); P5_SB();
        consume(4, bufA); P5_SB(); issue(6, bufA); P5_SB();
        consume(5, bufB); P5_SB(); issue(7, bufB); P5_SB();
        const u32x4 xa = ldg16(H1B + (size_t)tok * 1024 + lane * 16), xb = ldg16(H1B + (size_t)tok * 1024 + lane * 16 + 8);
        { const int tn = tok + nw < NTOK ? tok + nw : tok; header(tn); }
        consume(6, bufA); P5_SB();
        consume(7, bufB);
        float x[16];
        x[0] = bf_lo(xa.x); x[1] = bf_hi(xa.x); x[2] = bf_lo(xa.y); x[3] = bf_hi(xa.y); x[4] = bf_lo(xa.z); x[5] = bf_hi(xa.z); x[6] = bf_lo(xa.w); x[7] = bf_hi(xa.w);
        x[8] = bf_lo(xb.x); x[9] = bf_hi(xb.x); x[10] = bf_lo(xb.y); x[11] = bf_hi(xb.y); x[12] = bf_lo(xb.z); x[13] = bf_hi(xb.z); x[14] = bf_lo(xb.w); x[15] = bf_hi(xb.w);
        float s = 0.f;
#pragma unroll
        for (int i = 0; i < 16; ++i) { acc[i] = fmaf(ALPHA, x[i], acc[i]); s += acc[i]; }
        const float mu = wave_sum(s) * (1.f / 1024.f); float q = 0.f;
#pragma unroll
        for (int i = 0; i < 16; ++i) { const float dd = acc[i] - mu; q = fmaf(dd, dd, q); }
        const float rstd = rsqrtf(wave_sum(q) * (1.f / 1024.f) + LN_EPS);
#pragma unroll
        for (int k4 = 0; k4 < 4; ++k4) {
            const int col = lane * 16 + k4 * 4;
            const f32x4 gg = *(const f32x4*)(p.ln2_g + col), bb = *(const f32x4*)(p.ln2_b + col);
            f32x4 o;
#pragma unroll
            for (int e = 0; e < 4; ++e) o[e] = (acc[k4 * 4 + e] - mu) * rstd * gg[e] + bb[e];
            *(f32x4*)(p.out + (size_t)tok * 1024 + col) = o;
        }
    }
}

#define XB_TMO      128
#define XB_XCNT(j)  (256  + 64 * (j))
#define XB_XSUB(j)  (1280 + 64 * (j))
#define XB_XGEN(j)  (2304 + 64 * (j))
#define XB_TOP      3328
#define XB_TOPGEN   3392
#define XCD_BAR_WORDS 3456
#define XB_SPIN_CAP (1u << 22)
#define LAS __attribute__((address_space(3)))
DI unsigned xb_ld(unsigned* p)              { return __hip_atomic_load(p, __ATOMIC_RELAXED, __HIP_MEMORY_SCOPE_AGENT); }
DI unsigned xb_add(unsigned* p, unsigned v) { return __hip_atomic_fetch_add(p, v, __ATOMIC_RELAXED, __HIP_MEMORY_SCOPE_AGENT); }
DI unsigned xb_xcc_id() { return (unsigned)__builtin_amdgcn_s_getreg((3 << 11) | 20) & 0xFu; }
#define XB_SPIN(cond, bar) do { unsigned _sp = 0; while (cond) { __builtin_amdgcn_s_sleep(1); \
    if ((++_sp & 255u) == 0u) { if (xb_ld(&(bar)[XB_TMO])) break; if (_sp > XB_SPIN_CAP) { atomicAdd(&(bar)[XB_TMO], 1u); break; } } } } while (0)
struct XcdBarrier { unsigned* bar; unsigned x; volatile LAS unsigned* st; };
DI XcdBarrier xcd_barrier_post(unsigned* bar, volatile LAS unsigned* st) {
    XcdBarrier b; b.bar = bar; b.x = xb_xcc_id(); b.st = st;
    if (threadIdx.x == 0) (void)xb_add(&bar[XB_XCNT(b.x)], 1u);
    return b;
}
DI void xcd_barrier_complete(unsigned* bar, unsigned x, unsigned& nloc, unsigned& nx) {
    const unsigned G = gridDim.x * gridDim.y * gridDim.z;
    unsigned sum, cnt, mine, sp = 0u;
    for (;;) {
        sum = 0u; cnt = 0u; mine = 0u;
#pragma unroll
        for (unsigned j = 0; j < 16; ++j) { const unsigned c = xb_ld(&bar[XB_XCNT(j)]); sum += c; cnt += (c > 0u) ? 1u : 0u; mine = (j == x) ? c : mine; }
        if (sum == G) break;
        __builtin_amdgcn_s_sleep(1);
        if ((++sp & 255u) == 0u) { if (xb_ld(&bar[XB_TMO])) break; if (sp > XB_SPIN_CAP) { atomicAdd(&bar[XB_TMO], 1u); break; } }
    }
    nloc = mine > 0u ? mine : 1u; nx = cnt > 0u ? cnt : 1u;
}
DI void xcd_barrier(const XcdBarrier& b) {
    asm volatile("s_waitcnt vmcnt(0)" ::: "memory");
    __syncthreads();
    if (threadIdx.x == 0) {
        unsigned* bar = b.bar;
        __builtin_amdgcn_s_waitcnt(0);
        unsigned nloc = b.st[0], nx = b.st[1];
        if (nloc == 0u) { xcd_barrier_complete(bar, b.x, nloc, nx); b.st[0] = nloc; b.st[1] = nx; }
        const unsigned old = xb_add(&bar[XB_XSUB(b.x)], 1u);
        const unsigned gen = old / nloc;
        if (old + 1u == (gen + 1u) * nloc) {
            __builtin_amdgcn_fence(__ATOMIC_RELEASE, "agent");
            asm volatile("s_waitcnt vmcnt(0)" ::: "memory");
            const unsigned og = xb_add(&bar[XB_TOP], 1u);
            const unsigned tg = og / nx;
            if (og + 1u == (tg + 1u) * nx) xb_add(&bar[XB_TOPGEN], 1u);
            else XB_SPIN(xb_ld(&bar[XB_TOPGEN]) == tg, bar);
            __builtin_amdgcn_fence(__ATOMIC_ACQUIRE, "agent");
            xb_add(&bar[XB_XGEN(b.x)], 1u);
            asm volatile("s_waitcnt vmcnt(0)" ::: "memory");
        } else {
            XB_SPIN(xb_ld(&bar[XB_XGEN(b.x)]) == gen, bar);
            __builtin_amdgcn_fence(__ATOMIC_ACQUIRE, "agent");
            asm volatile("s_waitcnt vmcnt(0)" ::: "memory");
        }
    }
    __syncthreads();
}

constexpr int NPHASE = 7;
__global__ void __launch_bounds__(NTHREADS, 2) mega_fwd(Params p) {
    extern __shared__ __attribute__((aligned(16))) unsigned char lds[];
    cg::grid_group grid = cg::this_grid();
    const int lo = p.ph_lo, hi = p.ph_hi;
    volatile LAS unsigned* xbst = (volatile LAS unsigned*)(LAS unsigned char*)(lds + LDS_BYTES - 16);
#ifndef REP_MASK
#define REP_MASK 0
#endif
#ifndef P2_PROBE_MODE
#define P2_PROBE_MODE 15
#endif
#ifndef PH_MASK
#define PH_MASK 127
#endif
    if (lo == 0x7fffffff) grid.sync();
    if (threadIdx.x == 0) { xbst[0] = 0u; xbst[1] = 0u; }
    __syncthreads();
    XcdBarrier xb = xcd_barrier_post((unsigned*)(p.ws + WS_BAR), xbst);
#define GSYNC() xcd_barrier(xb)
#if REP_MASK & 1
    p0_prep(p, lds); GSYNC();
#endif
    p0_prep(p, lds);
    GSYNC();
#define RUN_PHASE(k, call) { call; if ((REP_MASK >> (k)) & 1) { GSYNC(); call; } }
#if PH_MASK & 2
    RUN_PHASE(1, p1_inproj(p, lds))
#endif
    GSYNC();
#if PH_MASK & 4
#if (REP_MASK >> 2) & 1
    p2a_indexer(p, lds); GSYNC(); p2_attention<P2_PROBE_MODE>(p, lds, 1); GSYNC();
#endif
    p2a_indexer(p, lds);
    GSYNC();
    p2_attention<15>(p, lds, 0);
#endif
    GSYNC();
#if PH_MASK & 8
    RUN_PHASE(3, p3_outproj(p, lds))
#endif
    GSYNC();
#if PH_MASK & 16
    RUN_PHASE(4, p3b_ln1(p))
#endif
    GSYNC();
#if PH_MASK & 32
    RUN_PHASE(5, p4_peer_query(p, lds))
#endif
    GSYNC();
#if PH_MASK & 64
    p5a_udot<0>(p, lds);
#ifdef P5A_REP
    GSYNC(); p5a_udot<P5A_REP>(p, lds);
#endif
    GSYNC();
    p5b_ffn(p);
#endif
}

#ifndef MK_N_LAUNCHES
#define MK_N_LAUNCHES 1
#endif

extern "C" void kernel_launch(void* const* d_in, const int* in_sizes, int n_in, void* d_out, int out_size, void* d_ws, size_t ws_size, hipStream_t stream) {
    static int grid_blocks = 0;
    if (grid_blocks == 0) {
        if (n_in != 14 || out_size != NTOK * D_MODEL || ws_size < WS_END) {
            fprintf(stderr, "kernel_launch: unexpected problem (n_in %d, out %d, ws %zu, need %zu)\n", n_in, out_size, ws_size, (size_t)WS_END); grid_blocks = -1; return;
        }
        int dev = 0, cus = 0, per_cu = 0;
        hipGetDevice(&dev);
        hipDeviceGetAttribute(&cus, hipDeviceAttributeMultiprocessorCount, dev);
        if (hipFuncSetAttribute((const void*)mega_fwd, hipFuncAttributeMaxDynamicSharedMemorySize, LDS_BYTES) != hipSuccess) { fprintf(stderr, "kernel_launch: hipFuncSetAttribute failed\n"); }
        if (hipOccupancyMaxActiveBlocksPerMultiprocessor(&per_cu, (const void*)mega_fwd, NTHREADS, LDS_BYTES) != hipSuccess || per_cu < 1) { fprintf(stderr, "kernel_launch: occupancy query failed\n"); per_cu = 1; }
        if (per_cu > 2) per_cu = 2;
        (void)hipGetLastError();
        grid_blocks = cus * per_cu;
        fprintf(stderr, "kernel_launch: %d CUs x %d blocks\n", cus, per_cu);
    }
    if (grid_blocks < 0) return;
    Params p{};
    p.x = (const float*)d_in[0]; p.w_in = (const float*)d_in[1]; p.idx_k_g = (const float*)d_in[2]; p.idx_k_b = (const float*)d_in[3]; p.sinks = (const float*)d_in[4];
    p.w_o = (const float*)d_in[5]; p.ln1_g = (const float*)d_in[6]; p.ln1_b = (const float*)d_in[7]; p.peer_wq = (const float*)d_in[8]; p.peer_subkeys = (const float*)d_in[9];
    p.peer_u = (const float*)d_in[10]; p.peer_v = (const float*)d_in[11]; p.ln2_g = (const float*)d_in[12]; p.ln2_b = (const float*)d_in[13];
    p.out = (float*)d_out; p.ws = (unsigned char*)d_ws;
    p.ph_lo = 0; p.ph_hi = NPHASE;
    if (hipMemsetAsync((unsigned char*)d_ws + WS_BAR, 0, 16384 + 64, stream) != hipSuccess) { fprintf(stderr, "kernel_launch: memset of the barrier words failed\n"); return; }
    void* args[] = {&p};
    hipError_t e = hipLaunchCooperativeKernel((const void*)mega_fwd, dim3(grid_blocks), dim3(NTHREADS), args, LDS_BYTES, stream);
    if (e != hipSuccess) fprintf(stderr, "cooperative launch failed: %s (grid %d)\n", hipGetErrorString(e), grid_blocks);
}
```

```cpp
#include <hip/hip_runtime.h>
#include <hip/hip_cooperative_groups.h>
#include <cstdio>
#include <cstdint>
namespace cg = cooperative_groups;

typedef unsigned short bf16_t;
typedef short bf16x8 __attribute__((ext_vector_type(8)));
typedef float f32x4 __attribute__((ext_vector_type(4)));
typedef float f32x16 __attribute__((ext_vector_type(16)));
typedef unsigned u32x4 __attribute__((ext_vector_type(4)));
typedef unsigned u32x2 __attribute__((ext_vector_type(2)));
typedef int i32x8 __attribute__((ext_vector_type(8)));
#define DI __device__ __forceinline__

constexpr int D_MODEL = 1024, BATCH = 8, SEQ = 4096, NTOK = BATCH * SEQ;
constexpr int NMIX = 1732, NMIX_PAD = 1792;
constexpr int P1_F8_COLS = 1408;
constexpr int PEER_N = 2048;
constexpr float ALPHA = 1.189207115002721f;
constexpr float LN_EPS = 1e-5f;
constexpr int NTHREADS = 256;
constexpr int LDS_BYTES = 77824;

constexpr size_t MB = 1024 * 1024;
constexpr size_t WS_CTL   = 0;
constexpr size_t WS_AMAX  = 65536 + 16384;
constexpr size_t WS_BAR   = 65536;
constexpr size_t WS_ROPE  = 1 * MB;
constexpr size_t WS_WINT  = 2 * MB;
constexpr size_t WS_WOT   = 6 * MB;
constexpr size_t WS_WQT   = 8 * MB;
constexpr size_t WS_SK    = 12 * MB;
constexpr size_t WS_UT    = 13 * MB;
constexpr size_t WS_VT    = 29 * MB;
constexpr size_t WS_SU    = 45 * MB;
constexpr size_t WS_SV    = 46 * MB;
constexpr size_t WS_SXR   = 47 * MB + 262144;
constexpr size_t WS_SWN   = 47 * MB + 524288;
constexpr size_t WS_X8    = 282 * MB;
constexpr size_t WS_SX    = 47 * MB;
constexpr size_t WS_XB    = 77 * MB;
constexpr size_t WS_QA    = 141 * MB;
constexpr size_t WS_KA    = 173 * MB;
constexpr size_t WS_VA    = 181 * MB;
constexpr size_t WS_QB    = 189 * MB;
constexpr size_t WS_KB    = 221 * MB;
constexpr size_t WS_VB    = 225 * MB;
constexpr size_t WS_QI    = 229 * MB;
constexpr size_t WS_KI    = 245 * MB;
constexpr size_t WS_WI    = 249 * MB;
constexpr size_t WS_ATT   = 250 * MB;
constexpr size_t WS_PE    = 314 * MB;
constexpr size_t WS_PG    = 322 * MB;
constexpr size_t WS_PS    = 338 * MB;
constexpr size_t WS_END   = 354 * MB;

struct Params {
    const float* x; const float* w_in; const float* idx_k_g; const float* idx_k_b; const float* sinks; const float* w_o;
    const float* ln1_g; const float* ln1_b; const float* peer_wq; const float* peer_subkeys; const float* peer_u; const float* peer_v;
    const float* ln2_g; const float* ln2_b;
    float* out; unsigned char* ws;
    int ph_lo, ph_hi;
};

typedef float f32x2 __attribute__((ext_vector_type(2)));
typedef __bf16 bf16x2_t __attribute__((ext_vector_type(2)));
DI unsigned pack_bf16(float lo, float hi) { const f32x2 v = {lo, hi}; return __builtin_bit_cast(unsigned, __builtin_convertvector(v, bf16x2_t)); }
DI unsigned f2bf(float x) { return pack_bf16(x, 0.f) & 0xffffu; }
DI float bf_lo(unsigned w) { return __uint_as_float(w << 16); }
DI float bf_hi(unsigned w) { return __uint_as_float(w & 0xffff0000u); }
DI bf16x8 as_bf16x8(u32x4 v) { return __builtin_bit_cast(bf16x8, v); }
DI u32x4 ldg16(const void* p) { return *(const u32x4*)p; }
DI f32x4 mfma16(bf16x8 a, bf16x8 b, f32x4 c) { return __builtin_amdgcn_mfma_f32_16x16x32_bf16(a, b, c, 0, 0, 0); }
DI f32x16 mfma32(bf16x8 a, bf16x8 b, f32x16 c) { return __builtin_amdgcn_mfma_f32_32x32x16_bf16(a, b, c, 0, 0, 0); }
DI float wave_sum(float v) {
#pragma unroll
    for (int o = 32; o >= 1; o >>= 1) v += __shfl_xor(v, o);
    return v;
}

DI void glds16(const void* src, void* lds_dst) { __builtin_amdgcn_global_load_lds((const unsigned*)src, (__attribute__((address_space(3))) unsigned*)lds_dst, 16, 0, 0); }
DI void gemm_128x128(const bf16_t* __restrict__ X, int ldx, const bf16_t* __restrict__ Wt, int ldw, int K, unsigned char* lds, f32x4 (&acc)[4][4]) {
    int tid = threadIdx.x; asm volatile("" : "+v"(tid));
    const int lane = tid & 63, wave = tid >> 6, wm = wave >> 1, wn = wave & 1, c = lane & 15, g = lane >> 4;
    const int lrow = tid >> 3, lch = tid & 7;
    const bf16_t* xp = X + (size_t)lrow * ldx + ((lch ^ (lrow & 7)) * 8);
    const bf16_t* wp = Wt + (size_t)lrow * ldw + ((lch ^ (lrow & 7)) * 8);
    unsigned char* dst0 = lds + tid * 16;
#pragma unroll
    for (int m = 0; m < 4; ++m)
#pragma unroll
        for (int n = 0; n < 4; ++n) acc[m][n] = (f32x4){0.f, 0.f, 0.f, 0.f};
    const int nk = K / 64;
    __syncthreads();
#pragma unroll
    for (int i = 0; i < 4; ++i) { glds16(xp + (size_t)(32 * i) * ldx, dst0 + i * 4096); glds16(wp + (size_t)(32 * i) * ldw, dst0 + 16384 + i * 4096); }
    asm volatile("s_waitcnt vmcnt(0)" ::: "memory");
    __syncthreads();
    for (int kt = 0; kt < nk; ++kt) {
        const unsigned char* Xs = lds + (kt & 1) * 32768; const unsigned char* Ws = Xs + 16384;
        if (kt + 1 < nk) {
            unsigned char* d = dst0 + ((kt + 1) & 1) * 32768;
#pragma unroll
            for (int i = 0; i < 4; ++i) { glds16(xp + (size_t)(32 * i) * ldx + (kt + 1) * 64, d + i * 4096); glds16(wp + (size_t)(32 * i) * ldw + (kt + 1) * 64, d + 16384 + i * 4096); }
        }
#pragma unroll
        for (int s = 0; s < 2; ++s) {
            bf16x8 xf[4], wf[4];
#pragma unroll
            for (int m = 0; m < 4; ++m) { const int row = wm * 64 + m * 16 + c; xf[m] = as_bf16x8(*(const u32x4*)(Xs + row * 128 + (((4 * s + g) ^ (c & 7)) << 4))); }
#pragma unroll
            for (int n = 0; n < 4; ++n) { const int row = wn * 64 + n * 16 + c; wf[n] = as_bf16x8(*(const u32x4*)(Ws + row * 128 + (((4 * s + g) ^ (c & 7)) << 4))); }
#pragma unroll
            for (int m = 0; m < 4; ++m)
#pragma unroll
                for (int n = 0; n < 4; ++n) acc[m][n] = mfma16(wf[n], xf[m], acc[m][n]);
        }
        asm volatile("s_waitcnt vmcnt(0)" ::: "memory");
        __syncthreads();
    }
}

DI void gemm8_128x128(const unsigned char* __restrict__ X, int ldx, const unsigned char* __restrict__ Wt, int ldw, int K, unsigned char* lds, f32x4 (&acc)[4][4]) {
    int tid = threadIdx.x; asm volatile("" : "+v"(tid));
    const int lane = tid & 63, wave = tid >> 6, wm = wave >> 1, wn = wave & 1, c = lane & 15, g = lane >> 4;
    const int lrow = tid >> 3, lch = tid & 7;
    const unsigned char* xp = X + (size_t)lrow * ldx + ((lch ^ (lrow & 7)) * 16);
    const unsigned char* wp = Wt + (size_t)lrow * ldw + ((lch ^ (lrow & 7)) * 16);
    unsigned char* dst0 = lds + tid * 16;
#pragma unroll
    for (int m = 0; m < 4; ++m)
#pragma unroll
        for (int n = 0; n < 4; ++n) acc[m][n] = (f32x4){0.f, 0.f, 0.f, 0.f};
    const int nk = K / 128;
    __syncthreads();
#pragma unroll
    for (int i = 0; i < 4; ++i) { glds16(xp + (size_t)(32 * i) * ldx, dst0 + i * 4096); glds16(wp + (size_t)(32 * i) * ldw, dst0 + 16384 + i * 4096); }
    asm volatile("s_waitcnt vmcnt(0)" ::: "memory");
    __syncthreads();
    for (int kt = 0; kt < nk; ++kt) {
        const unsigned char* Xs = lds + (kt & 1) * 32768; const unsigned char* Ws = Xs + 16384;
        if (kt + 1 < nk) {
            unsigned char* d = dst0 + ((kt + 1) & 1) * 32768;
#pragma unroll
            for (int i = 0; i < 4; ++i) { glds16(xp + (size_t)(32 * i) * ldx + (kt + 1) * 128, d + i * 4096); glds16(wp + (size_t)(32 * i) * ldw + (kt + 1) * 128, d + 16384 + i * 4096); }
        }
        i32x8 xf[4], wf[4];
#pragma unroll
        for (int m = 0; m < 4; ++m) {
            const int row = wm * 64 + m * 16 + c;
            const u32x4 lo = *(const u32x4*)(Xs + row * 128 + ((g ^ (c & 7)) << 4)), hi = *(const u32x4*)(Xs + row * 128 + (((4 + g) ^ (c & 7)) << 4));
            xf[m][0] = (int)lo.x; xf[m][1] = (int)lo.y; xf[m][2] = (int)lo.z; xf[m][3] = (int)lo.w; xf[m][4] = (int)hi.x; xf[m][5] = (int)hi.y; xf[m][6] = (int)hi.z; xf[m][7] = (int)hi.w;
        }
#pragma unroll
        for (int n = 0; n < 4; ++n) {
            const int row = wn * 64 + n * 16 + c;
            const u32x4 lo = *(const u32x4*)(Ws + row * 128 + ((g ^ (c & 7)) << 4)), hi = *(const u32x4*)(Ws + row * 128 + (((4 + g) ^ (c & 7)) << 4));
            wf[n][0] = (int)lo.x; wf[n][1] = (int)lo.y; wf[n][2] = (int)lo.z; wf[n][3] = (int)lo.w; wf[n][4] = (int)hi.x; wf[n][5] = (int)hi.y; wf[n][6] = (int)hi.z; wf[n][7] = (int)hi.w;
        }
#pragma unroll
        for (int m = 0; m < 4; ++m)
#pragma unroll
            for (int n = 0; n < 4; ++n) acc[m][n] = __builtin_amdgcn_mfma_scale_f32_16x16x128_f8f6f4(wf[n], xf[m], acc[m][n], 0, 0, 0, 0, 0, 0);
        asm volatile("s_waitcnt vmcnt(0)" ::: "memory");
        __syncthreads();
    }
}

DI bool tile_of(int k, int NT, int MT, int& mt, int& nt) {
    const int G = gridDim.x, bid = blockIdx.x;
    if (((G | MT) & 7) == 0) {
        const int idx = (bid >> 3) + k * (G >> 3);
        if (idx >= (MT >> 3) * NT) return false;
        mt = (idx / NT) * 8 + (bid & 7); nt = idx % NT;
    } else {
        const int t = bid + k * G;
        if (t >= MT * NT) return false;
        mt = t / NT; nt = t % NT;
    }
    return true;
}

DI void p0_prep(const Params& p, unsigned char* lds) {
    const int tid = threadIdx.x, nb = gridDim.x, bid = blockIdx.x;
    const size_t gtid = (size_t)bid * NTHREADS + tid, gsz = (size_t)nb * NTHREADS;
    unsigned char* ws = p.ws;
    constexpr int W_ITEMS = (P1_F8_COLS / 64) * 4 + ((NMIX_PAD - P1_F8_COLS) / 64) * 16;
    const int nwb = nb >= 8 ? (nb / 2 < W_ITEMS ? nb / 2 : W_ITEMS) : nb, nxb = nb >= 8 ? nb - nwb : nb;
    const bool xrole = nb < 8 || bid < nxb, wrole = nb < 8 || bid >= nxb;
    const int wbid = nb >= 8 ? bid - nxb : bid;
    {
        float* ct = (float*)(ws + WS_ROPE); float* stb = ct + SEQ * 32;
        for (size_t i = gtid; i < (size_t)SEQ * 32; i += gsz) {
            const int pos = (int)(i >> 5), fi = (int)(i & 31);
            const float inv = powf(10000.0f, -(float)(2 * fi) / 64.0f);
            const float ang = (float)pos * inv;
            ct[i] = cosf(ang); stb[i] = sinf(ang);
        }
    }
    auto conv = [&](const float* src, bf16_t* dst, size_t n) {
        for (size_t i = gtid * 8; i < n; i += gsz * 8) {
            const f32x4 a = *(const f32x4*)(src + i), b = *(const f32x4*)(src + i + 4);
            u32x4 o; o.x = pack_bf16(a.x, a.y); o.y = pack_bf16(a.z, a.w); o.z = pack_bf16(b.x, b.y); o.w = pack_bf16(b.z, b.w);
            *(u32x4*)(dst + i) = o;
        }
    };
    if ((bid & 7) == 0 || nb < 8) {
        const int sb = nb < 8 ? bid : (bid >> 3), nsb = nb < 8 ? nb : ((nb + 7) >> 3);
        float m = 0.f;
        for (size_t i = ((size_t)sb * NTHREADS + tid) * 4; i < (size_t)1024 * 1024; i += (size_t)nsb * NTHREADS * 4) { const f32x4 v = *(const f32x4*)(p.w_o + i); m = fmaxf(m, fmaxf(fmaxf(fabsf(v[0]), fabsf(v[1])), fmaxf(fabsf(v[2]), fabsf(v[3])))); }
#pragma unroll
        for (int o = 32; o >= 1; o >>= 1) m = fmaxf(m, __shfl_xor(m, o));
        float* red = (float*)lds;
        __syncthreads();
        if ((tid & 63) == 0) red[tid >> 6] = m;
        __syncthreads();
        if (tid == 0) { const float mm = fmaxf(fmaxf(red[0], red[1]), fmaxf(red[2], red[3])); if (mm > 0.f) atomicMax((unsigned*)(ws + WS_AMAX), __float_as_uint(mm)); }
        __syncthreads();
    }
    if (xrole) {
        const int lane = tid & 63, gw = bid * 4 + (tid >> 6), nw = nxb * 4;
        bf16_t* XBo = (bf16_t*)(ws + WS_XB); unsigned char* X8o = ws + WS_X8; float* SXRo = (float*)(ws + WS_SXR);
        for (int row0 = gw * 4; row0 < NTOK; row0 += nw * 4) {
            f32x4 v[4][4];
#pragma unroll
            for (int r = 0; r < 4; ++r)
#pragma unroll
                for (int i = 0; i < 4; ++i) v[r][i] = *(const f32x4*)(p.x + (size_t)(row0 + r) * 1024 + lane * 16 + 4 * i);
#pragma unroll
            for (int r = 0; r < 4; ++r) {
                const int row = row0 + r;
                float m = 0.f;
#pragma unroll
                for (int i = 0; i < 4; ++i) m = fmaxf(m, fmaxf(fmaxf(fabsf(v[r][i][0]), fabsf(v[r][i][1])), fmaxf(fabsf(v[r][i][2]), fabsf(v[r][i][3]))));
#pragma unroll
                for (int o = 32; o >= 1; o >>= 1) m = fmaxf(m, __shfl_xor(m, o));
                const float sc = m > 0.f ? 439.f / m : 1.f;
                u32x4 o0, o1, q8;
                o0.x = pack_bf16(v[r][0][0], v[r][0][1]); o0.y = pack_bf16(v[r][0][2], v[r][0][3]); o0.z = pack_bf16(v[r][1][0], v[r][1][1]); o0.w = pack_bf16(v[r][1][2], v[r][1][3]);
                o1.x = pack_bf16(v[r][2][0], v[r][2][1]); o1.y = pack_bf16(v[r][2][2], v[r][2][3]); o1.z = pack_bf16(v[r][3][0], v[r][3][1]); o1.w = pack_bf16(v[r][3][2], v[r][3][3]);
#pragma unroll
                for (int i = 0; i < 4; ++i) {
                    int pk = __builtin_amdgcn_cvt_pk_fp8_f32(v[r][i][0] * sc, v[r][i][1] * sc, 0, false);
                    pk = __builtin_amdgcn_cvt_pk_fp8_f32(v[r][i][2] * sc, v[r][i][3] * sc, pk, true);
                    q8[i] = (unsigned)pk;
                }
                *(u32x4*)(XBo + (size_t)row * 1024 + lane * 16) = o0; *(u32x4*)(XBo + (size_t)row * 1024 + lane * 16 + 8) = o1;
                *(u32x4*)(X8o + (size_t)row * 1024 + lane * 16) = q8;
                if (lane == 0) SXRo[row] = m > 0.f ? m * (1.f / 439.f) : 1.f;
            }
        }
    }
    conv(p.peer_subkeys, (bf16_t*)(ws + WS_SK), (size_t)8 * 2 * 128 * 128);
    float* tl = (float*)lds;
    auto transp = [&](const float* src, bf16_t* dst, int N, int Npad, int nt0) {
        const int tn = Npad / 64 - nt0, tk = 1024 / 64;
        for (int t = wbid - (P1_F8_COLS / 64) * 4; t < tn * tk; t += nwb) {
            if (t < 0) continue;
            const int n0 = (nt0 + t % tn) * 64, k0 = (t / tn) * 64;
            __syncthreads();
            for (int e = tid; e < 4096; e += NTHREADS) { const int kk = e >> 6, nn = e & 63; tl[kk * 65 + nn] = (n0 + nn < N) ? src[(size_t)(k0 + kk) * N + n0 + nn] : 0.f; }
            __syncthreads();
            for (int e = tid; e < 4096; e += NTHREADS) { const int nn = e >> 6, kk = e & 63; dst[(size_t)(n0 + nn) * 1024 + k0 + kk] = (bf16_t)f2bf(tl[kk * 65 + nn]); }
        }
    };
    if (wrole) transp(p.w_in, (bf16_t*)(ws + WS_WINT), NMIX, NMIX_PAD, P1_F8_COLS / 64);
    if (wrole) {
        unsigned char* w8 = ws + WS_WINT; float* swn = (float*)(ws + WS_SWN);
        float* cm = (float*)lds + 64 * 65;
        for (int item = wbid; item < (P1_F8_COLS / 64) * 4; item += nwb) {
            const int n0 = (item >> 2) * 64, kpart = item & 3;
            {
                const int n4 = (tid & 15) * 4, kq = tid >> 4;
                f32x4 m4 = {0.f, 0.f, 0.f, 0.f};
#pragma unroll 8
                for (int k2 = kq; k2 < 1024; k2 += 16) {
                    const f32x4 v = *(const f32x4*)(p.w_in + (size_t)k2 * NMIX + n0 + n4);
                    m4[0] = fmaxf(m4[0], fabsf(v[0])); m4[1] = fmaxf(m4[1], fabsf(v[1])); m4[2] = fmaxf(m4[2], fabsf(v[2])); m4[3] = fmaxf(m4[3], fabsf(v[3]));
                }
                __syncthreads();
                *(f32x4*)(cm + kq * 64 + n4) = m4;
                __syncthreads();
                if (tid < 64) {
                    float a = 0.f;
#pragma unroll
                    for (int r = 0; r < 16; ++r) a = fmaxf(a, cm[r * 64 + tid]);
                    cm[1024 + tid] = a > 0.f ? 439.f / a : 1.f;
                    if (kpart == 0) swn[n0 + tid] = a > 0.f ? a * (1.f / 439.f) : 1.f;
                }
            }
            for (int k0 = kpart * 256; k0 < kpart * 256 + 256; k0 += 64) {
                __syncthreads();
                for (int e = tid; e < 4096; e += NTHREADS) { const int kk = e >> 6, n2 = e & 63; tl[kk * 65 + n2] = p.w_in[(size_t)(k0 + kk) * NMIX + n0 + n2]; }
                __syncthreads();
                for (int e = tid; e < 1024; e += NTHREADS) {
                    const int n2 = e >> 4, kq4 = (e & 15) * 4; const float sc = cm[1024 + n2];
                    int pk = __builtin_amdgcn_cvt_pk_fp8_f32(tl[kq4 * 65 + n2] * sc, tl[(kq4 + 1) * 65 + n2] * sc, 0, false);
                    pk = __builtin_amdgcn_cvt_pk_fp8_f32(tl[(kq4 + 2) * 65 + n2] * sc, tl[(kq4 + 3) * 65 + n2] * sc, pk, true);
                    *(int*)(w8 + (size_t)(n0 + n2) * 1024 + k0 + kq4) = pk;
                }
            }
        }
    }
}

DI void p0_late(const Params& p, unsigned char* lds) {
    const int tid = threadIdx.x, nb = gridDim.x, bid = blockIdx.x;
    unsigned char* ws = p.ws;
    {
        const int lane = tid & 63, gw = bid * 4 + (tid >> 6), nw = nb * 4;
        for (int row0 = gw * 4; row0 < 2 * 16384; row0 += nw * 4) {
            f32x4 v[4][4];
#pragma unroll
            for (int r = 0; r < 4; ++r) {
                const int row = row0 + r; const bool isv = row >= 16384; const int e = isv ? row - 16384 : row;
                const float* src = (isv ? p.peer_v : p.peer_u) + (size_t)e * 1024 + lane * 16;
#pragma unroll
                for (int i = 0; i < 4; ++i) v[r][i] = *(const f32x4*)(src + 4 * i);
            }
#pragma unroll
            for (int r = 0; r < 4; ++r) {
                const int row = row0 + r; const bool isv = row >= 16384; const int e = isv ? row - 16384 : row;
                float mx = 0.f;
#pragma unroll
                for (int i = 0; i < 4; ++i) mx = fmaxf(mx, fmaxf(fmaxf(fabsf(v[r][i][0]), fabsf(v[r][i][1])), fmaxf(fabsf(v[r][i][2]), fabsf(v[r][i][3]))));
#pragma unroll
                for (int o = 32; o >= 1; o >>= 1) mx = fmaxf(mx, __shfl_xor(mx, o));
                const float sc = mx > 0.f ? mx * (1.0f / 5.99f) : 1.0f, inv = mx > 0.f ? 5.99f / mx : 1.0f;
                u32x2 o2;
#pragma unroll
                for (int k = 0; k < 2; ++k) {
                    unsigned w = 0;
                    w = __builtin_amdgcn_cvt_scalef32_pk_fp4_f32(w, v[r][2 * k][0] * inv, v[r][2 * k][1] * inv, 1.0f, 0);
                    w = __builtin_amdgcn_cvt_scalef32_pk_fp4_f32(w, v[r][2 * k][2] * inv, v[r][2 * k][3] * inv, 1.0f, 1);
                    w = __builtin_amdgcn_cvt_scalef32_pk_fp4_f32(w, v[r][2 * k + 1][0] * inv, v[r][2 * k + 1][1] * inv, 1.0f, 2);
                    w = __builtin_amdgcn_cvt_scalef32_pk_fp4_f32(w, v[r][2 * k + 1][2] * inv, v[r][2 * k + 1][3] * inv, 1.0f, 3);
                    o2[k] = w;
                }
                *(u32x2*)(ws + (isv ? WS_VT : WS_UT) + (size_t)e * 512 + lane * 8) = o2;
                if (lane == 0) ((float*)(ws + (isv ? WS_SV : WS_SU)))[e] = sc;
            }
        }
    }
    float* tl = (float*)lds;
    auto transp = [&](const float* src, bf16_t* dst, int N, int Npad) {
        const int tn = Npad / 64, tk = 1024 / 64;
        for (int t = bid; t < tn * tk; t += nb) {
            const int n0 = (t % tn) * 64, k0 = (t / tn) * 64;
            __syncthreads();
            for (int e = tid; e < 4096; e += NTHREADS) { const int kk = e >> 6, nn = e & 63; tl[kk * 65 + nn] = (n0 + nn < N) ? src[(size_t)(k0 + kk) * N + n0 + nn] : 0.f; }
            __syncthreads();
            for (int e = tid; e < 4096; e += NTHREADS) { const int nn = e >> 6, kk = e & 63; dst[(size_t)(n0 + nn) * 1024 + k0 + kk] = (bf16_t)f2bf(tl[kk * 65 + nn]); }
        }
    };
    {
        const float amax = __uint_as_float(*(const unsigned*)(ws + WS_AMAX)), sw = amax > 0.f ? 439.f / amax : 1.f;
        unsigned char* dst8 = ws + WS_WOT;
        for (int t = bid; t < 16 * 16; t += nb) {
            const int n0 = (t % 16) * 64, k0 = (t / 16) * 64;
            __syncthreads();
            for (int e = tid; e < 4096; e += NTHREADS) { const int kk = e >> 6, nn = e & 63; tl[kk * 65 + nn] = p.w_o[(size_t)(k0 + kk) * 1024 + n0 + nn]; }
            __syncthreads();
            for (int e = tid; e < 1024; e += NTHREADS) {
                const int nn = e >> 4, kq = (e & 15) * 4;
                int pk = __builtin_amdgcn_cvt_pk_fp8_f32(tl[kq * 65 + nn] * sw, tl[(kq + 1) * 65 + nn] * sw, 0, false);
                pk = __builtin_amdgcn_cvt_pk_fp8_f32(tl[(kq + 2) * 65 + nn] * sw, tl[(kq + 3) * 65 + nn] * sw, pk, true);
                *(int*)(dst8 + (size_t)(n0 + nn) * 1024 + k0 + kq) = pk;
            }
        }
    }
    transp(p.peer_wq, (bf16_t*)(ws + WS_WQT), PEER_N, PEER_N);
}

DI void p1_inproj(const Params& p, unsigned char* lds) {
    unsigned char* ws = p.ws;
    const bf16_t* XB = (const bf16_t*)(ws + WS_XB); const bf16_t* WT = (const bf16_t*)(ws + WS_WINT);
    const float* cosT = (const float*)(ws + WS_ROPE); const float* sinT = cosT + SEQ * 32;
    const int tid = threadIdx.x, lane = tid & 63, wave = tid >> 6, wm = wave >> 1, wn = wave & 1, c = lane & 15, g = lane >> 4;
    constexpr int NT = NMIX_PAD / 128, MT = NTOK / 128;
    int mt, nt;
    for (int k = 0; tile_of(k, NT, MT, mt, nt); ++k) {
        f32x4 acc[4][4];
        const bool f8 = nt < P1_F8_COLS / 128;
        if (f8) gemm8_128x128(ws + WS_X8 + (size_t)mt * 128 * 1024, 1024, ws + WS_WINT + (size_t)nt * 128 * 1024, 1024, 1024, lds, acc);
        else gemm_128x128(XB + (size_t)mt * 128 * 1024, 1024, WT + (size_t)nt * 128 * 1024, 1024, 1024, lds, acc);
        f32x4 swn4[4];
#pragma unroll
        for (int n = 0; n < 4; ++n) swn4[n] = f8 ? *(const f32x4*)((const float*)(ws + WS_SWN) + nt * 128 + wn * 64 + 16 * n + 4 * g) : (f32x4){1.f, 1.f, 1.f, 1.f};
        const int col64 = nt * 2 + wn;
        bf16_t* dst; int ld, coff; bool rope = true; float scale = 1.f; float vmax = 0.f;
        if (col64 < 8)       { dst = (bf16_t*)(ws + WS_QA); ld = 512; coff = col64 * 64; scale = 0.125f; }
        else if (col64 < 10) { dst = (bf16_t*)(ws + WS_KA); ld = 128; coff = (col64 - 8) * 64; }
        else if (col64 < 12) { dst = (bf16_t*)(ws + WS_VA); ld = 128; coff = (col64 - 10) * 64; rope = false; }
        else if (col64 < 20) { dst = (bf16_t*)(ws + WS_QB); ld = 512; coff = (col64 - 12) * 64; scale = 0.125f; }
        else if (col64 == 20) { dst = (bf16_t*)(ws + WS_KB); ld = 64; coff = 0; }
        else if (col64 == 21) { dst = (bf16_t*)(ws + WS_VB); ld = 64; coff = 0; rope = false; }
        else if (col64 < 26) { dst = (bf16_t*)(ws + WS_QI); ld = 256; coff = (col64 - 22) * 64; }
        else                 { dst = (bf16_t*)(ws + WS_KI); ld = 64; coff = 0; }
        if (col64 == 27) {
            if (g == 0) {
#pragma unroll
                for (int m = 0; m < 4; ++m) { const int tok = mt * 128 + wm * 64 + m * 16 + c; *(f32x4*)((float*)(ws + WS_WI) + (size_t)tok * 4) = acc[m][0] * 0.0625f; }
            }
            continue;
        }
#pragma unroll
        for (int m = 0; m < 4; ++m) {
            const int tok = mt * 128 + wm * 64 + m * 16 + c, pos = tok & (SEQ - 1);
            const float sxr = f8 ? ((const float*)(ws + WS_SXR))[tok] : 1.f;
            f32x4 v[4] = {acc[m][0] * (swn4[0] * sxr), acc[m][1] * (swn4[1] * sxr), acc[m][2] * (swn4[2] * sxr), acc[m][3] * (swn4[3] * sxr)};
            if (col64 == 26) {
                float s = 0.f;
#pragma unroll
                for (int n = 0; n < 4; ++n) s += (v[n][0] + v[n][1]) + (v[n][2] + v[n][3]);
                s += __shfl_xor(s, 16); s += __shfl_xor(s, 32);
                const float mu = s * (1.f / 64.f); float q = 0.f;
#pragma unroll
                for (int n = 0; n < 4; ++n) { const f32x4 d = v[n] - mu; q += (d[0] * d[0] + d[1] * d[1]) + (d[2] * d[2] + d[3] * d[3]); }
                q += __shfl_xor(q, 16); q += __shfl_xor(q, 32);
                const float rstd = rsqrtf(q * (1.f / 64.f) + LN_EPS);
#pragma unroll
                for (int n = 0; n < 4; ++n) {
                    const f32x4 gg = *(const f32x4*)(p.idx_k_g + 16 * n + 4 * g), bb = *(const f32x4*)(p.idx_k_b + 16 * n + 4 * g);
                    v[n] = (v[n] - mu) * rstd * gg + bb;
                }
            }
            if (rope) {
#pragma unroll
                for (int n = 0; n < 2; ++n) {
                    const f32x4 cs = *(const f32x4*)(cosT + pos * 32 + 16 * n + 4 * g), sn = *(const f32x4*)(sinT + pos * 32 + 16 * n + 4 * g);
                    const f32x4 t1 = v[n], t2 = v[n + 2];
                    v[n] = t1 * cs - t2 * sn; v[n + 2] = t2 * cs + t1 * sn;
                }
            }
#pragma unroll
            for (int n = 0; n < 4; ++n) {
                const f32x4 o = v[n] * scale; u32x2 w; w.x = pack_bf16(o[0], o[1]); w.y = pack_bf16(o[2], o[3]);
                *(u32x2*)(dst + (size_t)tok * ld + coff + 16 * n + 4 * g) = w;
                if (!rope) vmax = fmaxf(vmax, fmaxf(fmaxf(fabsf(o[0]), fabsf(o[1])), fmaxf(fabsf(o[2]), fabsf(o[3]))));
            }
        }
        if (!rope) {
#pragma unroll
            for (int o = 32; o >= 1; o >>= 1) vmax = fmaxf(vmax, __shfl_xor(vmax, o));
            if (lane == 0 && vmax > 0.f) atomicMax((unsigned*)(ws + WS_AMAX) + 1, __float_as_uint(vmax));
        }
    }
}

constexpr int NDSA = NTOK / 4, NSWA = BATCH * 32 * 8;
constexpr int P2_STG = 0  , P2_LIST = 32768;

DI unsigned f16_key(float v) {
    _Float16 hv = (_Float16)v; unsigned short hb = __builtin_bit_cast(unsigned short, hv); unsigned b = hb;
    if (b == 0x8000u) b = 0u;
    return (b & 0x8000u) ? ((~b) & 0xffffu) : (b | 0x8000u);
}

DI size_t sc_row_off(int t) { const size_t m = (size_t)(t >> 3); return 8 * (4 * m * (m + 1) + (size_t)(t & 7) * (m + 1)); }
constexpr size_t SC_BATCH = 8404992;
DI unsigned short* sc_batch_base(const Params& p, int b) { return (b < 7) ? (unsigned short*)p.out + (size_t)b * SC_BATCH : (unsigned short*)(p.ws + WS_PG); }

DI void p2a_indexer(const Params& p, unsigned char* lds) {
    unsigned char* ws = p.ws;
    const bf16_t* QI = (const bf16_t*)(ws + WS_QI); const bf16_t* KI = (const bf16_t*)(ws + WS_KI); const float* WI = (const float*)(ws + WS_WI);
    const int G = gridDim.x, bi = blockIdx.x;
    for (int it = 0; it < 2; ++it) {
        const int item = (it == 0) ? bi : 1023 - bi;
        for (int id = (G == 512) ? item : bi + it * G; id < 1024; id += (G == 512) ? 1024 : 2 * G) {
            int tid = threadIdx.x; asm volatile("" : "+v"(tid));
            const int lane = tid & 63, wave = tid >> 6, c = lane & 15, g = lane >> 4, lrow = tid >> 3, lch = tid & 7;
            const int b = id >> 7, t0 = (id & 127) * 32, tokw = b * SEQ + t0 + 8 * wave;
            unsigned short* scb = sc_batch_base(p, b);
            bf16x8 af[2][2]; f32x4 wv[2];
#pragma unroll
            for (int rt = 0; rt < 2; ++rt) {
#pragma unroll
                for (int s2 = 0; s2 < 2; ++s2) af[rt][s2] = as_bf16x8(ldg16(QI + (size_t)(tokw + 4 * rt + (c >> 2)) * 256 + (c & 3) * 64 + 32 * s2 + 8 * g));
                wv[rt] = *(const f32x4*)(WI + (size_t)(tokw + 4 * rt + g) * 4);
            }
            asm volatile("" :: "v"(af[0][0]), "v"(af[0][1]), "v"(af[1][0]), "v"(af[1][1]), "v"(wv[0]), "v"(wv[1]));
            const int nkt = ((t0 + 31) >> 7) + 1;
            const unsigned char* kib = (const unsigned char*)(KI + (size_t)b * SEQ * 64);
            unsigned char* dst0 = lds + tid * 16;
            auto stage = [&](int kt, int buf) {
#pragma unroll
                for (int i = 0; i < 4; ++i) {
                    const int row = lrow + 32 * i;
                    glds16(kib + (size_t)(kt * 128 + row) * 128 + ((lch ^ ((row >> 3) & 7)) << 4), dst0 + buf * 16384 + i * 4096);
                }
            };
            __syncthreads();
            stage(0, 0); if (nkt > 1) stage(1, 1);
            for (int kt = 0; kt < nkt; ++kt) {
                if (kt + 1 < nkt) asm volatile("s_waitcnt vmcnt(4)" ::: "memory");
                else asm volatile("s_waitcnt vmcnt(0)" ::: "memory");
                asm volatile("s_waitcnt lgkmcnt(0)" ::: "memory");
                __builtin_amdgcn_s_barrier();
                if (kt + 2 < nkt) stage(kt + 2, (kt + 2) % 3);
                const unsigned char* Ks = lds + (kt % 3) * 16384;
                unsigned res[2][4];
#pragma unroll
                for (int ct = 0; ct < 8; ++ct) {
                    const int row = 8 * c + ct;
                    const bf16x8 k0 = as_bf16x8(*(const u32x4*)(Ks + row * 128 + ((g ^ (c & 7)) << 4)));
                    const bf16x8 k1 = as_bf16x8(*(const u32x4*)(Ks + row * 128 + (((4 + g) ^ (c & 7)) << 4)));
#pragma unroll
                    for (int rt = 0; rt < 2; ++rt) {
                        f32x4 d = mfma16(af[rt][0], k0, (f32x4){0.f, 0.f, 0.f, 0.f});
                        d = mfma16(af[rt][1], k1, d);
                        const float sv = wv[rt][0] * fmaxf(d[0], 0.f) + wv[rt][1] * fmaxf(d[1], 0.f) + wv[rt][2] * fmaxf(d[2], 0.f) + wv[rt][3] * fmaxf(d[3], 0.f);
                        const int key = kt * 128 + row, tq = t0 + 8 * wave + 4 * rt + g;
                        const unsigned kv = (key <= tq) ? f16_key(sv) : 0u;
                        if (ct & 1) res[rt][ct >> 1] |= kv << 16; else res[rt][ct >> 1] = kv;
                    }
                }
#pragma unroll
                for (int rt = 0; rt < 2; ++rt) {
                    const int tq = t0 + 8 * wave + 4 * rt + g;
                    if (16 * kt + c <= (tq >> 3)) {
                        u32x4 w; w.x = res[rt][0]; w.y = res[rt][1]; w.z = res[rt][2]; w.w = res[rt][3];
                        *(u32x4*)(scb + sc_row_off(tq) + kt * 128 + 8 * c) = w;
                    }
                }
            }
        }
    }
    __syncthreads();
    p0_late(p, lds);
}

template <int MODE> DI void p2_dsa_item(const Params& p, unsigned char* lds, int b, int tb) {
    unsigned char* ws = p.ws;
    const bf16_t* QI = (const bf16_t*)(ws + WS_QI); const bf16_t* KI = (const bf16_t*)(ws + WS_KI); const float* WI = (const float*)(ws + WS_WI);
    const bf16_t* QB = (const bf16_t*)(ws + WS_QB); const bf16_t* KB = (const bf16_t*)(ws + WS_KB); const bf16_t* VB = (const bf16_t*)(ws + WS_VB);
    unsigned char* ATT8 = ws + WS_ATT;
    const float sa8 = 439.f / fmaxf(__uint_as_float(*(const unsigned*)(ws + WS_AMAX + 4)), 1e-30f);
    int tid = threadIdx.x; asm volatile("" : "+v"(tid));
    const int lane = tid & 63, wave = __builtin_amdgcn_readfirstlane(tid >> 6), c = lane & 15, g = lane >> 4;
    const int t0 = tb * 4, tok0 = b * SEQ + t0;
    unsigned char* stg = lds + P2_STG + wave * 8192;
    unsigned* hist = (unsigned*)stg;
    unsigned short* list = (unsigned short*)(lds + P2_LIST) + wave * 256;
    const int tok = tok0 + wave;
    if (!(MODE & 2)) return;
    const int n = t0 + wave + 1;
    const int L = n < 256 ? n : 256;
    const unsigned short* myk = sc_batch_base(p, b) + sc_row_off(t0 + wave);
    if (n <= 256) {
        for (int i = lane; i < n; i += 64) list[i] = (unsigned short)i;
    } else {
        u32x4 kk[8];
#pragma unroll
        for (int i = 0; i < 8; ++i) kk[i] = (512 * i + 8 * lane < n) ? ldg16(myk + 512 * i + 8 * lane) : (u32x4){0u, 0u, 0u, 0u};
#pragma unroll
        for (int i = 0; i < 4; ++i) *(u32x4*)(hist + lane * 16 + i * 4) = (u32x4){0u, 0u, 0u, 0u};
#pragma unroll
        for (int i = 0; i < 8; ++i) {
            if (512 * i < n) {
#pragma unroll
                for (int w = 0; w < 4; ++w) { const unsigned wd = kk[i][w]; atomicAdd(&hist[(wd & 0xffffu) >> 6], 1u); atomicAdd(&hist[wd >> 22], 1u); }
            }
        }
        unsigned h[16];
#pragma unroll
        for (int i = 0; i < 4; ++i) { const u32x4 t = *(const u32x4*)(hist + lane * 16 + i * 4); h[4 * i] = t.x; h[4 * i + 1] = t.y; h[4 * i + 2] = t.z; h[4 * i + 3] = t.w; }
#pragma unroll
        for (int i = 0; i < 4; ++i) *(u32x4*)(hist + lane * 16 + i * 4) = (u32x4){0u, 0u, 0u, 0u};
        unsigned sl = 0;
#pragma unroll
        for (int i = 0; i < 16; ++i) sl += h[i];
        unsigned pre = sl;
#pragma unroll
        for (int o = 1; o < 64; o <<= 1) { const unsigned t = __shfl_up(pre, o); if (lane >= o) pre += t; }
        const unsigned tot = __shfl(pre, 63);
        const unsigned suf = tot - pre;
        int found = -1; unsigned cab = 0, cum = suf;
#pragma unroll
        for (int j = 15; j >= 0; --j) { const bool hit = (found < 0) && (cum + h[j] >= 256u); if (hit) { found = lane * 16 + j; cab = cum; } cum += h[j]; }
        const bool mine = (suf < 256u) && (suf + sl >= 256u);
        const unsigned long long mm = __ballot(mine);
        const int src = __ffsll((long long)mm) - 1;
        const unsigned bstar = (unsigned)__shfl(found, src), cabove = __shfl(cab, src);
        const unsigned r1 = 256u - cabove;
#pragma unroll
        for (int i = 0; i < 8; ++i) {
            if (512 * i < n) {
#pragma unroll
                for (int w = 0; w < 4; ++w) {
                    const unsigned wd = kk[i][w];
                    if (((wd & 0xffffu) >> 6) == bstar) atomicAdd(&hist[wd & 63u], 1u);
                    if ((wd >> 22) == bstar) atomicAdd(&hist[(wd >> 16) & 63u], 1u);
                }
            }
        }
        const unsigned cnt = hist[lane];
        hist[lane] = 0u;
        unsigned pre2 = cnt;
#pragma unroll
        for (int o = 1; o < 64; o <<= 1) { const unsigned t = __shfl_up(pre2, o); if (lane >= o) pre2 += t; }
        const unsigned tot2 = __shfl(pre2, 63);
        const unsigned suf2 = tot2 - pre2;
        const bool mine2 = (suf2 < r1) && (suf2 + cnt >= r1);
        const unsigned long long mm2 = __ballot(mine2);
        const int src2 = __ffsll((long long)mm2) - 1;
        const unsigned T = (bstar << 6) | (unsigned)src2;
        const unsigned req = r1 - __shfl(suf2, src2);
        const unsigned toteq = __shfl(cnt, src2);
        const bool alleq = (req == toteq);
        const unsigned Tt = alleq ? T : T + 1u;
        unsigned cg = 0;
#pragma unroll
        for (int i = 0; i < 8; ++i)
#pragma unroll
            for (int w = 0; w < 4; ++w) { const unsigned wd = kk[i][w]; cg += ((wd & 0xffffu) >= Tt) ? 1u : 0u; cg += ((wd >> 16) >= Tt) ? 1u : 0u; }
        unsigned pre3 = cg;
#pragma unroll
        for (int o = 1; o < 64; o <<= 1) { const unsigned t = __shfl_up(pre3, o); if (lane >= o) pre3 += t; }
        unsigned off = pre3 - cg;
#pragma unroll
        for (int i = 0; i < 8; ++i)
#pragma unroll
            for (int w = 0; w < 4; ++w) {
                const unsigned wd = kk[i][w]; const int idx = 512 * i + 8 * lane + 2 * w;
                if ((wd & 0xffffu) >= Tt) { list[off & 255u] = (unsigned short)idx; ++off; }
                if ((wd >> 16) >= Tt) { list[off & 255u] = (unsigned short)(idx + 1); ++off; }
            }
        if (!alleq) {
            const unsigned cgt = 256u - req; unsigned eq_run = 0;
            for (int base = 0; base < n; base += 64) {
                const int i = base + lane; const unsigned m = (i < n) ? myk[i] : 0u;
                const bool eq = (m == T);
                const unsigned long long eqm = __ballot(eq);
                const unsigned rank = eq_run + __builtin_amdgcn_mbcnt_hi((unsigned)(eqm >> 32), __builtin_amdgcn_mbcnt_lo((unsigned)eqm, 0u));
                if (eq && rank < req) list[cgt + rank] = (unsigned short)i;
                eq_run += (unsigned)__popcll(eqm);
            }
        }
    }
    if (!(MODE & 4)) return;
    bf16x8 qf[2], sel[2];
#pragma unroll
    for (int s = 0; s < 2; ++s) {
        u32x4 t = (u32x4){0u, 0u, 0u, 0u};
        if (c < 8) t = ldg16(QB + (size_t)tok * 512 + c * 64 + 32 * s + 8 * g);
        qf[s] = as_bf16x8(t);
#pragma unroll
        for (int j = 0; j < 8; ++j) sel[s][j] = (8 * g + j == 16 * s + c) ? (short)0x3F80 : (short)0;
    }
    f32x4 st[16];
    const unsigned char* kbb = (const unsigned char*)(KB + (size_t)b * SEQ * 64); const unsigned char* vbb = (const unsigned char*)(VB + (size_t)b * SEQ * 64);
    const int lr = lane >> 3, lc = lane & 7;
    const unsigned st_off = lr * 128 + ((lc ^ lr) << 4);
    auto loadg = [&](const unsigned char* base, int T0, u32x4 (&dst)[8]) {
#pragma unroll
        for (int i = 0; i < 8; ++i) {
            const int idx = T0 * 16 + i * 8 + lr; const unsigned kid = (idx < L) ? (unsigned)list[idx] : 0u;
            dst[i] = ldg16(base + kid * 128u + lc * 16u);
        }
    };
    auto stage = [&](const u32x4 (&src)[8]) {
#pragma unroll
        for (int i = 0; i < 8; ++i) *(u32x4*)(stg + i * 1024 + st_off) = src[i];
    };
    auto frag = [&](int u, int s2) -> bf16x8 { return as_bf16x8(*(const u32x4*)(stg + (16 * u + c) * 128 + (((4 * s2 + g) ^ (c & 7)) << 4))); };
    auto scoreK = [&](int T0) {
#pragma unroll
        for (int T = 0; T < 4; ++T) {
            f32x4 d = mfma16(frag(T, 0), qf[0], (f32x4){0.f, 0.f, 0.f, 0.f});
            st[T0 + T] = mfma16(frag(T, 1), qf[1], d);
        }
    };
    u32x4 rA[8], rB[8], rC[8], rD[8];
    loadg(kbb, 0, rA); loadg(kbb, 4, rB); loadg(kbb, 8, rC); loadg(kbb, 12, rD);
    __builtin_amdgcn_sched_barrier(0);
    stage(rA); scoreK(0);
    stage(rB); scoreK(4);
    __builtin_amdgcn_sched_barrier(0);
    loadg(vbb, 0, rA); loadg(vbb, 4, rB);
    stage(rC); scoreK(8);
    stage(rD); scoreK(12);
    __builtin_amdgcn_sched_barrier(0);
    float mx = -3.0e38f;
    {
        const int lrem = L - 4 * g;
#pragma unroll
        for (int T = 0; T < 16; ++T)
#pragma unroll
            for (int r = 0; r < 4; ++r) { const float sv = (T * 16 + r < lrem) ? st[T][r] : -3.0e38f; st[T][r] = sv; mx = fmaxf(mx, sv); }
    }
    mx = fmaxf(mx, __shfl_xor(mx, 16)); mx = fmaxf(mx, __shfl_xor(mx, 32));
    float lsum = 0.f;
#pragma unroll
    for (int T = 0; T < 16; ++T)
#pragma unroll
        for (int r = 0; r < 4; ++r) { const float e = __expf(st[T][r] - mx); st[T][r] = e; lsum += e; }
    lsum += __shfl_xor(lsum, 16); lsum += __shfl_xor(lsum, 32);
    const float rl = 1.0f / lsum;
    u32x4 pfv[8];
#pragma unroll
    for (int u = 0; u < 8; ++u) {
        const int Ta = 2 * u, Tb = Ta + 1;
        pfv[u].x = pack_bf16(st[Ta][0] * rl, st[Ta][1] * rl); pfv[u].y = pack_bf16(st[Ta][2] * rl, st[Ta][3] * rl);
        pfv[u].z = pack_bf16(st[Tb][0] * rl, st[Tb][1] * rl); pfv[u].w = pack_bf16(st[Tb][2] * rl, st[Tb][3] * rl);
    }
    __builtin_amdgcn_sched_barrier(0);
    f32x4 O[4];
#pragma unroll
    for (int cb = 0; cb < 4; ++cb) O[cb] = (f32x4){0.f, 0.f, 0.f, 0.f};
    auto pv = [&](int T0) {
#pragma unroll
        for (int u = 0; u < 2; ++u) {
            const u32x4 pf = pfv[(T0 >> 1) + u];
#pragma unroll
            for (int cb = 0; cb < 4; ++cb) {
                const f32x4 z = (f32x4){0.f, 0.f, 0.f, 0.f};
                const f32x4 v0 = mfma16(frag(2 * u, cb >> 1), sel[cb & 1], z), v1 = mfma16(frag(2 * u + 1, cb >> 1), sel[cb & 1], z);
                u32x4 vf; vf.x = pack_bf16(v0[0], v0[1]); vf.y = pack_bf16(v0[2], v0[3]); vf.z = pack_bf16(v1[0], v1[1]); vf.w = pack_bf16(v1[2], v1[3]);
                O[cb] = mfma16(as_bf16x8(pf), as_bf16x8(vf), O[cb]);
            }
        }
    };
    loadg(vbb, 8, rC); loadg(vbb, 12, rD);
    __builtin_amdgcn_sched_barrier(0);
    stage(rA); pv(0);
    stage(rB); pv(4);
    __builtin_amdgcn_sched_barrier(0);
    stage(rC); pv(8);
    stage(rD); pv(12);
    if (g < 2) {
#pragma unroll
        for (int cb = 0; cb < 4; ++cb)
#pragma unroll
            for (int r = 0; r < 4; ++r) ATT8[(size_t)tok * 1024 + 512 + (4 * g + r) * 64 + 16 * cb + c] = (unsigned char)__builtin_amdgcn_cvt_pk_fp8_f32(O[cb][r] * sa8, 0.f, 0, false);
    }
}

DI void p2_swa_item(const Params& p, int item2) {
    unsigned char* ws = p.ws;
    const bf16_t* QA = (const bf16_t*)(ws + WS_QA); const bf16_t* KA = (const bf16_t*)(ws + WS_KA); const bf16_t* VA = (const bf16_t*)(ws + WS_VA);
    unsigned char* ATT8 = ws + WS_ATT;
    const float sa8 = 439.f / fmaxf(__uint_as_float(*(const unsigned*)(ws + WS_AMAX + 4)), 1e-30f);
    int tid = threadIdx.x; asm volatile("" : "+v"(tid));
    const int lane = tid & 63, wave = __builtin_amdgcn_readfirstlane(tid >> 6), r = lane & 31, h = lane >> 5;
    const int hq = item2 & 7, blk = (item2 >> 3) & 31, b = item2 >> 8, kvh = hq >> 2;
    const int qi = 32 * wave + r, tokq = b * SEQ + blk * 128 + qi;
    bf16x8 qf[4], sel[2];
#pragma unroll
    for (int s = 0; s < 4; ++s) qf[s] = as_bf16x8(ldg16(QA + (size_t)tokq * 512 + hq * 64 + 16 * s + 8 * h));
#pragma unroll
    for (int x = 0; x < 2; ++x)
#pragma unroll
        for (int j = 0; j < 8; ++j) sel[x][j] = (8 * h + j + 16 * x == r) ? (short)0x3F80 : (short)0;
    const float sink = p.sinks[hq];
    f32x16 ST[5];
#pragma unroll
    for (int ti = 0; ti < 5; ++ti) {
        const int sj = 32 * (wave + ti) + r; int pos = blk * 128 - 128 + sj; pos = pos < 0 ? 0 : pos;
        const bf16_t* kp = KA + (size_t)(b * SEQ + pos) * 128 + kvh * 64 + 8 * h;
        f32x16 d; for (int i = 0; i < 16; ++i) d[i] = 0.f;
#pragma unroll
        for (int s = 0; s < 4; ++s) d = mfma32(as_bf16x8(ldg16(kp + 16 * s)), qf[s], d);
        ST[ti] = d;
    }
    float mx = sink;
    {
        const int lo = r + 1 - 4 * h;
        const int lo0 = (blk > 0) ? lo : (lo > 128 - 32 * wave - 4 * h ? lo : 128 - 32 * wave - 4 * h);
#pragma unroll
        for (int ti = 0; ti < 5; ++ti)
#pragma unroll
            for (int reg = 0; reg < 16; ++reg) {
                const int e = 32 * ti + (reg & 3) + 8 * (reg >> 2);
                const float sv = (e >= lo0 && e < lo + 128) ? ST[ti][reg] : -3.0e38f; ST[ti][reg] = sv; mx = fmaxf(mx, sv);
            }
    }
    mx = fmaxf(mx, __shfl_xor(mx, 32));
    float lsum = 0.f;
#pragma unroll
    for (int ti = 0; ti < 5; ++ti)
#pragma unroll
        for (int reg = 0; reg < 16; ++reg) { const float e = __expf(ST[ti][reg] - mx); ST[ti][reg] = e; lsum += e; }
    lsum += __shfl_xor(lsum, 32);
    lsum += __expf(sink - mx);
    const float rl = 1.0f / lsum;
    f32x16 OT[2];
    for (int i = 0; i < 16; ++i) { OT[0][i] = 0.f; OT[1][i] = 0.f; }
#pragma unroll
    for (int ti = 0; ti < 5; ++ti) {
        const int sj = 32 * (wave + ti) + r; int pos = blk * 128 - 128 + sj; pos = pos < 0 ? 0 : pos;
        const bf16_t* vp = VA + (size_t)(b * SEQ + pos) * 128 + kvh * 64 + 8 * h;
        bf16x8 vf[4];
#pragma unroll
        for (int s = 0; s < 4; ++s) vf[s] = as_bf16x8(ldg16(vp + 16 * s));
        u32x4 pb[2];
#pragma unroll
        for (int s2 = 0; s2 < 2; ++s2) {
            pb[s2].x = pack_bf16(ST[ti][8 * s2 + 0] * rl, ST[ti][8 * s2 + 1] * rl); pb[s2].y = pack_bf16(ST[ti][8 * s2 + 2] * rl, ST[ti][8 * s2 + 3] * rl);
            pb[s2].z = pack_bf16(ST[ti][8 * s2 + 4] * rl, ST[ti][8 * s2 + 5] * rl); pb[s2].w = pack_bf16(ST[ti][8 * s2 + 6] * rl, ST[ti][8 * s2 + 7] * rl);
        }
#pragma unroll
        for (int db = 0; db < 2; ++db) {
            f32x16 vt; for (int i = 0; i < 16; ++i) vt[i] = 0.f;
            vt = mfma32(vf[2 * db], sel[0], vt); vt = mfma32(vf[2 * db + 1], sel[1], vt);
#pragma unroll
            for (int s2 = 0; s2 < 2; ++s2) {
                u32x4 va; va.x = pack_bf16(vt[8 * s2 + 0], vt[8 * s2 + 1]); va.y = pack_bf16(vt[8 * s2 + 2], vt[8 * s2 + 3]);
                va.z = pack_bf16(vt[8 * s2 + 4], vt[8 * s2 + 5]); va.w = pack_bf16(vt[8 * s2 + 6], vt[8 * s2 + 7]);
                OT[db] = mfma32(as_bf16x8(va), as_bf16x8(pb[s2]), OT[db]);
            }
        }
    }
#pragma unroll
    for (int db = 0; db < 2; ++db)
#pragma unroll
        for (int q4 = 0; q4 < 4; ++q4) {
            int pk = __builtin_amdgcn_cvt_pk_fp8_f32(OT[db][4 * q4] * sa8, OT[db][4 * q4 + 1] * sa8, 0, false);
            pk = __builtin_amdgcn_cvt_pk_fp8_f32(OT[db][4 * q4 + 2] * sa8, OT[db][4 * q4 + 3] * sa8, pk, true);
            *(int*)(ATT8 + (size_t)tokq * 1024 + hq * 64 + 32 * db + 8 * q4 + 4 * h) = pk;
        }
}

template <int MODE> DI void p2_attention(const Params& p, unsigned char* lds, int cidx = 0) {
    const int G = gridDim.x, bi = blockIdx.x, rounds = (1024 + G - 1) / G;
    for (int b = 0; b < BATCH; ++b)
        for (int r = 0; r < rounds; ++r) {
            const int idx = (r & 1) ? r * G + (G - 1 - bi) : r * G + bi;
            if (idx < 1024) p2_dsa_item<MODE>(p, lds, b, 1023 - idx);
        }
    if (MODE & 8) for (int item2 = bi; item2 < NSWA; item2 += G) p2_swa_item(p, item2);
}

DI void p3_outproj(const Params& p, unsigned char* lds) {
    unsigned char* ws = p.ws;
    const unsigned char* ATT8 = ws + WS_ATT; const unsigned char* WT8 = ws + WS_WOT;
    const float desc = (fmaxf(__uint_as_float(*(const unsigned*)(ws + WS_AMAX + 4)), 1e-30f) * (1.f / 439.f)) * (fmaxf(__uint_as_float(*(const unsigned*)(ws + WS_AMAX)), 1e-30f) * (1.f / 439.f));
    const int tid = threadIdx.x, lane = tid & 63, wave = tid >> 6, wm = wave >> 1, wn = wave & 1, c = lane & 15, g = lane >> 4;
    constexpr int NT = 8, MT = NTOK / 128;
    int mt, nt;
    for (int k = 0; tile_of(k, NT, MT, mt, nt); ++k) {
        f32x4 acc[4][4];
        gemm8_128x128(ATT8 + (size_t)mt * 128 * 1024, 1024, WT8 + (size_t)nt * 128 * 1024, 1024, 1024, lds, acc);
#pragma unroll
        for (int m = 0; m < 4; ++m) {
            const int tok = mt * 128 + wm * 64 + m * 16 + c;
#pragma unroll
            for (int n = 0; n < 4; ++n) {
                const size_t o = (size_t)tok * 1024 + nt * 128 + wn * 64 + 16 * n + 4 * g;
                const u32x2 xw = *(const u32x2*)((const bf16_t*)(ws + WS_XB) + o);
                const f32x4 xv = {bf_lo(xw.x), bf_hi(xw.x), bf_lo(xw.y), bf_hi(xw.y)};
                const f32x4 hv = xv * ALPHA + acc[m][n] * desc;
                u32x2 w; w.x = pack_bf16(hv[0], hv[1]); w.y = pack_bf16(hv[2], hv[3]);
                *(u32x2*)((bf16_t*)p.out + o) = w;
            }
        }
    }
}

DI void p3b_ln1(const Params& p) {
    bf16_t* H1B = (bf16_t*)(p.ws + WS_XB); const bf16_t* HP = (const bf16_t*)p.out;
    const int lane = threadIdx.x & 63, gw = blockIdx.x * 4 + (threadIdx.x >> 6), nw = gridDim.x * 4;
    for (int row = gw; row < NTOK; row += nw) {
        const u32x4 ra = ldg16(HP + (size_t)row * 1024 + lane * 16), rb = ldg16(HP + (size_t)row * 1024 + lane * 16 + 8);
        float v[16];
        v[0] = bf_lo(ra.x); v[1] = bf_hi(ra.x); v[2] = bf_lo(ra.y); v[3] = bf_hi(ra.y); v[4] = bf_lo(ra.z); v[5] = bf_hi(ra.z); v[6] = bf_lo(ra.w); v[7] = bf_hi(ra.w);
        v[8] = bf_lo(rb.x); v[9] = bf_hi(rb.x); v[10] = bf_lo(rb.y); v[11] = bf_hi(rb.y); v[12] = bf_lo(rb.z); v[13] = bf_hi(rb.z); v[14] = bf_lo(rb.w); v[15] = bf_hi(rb.w);
        float s = 0.f;
#pragma unroll
        for (int i = 0; i < 16; ++i) s += v[i];
        const float mu = wave_sum(s) * (1.f / 1024.f); float q = 0.f;
#pragma unroll
        for (int i = 0; i < 16; ++i) { const float d = v[i] - mu; q = fmaf(d, d, q); }
        const float rstd = rsqrtf(wave_sum(q) * (1.f / 1024.f) + LN_EPS);
        u32x4 oa, ob; float ov[16]; float amax = 0.f;
#pragma unroll
        for (int k4 = 0; k4 < 4; ++k4) {
            const int col = lane * 16 + k4 * 4;
            const f32x4 gg = *(const f32x4*)(p.ln1_g + col), bb = *(const f32x4*)(p.ln1_b + col);
            float o[4];
#pragma unroll
            for (int e = 0; e < 4; ++e) { o[e] = (v[k4 * 4 + e] - mu) * rstd * gg[e] + bb[e]; ov[k4 * 4 + e] = o[e]; amax = fmaxf(amax, fabsf(o[e])); }
            const unsigned w0 = pack_bf16(o[0], o[1]), w1 = pack_bf16(o[2], o[3]);
            if (k4 == 0) { oa.x = w0; oa.y = w1; } else if (k4 == 1) { oa.z = w0; oa.w = w1; } else if (k4 == 2) { ob.x = w0; ob.y = w1; } else { ob.z = w0; ob.w = w1; }
        }
        *(u32x4*)(H1B + (size_t)row * 1024 + lane * 16) = oa; *(u32x4*)(H1B + (size_t)row * 1024 + lane * 16 + 8) = ob;
        {
#pragma unroll
            for (int o2 = 32; o2 >= 1; o2 >>= 1) amax = fmaxf(amax, __shfl_xor(amax, o2));
            const float sx = amax > 0.f ? amax * (1.0f / 440.0f) : 1.0f, inv = amax > 0.f ? 440.0f / amax : 1.0f;
            u32x4 q8;
#pragma unroll
            for (int k4 = 0; k4 < 4; ++k4) {
                int w = 0;
                w = __builtin_amdgcn_cvt_pk_fp8_f32(ov[4 * k4] * inv, ov[4 * k4 + 1] * inv, w, false);
                w = __builtin_amdgcn_cvt_pk_fp8_f32(ov[4 * k4 + 2] * inv, ov[4 * k4 + 3] * inv, w, true);
                q8[k4] = (unsigned)w;
            }
            *(u32x4*)(p.ws + WS_QA + (size_t)row * 1024 + lane * 16) = q8;
            if (lane == 0) ((float*)(p.ws + WS_SX))[row] = sx;
        }
    }
}

DI int f2key(float v) { const int b = __float_as_int(v); return b ^ ((b >> 31) & 0x7fffffff); }
DI float key2f(int k) { return __int_as_float(k ^ ((k >> 31) & 0x7fffffff)); }
DI void ce_desc(int& a, int& b) { const int hi = a > b ? a : b, lo = a > b ? b : a; a = hi; b = lo; }
DI void bitonic_merge16(int (&k)[16]) {
#pragma unroll
    for (int d = 8; d >= 1; d >>= 1)
#pragma unroll
        for (int i = 0; i < 16; ++i) if ((i & d) == 0) ce_desc(k[i], k[i | d]);
}
DI void bitonic_sort16(int (&k)[16]) {
#pragma unroll
    for (int sz = 2; sz <= 16; sz <<= 1) {
#pragma unroll
        for (int i = 0; i < 16; ++i) { const int j = i ^ (sz - 1); if (j > i) ce_desc(k[i], k[j]); }
#pragma unroll
        for (int d = sz >> 2; d >= 1; d >>= 1)
#pragma unroll
            for (int i = 0; i < 16; ++i) if ((i & d) == 0) ce_desc(k[i], k[i | d]);
    }
}
DI void top16_merge(int (&t)[16], const int (&sdesc)[16]) {
#pragma unroll
    for (int i = 0; i < 16; ++i) t[i] = t[i] > sdesc[15 - i] ? t[i] : sdesc[15 - i];
    bitonic_merge16(t);
}
constexpr int P4_QS = 32768, P4_SS_STRIDE = 132, P4_ST0 = 67584  , P4_M = 0  , P4_ST1 = 8704  ;

DI void p4_peer_query(const Params& p, unsigned char* lds) {
    unsigned char* ws = p.ws;
    const bf16_t* H1B = (const bf16_t*)(ws + WS_XB); const bf16_t* WQT = (const bf16_t*)(ws + WS_WQT); const bf16_t* SK = (const bf16_t*)(ws + WS_SK);
    unsigned short* PE = (unsigned short*)(ws + WS_PE); float* PG = (float*)(ws + WS_PG); float* PS = (float*)(ws + WS_PS);
    const float* SU = (const float*)(ws + WS_SU); const float* SV = (const float*)(ws + WS_SV);
    float* Ss = (float*)lds;
    float* st0 = (float*)(lds + P4_ST0); float* mbuf = (float*)(lds + P4_M); float* st1 = (float*)(lds + P4_ST1);
    constexpr int MT = NTOK / 128;
    int mt, head;
    for (int k = 0; tile_of(k, 8, MT, mt, head); ++k) {
        int tid = threadIdx.x; asm volatile("" : "+v"(tid));
        const int lane = tid & 63, wave = tid >> 6, wm = wave >> 1, wn = wave & 1, c = lane & 15, g = lane >> 4;
        const int lrow = tid >> 3, lch = tid & 7;
        const int srow = tid & 127, shalf = tid >> 7;
#pragma unroll 1
        for (int ph = 0; ph < 2; ++ph) {
            f32x4 acc[4][4];
            gemm_128x128(H1B + (size_t)mt * 128 * 1024, 1024, WQT + (size_t)(head * 256 + ph * 128) * 1024, 1024, 1024, lds, acc);
            __syncthreads();
#pragma unroll
            for (int m = 0; m < 4; ++m)
#pragma unroll
                for (int n = 0; n < 4; ++n) {
                    const int row = wm * 64 + m * 16 + c;
                    u32x2 w; w.x = pack_bf16(acc[m][n][0], acc[m][n][1]); w.y = pack_bf16(acc[m][n][2], acc[m][n][3]);
                    *(u32x2*)(lds + P4_QS + wn * 16384 + row * 128 + (((2 * n + (g >> 1)) ^ (row & 7)) << 4) + (g & 1) * 8) = w;
                }
            {
                const bf16_t* sp = SK + (size_t)((head * 2 + ph) * 128 + lrow) * 128 + lch * 8;
#pragma unroll
                for (int k2 = 0; k2 < 2; ++k2)
#pragma unroll
                    for (int i = 0; i < 4; ++i) *(u32x4*)(lds + k2 * 16384 + (lrow + 32 * i) * 128 + ((lch ^ (lrow & 7)) << 4)) = ldg16(sp + (size_t)(32 * i) * 128 + k2 * 64);
            }
            __syncthreads();
            f32x4 a2[4][4];
#pragma unroll
            for (int m = 0; m < 4; ++m)
#pragma unroll
                for (int n = 0; n < 4; ++n) a2[m][n] = (f32x4){0.f, 0.f, 0.f, 0.f};
#pragma unroll
            for (int k2 = 0; k2 < 2; ++k2)
#pragma unroll
                for (int s = 0; s < 2; ++s) {
                    bf16x8 xf[4], wf[4];
#pragma unroll
                    for (int m = 0; m < 4; ++m) { const int row = wm * 64 + m * 16 + c; xf[m] = as_bf16x8(*(const u32x4*)(lds + P4_QS + k2 * 16384 + row * 128 + (((4 * s + g) ^ (c & 7)) << 4))); }
#pragma unroll
                    for (int n = 0; n < 4; ++n) { const int row = wn * 64 + n * 16 + c; wf[n] = as_bf16x8(*(const u32x4*)(lds + k2 * 16384 + row * 128 + (((4 * s + g) ^ (c & 7)) << 4))); }
#pragma unroll
                    for (int m = 0; m < 4; ++m)
#pragma unroll
                        for (int n = 0; n < 4; ++n) a2[m][n] = mfma16(wf[n], xf[m], a2[m][n]);
                }
            __syncthreads();
#pragma unroll
            for (int m = 0; m < 4; ++m)
#pragma unroll
                for (int n = 0; n < 4; ++n) {
                    const int key0 = wn * 64 + 16 * n + 4 * g;
                    u32x4 w;
#pragma unroll
                    for (int r = 0; r < 4; ++r) w[r] = (unsigned)f2key(__uint_as_float((__float_as_uint(a2[m][n][r]) & 0xFFFFFF80u) | (unsigned)(key0 + r)));
                    *(u32x4*)(Ss + (wm * 64 + m * 16 + c) * P4_SS_STRIDE + key0) = w;
                }
            __syncthreads();
            int tv[16];
            {
                const int* rowp = (const int*)Ss + srow * P4_SS_STRIDE + shalf * 64;
#pragma unroll
                for (int bt = 0; bt < 4; ++bt) {
                    int bk[16];
#pragma unroll
                    for (int j = 0; j < 4; ++j) { const u32x4 v = *(const u32x4*)(rowp + 16 * bt + 4 * j); bk[4 * j] = (int)v.x; bk[4 * j + 1] = (int)v.y; bk[4 * j + 2] = (int)v.z; bk[4 * j + 3] = (int)v.w; }
                    bitonic_sort16(bk);
                    if (bt == 0) {
#pragma unroll
                        for (int j = 0; j < 16; ++j) tv[j] = bk[j];
                    } else top16_merge(tv, bk);
                }
            }
            __syncthreads();
            int* mbi = (int*)mbuf;
            if (shalf == 1) {
#pragma unroll
                for (int j = 0; j < 16; ++j) mbi[srow * 17 + j] = tv[j];
            }
            __syncthreads();
            if (shalf == 0) {
                int* dst = (int*)((ph == 0) ? st0 : st1);
                int ob[16];
#pragma unroll
                for (int j = 0; j < 16; ++j) ob[j] = mbi[srow * 17 + j];
                top16_merge(tv, ob);
#pragma unroll
                for (int j = 0; j < 16; ++j) dst[srow * 17 + j] = tv[j];
            }
        }
        __syncthreads();
        int cv[16];
        {
            const int* st0i = (const int*)st0; const int* st1i = (const int*)st1;
            float v2[16];
#pragma unroll
            for (int b = 0; b < 16; ++b) v2[b] = key2f(st1i[srow * 17 + b]);
#pragma unroll
            for (int a8 = 0; a8 < 8; ++a8) {
                const int a = shalf * 8 + a8; const float va = key2f(st0i[srow * 17 + a]);
                int bk[16];
#pragma unroll
                for (int b = 0; b < 16; ++b) bk[b] = (f2key(va + v2[b]) & (int)0xFFFFFF00) | (a * 16 + 15 - b);
                if (a8 == 0) {
#pragma unroll
                    for (int j = 0; j < 16; ++j) cv[j] = bk[j];
                } else top16_merge(cv, bk);
            }
        }
        __syncthreads();
        int* mbi = (int*)mbuf;
        if (shalf == 1) {
#pragma unroll
            for (int j = 0; j < 16; ++j) mbi[srow * 17 + j] = cv[j];
        }
        __syncthreads();
        if (shalf == 0) {
            const int* st0i = (const int*)st0; const int* st1i = (const int*)st1;
            int fk[16]; float fv[16];
#pragma unroll
            for (int j = 0; j < 16; ++j) { const int o = mbi[srow * 17 + 15 - j]; fk[j] = cv[j] > o ? cv[j] : o; fv[j] = key2f(fk[j]); }
            float cmax = fv[0];
#pragma unroll
            for (int j = 1; j < 16; ++j) cmax = fmaxf(cmax, fv[j]);
            float den = 0.f; float ev[16];
#pragma unroll
            for (int j = 0; j < 16; ++j) { ev[j] = __expf(fv[j] - cmax); den += ev[j]; }
            const float rden = 1.0f / den;
            const size_t ob = (size_t)(mt * 128 + srow) * 128 + head * 16;
            int ee[16]; float svv[16], suv[16];
#pragma unroll
            for (int j = 0; j < 16; ++j) {
                const unsigned cde = (unsigned)fk[j] & 0xFFu;
                const unsigned a = cde >> 4, b = 15u - (cde & 15u);
                const unsigned i1 = __float_as_uint(key2f(st0i[srow * 17 + a])) & 0x7Fu, i2 = __float_as_uint(key2f(st1i[srow * 17 + b])) & 0x7Fu;
                ee[j] = (int)(i1 * 128u + i2);
                svv[j] = SV[ee[j]]; suv[j] = SU[ee[j]];
            }
            {
                u32x4 pe0, pe1;
                pe0.x = (unsigned)ee[0] | ((unsigned)ee[1] << 16); pe0.y = (unsigned)ee[2] | ((unsigned)ee[3] << 16); pe0.z = (unsigned)ee[4] | ((unsigned)ee[5] << 16); pe0.w = (unsigned)ee[6] | ((unsigned)ee[7] << 16);
                pe1.x = (unsigned)ee[8] | ((unsigned)ee[9] << 16); pe1.y = (unsigned)ee[10] | ((unsigned)ee[11] << 16); pe1.z = (unsigned)ee[12] | ((unsigned)ee[13] << 16); pe1.w = (unsigned)ee[14] | ((unsigned)ee[15] << 16);
                *(u32x4*)(PE + ob) = pe0; *(u32x4*)(PE + ob + 8) = pe1;
#pragma unroll
                for (int j4 = 0; j4 < 4; ++j4) {
                    f32x4 g4, s4;
#pragma unroll
                    for (int r = 0; r < 4; ++r) { g4[r] = ev[4 * j4 + r] * rden * svv[4 * j4 + r]; s4[r] = suv[4 * j4 + r]; }
                    *(f32x4*)(PG + ob + 4 * j4) = g4; *(f32x4*)(PS + ob + 4 * j4) = s4;
                }
            }
        }
        __syncthreads();
    }
}

DI float gelu_exact(float z) { return 0.5f * z * (1.0f + erff(z * 0.70710678118654752f)); }
DI float rdlane(float v, int l) { return __int_as_float(__builtin_amdgcn_readlane(__float_as_int(v), l)); }

constexpr int P5A_LIST_BYTES = (2048 + 128) * 4, P5A_WAVE_LDS = P5A_LIST_BYTES + 8192;
template <int MODE>
DI void p5a_udot(const Params& p, unsigned char* lds) {
    unsigned char* ws = p.ws;
    const unsigned char* H1Q = ws + WS_QA; const unsigned char* UT = ws + WS_UT;
    const unsigned short* PE = (const unsigned short*)(ws + WS_PE); float* ZB = (float*)(ws + (MODE ? WS_QI : WS_QB));
    const int lane = threadIdx.x & 63, wave = threadIdx.x >> 6, c = lane & 15, kb = lane >> 4;
    const int G = gridDim.x, bid = blockIdx.x;
    const bool affine = (G & 7) == 0;
    const int npass = affine ? 1 : 4;
    unsigned* list = (unsigned*)(lds + wave * P5A_WAVE_LDS);
    unsigned char* slot = lds + wave * P5A_WAVE_LDS + P5A_LIST_BYTES;
    const int l31 = lane & 31, lh = lane >> 5;
    unsigned cq[8];
#pragma unroll
    for (int q = 0; q < 8; ++q) cq[q] = (unsigned)((l31 ^ (q + 8 * lh)) * 16);
    for (int pass = 0; pass < npass; ++pass) {
        const int part = affine ? (bid & 3) : pass, rank = affine ? (bid >> 2) : bid, nper = affine ? (G >> 2) : G;
        const unsigned char* UTp = UT + (size_t)part * (4096 * 512);
        for (int gid = rank * 4 + wave; gid < NTOK / 16; gid += nper * 4) {
            const int t0 = gid * 16;
            u32x4 pv[4];
#pragma unroll
            for (int i = 0; i < 4; ++i) pv[i] = ldg16(PE + (size_t)(t0 + (lane >> 2)) * 128 + (lane & 3) * 32 + 8 * i);
            i32x8 ax[8];
#pragma unroll
            for (int s2 = 0; s2 < 8; ++s2) {
                const unsigned char* xp = H1Q + (size_t)(t0 + c) * 1024 + 128 * s2 + 16 * kb;
                const u32x4 lo = ldg16(xp), hi = ldg16(xp + 64);
                ax[s2][0] = (int)lo.x; ax[s2][1] = (int)lo.y; ax[s2][2] = (int)lo.z; ax[s2][3] = (int)lo.w; ax[s2][4] = (int)hi.x; ax[s2][5] = (int)hi.y; ax[s2][6] = (int)hi.z; ax[s2][7] = (int)hi.w;
            }
            unsigned base = 0;
            const unsigned zl = (unsigned)((lane >> 2) * 128 + (lane & 3) * 32) << 21;
#pragma unroll
            for (int i = 0; i < 4; ++i)
#pragma unroll
                for (int w = 0; w < 4; ++w)
#pragma unroll
                    for (int hf = 0; hf < 2; ++hf) {
                        const unsigned e = hf ? (pv[i][w] >> 16) : (pv[i][w] & 0xffffu);
                        const bool cnd = (int)(e >> 12) == part;
                        const unsigned long long mk = __ballot(cnd);
                        if (mk) {
                            const unsigned pos = base + __builtin_amdgcn_mbcnt_hi((unsigned)(mk >> 32), __builtin_amdgcn_mbcnt_lo((unsigned)mk, 0u));
                            if (cnd) list[pos] = ((e & 4095u) << 9) | (zl + ((unsigned)(8 * i + 2 * w + hf) << 21));
                            base += (unsigned)__popcll(mk);
                        }
                    }
            const int count = (int)base, nrt = (count + 15) >> 4;
            if (MODE == 2) { if (count == 12345) ZB[lane] = (float)ax[7][7] + (float)ax[0][0]; }
            else if (count > 0) {
                {
                    const unsigned last = list[count - 1];
                    list[count + lane] = last; list[count + 64 + lane] = last;
                }
                float* ZBg = ZB + (size_t)t0 * 128;
                auto loadA = [&](int rt, u32x4 (&dst)[8]) {
                    const u32x4 ea = *(const u32x4*)(list + 16 * rt + 8 * lh), eb = *(const u32x4*)(list + 16 * rt + 8 * lh + 4);
#pragma unroll
                    for (int q = 0; q < 8; ++q) {
                        const unsigned ent = q < 4 ? ea[q & 3] : eb[q & 3];
                        dst[q] = ldg16(UTp + ((ent & 0x1ffe00u) | cq[q]));
                    }
                };
                auto compute = [&](int rt, const u32x4 (&st)[8]) {
#pragma unroll
                    for (int q = 0; q < 8; ++q) *(u32x4*)(slot + q * 512 + lh * 4096 + l31 * 16) = st[q];
                    u32x4 bf[8];
#pragma unroll
                    for (int s2 = 0; s2 < 8; ++s2) bf[s2] = *(const u32x4*)(slot + c * 512 + (((4 * s2 + kb) ^ c) * 16));
                    const unsigned ent = list[16 * rt + c];
                    f32x4 D = {0.f, 0.f, 0.f, 0.f};
#pragma unroll
                    for (int s2 = 0; s2 < 8; ++s2) {
                        i32x8 b8; b8[0] = (int)bf[s2].x; b8[1] = (int)bf[s2].y; b8[2] = (int)bf[s2].z; b8[3] = (int)bf[s2].w; b8[4] = 0; b8[5] = 0; b8[6] = 0; b8[7] = 0;
                        D = __builtin_amdgcn_mfma_scale_f32_16x16x128_f8f6f4(ax[s2], b8, D, 0  , 4  , 0, 0, 0, 0);
                    }
                    const unsigned zoff = ent >> 21, tk = zoff >> 7;
                    const float val = (tk & 2u) ? ((tk & 1u) ? D[3] : D[2]) : ((tk & 1u) ? D[1] : D[0]);
                    if ((int)(tk >> 2) == kb && 16 * rt + c < count && (MODE != 3 || val == 1234.5f)) ZBg[zoff] = val;
                };
                u32x4 a0[8], a1[8], a2[8];
                loadA(0, a0); loadA(1, a1); loadA(2, a2);
                for (int rt = 0; rt < nrt; rt += 3) {
                    compute(rt, a0); loadA(rt + 3, a0);
                    if (rt + 1 < nrt) compute(rt + 1, a1);
                    loadA(rt + 4, a1);
                    if (rt + 2 < nrt) compute(rt + 2, a2);
                    loadA(rt + 5, a2);
                }
            }
        }
    }
}

DI void p5b_ffn(const Params& p) {
    unsigned char* ws = p.ws;
    const bf16_t* H1B = (const bf16_t*)(ws + WS_XB); const unsigned char* VT = ws + WS_VT;
    const unsigned short* PE = (const unsigned short*)(ws + WS_PE); const float* PG = (const float*)(ws + WS_PG); const float* PS = (const float*)(ws + WS_PS);
    const int lane = threadIdx.x & 63, gw = blockIdx.x * 4 + (threadIdx.x >> 6), nw = gridDim.x * 4;
    const float* ZB = (const float*)(ws + WS_QB); const float* SXp = (const float*)(ws + WS_SX);
    int n_pe_lo = 0, n_pe_hi = 0; float n_z_lo = 0.f, n_z_hi = 0.f, n_ps_lo = 0.f, n_ps_hi = 0.f, n_pg_lo = 0.f, n_pg_hi = 0.f, n_sx = 0.f;
    auto header = [&](int t) {
        const size_t o = (size_t)t * 128 + lane;
        n_pe_lo = (int)PE[o]; n_pe_hi = (int)PE[o + 64]; n_z_lo = ZB[o]; n_z_hi = ZB[o + 64]; n_ps_lo = PS[o]; n_ps_hi = PS[o + 64]; n_pg_lo = PG[o]; n_pg_hi = PG[o + 64]; n_sx = SXp[t];
    };
    if (gw < NTOK) header(gw);
    for (int tok = gw; tok < NTOK; tok += nw) {
        float acc[16];
#pragma unroll
        for (int i = 0; i < 16; ++i) acc[i] = 0.f;
        const int pe_lo = n_pe_lo, pe_hi = n_pe_hi;
        const float cf_lo = gelu_exact(n_z_lo * n_ps_lo * n_sx) * n_pg_lo;
        const float cf_hi = gelu_exact(n_z_hi * n_ps_hi * n_sx) * n_pg_hi;
#define P5_AXPY(vw, k, bs) { const f32x2 f = __builtin_amdgcn_cvt_scalef32_pk_f32_fp4(vw[k], 1.0f, bs); acc[8 * (k) + 2 * (bs)] = fmaf(cj, f.x, acc[8 * (k) + 2 * (bs)]); acc[8 * (k) + 2 * (bs) + 1] = fmaf(cj, f.y, acc[8 * (k) + 2 * (bs) + 1]); }
        u32x2 bufA[16], bufB[16];
        auto issue = [&](int gq, u32x2 (&buf)[16]) {
            const int pes = gq < 4 ? pe_lo : pe_hi; const int lb = (gq & 3) * 16;
#pragma unroll
            for (int j = 0; j < 16; ++j) { const int e = __builtin_amdgcn_readlane(pes, lb + j); buf[j] = *(const u32x2*)(VT + (size_t)e * 512 + lane * 8); }
        };
        auto consume = [&](int gq, const u32x2 (&buf)[16]) {
            const float cfs = gq < 4 ? cf_lo : cf_hi; const int lb = (gq & 3) * 16;
#pragma unroll
            for (int j = 0; j < 16; ++j) {
                const float cj = rdlane(cfs, lb + j);
                const u32x2 vw = buf[j];
                P5_AXPY(vw, 0, 0) P5_AXPY(vw, 0, 1) P5_AXPY(vw, 0, 2) P5_AXPY(vw, 0, 3) P5_AXPY(vw, 1, 0) P5_AXPY(vw, 1, 1) P5_AXPY(vw, 1, 2) P5_AXPY(vw, 1, 3)
            }
        };
#define P5_SB() do {} while (0)
        issue(0, bufA); P5_SB(); issue(1, bufB); P5_SB();
        consume(0, bufA); P5_SB(); issue(2, bufA); P5_SB();
        consume(1, bufB); P5_SB(); issue(3, bufB); P5_SB();
        consume(2, bufA); P5_SB(); issue(4, bufA); P5_SB();
        consume(3, bufB); P5_SB(); issue(5, bufB); P5_SB();
        consume(4, bufA); P5_SB(); issue(6, bufA); P5_SB();
        consume(5, bufB); P5_SB(); issue(7, bufB); P5_SB();
        const u32x4 xa = ldg16(H1B + (size_t)tok * 1024 + lane * 16), xb = ldg16(H1B + (size_t)tok * 1024 + lane * 16 + 8);
        { const int tn = tok + nw < NTOK ? tok + nw : tok; header(tn); }
        consume(6, bufA); P5_SB();
        consume(7, bufB);
        float x[16];
        x[0] = bf_lo(xa.x); x[1] = bf_hi(xa.x); x[2] = bf_lo(xa.y); x[3] = bf_hi(xa.y); x[4] = bf_lo(xa.z); x[5] = bf_hi(xa.z); x[6] = bf_lo(xa.w); x[7] = bf_hi(xa.w);
        x[8] = bf_lo(xb.x); x[9] = bf_hi(xb.x); x[10] = bf_lo(xb.y); x[11] = bf_hi(xb.y); x[12] = bf_lo(xb.z); x[13] = bf_hi(xb.z); x[14] = bf_lo(xb.w); x[15] = bf_hi(xb.w);
        float s = 0.f;
#pragma unroll
        for (int i = 0; i < 16; ++i) { acc[i] = fmaf(ALPHA, x[i], acc[i]); s += acc[i]; }
        const float mu = wave_sum(s) * (1.f / 1024.f); float q = 0.f;
#pragma unroll
        for (int i = 0; i < 16; ++i) { const float dd = acc[i] - mu; q = fmaf(dd, dd, q); }
        const float rstd = rsqrtf(wave_sum(q) * (1.f / 1024.f) + LN_EPS);
        f32x4 gg[4], bb[4];
#pragma unroll
        for (int k4 = 0; k4 < 4; ++k4) { gg[k4] = *(const f32x4*)(p.ln2_g + lane * 16 + k4 * 4); bb[k4] = *(const f32x4*)(p.ln2_b + lane * 16 + k4 * 4); }
#pragma unroll
        for (int k4 = 0; k4 < 4; ++k4) {
            const int col = lane * 16 + k4 * 4;
            f32x4 o;
#pragma unroll
            for (int e = 0; e < 4; ++e) o[e] = (acc[k4 * 4 + e] - mu) * rstd * gg[k4][e] + bb[k4][e];
            *(f32x4*)(p.out + (size_t)tok * 1024 + col) = o;
        }
    }
}

#define XB_TMO      128
#define XB_XCNT(j)  (256  + 64 * (j))
#define XB_XSUB(j)  (1280 + 64 * (j))
#define XB_XGEN(j)  (2304 + 64 * (j))
#define XB_TOP      3328
#define XB_TOPGEN   3392
#define XCD_BAR_WORDS 3456
#define XB_SPIN_CAP (1u << 22)
#define LAS __attribute__((address_space(3)))
DI unsigned xb_ld(unsigned* p)              { return __hip_atomic_load(p, __ATOMIC_RELAXED, __HIP_MEMORY_SCOPE_AGENT); }
DI unsigned xb_add(unsigned* p, unsigned v) { return __hip_atomic_fetch_add(p, v, __ATOMIC_RELAXED, __HIP_MEMORY_SCOPE_AGENT); }
DI unsigned xb_xcc_id() { return (unsigned)__builtin_amdgcn_s_getreg((3 << 11) | 20) & 0xFu; }
#define XB_SPIN(cond, bar) do { unsigned _sp = 0; while (cond) { __builtin_amdgcn_s_sleep(1); \
    if ((++_sp & 255u) == 0u) { if (xb_ld(&(bar)[XB_TMO])) break; if (_sp > XB_SPIN_CAP) { atomicAdd(&(bar)[XB_TMO], 1u); break; } } } } while (0)
struct XcdBarrier { unsigned* bar; unsigned x; volatile LAS unsigned* st; };
DI XcdBarrier xcd_barrier_post(unsigned* bar, volatile LAS unsigned* st) {
    XcdBarrier b; b.bar = bar; b.x = xb_xcc_id(); b.st = st;
    if (threadIdx.x == 0) (void)xb_add(&bar[XB_XCNT(b.x)], 1u);
    return b;
}
DI void xcd_barrier_complete(unsigned* bar, unsigned x, unsigned& nloc, unsigned& nx) {
    const unsigned G = gridDim.x * gridDim.y * gridDim.z;
    unsigned sum, cnt, mine, sp = 0u;
    for (;;) {
        sum = 0u; cnt = 0u; mine = 0u;
#pragma unroll
        for (unsigned j = 0; j < 16; ++j) { const unsigned c = xb_ld(&bar[XB_XCNT(j)]); sum += c; cnt += (c > 0u) ? 1u : 0u; mine = (j == x) ? c : mine; }
        if (sum == G) break;
        __builtin_amdgcn_s_sleep(1);
        if ((++sp & 255u) == 0u) { if (xb_ld(&bar[XB_TMO])) break; if (sp > XB_SPIN_CAP) { atomicAdd(&bar[XB_TMO], 1u); break; } }
    }
    nloc = mine > 0u ? mine : 1u; nx = cnt > 0u ? cnt : 1u;
}
DI void xcd_barrier(const XcdBarrier& b) {
    asm volatile("s_waitcnt vmcnt(0)" ::: "memory");
    __syncthreads();
    if (threadIdx.x == 0) {
        unsigned* bar = b.bar;
        __builtin_amdgcn_s_waitcnt(0);
        unsigned nloc = b.st[0], nx = b.st[1];
        if (nloc == 0u) { xcd_barrier_complete(bar, b.x, nloc, nx); b.st[0] = nloc; b.st[1] = nx; }
        const unsigned old = xb_add(&bar[XB_XSUB(b.x)], 1u);
        const unsigned gen = old / nloc;
        if (old + 1u == (gen + 1u) * nloc) {
            __builtin_amdgcn_fence(__ATOMIC_RELEASE, "agent");
            asm volatile("s_waitcnt vmcnt(0)" ::: "memory");
            const unsigned og = xb_add(&bar[XB_TOP], 1u);
            const unsigned tg = og / nx;
            if (og + 1u == (tg + 1u) * nx) xb_add(&bar[XB_TOPGEN], 1u);
            else XB_SPIN(xb_ld(&bar[XB_TOPGEN]) == tg, bar);
            __builtin_amdgcn_fence(__ATOMIC_ACQUIRE, "agent");
            xb_add(&bar[XB_XGEN(b.x)], 1u);
            asm volatile("s_waitcnt vmcnt(0)" ::: "memory");
        } else {
            XB_SPIN(xb_ld(&bar[XB_XGEN(b.x)]) == gen, bar);
            __builtin_amdgcn_fence(__ATOMIC_ACQUIRE, "agent");
            asm volatile("s_waitcnt vmcnt(0)" ::: "memory");
        }
    }
    __syncthreads();
}

constexpr int NPHASE = 7;
__global__ void __launch_bounds__(NTHREADS, 2) mega_fwd(Params p) {
    extern __shared__ __attribute__((aligned(16))) unsigned char lds[];
    cg::grid_group grid = cg::this_grid();
    const int lo = p.ph_lo, hi = p.ph_hi;
    volatile LAS unsigned* xbst = (volatile LAS unsigned*)(LAS unsigned char*)(lds + LDS_BYTES - 16);
#ifndef REP_MASK
#define REP_MASK 0
#endif
#ifndef P2_PROBE_MODE
#define P2_PROBE_MODE 15
#endif
#ifndef PH_MASK
#define PH_MASK 127
#endif
    if (lo == 0x7fffffff) grid.sync();
    if (threadIdx.x == 0) { xbst[0] = 0u; xbst[1] = 0u; }
    __syncthreads();
    XcdBarrier xb = xcd_barrier_post((unsigned*)(p.ws + WS_BAR), xbst);
#define GSYNC() xcd_barrier(xb)
#if REP_MASK & 1
    p0_prep(p, lds); GSYNC();
#endif
    p0_prep(p, lds);
    GSYNC();
#define RUN_PHASE(k, call) { call; if ((REP_MASK >> (k)) & 1) { GSYNC(); call; } }
#if PH_MASK & 2
    RUN_PHASE(1, p1_inproj(p, lds))
#endif
    GSYNC();
#if PH_MASK & 4
#if (REP_MASK >> 2) & 1
    p2a_indexer(p, lds); GSYNC(); p2_attention<P2_PROBE_MODE>(p, lds, 1); GSYNC();
#endif
    p2a_indexer(p, lds);
    GSYNC();
    p2_attention<15>(p, lds, 0);
#endif
    GSYNC();
#if PH_MASK & 8
    RUN_PHASE(3, p3_outproj(p, lds))
#endif
    GSYNC();
#if PH_MASK & 16
    RUN_PHASE(4, p3b_ln1(p))
#endif
    GSYNC();
#if PH_MASK & 32
    RUN_PHASE(5, p4_peer_query(p, lds))
#endif
    GSYNC();
#if PH_MASK & 64
    p5a_udot<0>(p, lds);
#ifdef P5A_REP
    GSYNC(); p5a_udot<P5A_REP>(p, lds);
#endif
    GSYNC();
    p5b_ffn(p);
#endif
}

#ifndef MK_N_LAUNCHES
#define MK_N_LAUNCHES 1
#endif

extern "C" void kernel_launch(void* const* d_in, const int* in_sizes, int n_in, void* d_out, int out_size, void* d_ws, size_t ws_size, hipStream_t stream) {
    static int grid_blocks = 0;
    if (grid_blocks == 0) {
        if (n_in != 14 || out_size != NTOK * D_MODEL || ws_size < WS_END) {
            fprintf(stderr, "kernel_launch: unexpected problem (n_in %d, out %d, ws %zu, need %zu)\n", n_in, out_size, ws_size, (size_t)WS_END); grid_blocks = -1; return;
        }
        int dev = 0, cus = 0, per_cu = 0;
        hipGetDevice(&dev);
        hipDeviceGetAttribute(&cus, hipDeviceAttributeMultiprocessorCount, dev);
        if (hipFuncSetAttribute((const void*)mega_fwd, hipFuncAttributeMaxDynamicSharedMemorySize, LDS_BYTES) != hipSuccess) { fprintf(stderr, "kernel_launch: hipFuncSetAttribute failed\n"); }
        if (hipOccupancyMaxActiveBlocksPerMultiprocessor(&per_cu, (const void*)mega_fwd, NTHREADS, LDS_BYTES) != hipSuccess || per_cu < 1) { fprintf(stderr, "kernel_launch: occupancy query failed\n"); per_cu = 1; }
        if (per_cu > 2) per_cu = 2;
        (void)hipGetLastError();
        grid_blocks = cus * per_cu;
        fprintf(stderr, "kernel_launch: %d CUs x %d blocks\n", cus, per_cu);
    }
    if (grid_blocks < 0) return;
    Params p{};
    p.x = (const float*)d_in[0]; p.w_in = (const float*)d_in[1]; p.idx_k_g = (const float*)d_in[2]; p.idx_k_b = (const float*)d_in[3]; p.sinks = (const float*)d_in[4];
    p.w_o = (const float*)d_in[5]; p.ln1_g = (const float*)d_in[6]; p.ln1_b = (const float*)d_in[7]; p.peer_wq = (const float*)d_in[8]; p.peer_subkeys = (const float*)d_in[9];
    p.peer_u = (const float*)d_in[10]; p.peer_v = (const float*)d_in[11]; p.ln2_g = (const float*)d_in[12]; p.ln2_b = (const float*)d_in[13];
    p.out = (float*)d_out; p.ws = (unsigned char*)d_ws;
    p.ph_lo = 0; p.ph_hi = NPHASE;
    if (hipMemsetAsync((unsigned char*)d_ws + WS_BAR, 0, 16384 + 64, stream) != hipSuccess) { fprintf(stderr, "kernel_launch: memset of the barrier words failed\n"); return; }
    void* args[] = {&p};
    hipError_t e = hipLaunchCooperativeKernel((const void*)mega_fwd, dim3(grid_blocks), dim3(NTHREADS), args, LDS_BYTES, stream);
    if (e != hipSuccess) fprintf(stderr, "cooperative launch failed: %s (grid %d)\n", hipGetErrorString(e), grid_blocks);
}
```
